# Optimizing an MI355X kernel written in HIP

```python
import jax, jax.numpy as jnp
from jax import lax
import numpy as np

D_MODEL = 1024
BATCH = 16
SEQ = 2048
DEPTH = 1
DEC_BATCH = 32
DEC_SEQ = 1
PAST_LEN = 16384
PAGE_SIZE = 128

N_MEM = 256
ROPE_THETA = 10000.0
EPS = 1e-6
GLA_HEADS = 4
GLA_DK = D_MODEL // 16
GLA_DV = D_MODEL // 8
GLA_QK = GLA_HEADS * GLA_DK
GLA_WIDTH = GLA_HEADS * GLA_DV
GLA_GATE_RANK = 16
GLA_GATE_NORM = 16.0
GLA_CHUNK = 64
DSA_HEADS = 4
DSA_HEAD_DIM = D_MODEL // 16
DSA_WIDTH = DSA_HEADS * DSA_HEAD_DIM
IDX_HEADS = 4
IDX_DIM = 64
DSA_TOPK_MAX = 256
Q_BLOCK = 128
MEM_HEADS = 4
MEM_HEAD_DIM = D_MODEL // 16
MEM_WIDTH = MEM_HEADS * MEM_HEAD_DIM
MIX_WIDTH = GLA_WIDTH + DSA_WIDTH + MEM_WIDTH
COL_SIZES = (GLA_QK, GLA_QK, GLA_WIDTH, GLA_GATE_RANK, GLA_WIDTH,
             DSA_WIDTH, DSA_WIDTH, DSA_WIDTH, IDX_HEADS * IDX_DIM, IDX_DIM, IDX_HEADS, DSA_WIDTH,
             MEM_WIDTH, MEM_WIDTH)
D_IN = sum(COL_SIZES)

kernel_name = "hymba_gla_dsa_memory_step"


def rmsnorm(x, g):
    xf = x.astype(jnp.float32)
    y = xf * lax.rsqrt(jnp.mean(xf * xf, axis=-1, keepdims=True) + EPS)
    return (y * g.astype(jnp.float32)).astype(x.dtype)


def rope(x, pos):
    d = x.shape[-1]
    inv = ROPE_THETA ** (-jnp.arange(0, d, 2, dtype=jnp.float32) / d)
    ang = pos.astype(jnp.float32)[:, None] * inv[None, :]
    ang = ang.reshape((ang.shape[0],) + (1,) * (x.ndim - 3) + (d // 2,))
    cos, sin = jnp.cos(ang), jnp.sin(ang)
    xf = x.astype(jnp.float32)
    x1, x2 = xf[..., : d // 2], xf[..., d // 2:]
    return jnp.concatenate([x1 * cos - x2 * sin, x2 * cos + x1 * sin], axis=-1).astype(x.dtype)


def split_columns(z):
    offs, acc = [], 0
    for s in COL_SIZES[:-1]:
        acc += s
        offs.append(acc)
    return jnp.split(z, offs, axis=-1)


def project(h, g_in, w_in_l, w_g2, b_g, pos):
    B, T, _ = h.shape
    z = rmsnorm(h, g_in) @ w_in_l
    (gq, gk, gv, glr, ggate, dq, dk, dv, iq, ik, iw, dgate, mq, mgate) = split_columns(z)
    gla_q = gq.reshape(B, T, GLA_HEADS, GLA_DK) * (GLA_DK ** -0.5)
    gla_k = gk.reshape(B, T, GLA_HEADS, GLA_DK)
    gla_v = gv.reshape(B, T, GLA_HEADS, GLA_DV)
    gla_g = (jax.nn.log_sigmoid((glr @ w_g2 + b_g).astype(jnp.float32)) / GLA_GATE_NORM).reshape(B, T, GLA_HEADS, GLA_DK)
    q = rope(dq.reshape(B, T, DSA_HEADS, DSA_HEAD_DIM), pos)
    k = rope(dk.reshape(B, T, DSA_HEADS, DSA_HEAD_DIM), pos)
    v = dv.reshape(B, T, DSA_HEADS, DSA_HEAD_DIM)
    iq = rope(iq.reshape(B, T, IDX_HEADS, IDX_DIM), pos)
    ik = rope(ik, pos)
    iw = iw * (IDX_HEADS ** -0.5)
    mq = mq.reshape(B, T, MEM_HEADS, MEM_HEAD_DIM)
    return gla_q, gla_k, gla_v, gla_g, ggate, q, k, v, iq, ik, iw, dgate, mq, mgate


def gla_scan(q, k, v, g, s0):
    B, T, H, _ = q.shape
    C = GLA_CHUNK if T % GLA_CHUNK == 0 else T
    N = T // C
    chunks = lambda a: a.astype(jnp.float32).reshape(B, N, C, H, a.shape[-1]).transpose(1, 0, 3, 2, 4)
    mask = jnp.tril(jnp.ones((C, C), dtype=bool))

    def step(S, inp):
        qc, kc, vc, gc = inp
        b = jnp.cumsum(gc, axis=2)
        o_inter = jnp.einsum('bhtd,bhdv->bhtv', qc * jnp.exp(b), S)
        diff = b[:, :, :, None, :] - b[:, :, None, :, :]
        decay = jnp.exp(jnp.where(mask[None, None, :, :, None], diff, -jnp.inf))
        A = jnp.einsum('bhtd,bhsd,bhtsd->bhts', qc, kc, decay)
        o = o_inter + jnp.einsum('bhts,bhsv->bhtv', A, vc)
        b_last = b[:, :, -1:, :]
        S_new = jnp.exp(b_last[:, :, 0, :])[..., None] * S + jnp.einsum('bhsd,bhsv->bhdv', kc * jnp.exp(b_last - b), vc)
        return S_new, o

    S_fin, o = lax.scan(step, s0.astype(jnp.float32), (chunks(q), chunks(k), chunks(v), chunks(g)))
    o = o.transpose(1, 0, 3, 2, 4).reshape(B, T, H, v.shape[-1])
    return o.astype(v.dtype), S_fin.astype(v.dtype)


def index_scores(iq, ik, iw):
    r = jax.nn.relu(jnp.einsum('bqhd,bsd->bqhs', iq, ik).astype(jnp.float32))
    return jnp.einsum('bqh,bqhs->bqs', iw.astype(jnp.float32), r)


def sparse_attend(q, kg, vg, valid):
    s = jnp.einsum('bqhd,bqkhd->bqhk', q, kg).astype(jnp.float32) * (q.shape[-1] ** -0.5)
    p = jax.nn.softmax(jnp.where(valid[:, :, None, :], s, -jnp.inf), axis=-1)
    return jnp.einsum('bqhk,bqkhd->bqhd', p.astype(vg.dtype), vg)


def gather_rows(a, idx):
    return jax.vmap(lambda ab, ib: ab[ib])(a, idx)


def dsa_prompt(q, k, v, iq, ik, iw):
    B, T = q.shape[:2]
    topk = min(DSA_TOPK_MAX, T // 4)
    nb = T // Q_BLOCK
    kpos = jnp.arange(T)
    blocks = lambda a: a.reshape((B, nb, Q_BLOCK) + a.shape[2:]).swapaxes(0, 1)

    def one(args):
        qb, iqb, iwb, qpos = args
        sc = index_scores(iqb, ik, iwb)
        sc = jnp.where(kpos[None, None, :] <= qpos[None, :, None], sc, -jnp.inf)
        _, idx = lax.top_k(sc, topk)
        valid = idx <= qpos[None, :, None]
        return sparse_attend(qb, gather_rows(k, idx), gather_rows(v, idx), valid)

    out = lax.map(one, (blocks(q), blocks(iq), blocks(iw), kpos.reshape(nb, Q_BLOCK)))
    return out.swapaxes(0, 1).reshape(B, T, DSA_HEADS, DSA_HEAD_DIM)


def dsa_sample(q, k, v, iq, ik, iw, ck, cv, cik, page_table):
    Bd, Tn = q.shape[:2]
    past = page_table.shape[1] * PAGE_SIZE
    L = past + Tn
    topk = min(DSA_TOPK_MAX, L // 4)
    past_ik = cik[page_table].reshape(Bd, past, IDX_DIM)
    ik_all = jnp.concatenate([past_ik, ik], axis=1)
    qpos = past + jnp.arange(Tn)
    kpos = jnp.arange(L)
    sc = index_scores(iq, ik_all, iw)
    sc = jnp.where(kpos[None, None, :] <= qpos[None, :, None], sc, -jnp.inf)
    _, idx = lax.top_k(sc, topk)
    valid = idx <= qpos[None, :, None]
    in_past = (idx < past)[..., None, None]
    pidx = jnp.minimum(idx, past - 1)
    phys = jax.vmap(lambda pt, i: pt[i // PAGE_SIZE])(page_table, pidx) * PAGE_SIZE + pidx % PAGE_SIZE
    nidx = jnp.clip(idx - past, 0, Tn - 1)
    kg = jnp.where(in_past, ck.reshape(-1, DSA_HEADS, DSA_HEAD_DIM)[phys], gather_rows(k, nidx))
    vg = jnp.where(in_past, cv.reshape(-1, DSA_HEADS, DSA_HEAD_DIM)[phys], gather_rows(v, nidx))
    return sparse_attend(q, kg, vg, valid)


def mem_kv(mem, g, w):
    B = mem.shape[0]
    mk, mv = jnp.split(rmsnorm(mem, g) @ w, 2, axis=-1)
    shp = (B, mem.shape[1], MEM_HEADS, MEM_HEAD_DIM)
    return mk.reshape(shp), mv.reshape(shp)


def mem_attend(q, mk, mv):
    s = jnp.einsum('bthd,bmhd->bhtm', q, mk).astype(jnp.float32) * (MEM_HEAD_DIM ** -0.5)
    p = jax.nn.softmax(s, axis=-1)
    return jnp.einsum('bhtm,bmhd->bthd', p.astype(mv.dtype), mv)


def combine(gla_o, dsa_o, mem_o, ggate, dgate, mgate, onorm, w_out_l):
    B, T = gla_o.shape[:2]
    a = rmsnorm(gla_o, onorm).reshape(B, T, GLA_WIDTH) * jax.nn.silu(ggate)
    b = dsa_o.reshape(B, T, DSA_WIDTH) * jax.nn.silu(dgate)
    m = mem_o.reshape(B, T, MEM_WIDTH) * jax.nn.silu(mgate)
    return jnp.concatenate([a, b, m], axis=-1) @ w_out_l


def setup_inputs(seed: int = 0) -> dict:
    key = jax.random.key(seed)
    ks = jax.random.split(key, 20)
    n_pages = PAST_LEN // PAGE_SIZE
    n_used = DEC_BATCH * n_pages
    n_pool = (5 * n_used + 3) // 4
    nrm = lambda k, shape, scale=1.0: jax.random.normal(k, shape, jnp.float32) * scale
    return {
        "x_prompt": nrm(ks[0], (BATCH, SEQ, D_MODEL)),
        "x_sample": nrm(ks[1], (DEC_BATCH, DEC_SEQ, D_MODEL)),
        "mem_prompt": nrm(ks[2], (BATCH, N_MEM, D_MODEL)),
        "state_gla": nrm(ks[3], (DEPTH, DEC_BATCH, GLA_HEADS, GLA_DK, GLA_DV), 0.5),
        "cache_k": nrm(ks[4], (n_pool, DEPTH, PAGE_SIZE, DSA_HEADS, DSA_HEAD_DIM)),
        "cache_v": nrm(ks[5], (n_pool, DEPTH, PAGE_SIZE, DSA_HEADS, DSA_HEAD_DIM)),
        "cache_ik": nrm(ks[6], (n_pool, DEPTH, PAGE_SIZE, IDX_DIM)),
        "cache_mem_k": nrm(ks[7], (DEPTH, DEC_BATCH, N_MEM, MEM_HEADS, MEM_HEAD_DIM)),
        "cache_mem_v": nrm(ks[8], (DEPTH, DEC_BATCH, N_MEM, MEM_HEADS, MEM_HEAD_DIM)),
        "page_table": jax.random.permutation(ks[9], n_pool)[:n_used].reshape(DEC_BATCH, n_pages).astype(jnp.int32),
        "norm_in": 1.0 + nrm(ks[10], (DEPTH, D_MODEL), 0.01),
        "w_in": nrm(ks[11], (DEPTH, D_MODEL, D_IN), D_MODEL ** -0.5),
        "w_gla_g2": nrm(ks[12], (DEPTH, GLA_GATE_RANK, GLA_QK), GLA_GATE_RANK ** -0.5),
        "b_gla_g": nrm(ks[13], (DEPTH, GLA_QK), 0.01),
        "gla_onorm": 1.0 + nrm(ks[14], (DEPTH, GLA_DV), 0.01),
        "mem_norm": 1.0 + nrm(ks[15], (DEPTH, D_MODEL), 0.01),
        "w_mem_kv": nrm(ks[16], (DEPTH, D_MODEL, 2 * MEM_WIDTH), D_MODEL ** -0.5),
        "w_out": nrm(ks[17], (DEPTH, MIX_WIDTH, D_MODEL), MIX_WIDTH ** -0.5),
        "norm_final": 1.0 + nrm(ks[18], (D_MODEL,), 0.01),
    }


def reference(x_prompt, x_sample, mem_prompt, state_gla, cache_k, cache_v, cache_ik, cache_mem_k, cache_mem_v,
              page_table, norm_in, w_in, w_gla_g2, b_gla_g, gla_onorm, mem_norm, w_mem_kv, w_out, norm_final):
    Bp, Tp, _ = x_prompt.shape
    Bs, Ts, _ = x_sample.shape
    past = page_table.shape[1] * PAGE_SIZE
    pos_p = jnp.arange(Tp)
    pos_s = past + jnp.arange(Ts)
    hp, hs = x_prompt, x_sample
    gla_p, k_p, v_p, ik_p, mk_p, mv_p = [], [], [], [], [], []
    gla_s, k_s, v_s, ik_s = [], [], [], []
    for l in range(DEPTH):
        (gq, gk, gv, gg, ggate, q, k, v, iq, ik, iw, dgate, mq, mgate) = project(
            hp, norm_in[l], w_in[l], w_gla_g2[l], b_gla_g[l], pos_p)
        s0 = jnp.zeros((Bp, GLA_HEADS, GLA_DK, GLA_DV), jnp.float32)
        gla_o, S_p = gla_scan(gq, gk, gv, gg, s0)
        dsa_o = dsa_prompt(q, k, v, iq, ik, iw)
        mk, mv = mem_kv(mem_prompt, mem_norm[l], w_mem_kv[l])
        mem_o = mem_attend(mq, mk, mv)
        hp = hp + combine(gla_o, dsa_o, mem_o, ggate, dgate, mgate, gla_onorm[l], w_out[l])
        gla_p.append(S_p); k_p.append(k); v_p.append(v); ik_p.append(ik); mk_p.append(mk); mv_p.append(mv)
        (gq, gk, gv, gg, ggate, q, k, v, iq, ik, iw, dgate, mq, mgate) = project(
            hs, norm_in[l], w_in[l], w_gla_g2[l], b_gla_g[l], pos_s)
        gla_o, S_s = gla_scan(gq, gk, gv, gg, state_gla[l])
        dsa_o = dsa_sample(q, k, v, iq, ik, iw, cache_k[:, l], cache_v[:, l], cache_ik[:, l], page_table)
        mem_o = mem_attend(mq, cache_mem_k[l], cache_mem_v[l])
        hs = hs + combine(gla_o, dsa_o, mem_o, ggate, dgate, mgate, gla_onorm[l], w_out[l])
        gla_s.append(S_s); k_s.append(k); v_s.append(v); ik_s.append(ik)
    y_prompt = rmsnorm(hp, norm_final)
    y_sample = rmsnorm(hs, norm_final)
    return (y_prompt, y_sample,
            jnp.stack(gla_p, axis=0), jnp.stack(k_p, axis=1), jnp.stack(v_p, axis=1), jnp.stack(ik_p, axis=1),
            jnp.stack(mk_p, axis=0), jnp.stack(mv_p, axis=0),
            jnp.stack(gla_s, axis=0), jnp.stack(k_s, axis=1), jnp.stack(v_s, axis=1), jnp.stack(ik_s, axis=1))
```

```cpp
#include <hip/hip_runtime.h>
#include <cstdint>
#include <cstdio>
namespace pg8 {
#define PG8_LAS __attribute__((address_space(3)))
typedef unsigned short bf16_t;
typedef short bf16x8 __attribute__((ext_vector_type(8)));
typedef float f32x4 __attribute__((ext_vector_type(4)));
typedef unsigned u32x4 __attribute__((ext_vector_type(4)));
constexpr int BM = 256, BK = 64, HALF = 128, HTB = HALF * BK * 2  , STAGE_BYTES = 8 * HTB, NXCD = 8, WGM = 8;

__host__ __device__ __forceinline__ int lds_byte(int r, int c) { const int st = (r >> 4) * 2 + (c >> 5), rr = r & 15, cc = c & 31, ob = rr * 64 + cc * 2; return st * 1024 + (ob ^ (((ob >> 9) & 1) << 5)); }
__host__ __device__ __forceinline__ void stage_rc(int b, int& R, int& C) { const int st = b / 1024, sb = b % 1024, swz = sb ^ (((sb >> 9) & 1) << 5); R = (st >> 1) * 16 + swz / 64; C = (st & 1) * 32 + (swz % 64) / 2; }
__host__ __device__ __forceinline__ int perm32(int rho) { const int n = rho >> 4, i = rho & 15; return 8 * (i >> 2) + 4 * n + (i & 3); }

struct Unit { int pm, pn; };
struct Gemm { const bf16_t* A; const bf16_t* Bt; int M, N, K; };

struct StaticOrder {
    int nM, nN, nwg, G, c;
    __host__ __device__ void init(int M, int N, int G_, int c_) { nM = M / BM; nN = N / BM; nwg = nM * nN; G = G_; c = c_; }
    __host__ __device__ bool next(int i, Unit& u) const {
        const long L = (long)i * G + c; if (L >= nwg) return false;
        int wgid = (int)L; { const int q = nwg / NXCD, r = nwg % NXCD, xcd = wgid % NXCD, off = wgid / NXCD; wgid = (xcd < r ? xcd * (q + 1) : r * (q + 1) + (xcd - r) * q) + off; }
        const int nig = WGM * nN, gid = wgid / nig, fm = gid * WGM, gsz = (nM - fm) < WGM ? (nM - fm) : WGM;
        u.pm = fm + ((wgid % nig) % gsz); u.pn = (wgid % nig) / gsz; return true;
    }
    __device__ __forceinline__ void a_ready(const Unit&) const {}
    __device__ __forceinline__ void done(const Unit&) const {}
};

template <class Epi, class Sched, bool ALIGN_EPI = false, bool SP2 = false>
__device__ __forceinline__ void gemm_phase(PG8_LAS unsigned char* lds, const Gemm g, const Sched& S, const Epi& E) {
    const int tid = threadIdx.x, wid = __builtin_amdgcn_readfirstlane(tid >> 6), lane = tid & 63, wr = wid >> 2, wc = wid & 3, fr = lane & 15, fq = lane >> 4;
    const int K = g.K, nt = K / BK;
    unsigned voffA[2], voffB[2];
#pragma unroll
    for (int i = 0; i < 2; ++i) { int R, C; stage_rc(tid * 16 + i * 8192, R, C); const int Rb = Epi::PERM ? ((R & ~31) + perm32(R & 31)) : R;
        voffA[i] = (unsigned)(R * K + C) * 2u; voffB[i] = (unsigned)(Rb * K + C) * 2u; }
    const size_t kstep = (size_t)(BK * 2);
    const size_t hstep = (size_t)HALF * K * 2;
    const size_t tstep = 2 * hstep;
    const unsigned ldsw = (unsigned)wid * 1024u;
    const int aoff = lds_byte(wr * 64 + fr, fq * 8), boff = lds_byte(wc * 32 + fr, fq * 8);
#define PG8_SA(b, h) (((b) * 2 + (h)) * HTB)
#define PG8_SB(b, h) ((4 + (b) * 2 + (h)) * HTB)
#define PG8_STAGE(bufoff, gbase, voff) do { _Pragma("unroll") for (int _i = 0; _i < 2; ++_i) \
        __builtin_amdgcn_global_load_lds((const unsigned*)((const char*)(gbase) + (voff)[_i]), (PG8_LAS unsigned*)(lds + (bufoff) + ldsw + _i * 8192), 16, 0, 0); } while (0)
#define PG8_LDA(dst, b, h) do { _Pragma("unroll") for (int m = 0; m < 4; ++m) _Pragma("unroll") for (int k = 0; k < 2; ++k) dst[m][k] = *(const PG8_LAS bf16x8*)(lds + PG8_SA(b, h) + aoff + m * 2048 + k * 1024); } while (0)
#define PG8_LDB(dst, b, h) do { _Pragma("unroll") for (int n = 0; n < 2; ++n) _Pragma("unroll") for (int k = 0; k < 2; ++k) dst[n][k] = *(const PG8_LAS bf16x8*)(lds + PG8_SB(b, h) + boff + n * 2048 + k * 1024); } while (0)
#define PG8_MMA(ai, bj, At, Bt) do { __builtin_amdgcn_s_setprio(1); _Pragma("unroll") for (int m = 0; m < 4; ++m) _Pragma("unroll") for (int n = 0; n < 2; ++n) _Pragma("unroll") for (int k = 0; k < 2; ++k) \
        acc[ai][bj][m][n] = __builtin_amdgcn_mfma_f32_16x16x32_bf16(Bt[n][k], At[m][k], acc[ai][bj][m][n], 0, 0, 0); __builtin_amdgcn_s_setprio(0); } while (0)
#define PG8_WAIT_V(n) asm volatile("s_waitcnt vmcnt(" #n ")" ::: "memory")
#define PG8_WAIT_L(n) asm volatile("s_waitcnt lgkmcnt(" #n ")" ::: "memory")
#define PG8_BAR __builtin_amdgcn_s_barrier()
#define PG8_SCHED __builtin_amdgcn_sched_barrier(0)
    Unit cur, nxt; int ui = 0;
    if (!S.next(0, cur)) return;
    f32x4 acc[2][2][4][2];
#pragma unroll
    for (int a = 0; a < 2; ++a)
#pragma unroll
        for (int b = 0; b < 2; ++b)
#pragma unroll
            for (int m = 0; m < 4; ++m)
#pragma unroll
                for (int n = 0; n < 2; ++n) acc[a][b][m][n] = (f32x4){0.f, 0.f, 0.f, 0.f};
    bf16x8 At[4][2], B0[2][2], B1[2][2];
    const char* cA = (const char*)g.A + (size_t)cur.pm * tstep; const char* cB = (const char*)g.Bt + (size_t)cur.pn * tstep;
    S.a_ready(cur);
    if constexpr (SP2) {
        PG8_STAGE(PG8_SB(0, 0), cB, voffB); PG8_STAGE(PG8_SB(0, 1), cB + hstep, voffB); PG8_STAGE(PG8_SA(0, 0), cA, voffA); PG8_STAGE(PG8_SA(0, 1), cA + hstep, voffA);
        if (wr == 1) PG8_BAR;
        PG8_WAIT_V(2); PG8_BAR;
        PG8_STAGE(PG8_SB(1, 0), cB + kstep, voffB); PG8_STAGE(PG8_SA(1, 0), cA + kstep, voffA); PG8_STAGE(PG8_SB(1, 1), cB + hstep + kstep, voffB);
        PG8_WAIT_V(6); PG8_BAR;
    } else {
        PG8_STAGE(PG8_SB(0, 0), cB, voffB); PG8_STAGE(PG8_SA(0, 0), cA, voffA); PG8_STAGE(PG8_SB(0, 1), cB + hstep, voffB); PG8_STAGE(PG8_SA(0, 1), cA + hstep, voffA);
        if (wr == 1) PG8_BAR;
        PG8_WAIT_V(4); PG8_BAR;
        PG8_STAGE(PG8_SB(1, 0), cB + kstep, voffB); PG8_STAGE(PG8_SA(1, 0), cA + kstep, voffA); PG8_STAGE(PG8_SB(1, 1), cB + hstep + kstep, voffB);
        PG8_WAIT_V(6); PG8_BAR;
    }
    for (;;) {
        const bool has_next = S.next(ui + 1, nxt);
        const char* nA = has_next ? (const char*)g.A + (size_t)nxt.pm * tstep : cA; const char* nB = has_next ? (const char*)g.Bt + (size_t)nxt.pn * tstep : cB;
        for (int t = 0; t < nt; t += 2) {
            const bool last = (t == nt - 2);
            const char* a1 = cA + (size_t)(t + 1) * kstep;
            const char* a2 = last ? nA : cA + (size_t)(t + 2) * kstep; const char* b2 = last ? nB : cB + (size_t)(t + 2) * kstep;
            const char* a3 = a2 + kstep; const char* b3 = b2 + kstep;
            if (last && has_next) S.a_ready(nxt);
            if constexpr (SP2) {
            PG8_LDB(B0, 0, 0); PG8_LDB(B1, 0, 1); PG8_SCHED; PG8_LDA(At, 0, 0); PG8_STAGE(PG8_SA(1, 1), a1 + hstep, voffA);
            PG8_WAIT_V(8); PG8_WAIT_L(0); PG8_BAR; PG8_MMA(0, 0, At, B0); PG8_MMA(0, 1, At, B1); PG8_BAR; PG8_SCHED;
            PG8_LDA(At, 0, 1); PG8_STAGE(PG8_SB(0, 0), b2, voffB); PG8_STAGE(PG8_SB(0, 1), b2 + hstep, voffB); PG8_STAGE(PG8_SA(0, 0), a2, voffA);
            PG8_WAIT_V(8); PG8_WAIT_L(0); PG8_BAR; PG8_MMA(1, 0, At, B0); PG8_MMA(1, 1, At, B1); PG8_BAR; PG8_SCHED;
            PG8_LDB(B0, 1, 0); PG8_LDB(B1, 1, 1); PG8_SCHED; PG8_LDA(At, 1, 0); PG8_STAGE(PG8_SA(0, 1), a2 + hstep, voffA);
            PG8_WAIT_V(8); PG8_WAIT_L(0); PG8_BAR; PG8_MMA(0, 0, At, B0); PG8_MMA(0, 1, At, B1); PG8_BAR; PG8_SCHED;
            PG8_LDA(At, 1, 1); PG8_STAGE(PG8_SB(1, 0), b3, voffB); PG8_STAGE(PG8_SB(1, 1), b3 + hstep, voffB); PG8_STAGE(PG8_SA(1, 0), a3, voffA);
            PG8_WAIT_V(8); PG8_WAIT_L(0); PG8_BAR; PG8_MMA(1, 0, At, B0); PG8_MMA(1, 1, At, B1); PG8_BAR; PG8_SCHED;
            } else {
            PG8_LDB(B0, 0, 0); PG8_SCHED; PG8_LDA(At, 0, 0); PG8_STAGE(PG8_SA(1, 1), a1 + hstep, voffA);
            PG8_WAIT_L(8); PG8_BAR; PG8_WAIT_L(0); PG8_MMA(0, 0, At, B0); PG8_BAR; PG8_SCHED;
            PG8_LDB(B1, 0, 1); PG8_STAGE(PG8_SB(0, 0), b2, voffB);
            PG8_BAR; PG8_WAIT_L(0); PG8_MMA(0, 1, At, B1); PG8_BAR;
            PG8_LDA(At, 0, 1); PG8_STAGE(PG8_SA(0, 0), a2, voffA);
            PG8_BAR; PG8_WAIT_L(0); PG8_MMA(1, 0, At, B0); PG8_BAR; PG8_SCHED;
            PG8_STAGE(PG8_SB(0, 1), b2 + hstep, voffB);
            PG8_WAIT_V(6); PG8_BAR; PG8_MMA(1, 1, At, B1); PG8_BAR;
            PG8_LDB(B0, 1, 0); PG8_SCHED; PG8_LDA(At, 1, 0); PG8_STAGE(PG8_SA(0, 1), a2 + hstep, voffA);
            PG8_WAIT_L(8); PG8_BAR; PG8_WAIT_L(0); PG8_MMA(0, 0, At, B0); PG8_BAR; PG8_SCHED;
            PG8_LDB(B1, 1, 1); PG8_STAGE(PG8_SB(1, 0), b3, voffB);
            PG8_BAR; PG8_WAIT_L(0); PG8_MMA(0, 1, At, B1); PG8_BAR;
            PG8_LDA(At, 1, 1); PG8_STAGE(PG8_SA(1, 0), a3, voffA);
            PG8_BAR; PG8_WAIT_L(0); PG8_MMA(1, 0, At, B0); PG8_BAR; PG8_SCHED;
            PG8_STAGE(PG8_SB(1, 1), b3 + hstep, voffB);
            PG8_WAIT_V(6); PG8_BAR; PG8_MMA(1, 1, At, B1); PG8_BAR;
            }
        }
        if constexpr (ALIGN_EPI) { if (wr == 0) PG8_BAR; }
        if constexpr (!Epi::AFTER_DRAIN) { E(acc, cur, wr, wc, fr, fq); S.done(cur); }
        if (!has_next) break;
#pragma unroll
        for (int a = 0; a < 2; ++a)
#pragma unroll
            for (int b = 0; b < 2; ++b)
#pragma unroll
                for (int m = 0; m < 4; ++m)
#pragma unroll
                    for (int n = 0; n < 2; ++n) acc[a][b][m][n] = (f32x4){0.f, 0.f, 0.f, 0.f};
        cur = nxt; cA = nA; cB = nB; ++ui;
        if constexpr (ALIGN_EPI) { if (wr == 1) PG8_BAR; }
    }
    PG8_WAIT_V(0);
    if constexpr (!ALIGN_EPI) { if (wr == 0) PG8_BAR; }
    PG8_BAR;
    if constexpr (Epi::AFTER_DRAIN) { E.fused(acc, cur, wr, wc, fr, fq, lds, wid, lane); S.done(cur); }
#undef PG8_SA
#undef PG8_SB
#undef PG8_STAGE
#undef PG8_LDA
#undef PG8_LDB
#undef PG8_MMA
#undef PG8_WAIT_V
#undef PG8_WAIT_L
#undef PG8_BAR
#undef PG8_SCHED
}
}
#define XB_TMO      128
#define XB_XCNT(j)  (256  + 64 * (j))
#define XB_XSUB(j)  (1280 + 64 * (j))
#define XB_XGEN(j)  (2304 + 64 * (j))
#define XB_TOP      3328
#define XB_TOPGEN   3392
#define XCD_BAR_WORDS 3456
#define XB_SPIN_CAP (1u << 18)
#define LAS __attribute__((address_space(3)))

__device__ __forceinline__ unsigned xb_ld(unsigned* p)              { return __hip_atomic_load(p, __ATOMIC_RELAXED, __HIP_MEMORY_SCOPE_AGENT); }
__device__ __forceinline__ unsigned xb_add(unsigned* p, unsigned v) { return __hip_atomic_fetch_add(p, v, __ATOMIC_RELAXED, __HIP_MEMORY_SCOPE_AGENT); }
__device__ __forceinline__ unsigned xb_xcc_id() { return (unsigned)__builtin_amdgcn_s_getreg((3 << 11) | 20) & 0xFu; }
#define XB_SPIN(cond, bar) do { unsigned _sp = 0; while (cond) { __builtin_amdgcn_s_sleep(1); \
    if ((++_sp & 255u) == 0u) { if (xb_ld(&(bar)[XB_TMO])) break; if (_sp > XB_SPIN_CAP) { atomicAdd(&(bar)[XB_TMO], 1u); break; } } } } while (0)

struct XcdBarrier {
    unsigned* bar; unsigned x;
    volatile LAS unsigned* st;
};

__device__ __forceinline__ XcdBarrier xcd_barrier_post(unsigned* bar, volatile LAS unsigned* st) {
    XcdBarrier b; b.bar = bar; b.x = xb_xcc_id(); b.st = st;
    if (threadIdx.x == 0) (void)xb_add(&bar[XB_XCNT(b.x)], 1u);
    return b;
}
__device__ __forceinline__ void xcd_barrier_complete(unsigned* bar, unsigned x, unsigned& nloc, unsigned& nx) {
    const unsigned G = gridDim.x * gridDim.y * gridDim.z;
    unsigned sum, cnt, mine, sp = 0u;
    for (;;) {
        sum = 0u; cnt = 0u; mine = 0u;
#pragma unroll
        for (unsigned j = 0; j < 16; ++j) { const unsigned c = xb_ld(&bar[XB_XCNT(j)]); sum += c; cnt += (c > 0u) ? 1u : 0u; mine = (j == x) ? c : mine; }
        if (sum == G) break;
        __builtin_amdgcn_s_sleep(1);
        if ((++sp & 255u) == 0u) { if (xb_ld(&bar[XB_TMO])) break; if (sp > XB_SPIN_CAP) { atomicAdd(&bar[XB_TMO], 1u); break; } }
    }
    nloc = mine > 0u ? mine : 1u; nx = cnt > 0u ? cnt : 1u;
}

__device__ __forceinline__ void xcd_barrier(const XcdBarrier& b) {
    asm volatile("s_waitcnt vmcnt(0)" ::: "memory");
    __syncthreads();
    if (threadIdx.x == 0) {
        unsigned* bar = b.bar;
        __builtin_amdgcn_s_waitcnt(0);
        unsigned nloc = b.st[0], nx = b.st[1];
        if (nloc == 0u) { xcd_barrier_complete(bar, b.x, nloc, nx); b.st[0] = nloc; b.st[1] = nx; }
        const unsigned old = xb_add(&bar[XB_XSUB(b.x)], 1u);
        const unsigned gen = old / nloc;
        if (old + 1u == (gen + 1u) * nloc) {
            __builtin_amdgcn_fence(__ATOMIC_RELEASE, "agent");
            asm volatile("s_waitcnt vmcnt(0)" ::: "memory");
            const unsigned og = xb_add(&bar[XB_TOP], 1u);
            const unsigned tg = og / nx;
            if (og + 1u == (tg + 1u) * nx) xb_add(&bar[XB_TOPGEN], 1u);
            else XB_SPIN(xb_ld(&bar[XB_TOPGEN]) == tg, bar);
            __builtin_amdgcn_fence(__ATOMIC_ACQUIRE, "agent");
            xb_add(&bar[XB_XGEN(b.x)], 1u);
            asm volatile("s_waitcnt vmcnt(0)" ::: "memory");
        } else {
            XB_SPIN(xb_ld(&bar[XB_XGEN(b.x)]) == gen, bar);
            __builtin_amdgcn_fence(__ATOMIC_ACQUIRE, "agent");
            asm volatile("s_waitcnt vmcnt(0)" ::: "memory");
        }
    }
    __syncthreads();
}
#define DI __device__ __forceinline__
#define LAS3 __attribute__((address_space(3)))
using pg8::bf16_t; using pg8::bf16x8; using pg8::f32x4; using pg8::u32x4;
typedef unsigned u32x2 __attribute__((ext_vector_type(2)));
typedef short s16x4 __attribute__((ext_vector_type(4)));
typedef float f32x2 __attribute__((ext_vector_type(2)));
typedef __bf16 bf16x2_t __attribute__((ext_vector_type(2)));

constexpr int DM = 1024, NB = 16, SEQ = 2048, MP = NB * SEQ  , NDB = 32  , MROWS = 33024  ;
constexpr int NMEM = 256, MMEM = NB * NMEM  , DIN = 3412, NIN = 3584, NPAGES = 128;
constexpr int NTHREADS = 512;
constexpr size_t O_YP = 0, O_YS = O_YP + (size_t)MP * DM, O_GSP = O_YS + (size_t)NDB * DM, O_KP = O_GSP + (size_t)NB * 4 * 64 * 128,
                 O_VP = O_KP + (size_t)MP * 256, O_IKP = O_VP + (size_t)MP * 256, O_MKP = O_IKP + (size_t)MP * 64, O_MVP = O_MKP + (size_t)MMEM * 256,
                 O_GSS = O_MVP + (size_t)MMEM * 256, O_KS = O_GSS + (size_t)NDB * 4 * 64 * 128, O_VS = O_KS + (size_t)NDB * 256, O_IKS = O_VS + (size_t)NDB * 256,
                 O_END = O_IKS + (size_t)NDB * 64;
static_assert(O_END == 56150016, "output size");
constexpr size_t al256(size_t x) { return (x + 255) & ~(size_t)255; }
constexpr size_t CTRL_BYTES = 32768;
constexpr size_t CW_QDSA = 16384  , CW_QMEM = 18432  , CW_SCNT = 20480, CW_TMO = 20736, CW_CHK = 20992, CW_TSUM = 21248, CW_TMAX = 21504;
constexpr int SCLD = 16400;
constexpr size_t W_ROPE = CTRL_BYTES;
constexpr size_t W_XN = al256(W_ROPE + (size_t)2049 * 32 * 8);
constexpr size_t W_MEMN = W_XN + (size_t)MROWS * 1024 * 2;
constexpr size_t W_WTIN = W_MEMN + (size_t)MMEM * 1024 * 2;
constexpr size_t W_WTMEM = W_WTIN + (size_t)NIN * 1024 * 2;
constexpr size_t W_WTOUT = W_WTMEM + (size_t)512 * 1024 * 2;
constexpr size_t W_GQ = W_WTOUT + (size_t)1024 * 1024 * 2;
constexpr size_t W_GK = W_GQ + (size_t)MROWS * 256 * 2;
constexpr size_t W_GV = W_GK + (size_t)MROWS * 256 * 2;
constexpr size_t W_GG = W_GV + (size_t)MROWS * 512 * 2;
constexpr size_t W_DQ = W_GG + (size_t)MROWS * 512 * 2;
constexpr size_t W_DK = W_DQ + (size_t)MROWS * 256 * 2;
constexpr size_t W_DVT = W_DK + (size_t)MROWS * 256 * 2;
constexpr size_t W_IQ = W_DVT + (size_t)MP * 256 * 2;
constexpr size_t W_DG = W_IQ + (size_t)MROWS * 256 * 2;
constexpr size_t W_MQ = W_DG + (size_t)MROWS * 256 * 2;
constexpr size_t W_MG = W_MQ + (size_t)MROWS * 256 * 2;
constexpr size_t W_IK = W_MG + (size_t)MROWS * 256 * 2;
constexpr size_t W_IW = W_IK + (size_t)MROWS * 64 * 2;
constexpr size_t W_GLR = W_IW + (size_t)MROWS * 4 * 4;
constexpr size_t W_MK = W_GLR + (size_t)MROWS * 16 * 4;
constexpr size_t W_MVT = W_MK + (size_t)MMEM * 256 * 2;
constexpr size_t W_MIX = W_MVT + (size_t)MMEM * 256 * 2;
constexpr size_t W_SC = W_MIX + (size_t)MROWS * 1024 * 2;
constexpr size_t W_END = W_SC + (size_t)NDB * SCLD * 4;
constexpr int LDS_MISC = 131072, LDS_BYTES = 131072 + 256;

struct Params {
    const float *x_prompt, *x_sample, *mem_prompt, *state_gla, *cache_k, *cache_v, *cache_ik, *cache_mem_k, *cache_mem_v;
    const int* page_table;
    const float *norm_in, *w_in, *w_g2, *b_g, *onorm, *mem_norm, *w_mem_kv, *w_out, *norm_final;
    float* out; unsigned char* ws; int ph_lo, ph_hi;
};

#ifdef TSEL
#define TDECL unsigned tacc_ = 0u, tbeg_ = 0u
#define TBEG(k) do { if ((k) == TSEL) tbeg_ = (unsigned)__builtin_amdgcn_s_memrealtime(); } while (0)
#define TEND(k) do { if ((k) == TSEL) tacc_ += (unsigned)__builtin_amdgcn_s_memrealtime() - tbeg_; } while (0)
#define TARGS , unsigned& tacc_, unsigned& tbeg_
#define TPASS , tacc_, tbeg_
#else
#define TARGS
#define TPASS
#define TDECL do {} while (0)
#define TBEG(k) do {} while (0)
#define TEND(k) do {} while (0)
#endif
DI float bf2f(bf16_t v) { return __uint_as_float((unsigned)v << 16); }
DI unsigned cvtpk(float lo, float hi) { f32x2 v = {lo, hi}; bf16x2_t b = __builtin_convertvector(v, bf16x2_t); return __builtin_bit_cast(unsigned, b); }
DI bf16_t f2bf(float x) { return (bf16_t)(cvtpk(x, 0.f) & 0xffffu); }
DI f32x4 mfma16(bf16x8 a, bf16x8 b, f32x4 c) { return __builtin_amdgcn_mfma_f32_16x16x32_bf16(a, b, c, 0, 0, 0); }
DI float siluf(float x) { return x / (1.f + __expf(-x)); }
DI float logsigf(float u) { return fminf(u, 0.f) - log1pf(expf(-fabsf(u))); }
DI unsigned fkey(float x) { unsigned u = __float_as_uint(x); u = (u == 0x80000000u) ? 0u : u; return u ^ ((unsigned)((int)u >> 31) | 0x80000000u); }
DI float wsum64(float v) { v += __shfl_xor(v, 1); v += __shfl_xor(v, 2); v += __shfl_xor(v, 4); v += __shfl_xor(v, 8); v += __shfl_xor(v, 16); v += __shfl_xor(v, 32); return v; }
DI float wmax64(float v) { v = fmaxf(v, __shfl_xor(v, 1)); v = fmaxf(v, __shfl_xor(v, 2)); v = fmaxf(v, __shfl_xor(v, 4)); v = fmaxf(v, __shfl_xor(v, 8)); v = fmaxf(v, __shfl_xor(v, 16)); v = fmaxf(v, __shfl_xor(v, 32)); return v; }
DI unsigned lds_add(LAS3 unsigned* p, unsigned v) { return __hip_atomic_fetch_add(p, v, __ATOMIC_RELAXED, __HIP_MEMORY_SCOPE_WORKGROUP); }
DI unsigned lds_or(LAS3 unsigned* p, unsigned v) { return __hip_atomic_fetch_or(p, v, __ATOMIC_RELAXED, __HIP_MEMORY_SCOPE_WORKGROUP); }
DI void st_bf16x4(bf16_t* p, f32x4 v) { u32x2 w; w.x = cvtpk(v[0], v[1]); w.y = cvtpk(v[2], v[3]); *(u32x2*)p = w; }
DI const float* vaddr(const float* q) { asm volatile("" : "+v"(q)); return q; }
constexpr float LOG2E = 1.4426950408889634f;
#define NEG_INF (-__builtin_inff())

DI int rope_perm(int vc) { return 64 * (vc >> 6) + 16 * ((vc >> 5) & 1) + (vc & 15) + 32 * ((vc >> 4) & 1); }
DI int in_src(int np) {
    const int pn = np >> 8, vc = np & 255;
    switch (pn) {
        case 0: return vc;
        case 1: return 256 + vc;
        case 2: case 3: return 512 + 256 * (pn - 2) + vc;
        case 4: case 5: return 1040 + 256 * (pn - 4) + vc;
        case 6: return 1552 + rope_perm(vc);
        case 7: return 1808 + rope_perm(vc);
        case 8: return 2064 + vc;
        case 9: return 2320 + rope_perm(vc);
        case 10: return 2644 + vc;
        case 11: return 2900 + vc;
        case 12: return 3156 + vc;
        default: break;
    }
    if (vc < 64) return 2576 + rope_perm(vc);
    if (vc < 68) return 2640 + (vc - 64);
    if (vc < 84) return 1024 + (vc - 68);
    return -1;
}

struct EpiIn {
    static constexpr bool PERM = false, AFTER_DRAIN = false;
    unsigned char* ws; float* out;
    DI void operator()(const f32x4 (&acc)[2][2][4][2], const pg8::Unit& u, int wr, int wc, int fr, int fq) const {
        const int pn = u.pn, rbase = u.pm * 256 + wr * 64 + fr;
        if (pn <= 5 || (pn >= 10 && pn <= 12)) {
            bf16_t* dst; int ldc = 256, coff = 0; float sc = 1.f; bool silu = false;
            switch (pn) {
                case 0: dst = (bf16_t*)(ws + W_GQ); sc = 0.125f; break;
                case 1: dst = (bf16_t*)(ws + W_GK); break;
                case 2: dst = (bf16_t*)(ws + W_GV); ldc = 512; break;
                case 3: dst = (bf16_t*)(ws + W_GV); ldc = 512; coff = 256; break;
                case 4: dst = (bf16_t*)(ws + W_GG); ldc = 512; silu = true; break;
                case 5: dst = (bf16_t*)(ws + W_GG); ldc = 512; coff = 256; silu = true; break;
                case 10: dst = (bf16_t*)(ws + W_DG); silu = true; break;
                case 11: dst = (bf16_t*)(ws + W_MQ); sc = 0.125f; break;
                default: dst = (bf16_t*)(ws + W_MG); silu = true; break;
            }
#pragma unroll
            for (int ai = 0; ai < 2; ++ai)
#pragma unroll
                for (int m = 0; m < 4; ++m) {
                    const int row = rbase + ai * 128 + m * 16;
                    bf16_t* rp = dst + (size_t)row * ldc + coff + wc * 32 + 4 * fq;
#pragma unroll
                    for (int bj = 0; bj < 2; ++bj)
#pragma unroll
                        for (int n = 0; n < 2; ++n) {
                            f32x4 v = acc[ai][bj][m][n];
                            if (silu) { v[0] = siluf(v[0]); v[1] = siluf(v[1]); v[2] = siluf(v[2]); v[3] = siluf(v[3]); } else v = v * sc;
                            st_bf16x4(rp + bj * 128 + n * 16, v);
                        }
                }
        } else if (pn == 6 || pn == 7 || pn == 9) {
            bf16_t* dst = (bf16_t*)(ws + (pn == 6 ? W_DQ : (pn == 7 ? W_DK : W_IQ)));
            const float sc = (pn == 6) ? 0.125f : 1.f;
            const float* rope = (const float*)(ws + W_ROPE);
#pragma unroll
            for (int ai = 0; ai < 2; ++ai)
#pragma unroll
                for (int m = 0; m < 4; ++m) {
                    const int row = rbase + ai * 128 + m * 16;
                    const int pi = row < MP ? (row & 2047) : 2048;
                    const int f0 = 16 * (wc & 1) + 4 * fq;
                    const f32x4 cs0 = *(const f32x4*)(rope + ((size_t)pi * 32 + f0) * 2), cs1 = *(const f32x4*)(rope + ((size_t)pi * 32 + f0) * 2 + 4);
                    const f32x4 c = {cs0[0], cs0[2], cs1[0], cs1[2]}, s = {cs0[1], cs0[3], cs1[1], cs1[3]};
#pragma unroll
                    for (int bj = 0; bj < 2; ++bj) {
                        const f32x4 v0 = acc[ai][bj][m][0], v1 = acc[ai][bj][m][1];
                        const f32x4 o1 = (v0 * c - v1 * s) * sc, o2 = (v1 * c + v0 * s) * sc;
                        const int col1 = 64 * (2 * bj + (wc >> 1)) + f0, col2 = col1 + 32;
                        st_bf16x4(dst + (size_t)row * 256 + col1, o1); st_bf16x4(dst + (size_t)row * 256 + col2, o2);
                        if (pn == 7) {
                            float* op = nullptr;
                            if (row < MP) op = out + O_KP + (size_t)row * 256; else if (row < MP + NDB) op = out + O_KS + (size_t)(row - MP) * 256;
                            if (op) { *(f32x4*)(op + col1) = o1; *(f32x4*)(op + col2) = o2; }
                        }
                    }
                }
        } else if (pn == 8) {
            bf16_t* dvt = (bf16_t*)(ws + W_DVT);
#pragma unroll
            for (int ai = 0; ai < 2; ++ai)
#pragma unroll
                for (int m = 0; m < 4; ++m) {
                    const int row = rbase + ai * 128 + m * 16;
                    float* op = nullptr;
                    if (row < MP) op = out + O_VP + (size_t)row * 256; else if (row < MP + NDB) op = out + O_VS + (size_t)(row - MP) * 256;
#pragma unroll
                    for (int bj = 0; bj < 2; ++bj)
#pragma unroll
                        for (int n = 0; n < 2; ++n) {
                            const f32x4 v = acc[ai][bj][m][n];
                            const int col = 128 * bj + 32 * wc + 16 * n + 4 * fq;
                            if (op) *(f32x4*)(op + col) = v;
                            if (row < MP) {
                                bf16_t* tp = dvt + ((size_t)((row >> 11) * 4 + (col >> 6)) * 64 + (col & 63)) * 2048 + (row & 2047);
                                tp[0] = f2bf(v[0]); tp[2048] = f2bf(v[1]); tp[4096] = f2bf(v[2]); tp[6144] = f2bf(v[3]);
                            }
                        }
                }
        } else {
            bf16_t* ikb = (bf16_t*)(ws + W_IK); float* iw = (float*)(ws + W_IW); float* glr = (float*)(ws + W_GLR);
            const float* rope = (const float*)(ws + W_ROPE);
#pragma unroll
            for (int ai = 0; ai < 2; ++ai)
#pragma unroll
                for (int m = 0; m < 4; ++m) {
                    const int row = rbase + ai * 128 + m * 16;
                    const f32x4 v0 = acc[ai][0][m][0], v1 = acc[ai][0][m][1];
                    if (wc < 2) {
                        const int pi = row < MP ? (row & 2047) : 2048;
                        const int f0 = 16 * wc + 4 * fq;
                        const f32x4 cs0 = *(const f32x4*)(rope + ((size_t)pi * 32 + f0) * 2), cs1 = *(const f32x4*)(rope + ((size_t)pi * 32 + f0) * 2 + 4);
                        const f32x4 c = {cs0[0], cs0[2], cs1[0], cs1[2]}, s = {cs0[1], cs0[3], cs1[1], cs1[3]};
                        const f32x4 o1 = v0 * c - v1 * s, o2 = v1 * c + v0 * s;
                        st_bf16x4(ikb + (size_t)row * 64 + f0, o1); st_bf16x4(ikb + (size_t)row * 64 + f0 + 32, o2);
                        float* op = nullptr;
                        if (row < MP) op = out + O_IKP + (size_t)row * 64; else if (row < MP + NDB) op = out + O_IKS + (size_t)(row - MP) * 64;
                        if (op) { *(f32x4*)(op + f0) = o1; *(f32x4*)(op + f0 + 32) = o2; }
                    } else if (wc == 2) {
                        if (fq == 0) { *(f32x4*)(iw + (size_t)row * 4) = v0 * 0.5f; *(f32x4*)(glr + (size_t)row * 16 + 12) = v1; }
                        else *(f32x4*)(glr + (size_t)row * 16 + 4 * (fq - 1)) = v0;
                    }
                }
        }
    }
};
struct EpiMem {
    static constexpr bool PERM = false, AFTER_DRAIN = false;
    unsigned char* ws; float* out;
    DI void operator()(const f32x4 (&acc)[2][2][4][2], const pg8::Unit& u, int wr, int wc, int fr, int fq) const {
        const int pn = u.pn, rbase = u.pm * 256 + wr * 64 + fr;
        bf16_t* mk = (bf16_t*)(ws + W_MK); bf16_t* mvt = (bf16_t*)(ws + W_MVT);
        float* op0 = out + (pn == 0 ? O_MKP : O_MVP);
#pragma unroll
        for (int ai = 0; ai < 2; ++ai)
#pragma unroll
            for (int m = 0; m < 4; ++m) {
                const int row = rbase + ai * 128 + m * 16;
#pragma unroll
                for (int bj = 0; bj < 2; ++bj)
#pragma unroll
                    for (int n = 0; n < 2; ++n) {
                        const f32x4 v = acc[ai][bj][m][n];
                        const int col = 128 * bj + 32 * wc + 16 * n + 4 * fq;
                        *(f32x4*)(op0 + (size_t)row * 256 + col) = v;
                        if (pn == 0) st_bf16x4(mk + (size_t)row * 256 + col, v);
                        else { bf16_t* tp = mvt + ((size_t)((row >> 8) * 4 + (col >> 6)) * 64 + (col & 63)) * 256 + (row & 255);
                               tp[0] = f2bf(v[0]); tp[256] = f2bf(v[1]); tp[512] = f2bf(v[2]); tp[768] = f2bf(v[3]); }
                    }
            }
    }
};
struct EpiOut {
    static constexpr bool PERM = false, AFTER_DRAIN = false;
    const float* xp; const float* xs; float* out;
    DI void operator()(const f32x4 (&acc)[2][2][4][2], const pg8::Unit& u, int wr, int wc, int fr, int fq) const {
        const int rbase = u.pm * 256 + wr * 64 + fr, cbase = u.pn * 256 + wc * 32 + 4 * fq;
#pragma unroll
        for (int ai = 0; ai < 2; ++ai)
#pragma unroll
            for (int m = 0; m < 4; ++m) {
                const int row = rbase + ai * 128 + m * 16;
                const float* xr; float* orow;
                if (row < MP) { xr = xp + (size_t)row * DM; orow = out + O_YP + (size_t)row * DM; }
                else if (row < MP + NDB) { xr = xs + (size_t)(row - MP) * DM; orow = out + O_YS + (size_t)(row - MP) * DM; }
                else continue;
#pragma unroll
                for (int bj = 0; bj < 2; ++bj)
#pragma unroll
                    for (int n = 0; n < 2; ++n) { const int col = cbase + bj * 128 + n * 16; *(f32x4*)(orow + col) = acc[ai][bj][m][n] + *(const f32x4*)(xr + col); }
            }
    }
};
DI void p0_prologue(const Params& p, LAS3 unsigned char* lds) {
    const int tid = threadIdx.x, lane = tid & 63, wv = tid >> 6;
    unsigned char* ws = p.ws;
    for (int r = blockIdx.x * 8 + wv; r < MROWS + MMEM; r += gridDim.x * 8) {
        const float* src = nullptr; const float* g = p.norm_in; bf16_t* dst;
        if (r < MP) { src = p.x_prompt + (size_t)r * DM; dst = (bf16_t*)(ws + W_XN) + (size_t)r * DM; }
        else if (r < MP + NDB) { src = p.x_sample + (size_t)(r - MP) * DM; dst = (bf16_t*)(ws + W_XN) + (size_t)r * DM; }
        else if (r < MROWS) { dst = (bf16_t*)(ws + W_XN) + (size_t)r * DM; }
        else { src = p.mem_prompt + (size_t)(r - MROWS) * DM; g = p.mem_norm; dst = (bf16_t*)(ws + W_MEMN) + (size_t)(r - MROWS) * DM; }
        if (!src) {
#pragma unroll
            for (int i = 0; i < 4; ++i) *(u32x2*)(dst + i * 256 + lane * 4) = (u32x2){0u, 0u};
            continue;
        }
        f32x4 v[4]; float ss = 0.f;
#pragma unroll
        for (int i = 0; i < 4; ++i) { v[i] = *(const f32x4*)(src + i * 256 + lane * 4); ss += v[i][0] * v[i][0] + v[i][1] * v[i][1] + v[i][2] * v[i][2] + v[i][3] * v[i][3]; }
        ss = wsum64(ss);
        const float rstd = rsqrtf(ss * (1.f / DM) + 1e-6f);
#pragma unroll
        for (int i = 0; i < 4; ++i) { const f32x4 gv = *(const f32x4*)(g + i * 256 + lane * 4); st_bf16x4(dst + i * 256 + lane * 4, v[i] * rstd * gv); }
    }
    for (int e = blockIdx.x * NTHREADS + tid; e < 2049 * 32; e += gridDim.x * NTHREADS) {
        const int pi = e >> 5, f = e & 31;
        const float inv = powf(10000.0f, -(float)(2 * f) / 64.0f);
        const float ang = (float)(pi == 2048 ? 16384 : pi) * inv;
        float sn, cs; sincosf(ang, &sn, &cs);
        ((f32x2*)(ws + W_ROPE))[e] = (f32x2){cs, sn};
    }
    LAS3 float* tl = (LAS3 float*)lds;
    for (int tile = blockIdx.x; tile < 1280; tile += gridDim.x) {
        int which, t2, ld; const float* W; bf16_t* dst;
        if (tile < 896) { which = 0; t2 = tile; W = p.w_in; ld = DIN; dst = (bf16_t*)(ws + W_WTIN); }
        else if (tile < 1024) { which = 1; t2 = tile - 896; W = p.w_mem_kv; ld = 512; dst = (bf16_t*)(ws + W_WTMEM); }
        else { which = 2; t2 = tile - 1024; W = p.w_out; ld = 1024; dst = (bf16_t*)(ws + W_WTOUT); }
        const int nt = t2 >> 4, kt = t2 & 15;
        { const int nn = tid & 63, kk0 = tid >> 6; const int np = nt * 64 + nn; const int sc = which == 0 ? in_src(np) : np;
#pragma unroll
          for (int i = 0; i < 8; ++i) { const int k = kk0 + 8 * i; tl[k * 65 + nn] = sc >= 0 ? W[(size_t)(kt * 64 + k) * ld + sc] : 0.f; } }
        __syncthreads();
        { const int kk = tid & 63, nn0 = tid >> 6;
#pragma unroll
          for (int i = 0; i < 8; ++i) { const int n = nn0 + 8 * i; dst[(size_t)(nt * 64 + n) * 1024 + kt * 64 + kk] = f2bf(tl[kk * 65 + n]); } }
        __syncthreads();
    }
}

DI void cnt_ge(unsigned& c, unsigned key, unsigned cand) { asm volatile("v_cmp_ge_u32 vcc, %1, %2\n\tv_addc_co_u32 %0, vcc, 0, %0, vcc" : "+v"(c) : "v"(key), "v"(cand) : "vcc"); }
DI void cnt_gt(unsigned& c, unsigned key, unsigned cand) { asm volatile("v_cmp_gt_u32 vcc, %1, %2\n\tv_addc_co_u32 %0, vcc, 0, %0, vcc" : "+v"(c) : "v"(key), "v"(cand) : "vcc"); }
DI void cnt_eq_lt(unsigned& c, unsigned key, unsigned T, unsigned idx, unsigned cand) {
    unsigned tmp;
    asm volatile("v_cmp_eq_u32 vcc, %2, %3\n\tv_cndmask_b32 %1, -1, %4, vcc\n\tv_cmp_lt_u32 vcc, %1, %5\n\tv_addc_co_u32 %0, vcc, 0, %0, vcc" : "+v"(c), "=&v"(tmp) : "v"(key), "v"(T), "v"(idx), "v"(cand) : "vcc"); }
DI unsigned grp_count16(unsigned c, LAS3 unsigned* CNT, int& it, int fr, int lane) {
    c += __shfl_xor(c, 16); c += __shfl_xor(c, 32);
    LAS3 unsigned* cur = CNT + (it % 3) * 16;
    if (lane < 16) lds_add(cur + fr, c);
    __syncthreads();
    const unsigned tot = cur[fr];
    if (threadIdx.x < 16) CNT[((it + 2) % 3) * 16 + threadIdx.x] = 0u;
    ++it; return tot;
}
DI unsigned blk_count(unsigned c, LAS3 unsigned* CNT, int& it, int lane) {
    c += __shfl_xor(c, 1); c += __shfl_xor(c, 2); c += __shfl_xor(c, 4); c += __shfl_xor(c, 8); c += __shfl_xor(c, 16); c += __shfl_xor(c, 32);
    LAS3 unsigned* cur = CNT + (it % 3) * 16;
    if (lane == 0) lds_add(cur, c);
    __syncthreads();
    const unsigned tot = cur[0];
    if (threadIdx.x == 0) CNT[((it + 2) % 3) * 16] = 0u;
    ++it; return tot;
}

template <bool MASKED>
DI void attn32(const bf16_t* Q, int ldq, const bf16_t* K, int ldk, const bf16_t* Vt, int ldv, int nkb, const LAS3 unsigned* mask, int fr, int fq,
               f32x4 (&o)[4][2], float (&linv)[2]) {
    bf16x8 qf[2][2];
#pragma unroll
    for (int qt = 0; qt < 2; ++qt)
#pragma unroll
        for (int ks = 0; ks < 2; ++ks) qf[qt][ks] = *(const bf16x8*)(Q + (size_t)(16 * qt + fr) * ldq + ks * 32 + fq * 8);
    float m[2] = {NEG_INF, NEG_INF}, l[2] = {0.f, 0.f};
    const f32x4 zero = {0.f, 0.f, 0.f, 0.f};
#pragma unroll
    for (int dt = 0; dt < 4; ++dt) { o[dt][0] = zero; o[dt][1] = zero; }
    const bf16_t* kl = K + (size_t)fr * ldk + fq * 8;
    const bf16_t* vl = Vt + (size_t)fr * ldv + 4 * fq;
    bf16x8 kfA[2][2], kfB[2][2]; s16x4 vA[4][2], vB[4][2];
#define ATT_LOAD(KF, VF, kb_) do { \
        _Pragma("unroll") for (int i2 = 0; i2 < 2; ++i2) _Pragma("unroll") for (int ks = 0; ks < 2; ++ks) KF[i2][ks] = *(const bf16x8*)(kl + (size_t)(32 * (kb_) + 16 * i2) * ldk + ks * 32); \
        _Pragma("unroll") for (int dt = 0; dt < 4; ++dt) { VF[dt][0] = *(const s16x4*)(vl + (size_t)(16 * dt) * ldv + 32 * (kb_)); VF[dt][1] = *(const s16x4*)(vl + (size_t)(16 * dt) * ldv + 32 * (kb_) + 16); } } while (0)
#define ATT_COMPUTE(KF, VF, kb_) do { \
        _Pragma("unroll") for (int qt = 0; qt < 2; ++qt) { \
            f32x4 s0 = mfma16(KF[0][0], qf[qt][0], zero); s0 = mfma16(KF[0][1], qf[qt][1], s0); \
            f32x4 s1 = mfma16(KF[1][0], qf[qt][0], zero); s1 = mfma16(KF[1][1], qf[qt][1], s1); \
            if (MASKED) { const unsigned mw = mask[(16 * qt + fr) * 65 + (kb_)]; const unsigned b0 = mw >> (4 * fq), b1 = mw >> (16 + 4 * fq); \
                _Pragma("unroll") for (int r = 0; r < 4; ++r) { s0[r] = ((b0 >> r) & 1u) ? s0[r] : NEG_INF; s1[r] = ((b1 >> r) & 1u) ? s1[r] : NEG_INF; } } \
            float mx = fmaxf(fmaxf(fmaxf(s0[0], s0[1]), fmaxf(s0[2], s0[3])), fmaxf(fmaxf(s1[0], s1[1]), fmaxf(s1[2], s1[3]))); \
            mx = fmaxf(mx, __shfl_xor(mx, 16)); mx = fmaxf(mx, __shfl_xor(mx, 32)); \
            const float mn = fmaxf(m[qt], mx), ms = (mn == NEG_INF) ? 0.f : mn; \
            const float alpha = __builtin_amdgcn_exp2f((m[qt] - ms) * LOG2E); \
            f32x4 p0, p1; \
            _Pragma("unroll") for (int r = 0; r < 4; ++r) { p0[r] = __builtin_amdgcn_exp2f((s0[r] - ms) * LOG2E); p1[r] = __builtin_amdgcn_exp2f((s1[r] - ms) * LOG2E); } \
            l[qt] = l[qt] * alpha + ((p0[0] + p0[1]) + (p0[2] + p0[3])) + ((p1[0] + p1[1]) + (p1[2] + p1[3])); \
            m[qt] = mn; \
            u32x4 pw; pw.x = cvtpk(p0[0], p0[1]); pw.y = cvtpk(p0[2], p0[3]); pw.z = cvtpk(p1[0], p1[1]); pw.w = cvtpk(p1[2], p1[3]); \
            const bf16x8 pf = __builtin_bit_cast(bf16x8, pw); \
            _Pragma("unroll") for (int dt = 0; dt < 4; ++dt) { const bf16x8 vf = __builtin_shufflevector(VF[dt][0], VF[dt][1], 0, 1, 2, 3, 4, 5, 6, 7); \
                o[dt][qt] = o[dt][qt] * alpha; o[dt][qt] = mfma16(vf, pf, o[dt][qt]); } } } while (0)
    ATT_LOAD(kfA, vA, 0);
    const int last = nkb - 1;
    for (int kb = 0; kb < nkb; kb += 2) {
        ATT_LOAD(kfB, vB, kb + 1);
        ATT_COMPUTE(kfA, vA, kb);
        { const int k2 = kb + 2 < last ? kb + 2 : last; ATT_LOAD(kfA, vA, k2); }
        ATT_COMPUTE(kfB, vB, kb + 1);
    }
#undef ATT_LOAD
#undef ATT_COMPUTE
#pragma unroll
    for (int qt = 0; qt < 2; ++qt) { float lt = l[qt]; lt += __shfl_xor(lt, 16); lt += __shfl_xor(lt, 32); linv[qt] = 1.f / lt; }
}
DI void attn_store(const f32x4 (&o)[4][2], const float (&linv)[2], const bf16_t* gate  , bf16_t* mix  , int fr, int fq) {
#pragma unroll
    for (int qt = 0; qt < 2; ++qt)
#pragma unroll
        for (int dt = 0; dt < 4; ++dt) {
            const size_t row = 16 * qt + fr; const int col = 16 * dt + 4 * fq;
            const u32x2 gw = *(const u32x2*)(gate + row * 256 + col);
            f32x4 v = o[dt][qt] * linv[qt];
            v[0] *= __uint_as_float(gw.x << 16); v[1] *= __uint_as_float(gw.x & 0xffff0000u); v[2] *= __uint_as_float(gw.y << 16); v[3] *= __uint_as_float(gw.y & 0xffff0000u);
            st_bf16x4(mix + row * 1024 + col, v);
        }
}

constexpr int DS_MASK = 0, DS_CNT = 16640, DS_KMAX = 19072, DS_N3 = 19136, DS_TSEL = 19200, DS_CANDN = 19328, DS_CAND = 19456;
typedef unsigned short u16x2 __attribute__((ext_vector_type(2)));
DI unsigned pk_cnt_ge(unsigned acc, unsigned kpair, unsigned cm1, unsigned ones) {
    unsigned t;
    asm("v_pk_sub_u16 %1, %2, %3 clamp\n\tv_pk_min_u16 %1, %1, %4\n\tv_pk_add_u16 %0, %0, %1" : "+v"(acc), "=&v"(t) : "v"(kpair), "v"(cm1), "v"(ones));
    return acc;
}
DI void select_bitwise(const unsigned (&key)[16][4], int lbase, LAS3 unsigned* CNT, int& it, int fr, int lane, unsigned& T, int& Xrel) {
    bool fin = false;
    T = 0u; Xrel = 0x7fffffff;
    for (int bit = 31; bit >= 0; --bit) {
        const unsigned cand = T | (1u << bit);
        unsigned c = 0;
#pragma unroll
        for (int n = 0; n < 16; ++n)
#pragma unroll
            for (int r = 0; r < 4; ++r) cnt_ge(c, key[n][r], cand);
        const unsigned tot = grp_count16(c, CNT, it, fr, lane);
        if (!fin && tot >= 256u) { T = cand; fin = (tot == 256u); }
        if (__all(fin)) break;
    }
    if (!__all(fin)) {
        unsigned c = 0;
#pragma unroll
        for (int n = 0; n < 16; ++n)
#pragma unroll
            for (int r = 0; r < 4; ++r) cnt_gt(c, key[n][r], T);
        const unsigned cgt = grp_count16(c, CNT, it, fr, lane);
        const unsigned need = 256u - cgt;
        unsigned Xl = 0u;
        for (int bit = 10; bit >= 0; --bit) {
            const unsigned cand = Xl | (1u << bit);
            const int crel = (int)cand - lbase;
            c = 0;
#pragma unroll
            for (int n = 0; n < 16; ++n) { const int crn = crel - 128 * n;
#pragma unroll
                for (int r = 0; r < 4; ++r) c += (key[n][r] == T && r < crn) ? 1u : 0u; }
            const unsigned tot = grp_count16(c, CNT, it, fr, lane);
            if (tot < need) Xl = cand;
        }
        if (!fin) Xrel = (int)Xl - lbase;
    }
}
DI unsigned pk_flag_ge(unsigned kpair, unsigned cm1, unsigned ones) {
    unsigned t;
    asm("v_pk_sub_u16 %0, %1, %2 clamp\n\tv_pk_min_u16 %0, %0, %3" : "=&v"(t) : "v"(kpair), "v"(cm1), "v"(ones));
    return t;
}
DI unsigned pk_max(unsigned a, unsigned b2) { unsigned t; asm("v_pk_max_u16 %0, %1, %2" : "=v"(t) : "v"(a), "v"(b2)); return t; }
DI void dsa_unit(const Params& p, LAS3 unsigned char* lds, int b, int j TARGS) {
    int tid = threadIdx.x; asm volatile("" : "+v"(tid));
    const int lane = tid & 63, w = __builtin_amdgcn_readfirstlane(tid >> 6), fr = lane & 15, fq = lane >> 4;
    unsigned char* ws = p.ws;
    LAS3 unsigned* MASK = (LAS3 unsigned*)(lds + DS_MASK);
    LAS3 unsigned* CNT = (LAS3 unsigned*)(lds + DS_CNT);
    LAS3 unsigned* KMAX = (LAS3 unsigned*)(lds + DS_KMAX);
    LAS3 unsigned* N3 = (LAS3 unsigned*)(lds + DS_N3);
    LAS3 unsigned* CANDN = (LAS3 unsigned*)(lds + DS_CANDN);
    LAS3 unsigned* CAND = (LAS3 unsigned*)(lds + DS_CAND);
    const bf16_t* IQ = (const bf16_t*)(ws + W_IQ); const bf16_t* IK = (const bf16_t*)(ws + W_IK); const float* IW = (const float*)(ws + W_IW);
    const int q0 = 64 * j;
    for (int i = tid; i < 64 * 65 + 48; i += NTHREADS) MASK[i] = 0u;
    __syncthreads();
    int it = 0;
    const f32x4 zero = {0.f, 0.f, 0.f, 0.f};
    const unsigned laneoff0 = (unsigned)(fr * 128 + fq * 16);
    const int lbase0 = 16 * w + 4 * fq;
#ifndef REPSA
#define REPSA 1
#endif
    TBEG(30);
#pragma unroll 1
    for (int rsa = 0; rsa < REPSA; ++rsa)
#pragma unroll 1
    for (int qg = 0; qg < 4; ++qg) {
        TBEG(32);
        int lbase = lbase0; unsigned laneoff = laneoff0;
        asm volatile("" : "+v"(lbase), "+v"(laneoff));
        const int tq = q0 + 16 * qg + fr; const size_t qrow = (size_t)b * SEQ + tq;
        bf16x8 bq[4][2];
#pragma unroll
        for (int h = 0; h < 4; ++h)
#pragma unroll
            for (int ks = 0; ks < 2; ++ks) bq[h][ks] = *(const bf16x8*)(IQ + qrow * 256 + h * 64 + ks * 32 + fq * 8);
        const f32x4 wq = *(const f32x4*)(IW + qrow * 4);
        float Lh[4];
#pragma unroll
        for (int h = 0; h < 4; ++h) Lh[h] = wq[h] < 0.f ? NEG_INF : -NEG_INF;
        const int ntile = 4 * j + qg + 1;
        const int nloc = ntile > w ? (ntile - w + 7) >> 3 : 0;
        const int lim = tq - lbase;
        unsigned key[16][4];
        bf16x8 ab[3][2];
#define DSA_ISSUE(nn) do { if ((nn) < 16) { const char* tb_ = (const char*)IK + ((size_t)b * SEQ + 16 * (w + 8 * (nn))) * 128; \
            ab[(nn) % 3][0] = *(const bf16x8*)(tb_ + laneoff); ab[(nn) % 3][1] = *(const bf16x8*)(tb_ + laneoff + 64); } } while (0)
        DSA_ISSUE(0); DSA_ISSUE(1);
#pragma unroll
        for (int n = 0; n < 16; ++n) {
            DSA_ISSUE(n + 2);
            {
                f32x4 sc = zero;
#pragma unroll
                for (int h = 0; h < 4; ++h) {
                    f32x4 d = mfma16(ab[n % 3][0], bq[h][0], zero); d = mfma16(ab[n % 3][1], bq[h][1], d);
                    d = d * wq[h];
#pragma unroll
                    for (int r = 0; r < 4; ++r) sc[r] += __builtin_amdgcn_fmed3f(d[r], 0.f, Lh[h]);
                }
                const int limn = (n < nloc) ? ((w + 8 * n == ntile - 1) ? lim - 128 * n : 3) : -1;
#pragma unroll
                for (int r = 0; r < 4; ++r) { const unsigned u = __float_as_uint(sc[r] + 0.f); const unsigned k = u ^ ((unsigned)((int)u >> 31) | 0x80000000u);
                    key[n][r] = (r <= limn) ? k : 0u; }
            }
            __builtin_amdgcn_sched_barrier(0);
        }
#undef DSA_ISSUE
        TEND(32); TBEG(33);
        unsigned pk[16][2];
#pragma unroll
        for (int n = 0; n < 16; ++n) { pk[n][0] = __builtin_amdgcn_perm(key[n][1], key[n][0], 0x07060302u); pk[n][1] = __builtin_amdgcn_perm(key[n][3], key[n][2], 0x07060302u); }
        unsigned ones = 0x00010001u; asm volatile("" : "+v"(ones));
        unsigned ub = 1u;
        bool slow = false; unsigned T = 0u; int Xrel = 0x7fffffff;
        if (q0 + 16 * qg >= 256) {
            if (tid < 16) { CANDN[tid] = 0u; KMAX[tid] = 0u; }
            unsigned mx = 0u;
#pragma unroll
            for (int n = 0; n < 16; ++n) if (n < nloc) mx = pk_max(mx, pk_max(pk[n][0], pk[n][1]));
            mx = max(mx & 0xffffu, mx >> 16); mx = max(mx, (unsigned)__shfl_xor((int)mx, 16)); mx = max(mx, (unsigned)__shfl_xor((int)mx, 32));
            __syncthreads();
            if (lane < 16) __hip_atomic_fetch_max(KMAX + fr, mx, __ATOMIC_RELAXED, __HIP_MEMORY_SCOPE_WORKGROUP);
            __syncthreads();
            const unsigned kmax = KMAX[fr];
            unsigned T16 = 0u, cabove = 0u, cntT = 0x7fffffffu; bool done = false;
            ub = 0x10000u;
            for (int bit = 15; bit >= 0; --bit) {
                const unsigned cand = T16 | (1u << bit);
                if (__all(done || cand > kmax)) { if (!done) ub = cand; continue; }
                const unsigned cm1 = (cand - 1u) * 0x00010001u;
                unsigned a0 = 0u, a1 = 0u;
#pragma unroll
                for (int n = 0; n < 16; ++n) if (n < nloc) { a0 = pk_cnt_ge(a0, pk[n][0], cm1, ones); a1 = pk_cnt_ge(a1, pk[n][1], cm1, ones); }
                const unsigned c = (a0 & 0xffffu) + (a0 >> 16) + (a1 & 0xffffu) + (a1 >> 16);
                const unsigned tot = grp_count16(c, CNT, it, fr, lane);
                if (!done) { if (tot >= 256u) { T16 = cand; cntT = tot; } else { ub = cand; cabove = tot; } done = (cntT - cabove <= 32u); }
                if (__all(done)) break;
            }
            if (w == 0 && fq == 0) N3[fr] = 256u - cabove;
            const unsigned bw = ub - T16, t16p = T16 * 0x00010001u, bwp = bw * 0x00010001u;
#pragma unroll
            for (int n = 0; n < 16; ++n) if (n < nloc) {
#pragma unroll
                for (int hp = 0; hp < 2; ++hp) {
                    unsigned d, m;
                    asm("v_pk_sub_u16 %0, %2, %3\n\tv_pk_min_u16 %1, %0, %4" : "=&v"(d), "=&v"(m) : "v"(pk[n][hp]), "v"(t16p), "v"(bwp));
                    if (m != bwp) {
#pragma unroll
                        for (int e = 0; e < 2; ++e) if (((d >> (16 * e)) & 0xffffu) < bw) {
                            const unsigned pos = lds_add(CANDN + fr, 1u);
                            const unsigned slot = pos < 64u ? pos : 64u;
                            CAND[(fr * 65 + slot) * 2] = key[n][2 * hp + e]; CAND[(fr * 65 + slot) * 2 + 1] = (unsigned)(lbase + 128 * n + 2 * hp + e);
                        }
                    }
                }
            }
            __syncthreads();
            { const u32x4 c0 = *(const LAS3 u32x4*)CANDN, c1 = *(const LAS3 u32x4*)(CANDN + 4), c2 = *(const LAS3 u32x4*)(CANDN + 8), c3 = *(const LAS3 u32x4*)(CANDN + 12);
              const unsigned mxc = max(max(max(c0.x, c0.y), max(c0.z, c0.w)), max(max(max(c1.x, c1.y), max(c1.z, c1.w)), max(max(max(c2.x, c2.y), max(c2.z, c2.w)), max(max(c3.x, c3.y), max(c3.z, c3.w)))));
              slow = mxc > 64u; }
            if (!slow) {
                const int q = tid & 15, c = tid >> 4; const unsigned nq = CANDN[q], need = N3[q];
#pragma unroll
                for (int cc = 0; cc < 2; ++cc) {
                    const unsigned ci = (unsigned)(c + 32 * cc);
                    if (ci < nq) {
                        const unsigned ki = CAND[(q * 65 + ci) * 2], xi = CAND[(q * 65 + ci) * 2 + 1];
                        unsigned rank = 0;
                        for (unsigned jj = 0; jj < nq; ++jj) { const unsigned kj = CAND[(q * 65 + jj) * 2], xj = CAND[(q * 65 + jj) * 2 + 1]; rank += (kj > ki || (kj == ki && xj < xi)) ? 1u : 0u; }
                        if (rank < need) lds_or(MASK + (16 * qg + q) * 65 + (xi >> 5), 1u << (xi & 31u));
                    }
                }
            } else {
                select_bitwise(key, lbase, CNT, it, fr, lane, T, Xrel);
            }
        }
        LAS3 unsigned* mrow = MASK + (16 * qg + fr) * 65 + (w >> 1);
        const int msh = 16 * (w & 1) + 4 * fq;
        if (!slow) {
            const unsigned um1 = (ub - 1u) * 0x00010001u;
#pragma unroll
            for (int n = 0; n < 16; ++n) if (n < nloc) {
                const unsigned f0 = pk_flag_ge(pk[n][0], um1, ones), f1 = pk_flag_ge(pk[n][1], um1, ones);
                const unsigned y = f0 | (f1 << 2), nib = (y | (y >> 15)) & 0xfu;
                lds_or(mrow + 4 * n, nib << msh);
            }
        } else {
#pragma unroll
            for (int n = 0; n < 16; ++n) if (n < nloc) {
                unsigned nib = 0; const int xrn = Xrel - 128 * n;
#pragma unroll
                for (int r = 0; r < 4; ++r) { const bool sel = key[n][r] > T || (key[n][r] == T && r <= xrn); nib |= sel ? (1u << r) : 0u; }
                lds_or(mrow + 4 * n, nib << msh);
            }
        }
        TEND(33);
        if (q0 + 16 * qg >= 256) __syncthreads();
#ifdef CHECK_SEL
        if (q0 + 16 * qg >= 256) {
            __syncthreads();
            unsigned T2; int X2; select_bitwise(key, lbase, CNT, it, fr, lane, T2, X2);
            bool bad = false;
#pragma unroll
            for (int n = 0; n < 16; ++n) if (n < nloc) { const int x2 = X2 - 128 * n; const unsigned mw = mrow[4 * n] >> msh;
#pragma unroll
                for (int r = 0; r < 4; ++r) { const bool s2 = key[n][r] > T2 || (key[n][r] == T2 && r <= x2); bad |= (s2 != (((mw >> r) & 1u) != 0u)); } }
            if (__any(bad) && lane == 0) atomicAdd((unsigned*)(ws + CW_CHK), 1u);
            if (!slow && lane == 0 && w == 0) atomicAdd((unsigned*)(ws + CW_CHK + 4), 1u);
        }
#endif
    }
    __syncthreads();
    TEND(30); TBEG(31);
#ifndef REPSB
#define REPSB 1
#endif
#pragma unroll
    for (int rsb = 0; rsb < REPSB; ++rsb)
    {
        const int h = w & 3, hf = w >> 2;
        const size_t qrow0 = (size_t)b * SEQ + q0 + 32 * hf;
        f32x4 o[4][2]; float linv[2];
        attn32<true>((const bf16_t*)(ws + W_DQ) + qrow0 * 256 + h * 64, 256, (const bf16_t*)(ws + W_DK) + (size_t)b * SEQ * 256 + h * 64, 256,
                     (const bf16_t*)(ws + W_DVT) + (size_t)(b * 4 + h) * 64 * SEQ, SEQ, 2 * j + 2  , MASK + 32 * hf * 65, fr, fq, o, linv);
        attn_store(o, linv, (const bf16_t*)(ws + W_DG) + qrow0 * 256 + h * 64, (bf16_t*)(ws + W_MIX) + qrow0 * 1024 + 512 + h * 64, fr, fq);
    }
    __syncthreads();
    TEND(31);
}
DI void mem_unit(const Params& p, int n) {
    const int tid = threadIdx.x, lane = tid & 63, w = __builtin_amdgcn_readfirstlane(tid >> 6), fr = lane & 15, fq = lane >> 4;
    unsigned char* ws = p.ws;
    const int h = w & 3, hf = w >> 2;
    const size_t qrow0 = (size_t)n * 64 + 32 * hf; const int b = n >> 5;
    f32x4 o[4][2]; float linv[2];
    attn32<false>((const bf16_t*)(ws + W_MQ) + qrow0 * 256 + h * 64, 256, (const bf16_t*)(ws + W_MK) + (size_t)b * NMEM * 256 + h * 64, 256,
                  (const bf16_t*)(ws + W_MVT) + (size_t)(b * 4 + h) * 64 * NMEM, NMEM, 8, nullptr, fr, fq, o, linv);
    attn_store(o, linv, (const bf16_t*)(ws + W_MG) + qrow0 * 256 + h * 64, (bf16_t*)(ws + W_MIX) + qrow0 * 1024 + 768 + h * 64, fr, fq);
}
constexpr int GL_QT = 0, GL_KT = 9216, GL_KPT = 18432, GL_VT = 27648, GL_SBT = 46080, GL_PM = 64512, GL_OF = 73728, GL_GTOT = 107520, GL_W2 = 109568, GL_BG = 113664, GL_DEC = 113920;
constexpr int LDP = 72;
DI void gla_unit(const Params& p, LAS3 unsigned char* lds, int b, int h) {
    const int tid = threadIdx.x, lane = tid & 63, w = __builtin_amdgcn_readfirstlane(tid >> 6), fr = lane & 15, fq = lane >> 4;
    unsigned char* ws = p.ws;
    LAS3 bf16_t* Qt = (LAS3 bf16_t*)(lds + GL_QT); LAS3 bf16_t* Kt = (LAS3 bf16_t*)(lds + GL_KT); LAS3 bf16_t* KpT = (LAS3 bf16_t*)(lds + GL_KPT);
    LAS3 bf16_t* Vt = (LAS3 bf16_t*)(lds + GL_VT); LAS3 bf16_t* SbT = (LAS3 bf16_t*)(lds + GL_SBT); LAS3 bf16_t* Pm = (LAS3 bf16_t*)(lds + GL_PM);
    LAS3 float* Of = (LAS3 float*)(lds + GL_OF); LAS3 float* gtot = (LAS3 float*)(lds + GL_GTOT); LAS3 float* w2s = (LAS3 float*)(lds + GL_W2);
    LAS3 float* bgs = (LAS3 float*)(lds + GL_BG); LAS3 float* dec = (LAS3 float*)(lds + GL_DEC);
    const bf16_t* GQ = (const bf16_t*)(ws + W_GQ); const bf16_t* GK = (const bf16_t*)(ws + W_GK); const bf16_t* GV = (const bf16_t*)(ws + W_GV);
    const bf16_t* GG = (const bf16_t*)(ws + W_GG); const float* GLR = (const float*)(ws + W_GLR); bf16_t* MIX = (bf16_t*)(ws + W_MIX);
    for (int i = tid; i < 128 * LDP / 2; i += NTHREADS) ((LAS3 unsigned*)SbT)[i] = 0u;
    for (int i = tid; i < 16 * 64; i += NTHREADS) w2s[i] = p.w_g2[(i >> 6) * 256 + h * 64 + (i & 63)];
    if (tid < 64) bgs[tid] = p.b_g[h * 64 + tid];
    __syncthreads();
    const int d = tid & 63, tg = w;
    float wreg[16];
#pragma unroll
    for (int r = 0; r < 16; ++r) wreg[r] = w2s[r * 64 + d];
    const float bgd = bgs[d];
    const f32x4 zero = {0.f, 0.f, 0.f, 0.f};
    f32x4 Sacc[4] = {zero, zero, zero, zero};
    const int tt = w & 3, vh = w >> 2;
    for (int c = 0; c < 32; ++c) {
        const size_t rb = (size_t)b * SEQ + c * 64;
        float g8[8];
#pragma unroll
        for (int i = 0; i < 8; ++i) {
            const float* gl = vaddr(GLR + (rb + tg * 8 + i) * 16);
            float u = bgd;
#pragma unroll
            for (int r = 0; r < 16; ++r) u += gl[r] * wreg[r];
            const float g = logsigf(u) * (1.f / 16.f);
            g8[i] = (i ? g8[i - 1] : 0.f) + g;
        }
        gtot[tg * 64 + d] = g8[7];
        __syncthreads();
        float off = 0.f, blast = 0.f;
#pragma unroll
        for (int g2 = 0; g2 < 8; ++g2) { const float v = gtot[g2 * 64 + d]; off += (g2 < tg) ? v : 0.f; blast += v; }
        float kp[8];
#pragma unroll
        for (int i = 0; i < 8; ++i) {
            const int t = tg * 8 + i; const float bt = off + g8[i];
            const float q = bf2f(GQ[(rb + t) * 256 + h * 64 + d]), k = bf2f(GK[(rb + t) * 256 + h * 64 + d]);
            Qt[t * LDP + d] = f2bf(q * expf(bt)); Kt[t * LDP + d] = f2bf(k * expf(-bt)); kp[i] = k * expf(blast - bt);
        }
        { u32x4 kw; kw.x = cvtpk(kp[0], kp[1]); kw.y = cvtpk(kp[2], kp[3]); kw.z = cvtpk(kp[4], kp[5]); kw.w = cvtpk(kp[6], kp[7]); *(LAS3 u32x4*)(KpT + d * LDP + tg * 8) = kw; }
        if (tg == 0) dec[d] = expf(blast);
        { const int v = tid & 127, sg = tid >> 7; bf16_t vv[16];
#pragma unroll
          for (int i = 0; i < 16; ++i) vv[i] = GV[(rb + sg * 16 + i) * 512 + h * 128 + v];
          u32x4 a, bb; a.x = vv[0] | ((unsigned)vv[1] << 16); a.y = vv[2] | ((unsigned)vv[3] << 16); a.z = vv[4] | ((unsigned)vv[5] << 16); a.w = vv[6] | ((unsigned)vv[7] << 16);
          bb.x = vv[8] | ((unsigned)vv[9] << 16); bb.y = vv[10] | ((unsigned)vv[11] << 16); bb.z = vv[12] | ((unsigned)vv[13] << 16); bb.w = vv[14] | ((unsigned)vv[15] << 16);
          *(LAS3 u32x4*)(Vt + v * LDP + sg * 16) = a; *(LAS3 u32x4*)(Vt + v * LDP + sg * 16 + 8) = bb; }
        __syncthreads();
#pragma unroll
        for (int s2 = 0; s2 < 2; ++s2) {
            const int st = 2 * vh + s2;
            f32x4 acc = zero;
#pragma unroll
            for (int ks = 0; ks < 2; ++ks) {
                const bf16x8 a = *(const LAS3 bf16x8*)(Kt + (st * 16 + fr) * LDP + ks * 32 + fq * 8), bq = *(const LAS3 bf16x8*)(Qt + (tt * 16 + fr) * LDP + ks * 32 + fq * 8);
                acc = mfma16(a, bq, acc);
            }
            const int t = tt * 16 + fr, s0 = st * 16 + 4 * fq;
            u32x2 pw; pw.x = cvtpk(s0 <= t ? acc[0] : 0.f, s0 + 1 <= t ? acc[1] : 0.f); pw.y = cvtpk(s0 + 2 <= t ? acc[2] : 0.f, s0 + 3 <= t ? acc[3] : 0.f);
            *(LAS3 u32x2*)(Pm + t * LDP + s0) = pw;
        }
        __syncthreads();
        f32x4 oacc[4];
        {
            bf16x8 aq[2], ap[2], ak[2];
#pragma unroll
            for (int ks = 0; ks < 2; ++ks) {
                aq[ks] = *(const LAS3 bf16x8*)(Qt + (tt * 16 + fr) * LDP + ks * 32 + fq * 8);
                ap[ks] = *(const LAS3 bf16x8*)(Pm + (tt * 16 + fr) * LDP + ks * 32 + fq * 8);
                ak[ks] = *(const LAS3 bf16x8*)(KpT + (tt * 16 + fr) * LDP + ks * 32 + fq * 8);
            }
            const f32x4 dv = *(const LAS3 f32x4*)(dec + tt * 16 + 4 * fq);
#pragma unroll
            for (int jv = 0; jv < 4; ++jv) {
                const int vt = vh * 4 + jv;
                bf16x8 bs[2], bv[2];
#pragma unroll
                for (int ks = 0; ks < 2; ++ks) {
                    bs[ks] = *(const LAS3 bf16x8*)(SbT + (vt * 16 + fr) * LDP + ks * 32 + fq * 8);
                    bv[ks] = *(const LAS3 bf16x8*)(Vt + (vt * 16 + fr) * LDP + ks * 32 + fq * 8);
                }
                f32x4 oa = mfma16(aq[0], bs[0], zero); oa = mfma16(aq[1], bs[1], oa); oa = mfma16(ap[0], bv[0], oa); oa = mfma16(ap[1], bv[1], oa);
                oacc[jv] = oa;
                f32x4 sa = Sacc[jv] * dv; sa = mfma16(ak[0], bv[0], sa); sa = mfma16(ak[1], bv[1], sa);
                Sacc[jv] = sa;
            }
        }
        __syncthreads();
#pragma unroll
        for (int jv = 0; jv < 4; ++jv) {
            const int vt = vh * 4 + jv;
#pragma unroll
            for (int r = 0; r < 4; ++r) Of[(tt * 16 + 4 * fq + r) * 132 + vt * 16 + fr] = oacc[jv][r];
            u32x2 sw; sw.x = cvtpk(Sacc[jv][0], Sacc[jv][1]); sw.y = cvtpk(Sacc[jv][2], Sacc[jv][3]);
            *(LAS3 u32x2*)(SbT + (vt * 16 + fr) * LDP + tt * 16 + 4 * fq) = sw;
        }
        __syncthreads();
        {
            const int t = tid >> 3, seg = tid & 7;
            const LAS3 float* op = Of + t * 132 + seg * 16;
            f32x4 ov[4]; float ss = 0.f;
#pragma unroll
            for (int i = 0; i < 4; ++i) { ov[i] = *(const LAS3 f32x4*)(op + 4 * i); ss += ov[i][0] * ov[i][0] + ov[i][1] * ov[i][1] + ov[i][2] * ov[i][2] + ov[i][3] * ov[i][3]; }
            ss += __shfl_xor(ss, 1); ss += __shfl_xor(ss, 2); ss += __shfl_xor(ss, 4);
            const float rstd = rsqrtf(ss * (1.f / 128.f) + 1e-6f);
            const bf16_t* gp = GG + (rb + t) * 512 + h * 128 + seg * 16;
            const u32x4 g0 = *(const u32x4*)gp, g1 = *(const u32x4*)(gp + 8);
            const unsigned gw[8] = {g0.x, g0.y, g0.z, g0.w, g1.x, g1.y, g1.z, g1.w};
            unsigned ow[8];
#pragma unroll
            for (int i = 0; i < 4; ++i) {
                const f32x4 on = *(const f32x4*)(p.onorm + seg * 16 + 4 * i);
                const float y0 = ov[i][0] * rstd * on[0] * __uint_as_float(gw[2 * i] << 16), y1 = ov[i][1] * rstd * on[1] * __uint_as_float(gw[2 * i] & 0xffff0000u);
                const float y2 = ov[i][2] * rstd * on[2] * __uint_as_float(gw[2 * i + 1] << 16), y3 = ov[i][3] * rstd * on[3] * __uint_as_float(gw[2 * i + 1] & 0xffff0000u);
                ow[2 * i] = cvtpk(y0, y1); ow[2 * i + 1] = cvtpk(y2, y3);
            }
            bf16_t* mp = MIX + (rb + t) * 1024 + h * 128 + seg * 16;
            *(u32x4*)mp = (u32x4){ow[0], ow[1], ow[2], ow[3]}; *(u32x4*)(mp + 8) = (u32x4){ow[4], ow[5], ow[6], ow[7]};
        }
    }
#pragma unroll
    for (int jv = 0; jv < 4; ++jv)
#pragma unroll
        for (int r = 0; r < 4; ++r) p.out[O_GSP + ((size_t)(b * 4 + h) * 64 + tt * 16 + 4 * fq + r) * 128 + (vh * 4 + jv) * 16 + fr] = Sacc[jv][r];
    __syncthreads();
}

DI void sscore_unit(const Params& p, LAS3 unsigned char* lds, int u) {
    const int tid = threadIdx.x;
    unsigned char* ws = p.ws;
    const int b = u >> 3, pg = u & 7;
    LAS3 float* qf = (LAS3 float*)lds;
    if (tid < 256) qf[tid] = bf2f(((const bf16_t*)(ws + W_IQ))[(size_t)(MP + b) * 256 + tid]);
    __syncthreads();
    const int seg = tid & 15;
    f32x4 q[4];
#pragma unroll
    for (int h = 0; h < 4; ++h) q[h] = *(const LAS3 f32x4*)(qf + h * 64 + seg * 4);
    const f32x4 wv = *(const f32x4*)vaddr((const float*)(ws + W_IW) + (size_t)(MP + b) * 4);
    unsigned* sc = (unsigned*)(ws + W_SC) + (size_t)b * SCLD;
    for (int pi = pg * 16; pi < pg * 16 + 16; ++pi) {
        const int phys = p.page_table[b * NPAGES + pi];
        const float* base = p.cache_ik + (size_t)phys * 8192;
#pragma unroll
        for (int i = 0; i < 4; ++i) {
            const int e = tid + 512 * i;
            const f32x4 kv = *(const f32x4*)(base + (size_t)e * 4);
            float dh[4];
#pragma unroll
            for (int h = 0; h < 4; ++h) {
                float x = q[h][0] * kv[0] + q[h][1] * kv[1] + q[h][2] * kv[2] + q[h][3] * kv[3];
                x += __shfl_xor(x, 1); x += __shfl_xor(x, 2); x += __shfl_xor(x, 4); x += __shfl_xor(x, 8);
                dh[h] = x;
            }
            const float s = wv[0] * fmaxf(dh[0], 0.f) + wv[1] * fmaxf(dh[1], 0.f) + wv[2] * fmaxf(dh[2], 0.f) + wv[3] * fmaxf(dh[3], 0.f);
            if (seg == 0) __hip_atomic_store(sc + pi * 128 + (e >> 4), __float_as_uint(s), __ATOMIC_RELAXED, __HIP_MEMORY_SCOPE_AGENT);
        }
    }
    asm volatile("s_waitcnt vmcnt(0)" ::: "memory");
    __syncthreads();
    if (tid == 0) __hip_atomic_fetch_add((unsigned*)(ws + CW_SCNT), 1u, __ATOMIC_RELAXED, __HIP_MEMORY_SCOPE_AGENT);
}

constexpr int SA_Q = 2048, SA_S = 3072, SA_KP = 8192, SA_VP = 10240;
DI void sattend(const Params& p, LAS3 unsigned char* lds, const bf16_t* qrow  , const bf16_t* gate, bf16_t* mix) {
    const int tid = threadIdx.x, lane = tid & 63, w = tid >> 6;
    LAS3 float* qf = (LAS3 float*)(lds + SA_Q); LAS3 float* S = (LAS3 float*)(lds + SA_S);
    const float* const LAS3* kptr = (const float* const LAS3*)(lds + SA_KP); const float* const LAS3* vptr = (const float* const LAS3*)(lds + SA_VP);
    if (tid < 256) qf[tid] = bf2f(qrow[tid]);
    __syncthreads();
    {
        const int jk = tid >> 1, hp = tid & 1;
        const float* kr = kptr[jk] + hp * 128;
        float s0 = 0.f, s1 = 0.f;
#pragma unroll 4
        for (int i = 0; i < 16; ++i) {
            const f32x4 k0 = *(const f32x4*)(kr + 4 * i), k1 = *(const f32x4*)(kr + 64 + 4 * i);
            const f32x4 q0 = *(const LAS3 f32x4*)(qf + hp * 128 + 4 * i), q1 = *(const LAS3 f32x4*)(qf + hp * 128 + 64 + 4 * i);
            s0 += q0[0] * k0[0] + q0[1] * k0[1] + q0[2] * k0[2] + q0[3] * k0[3];
            s1 += q1[0] * k1[0] + q1[1] * k1[1] + q1[2] * k1[2] + q1[3] * k1[3];
        }
        S[(2 * hp) * 256 + jk] = s0; S[(2 * hp + 1) * 256 + jk] = s1;
    }
    __syncthreads();
    if (w < 4) {
        float v[4], mx = NEG_INF;
#pragma unroll
        for (int i = 0; i < 4; ++i) { v[i] = S[w * 256 + lane + 64 * i]; mx = fmaxf(mx, v[i]); }
        mx = wmax64(mx);
        float sum = 0.f;
#pragma unroll
        for (int i = 0; i < 4; ++i) { v[i] = __expf(v[i] - mx); sum += v[i]; }
        sum = wsum64(sum);
        const float inv = 1.f / sum;
#pragma unroll
        for (int i = 0; i < 4; ++i) S[w * 256 + lane + 64 * i] = v[i] * inv;
    }
    __syncthreads();
    {
        const int h = tid >> 7, dd = (tid >> 1) & 63, hf = tid & 1;
        float acc = 0.f;
#pragma unroll 4
        for (int jk = hf * 128; jk < hf * 128 + 128; ++jk) acc += S[h * 256 + jk] * vptr[jk][h * 64 + dd];
        acc += __shfl_xor(acc, 1);
        if (hf == 0) mix[h * 64 + dd] = f2bf(acc * bf2f(gate[h * 64 + dd]));
    }
    __syncthreads();
}
DI void smem_unit(const Params& p, LAS3 unsigned char* lds, int b) {
    const int tid = threadIdx.x; unsigned char* ws = p.ws;
    const float* LAS3* kptr = (const float* LAS3*)(lds + SA_KP); const float* LAS3* vptr = (const float* LAS3*)(lds + SA_VP);
    if (tid < 256) { kptr[tid] = p.cache_mem_k + ((size_t)b * NMEM + tid) * 256; vptr[tid] = p.cache_mem_v + ((size_t)b * NMEM + tid) * 256; }
    const size_t row = MP + b;
    sattend(p, lds, (const bf16_t*)(ws + W_MQ) + row * 256, (const bf16_t*)(ws + W_MG) + row * 256, (bf16_t*)(ws + W_MIX) + row * 1024 + 768);
}
DI void ssel_unit(const Params& p, LAS3 unsigned char* lds, int b) {
    const int tid = threadIdx.x, lane = tid & 63, w = tid >> 6; unsigned char* ws = p.ws;
    LAS3 unsigned* CNT = (LAS3 unsigned*)lds;
    LAS3 unsigned* wsum = (LAS3 unsigned*)(lds + 256);
    LAS3 float* newsc = (LAS3 float*)(lds + 320);
    LAS3 int* list = (LAS3 int*)(lds + 512);
    const float* LAS3* kptr = (const float* LAS3*)(lds + SA_KP); const float* LAS3* vptr = (const float* LAS3*)(lds + SA_VP);
    if (tid < 48) CNT[tid] = 0u;
    if (tid == 0) {
        unsigned* cnt = (unsigned*)(ws + CW_SCNT); unsigned* tmo = (unsigned*)(ws + CW_TMO); unsigned sp = 0;
        while (__hip_atomic_load(cnt, __ATOMIC_RELAXED, __HIP_MEMORY_SCOPE_AGENT) < 256u) {
            __builtin_amdgcn_s_sleep(2);
            if ((++sp & 255u) == 0u) { if (__hip_atomic_load(tmo, __ATOMIC_RELAXED, __HIP_MEMORY_SCOPE_AGENT)) break; if (sp > (1u << 20)) { __hip_atomic_store(tmo, 1u, __ATOMIC_RELAXED, __HIP_MEMORY_SCOPE_AGENT); break; } }
        }
        __builtin_amdgcn_fence(__ATOMIC_ACQUIRE, "agent");
        asm volatile("s_waitcnt vmcnt(0)" ::: "memory");
    }
    if (w == 1) {
        const bf16_t* iq = (const bf16_t*)(ws + W_IQ) + (size_t)(MP + b) * 256; const float kd = bf2f(((const bf16_t*)(ws + W_IK))[(size_t)(MP + b) * 64 + lane]);
        const f32x4 wv = *(const f32x4*)vaddr((const float*)(ws + W_IW) + (size_t)(MP + b) * 4);
        float s = 0.f;
#pragma unroll
        for (int h = 0; h < 4; ++h) { const float dh = wsum64(bf2f(iq[h * 64 + lane]) * kd); s += wv[h] * fmaxf(dh, 0.f); }
        if (lane == 0) *newsc = s;
    }
    __syncthreads();
    const float* sc = (const float*)(ws + W_SC) + (size_t)b * SCLD;
    unsigned key[33];
#pragma unroll
    for (int n = 0; n < 32; ++n) key[n] = fkey(sc[tid + 512 * n]);
    key[32] = (tid == 0) ? fkey(*newsc) : 0u;
    int it = 0;
    unsigned T = 0u, X = 0x7fffffffu; bool fin = false;
    for (int bit = 31; bit >= 0; --bit) {
        const unsigned cand = T | (1u << bit);
        unsigned c = 0;
#pragma unroll
        for (int n = 0; n < 33; ++n) cnt_ge(c, key[n], cand);
        const unsigned tot = blk_count(c, CNT, it, lane);
        if (tot >= 256u) { T = cand; fin = (tot == 256u); }
        if (fin) break;
    }
    if (!fin) {
        unsigned c = 0;
#pragma unroll
        for (int n = 0; n < 33; ++n) cnt_gt(c, key[n], T);
        const unsigned need = 256u - blk_count(c, CNT, it, lane);
        unsigned Xl = 0u;
        for (int bit = 14; bit >= 0; --bit) {
            const unsigned cand = Xl | (1u << bit);
            c = 0;
#pragma unroll
            for (int n = 0; n < 33; ++n) cnt_eq_lt(c, key[n], T, (unsigned)(tid + 512 * n), cand);
            if (blk_count(c, CNT, it, lane) < need) Xl = cand;
        }
        X = Xl;
    }
    unsigned selm = 0, hi = 0;
#pragma unroll
    for (int n = 0; n < 32; ++n) selm |= (key[n] > T || (key[n] == T && (unsigned)(tid + 512 * n) <= X)) ? (1u << n) : 0u;
    hi = (key[32] > T || (key[32] == T && (unsigned)(tid + 16384) <= X)) ? 1u : 0u;
    const unsigned cs = __popc(selm) + hi;
    unsigned inc = cs;
#pragma unroll
    for (int o2 = 1; o2 < 64; o2 <<= 1) { const unsigned t2 = __shfl_up(inc, o2); if (lane >= o2) inc += t2; }
    if (lane == 63) wsum[w] = inc;
    __syncthreads();
    unsigned pos = inc - cs;
    for (int w2 = 0; w2 < w; ++w2) pos += wsum[w2];
#pragma unroll
    for (int n = 0; n < 32; ++n) if ((selm >> n) & 1u) { if (pos < 256u) list[pos] = tid + 512 * n; ++pos; }
    if (hi) { if (pos < 256u) list[pos] = tid + 16384; ++pos; }
    __syncthreads();
    if (tid < 256) {
        const int idx = list[tid];
        if (idx < 16384) { const size_t phys = (size_t)p.page_table[b * NPAGES + (idx >> 7)] * 128 + (idx & 127); kptr[tid] = p.cache_k + phys * 256; vptr[tid] = p.cache_v + phys * 256; }
        else { kptr[tid] = p.out + O_KS + (size_t)b * 256; vptr[tid] = p.out + O_VS + (size_t)b * 256; }
    }
    const size_t row = MP + b;
    sattend(p, lds, (const bf16_t*)(ws + W_DQ) + row * 256, (const bf16_t*)(ws + W_DG) + row * 256, (bf16_t*)(ws + W_MIX) + row * 1024 + 512);
}
DI void sgla_unit(const Params& p, LAS3 unsigned char* lds, int b) {
    const int tid = threadIdx.x, lane = tid & 63, w = tid >> 6; unsigned char* ws = p.ws;
    LAS3 float* qs = (LAS3 float*)lds; LAS3 float* ks = qs + 256; LAS3 float* gs = qs + 512; LAS3 float* vs = qs + 768; LAS3 float* part = qs + 1280;
    const size_t row = MP + b;
    if (tid < 256) {
        float u = p.b_g[tid];
        const float* gl = vaddr((const float*)(ws + W_GLR) + row * 16);
#pragma unroll
        for (int r = 0; r < 16; ++r) u += gl[r] * p.w_g2[r * 256 + tid];
        gs[tid] = expf(logsigf(u) * (1.f / 16.f));
        qs[tid] = bf2f(((const bf16_t*)(ws + W_GQ))[row * 256 + tid]); ks[tid] = bf2f(((const bf16_t*)(ws + W_GK))[row * 256 + tid]);
    }
    vs[tid] = bf2f(((const bf16_t*)(ws + W_GV))[row * 512 + tid]);
    __syncthreads();
    const int h = tid >> 7, v = tid & 127;
    const float* sp = p.state_gla + ((size_t)(b * 4 + h) * 64) * 128 + v; float* so = p.out + O_GSS + ((size_t)(b * 4 + h) * 64) * 128 + v;
    const float vv = vs[h * 128 + v];
    float o = 0.f;
#pragma unroll 8
    for (int dd = 0; dd < 64; ++dd) { const float sn = gs[h * 64 + dd] * sp[dd * 128] + ks[h * 64 + dd] * vv; so[dd * 128] = sn; o += qs[h * 64 + dd] * sn; }
    const float ss = wsum64(o * o);
    if (lane == 0) part[w] = ss;
    __syncthreads();
    const float rstd = rsqrtf((part[2 * h] + part[2 * h + 1]) * (1.f / 128.f) + 1e-6f);
    ((bf16_t*)(ws + W_MIX))[row * 1024 + h * 128 + v] = f2bf(o * rstd * p.onorm[v] * bf2f(((const bf16_t*)(ws + W_GG))[row * 512 + h * 128 + v]));
    __syncthreads();
}
DI void p4_final(const Params& p) {
    const int tid = threadIdx.x, lane = tid & 63, wv = tid >> 6;
    for (int r = blockIdx.x * 8 + wv; r < MP + NDB; r += gridDim.x * 8) {
        float* y = p.out + (r < MP ? O_YP + (size_t)r * DM : O_YS + (size_t)(r - MP) * DM);
        f32x4 v[4]; float ss = 0.f;
#pragma unroll
        for (int i = 0; i < 4; ++i) { v[i] = *(const f32x4*)(y + i * 256 + lane * 4); ss += v[i][0] * v[i][0] + v[i][1] * v[i][1] + v[i][2] * v[i][2] + v[i][3] * v[i][3]; }
        ss = wsum64(ss);
        const float rstd = rsqrtf(ss * (1.f / DM) + 1e-6f);
#pragma unroll
        for (int i = 0; i < 4; ++i) { const f32x4 gv = *(const f32x4*)(p.norm_final + i * 256 + lane * 4); *(f32x4*)(y + i * 256 + lane * 4) = v[i] * rstd * gv; }
    }
}

DI int next_unit(unsigned* ctr, volatile LAS3 unsigned* slot) {
    if (threadIdx.x == 0) *slot = __hip_atomic_fetch_add(ctr, 1u, __ATOMIC_RELAXED, __HIP_MEMORY_SCOPE_AGENT);
    __syncthreads();
    const int v = __builtin_amdgcn_readfirstlane((int)*slot);
    __syncthreads();
    return v;
}

#ifndef REP1
#define REP1 1
#endif
#ifndef REP2
#define REP2 1
#endif
#ifndef REP3
#define REP3 1
#endif
#ifndef REP2A
#define REP2A 1
#endif
#ifndef REP2B
#define REP2B 1
#endif
#ifndef REP2C
#define REP2C 1
#endif
#ifndef REP2D
#define REP2D 1
#endif
#ifndef REP2E
#define REP2E 1
#endif
DI void phase1(const Params& p, LAS3 unsigned char* lds) {
    unsigned char* ws = p.ws;
    { pg8::Gemm g{(const bf16_t*)(ws + W_XN), (const bf16_t*)(ws + W_WTIN), MROWS, NIN, DM}; pg8::StaticOrder S; S.init(MROWS, NIN, (int)gridDim.x, (int)blockIdx.x);
      EpiIn E{ws, p.out}; pg8::gemm_phase<EpiIn, pg8::StaticOrder, true, true>(lds, g, S, E); }
    { pg8::Gemm g{(const bf16_t*)(ws + W_MEMN), (const bf16_t*)(ws + W_WTMEM), MMEM, 512, DM}; pg8::StaticOrder S;
      S.init(MMEM, 512, (int)gridDim.x, (int)((blockIdx.x + gridDim.x - (1806u % gridDim.x)) % gridDim.x));
      EpiMem E{ws, p.out}; pg8::gemm_phase<EpiMem, pg8::StaticOrder, true, true>(lds, g, S, E); }
}
template <int QI> DI void p2_sscore(const Params& p, LAS3 unsigned char* lds) { for (int u = blockIdx.x; u < 256; u += gridDim.x) { sscore_unit(p, lds, u); __syncthreads(); } }
template <int QI> DI void p2_gla(const Params& p, LAS3 unsigned char* lds) { for (int u = blockIdx.x; u < 64; u += gridDim.x) gla_unit(p, lds, u >> 2, u & 3); }
DI int next_unit_xcd(unsigned char* qbase, volatile LAS3 unsigned* slot, unsigned x0) {
    if (threadIdx.x == 0) {
        unsigned res = 0xffffffffu;
        for (unsigned k = 0; k < 8u; ++k) {
            const unsigned xq = (x0 + k) & 7u;
            const unsigned mq = __hip_atomic_fetch_add((unsigned*)(qbase + 256 * xq), 1u, __ATOMIC_RELAXED, __HIP_MEMORY_SCOPE_AGENT);
            if (mq < 64u) { res = xq * 64u + mq; break; }
        }
        *slot = res;
    }
    __syncthreads();
    const int v = __builtin_amdgcn_readfirstlane((int)*slot);
    __syncthreads();
    return v;
}
template <int QI> DI void p2_dsa(const Params& p, LAS3 unsigned char* lds, volatile LAS3 unsigned* MISC TARGS) {
#if defined(XCDQ) && XCDQ
    const unsigned x0 = xb_xcc_id() & 7u;
    for (;;) { const int n = next_unit_xcd(p.ws + CW_QDSA + 8192 * QI, MISC + 4, x0); if (n < 0) break; const int m = n & 63; dsa_unit(p, lds, 2 * (n >> 6) + (m >> 5), 31 - (m & 31) TPASS); }
#else
    for (;;) { const int n = next_unit((unsigned*)(p.ws + CW_QDSA + 8192 * QI), MISC + 4); if (n >= 512) break; dsa_unit(p, lds, n & 15, 31 - (n >> 4) TPASS); }
#endif
}
template <int QI> DI void p2_mem(const Params& p, LAS3 unsigned char* lds, volatile LAS3 unsigned* MISC) {
    for (;;) { const int n = next_unit((unsigned*)(p.ws + CW_QMEM + 8192 * QI), MISC + 4); if (n >= 512) break; mem_unit(p, n); } }
template <int QI> DI void p2_sample(const Params& p, LAS3 unsigned char* lds) {
    for (int u = (int)gridDim.x - 1 - (int)blockIdx.x; u < 96; u += gridDim.x) { if (u < 32) sgla_unit(p, lds, u); else if (u < 64) smem_unit(p, lds, u - 32); else ssel_unit(p, lds, u - 64); } }
template <int RI> DI void phase2(const Params& p, LAS3 unsigned char* lds, volatile LAS3 unsigned* MISC TARGS) {
    TBEG(20); TBEG(21); p2_sscore<0>(p, lds); TEND(21); if (REP2A > 1) p2_sscore<1>(p, lds);
    TBEG(25); p2_sample<0>(p, lds); TEND(25); if (REP2E > 1) p2_sample<1>(p, lds);
    TBEG(22); p2_gla<0>(p, lds); TEND(22); if (REP2B > 1) p2_gla<1>(p, lds);
    TBEG(23); p2_dsa<0>(p, lds, MISC TPASS); TEND(23); if (REP2C > 1) p2_dsa<1>(p, lds, MISC TPASS);
    TBEG(24); p2_mem<0>(p, lds, MISC); TEND(24); if (REP2D > 1) p2_mem<1>(p, lds, MISC);
    TEND(20);
}
DI void phase3(const Params& p, LAS3 unsigned char* lds) {
    pg8::Gemm g{(const bf16_t*)(p.ws + W_MIX), (const bf16_t*)(p.ws + W_WTOUT), MP, DM, DM}; pg8::StaticOrder S; S.init(MP, DM, (int)gridDim.x, (int)blockIdx.x);
    EpiOut E{p.x_prompt, p.x_sample, p.out}; pg8::gemm_phase<EpiOut, pg8::StaticOrder, true, true>(lds, g, S, E);
    const int tid = threadIdx.x, lane = tid & 63, wv = tid >> 6;
    for (int u = blockIdx.x; u < 256; u += gridDim.x) {
        const int b = u >> 3, col0 = (u & 7) * 128 + wv * 16;
        const bf16_t* mrow = (const bf16_t*)(p.ws + W_MIX) + (size_t)(MP + b) * 1024 + lane * 16;
        const u32x4 m0 = *(const u32x4*)mrow, m1 = *(const u32x4*)(mrow + 8);
        const unsigned mw[8] = {m0.x, m0.y, m0.z, m0.w, m1.x, m1.y, m1.z, m1.w};
        float res = 0.f;
#pragma unroll 4
        for (int i = 0; i < 16; ++i) {
            const bf16_t* wrow = (const bf16_t*)(p.ws + W_WTOUT) + (size_t)(col0 + i) * 1024 + lane * 16;
            const u32x4 w0 = *(const u32x4*)wrow, w1 = *(const u32x4*)(wrow + 8);
            const unsigned ww[8] = {w0.x, w0.y, w0.z, w0.w, w1.x, w1.y, w1.z, w1.w};
            float acc = 0.f;
#pragma unroll
            for (int e = 0; e < 8; ++e) acc += __uint_as_float(mw[e] << 16) * __uint_as_float(ww[e] << 16) + __uint_as_float(mw[e] & 0xffff0000u) * __uint_as_float(ww[e] & 0xffff0000u);
            acc = wsum64(acc);
            res = (lane == i) ? acc : res;
        }
        if (lane < 16) p.out[O_YS + (size_t)b * DM + col0 + lane] = p.x_sample[(size_t)b * DM + col0 + lane] + res;
    }
}
__global__ void __launch_bounds__(NTHREADS, 2) hymba_fwd(Params p) {
    extern __shared__ __attribute__((aligned(16))) unsigned char lds_raw[];
    LAS3 unsigned char* lds = (LAS3 unsigned char*)lds_raw;
    volatile LAS3 unsigned* MISC = (volatile LAS3 unsigned*)(lds + LDS_MISC);
    const int tid = threadIdx.x;
    if (tid < 64) MISC[tid] = 0u;
    __syncthreads();
    const int lo = p.ph_lo, hi = p.ph_hi;
    TDECL;
    XcdBarrier bar; bar.bar = (unsigned*)p.ws; bar.x = 0; bar.st = MISC;
    if (hi > lo) bar = xcd_barrier_post((unsigned*)p.ws, MISC);
#define IN(k) (lo <= (k) && (k) <= hi)
#define SEAM(k) do { if (IN(k) && IN((k) + 1)) xcd_barrier(bar); } while (0)
    TBEG(0); if (IN(0)) p0_prologue(p, lds); TEND(0);
    TBEG(10); SEAM(0); TEND(10);
    TBEG(1); if (IN(1)) { phase1(p, lds); if (REP1 > 1) { xcd_barrier(bar); phase1(p, lds); } } TEND(1);
    TBEG(11); SEAM(1); TEND(11);
    TBEG(2); if (IN(2)) { phase2<0>(p, lds, MISC TPASS); } TEND(2);
    TBEG(12); SEAM(2); TEND(12);
    TBEG(3); if (IN(3)) { phase3(p, lds); if (REP3 > 1) { xcd_barrier(bar); phase3(p, lds); } } TEND(3);
    TBEG(13); SEAM(3); TEND(13);
    TBEG(4); if (IN(4)) p4_final(p); TEND(4);
#ifdef TSEL
    {
        if (tid == 0) { atomicAdd((unsigned long long*)(p.ws + CW_TSUM), (unsigned long long)tacc_); atomicMax((unsigned long long*)(p.ws + CW_TMAX), (unsigned long long)tacc_); }
        xcd_barrier(bar);
        if (blockIdx.x == 0 && tid == 0) {
#ifdef TMAX
            const unsigned long long dly = __hip_atomic_load((unsigned long long*)(p.ws + CW_TMAX), __ATOMIC_RELAXED, __HIP_MEMORY_SCOPE_AGENT);
#else
            const unsigned long long dly = __hip_atomic_load((unsigned long long*)(p.ws + CW_TSUM), __ATOMIC_RELAXED, __HIP_MEMORY_SCOPE_AGENT) / gridDim.x;
#endif
            const unsigned long long t0 = __builtin_amdgcn_s_memrealtime();
            while (__builtin_amdgcn_s_memrealtime() - t0 < dly && __builtin_amdgcn_s_memrealtime() - t0 < 400000ull) __builtin_amdgcn_s_sleep(8);
        }
    }
#endif
#ifdef CHECK_SEL
    {
        xcd_barrier(bar);
        const unsigned nbad = __hip_atomic_load((unsigned*)(p.ws + CW_CHK), __ATOMIC_RELAXED, __HIP_MEMORY_SCOPE_AGENT);
        const unsigned nhist = __hip_atomic_load((unsigned*)(p.ws + CW_CHK + 4), __ATOMIC_RELAXED, __HIP_MEMORY_SCOPE_AGENT);
        if (nbad != 0u || nhist < CHECK_MIN_HIST) for (int i = blockIdx.x * NTHREADS + tid; i < NDB * DM; i += gridDim.x * NTHREADS) p.out[O_YS + i] = __builtin_nanf("");
    }
#endif
#undef IN
#undef SEAM
}

#ifndef N_LAUNCHES
#define N_LAUNCHES 1
#endif
extern "C" void kernel_launch(void* const* d_in, const int* in_sizes, int n_in, void* d_out, int out_size, void* d_ws, size_t ws_size, hipStream_t stream) {
    static int grid = 0;
    if (grid == 0) {
        if (n_in != 19 || (size_t)out_size != O_END || ws_size < W_END) fprintf(stderr, "kernel_launch: unexpected sizes: n_in %d out %d ws %zu (need %zu)\n", n_in, out_size, ws_size, (size_t)W_END);
        int dev = 0, cus = 0, per_cu = 0;
        if (hipGetDevice(&dev) != hipSuccess || hipDeviceGetAttribute(&cus, hipDeviceAttributeMultiprocessorCount, dev) != hipSuccess) { fprintf(stderr, "kernel_launch: device query failed\n"); grid = -1; return; }
        if (hipFuncSetAttribute((const void*)hymba_fwd, hipFuncAttributeMaxDynamicSharedMemorySize, LDS_BYTES) != hipSuccess) { fprintf(stderr, "kernel_launch: hipFuncSetAttribute failed\n"); grid = -1; return; }
        if (hipOccupancyMaxActiveBlocksPerMultiprocessor(&per_cu, (const void*)hymba_fwd, NTHREADS, LDS_BYTES) != hipSuccess || per_cu < 1) fprintf(stderr, "kernel_launch: occupancy query reports %d blocks per CU\n", per_cu);
        (void)hipGetLastError();
        grid = cus;
    }
    if (grid < 0) return;
    (void)hipMemsetAsync(d_ws, 0, CTRL_BYTES, stream);
    Params p{};
    p.x_prompt = (const float*)d_in[0]; p.x_sample = (const float*)d_in[1]; p.mem_prompt = (const float*)d_in[2]; p.state_gla = (const float*)d_in[3];
    p.cache_k = (const float*)d_in[4]; p.cache_v = (const float*)d_in[5]; p.cache_ik = (const float*)d_in[6]; p.cache_mem_k = (const float*)d_in[7]; p.cache_mem_v = (const float*)d_in[8];
    p.page_table = (const int*)d_in[9];
    p.norm_in = (const float*)d_in[10]; p.w_in = (const float*)d_in[11]; p.w_g2 = (const float*)d_in[12]; p.b_g = (const float*)d_in[13]; p.onorm = (const float*)d_in[14];
    p.mem_norm = (const float*)d_in[15]; p.w_mem_kv = (const float*)d_in[16]; p.w_out = (const float*)d_in[17]; p.norm_final = (const float*)d_in[18];
    p.out = (float*)d_out; p.ws = (unsigned char*)d_ws;
#if N_LAUNCHES == 1
    p.ph_lo = 0; p.ph_hi = 4;
    hipLaunchKernelGGL(hymba_fwd, dim3(grid), dim3(NTHREADS), LDS_BYTES, stream, p);
#else
    for (int ph = 0; ph < 5; ++ph) { p.ph_lo = ph; p.ph_hi = ph; hipLaunchKernelGGL(hymba_fwd, dim3(grid), dim3(NTHREADS), LDS_BYTES, stream, p); }
#endif
    const hipError_t le = hipPeekAtLastError();
    if (le != hipSuccess) fprintf(stderr, "kernel_launch: launch failed: %s\n", hipGetErrorName(le));
}
```

```cpp
#include <hip/hip_runtime.h>
#include <cstdint>
#include <cstdio>
namespace pg8 {
#define PG8_LAS __attribute__((address_space(3)))
typedef unsigned short bf16_t;
typedef short bf16x8 __attribute__((ext_vector_type(8)));
typedef float f32x4 __attribute__((ext_vector_type(4)));
typedef unsigned u32x4 __attribute__((ext_vector_type(4)));
constexpr int BM = 256, BK = 64, HALF = 128, HTB = HALF * BK * 2  , STAGE_BYTES = 8 * HTB, NXCD = 8, WGM = 8;

__host__ __device__ __forceinline__ int lds_byte(int r, int c) { const int st = (r >> 4) * 2 + (c >> 5), rr = r & 15, cc = c & 31, ob = rr * 64 + cc * 2; return st * 1024 + (ob ^ (((ob >> 9) & 1) << 5)); }
__host__ __device__ __forceinline__ void stage_rc(int b, int& R, int& C) { const int st = b / 1024, sb = b % 1024, swz = sb ^ (((sb >> 9) & 1) << 5); R = (st >> 1) * 16 + swz / 64; C = (st & 1) * 32 + (swz % 64) / 2; }
__host__ __device__ __forceinline__ int perm32(int rho) { const int n = rho >> 4, i = rho & 15; return 8 * (i >> 2) + 4 * n + (i & 3); }

struct Unit { int pm, pn; };
struct Gemm { const bf16_t* A; const bf16_t* Bt; int M, N, K; };

struct StaticOrder {
    int nM, nN, nwg, G, c;
    __host__ __device__ void init(int M, int N, int G_, int c_) { nM = M / BM; nN = N / BM; nwg = nM * nN; G = G_; c = c_; }
    __host__ __device__ bool next(int i, Unit& u) const {
        const long L = (long)i * G + c; if (L >= nwg) return false;
        int wgid = (int)L; { const int q = nwg / NXCD, r = nwg % NXCD, xcd = wgid % NXCD, off = wgid / NXCD; wgid = (xcd < r ? xcd * (q + 1) : r * (q + 1) + (xcd - r) * q) + off; }
        const int nig = WGM * nN, gid = wgid / nig, fm = gid * WGM, gsz = (nM - fm) < WGM ? (nM - fm) : WGM;
        u.pm = fm + ((wgid % nig) % gsz); u.pn = (wgid % nig) / gsz; return true;
    }
    __device__ __forceinline__ void a_ready(const Unit&) const {}
    __device__ __forceinline__ void done(const Unit&) const {}
};

template <class Epi, class Sched, bool ALIGN_EPI = false, bool SP2 = false>
__device__ __forceinline__ void gemm_phase(PG8_LAS unsigned char* lds, const Gemm g, const Sched& S, const Epi& E) {
    const int tid = threadIdx.x, wid = __builtin_amdgcn_readfirstlane(tid >> 6), lane = tid & 63, wr = wid >> 2, wc = wid & 3, fr = lane & 15, fq = lane >> 4;
    const int K = g.K, nt = K / BK;
    unsigned voffA[2], voffB[2];
#pragma unroll
    for (int i = 0; i < 2; ++i) { int R, C; stage_rc(tid * 16 + i * 8192, R, C); const int Rb = Epi::PERM ? ((R & ~31) + perm32(R & 31)) : R;
        voffA[i] = (unsigned)(R * K + C) * 2u; voffB[i] = (unsigned)(Rb * K + C) * 2u; }
    const size_t kstep = (size_t)(BK * 2);
    const size_t hstep = (size_t)HALF * K * 2;
    const size_t tstep = 2 * hstep;
    const unsigned ldsw = (unsigned)wid * 1024u;
    const int aoff = lds_byte(wr * 64 + fr, fq * 8), boff = lds_byte(wc * 32 + fr, fq * 8);
#define PG8_SA(b, h) (((b) * 2 + (h)) * HTB)
#define PG8_SB(b, h) ((4 + (b) * 2 + (h)) * HTB)
#define PG8_STAGE(bufoff, gbase, voff) do { _Pragma("unroll") for (int _i = 0; _i < 2; ++_i) \
        __builtin_amdgcn_global_load_lds((const unsigned*)((const char*)(gbase) + (voff)[_i]), (PG8_LAS unsigned*)(lds + (bufoff) + ldsw + _i * 8192), 16, 0, 0); } while (0)
#define PG8_LDA(dst, b, h) do { _Pragma("unroll") for (int m = 0; m < 4; ++m) _Pragma("unroll") for (int k = 0; k < 2; ++k) dst[m][k] = *(const PG8_LAS bf16x8*)(lds + PG8_SA(b, h) + aoff + m * 2048 + k * 1024); } while (0)
#define PG8_LDB(dst, b, h) do { _Pragma("unroll") for (int n = 0; n < 2; ++n) _Pragma("unroll") for (int k = 0; k < 2; ++k) dst[n][k] = *(const PG8_LAS bf16x8*)(lds + PG8_SB(b, h) + boff + n * 2048 + k * 1024); } while (0)
#define PG8_MMA(ai, bj, At, Bt) do { __builtin_amdgcn_s_setprio(1); _Pragma("unroll") for (int m = 0; m < 4; ++m) _Pragma("unroll") for (int n = 0; n < 2; ++n) _Pragma("unroll") for (int k = 0; k < 2; ++k) \
        acc[ai][bj][m][n] = __builtin_amdgcn_mfma_f32_16x16x32_bf16(Bt[n][k], At[m][k], acc[ai][bj][m][n], 0, 0, 0); __builtin_amdgcn_s_setprio(0); } while (0)
#define PG8_WAIT_V(n) asm volatile("s_waitcnt vmcnt(" #n ")" ::: "memory")
#define PG8_WAIT_L(n) asm volatile("s_waitcnt lgkmcnt(" #n ")" ::: "memory")
#define PG8_BAR __builtin_amdgcn_s_barrier()
#define PG8_SCHED __builtin_amdgcn_sched_barrier(0)
    Unit cur, nxt; int ui = 0;
    if (!S.next(0, cur)) return;
    f32x4 acc[2][2][4][2];
#pragma unroll
    for (int a = 0; a < 2; ++a)
#pragma unroll
        for (int b = 0; b < 2; ++b)
#pragma unroll
            for (int m = 0; m < 4; ++m)
#pragma unroll
                for (int n = 0; n < 2; ++n) acc[a][b][m][n] = (f32x4){0.f, 0.f, 0.f, 0.f};
    bf16x8 At[4][2], B0[2][2], B1[2][2];
    const char* cA = (const char*)g.A + (size_t)cur.pm * tstep; const char* cB = (const char*)g.Bt + (size_t)cur.pn * tstep;
    S.a_ready(cur);
    if constexpr (SP2) {
        PG8_STAGE(PG8_SB(0, 0), cB, voffB); PG8_STAGE(PG8_SB(0, 1), cB + hstep, voffB); PG8_STAGE(PG8_SA(0, 0), cA, voffA); PG8_STAGE(PG8_SA(0, 1), cA + hstep, voffA);
        if (wr == 1) PG8_BAR;
        PG8_WAIT_V(2); PG8_BAR;
        PG8_STAGE(PG8_SB(1, 0), cB + kstep, voffB); PG8_STAGE(PG8_SA(1, 0), cA + kstep, voffA); PG8_STAGE(PG8_SB(1, 1), cB + hstep + kstep, voffB);
        PG8_WAIT_V(6); PG8_BAR;
    } else {
        PG8_STAGE(PG8_SB(0, 0), cB, voffB); PG8_STAGE(PG8_SA(0, 0), cA, voffA); PG8_STAGE(PG8_SB(0, 1), cB + hstep, voffB); PG8_STAGE(PG8_SA(0, 1), cA + hstep, voffA);
        if (wr == 1) PG8_BAR;
        PG8_WAIT_V(4); PG8_BAR;
        PG8_STAGE(PG8_SB(1, 0), cB + kstep, voffB); PG8_STAGE(PG8_SA(1, 0), cA + kstep, voffA); PG8_STAGE(PG8_SB(1, 1), cB + hstep + kstep, voffB);
        PG8_WAIT_V(6); PG8_BAR;
    }
    for (;;) {
        const bool has_next = S.next(ui + 1, nxt);
        const char* nA = has_next ? (const char*)g.A + (size_t)nxt.pm * tstep : cA; const char* nB = has_next ? (const char*)g.Bt + (size_t)nxt.pn * tstep : cB;
        for (int t = 0; t < nt; t += 2) {
            const bool last = (t == nt - 2);
            const char* a1 = cA + (size_t)(t + 1) * kstep;
            const char* a2 = last ? nA : cA + (size_t)(t + 2) * kstep; const char* b2 = last ? nB : cB + (size_t)(t + 2) * kstep;
            const char* a3 = a2 + kstep; const char* b3 = b2 + kstep;
            if (last && has_next) S.a_ready(nxt);
            if constexpr (SP2) {
            PG8_LDB(B0, 0, 0); PG8_LDB(B1, 0, 1); PG8_SCHED; PG8_LDA(At, 0, 0); PG8_STAGE(PG8_SA(1, 1), a1 + hstep, voffA);
            PG8_WAIT_V(8); PG8_WAIT_L(0); PG8_BAR; PG8_MMA(0, 0, At, B0); PG8_MMA(0, 1, At, B1); PG8_BAR; PG8_SCHED;
            PG8_LDA(At, 0, 1); PG8_STAGE(PG8_SB(0, 0), b2, voffB); PG8_STAGE(PG8_SB(0, 1), b2 + hstep, voffB); PG8_STAGE(PG8_SA(0, 0), a2, voffA);
            PG8_WAIT_V(8); PG8_WAIT_L(0); PG8_BAR; PG8_MMA(1, 0, At, B0); PG8_MMA(1, 1, At, B1); PG8_BAR; PG8_SCHED;
            PG8_LDB(B0, 1, 0); PG8_LDB(B1, 1, 1); PG8_SCHED; PG8_LDA(At, 1, 0); PG8_STAGE(PG8_SA(0, 1), a2 + hstep, voffA);
            PG8_WAIT_V(8); PG8_WAIT_L(0); PG8_BAR; PG8_MMA(0, 0, At, B0); PG8_MMA(0, 1, At, B1); PG8_BAR; PG8_SCHED;
            PG8_LDA(At, 1, 1); PG8_STAGE(PG8_SB(1, 0), b3, voffB); PG8_STAGE(PG8_SB(1, 1), b3 + hstep, voffB); PG8_STAGE(PG8_SA(1, 0), a3, voffA);
            PG8_WAIT_V(8); PG8_WAIT_L(0); PG8_BAR; PG8_MMA(1, 0, At, B0); PG8_MMA(1, 1, At, B1); PG8_BAR; PG8_SCHED;
            } else {
            PG8_LDB(B0, 0, 0); PG8_SCHED; PG8_LDA(At, 0, 0); PG8_STAGE(PG8_SA(1, 1), a1 + hstep, voffA);
            PG8_WAIT_L(8); PG8_BAR; PG8_WAIT_L(0); PG8_MMA(0, 0, At, B0); PG8_BAR; PG8_SCHED;
            PG8_LDB(B1, 0, 1); PG8_STAGE(PG8_SB(0, 0), b2, voffB);
            PG8_BAR; PG8_WAIT_L(0); PG8_MMA(0, 1, At, B1); PG8_BAR;
            PG8_LDA(At, 0, 1); PG8_STAGE(PG8_SA(0, 0), a2, voffA);
            PG8_BAR; PG8_WAIT_L(0); PG8_MMA(1, 0, At, B0); PG8_BAR; PG8_SCHED;
            PG8_STAGE(PG8_SB(0, 1), b2 + hstep, voffB);
            PG8_WAIT_V(6); PG8_BAR; PG8_MMA(1, 1, At, B1); PG8_BAR;
            PG8_LDB(B0, 1, 0); PG8_SCHED; PG8_LDA(At, 1, 0); PG8_STAGE(PG8_SA(0, 1), a2 + hstep, voffA);
            PG8_WAIT_L(8); PG8_BAR; PG8_WAIT_L(0); PG8_MMA(0, 0, At, B0); PG8_BAR; PG8_SCHED;
            PG8_LDB(B1, 1, 1); PG8_STAGE(PG8_SB(1, 0), b3, voffB);
            PG8_BAR; PG8_WAIT_L(0); PG8_MMA(0, 1, At, B1); PG8_BAR;
            PG8_LDA(At, 1, 1); PG8_STAGE(PG8_SA(1, 0), a3, voffA);
            PG8_BAR; PG8_WAIT_L(0); PG8_MMA(1, 0, At, B0); PG8_BAR; PG8_SCHED;
            PG8_STAGE(PG8_SB(1, 1), b3 + hstep, voffB);
            PG8_WAIT_V(6); PG8_BAR; PG8_MMA(1, 1, At, B1); PG8_BAR;
            }
        }
        if constexpr (ALIGN_EPI) { if (wr == 0) PG8_BAR; }
        if constexpr (!Epi::AFTER_DRAIN) { E(acc, cur, wr, wc, fr, fq); S.done(cur); }
        if (!has_next) break;
#pragma unroll
        for (int a = 0; a < 2; ++a)
#pragma unroll
            for (int b = 0; b < 2; ++b)
#pragma unroll
                for (int m = 0; m < 4; ++m)
#pragma unroll
                    for (int n = 0; n < 2; ++n) acc[a][b][m][n] = (f32x4){0.f, 0.f, 0.f, 0.f};
        cur = nxt; cA = nA; cB = nB; ++ui;
        if constexpr (ALIGN_EPI) { if (wr == 1) PG8_BAR; }
    }
    PG8_WAIT_V(0);
    if constexpr (!ALIGN_EPI) { if (wr == 0) PG8_BAR; }
    PG8_BAR;
    if constexpr (Epi::AFTER_DRAIN) { E.fused(acc, cur, wr, wc, fr, fq, lds, wid, lane); S.done(cur); }
#undef PG8_SA
#undef PG8_SB
#undef PG8_STAGE
#undef PG8_LDA
#undef PG8_LDB
#undef PG8_MMA
#undef PG8_WAIT_V
#undef PG8_WAIT_L
#undef PG8_BAR
#undef PG8_SCHED
}
}
#define XB_TMO      128
#define XB_XCNT(j)  (256  + 64 * (j))
#define XB_XSUB(j)  (1280 + 64 * (j))
#define XB_XGEN(j)  (2304 + 64 * (j))
#define XB_TOP      3328
#define XB_TOPGEN   3392
#define XCD_BAR_WORDS 3456
#define XB_SPIN_CAP (1u << 18)
#define LAS __attribute__((address_space(3)))

__device__ __forceinline__ unsigned xb_ld(unsigned* p)              { return __hip_atomic_load(p, __ATOMIC_RELAXED, __HIP_MEMORY_SCOPE_AGENT); }
__device__ __forceinline__ unsigned xb_add(unsigned* p, unsigned v) { return __hip_atomic_fetch_add(p, v, __ATOMIC_RELAXED, __HIP_MEMORY_SCOPE_AGENT); }
__device__ __forceinline__ unsigned xb_xcc_id() { return (unsigned)__builtin_amdgcn_s_getreg((3 << 11) | 20) & 0xFu; }
#define XB_SPIN(cond, bar) do { unsigned _sp = 0; while (cond) { __builtin_amdgcn_s_sleep(1); \
    if ((++_sp & 255u) == 0u) { if (xb_ld(&(bar)[XB_TMO])) break; if (_sp > XB_SPIN_CAP) { atomicAdd(&(bar)[XB_TMO], 1u); break; } } } } while (0)

struct XcdBarrier {
    unsigned* bar; unsigned x;
    volatile LAS unsigned* st;
};

__device__ __forceinline__ XcdBarrier xcd_barrier_post(unsigned* bar, volatile LAS unsigned* st) {
    XcdBarrier b; b.bar = bar; b.x = xb_xcc_id(); b.st = st;
    if (threadIdx.x == 0) (void)xb_add(&bar[XB_XCNT(b.x)], 1u);
    return b;
}
__device__ __forceinline__ void xcd_barrier_complete(unsigned* bar, unsigned x, unsigned& nloc, unsigned& nx) {
    const unsigned G = gridDim.x * gridDim.y * gridDim.z;
    unsigned sum, cnt, mine, sp = 0u;
    for (;;) {
        sum = 0u; cnt = 0u; mine = 0u;
#pragma unroll
        for (unsigned j = 0; j < 16; ++j) { const unsigned c = xb_ld(&bar[XB_XCNT(j)]); sum += c; cnt += (c > 0u) ? 1u : 0u; mine = (j == x) ? c : mine; }
        if (sum == G) break;
        __builtin_amdgcn_s_sleep(1);
        if ((++sp & 255u) == 0u) { if (xb_ld(&bar[XB_TMO])) break; if (sp > XB_SPIN_CAP) { atomicAdd(&bar[XB_TMO], 1u); break; } }
    }
    nloc = mine > 0u ? mine : 1u; nx = cnt > 0u ? cnt : 1u;
}

__device__ __forceinline__ void xcd_barrier(const XcdBarrier& b) {
    asm volatile("s_waitcnt vmcnt(0)" ::: "memory");
    __syncthreads();
    if (threadIdx.x == 0) {
        unsigned* bar = b.bar;
        __builtin_amdgcn_s_waitcnt(0);
        unsigned nloc = b.st[0], nx = b.st[1];
        if (nloc == 0u) { xcd_barrier_complete(bar, b.x, nloc, nx); b.st[0] = nloc; b.st[1] = nx; }
        const unsigned old = xb_add(&bar[XB_XSUB(b.x)], 1u);
        const unsigned gen = old / nloc;
        if (old + 1u == (gen + 1u) * nloc) {
            __builtin_amdgcn_fence(__ATOMIC_RELEASE, "agent");
            asm volatile("s_waitcnt vmcnt(0)" ::: "memory");
            const unsigned og = xb_add(&bar[XB_TOP], 1u);
            const unsigned tg = og / nx;
            if (og + 1u == (tg + 1u) * nx) xb_add(&bar[XB_TOPGEN], 1u);
            else XB_SPIN(xb_ld(&bar[XB_TOPGEN]) == tg, bar);
            __builtin_amdgcn_fence(__ATOMIC_ACQUIRE, "agent");
            xb_add(&bar[XB_XGEN(b.x)], 1u);
            asm volatile("s_waitcnt vmcnt(0)" ::: "memory");
        } else {
            XB_SPIN(xb_ld(&bar[XB_XGEN(b.x)]) == gen, bar);
            __builtin_amdgcn_fence(__ATOMIC_ACQUIRE, "agent");
            asm volatile("s_waitcnt vmcnt(0)" ::: "memory");
        }
    }
    __syncthreads();
}
#define DI __device__ __forceinline__
#define LAS3 __attribute__((address_space(3)))
using pg8::bf16_t; using pg8::bf16x8; using pg8::f32x4; using pg8::u32x4;
typedef unsigned u32x2 __attribute__((ext_vector_type(2)));
typedef short s16x4 __attribute__((ext_vector_type(4)));
typedef float f32x2 __attribute__((ext_vector_type(2)));
typedef __bf16 bf16x2_t __attribute__((ext_vector_type(2)));

constexpr int DM = 1024, NB = 16, SEQ = 2048, MP = NB * SEQ  , NDB = 32  , MROWS = 33024  ;
constexpr int NMEM = 256, MMEM = NB * NMEM  , DIN = 3412, NIN = 3584, NPAGES = 128;
constexpr int NTHREADS = 512;
constexpr size_t O_YP = 0, O_YS = O_YP + (size_t)MP * DM, O_GSP = O_YS + (size_t)NDB * DM, O_KP = O_GSP + (size_t)NB * 4 * 64 * 128,
                 O_VP = O_KP + (size_t)MP * 256, O_IKP = O_VP + (size_t)MP * 256, O_MKP = O_IKP + (size_t)MP * 64, O_MVP = O_MKP + (size_t)MMEM * 256,
                 O_GSS = O_MVP + (size_t)MMEM * 256, O_KS = O_GSS + (size_t)NDB * 4 * 64 * 128, O_VS = O_KS + (size_t)NDB * 256, O_IKS = O_VS + (size_t)NDB * 256,
                 O_END = O_IKS + (size_t)NDB * 64;
static_assert(O_END == 56150016, "output size");
constexpr size_t al256(size_t x) { return (x + 255) & ~(size_t)255; }
constexpr size_t CTRL_BYTES = 32768;
constexpr size_t CW_QDSA = 16384  , CW_QMEM = 18432  , CW_SCNT = 20480, CW_TMO = 20736, CW_CHK = 20992, CW_TSUM = 21248, CW_TMAX = 21504;
constexpr int SCLD = 16400;
constexpr size_t W_ROPE = CTRL_BYTES;
constexpr size_t W_XN = al256(W_ROPE + (size_t)2049 * 32 * 8);
constexpr size_t W_MEMN = W_XN + (size_t)MROWS * 1024 * 2;
constexpr size_t W_WTIN = W_MEMN + (size_t)MMEM * 1024 * 2;
constexpr size_t W_WTMEM = W_WTIN + (size_t)NIN * 1024 * 2;
constexpr size_t W_WTOUT = W_WTMEM + (size_t)512 * 1024 * 2;
constexpr size_t W_GQ = W_WTOUT + (size_t)1024 * 1024 * 2;
constexpr size_t W_GK = W_GQ + (size_t)MROWS * 256 * 2;
constexpr size_t W_GV = W_GK + (size_t)MROWS * 256 * 2;
constexpr size_t W_GG = W_GV + (size_t)MROWS * 512 * 2;
constexpr size_t W_DQ = W_GG + (size_t)MROWS * 512 * 2;
constexpr size_t W_DK = W_DQ + (size_t)MROWS * 256 * 2;
constexpr size_t W_DVT = W_DK + (size_t)MROWS * 256 * 2;
constexpr size_t W_IQ = W_DVT + (size_t)MP * 256 * 2;
constexpr size_t W_DG = W_IQ + (size_t)MROWS * 256 * 2;
constexpr size_t W_MQ = W_DG + (size_t)MROWS * 256 * 2;
constexpr size_t W_MG = W_MQ + (size_t)MROWS * 256 * 2;
constexpr size_t W_IK = W_MG + (size_t)MROWS * 256 * 2;
constexpr size_t W_IW = W_IK + (size_t)MROWS * 64 * 2;
constexpr size_t W_GLR = W_IW + (size_t)MROWS * 4 * 4;
constexpr size_t W_MK = W_GLR + (size_t)MROWS * 16 * 4;
constexpr size_t W_MVT = W_MK + (size_t)MMEM * 256 * 2;
constexpr size_t W_MIX = W_MVT + (size_t)MMEM * 256 * 2;
constexpr size_t W_SC = W_MIX + (size_t)MROWS * 1024 * 2;
constexpr size_t W_END = W_SC + (size_t)NDB * SCLD * 4;
constexpr int LDS_MISC = 148480, LDS_BYTES = 148480 + 256;

struct Params {
    const float *x_prompt, *x_sample, *mem_prompt, *state_gla, *cache_k, *cache_v, *cache_ik, *cache_mem_k, *cache_mem_v;
    const int* page_table;
    const float *norm_in, *w_in, *w_g2, *b_g, *onorm, *mem_norm, *w_mem_kv, *w_out, *norm_final;
    float* out; unsigned char* ws; int ph_lo, ph_hi;
};

#ifdef TSEL
#define TDECL unsigned tacc_ = 0u, tbeg_ = 0u
#define TBEG(k) do { if ((k) == TSEL) tbeg_ = (unsigned)__builtin_amdgcn_s_memrealtime(); } while (0)
#define TEND(k) do { if ((k) == TSEL) tacc_ += (unsigned)__builtin_amdgcn_s_memrealtime() - tbeg_; } while (0)
#define TARGS , unsigned& tacc_, unsigned& tbeg_
#define TPASS , tacc_, tbeg_
#else
#define TARGS
#define TPASS
#define TDECL do {} while (0)
#define TBEG(k) do {} while (0)
#define TEND(k) do {} while (0)
#endif
DI float bf2f(bf16_t v) { return __uint_as_float((unsigned)v << 16); }
DI unsigned cvtpk(float lo, float hi) { f32x2 v = {lo, hi}; bf16x2_t b = __builtin_convertvector(v, bf16x2_t); return __builtin_bit_cast(unsigned, b); }
DI bf16_t f2bf(float x) { return (bf16_t)(cvtpk(x, 0.f) & 0xffffu); }
DI f32x4 mfma16(bf16x8 a, bf16x8 b, f32x4 c) { return __builtin_amdgcn_mfma_f32_16x16x32_bf16(a, b, c, 0, 0, 0); }
DI float siluf(float x) { return x / (1.f + __expf(-x)); }
DI float logsigf(float u) { return fminf(u, 0.f) - log1pf(expf(-fabsf(u))); }
DI unsigned fkey(float x) { unsigned u = __float_as_uint(x); u = (u == 0x80000000u) ? 0u : u; return u ^ ((unsigned)((int)u >> 31) | 0x80000000u); }
DI float wsum64(float v) { v += __shfl_xor(v, 1); v += __shfl_xor(v, 2); v += __shfl_xor(v, 4); v += __shfl_xor(v, 8); v += __shfl_xor(v, 16); v += __shfl_xor(v, 32); return v; }
DI float wmax64(float v) { v = fmaxf(v, __shfl_xor(v, 1)); v = fmaxf(v, __shfl_xor(v, 2)); v = fmaxf(v, __shfl_xor(v, 4)); v = fmaxf(v, __shfl_xor(v, 8)); v = fmaxf(v, __shfl_xor(v, 16)); v = fmaxf(v, __shfl_xor(v, 32)); return v; }
DI unsigned lds_add(LAS3 unsigned* p, unsigned v) { return __hip_atomic_fetch_add(p, v, __ATOMIC_RELAXED, __HIP_MEMORY_SCOPE_WORKGROUP); }
DI unsigned lds_or(LAS3 unsigned* p, unsigned v) { return __hip_atomic_fetch_or(p, v, __ATOMIC_RELAXED, __HIP_MEMORY_SCOPE_WORKGROUP); }
DI void st_bf16x4(bf16_t* p, f32x4 v) { u32x2 w; w.x = cvtpk(v[0], v[1]); w.y = cvtpk(v[2], v[3]); *(u32x2*)p = w; }
DI const float* vaddr(const float* q) { asm volatile("" : "+v"(q)); return q; }
constexpr float LOG2E = 1.4426950408889634f;
#define NEG_INF (-__builtin_inff())

DI int rope_perm(int vc) { return 64 * (vc >> 6) + 16 * ((vc >> 5) & 1) + (vc & 15) + 32 * ((vc >> 4) & 1); }
DI int in_src(int np) {
    const int pn = np >> 8, vc = np & 255;
    switch (pn) {
        case 0: return vc;
        case 1: return 256 + vc;
        case 2: case 3: return 512 + 256 * (pn - 2) + vc;
        case 4: case 5: return 1040 + 256 * (pn - 4) + vc;
        case 6: return 1552 + rope_perm(vc);
        case 7: return 1808 + rope_perm(vc);
        case 8: return 2064 + vc;
        case 9: return 2320 + rope_perm(vc);
        case 10: return 2644 + vc;
        case 11: return 2900 + vc;
        case 12: return 3156 + vc;
        default: break;
    }
    if (vc < 64) return 2576 + rope_perm(vc);
    if (vc < 68) return 2640 + (vc - 64);
    if (vc < 84) return 1024 + (vc - 68);
    return -1;
}

struct EpiIn {
    static constexpr bool PERM = false, AFTER_DRAIN = false;
    unsigned char* ws; float* out;
    DI void operator()(const f32x4 (&acc)[2][2][4][2], const pg8::Unit& u, int wr, int wc, int fr, int fq) const {
        const int pn = u.pn, rbase = u.pm * 256 + wr * 64 + fr;
        if (pn <= 5 || (pn >= 10 && pn <= 12)) {
            bf16_t* dst; int ldc = 256, coff = 0; float sc = 1.f; bool silu = false;
            switch (pn) {
                case 0: dst = (bf16_t*)(ws + W_GQ); sc = 0.125f; break;
                case 1: dst = (bf16_t*)(ws + W_GK); break;
                case 2: dst = (bf16_t*)(ws + W_GV); ldc = 512; break;
                case 3: dst = (bf16_t*)(ws + W_GV); ldc = 512; coff = 256; break;
                case 4: dst = (bf16_t*)(ws + W_GG); ldc = 512; silu = true; break;
                case 5: dst = (bf16_t*)(ws + W_GG); ldc = 512; coff = 256; silu = true; break;
                case 10: dst = (bf16_t*)(ws + W_DG); silu = true; break;
                case 11: dst = (bf16_t*)(ws + W_MQ); sc = 0.125f; break;
                default: dst = (bf16_t*)(ws + W_MG); silu = true; break;
            }
#pragma unroll
            for (int ai = 0; ai < 2; ++ai)
#pragma unroll
                for (int m = 0; m < 4; ++m) {
                    const int row = rbase + ai * 128 + m * 16;
                    bf16_t* rp = dst + (size_t)row * ldc + coff + wc * 32 + 4 * fq;
#pragma unroll
                    for (int bj = 0; bj < 2; ++bj)
#pragma unroll
                        for (int n = 0; n < 2; ++n) {
                            f32x4 v = acc[ai][bj][m][n];
                            if (silu) { v[0] = siluf(v[0]); v[1] = siluf(v[1]); v[2] = siluf(v[2]); v[3] = siluf(v[3]); } else v = v * sc;
                            st_bf16x4(rp + bj * 128 + n * 16, v);
                        }
                }
        } else if (pn == 6 || pn == 7 || pn == 9) {
            bf16_t* dst = (bf16_t*)(ws + (pn == 6 ? W_DQ : (pn == 7 ? W_DK : W_IQ)));
            const float sc = (pn == 6) ? 0.125f : 1.f;
            const float* rope = (const float*)(ws + W_ROPE);
#pragma unroll
            for (int ai = 0; ai < 2; ++ai)
#pragma unroll
                for (int m = 0; m < 4; ++m) {
                    const int row = rbase + ai * 128 + m * 16;
                    const int pi = row < MP ? (row & 2047) : 2048;
                    const int f0 = 16 * (wc & 1) + 4 * fq;
                    const f32x4 cs0 = *(const f32x4*)(rope + ((size_t)pi * 32 + f0) * 2), cs1 = *(const f32x4*)(rope + ((size_t)pi * 32 + f0) * 2 + 4);
                    const f32x4 c = {cs0[0], cs0[2], cs1[0], cs1[2]}, s = {cs0[1], cs0[3], cs1[1], cs1[3]};
#pragma unroll
                    for (int bj = 0; bj < 2; ++bj) {
                        const f32x4 v0 = acc[ai][bj][m][0], v1 = acc[ai][bj][m][1];
                        const f32x4 o1 = (v0 * c - v1 * s) * sc, o2 = (v1 * c + v0 * s) * sc;
                        const int col1 = 64 * (2 * bj + (wc >> 1)) + f0, col2 = col1 + 32;
                        st_bf16x4(dst + (size_t)row * 256 + col1, o1); st_bf16x4(dst + (size_t)row * 256 + col2, o2);
                        if (pn == 7) {
                            float* op = nullptr;
                            if (row < MP) op = out + O_KP + (size_t)row * 256; else if (row < MP + NDB) op = out + O_KS + (size_t)(row - MP) * 256;
                            if (op) { *(f32x4*)(op + col1) = o1; *(f32x4*)(op + col2) = o2; }
                        }
                    }
                }
        } else if (pn == 8) {
            bf16_t* dvt = (bf16_t*)(ws + W_DVT);
#pragma unroll
            for (int ai = 0; ai < 2; ++ai)
#pragma unroll
                for (int m = 0; m < 4; ++m) {
                    const int row = rbase + ai * 128 + m * 16;
                    float* op = nullptr;
                    if (row < MP) op = out + O_VP + (size_t)row * 256; else if (row < MP + NDB) op = out + O_VS + (size_t)(row - MP) * 256;
#pragma unroll
                    for (int bj = 0; bj < 2; ++bj)
#pragma unroll
                        for (int n = 0; n < 2; ++n) {
                            const f32x4 v = acc[ai][bj][m][n];
                            const int col = 128 * bj + 32 * wc + 16 * n + 4 * fq;
                            if (op) *(f32x4*)(op + col) = v;
                            if (row < MP) {
                                bf16_t* tp = dvt + ((size_t)((row >> 11) * 4 + (col >> 6)) * 64 + (col & 63)) * 2048 + (row & 2047);
                                tp[0] = f2bf(v[0]); tp[2048] = f2bf(v[1]); tp[4096] = f2bf(v[2]); tp[6144] = f2bf(v[3]);
                            }
                        }
                }
        } else {
            bf16_t* ikb = (bf16_t*)(ws + W_IK); float* iw = (float*)(ws + W_IW); float* glr = (float*)(ws + W_GLR);
            const float* rope = (const float*)(ws + W_ROPE);
#pragma unroll
            for (int ai = 0; ai < 2; ++ai)
#pragma unroll
                for (int m = 0; m < 4; ++m) {
                    const int row = rbase + ai * 128 + m * 16;
                    const f32x4 v0 = acc[ai][0][m][0], v1 = acc[ai][0][m][1];
                    if (wc < 2) {
                        const int pi = row < MP ? (row & 2047) : 2048;
                        const int f0 = 16 * wc + 4 * fq;
                        const f32x4 cs0 = *(const f32x4*)(rope + ((size_t)pi * 32 + f0) * 2), cs1 = *(const f32x4*)(rope + ((size_t)pi * 32 + f0) * 2 + 4);
                        const f32x4 c = {cs0[0], cs0[2], cs1[0], cs1[2]}, s = {cs0[1], cs0[3], cs1[1], cs1[3]};
                        const f32x4 o1 = v0 * c - v1 * s, o2 = v1 * c + v0 * s;
                        st_bf16x4(ikb + (size_t)row * 64 + f0, o1); st_bf16x4(ikb + (size_t)row * 64 + f0 + 32, o2);
                        float* op = nullptr;
                        if (row < MP) op = out + O_IKP + (size_t)row * 64; else if (row < MP + NDB) op = out + O_IKS + (size_t)(row - MP) * 64;
                        if (op) { *(f32x4*)(op + f0) = o1; *(f32x4*)(op + f0 + 32) = o2; }
                    } else if (wc == 2) {
                        if (fq == 0) { *(f32x4*)(iw + (size_t)row * 4) = v0 * 0.5f; *(f32x4*)(glr + (size_t)row * 16 + 12) = v1; }
                        else *(f32x4*)(glr + (size_t)row * 16 + 4 * (fq - 1)) = v0;
                    }
                }
        }
    }
};
struct EpiMem {
    static constexpr bool PERM = false, AFTER_DRAIN = false;
    unsigned char* ws; float* out;
    DI void operator()(const f32x4 (&acc)[2][2][4][2], const pg8::Unit& u, int wr, int wc, int fr, int fq) const {
        const int pn = u.pn, rbase = u.pm * 256 + wr * 64 + fr;
        bf16_t* mk = (bf16_t*)(ws + W_MK); bf16_t* mvt = (bf16_t*)(ws + W_MVT);
        float* op0 = out + (pn == 0 ? O_MKP : O_MVP);
#pragma unroll
        for (int ai = 0; ai < 2; ++ai)
#pragma unroll
            for (int m = 0; m < 4; ++m) {
                const int row = rbase + ai * 128 + m * 16;
#pragma unroll
                for (int bj = 0; bj < 2; ++bj)
#pragma unroll
                    for (int n = 0; n < 2; ++n) {
                        const f32x4 v = acc[ai][bj][m][n];
                        const int col = 128 * bj + 32 * wc + 16 * n + 4 * fq;
                        *(f32x4*)(op0 + (size_t)row * 256 + col) = v;
                        if (pn == 0) st_bf16x4(mk + (size_t)row * 256 + col, v);
                        else { bf16_t* tp = mvt + ((size_t)((row >> 8) * 4 + (col >> 6)) * 64 + (col & 63)) * 256 + (row & 255);
                               tp[0] = f2bf(v[0]); tp[256] = f2bf(v[1]); tp[512] = f2bf(v[2]); tp[768] = f2bf(v[3]); }
                    }
            }
    }
};
struct EpiOut {
    static constexpr bool PERM = false, AFTER_DRAIN = false;
    const float* xp; const float* xs; float* out;
    DI void operator()(const f32x4 (&acc)[2][2][4][2], const pg8::Unit& u, int wr, int wc, int fr, int fq) const {
        const int rbase = u.pm * 256 + wr * 64 + fr, cbase = u.pn * 256 + wc * 32 + 4 * fq;
#pragma unroll
        for (int ai = 0; ai < 2; ++ai)
#pragma unroll
            for (int m = 0; m < 4; ++m) {
                const int row = rbase + ai * 128 + m * 16;
                const float* xr; float* orow;
                if (row < MP) { xr = xp + (size_t)row * DM; orow = out + O_YP + (size_t)row * DM; }
                else if (row < MP + NDB) { xr = xs + (size_t)(row - MP) * DM; orow = out + O_YS + (size_t)(row - MP) * DM; }
                else continue;
#pragma unroll
                for (int bj = 0; bj < 2; ++bj)
#pragma unroll
                    for (int n = 0; n < 2; ++n) { const int col = cbase + bj * 128 + n * 16; *(f32x4*)(orow + col) = acc[ai][bj][m][n] + *(const f32x4*)(xr + col); }
            }
    }
};
DI void p0_prologue(const Params& p, LAS3 unsigned char* lds) {
    const int tid = threadIdx.x, lane = tid & 63, wv = tid >> 6;
    unsigned char* ws = p.ws;
    for (int r = blockIdx.x * 8 + wv; r < MROWS + MMEM; r += gridDim.x * 8) {
        const float* src = nullptr; const float* g = p.norm_in; bf16_t* dst;
        if (r < MP) { src = p.x_prompt + (size_t)r * DM; dst = (bf16_t*)(ws + W_XN) + (size_t)r * DM; }
        else if (r < MP + NDB) { src = p.x_sample + (size_t)(r - MP) * DM; dst = (bf16_t*)(ws + W_XN) + (size_t)r * DM; }
        else if (r < MROWS) { dst = (bf16_t*)(ws + W_XN) + (size_t)r * DM; }
        else { src = p.mem_prompt + (size_t)(r - MROWS) * DM; g = p.mem_norm; dst = (bf16_t*)(ws + W_MEMN) + (size_t)(r - MROWS) * DM; }
        if (!src) {
#pragma unroll
            for (int i = 0; i < 4; ++i) *(u32x2*)(dst + i * 256 + lane * 4) = (u32x2){0u, 0u};
            continue;
        }
        f32x4 v[4]; float ss = 0.f;
#pragma unroll
        for (int i = 0; i < 4; ++i) { v[i] = *(const f32x4*)(src + i * 256 + lane * 4); ss += v[i][0] * v[i][0] + v[i][1] * v[i][1] + v[i][2] * v[i][2] + v[i][3] * v[i][3]; }
        ss = wsum64(ss);
        const float rstd = rsqrtf(ss * (1.f / DM) + 1e-6f);
#pragma unroll
        for (int i = 0; i < 4; ++i) { const f32x4 gv = *(const f32x4*)(g + i * 256 + lane * 4); st_bf16x4(dst + i * 256 + lane * 4, v[i] * rstd * gv); }
    }
    for (int e = blockIdx.x * NTHREADS + tid; e < 2049 * 32; e += gridDim.x * NTHREADS) {
        const int pi = e >> 5, f = e & 31;
        const float inv = powf(10000.0f, -(float)(2 * f) / 64.0f);
        const float ang = (float)(pi == 2048 ? 16384 : pi) * inv;
        float sn, cs; sincosf(ang, &sn, &cs);
        ((f32x2*)(ws + W_ROPE))[e] = (f32x2){cs, sn};
    }
    LAS3 float* tl = (LAS3 float*)lds;
    for (int tile = blockIdx.x; tile < 1280; tile += gridDim.x) {
        int which, t2, ld; const float* W; bf16_t* dst;
        if (tile < 896) { which = 0; t2 = tile; W = p.w_in; ld = DIN; dst = (bf16_t*)(ws + W_WTIN); }
        else if (tile < 1024) { which = 1; t2 = tile - 896; W = p.w_mem_kv; ld = 512; dst = (bf16_t*)(ws + W_WTMEM); }
        else { which = 2; t2 = tile - 1024; W = p.w_out; ld = 1024; dst = (bf16_t*)(ws + W_WTOUT); }
        const int nt = t2 >> 4, kt = t2 & 15;
        { const int nn = tid & 63, kk0 = tid >> 6; const int np = nt * 64 + nn; const int sc = which == 0 ? in_src(np) : np;
#pragma unroll
          for (int i = 0; i < 8; ++i) { const int k = kk0 + 8 * i; tl[k * 65 + nn] = sc >= 0 ? W[(size_t)(kt * 64 + k) * ld + sc] : 0.f; } }
        __syncthreads();
        { const int kk = tid & 63, nn0 = tid >> 6;
#pragma unroll
          for (int i = 0; i < 8; ++i) { const int n = nn0 + 8 * i; dst[(size_t)(nt * 64 + n) * 1024 + kt * 64 + kk] = f2bf(tl[kk * 65 + n]); } }
        __syncthreads();
    }
}

DI void cnt_ge(unsigned& c, unsigned key, unsigned cand) { asm volatile("v_cmp_ge_u32 vcc, %1, %2\n\tv_addc_co_u32 %0, vcc, 0, %0, vcc" : "+v"(c) : "v"(key), "v"(cand) : "vcc"); }
DI void cnt_gt(unsigned& c, unsigned key, unsigned cand) { asm volatile("v_cmp_gt_u32 vcc, %1, %2\n\tv_addc_co_u32 %0, vcc, 0, %0, vcc" : "+v"(c) : "v"(key), "v"(cand) : "vcc"); }
DI void cnt_eq_lt(unsigned& c, unsigned key, unsigned T, unsigned idx, unsigned cand) {
    unsigned tmp;
    asm volatile("v_cmp_eq_u32 vcc, %2, %3\n\tv_cndmask_b32 %1, -1, %4, vcc\n\tv_cmp_lt_u32 vcc, %1, %5\n\tv_addc_co_u32 %0, vcc, 0, %0, vcc" : "+v"(c), "=&v"(tmp) : "v"(key), "v"(T), "v"(idx), "v"(cand) : "vcc"); }
DI unsigned grp_count16(unsigned c, LAS3 unsigned* CNT, int& it, int fr, int lane) {
    c += __shfl_xor(c, 16); c += __shfl_xor(c, 32);
    LAS3 unsigned* cur = CNT + (it % 3) * 16;
    if (lane < 16) lds_add(cur + fr, c);
    __syncthreads();
    const unsigned tot = cur[fr];
    if (threadIdx.x < 16) CNT[((it + 2) % 3) * 16 + threadIdx.x] = 0u;
    ++it; return tot;
}
DI unsigned blk_count(unsigned c, LAS3 unsigned* CNT, int& it, int lane) {
    c += __shfl_xor(c, 1); c += __shfl_xor(c, 2); c += __shfl_xor(c, 4); c += __shfl_xor(c, 8); c += __shfl_xor(c, 16); c += __shfl_xor(c, 32);
    LAS3 unsigned* cur = CNT + (it % 3) * 16;
    if (lane == 0) lds_add(cur, c);
    __syncthreads();
    const unsigned tot = cur[0];
    if (threadIdx.x == 0) CNT[((it + 2) % 3) * 16] = 0u;
    ++it; return tot;
}

template <bool MASKED>
DI void attn32(const bf16_t* Q, int ldq, const bf16_t* K, int ldk, const bf16_t* Vt, int ldv, int nkb, const LAS3 unsigned* mask, int fr, int fq,
               f32x4 (&o)[4][2], float (&linv)[2]) {
    bf16x8 qf[2][2];
#pragma unroll
    for (int qt = 0; qt < 2; ++qt)
#pragma unroll
        for (int ks = 0; ks < 2; ++ks) qf[qt][ks] = *(const bf16x8*)(Q + (size_t)(16 * qt + fr) * ldq + ks * 32 + fq * 8);
    float m[2] = {NEG_INF, NEG_INF}, l[2] = {0.f, 0.f};
    const f32x4 zero = {0.f, 0.f, 0.f, 0.f};
#pragma unroll
    for (int dt = 0; dt < 4; ++dt) { o[dt][0] = zero; o[dt][1] = zero; }
    const bf16_t* kl = K + (size_t)fr * ldk + fq * 8;
    const bf16_t* vl = Vt + (size_t)fr * ldv + 4 * fq;
    bf16x8 kfA[2][2], kfB[2][2]; s16x4 vA[4][2], vB[4][2];
#define ATT_LOAD(KF, VF, kb_) do { \
        _Pragma("unroll") for (int i2 = 0; i2 < 2; ++i2) _Pragma("unroll") for (int ks = 0; ks < 2; ++ks) KF[i2][ks] = *(const bf16x8*)(kl + (size_t)(32 * (kb_) + 16 * i2) * ldk + ks * 32); \
        _Pragma("unroll") for (int dt = 0; dt < 4; ++dt) { VF[dt][0] = *(const s16x4*)(vl + (size_t)(16 * dt) * ldv + 32 * (kb_)); VF[dt][1] = *(const s16x4*)(vl + (size_t)(16 * dt) * ldv + 32 * (kb_) + 16); } } while (0)
#define ATT_COMPUTE(KF, VF, kb_) do { \
        _Pragma("unroll") for (int qt = 0; qt < 2; ++qt) { \
            f32x4 s0 = mfma16(KF[0][0], qf[qt][0], zero); s0 = mfma16(KF[0][1], qf[qt][1], s0); \
            f32x4 s1 = mfma16(KF[1][0], qf[qt][0], zero); s1 = mfma16(KF[1][1], qf[qt][1], s1); \
            if (MASKED) { const unsigned mw = mask[(16 * qt + fr) * 65 + (kb_)]; const unsigned b0 = mw >> (2 * fq), b1 = mw >> (8 + 2 * fq); \
                _Pragma("unroll") for (int r = 0; r < 4; ++r) { const int sh_ = (r >> 1) + 16 * (r & 1); s0[r] = ((b0 >> sh_) & 1u) ? s0[r] : NEG_INF; s1[r] = ((b1 >> sh_) & 1u) ? s1[r] : NEG_INF; } } \
            float mx = fmaxf(fmaxf(fmaxf(s0[0], s0[1]), fmaxf(s0[2], s0[3])), fmaxf(fmaxf(s1[0], s1[1]), fmaxf(s1[2], s1[3]))); \
            mx = fmaxf(mx, __shfl_xor(mx, 16)); mx = fmaxf(mx, __shfl_xor(mx, 32)); \
            const float mn = fmaxf(m[qt], mx), ms = (mn == NEG_INF) ? 0.f : mn; \
            const float alpha = __builtin_amdgcn_exp2f((m[qt] - ms) * LOG2E); \
            f32x4 p0, p1; \
            _Pragma("unroll") for (int r = 0; r < 4; ++r) { p0[r] = __builtin_amdgcn_exp2f((s0[r] - ms) * LOG2E); p1[r] = __builtin_amdgcn_exp2f((s1[r] - ms) * LOG2E); } \
            l[qt] = l[qt] * alpha + ((p0[0] + p0[1]) + (p0[2] + p0[3])) + ((p1[0] + p1[1]) + (p1[2] + p1[3])); \
            m[qt] = mn; \
            u32x4 pw; pw.x = cvtpk(p0[0], p0[1]); pw.y = cvtpk(p0[2], p0[3]); pw.z = cvtpk(p1[0], p1[1]); pw.w = cvtpk(p1[2], p1[3]); \
            const bf16x8 pf = __builtin_bit_cast(bf16x8, pw); \
            _Pragma("unroll") for (int dt = 0; dt < 4; ++dt) { const bf16x8 vf = __builtin_shufflevector(VF[dt][0], VF[dt][1], 0, 1, 2, 3, 4, 5, 6, 7); \
                o[dt][qt] = o[dt][qt] * alpha; o[dt][qt] = mfma16(vf, pf, o[dt][qt]); } } } while (0)
    ATT_LOAD(kfA, vA, 0);
    const int last = nkb - 1;
    for (int kb = 0; kb < nkb; kb += 2) {
        ATT_LOAD(kfB, vB, kb + 1);
        ATT_COMPUTE(kfA, vA, kb);
        { const int k2 = kb + 2 < last ? kb + 2 : last; ATT_LOAD(kfA, vA, k2); }
        ATT_COMPUTE(kfB, vB, kb + 1);
    }
#undef ATT_LOAD
#undef ATT_COMPUTE
#pragma unroll
    for (int qt = 0; qt < 2; ++qt) { float lt = l[qt]; lt += __shfl_xor(lt, 16); lt += __shfl_xor(lt, 32); linv[qt] = 1.f / lt; }
}
DI void attn_store(const f32x4 (&o)[4][2], const float (&linv)[2], const bf16_t* gate  , bf16_t* mix  , int fr, int fq) {
#pragma unroll
    for (int qt = 0; qt < 2; ++qt)
#pragma unroll
        for (int dt = 0; dt < 4; ++dt) {
            const size_t row = 16 * qt + fr; const int col = 16 * dt + 4 * fq;
            const u32x2 gw = *(const u32x2*)(gate + row * 256 + col);
            f32x4 v = o[dt][qt] * linv[qt];
            v[0] *= __uint_as_float(gw.x << 16); v[1] *= __uint_as_float(gw.x & 0xffff0000u); v[2] *= __uint_as_float(gw.y << 16); v[3] *= __uint_as_float(gw.y & 0xffff0000u);
            st_bf16x4(mix + row * 1024 + col, v);
        }
}

constexpr int DS_MASK = 0, DS_PKT = 16640, PKT_LD = 2052, DS_CNT = 147968;
typedef unsigned short u16x2 __attribute__((ext_vector_type(2)));
DI unsigned pk_cnt_ge(unsigned acc, unsigned kpair, unsigned cm1, unsigned ones) {
    unsigned t;
    asm("v_pk_sub_u16 %1, %2, %3 clamp\n\tv_pk_min_u16 %1, %1, %4\n\tv_pk_add_u16 %0, %0, %1" : "+v"(acc), "=&v"(t) : "v"(kpair), "v"(cm1), "v"(ones));
    return acc;
}
DI void select_bitwise(const unsigned (&key)[16][4], int lbase, LAS3 unsigned* CNT, int& it, int fr, int lane, unsigned& T, int& Xrel) {
    bool fin = false;
    T = 0u; Xrel = 0x7fffffff;
    for (int bit = 31; bit >= 0; --bit) {
        const unsigned cand = T | (1u << bit);
        unsigned c = 0;
#pragma unroll
        for (int n = 0; n < 16; ++n)
#pragma unroll
            for (int r = 0; r < 4; ++r) cnt_ge(c, key[n][r], cand);
        const unsigned tot = grp_count16(c, CNT, it, fr, lane);
        if (!fin && tot >= 256u) { T = cand; fin = (tot == 256u); }
        if (__all(fin)) break;
    }
    if (!__all(fin)) {
        unsigned c = 0;
#pragma unroll
        for (int n = 0; n < 16; ++n)
#pragma unroll
            for (int r = 0; r < 4; ++r) cnt_gt(c, key[n][r], T);
        const unsigned cgt = grp_count16(c, CNT, it, fr, lane);
        const unsigned need = 256u - cgt;
        unsigned Xl = 0u;
        for (int bit = 10; bit >= 0; --bit) {
            const unsigned cand = Xl | (1u << bit);
            const int crel = (int)cand - lbase;
            c = 0;
#pragma unroll
            for (int n = 0; n < 16; ++n) { const int crn = crel - 128 * n;
#pragma unroll
                for (int r = 0; r < 4; ++r) c += (key[n][r] == T && r < crn) ? 1u : 0u; }
            const unsigned tot = grp_count16(c, CNT, it, fr, lane);
            if (tot < need) Xl = cand;
        }
        if (!fin) Xrel = (int)Xl - lbase;
    }
}
DI unsigned pk_flag_ge(unsigned kpair, unsigned cm1, unsigned ones) {
    unsigned t;
    asm("v_pk_sub_u16 %0, %1, %2 clamp\n\tv_pk_min_u16 %0, %0, %3" : "=&v"(t) : "v"(kpair), "v"(cm1), "v"(ones));
    return t;
}
DI unsigned pk_max(unsigned a, unsigned b2) { unsigned t; asm("v_pk_max_u16 %0, %1, %2" : "=v"(t) : "v"(a), "v"(b2)); return t; }
DI unsigned hsum32(unsigned x) {
    x += __builtin_amdgcn_update_dpp(0u, x, 0xB1, 0xF, 0xF, false); x += __builtin_amdgcn_update_dpp(0u, x, 0x4E, 0xF, 0xF, false);
    x += __builtin_amdgcn_update_dpp(0u, x, 0x141, 0xF, 0xF, false); x += __builtin_amdgcn_update_dpp(0u, x, 0x140, 0xF, 0xF, false);
    const auto r = __builtin_amdgcn_permlane16_swap(x, x, false, false); return r[0] + r[1];
}
DI unsigned hmax32(unsigned x) {
    x = max(x, (unsigned)__builtin_amdgcn_update_dpp(0u, x, 0xB1, 0xF, 0xF, false)); x = max(x, (unsigned)__builtin_amdgcn_update_dpp(0u, x, 0x4E, 0xF, 0xF, false));
    x = max(x, (unsigned)__builtin_amdgcn_update_dpp(0u, x, 0x141, 0xF, 0xF, false)); x = max(x, (unsigned)__builtin_amdgcn_update_dpp(0u, x, 0x140, 0xF, 0xF, false));
    const auto r = __builtin_amdgcn_permlane16_swap(x, x, false, false); return max(r[0], r[1]);
}
DI unsigned pk_count32(const unsigned (&rk)[32], unsigned cm1, unsigned ones) {
    unsigned a0 = 0u, a1 = 0u;
#pragma unroll
    for (int k = 0; k < 32; k += 2) { a0 = pk_cnt_ge(a0, rk[k], cm1, ones); a1 = pk_cnt_ge(a1, rk[k + 1], cm1, ones); }
    return (a0 & 0xffffu) + (a0 >> 16) + (a1 & 0xffffu) + (a1 >> 16);
}
DI void dsa_unit(const Params& p, LAS3 unsigned char* lds, int b, int j TARGS) {
    int tid = threadIdx.x; asm volatile("" : "+v"(tid));
    const int lane0 = tid & 63, w = __builtin_amdgcn_readfirstlane(tid >> 6);
    unsigned char* ws = p.ws;
    LAS3 unsigned* MASK = (LAS3 unsigned*)(lds + DS_MASK);
    LAS3 unsigned* PKT = (LAS3 unsigned*)(lds + DS_PKT);
    const bf16_t* IQ = (const bf16_t*)(ws + W_IQ); const bf16_t* IK = (const bf16_t*)(ws + W_IK); const float* IW = (const float*)(ws + W_IW);
    const int q0 = 64 * j;
    const f32x4 zero = {0.f, 0.f, 0.f, 0.f};
#ifdef CHECK_SEL
    LAS3 unsigned* CNT = (LAS3 unsigned*)(lds + DS_CNT); int it = 0;
    if (tid < 48) CNT[tid] = 0u;
    __syncthreads();
#endif
    TBEG(30);
#pragma unroll 1
    for (int qg = 0; qg < 4; ++qg) {
        TBEG(32);
        int lane = lane0; asm volatile("" : "+v"(lane));
        const int fr = lane & 15, fq = lane >> 4;
        const int tq = q0 + 16 * qg + fr; const size_t qrow = (size_t)b * SEQ + tq;
        const int ntile = 4 * j + qg + 1;
        const int nloc = ntile > w ? (ntile - w + 7) >> 3 : 0;
        const bool selecting = q0 + 16 * qg >= 256;
        {
            bf16x8 bq[4][2];
#pragma unroll
            for (int h = 0; h < 4; ++h)
#pragma unroll
                for (int ks = 0; ks < 2; ++ks) bq[h][ks] = *(const bf16x8*)(IQ + qrow * 256 + h * 64 + ks * 32 + fq * 8);
            const f32x4 wq = *(const f32x4*)(IW + qrow * 4);
            float Lh[4];
#pragma unroll
            for (int h = 0; h < 4; ++h) Lh[h] = wq[h] < 0.f ? NEG_INF : -NEG_INF;
            const char* tb = (const char*)IK + ((size_t)b * SEQ + 16 * w) * 128 + (unsigned)(fr * 128 + fq * 16);
            LAS3 unsigned* krow = PKT + fr * PKT_LD + 16 * w + 4 * fq;
            const int lim0 = tq - (16 * w + 4 * fq);
#define DSA_TILE(A0, A1, nn) do { \
                f32x4 sc = zero; \
                _Pragma("unroll") for (int h = 0; h < 4; ++h) { f32x4 d = mfma16(A0, bq[h][0], zero); d = mfma16(A1, bq[h][1], d); d = d * wq[h]; \
                    _Pragma("unroll") for (int r = 0; r < 4; ++r) sc[r] += __builtin_amdgcn_fmed3f(d[r], 0.f, Lh[h]); } \
                { const char* t2_ = tb + (size_t)((nn) + 2 < nloc ? (nn) + 2 : nloc - 1) * 16384; A0 = *(const bf16x8*)t2_; A1 = *(const bf16x8*)(t2_ + 64); } \
                const int limn = lim0 - 128 * (nn);                   \
                u32x4 kv; \
                _Pragma("unroll") for (int r = 0; r < 4; ++r) { const unsigned u = __float_as_uint(sc[r] + 0.f); const unsigned k = u ^ ((unsigned)((int)u >> 31) | 0x80000000u);   \
                    kv[r] = (r <= limn) ? k : 0u; } \
                *(LAS3 u32x4*)(krow + 128 * (nn)) = kv; } while (0)
            if (nloc > 0) {
                bf16x8 a0 = *(const bf16x8*)tb, a1 = *(const bf16x8*)(tb + 64);
                const char* t1 = tb + (size_t)(1 < nloc ? 1 : 0) * 16384;
                bf16x8 b0 = *(const bf16x8*)t1, b1 = *(const bf16x8*)(t1 + 64);
#pragma unroll 1
                for (int n = 0; n < nloc; n += 2) {
                    DSA_TILE(a0, a1, n);
                    if (n + 1 < nloc) DSA_TILE(b0, b1, n + 1);
                }
            }
#undef DSA_TILE
        }
        TEND(32); TBEG(33);
        __syncthreads();
        {
            const int hh = lane >> 5, pos = lane & 31, oq = 2 * w + hh;
            const unsigned nkeys = 16u * (unsigned)ntile;
            const LAS3 unsigned* orow = PKT + oq * PKT_LD + 2 * pos;
            unsigned ones = 0x00010001u; asm volatile("" : "+v"(ones));
            unsigned Tfull = 1u, X = 0xffffffffu;
            if (selecting) {
                unsigned rk[32];
#pragma unroll
                for (int k = 0; k < 32; ++k) { const u32x2 kk = *(const LAS3 u32x2*)(orow + 64 * k); rk[k] = (2u * (unsigned)(pos + 32 * k) < nkeys) ? __builtin_amdgcn_perm(kk.y, kk.x, 0x07060302u) : 0u; }
                unsigned mx = 0u;
#pragma unroll
                for (int k = 0; k < 32; ++k) mx = pk_max(mx, rk[k]);
                const unsigned kmax = hmax32(max(mx & 0xffffu, mx >> 16));
                unsigned T16 = 0u, cabove = 0u; bool exact = false;
                {
                    unsigned ub = 0x10000u;
#pragma unroll 1
                    for (int bit = 15; bit >= 0; --bit) {
                        const unsigned cand = T16 | (1u << bit);
                        if (__all(cand > kmax)) { ub = cand; continue; }
                        const unsigned tot = hsum32(pk_count32(rk, (cand - 1u) * 0x00010001u, ones));
                        if (tot >= 256u) T16 = cand; else { ub = cand; cabove = tot; }
                    }
                    (void)ub;
                }
                const unsigned need = 256u - cabove;
#pragma unroll
                for (int k = 0; k < 32; ++k) { const u32x2 kk = *(const LAS3 u32x2*)(orow + 64 * k); const bool in = 2u * (unsigned)(pos + 32 * k) < nkeys;
                    const unsigned lo0 = (in && (kk.x >> 16) == T16) ? (kk.x & 0xffffu) : 0u, lo1 = (in && (kk.y >> 16) == T16) ? (kk.y & 0xffffu) : 0u; rk[k] = lo0 | (lo1 << 16); }
                unsigned Tlo = 0u;
#pragma unroll 1
                for (int bit = 15; bit >= 0; --bit) {
                    const unsigned cand = Tlo | (1u << bit);
                    const unsigned tot = hsum32(pk_count32(rk, (cand - 1u) * 0x00010001u, ones));
                    if (!exact && tot >= need) { Tlo = cand; exact = (tot == need); }
                    if (__all(exact)) break;
                }
                Tfull = (T16 << 16) | Tlo;
                if (!__all(exact)) {
                    unsigned cgt = 0u, ceq = 0u;
#pragma unroll 1
                    for (int k = 0; k < 32; ++k) { const u32x2 kk = *(const LAS3 u32x2*)(orow + 64 * k); const bool in = 2u * (unsigned)(pos + 32 * k) < nkeys;
                        cgt += (in && kk.x > Tfull && (kk.x >> 16) == T16 ? 1u : 0u) + (in && kk.y > Tfull && (kk.y >> 16) == T16 ? 1u : 0u); }
                    (void)ceq;
                    const unsigned needt = need - hsum32(cgt);
                    unsigned Xl = 0u;
#pragma unroll 1
                    for (int bit = 10; bit >= 0; --bit) {
                        const unsigned cx = Xl | (1u << bit);
                        unsigned c = 0u;
#pragma unroll 1
                        for (int k = 0; k < 32; ++k) { const u32x2 kk = *(const LAS3 u32x2*)(orow + 64 * k); const unsigned i0 = 2u * (unsigned)(pos + 32 * k);
                            c += (i0 < nkeys && kk.x == Tfull && i0 < cx ? 1u : 0u) + (i0 < nkeys && kk.y == Tfull && i0 + 1u < cx ? 1u : 0u); }
                        if (hsum32(c) < needt) Xl = cx;
                    }
                    if (!exact) X = Xl;
                }
            }
            LAS3 unsigned* mrow = MASK + (16 * qg + oq) * 65 + (pos >> 4);
            const unsigned sh = 32u * hh + (pos & 16);
#pragma unroll 2
            for (int k = 0; k <= j; ++k) {
                const u32x2 kk = *(const LAS3 u32x2*)(orow + 64 * k); const unsigned i0 = 2u * (unsigned)(pos + 32 * k);
                const bool s0 = i0 < nkeys && (kk.x > Tfull || (kk.x == Tfull && i0 <= X)), s1 = i0 < nkeys && (kk.y > Tfull || (kk.y == Tfull && i0 + 1u <= X));
                const unsigned long long blo = __ballot(s0), bhi = __ballot(s1);
                const unsigned wv = ((unsigned)(blo >> sh) & 0xffffu) | ((unsigned)(bhi >> sh) << 16);
                if ((pos & 15) == 0) mrow[2 * k] = wv;
            }
        }
        TEND(33);
        __syncthreads();
#ifdef CHECK_SEL
        if (selecting) {
            const int lbase = 16 * w + 4 * fq;
            unsigned key[16][4];
#pragma unroll
            for (int n = 0; n < 16; ++n)
#pragma unroll
                for (int r = 0; r < 4; ++r) key[n][r] = (n < nloc) ? PKT[fr * PKT_LD + lbase + 128 * n + r] : 0u;
            unsigned T2; int X2; select_bitwise(key, lbase, CNT, it, fr, lane, T2, X2);
            bool bad = false;
#pragma unroll
            for (int n = 0; n < 16; ++n) if (n < nloc) { const int x2 = X2 - 128 * n;
#pragma unroll
                for (int r = 0; r < 4; ++r) { const unsigned idx = (unsigned)(lbase + 128 * n + r); const unsigned mw = MASK[(16 * qg + fr) * 65 + (idx >> 5)];
                    const bool s2 = key[n][r] > T2 || (key[n][r] == T2 && r <= x2); bad |= (s2 != (((mw >> (((idx & 31u) >> 1) + 16u * (idx & 1u))) & 1u) != 0u)); } }
            if (__any(bad) && lane == 0) atomicAdd((unsigned*)(ws + CW_CHK), 1u);
            if (lane == 0 && w == 0) atomicAdd((unsigned*)(ws + CW_CHK + 4), 1u);
            __syncthreads();
        }
#endif
    }
    TEND(30); TBEG(31);
    {
        const int h = w & 3, hf = w >> 2, fr = lane0 & 15, fq = lane0 >> 4;
        const size_t qrow0 = (size_t)b * SEQ + q0 + 32 * hf;
        f32x4 o[4][2]; float linv[2];
        attn32<true>((const bf16_t*)(ws + W_DQ) + qrow0 * 256 + h * 64, 256, (const bf16_t*)(ws + W_DK) + (size_t)b * SEQ * 256 + h * 64, 256,
                     (const bf16_t*)(ws + W_DVT) + (size_t)(b * 4 + h) * 64 * SEQ, SEQ, 2 * j + 2  , MASK + 32 * hf * 65, fr, fq, o, linv);
        attn_store(o, linv, (const bf16_t*)(ws + W_DG) + qrow0 * 256 + h * 64, (bf16_t*)(ws + W_MIX) + qrow0 * 1024 + 512 + h * 64, fr, fq);
    }
    __syncthreads();
    TEND(31);
}
DI void mem_unit(const Params& p, int n) {
    const int tid = threadIdx.x, lane = tid & 63, w = __builtin_amdgcn_readfirstlane(tid >> 6), fr = lane & 15, fq = lane >> 4;
    unsigned char* ws = p.ws;
    const int h = w & 3, hf = w >> 2;
    const size_t qrow0 = (size_t)n * 64 + 32 * hf; const int b = n >> 5;
    f32x4 o[4][2]; float linv[2];
    attn32<false>((const bf16_t*)(ws + W_MQ) + qrow0 * 256 + h * 64, 256, (const bf16_t*)(ws + W_MK) + (size_t)b * NMEM * 256 + h * 64, 256,
                  (const bf16_t*)(ws + W_MVT) + (size_t)(b * 4 + h) * 64 * NMEM, NMEM, 8, nullptr, fr, fq, o, linv);
    attn_store(o, linv, (const bf16_t*)(ws + W_MG) + qrow0 * 256 + h * 64, (bf16_t*)(ws + W_MIX) + qrow0 * 1024 + 768 + h * 64, fr, fq);
}
constexpr int GL_QT = 0, GL_KT = 9216, GL_KPT = 18432, GL_VT = 27648, GL_SBT = 46080, GL_PM = 64512, GL_OF = 73728, GL_GTOT = 107520, GL_W2 = 109568, GL_BG = 113664, GL_DEC = 113920;
constexpr int LDP = 72;
DI void gla_unit(const Params& p, LAS3 unsigned char* lds, int b, int h) {
    const int tid = threadIdx.x, lane = tid & 63, w = __builtin_amdgcn_readfirstlane(tid >> 6), fr = lane & 15, fq = lane >> 4;
    unsigned char* ws = p.ws;
    LAS3 bf16_t* Qt = (LAS3 bf16_t*)(lds + GL_QT); LAS3 bf16_t* Kt = (LAS3 bf16_t*)(lds + GL_KT); LAS3 bf16_t* KpT = (LAS3 bf16_t*)(lds + GL_KPT);
    LAS3 bf16_t* Vt = (LAS3 bf16_t*)(lds + GL_VT); LAS3 bf16_t* SbT = (LAS3 bf16_t*)(lds + GL_SBT); LAS3 bf16_t* Pm = (LAS3 bf16_t*)(lds + GL_PM);
    LAS3 float* Of = (LAS3 float*)(lds + GL_OF); LAS3 float* gtot = (LAS3 float*)(lds + GL_GTOT); LAS3 float* w2s = (LAS3 float*)(lds + GL_W2);
    LAS3 float* bgs = (LAS3 float*)(lds + GL_BG); LAS3 float* dec = (LAS3 float*)(lds + GL_DEC);
    const bf16_t* GQ = (const bf16_t*)(ws + W_GQ); const bf16_t* GK = (const bf16_t*)(ws + W_GK); const bf16_t* GV = (const bf16_t*)(ws + W_GV);
    const bf16_t* GG = (const bf16_t*)(ws + W_GG); const float* GLR = (const float*)(ws + W_GLR); bf16_t* MIX = (bf16_t*)(ws + W_MIX);
    for (int i = tid; i < 128 * LDP / 2; i += NTHREADS) ((LAS3 unsigned*)SbT)[i] = 0u;
    for (int i = tid; i < 16 * 64; i += NTHREADS) w2s[i] = p.w_g2[(i >> 6) * 256 + h * 64 + (i & 63)];
    if (tid < 64) bgs[tid] = p.b_g[h * 64 + tid];
    __syncthreads();
    const int d = tid & 63, tg = w;
    float wreg[16];
#pragma unroll
    for (int r = 0; r < 16; ++r) wreg[r] = w2s[r * 64 + d];
    const float bgd = bgs[d];
    const f32x4 zero = {0.f, 0.f, 0.f, 0.f};
    f32x4 Sacc[4] = {zero, zero, zero, zero};
    const int tt = w & 3, vh = w >> 2;
    for (int c = 0; c < 32; ++c) {
        const size_t rb = (size_t)b * SEQ + c * 64;
        float g8[8];
#pragma unroll
        for (int i = 0; i < 8; ++i) {
            const float* gl = vaddr(GLR + (rb + tg * 8 + i) * 16);
            float u = bgd;
#pragma unroll
            for (int r = 0; r < 16; ++r) u += gl[r] * wreg[r];
            const float g = logsigf(u) * (1.f / 16.f);
            g8[i] = (i ? g8[i - 1] : 0.f) + g;
        }
        gtot[tg * 64 + d] = g8[7];
        __syncthreads();
        float off = 0.f, blast = 0.f;
#pragma unroll
        for (int g2 = 0; g2 < 8; ++g2) { const float v = gtot[g2 * 64 + d]; off += (g2 < tg) ? v : 0.f; blast += v; }
        float kp[8];
#pragma unroll
        for (int i = 0; i < 8; ++i) {
            const int t = tg * 8 + i; const float bt = off + g8[i];
            const float q = bf2f(GQ[(rb + t) * 256 + h * 64 + d]), k = bf2f(GK[(rb + t) * 256 + h * 64 + d]);
            Qt[t * LDP + d] = f2bf(q * expf(bt)); Kt[t * LDP + d] = f2bf(k * expf(-bt)); kp[i] = k * expf(blast - bt);
        }
        { u32x4 kw; kw.x = cvtpk(kp[0], kp[1]); kw.y = cvtpk(kp[2], kp[3]); kw.z = cvtpk(kp[4], kp[5]); kw.w = cvtpk(kp[6], kp[7]); *(LAS3 u32x4*)(KpT + d * LDP + tg * 8) = kw; }
        if (tg == 0) dec[d] = expf(blast);
        { const int v = tid & 127, sg = tid >> 7; bf16_t vv[16];
#pragma unroll
          for (int i = 0; i < 16; ++i) vv[i] = GV[(rb + sg * 16 + i) * 512 + h * 128 + v];
          u32x4 a, bb; a.x = vv[0] | ((unsigned)vv[1] << 16); a.y = vv[2] | ((unsigned)vv[3] << 16); a.z = vv[4] | ((unsigned)vv[5] << 16); a.w = vv[6] | ((unsigned)vv[7] << 16);
          bb.x = vv[8] | ((unsigned)vv[9] << 16); bb.y = vv[10] | ((unsigned)vv[11] << 16); bb.z = vv[12] | ((unsigned)vv[13] << 16); bb.w = vv[14] | ((unsigned)vv[15] << 16);
          *(LAS3 u32x4*)(Vt + v * LDP + sg * 16) = a; *(LAS3 u32x4*)(Vt + v * LDP + sg * 16 + 8) = bb; }
        __syncthreads();
#pragma unroll
        for (int s2 = 0; s2 < 2; ++s2) {
            const int st = 2 * vh + s2;
            f32x4 acc = zero;
#pragma unroll
            for (int ks = 0; ks < 2; ++ks) {
                const bf16x8 a = *(const LAS3 bf16x8*)(Kt + (st * 16 + fr) * LDP + ks * 32 + fq * 8), bq = *(const LAS3 bf16x8*)(Qt + (tt * 16 + fr) * LDP + ks * 32 + fq * 8);
                acc = mfma16(a, bq, acc);
            }
            const int t = tt * 16 + fr, s0 = st * 16 + 4 * fq;
            u32x2 pw; pw.x = cvtpk(s0 <= t ? acc[0] : 0.f, s0 + 1 <= t ? acc[1] : 0.f); pw.y = cvtpk(s0 + 2 <= t ? acc[2] : 0.f, s0 + 3 <= t ? acc[3] : 0.f);
            *(LAS3 u32x2*)(Pm + t * LDP + s0) = pw;
        }
        __syncthreads();
        f32x4 oacc[4];
        {
            bf16x8 aq[2], ap[2], ak[2];
#pragma unroll
            for (int ks = 0; ks < 2; ++ks) {
                aq[ks] = *(const LAS3 bf16x8*)(Qt + (tt * 16 + fr) * LDP + ks * 32 + fq * 8);
                ap[ks] = *(const LAS3 bf16x8*)(Pm + (tt * 16 + fr) * LDP + ks * 32 + fq * 8);
                ak[ks] = *(const LAS3 bf16x8*)(KpT + (tt * 16 + fr) * LDP + ks * 32 + fq * 8);
            }
            const f32x4 dv = *(const LAS3 f32x4*)(dec + tt * 16 + 4 * fq);
#pragma unroll
            for (int jv = 0; jv < 4; ++jv) {
                const int vt = vh * 4 + jv;
                bf16x8 bs[2], bv[2];
#pragma unroll
                for (int ks = 0; ks < 2; ++ks) {
                    bs[ks] = *(const LAS3 bf16x8*)(SbT + (vt * 16 + fr) * LDP + ks * 32 + fq * 8);
                    bv[ks] = *(const LAS3 bf16x8*)(Vt + (vt * 16 + fr) * LDP + ks * 32 + fq * 8);
                }
                f32x4 oa = mfma16(aq[0], bs[0], zero); oa = mfma16(aq[1], bs[1], oa); oa = mfma16(ap[0], bv[0], oa); oa = mfma16(ap[1], bv[1], oa);
                oacc[jv] = oa;
                f32x4 sa = Sacc[jv] * dv; sa = mfma16(ak[0], bv[0], sa); sa = mfma16(ak[1], bv[1], sa);
                Sacc[jv] = sa;
            }
        }
        __syncthreads();
#pragma unroll
        for (int jv = 0; jv < 4; ++jv) {
            const int vt = vh * 4 + jv;
#pragma unroll
            for (int r = 0; r < 4; ++r) Of[(tt * 16 + 4 * fq + r) * 132 + vt * 16 + fr] = oacc[jv][r];
            u32x2 sw; sw.x = cvtpk(Sacc[jv][0], Sacc[jv][1]); sw.y = cvtpk(Sacc[jv][2], Sacc[jv][3]);
            *(LAS3 u32x2*)(SbT + (vt * 16 + fr) * LDP + tt * 16 + 4 * fq) = sw;
        }
        __syncthreads();
        {
            const int t = tid >> 3, seg = tid & 7;
            const LAS3 float* op = Of + t * 132 + seg * 16;
            f32x4 ov[4]; float ss = 0.f;
#pragma unroll
            for (int i = 0; i < 4; ++i) { ov[i] = *(const LAS3 f32x4*)(op + 4 * i); ss += ov[i][0] * ov[i][0] + ov[i][1] * ov[i][1] + ov[i][2] * ov[i][2] + ov[i][3] * ov[i][3]; }
            ss += __shfl_xor(ss, 1); ss += __shfl_xor(ss, 2); ss += __shfl_xor(ss, 4);
            const float rstd = rsqrtf(ss * (1.f / 128.f) + 1e-6f);
            const bf16_t* gp = GG + (rb + t) * 512 + h * 128 + seg * 16;
            const u32x4 g0 = *(const u32x4*)gp, g1 = *(const u32x4*)(gp + 8);
            const unsigned gw[8] = {g0.x, g0.y, g0.z, g0.w, g1.x, g1.y, g1.z, g1.w};
            unsigned ow[8];
#pragma unroll
            for (int i = 0; i < 4; ++i) {
                const f32x4 on = *(const f32x4*)(p.onorm + seg * 16 + 4 * i);
                const float y0 = ov[i][0] * rstd * on[0] * __uint_as_float(gw[2 * i] << 16), y1 = ov[i][1] * rstd * on[1] * __uint_as_float(gw[2 * i] & 0xffff0000u);
                const float y2 = ov[i][2] * rstd * on[2] * __uint_as_float(gw[2 * i + 1] << 16), y3 = ov[i][3] * rstd * on[3] * __uint_as_float(gw[2 * i + 1] & 0xffff0000u);
                ow[2 * i] = cvtpk(y0, y1); ow[2 * i + 1] = cvtpk(y2, y3);
            }
            bf16_t* mp = MIX + (rb + t) * 1024 + h * 128 + seg * 16;
            *(u32x4*)mp = (u32x4){ow[0], ow[1], ow[2], ow[3]}; *(u32x4*)(mp + 8) = (u32x4){ow[4], ow[5], ow[6], ow[7]};
        }
    }
#pragma unroll
    for (int jv = 0; jv < 4; ++jv)
#pragma unroll
        for (int r = 0; r < 4; ++r) p.out[O_GSP + ((size_t)(b * 4 + h) * 64 + tt * 16 + 4 * fq + r) * 128 + (vh * 4 + jv) * 16 + fr] = Sacc[jv][r];
    __syncthreads();
}

DI void sscore_unit(const Params& p, LAS3 unsigned char* lds, int u) {
    const int tid = threadIdx.x;
    unsigned char* ws = p.ws;
    const int b = u >> 3, pg = u & 7;
    LAS3 float* qf = (LAS3 float*)lds;
    if (tid < 256) qf[tid] = bf2f(((const bf16_t*)(ws + W_IQ))[(size_t)(MP + b) * 256 + tid]);
    __syncthreads();
    const int seg = tid & 15;
    f32x4 q[4];
#pragma unroll
    for (int h = 0; h < 4; ++h) q[h] = *(const LAS3 f32x4*)(qf + h * 64 + seg * 4);
    const f32x4 wv = *(const f32x4*)vaddr((const float*)(ws + W_IW) + (size_t)(MP + b) * 4);
    unsigned* sc = (unsigned*)(ws + W_SC) + (size_t)b * SCLD;
    for (int pi = pg * 16; pi < pg * 16 + 16; ++pi) {
        const int phys = p.page_table[b * NPAGES + pi];
        const float* base = p.cache_ik + (size_t)phys * 8192;
#pragma unroll
        for (int i = 0; i < 4; ++i) {
            const int e = tid + 512 * i;
            const f32x4 kv = *(const f32x4*)(base + (size_t)e * 4);
            float dh[4];
#pragma unroll
            for (int h = 0; h < 4; ++h) {
                float x = q[h][0] * kv[0] + q[h][1] * kv[1] + q[h][2] * kv[2] + q[h][3] * kv[3];
                x += __shfl_xor(x, 1); x += __shfl_xor(x, 2); x += __shfl_xor(x, 4); x += __shfl_xor(x, 8);
                dh[h] = x;
            }
            const float s = wv[0] * fmaxf(dh[0], 0.f) + wv[1] * fmaxf(dh[1], 0.f) + wv[2] * fmaxf(dh[2], 0.f) + wv[3] * fmaxf(dh[3], 0.f);
            if (seg == 0) __hip_atomic_store(sc + pi * 128 + (e >> 4), __float_as_uint(s), __ATOMIC_RELAXED, __HIP_MEMORY_SCOPE_AGENT);
        }
    }
    asm volatile("s_waitcnt vmcnt(0)" ::: "memory");
    __syncthreads();
    if (tid == 0) __hip_atomic_fetch_add((unsigned*)(ws + CW_SCNT), 1u, __ATOMIC_RELAXED, __HIP_MEMORY_SCOPE_AGENT);
}

constexpr int SA_Q = 2048, SA_S = 3072, SA_KP = 8192, SA_VP = 10240;
DI void sattend(const Params& p, LAS3 unsigned char* lds, const bf16_t* qrow  , const bf16_t* gate, bf16_t* mix) {
    const int tid = threadIdx.x, lane = tid & 63, w = tid >> 6;
    LAS3 float* qf = (LAS3 float*)(lds + SA_Q); LAS3 float* S = (LAS3 float*)(lds + SA_S);
    const float* const LAS3* kptr = (const float* const LAS3*)(lds + SA_KP); const float* const LAS3* vptr = (const float* const LAS3*)(lds + SA_VP);
    if (tid < 256) qf[tid] = bf2f(qrow[tid]);
    __syncthreads();
    {
        const int jk = tid >> 1, hp = tid & 1;
        const float* kr = kptr[jk] + hp * 128;
        float s0 = 0.f, s1 = 0.f;
#pragma unroll 4
        for (int i = 0; i < 16; ++i) {
            const f32x4 k0 = *(const f32x4*)(kr + 4 * i), k1 = *(const f32x4*)(kr + 64 + 4 * i);
            const f32x4 q0 = *(const LAS3 f32x4*)(qf + hp * 128 + 4 * i), q1 = *(const LAS3 f32x4*)(qf + hp * 128 + 64 + 4 * i);
            s0 += q0[0] * k0[0] + q0[1] * k0[1] + q0[2] * k0[2] + q0[3] * k0[3];
            s1 += q1[0] * k1[0] + q1[1] * k1[1] + q1[2] * k1[2] + q1[3] * k1[3];
        }
        S[(2 * hp) * 256 + jk] = s0; S[(2 * hp + 1) * 256 + jk] = s1;
    }
    __syncthreads();
    if (w < 4) {
        float v[4], mx = NEG_INF;
#pragma unroll
        for (int i = 0; i < 4; ++i) { v[i] = S[w * 256 + lane + 64 * i]; mx = fmaxf(mx, v[i]); }
        mx = wmax64(mx);
        float sum = 0.f;
#pragma unroll
        for (int i = 0; i < 4; ++i) { v[i] = __expf(v[i] - mx); sum += v[i]; }
        sum = wsum64(sum);
        const float inv = 1.f / sum;
#pragma unroll
        for (int i = 0; i < 4; ++i) S[w * 256 + lane + 64 * i] = v[i] * inv;
    }
    __syncthreads();
    {
        const int h = tid >> 7, dd = (tid >> 1) & 63, hf = tid & 1;
        float acc = 0.f;
#pragma unroll 4
        for (int jk = hf * 128; jk < hf * 128 + 128; ++jk) acc += S[h * 256 + jk] * vptr[jk][h * 64 + dd];
        acc += __shfl_xor(acc, 1);
        if (hf == 0) mix[h * 64 + dd] = f2bf(acc * bf2f(gate[h * 64 + dd]));
    }
    __syncthreads();
}
DI void smem_unit(const Params& p, LAS3 unsigned char* lds, int b) {
    const int tid = threadIdx.x; unsigned char* ws = p.ws;
    const float* LAS3* kptr = (const float* LAS3*)(lds + SA_KP); const float* LAS3* vptr = (const float* LAS3*)(lds + SA_VP);
    if (tid < 256) { kptr[tid] = p.cache_mem_k + ((size_t)b * NMEM + tid) * 256; vptr[tid] = p.cache_mem_v + ((size_t)b * NMEM + tid) * 256; }
    const size_t row = MP + b;
    sattend(p, lds, (const bf16_t*)(ws + W_MQ) + row * 256, (const bf16_t*)(ws + W_MG) + row * 256, (bf16_t*)(ws + W_MIX) + row * 1024 + 768);
}
DI void ssel_unit(const Params& p, LAS3 unsigned char* lds, int b) {
    const int tid = threadIdx.x, lane = tid & 63, w = tid >> 6; unsigned char* ws = p.ws;
    LAS3 unsigned* CNT = (LAS3 unsigned*)lds;
    LAS3 unsigned* wsum = (LAS3 unsigned*)(lds + 256);
    LAS3 float* newsc = (LAS3 float*)(lds + 320);
    LAS3 int* list = (LAS3 int*)(lds + 512);
    const float* LAS3* kptr = (const float* LAS3*)(lds + SA_KP); const float* LAS3* vptr = (const float* LAS3*)(lds + SA_VP);
    if (tid < 48) CNT[tid] = 0u;
    if (tid == 0) {
        unsigned* cnt = (unsigned*)(ws + CW_SCNT); unsigned* tmo = (unsigned*)(ws + CW_TMO); unsigned sp = 0;
        while (__hip_atomic_load(cnt, __ATOMIC_RELAXED, __HIP_MEMORY_SCOPE_AGENT) < 256u) {
            __builtin_amdgcn_s_sleep(2);
            if ((++sp & 255u) == 0u) { if (__hip_atomic_load(tmo, __ATOMIC_RELAXED, __HIP_MEMORY_SCOPE_AGENT)) break; if (sp > (1u << 20)) { __hip_atomic_store(tmo, 1u, __ATOMIC_RELAXED, __HIP_MEMORY_SCOPE_AGENT); break; } }
        }
        __builtin_amdgcn_fence(__ATOMIC_ACQUIRE, "agent");
        asm volatile("s_waitcnt vmcnt(0)" ::: "memory");
    }
    if (w == 1) {
        const bf16_t* iq = (const bf16_t*)(ws + W_IQ) + (size_t)(MP + b) * 256; const float kd = bf2f(((const bf16_t*)(ws + W_IK))[(size_t)(MP + b) * 64 + lane]);
        const f32x4 wv = *(const f32x4*)vaddr((const float*)(ws + W_IW) + (size_t)(MP + b) * 4);
        float s = 0.f;
#pragma unroll
        for (int h = 0; h < 4; ++h) { const float dh = wsum64(bf2f(iq[h * 64 + lane]) * kd); s += wv[h] * fmaxf(dh, 0.f); }
        if (lane == 0) *newsc = s;
    }
    __syncthreads();
    const float* sc = (const float*)(ws + W_SC) + (size_t)b * SCLD;
    unsigned key[33];
#pragma unroll
    for (int n = 0; n < 32; ++n) key[n] = fkey(sc[tid + 512 * n]);
    key[32] = (tid == 0) ? fkey(*newsc) : 0u;
    int it = 0;
    unsigned T = 0u, X = 0x7fffffffu; bool fin = false;
    for (int bit = 31; bit >= 0; --bit) {
        const unsigned cand = T | (1u << bit);
        unsigned c = 0;
#pragma unroll
        for (int n = 0; n < 33; ++n) cnt_ge(c, key[n], cand);
        const unsigned tot = blk_count(c, CNT, it, lane);
        if (tot >= 256u) { T = cand; fin = (tot == 256u); }
        if (fin) break;
    }
    if (!fin) {
        unsigned c = 0;
#pragma unroll
        for (int n = 0; n < 33; ++n) cnt_gt(c, key[n], T);
        const unsigned need = 256u - blk_count(c, CNT, it, lane);
        unsigned Xl = 0u;
        for (int bit = 14; bit >= 0; --bit) {
            const unsigned cand = Xl | (1u << bit);
            c = 0;
#pragma unroll
            for (int n = 0; n < 33; ++n) cnt_eq_lt(c, key[n], T, (unsigned)(tid + 512 * n), cand);
            if (blk_count(c, CNT, it, lane) < need) Xl = cand;
        }
        X = Xl;
    }
    unsigned selm = 0, hi = 0;
#pragma unroll
    for (int n = 0; n < 32; ++n) selm |= (key[n] > T || (key[n] == T && (unsigned)(tid + 512 * n) <= X)) ? (1u << n) : 0u;
    hi = (key[32] > T || (key[32] == T && (unsigned)(tid + 16384) <= X)) ? 1u : 0u;
    const unsigned cs = __popc(selm) + hi;
    unsigned inc = cs;
#pragma unroll
    for (int o2 = 1; o2 < 64; o2 <<= 1) { const unsigned t2 = __shfl_up(inc, o2); if (lane >= o2) inc += t2; }
    if (lane == 63) wsum[w] = inc;
    __syncthreads();
    unsigned pos = inc - cs;
    for (int w2 = 0; w2 < w; ++w2) pos += wsum[w2];
#pragma unroll
    for (int n = 0; n < 32; ++n) if ((selm >> n) & 1u) { if (pos < 256u) list[pos] = tid + 512 * n; ++pos; }
    if (hi) { if (pos < 256u) list[pos] = tid + 16384; ++pos; }
    __syncthreads();
    if (tid < 256) {
        const int idx = list[tid];
        if (idx < 16384) { const size_t phys = (size_t)p.page_table[b * NPAGES + (idx >> 7)] * 128 + (idx & 127); kptr[tid] = p.cache_k + phys * 256; vptr[tid] = p.cache_v + phys * 256; }
        else { kptr[tid] = p.out + O_KS + (size_t)b * 256; vptr[tid] = p.out + O_VS + (size_t)b * 256; }
    }
    const size_t row = MP + b;
    sattend(p, lds, (const bf16_t*)(ws + W_DQ) + row * 256, (const bf16_t*)(ws + W_DG) + row * 256, (bf16_t*)(ws + W_MIX) + row * 1024 + 512);
}
DI void sgla_unit(const Params& p, LAS3 unsigned char* lds, int b) {
    const int tid = threadIdx.x, lane = tid & 63, w = tid >> 6; unsigned char* ws = p.ws;
    LAS3 float* qs = (LAS3 float*)lds; LAS3 float* ks = qs + 256; LAS3 float* gs = qs + 512; LAS3 float* vs = qs + 768; LAS3 float* part = qs + 1280;
    const size_t row = MP + b;
    if (tid < 256) {
        float u = p.b_g[tid];
        const float* gl = vaddr((const float*)(ws + W_GLR) + row * 16);
#pragma unroll
        for (int r = 0; r < 16; ++r) u += gl[r] * p.w_g2[r * 256 + tid];
        gs[tid] = expf(logsigf(u) * (1.f / 16.f));
        qs[tid] = bf2f(((const bf16_t*)(ws + W_GQ))[row * 256 + tid]); ks[tid] = bf2f(((const bf16_t*)(ws + W_GK))[row * 256 + tid]);
    }
    vs[tid] = bf2f(((const bf16_t*)(ws + W_GV))[row * 512 + tid]);
    __syncthreads();
    const int h = tid >> 7, v = tid & 127;
    const float* sp = p.state_gla + ((size_t)(b * 4 + h) * 64) * 128 + v; float* so = p.out + O_GSS + ((size_t)(b * 4 + h) * 64) * 128 + v;
    const float vv = vs[h * 128 + v];
    float o = 0.f;
#pragma unroll 8
    for (int dd = 0; dd < 64; ++dd) { const float sn = gs[h * 64 + dd] * sp[dd * 128] + ks[h * 64 + dd] * vv; so[dd * 128] = sn; o += qs[h * 64 + dd] * sn; }
    const float ss = wsum64(o * o);
    if (lane == 0) part[w] = ss;
    __syncthreads();
    const float rstd = rsqrtf((part[2 * h] + part[2 * h + 1]) * (1.f / 128.f) + 1e-6f);
    ((bf16_t*)(ws + W_MIX))[row * 1024 + h * 128 + v] = f2bf(o * rstd * p.onorm[v] * bf2f(((const bf16_t*)(ws + W_GG))[row * 512 + h * 128 + v]));
    __syncthreads();
}
DI void p4_final(const Params& p) {
    const int tid = threadIdx.x, lane = tid & 63, wv = tid >> 6;
    for (int r = blockIdx.x * 8 + wv; r < MP + NDB; r += gridDim.x * 8) {
        float* y = p.out + (r < MP ? O_YP + (size_t)r * DM : O_YS + (size_t)(r - MP) * DM);
        f32x4 v[4]; float ss = 0.f;
#pragma unroll
        for (int i = 0; i < 4; ++i) { v[i] = *(const f32x4*)(y + i * 256 + lane * 4); ss += v[i][0] * v[i][0] + v[i][1] * v[i][1] + v[i][2] * v[i][2] + v[i][3] * v[i][3]; }
        ss = wsum64(ss);
        const float rstd = rsqrtf(ss * (1.f / DM) + 1e-6f);
#pragma unroll
        for (int i = 0; i < 4; ++i) { const f32x4 gv = *(const f32x4*)(p.norm_final + i * 256 + lane * 4); *(f32x4*)(y + i * 256 + lane * 4) = v[i] * rstd * gv; }
    }
}

DI int next_unit(unsigned* ctr, volatile LAS3 unsigned* slot) {
    if (threadIdx.x == 0) *slot = __hip_atomic_fetch_add(ctr, 1u, __ATOMIC_RELAXED, __HIP_MEMORY_SCOPE_AGENT);
    __syncthreads();
    const int v = __builtin_amdgcn_readfirstlane((int)*slot);
    __syncthreads();
    return v;
}

#ifndef REP1
#define REP1 1
#endif
#ifndef REP2
#define REP2 1
#endif
#ifndef REP3
#define REP3 1
#endif
#ifndef REP2A
#define REP2A 1
#endif
#ifndef REP2B
#define REP2B 1
#endif
#ifndef REP2C
#define REP2C 1
#endif
#ifndef REP2D
#define REP2D 1
#endif
#ifndef REP2E
#define REP2E 1
#endif
DI void phase1(const Params& p, LAS3 unsigned char* lds) {
    unsigned char* ws = p.ws;
    { pg8::Gemm g{(const bf16_t*)(ws + W_XN), (const bf16_t*)(ws + W_WTIN), MROWS, NIN, DM}; pg8::StaticOrder S; S.init(MROWS, NIN, (int)gridDim.x, (int)blockIdx.x);
      EpiIn E{ws, p.out}; pg8::gemm_phase<EpiIn, pg8::StaticOrder, true, true>(lds, g, S, E); }
    { pg8::Gemm g{(const bf16_t*)(ws + W_MEMN), (const bf16_t*)(ws + W_WTMEM), MMEM, 512, DM}; pg8::StaticOrder S;
      S.init(MMEM, 512, (int)gridDim.x, (int)((blockIdx.x + gridDim.x - (1806u % gridDim.x)) % gridDim.x));
      EpiMem E{ws, p.out}; pg8::gemm_phase<EpiMem, pg8::StaticOrder, true, true>(lds, g, S, E); }
}
template <int QI> DI void p2_sscore(const Params& p, LAS3 unsigned char* lds) { for (int u = blockIdx.x; u < 256; u += gridDim.x) { sscore_unit(p, lds, u); __syncthreads(); } }
template <int QI> DI void p2_gla(const Params& p, LAS3 unsigned char* lds) { for (int u = blockIdx.x; u < 64; u += gridDim.x) gla_unit(p, lds, u >> 2, u & 3); }
DI int next_unit_xcd(unsigned char* qbase, volatile LAS3 unsigned* slot, unsigned x0) {
    if (threadIdx.x == 0) {
        unsigned res = 0xffffffffu;
        for (unsigned k = 0; k < 8u; ++k) {
            const unsigned xq = (x0 + k) & 7u;
            const unsigned mq = __hip_atomic_fetch_add((unsigned*)(qbase + 256 * xq), 1u, __ATOMIC_RELAXED, __HIP_MEMORY_SCOPE_AGENT);
            if (mq < 64u) { res = xq * 64u + mq; break; }
        }
        *slot = res;
    }
    __syncthreads();
    const int v = __builtin_amdgcn_readfirstlane((int)*slot);
    __syncthreads();
    return v;
}
template <int QI> DI void p2_dsa(const Params& p, LAS3 unsigned char* lds, volatile LAS3 unsigned* MISC TARGS) {
#if defined(XCDQ) && XCDQ
    const unsigned x0 = xb_xcc_id() & 7u;
    for (;;) { const int n = next_unit_xcd(p.ws + CW_QDSA + 8192 * QI, MISC + 4, x0); if (n < 0) break; const int m = n & 63; dsa_unit(p, lds, 2 * (n >> 6) + (m >> 5), 31 - (m & 31) TPASS); }
#else
    for (;;) { const int n = next_unit((unsigned*)(p.ws + CW_QDSA + 8192 * QI), MISC + 4); if (n >= 512) break; dsa_unit(p, lds, n & 15, 31 - (n >> 4) TPASS); }
#endif
}
template <int QI> DI void p2_mem(const Params& p, LAS3 unsigned char* lds, volatile LAS3 unsigned* MISC) {
    for (;;) { const int n = next_unit((unsigned*)(p.ws + CW_QMEM + 8192 * QI), MISC + 4); if (n >= 512) break; mem_unit(p, n); } }
template <int QI> DI void p2_sample(const Params& p, LAS3 unsigned char* lds) {
    for (int u = (int)gridDim.x - 1 - (int)blockIdx.x; u < 96; u += gridDim.x) { if (u < 32) sgla_unit(p, lds, u); else if (u < 64) smem_unit(p, lds, u - 32); else ssel_unit(p, lds, u - 64); } }
template <int RI> DI void phase2(const Params& p, LAS3 unsigned char* lds, volatile LAS3 unsigned* MISC TARGS) {
    TBEG(20); TBEG(21); p2_sscore<0>(p, lds); TEND(21); if (REP2A > 1) p2_sscore<1>(p, lds);
    TBEG(25); p2_sample<0>(p, lds); TEND(25); if (REP2E > 1) p2_sample<1>(p, lds);
    TBEG(22); p2_gla<0>(p, lds); TEND(22); if (REP2B > 1) p2_gla<1>(p, lds);
    TBEG(23); p2_dsa<0>(p, lds, MISC TPASS); TEND(23); if (REP2C > 1) p2_dsa<1>(p, lds, MISC TPASS);
    TBEG(24); p2_mem<0>(p, lds, MISC); TEND(24); if (REP2D > 1) p2_mem<1>(p, lds, MISC);
    TEND(20);
}
DI void phase3(const Params& p, LAS3 unsigned char* lds) {
    pg8::Gemm g{(const bf16_t*)(p.ws + W_MIX), (const bf16_t*)(p.ws + W_WTOUT), MP, DM, DM}; pg8::StaticOrder S; S.init(MP, DM, (int)gridDim.x, (int)blockIdx.x);
    EpiOut E{p.x_prompt, p.x_sample, p.out}; pg8::gemm_phase<EpiOut, pg8::StaticOrder, true, true>(lds, g, S, E);
    const int tid = threadIdx.x, lane = tid & 63, wv = tid >> 6;
    for (int u = blockIdx.x; u < 256; u += gridDim.x) {
        const int b = u >> 3, col0 = (u & 7) * 128 + wv * 16;
        const bf16_t* mrow = (const bf16_t*)(p.ws + W_MIX) + (size_t)(MP + b) * 1024 + lane * 16;
        const u32x4 m0 = *(const u32x4*)mrow, m1 = *(const u32x4*)(mrow + 8);
        const unsigned mw[8] = {m0.x, m0.y, m0.z, m0.w, m1.x, m1.y, m1.z, m1.w};
        float res = 0.f;
#pragma unroll 4
        for (int i = 0; i < 16; ++i) {
            const bf16_t* wrow = (const bf16_t*)(p.ws + W_WTOUT) + (size_t)(col0 + i) * 1024 + lane * 16;
            const u32x4 w0 = *(const u32x4*)wrow, w1 = *(const u32x4*)(wrow + 8);
            const unsigned ww[8] = {w0.x, w0.y, w0.z, w0.w, w1.x, w1.y, w1.z, w1.w};
            float acc = 0.f;
#pragma unroll
            for (int e = 0; e < 8; ++e) acc += __uint_as_float(mw[e] << 16) * __uint_as_float(ww[e] << 16) + __uint_as_float(mw[e] & 0xffff0000u) * __uint_as_float(ww[e] & 0xffff0000u);
            acc = wsum64(acc);
            res = (lane == i) ? acc : res;
        }
        if (lane < 16) p.out[O_YS + (size_t)b * DM + col0 + lane] = p.x_sample[(size_t)b * DM + col0 + lane] + res;
    }
}
__global__ void __launch_bounds__(NTHREADS, 2) hymba_fwd(Params p) {
    extern __shared__ __attribute__((aligned(16))) unsigned char lds_raw[];
    LAS3 unsigned char* lds = (LAS3 unsigned char*)lds_raw;
    volatile LAS3 unsigned* MISC = (volatile LAS3 unsigned*)(lds + LDS_MISC);
    const int tid = threadIdx.x;
    if (tid < 64) MISC[tid] = 0u;
    __syncthreads();
    const int lo = p.ph_lo, hi = p.ph_hi;
    TDECL;
    XcdBarrier bar; bar.bar = (unsigned*)p.ws; bar.x = 0; bar.st = MISC;
    if (hi > lo) bar = xcd_barrier_post((unsigned*)p.ws, MISC);
#define IN(k) (lo <= (k) && (k) <= hi)
#define SEAM(k) do { if (IN(k) && IN((k) + 1)) xcd_barrier(bar); } while (0)
    TBEG(0); if (IN(0)) p0_prologue(p, lds); TEND(0);
    TBEG(10); SEAM(0); TEND(10);
    TBEG(1); if (IN(1)) { phase1(p, lds); if (REP1 > 1) { xcd_barrier(bar); phase1(p, lds); } } TEND(1);
    TBEG(11); SEAM(1); TEND(11);
    TBEG(2); if (IN(2)) { phase2<0>(p, lds, MISC TPASS); } TEND(2);
    TBEG(12); SEAM(2); TEND(12);
    TBEG(3); if (IN(3)) { phase3(p, lds); if (REP3 > 1) { xcd_barrier(bar); phase3(p, lds); } } TEND(3);
    TBEG(13); SEAM(3); TEND(13);
    TBEG(4); if (IN(4)) p4_final(p); TEND(4);
#ifdef TSEL
    {
        if (tid == 0) { atomicAdd((unsigned long long*)(p.ws + CW_TSUM), (unsigned long long)tacc_); atomicMax((unsigned long long*)(p.ws + CW_TMAX), (unsigned long long)tacc_); }
        xcd_barrier(bar);
        if (blockIdx.x == 0 && tid == 0) {
#ifdef TMAX
            const unsigned long long dly = __hip_atomic_load((unsigned long long*)(p.ws + CW_TMAX), __ATOMIC_RELAXED, __HIP_MEMORY_SCOPE_AGENT);
#else
            const unsigned long long dly = __hip_atomic_load((unsigned long long*)(p.ws + CW_TSUM), __ATOMIC_RELAXED, __HIP_MEMORY_SCOPE_AGENT) / gridDim.x;
#endif
            const unsigned long long t0 = __builtin_amdgcn_s_memrealtime();
            while (__builtin_amdgcn_s_memrealtime() - t0 < dly && __builtin_amdgcn_s_memrealtime() - t0 < 400000ull) __builtin_amdgcn_s_sleep(8);
        }
    }
#endif
#ifdef CHECK_SEL
    {
        xcd_barrier(bar);
        const unsigned nbad = __hip_atomic_load((unsigned*)(p.ws + CW_CHK), __ATOMIC_RELAXED, __HIP_MEMORY_SCOPE_AGENT);
        const unsigned nhist = __hip_atomic_load((unsigned*)(p.ws + CW_CHK + 4), __ATOMIC_RELAXED, __HIP_MEMORY_SCOPE_AGENT);
        if (nbad != 0u || nhist < CHECK_MIN_HIST) for (int i = blockIdx.x * NTHREADS + tid; i < NDB * DM; i += gridDim.x * NTHREADS) p.out[O_YS + i] = __builtin_nanf("");
    }
#endif
#undef IN
#undef SEAM
}

#ifndef N_LAUNCHES
#define N_LAUNCHES 1
#endif
extern "C" void kernel_launch(void* const* d_in, const int* in_sizes, int n_in, void* d_out, int out_size, void* d_ws, size_t ws_size, hipStream_t stream) {
    static int grid = 0;
    if (grid == 0) {
        if (n_in != 19 || (size_t)out_size != O_END || ws_size < W_END) fprintf(stderr, "kernel_launch: unexpected sizes: n_in %d out %d ws %zu (need %zu)\n", n_in, out_size, ws_size, (size_t)W_END);
        int dev = 0, cus = 0, per_cu = 0;
        if (hipGetDevice(&dev) != hipSuccess || hipDeviceGetAttribute(&cus, hipDeviceAttributeMultiprocessorCount, dev) != hipSuccess) { fprintf(stderr, "kernel_launch: device query failed\n"); grid = -1; return; }
        if (hipFuncSetAttribute((const void*)hymba_fwd, hipFuncAttributeMaxDynamicSharedMemorySize, LDS_BYTES) != hipSuccess) { fprintf(stderr, "kernel_launch: hipFuncSetAttribute failed\n"); grid = -1; return; }
        if (hipOccupancyMaxActiveBlocksPerMultiprocessor(&per_cu, (const void*)hymba_fwd, NTHREADS, LDS_BYTES) != hipSuccess || per_cu < 1) fprintf(stderr, "kernel_launch: occupancy query reports %d blocks per CU\n", per_cu);
        (void)hipGetLastError();
        grid = cus;
    }
    if (grid < 0) return;
    (void)hipMemsetAsync(d_ws, 0, CTRL_BYTES, stream);
    Params p{};
    p.x_prompt = (const float*)d_in[0]; p.x_sample = (const float*)d_in[1]; p.mem_prompt = (const float*)d_in[2]; p.state_gla = (const float*)d_in[3];
    p.cache_k = (const float*)d_in[4]; p.cache_v = (const float*)d_in[5]; p.cache_ik = (const float*)d_in[6]; p.cache_mem_k = (const float*)d_in[7]; p.cache_mem_v = (const float*)d_in[8];
    p.page_table = (const int*)d_in[9];
    p.norm_in = (const float*)d_in[10]; p.w_in = (const float*)d_in[11]; p.w_g2 = (const float*)d_in[12]; p.b_g = (const float*)d_in[13]; p.onorm = (const float*)d_in[14];
    p.mem_norm = (const float*)d_in[15]; p.w_mem_kv = (const float*)d_in[16]; p.w_out = (const float*)d_in[17]; p.norm_final = (const float*)d_in[18];
    p.out = (float*)d_out; p.ws = (unsigned char*)d_ws;
#if N_LAUNCHES == 1
    p.ph_lo = 0; p.ph_hi = 4;
    hipLaunchKernelGGL(hymba_fwd, dim3(grid), dim3(NTHREADS), LDS_BYTES, stream, p);
#else
    for (int ph = 0; ph < 5; ++ph) { p.ph_lo = ph; p.ph_hi = ph; hipLaunchKernelGGL(hymba_fwd, dim3(grid), dim3(NTHREADS), LDS_BYTES, stream, p); }
#endif
    const hipError_t le = hipPeekAtLastError();
    if (le != hipSuccess) fprintf(stderr, "kernel_launch: launch failed: %s\n", hipGetErrorName(le));
}
```

```cpp
#include <hip/hip_runtime.h>
#include <cstdint>
#include <cstdio>
namespace pg8 {
#define PG8_LAS __attribute__((address_space(3)))
typedef unsigned short bf16_t;
typedef short bf16x8 __attribute__((ext_vector_type(8)));
typedef float f32x4 __attribute__((ext_vector_type(4)));
typedef unsigned u32x4 __attribute__((ext_vector_type(4)));
constexpr int BM = 256, BK = 64, HALF = 128, HTB = HALF * BK * 2  , STAGE_BYTES = 8 * HTB, NXCD = 8, WGM = 8;

__host__ __device__ __forceinline__ int lds_byte(int r, int c) { const int st = (r >> 4) * 2 + (c >> 5), rr = r & 15, cc = c & 31, ob = rr * 64 + cc * 2; return st * 1024 + (ob ^ (((ob >> 9) & 1) << 5)); }
__host__ __device__ __forceinline__ void stage_rc(int b, int& R, int& C) { const int st = b / 1024, sb = b % 1024, swz = sb ^ (((sb >> 9) & 1) << 5); R = (st >> 1) * 16 + swz / 64; C = (st & 1) * 32 + (swz % 64) / 2; }
__host__ __device__ __forceinline__ int perm32(int rho) { const int n = rho >> 4, i = rho & 15; return 8 * (i >> 2) + 4 * n + (i & 3); }

struct Unit { int pm, pn; };
struct Gemm { const bf16_t* A; const bf16_t* Bt; int M, N, K; };

struct StaticOrder {
    int nM, nN, nwg, G, c;
    __host__ __device__ void init(int M, int N, int G_, int c_) { nM = M / BM; nN = N / BM; nwg = nM * nN; G = G_; c = c_; }
    __host__ __device__ bool next(int i, Unit& u) const {
        const long L = (long)i * G + c; if (L >= nwg) return false;
        int wgid = (int)L; { const int q = nwg / NXCD, r = nwg % NXCD, xcd = wgid % NXCD, off = wgid / NXCD; wgid = (xcd < r ? xcd * (q + 1) : r * (q + 1) + (xcd - r) * q) + off; }
        const int nig = WGM * nN, gid = wgid / nig, fm = gid * WGM, gsz = (nM - fm) < WGM ? (nM - fm) : WGM;
        u.pm = fm + ((wgid % nig) % gsz); u.pn = (wgid % nig) / gsz; return true;
    }
    __device__ __forceinline__ void a_ready(const Unit&) const {}
    __device__ __forceinline__ void done(const Unit&) const {}
};

template <class Epi, class Sched, bool ALIGN_EPI = false, bool SP2 = false>
__device__ __forceinline__ void gemm_phase(PG8_LAS unsigned char* lds, const Gemm g, const Sched& S, const Epi& E) {
    const int tid = threadIdx.x, wid = __builtin_amdgcn_readfirstlane(tid >> 6), lane = tid & 63, wr = wid >> 2, wc = wid & 3, fr = lane & 15, fq = lane >> 4;
    const int K = g.K, nt = K / BK;
    unsigned voffA[2], voffB[2];
#pragma unroll
    for (int i = 0; i < 2; ++i) { int R, C; stage_rc(tid * 16 + i * 8192, R, C); const int Rb = Epi::PERM ? ((R & ~31) + perm32(R & 31)) : R;
        voffA[i] = (unsigned)(R * K + C) * 2u; voffB[i] = (unsigned)(Rb * K + C) * 2u; }
    const size_t kstep = (size_t)(BK * 2);
    const size_t hstep = (size_t)HALF * K * 2;
    const size_t tstep = 2 * hstep;
    const unsigned ldsw = (unsigned)wid * 1024u;
    const int aoff = lds_byte(wr * 64 + fr, fq * 8), boff = lds_byte(wc * 32 + fr, fq * 8);
#define PG8_SA(b, h) (((b) * 2 + (h)) * HTB)
#define PG8_SB(b, h) ((4 + (b) * 2 + (h)) * HTB)
#define PG8_STAGE(bufoff, gbase, voff) do { _Pragma("unroll") for (int _i = 0; _i < 2; ++_i) \
        __builtin_amdgcn_global_load_lds((const unsigned*)((const char*)(gbase) + (voff)[_i]), (PG8_LAS unsigned*)(lds + (bufoff) + ldsw + _i * 8192), 16, 0, 0); } while (0)
#define PG8_LDA(dst, b, h) do { _Pragma("unroll") for (int m = 0; m < 4; ++m) _Pragma("unroll") for (int k = 0; k < 2; ++k) dst[m][k] = *(const PG8_LAS bf16x8*)(lds + PG8_SA(b, h) + aoff + m * 2048 + k * 1024); } while (0)
#define PG8_LDB(dst, b, h) do { _Pragma("unroll") for (int n = 0; n < 2; ++n) _Pragma("unroll") for (int k = 0; k < 2; ++k) dst[n][k] = *(const PG8_LAS bf16x8*)(lds + PG8_SB(b, h) + boff + n * 2048 + k * 1024); } while (0)
#define PG8_MMA(ai, bj, At, Bt) do { __builtin_amdgcn_s_setprio(1); _Pragma("unroll") for (int m = 0; m < 4; ++m) _Pragma("unroll") for (int n = 0; n < 2; ++n) _Pragma("unroll") for (int k = 0; k < 2; ++k) \
        acc[ai][bj][m][n] = __builtin_amdgcn_mfma_f32_16x16x32_bf16(Bt[n][k], At[m][k], acc[ai][bj][m][n], 0, 0, 0); __builtin_amdgcn_s_setprio(0); } while (0)
#define PG8_WAIT_V(n) asm volatile("s_waitcnt vmcnt(" #n ")" ::: "memory")
#define PG8_WAIT_L(n) asm volatile("s_waitcnt lgkmcnt(" #n ")" ::: "memory")
#define PG8_BAR __builtin_amdgcn_s_barrier()
#define PG8_SCHED __builtin_amdgcn_sched_barrier(0)
    Unit cur, nxt; int ui = 0;
    if (!S.next(0, cur)) return;
    f32x4 acc[2][2][4][2];
#pragma unroll
    for (int a = 0; a < 2; ++a)
#pragma unroll
        for (int b = 0; b < 2; ++b)
#pragma unroll
            for (int m = 0; m < 4; ++m)
#pragma unroll
                for (int n = 0; n < 2; ++n) acc[a][b][m][n] = (f32x4){0.f, 0.f, 0.f, 0.f};
    bf16x8 At[4][2], B0[2][2], B1[2][2];
    const char* cA = (const char*)g.A + (size_t)cur.pm * tstep; const char* cB = (const char*)g.Bt + (size_t)cur.pn * tstep;
    S.a_ready(cur);
    if constexpr (SP2) {
        PG8_STAGE(PG8_SB(0, 0), cB, voffB); PG8_STAGE(PG8_SB(0, 1), cB + hstep, voffB); PG8_STAGE(PG8_SA(0, 0), cA, voffA); PG8_STAGE(PG8_SA(0, 1), cA + hstep, voffA);
        if (wr == 1) PG8_BAR;
        PG8_WAIT_V(2); PG8_BAR;
        PG8_STAGE(PG8_SB(1, 0), cB + kstep, voffB); PG8_STAGE(PG8_SA(1, 0), cA + kstep, voffA); PG8_STAGE(PG8_SB(1, 1), cB + hstep + kstep, voffB);
        PG8_WAIT_V(6); PG8_BAR;
    } else {
        PG8_STAGE(PG8_SB(0, 0), cB, voffB); PG8_STAGE(PG8_SA(0, 0), cA, voffA); PG8_STAGE(PG8_SB(0, 1), cB + hstep, voffB); PG8_STAGE(PG8_SA(0, 1), cA + hstep, voffA);
        if (wr == 1) PG8_BAR;
        PG8_WAIT_V(4); PG8_BAR;
        PG8_STAGE(PG8_SB(1, 0), cB + kstep, voffB); PG8_STAGE(PG8_SA(1, 0), cA + kstep, voffA); PG8_STAGE(PG8_SB(1, 1), cB + hstep + kstep, voffB);
        PG8_WAIT_V(6); PG8_BAR;
    }
    for (;;) {
        const bool has_next = S.next(ui + 1, nxt);
        const char* nA = has_next ? (const char*)g.A + (size_t)nxt.pm * tstep : cA; const char* nB = has_next ? (const char*)g.Bt + (size_t)nxt.pn * tstep : cB;
        for (int t = 0; t < nt; t += 2) {
            const bool last = (t == nt - 2);
            const char* a1 = cA + (size_t)(t + 1) * kstep;
            const char* a2 = last ? nA : cA + (size_t)(t + 2) * kstep; const char* b2 = last ? nB : cB + (size_t)(t + 2) * kstep;
            const char* a3 = a2 + kstep; const char* b3 = b2 + kstep;
            if (last && has_next) S.a_ready(nxt);
            if constexpr (SP2) {
            PG8_LDB(B0, 0, 0); PG8_LDB(B1, 0, 1); PG8_SCHED; PG8_LDA(At, 0, 0); PG8_STAGE(PG8_SA(1, 1), a1 + hstep, voffA);
            PG8_WAIT_V(8); PG8_WAIT_L(0); PG8_BAR; PG8_MMA(0, 0, At, B0); PG8_MMA(0, 1, At, B1); PG8_BAR; PG8_SCHED;
            PG8_LDA(At, 0, 1); PG8_STAGE(PG8_SB(0, 0), b2, voffB); PG8_STAGE(PG8_SB(0, 1), b2 + hstep, voffB); PG8_STAGE(PG8_SA(0, 0), a2, voffA);
            PG8_WAIT_V(8); PG8_WAIT_L(0); PG8_BAR; PG8_MMA(1, 0, At, B0); PG8_MMA(1, 1, At, B1); PG8_BAR; PG8_SCHED;
            PG8_LDB(B0, 1, 0); PG8_LDB(B1, 1, 1); PG8_SCHED; PG8_LDA(At, 1, 0); PG8_STAGE(PG8_SA(0, 1), a2 + hstep, voffA);
            PG8_WAIT_V(8); PG8_WAIT_L(0); PG8_BAR; PG8_MMA(0, 0, At, B0); PG8_MMA(0, 1, At, B1); PG8_BAR; PG8_SCHED;
            PG8_LDA(At, 1, 1); PG8_STAGE(PG8_SB(1, 0), b3, voffB); PG8_STAGE(PG8_SB(1, 1), b3 + hstep, voffB); PG8_STAGE(PG8_SA(1, 0), a3, voffA);
            PG8_WAIT_V(8); PG8_WAIT_L(0); PG8_BAR; PG8_MMA(1, 0, At, B0); PG8_MMA(1, 1, At, B1); PG8_BAR; PG8_SCHED;
            } else {
            PG8_LDB(B0, 0, 0); PG8_SCHED; PG8_LDA(At, 0, 0); PG8_STAGE(PG8_SA(1, 1), a1 + hstep, voffA);
            PG8_WAIT_L(8); PG8_BAR; PG8_WAIT_L(0); PG8_MMA(0, 0, At, B0); PG8_BAR; PG8_SCHED;
            PG8_LDB(B1, 0, 1); PG8_STAGE(PG8_SB(0, 0), b2, voffB);
            PG8_BAR; PG8_WAIT_L(0); PG8_MMA(0, 1, At, B1); PG8_BAR;
            PG8_LDA(At, 0, 1); PG8_STAGE(PG8_SA(0, 0), a2, voffA);
            PG8_BAR; PG8_WAIT_L(0); PG8_MMA(1, 0, At, B0); PG8_BAR; PG8_SCHED;
            PG8_STAGE(PG8_SB(0, 1), b2 + hstep, voffB);
            PG8_WAIT_V(6); PG8_BAR; PG8_MMA(1, 1, At, B1); PG8_BAR;
            PG8_LDB(B0, 1, 0); PG8_SCHED; PG8_LDA(At, 1, 0); PG8_STAGE(PG8_SA(0, 1), a2 + hstep, voffA);
            PG8_WAIT_L(8); PG8_BAR; PG8_WAIT_L(0); PG8_MMA(0, 0, At, B0); PG8_BAR; PG8_SCHED;
            PG8_LDB(B1, 1, 1); PG8_STAGE(PG8_SB(1, 0), b3, voffB);
            PG8_BAR; PG8_WAIT_L(0); PG8_MMA(0, 1, At, B1); PG8_BAR;
            PG8_LDA(At, 1, 1); PG8_STAGE(PG8_SA(1, 0), a3, voffA);
            PG8_BAR; PG8_WAIT_L(0); PG8_MMA(1, 0, At, B0); PG8_BAR; PG8_SCHED;
            PG8_STAGE(PG8_SB(1, 1), b3 + hstep, voffB);
            PG8_WAIT_V(6); PG8_BAR; PG8_MMA(1, 1, At, B1); PG8_BAR;
            }
        }
        if constexpr (ALIGN_EPI) { if (wr == 0) PG8_BAR; }
        if constexpr (!Epi::AFTER_DRAIN) { E(acc, cur, wr, wc, fr, fq); S.done(cur); }
        if (!has_next) break;
#pragma unroll
        for (int a = 0; a < 2; ++a)
#pragma unroll
            for (int b = 0; b < 2; ++b)
#pragma unroll
                for (int m = 0; m < 4; ++m)
#pragma unroll
                    for (int n = 0; n < 2; ++n) acc[a][b][m][n] = (f32x4){0.f, 0.f, 0.f, 0.f};
        cur = nxt; cA = nA; cB = nB; ++ui;
        if constexpr (ALIGN_EPI) { if (wr == 1) PG8_BAR; }
    }
    PG8_WAIT_V(0);
    if constexpr (!ALIGN_EPI) { if (wr == 0) PG8_BAR; }
    PG8_BAR;
    if constexpr (Epi::AFTER_DRAIN) { E.fused(acc, cur, wr, wc, fr, fq, lds, wid, lane); S.done(cur); }
#undef PG8_SA
#undef PG8_SB
#undef PG8_STAGE
#undef PG8_LDA
#undef PG8_LDB
#undef PG8_MMA
#undef PG8_WAIT_V
#undef PG8_WAIT_L
#undef PG8_BAR
#undef PG8_SCHED
}
}
#define XB_TMO      128
#define XB_XCNT(j)  (256  + 64 * (j))
#define XB_XSUB(j)  (1280 + 64 * (j))
#define XB_XGEN(j)  (2304 + 64 * (j))
#define XB_TOP      3328
#define XB_TOPGEN   3392
#define XCD_BAR_WORDS 3456
#define XB_SPIN_CAP (1u << 18)
#define LAS __attribute__((address_space(3)))

__device__ __forceinline__ unsigned xb_ld(unsigned* p)              { return __hip_atomic_load(p, __ATOMIC_RELAXED, __HIP_MEMORY_SCOPE_AGENT); }
__device__ __forceinline__ unsigned xb_add(unsigned* p, unsigned v) { return __hip_atomic_fetch_add(p, v, __ATOMIC_RELAXED, __HIP_MEMORY_SCOPE_AGENT); }
__device__ __forceinline__ unsigned xb_xcc_id() { return (unsigned)__builtin_amdgcn_s_getreg((3 << 11) | 20) & 0xFu; }
#define XB_SPIN(cond, bar) do { unsigned _sp = 0; while (cond) { __builtin_amdgcn_s_sleep(1); \
    if ((++_sp & 255u) == 0u) { if (xb_ld(&(bar)[XB_TMO])) break; if (_sp > XB_SPIN_CAP) { atomicAdd(&(bar)[XB_TMO], 1u); break; } } } } while (0)

struct XcdBarrier {
    unsigned* bar; unsigned x;
    volatile LAS unsigned* st;
};

__device__ __forceinline__ XcdBarrier xcd_barrier_post(unsigned* bar, volatile LAS unsigned* st) {
    XcdBarrier b; b.bar = bar; b.x = xb_xcc_id(); b.st = st;
    if (threadIdx.x == 0) (void)xb_add(&bar[XB_XCNT(b.x)], 1u);
    return b;
}
__device__ __forceinline__ void xcd_barrier_complete(unsigned* bar, unsigned x, unsigned& nloc, unsigned& nx) {
    const unsigned G = gridDim.x * gridDim.y * gridDim.z;
    unsigned sum, cnt, mine, sp = 0u;
    for (;;) {
        sum = 0u; cnt = 0u; mine = 0u;
#pragma unroll
        for (unsigned j = 0; j < 16; ++j) { const unsigned c = xb_ld(&bar[XB_XCNT(j)]); sum += c; cnt += (c > 0u) ? 1u : 0u; mine = (j == x) ? c : mine; }
        if (sum == G) break;
        __builtin_amdgcn_s_sleep(1);
        if ((++sp & 255u) == 0u) { if (xb_ld(&bar[XB_TMO])) break; if (sp > XB_SPIN_CAP) { atomicAdd(&bar[XB_TMO], 1u); break; } }
    }
    nloc = mine > 0u ? mine : 1u; nx = cnt > 0u ? cnt : 1u;
}

__device__ __forceinline__ void xcd_barrier(const XcdBarrier& b) {
    asm volatile("s_waitcnt vmcnt(0)" ::: "memory");
    __syncthreads();
    if (threadIdx.x == 0) {
        unsigned* bar = b.bar;
        __builtin_amdgcn_s_waitcnt(0);
        unsigned nloc = b.st[0], nx = b.st[1];
        if (nloc == 0u) { xcd_barrier_complete(bar, b.x, nloc, nx); b.st[0] = nloc; b.st[1] = nx; }
        const unsigned old = xb_add(&bar[XB_XSUB(b.x)], 1u);
        const unsigned gen = old / nloc;
        if (old + 1u == (gen + 1u) * nloc) {
            __builtin_amdgcn_fence(__ATOMIC_RELEASE, "agent");
            asm volatile("s_waitcnt vmcnt(0)" ::: "memory");
            const unsigned og = xb_add(&bar[XB_TOP], 1u);
            const unsigned tg = og / nx;
            if (og + 1u == (tg + 1u) * nx) xb_add(&bar[XB_TOPGEN], 1u);
            else XB_SPIN(xb_ld(&bar[XB_TOPGEN]) == tg, bar);
            __builtin_amdgcn_fence(__ATOMIC_ACQUIRE, "agent");
            xb_add(&bar[XB_XGEN(b.x)], 1u);
            asm volatile("s_waitcnt vmcnt(0)" ::: "memory");
        } else {
            XB_SPIN(xb_ld(&bar[XB_XGEN(b.x)]) == gen, bar);
            __builtin_amdgcn_fence(__ATOMIC_ACQUIRE, "agent");
            asm volatile("s_waitcnt vmcnt(0)" ::: "memory");
        }
    }
    __syncthreads();
}
#define DI __device__ __forceinline__
#define LAS3 __attribute__((address_space(3)))
using pg8::bf16_t; using pg8::bf16x8; using pg8::f32x4; using pg8::u32x4;
typedef unsigned u32x2 __attribute__((ext_vector_type(2)));
typedef short s16x4 __attribute__((ext_vector_type(4)));
typedef float f32x2 __attribute__((ext_vector_type(2)));
typedef __bf16 bf16x2_t __attribute__((ext_vector_type(2)));

constexpr int DM = 1024, NB = 16, SEQ = 2048, MP = NB * SEQ  , NDB = 32  , MROWS = 33024  ;
constexpr int NMEM = 256, MMEM = NB * NMEM  , DIN = 3412, NIN = 3584, NPAGES = 128;
constexpr int NTHREADS = 512;
constexpr size_t O_YP = 0, O_YS = O_YP + (size_t)MP * DM, O_GSP = O_YS + (size_t)NDB * DM, O_KP = O_GSP + (size_t)NB * 4 * 64 * 128,
                 O_VP = O_KP + (size_t)MP * 256, O_IKP = O_VP + (size_t)MP * 256, O_MKP = O_IKP + (size_t)MP * 64, O_MVP = O_MKP + (size_t)MMEM * 256,
                 O_GSS = O_MVP + (size_t)MMEM * 256, O_KS = O_GSS + (size_t)NDB * 4 * 64 * 128, O_VS = O_KS + (size_t)NDB * 256, O_IKS = O_VS + (size_t)NDB * 256,
                 O_END = O_IKS + (size_t)NDB * 64;
static_assert(O_END == 56150016, "output size");
constexpr size_t al256(size_t x) { return (x + 255) & ~(size_t)255; }
constexpr size_t CTRL_BYTES = 32768;
constexpr size_t CW_QDSA = 16384  , CW_QMEM = 18432  , CW_SCNT = 20480, CW_TMO = 20736, CW_CHK = 20992, CW_TSUM = 21248, CW_TMAX = 21504;
constexpr int SCLD = 16400;
constexpr size_t W_ROPE = CTRL_BYTES;
constexpr size_t W_XN = al256(W_ROPE + (size_t)2049 * 32 * 8);
constexpr size_t W_MEMN = W_XN + (size_t)MROWS * 1024 * 2;
constexpr size_t W_WTIN = W_MEMN + (size_t)MMEM * 1024 * 2;
constexpr size_t W_WTMEM = W_WTIN + (size_t)NIN * 1024 * 2;
constexpr size_t W_WTOUT = W_WTMEM + (size_t)512 * 1024 * 2;
constexpr size_t W_GQ = W_WTOUT + (size_t)1024 * 1024 * 2;
constexpr size_t W_GK = W_GQ + (size_t)MROWS * 256 * 2;
constexpr size_t W_GV = W_GK + (size_t)MROWS * 256 * 2;
constexpr size_t W_GG = W_GV + (size_t)MROWS * 512 * 2;
constexpr size_t W_DQ = W_GG + (size_t)MROWS * 512 * 2;
constexpr size_t W_DK = W_DQ + (size_t)MROWS * 256 * 2;
constexpr size_t W_DVT = W_DK + (size_t)MROWS * 256 * 2;
constexpr size_t W_IQ = W_DVT + (size_t)MP * 256 * 2;
constexpr size_t W_DG = W_IQ + (size_t)MROWS * 256 * 2;
constexpr size_t W_MQ = W_DG + (size_t)MROWS * 256 * 2;
constexpr size_t W_MG = W_MQ + (size_t)MROWS * 256 * 2;
constexpr size_t W_IK = W_MG + (size_t)MROWS * 256 * 2;
constexpr size_t W_IW = W_IK + (size_t)MROWS * 64 * 2;
constexpr size_t W_GLR = W_IW + (size_t)MROWS * 4 * 4;
constexpr size_t W_MK = W_GLR + (size_t)MROWS * 16 * 4;
constexpr size_t W_MVT = W_MK + (size_t)MMEM * 256 * 2;
constexpr size_t W_MIX = W_MVT + (size_t)MMEM * 256 * 2;
constexpr size_t W_SC = W_MIX + (size_t)MROWS * 1024 * 2;
constexpr size_t W_END = W_SC + (size_t)NDB * SCLD * 4;
constexpr int LDS_MISC = 148480, LDS_BYTES = 148480 + 256;

struct Params {
    const float *x_prompt, *x_sample, *mem_prompt, *state_gla, *cache_k, *cache_v, *cache_ik, *cache_mem_k, *cache_mem_v;
    const int* page_table;
    const float *norm_in, *w_in, *w_g2, *b_g, *onorm, *mem_norm, *w_mem_kv, *w_out, *norm_final;
    float* out; unsigned char* ws; int ph_lo, ph_hi;
};

#ifdef TSEL
#define TDECL unsigned tacc_ = 0u, tbeg_ = 0u
#define TBEG(k) do { if ((k) == TSEL) tbeg_ = (unsigned)__builtin_amdgcn_s_memrealtime(); } while (0)
#define TEND(k) do { if ((k) == TSEL) tacc_ += (unsigned)__builtin_amdgcn_s_memrealtime() - tbeg_; } while (0)
#define TARGS , unsigned& tacc_, unsigned& tbeg_
#define TPASS , tacc_, tbeg_
#else
#define TARGS
#define TPASS
#define TDECL do {} while (0)
#define TBEG(k) do {} while (0)
#define TEND(k) do {} while (0)
#endif
DI float bf2f(bf16_t v) { return __uint_as_float((unsigned)v << 16); }
DI unsigned cvtpk(float lo, float hi) { f32x2 v = {lo, hi}; bf16x2_t b = __builtin_convertvector(v, bf16x2_t); return __builtin_bit_cast(unsigned, b); }
DI bf16_t f2bf(float x) { return (bf16_t)(cvtpk(x, 0.f) & 0xffffu); }
DI f32x4 mfma16(bf16x8 a, bf16x8 b, f32x4 c) { return __builtin_amdgcn_mfma_f32_16x16x32_bf16(a, b, c, 0, 0, 0); }
DI float siluf(float x) { return x / (1.f + __expf(-x)); }
DI float logsigf(float u) { return fminf(u, 0.f) - log1pf(expf(-fabsf(u))); }
DI unsigned fkey(float x) { unsigned u = __float_as_uint(x); u = (u == 0x80000000u) ? 0u : u; return u ^ ((unsigned)((int)u >> 31) | 0x80000000u); }
DI float wsum64(float v) { v += __shfl_xor(v, 1); v += __shfl_xor(v, 2); v += __shfl_xor(v, 4); v += __shfl_xor(v, 8); v += __shfl_xor(v, 16); v += __shfl_xor(v, 32); return v; }
DI float wmax64(float v) { v = fmaxf(v, __shfl_xor(v, 1)); v = fmaxf(v, __shfl_xor(v, 2)); v = fmaxf(v, __shfl_xor(v, 4)); v = fmaxf(v, __shfl_xor(v, 8)); v = fmaxf(v, __shfl_xor(v, 16)); v = fmaxf(v, __shfl_xor(v, 32)); return v; }
DI unsigned lds_add(LAS3 unsigned* p, unsigned v) { return __hip_atomic_fetch_add(p, v, __ATOMIC_RELAXED, __HIP_MEMORY_SCOPE_WORKGROUP); }
DI unsigned lds_or(LAS3 unsigned* p, unsigned v) { return __hip_atomic_fetch_or(p, v, __ATOMIC_RELAXED, __HIP_MEMORY_SCOPE_WORKGROUP); }
DI void st_bf16x4(bf16_t* p, f32x4 v) { u32x2 w; w.x = cvtpk(v[0], v[1]); w.y = cvtpk(v[2], v[3]); *(u32x2*)p = w; }
DI const float* vaddr(const float* q) { asm volatile("" : "+v"(q)); return q; }
constexpr float LOG2E = 1.4426950408889634f;
#define NEG_INF (-__builtin_inff())

DI int rope_perm(int vc) { return 64 * (vc >> 6) + 16 * ((vc >> 5) & 1) + (vc & 15) + 32 * ((vc >> 4) & 1); }
DI int in_src(int np) {
    const int pn = np >> 8, vc = np & 255;
    switch (pn) {
        case 0: return vc;
        case 1: return 256 + vc;
        case 2: case 3: return 512 + 256 * (pn - 2) + vc;
        case 4: case 5: return 1040 + 256 * (pn - 4) + vc;
        case 6: return 1552 + rope_perm(vc);
        case 7: return 1808 + rope_perm(vc);
        case 8: return 2064 + vc;
        case 9: return 2320 + rope_perm(vc);
        case 10: return 2644 + vc;
        case 11: return 2900 + vc;
        case 12: return 3156 + vc;
        default: break;
    }
    if (vc < 64) return 2576 + rope_perm(vc);
    if (vc < 68) return 2640 + (vc - 64);
    if (vc < 84) return 1024 + (vc - 68);
    return -1;
}

struct EpiIn {
    static constexpr bool PERM = false, AFTER_DRAIN = false;
    unsigned char* ws; float* out;
    DI void operator()(const f32x4 (&acc)[2][2][4][2], const pg8::Unit& u, int wr, int wc, int fr, int fq) const {
        const int pn = u.pn, rbase = u.pm * 256 + wr * 64 + fr;
        if (pn <= 5 || (pn >= 10 && pn <= 12)) {
            bf16_t* dst; int ldc = 256, coff = 0; float sc = 1.f; bool silu = false;
            switch (pn) {
                case 0: dst = (bf16_t*)(ws + W_GQ); sc = 0.125f; break;
                case 1: dst = (bf16_t*)(ws + W_GK); break;
                case 2: dst = (bf16_t*)(ws + W_GV); ldc = 512; break;
                case 3: dst = (bf16_t*)(ws + W_GV); ldc = 512; coff = 256; break;
                case 4: dst = (bf16_t*)(ws + W_GG); ldc = 512; silu = true; break;
                case 5: dst = (bf16_t*)(ws + W_GG); ldc = 512; coff = 256; silu = true; break;
                case 10: dst = (bf16_t*)(ws + W_DG); silu = true; break;
                case 11: dst = (bf16_t*)(ws + W_MQ); sc = 0.125f; break;
                default: dst = (bf16_t*)(ws + W_MG); silu = true; break;
            }
#pragma unroll
            for (int ai = 0; ai < 2; ++ai)
#pragma unroll
                for (int m = 0; m < 4; ++m) {
                    const int row = rbase + ai * 128 + m * 16;
                    bf16_t* rp = dst + (size_t)row * ldc + coff + wc * 32 + 4 * fq;
#pragma unroll
                    for (int bj = 0; bj < 2; ++bj)
#pragma unroll
                        for (int n = 0; n < 2; ++n) {
                            f32x4 v = acc[ai][bj][m][n];
                            if (silu) { v[0] = siluf(v[0]); v[1] = siluf(v[1]); v[2] = siluf(v[2]); v[3] = siluf(v[3]); } else v = v * sc;
                            st_bf16x4(rp + bj * 128 + n * 16, v);
                        }
                }
        } else if (pn == 6 || pn == 7 || pn == 9) {
            bf16_t* dst = (bf16_t*)(ws + (pn == 6 ? W_DQ : (pn == 7 ? W_DK : W_IQ)));
            const float sc = (pn == 6) ? 0.125f : 1.f;
            const float* rope = (const float*)(ws + W_ROPE);
#pragma unroll
            for (int ai = 0; ai < 2; ++ai)
#pragma unroll
                for (int m = 0; m < 4; ++m) {
                    const int row = rbase + ai * 128 + m * 16;
                    const int pi = row < MP ? (row & 2047) : 2048;
                    const int f0 = 16 * (wc & 1) + 4 * fq;
                    const f32x4 cs0 = *(const f32x4*)(rope + ((size_t)pi * 32 + f0) * 2), cs1 = *(const f32x4*)(rope + ((size_t)pi * 32 + f0) * 2 + 4);
                    const f32x4 c = {cs0[0], cs0[2], cs1[0], cs1[2]}, s = {cs0[1], cs0[3], cs1[1], cs1[3]};
#pragma unroll
                    for (int bj = 0; bj < 2; ++bj) {
                        const f32x4 v0 = acc[ai][bj][m][0], v1 = acc[ai][bj][m][1];
                        const f32x4 o1 = (v0 * c - v1 * s) * sc, o2 = (v1 * c + v0 * s) * sc;
                        const int col1 = 64 * (2 * bj + (wc >> 1)) + f0, col2 = col1 + 32;
                        st_bf16x4(dst + (size_t)row * 256 + col1, o1); st_bf16x4(dst + (size_t)row * 256 + col2, o2);
                        if (pn == 7) {
                            float* op = nullptr;
                            if (row < MP) op = out + O_KP + (size_t)row * 256; else if (row < MP + NDB) op = out + O_KS + (size_t)(row - MP) * 256;
                            if (op) { *(f32x4*)(op + col1) = o1; *(f32x4*)(op + col2) = o2; }
                        }
                    }
                }
        } else if (pn == 8) {
            bf16_t* dvt = (bf16_t*)(ws + W_DVT);
#pragma unroll
            for (int ai = 0; ai < 2; ++ai)
#pragma unroll
                for (int m = 0; m < 4; ++m) {
                    const int row = rbase + ai * 128 + m * 16;
                    float* op = nullptr;
                    if (row < MP) op = out + O_VP + (size_t)row * 256; else if (row < MP + NDB) op = out + O_VS + (size_t)(row - MP) * 256;
#pragma unroll
                    for (int bj = 0; bj < 2; ++bj)
#pragma unroll
                        for (int n = 0; n < 2; ++n) {
                            const f32x4 v = acc[ai][bj][m][n];
                            const int col = 128 * bj + 32 * wc + 16 * n + 4 * fq;
                            if (op) *(f32x4*)(op + col) = v;
                            if (row < MP) {
                                const int t_ = row & 2047, kk_ = t_ & 31;
                                bf16_t* tp = dvt + ((((size_t)(row >> 11) * 64 + (t_ >> 5)) * 4 + (col >> 6)) * 64 + (col & 63)) * 32 + 8 * ((kk_ >> 2) & 3) + 4 * (kk_ >> 4) + (kk_ & 3);
                                tp[0] = f2bf(v[0]); tp[32] = f2bf(v[1]); tp[64] = f2bf(v[2]); tp[96] = f2bf(v[3]);
                            }
                        }
                }
        } else {
            bf16_t* ikb = (bf16_t*)(ws + W_IK); float* iw = (float*)(ws + W_IW); float* glr = (float*)(ws + W_GLR);
            const float* rope = (const float*)(ws + W_ROPE);
#pragma unroll
            for (int ai = 0; ai < 2; ++ai)
#pragma unroll
                for (int m = 0; m < 4; ++m) {
                    const int row = rbase + ai * 128 + m * 16;
                    const f32x4 v0 = acc[ai][0][m][0], v1 = acc[ai][0][m][1];
                    if (wc < 2) {
                        const int pi = row < MP ? (row & 2047) : 2048;
                        const int f0 = 16 * wc + 4 * fq;
                        const f32x4 cs0 = *(const f32x4*)(rope + ((size_t)pi * 32 + f0) * 2), cs1 = *(const f32x4*)(rope + ((size_t)pi * 32 + f0) * 2 + 4);
                        const f32x4 c = {cs0[0], cs0[2], cs1[0], cs1[2]}, s = {cs0[1], cs0[3], cs1[1], cs1[3]};
                        const f32x4 o1 = v0 * c - v1 * s, o2 = v1 * c + v0 * s;
                        st_bf16x4(ikb + (size_t)row * 64 + f0, o1); st_bf16x4(ikb + (size_t)row * 64 + f0 + 32, o2);
                        float* op = nullptr;
                        if (row < MP) op = out + O_IKP + (size_t)row * 64; else if (row < MP + NDB) op = out + O_IKS + (size_t)(row - MP) * 64;
                        if (op) { *(f32x4*)(op + f0) = o1; *(f32x4*)(op + f0 + 32) = o2; }
                    } else if (wc == 2) {
                        if (fq == 0) { *(f32x4*)(iw + (size_t)row * 4) = v0 * 0.5f; *(f32x4*)(glr + (size_t)row * 16 + 12) = v1; }
                        else *(f32x4*)(glr + (size_t)row * 16 + 4 * (fq - 1)) = v0;
                    }
                }
        }
    }
};
struct EpiMem {
    static constexpr bool PERM = false, AFTER_DRAIN = false;
    unsigned char* ws; float* out;
    DI void operator()(const f32x4 (&acc)[2][2][4][2], const pg8::Unit& u, int wr, int wc, int fr, int fq) const {
        const int pn = u.pn, rbase = u.pm * 256 + wr * 64 + fr;
        bf16_t* mk = (bf16_t*)(ws + W_MK); bf16_t* mvt = (bf16_t*)(ws + W_MVT);
        float* op0 = out + (pn == 0 ? O_MKP : O_MVP);
#pragma unroll
        for (int ai = 0; ai < 2; ++ai)
#pragma unroll
            for (int m = 0; m < 4; ++m) {
                const int row = rbase + ai * 128 + m * 16;
#pragma unroll
                for (int bj = 0; bj < 2; ++bj)
#pragma unroll
                    for (int n = 0; n < 2; ++n) {
                        const f32x4 v = acc[ai][bj][m][n];
                        const int col = 128 * bj + 32 * wc + 16 * n + 4 * fq;
                        *(f32x4*)(op0 + (size_t)row * 256 + col) = v;
                        if (pn == 0) st_bf16x4(mk + (size_t)row * 256 + col, v);
                        else { const int m_ = row & 255, kk_ = m_ & 31;
                               bf16_t* tp = mvt + ((((size_t)(row >> 8) * 8 + (m_ >> 5)) * 4 + (col >> 6)) * 64 + (col & 63)) * 32 + 8 * ((kk_ >> 2) & 3) + 4 * (kk_ >> 4) + (kk_ & 3);
                               tp[0] = f2bf(v[0]); tp[32] = f2bf(v[1]); tp[64] = f2bf(v[2]); tp[96] = f2bf(v[3]); }
                    }
            }
    }
};
struct EpiOut {
    static constexpr bool PERM = false, AFTER_DRAIN = false;
    const float* xp; const float* xs; float* out;
    DI void operator()(const f32x4 (&acc)[2][2][4][2], const pg8::Unit& u, int wr, int wc, int fr, int fq) const {
        const int rbase = u.pm * 256 + wr * 64 + fr, cbase = u.pn * 256 + wc * 32 + 4 * fq;
#pragma unroll
        for (int ai = 0; ai < 2; ++ai)
#pragma unroll
            for (int m = 0; m < 4; ++m) {
                const int row = rbase + ai * 128 + m * 16;
                const float* xr; float* orow;
                if (row < MP) { xr = xp + (size_t)row * DM; orow = out + O_YP + (size_t)row * DM; }
                else if (row < MP + NDB) { xr = xs + (size_t)(row - MP) * DM; orow = out + O_YS + (size_t)(row - MP) * DM; }
                else continue;
#pragma unroll
                for (int bj = 0; bj < 2; ++bj)
#pragma unroll
                    for (int n = 0; n < 2; ++n) { const int col = cbase + bj * 128 + n * 16; *(f32x4*)(orow + col) = acc[ai][bj][m][n] + *(const f32x4*)(xr + col); }
            }
    }
};
DI void p0_prologue(const Params& p, LAS3 unsigned char* lds) {
    const int tid = threadIdx.x, lane = tid & 63, wv = tid >> 6;
    unsigned char* ws = p.ws;
    for (int r = blockIdx.x * 8 + wv; r < MROWS + MMEM; r += gridDim.x * 8) {
        const float* src = nullptr; const float* g = p.norm_in; bf16_t* dst;
        if (r < MP) { src = p.x_prompt + (size_t)r * DM; dst = (bf16_t*)(ws + W_XN) + (size_t)r * DM; }
        else if (r < MP + NDB) { src = p.x_sample + (size_t)(r - MP) * DM; dst = (bf16_t*)(ws + W_XN) + (size_t)r * DM; }
        else if (r < MROWS) { dst = (bf16_t*)(ws + W_XN) + (size_t)r * DM; }
        else { src = p.mem_prompt + (size_t)(r - MROWS) * DM; g = p.mem_norm; dst = (bf16_t*)(ws + W_MEMN) + (size_t)(r - MROWS) * DM; }
        if (!src) {
#pragma unroll
            for (int i = 0; i < 4; ++i) *(u32x2*)(dst + i * 256 + lane * 4) = (u32x2){0u, 0u};
            continue;
        }
        f32x4 v[4]; float ss = 0.f;
#pragma unroll
        for (int i = 0; i < 4; ++i) { v[i] = *(const f32x4*)(src + i * 256 + lane * 4); ss += v[i][0] * v[i][0] + v[i][1] * v[i][1] + v[i][2] * v[i][2] + v[i][3] * v[i][3]; }
        ss = wsum64(ss);
        const float rstd = rsqrtf(ss * (1.f / DM) + 1e-6f);
#pragma unroll
        for (int i = 0; i < 4; ++i) { const f32x4 gv = *(const f32x4*)(g + i * 256 + lane * 4); st_bf16x4(dst + i * 256 + lane * 4, v[i] * rstd * gv); }
    }
    for (int e = blockIdx.x * NTHREADS + tid; e < 2049 * 32; e += gridDim.x * NTHREADS) {
        const int pi = e >> 5, f = e & 31;
        const float inv = powf(10000.0f, -(float)(2 * f) / 64.0f);
        const float ang = (float)(pi == 2048 ? 16384 : pi) * inv;
        float sn, cs; sincosf(ang, &sn, &cs);
        ((f32x2*)(ws + W_ROPE))[e] = (f32x2){cs, sn};
    }
    LAS3 float* tl = (LAS3 float*)lds;
    for (int tile = blockIdx.x; tile < 1280; tile += gridDim.x) {
        int which, t2, ld; const float* W; bf16_t* dst;
        if (tile < 896) { which = 0; t2 = tile; W = p.w_in; ld = DIN; dst = (bf16_t*)(ws + W_WTIN); }
        else if (tile < 1024) { which = 1; t2 = tile - 896; W = p.w_mem_kv; ld = 512; dst = (bf16_t*)(ws + W_WTMEM); }
        else { which = 2; t2 = tile - 1024; W = p.w_out; ld = 1024; dst = (bf16_t*)(ws + W_WTOUT); }
        const int nt = t2 >> 4, kt = t2 & 15;
        { const int nn = tid & 63, kk0 = tid >> 6; const int np = nt * 64 + nn; const int sc = which == 0 ? in_src(np) : np;
#pragma unroll
          for (int i = 0; i < 8; ++i) { const int k = kk0 + 8 * i; tl[k * 65 + nn] = sc >= 0 ? W[(size_t)(kt * 64 + k) * ld + sc] : 0.f; } }
        __syncthreads();
        { const int kk = tid & 63, nn0 = tid >> 6;
#pragma unroll
          for (int i = 0; i < 8; ++i) { const int n = nn0 + 8 * i; dst[(size_t)(nt * 64 + n) * 1024 + kt * 64 + kk] = f2bf(tl[kk * 65 + n]); } }
        __syncthreads();
    }
}

DI void cnt_ge(unsigned& c, unsigned key, unsigned cand) { asm volatile("v_cmp_ge_u32 vcc, %1, %2\n\tv_addc_co_u32 %0, vcc, 0, %0, vcc" : "+v"(c) : "v"(key), "v"(cand) : "vcc"); }
DI void cnt_gt(unsigned& c, unsigned key, unsigned cand) { asm volatile("v_cmp_gt_u32 vcc, %1, %2\n\tv_addc_co_u32 %0, vcc, 0, %0, vcc" : "+v"(c) : "v"(key), "v"(cand) : "vcc"); }
DI void cnt_eq_lt(unsigned& c, unsigned key, unsigned T, unsigned idx, unsigned cand) {
    unsigned tmp;
    asm volatile("v_cmp_eq_u32 vcc, %2, %3\n\tv_cndmask_b32 %1, -1, %4, vcc\n\tv_cmp_lt_u32 vcc, %1, %5\n\tv_addc_co_u32 %0, vcc, 0, %0, vcc" : "+v"(c), "=&v"(tmp) : "v"(key), "v"(T), "v"(idx), "v"(cand) : "vcc"); }
DI unsigned grp_count16(unsigned c, LAS3 unsigned* CNT, int& it, int fr, int lane) {
    c += __shfl_xor(c, 16); c += __shfl_xor(c, 32);
    LAS3 unsigned* cur = CNT + (it % 3) * 16;
    if (lane < 16) lds_add(cur + fr, c);
    __syncthreads();
    const unsigned tot = cur[fr];
    if (threadIdx.x < 16) CNT[((it + 2) % 3) * 16 + threadIdx.x] = 0u;
    ++it; return tot;
}
DI unsigned blk_count(unsigned c, LAS3 unsigned* CNT, int& it, int lane) {
    c += __shfl_xor(c, 1); c += __shfl_xor(c, 2); c += __shfl_xor(c, 4); c += __shfl_xor(c, 8); c += __shfl_xor(c, 16); c += __shfl_xor(c, 32);
    LAS3 unsigned* cur = CNT + (it % 3) * 16;
    if (lane == 0) lds_add(cur, c);
    __syncthreads();
    const unsigned tot = cur[0];
    if (threadIdx.x == 0) CNT[((it + 2) % 3) * 16] = 0u;
    ++it; return tot;
}

template <bool MASKED>
DI void attn32(const bf16_t* Q, int ldq, const bf16_t* K, int ldk, const bf16_t* Vt, int ldv, int nkb, const LAS3 unsigned* mask, int fr, int fq,
               f32x4 (&o)[4][2], float (&linv)[2]) {
    bf16x8 qf[2][2];
#pragma unroll
    for (int qt = 0; qt < 2; ++qt)
#pragma unroll
        for (int ks = 0; ks < 2; ++ks) qf[qt][ks] = *(const bf16x8*)(Q + (size_t)(16 * qt + fr) * ldq + ks * 32 + fq * 8);
    float m[2] = {NEG_INF, NEG_INF}, l[2] = {0.f, 0.f};
    const f32x4 zero = {0.f, 0.f, 0.f, 0.f};
#pragma unroll
    for (int dt = 0; dt < 4; ++dt) { o[dt][0] = zero; o[dt][1] = zero; }
    const bf16_t* kl = K + (size_t)fr * ldk + fq * 8;
    const bf16_t* vl = Vt + fr * 32 + 8 * fq;
    bf16x8 kfA[2][2], kfB[2][2], vA[4], vB[4];
#define ATT_LOAD(KF, VF, kb_) do { \
        _Pragma("unroll") for (int i2 = 0; i2 < 2; ++i2) _Pragma("unroll") for (int ks = 0; ks < 2; ++ks) KF[i2][ks] = *(const bf16x8*)(kl + (size_t)(32 * (kb_) + 16 * i2) * ldk + ks * 32); \
        _Pragma("unroll") for (int dt = 0; dt < 4; ++dt) VF[dt] = *(const bf16x8*)(vl + (size_t)(kb_) * ldv + 512 * dt); } while (0)
#define ATT_COMPUTE(KF, VF, kb_) do { \
        _Pragma("unroll") for (int qt = 0; qt < 2; ++qt) { \
            f32x4 s0 = mfma16(KF[0][0], qf[qt][0], zero); s0 = mfma16(KF[0][1], qf[qt][1], s0); \
            f32x4 s1 = mfma16(KF[1][0], qf[qt][0], zero); s1 = mfma16(KF[1][1], qf[qt][1], s1); \
            if (MASKED) { const unsigned mw = mask[(16 * qt + fr) * 65 + (kb_)]; const unsigned b0 = mw >> (2 * fq), b1 = mw >> (8 + 2 * fq); \
                _Pragma("unroll") for (int r = 0; r < 4; ++r) { const int sh_ = (r >> 1) + 16 * (r & 1); s0[r] = ((b0 >> sh_) & 1u) ? s0[r] : NEG_INF; s1[r] = ((b1 >> sh_) & 1u) ? s1[r] : NEG_INF; } } \
            float mx = fmaxf(fmaxf(fmaxf(s0[0], s0[1]), fmaxf(s0[2], s0[3])), fmaxf(fmaxf(s1[0], s1[1]), fmaxf(s1[2], s1[3]))); \
            mx = fmaxf(mx, __shfl_xor(mx, 16)); mx = fmaxf(mx, __shfl_xor(mx, 32)); \
            const float mn = fmaxf(m[qt], mx), ms = (mn == NEG_INF) ? 0.f : mn; \
            const float alpha = __builtin_amdgcn_exp2f((m[qt] - ms) * LOG2E); \
            f32x4 p0, p1; \
            _Pragma("unroll") for (int r = 0; r < 4; ++r) { p0[r] = __builtin_amdgcn_exp2f((s0[r] - ms) * LOG2E); p1[r] = __builtin_amdgcn_exp2f((s1[r] - ms) * LOG2E); } \
            l[qt] = l[qt] * alpha + ((p0[0] + p0[1]) + (p0[2] + p0[3])) + ((p1[0] + p1[1]) + (p1[2] + p1[3])); \
            m[qt] = mn; \
            u32x4 pw; pw.x = cvtpk(p0[0], p0[1]); pw.y = cvtpk(p0[2], p0[3]); pw.z = cvtpk(p1[0], p1[1]); pw.w = cvtpk(p1[2], p1[3]); \
            const bf16x8 pf = __builtin_bit_cast(bf16x8, pw); \
            _Pragma("unroll") for (int dt = 0; dt < 4; ++dt) { o[dt][qt] = o[dt][qt] * alpha; o[dt][qt] = mfma16(VF[dt], pf, o[dt][qt]); } } } while (0)
    ATT_LOAD(kfA, vA, 0);
    const int last = nkb - 1;
    for (int kb = 0; kb < nkb; kb += 2) {
        ATT_LOAD(kfB, vB, kb + 1);
        ATT_COMPUTE(kfA, vA, kb);
        { const int k2 = kb + 2 < last ? kb + 2 : last; ATT_LOAD(kfA, vA, k2); }
        ATT_COMPUTE(kfB, vB, kb + 1);
    }
#undef ATT_LOAD
#undef ATT_COMPUTE
#pragma unroll
    for (int qt = 0; qt < 2; ++qt) { float lt = l[qt]; lt += __shfl_xor(lt, 16); lt += __shfl_xor(lt, 32); linv[qt] = 1.f / lt; }
}
DI void attn_store(const f32x4 (&o)[4][2], const float (&linv)[2], const bf16_t* gate  , bf16_t* mix  , int fr, int fq) {
#pragma unroll
    for (int qt = 0; qt < 2; ++qt)
#pragma unroll
        for (int dt = 0; dt < 4; ++dt) {
            const size_t row = 16 * qt + fr; const int col = 16 * dt + 4 * fq;
            const u32x2 gw = *(const u32x2*)(gate + row * 256 + col);
            f32x4 v = o[dt][qt] * linv[qt];
            v[0] *= __uint_as_float(gw.x << 16); v[1] *= __uint_as_float(gw.x & 0xffff0000u); v[2] *= __uint_as_float(gw.y << 16); v[3] *= __uint_as_float(gw.y & 0xffff0000u);
            st_bf16x4(mix + row * 1024 + col, v);
        }
}

constexpr int DS_MASK = 0, DS_PKT = 16640, PKT_LD = 2052, DS_CNT = 147968;
typedef unsigned short u16x2 __attribute__((ext_vector_type(2)));
DI unsigned pk_cnt_ge(unsigned acc, unsigned kpair, unsigned cm1, unsigned ones) {
    unsigned t;
    asm("v_pk_sub_u16 %1, %2, %3 clamp\n\tv_pk_min_u16 %1, %1, %4\n\tv_pk_add_u16 %0, %0, %1" : "+v"(acc), "=&v"(t) : "v"(kpair), "v"(cm1), "v"(ones));
    return acc;
}
DI void select_bitwise(const unsigned (&key)[16][4], int lbase, LAS3 unsigned* CNT, int& it, int fr, int lane, unsigned& T, int& Xrel) {
    bool fin = false;
    T = 0u; Xrel = 0x7fffffff;
    for (int bit = 31; bit >= 0; --bit) {
        const unsigned cand = T | (1u << bit);
        unsigned c = 0;
#pragma unroll
        for (int n = 0; n < 16; ++n)
#pragma unroll
            for (int r = 0; r < 4; ++r) cnt_ge(c, key[n][r], cand);
        const unsigned tot = grp_count16(c, CNT, it, fr, lane);
        if (!fin && tot >= 256u) { T = cand; fin = (tot == 256u); }
        if (__all(fin)) break;
    }
    if (!__all(fin)) {
        unsigned c = 0;
#pragma unroll
        for (int n = 0; n < 16; ++n)
#pragma unroll
            for (int r = 0; r < 4; ++r) cnt_gt(c, key[n][r], T);
        const unsigned cgt = grp_count16(c, CNT, it, fr, lane);
        const unsigned need = 256u - cgt;
        unsigned Xl = 0u;
        for (int bit = 10; bit >= 0; --bit) {
            const unsigned cand = Xl | (1u << bit);
            const int crel = (int)cand - lbase;
            c = 0;
#pragma unroll
            for (int n = 0; n < 16; ++n) { const int crn = crel - 128 * n;
#pragma unroll
                for (int r = 0; r < 4; ++r) c += (key[n][r] == T && r < crn) ? 1u : 0u; }
            const unsigned tot = grp_count16(c, CNT, it, fr, lane);
            if (tot < need) Xl = cand;
        }
        if (!fin) Xrel = (int)Xl - lbase;
    }
}
DI unsigned pk_flag_ge(unsigned kpair, unsigned cm1, unsigned ones) {
    unsigned t;
    asm("v_pk_sub_u16 %0, %1, %2 clamp\n\tv_pk_min_u16 %0, %0, %3" : "=&v"(t) : "v"(kpair), "v"(cm1), "v"(ones));
    return t;
}
DI unsigned pk_max(unsigned a, unsigned b2) { unsigned t; asm("v_pk_max_u16 %0, %1, %2" : "=v"(t) : "v"(a), "v"(b2)); return t; }
DI unsigned hsum32(unsigned x) {
    x += __builtin_amdgcn_update_dpp(0u, x, 0xB1, 0xF, 0xF, false); x += __builtin_amdgcn_update_dpp(0u, x, 0x4E, 0xF, 0xF, false);
    x += __builtin_amdgcn_update_dpp(0u, x, 0x141, 0xF, 0xF, false); x += __builtin_amdgcn_update_dpp(0u, x, 0x140, 0xF, 0xF, false);
    const auto r = __builtin_amdgcn_permlane16_swap(x, x, false, false); return r[0] + r[1];
}
DI unsigned hmax32(unsigned x) {
    x = max(x, (unsigned)__builtin_amdgcn_update_dpp(0u, x, 0xB1, 0xF, 0xF, false)); x = max(x, (unsigned)__builtin_amdgcn_update_dpp(0u, x, 0x4E, 0xF, 0xF, false));
    x = max(x, (unsigned)__builtin_amdgcn_update_dpp(0u, x, 0x141, 0xF, 0xF, false)); x = max(x, (unsigned)__builtin_amdgcn_update_dpp(0u, x, 0x140, 0xF, 0xF, false));
    const auto r = __builtin_amdgcn_permlane16_swap(x, x, false, false); return max(r[0], r[1]);
}
DI unsigned pk_count32(const unsigned (&rk)[32], unsigned cm1, unsigned ones) {
    unsigned a0 = 0u, a1 = 0u;
#pragma unroll
    for (int k = 0; k < 32; k += 2) { a0 = pk_cnt_ge(a0, rk[k], cm1, ones); a1 = pk_cnt_ge(a1, rk[k + 1], cm1, ones); }
    return (a0 & 0xffffu) + (a0 >> 16) + (a1 & 0xffffu) + (a1 >> 16);
}
DI void dsa_unit(const Params& p, LAS3 unsigned char* lds, int b, int j TARGS) {
    int tid = threadIdx.x; asm volatile("" : "+v"(tid));
    const int lane0 = tid & 63, w = __builtin_amdgcn_readfirstlane(tid >> 6);
    unsigned char* ws = p.ws;
    LAS3 unsigned* MASK = (LAS3 unsigned*)(lds + DS_MASK);
    LAS3 unsigned* PKT = (LAS3 unsigned*)(lds + DS_PKT);
    const bf16_t* IQ = (const bf16_t*)(ws + W_IQ); const bf16_t* IK = (const bf16_t*)(ws + W_IK); const float* IW = (const float*)(ws + W_IW);
    const int q0 = 64 * j;
    const f32x4 zero = {0.f, 0.f, 0.f, 0.f};
#ifdef CHECK_SEL
    LAS3 unsigned* CNT = (LAS3 unsigned*)(lds + DS_CNT); int it = 0;
    if (tid < 48) CNT[tid] = 0u;
    __syncthreads();
#endif
    TBEG(30);
#pragma unroll 1
    for (int qg = 0; qg < 4; ++qg) {
        TBEG(32);
        int lane = lane0; asm volatile("" : "+v"(lane));
        const int fr = lane & 15, fq = lane >> 4;
        const int tq = q0 + 16 * qg + fr; const size_t qrow = (size_t)b * SEQ + tq;
        const int ntile = 4 * j + qg + 1;
        const int nloc = ntile > w ? (ntile - w + 7) >> 3 : 0;
        const bool selecting = q0 + 16 * qg >= 256;
        {
            bf16x8 bq[4][2];
#pragma unroll
            for (int h = 0; h < 4; ++h)
#pragma unroll
                for (int ks = 0; ks < 2; ++ks) bq[h][ks] = *(const bf16x8*)(IQ + qrow * 256 + h * 64 + ks * 32 + fq * 8);
            const f32x4 wq = *(const f32x4*)(IW + qrow * 4);
            float Lh[4];
#pragma unroll
            for (int h = 0; h < 4; ++h) Lh[h] = wq[h] < 0.f ? NEG_INF : -NEG_INF;
            const char* tb = (const char*)IK + ((size_t)b * SEQ + 16 * w) * 128 + (unsigned)(fr * 128 + fq * 16);
            LAS3 unsigned* krow = PKT + fr * PKT_LD + 16 * w + 4 * fq;
            const int lim0 = tq - (16 * w + 4 * fq);
#define DSA_TILE(A0, A1, nn) do { \
                f32x4 sc = zero; \
                _Pragma("unroll") for (int h = 0; h < 4; ++h) { f32x4 d = mfma16(A0, bq[h][0], zero); d = mfma16(A1, bq[h][1], d); d = d * wq[h]; \
                    _Pragma("unroll") for (int r = 0; r < 4; ++r) sc[r] += __builtin_amdgcn_fmed3f(d[r], 0.f, Lh[h]); } \
                { const char* t2_ = tb + (size_t)((nn) + 2 < nloc ? (nn) + 2 : nloc - 1) * 16384; A0 = *(const bf16x8*)t2_; A1 = *(const bf16x8*)(t2_ + 64); } \
                const int limn = lim0 - 128 * (nn);                   \
                u32x4 kv; \
                _Pragma("unroll") for (int r = 0; r < 4; ++r) { const unsigned u = __float_as_uint(sc[r] + 0.f); const unsigned k = u ^ ((unsigned)((int)u >> 31) | 0x80000000u);   \
                    kv[r] = (r <= limn) ? k : 0u; } \
                *(LAS3 u32x4*)(krow + 128 * (nn)) = kv; } while (0)
            if (nloc > 0) {
                bf16x8 a0 = *(const bf16x8*)tb, a1 = *(const bf16x8*)(tb + 64);
                const char* t1 = tb + (size_t)(1 < nloc ? 1 : 0) * 16384;
                bf16x8 b0 = *(const bf16x8*)t1, b1 = *(const bf16x8*)(t1 + 64);
#pragma unroll 1
                for (int n = 0; n < nloc; n += 2) {
                    DSA_TILE(a0, a1, n);
                    if (n + 1 < nloc) DSA_TILE(b0, b1, n + 1);
                }
            }
#undef DSA_TILE
        }
        TEND(32); TBEG(33);
        __syncthreads();
        {
            const int hh = lane >> 5, pos = lane & 31, oq = 2 * w + hh;
            const unsigned nkeys = 16u * (unsigned)ntile;
            const LAS3 unsigned* orow = PKT + oq * PKT_LD + 2 * pos;
            unsigned ones = 0x00010001u; asm volatile("" : "+v"(ones));
            unsigned Tfull = 1u, X = 0xffffffffu;
            if (selecting) {
                unsigned rk[32];
#pragma unroll
                for (int k = 0; k < 32; ++k) { const u32x2 kk = *(const LAS3 u32x2*)(orow + 64 * k); rk[k] = (2u * (unsigned)(pos + 32 * k) < nkeys) ? __builtin_amdgcn_perm(kk.y, kk.x, 0x07060302u) : 0u; }
                unsigned mx = 0u;
#pragma unroll
                for (int k = 0; k < 32; ++k) mx = pk_max(mx, rk[k]);
                const unsigned kmax = hmax32(max(mx & 0xffffu, mx >> 16));
                unsigned T16 = 0u, cabove = 0u; bool exact = false;
                {
                    unsigned ub = 0x10000u;
#pragma unroll 1
                    for (int bit = 15; bit >= 0; --bit) {
                        const unsigned cand = T16 | (1u << bit);
                        if (__all(cand > kmax)) { ub = cand; continue; }
                        const unsigned tot = hsum32(pk_count32(rk, (cand - 1u) * 0x00010001u, ones));
                        if (tot >= 256u) T16 = cand; else { ub = cand; cabove = tot; }
                    }
                    (void)ub;
                }
                const unsigned need = 256u - cabove;
#pragma unroll
                for (int k = 0; k < 32; ++k) { const u32x2 kk = *(const LAS3 u32x2*)(orow + 64 * k); const bool in = 2u * (unsigned)(pos + 32 * k) < nkeys;
                    const unsigned lo0 = (in && (kk.x >> 16) == T16) ? (kk.x & 0xffffu) : 0u, lo1 = (in && (kk.y >> 16) == T16) ? (kk.y & 0xffffu) : 0u; rk[k] = lo0 | (lo1 << 16); }
                unsigned Tlo = 0u;
#pragma unroll 1
                for (int bit = 15; bit >= 0; --bit) {
                    const unsigned cand = Tlo | (1u << bit);
                    const unsigned tot = hsum32(pk_count32(rk, (cand - 1u) * 0x00010001u, ones));
                    if (!exact && tot >= need) { Tlo = cand; exact = (tot == need); }
                    if (__all(exact)) break;
                }
                Tfull = (T16 << 16) | Tlo;
                if (!__all(exact)) {
                    unsigned cgt = 0u, ceq = 0u;
#pragma unroll 1
                    for (int k = 0; k < 32; ++k) { const u32x2 kk = *(const LAS3 u32x2*)(orow + 64 * k); const bool in = 2u * (unsigned)(pos + 32 * k) < nkeys;
                        cgt += (in && kk.x > Tfull && (kk.x >> 16) == T16 ? 1u : 0u) + (in && kk.y > Tfull && (kk.y >> 16) == T16 ? 1u : 0u); }
                    (void)ceq;
                    const unsigned needt = need - hsum32(cgt);
                    unsigned Xl = 0u;
#pragma unroll 1
                    for (int bit = 10; bit >= 0; --bit) {
                        const unsigned cx = Xl | (1u << bit);
                        unsigned c = 0u;
#pragma unroll 1
                        for (int k = 0; k < 32; ++k) { const u32x2 kk = *(const LAS3 u32x2*)(orow + 64 * k); const unsigned i0 = 2u * (unsigned)(pos + 32 * k);
                            c += (i0 < nkeys && kk.x == Tfull && i0 < cx ? 1u : 0u) + (i0 < nkeys && kk.y == Tfull && i0 + 1u < cx ? 1u : 0u); }
                        if (hsum32(c) < needt) Xl = cx;
                    }
                    if (!exact) X = Xl;
                }
            }
            LAS3 unsigned* mrow = MASK + (16 * qg + oq) * 65 + (pos >> 4);
            const unsigned sh = 32u * hh + (pos & 16);
#pragma unroll 2
            for (int k = 0; k <= j; ++k) {
                const u32x2 kk = *(const LAS3 u32x2*)(orow + 64 * k); const unsigned i0 = 2u * (unsigned)(pos + 32 * k);
                const bool s0 = i0 < nkeys && (kk.x > Tfull || (kk.x == Tfull && i0 <= X)), s1 = i0 < nkeys && (kk.y > Tfull || (kk.y == Tfull && i0 + 1u <= X));
                const unsigned long long blo = __ballot(s0), bhi = __ballot(s1);
                const unsigned wv = ((unsigned)(blo >> sh) & 0xffffu) | ((unsigned)(bhi >> sh) << 16);
                if ((pos & 15) == 0) mrow[2 * k] = wv;
            }
        }
        TEND(33);
        __syncthreads();
#ifdef CHECK_SEL
        if (selecting) {
            const int lbase = 16 * w + 4 * fq;
            unsigned key[16][4];
#pragma unroll
            for (int n = 0; n < 16; ++n)
#pragma unroll
                for (int r = 0; r < 4; ++r) key[n][r] = (n < nloc) ? PKT[fr * PKT_LD + lbase + 128 * n + r] : 0u;
            unsigned T2; int X2; select_bitwise(key, lbase, CNT, it, fr, lane, T2, X2);
            bool bad = false;
#pragma unroll
            for (int n = 0; n < 16; ++n) if (n < nloc) { const int x2 = X2 - 128 * n;
#pragma unroll
                for (int r = 0; r < 4; ++r) { const unsigned idx = (unsigned)(lbase + 128 * n + r); const unsigned mw = MASK[(16 * qg + fr) * 65 + (idx >> 5)];
                    const bool s2 = key[n][r] > T2 || (key[n][r] == T2 && r <= x2); bad |= (s2 != (((mw >> (((idx & 31u) >> 1) + 16u * (idx & 1u))) & 1u) != 0u)); } }
            if (__any(bad) && lane == 0) atomicAdd((unsigned*)(ws + CW_CHK), 1u);
            if (lane == 0 && w == 0) atomicAdd((unsigned*)(ws + CW_CHK + 4), 1u);
            __syncthreads();
        }
#endif
    }
    TEND(30); TBEG(31);
    {
        const int h = w & 3, hf = w >> 2, fr = lane0 & 15, fq = lane0 >> 4;
        const size_t qrow0 = (size_t)b * SEQ + q0 + 32 * hf;
        f32x4 o[4][2]; float linv[2];
        attn32<true>((const bf16_t*)(ws + W_DQ) + qrow0 * 256 + h * 64, 256, (const bf16_t*)(ws + W_DK) + (size_t)b * SEQ * 256 + h * 64, 256,
                     (const bf16_t*)(ws + W_DVT) + ((size_t)b * 64 * 4 + h) * 2048, 4 * 2048, 2 * j + 2  , MASK + 32 * hf * 65, fr, fq, o, linv);
        attn_store(o, linv, (const bf16_t*)(ws + W_DG) + qrow0 * 256 + h * 64, (bf16_t*)(ws + W_MIX) + qrow0 * 1024 + 512 + h * 64, fr, fq);
    }
    __syncthreads();
    TEND(31);
}
DI void mem_unit(const Params& p, int n) {
    const int tid = threadIdx.x, lane = tid & 63, w = __builtin_amdgcn_readfirstlane(tid >> 6), fr = lane & 15, fq = lane >> 4;
    unsigned char* ws = p.ws;
    const int h = w & 3, hf = w >> 2;
    const size_t qrow0 = (size_t)n * 64 + 32 * hf; const int b = n >> 5;
    f32x4 o[4][2]; float linv[2];
    attn32<false>((const bf16_t*)(ws + W_MQ) + qrow0 * 256 + h * 64, 256, (const bf16_t*)(ws + W_MK) + (size_t)b * NMEM * 256 + h * 64, 256,
                  (const bf16_t*)(ws + W_MVT) + ((size_t)b * 8 * 4 + h) * 2048, 4 * 2048, 8, nullptr, fr, fq, o, linv);
    attn_store(o, linv, (const bf16_t*)(ws + W_MG) + qrow0 * 256 + h * 64, (bf16_t*)(ws + W_MIX) + qrow0 * 1024 + 768 + h * 64, fr, fq);
}
constexpr int GL_QT = 0, GL_KT = 9216, GL_KPT = 18432, GL_VT = 27648, GL_SBT = 46080, GL_PM = 64512, GL_OF = 73728, GL_GTOT = 107520, GL_W2 = 109568, GL_BG = 113664, GL_DEC = 113920;
constexpr int LDP = 72;
DI void gla_unit(const Params& p, LAS3 unsigned char* lds, int b, int h) {
    const int tid = threadIdx.x, lane = tid & 63, w = __builtin_amdgcn_readfirstlane(tid >> 6), fr = lane & 15, fq = lane >> 4;
    unsigned char* ws = p.ws;
    LAS3 bf16_t* Qt = (LAS3 bf16_t*)(lds + GL_QT); LAS3 bf16_t* Kt = (LAS3 bf16_t*)(lds + GL_KT); LAS3 bf16_t* KpT = (LAS3 bf16_t*)(lds + GL_KPT);
    LAS3 bf16_t* Vt = (LAS3 bf16_t*)(lds + GL_VT); LAS3 bf16_t* SbT = (LAS3 bf16_t*)(lds + GL_SBT); LAS3 bf16_t* Pm = (LAS3 bf16_t*)(lds + GL_PM);
    LAS3 float* Of = (LAS3 float*)(lds + GL_OF); LAS3 float* gtot = (LAS3 float*)(lds + GL_GTOT); LAS3 float* w2s = (LAS3 float*)(lds + GL_W2);
    LAS3 float* bgs = (LAS3 float*)(lds + GL_BG); LAS3 float* dec = (LAS3 float*)(lds + GL_DEC);
    const bf16_t* GQ = (const bf16_t*)(ws + W_GQ); const bf16_t* GK = (const bf16_t*)(ws + W_GK); const bf16_t* GV = (const bf16_t*)(ws + W_GV);
    const bf16_t* GG = (const bf16_t*)(ws + W_GG); const float* GLR = (const float*)(ws + W_GLR); bf16_t* MIX = (bf16_t*)(ws + W_MIX);
    for (int i = tid; i < 128 * LDP / 2; i += NTHREADS) ((LAS3 unsigned*)SbT)[i] = 0u;
    for (int i = tid; i < 16 * 64; i += NTHREADS) w2s[i] = p.w_g2[(i >> 6) * 256 + h * 64 + (i & 63)];
    if (tid < 64) bgs[tid] = p.b_g[h * 64 + tid];
    __syncthreads();
    const int d = tid & 63, tg = w;
    float wreg[16];
#pragma unroll
    for (int r = 0; r < 16; ++r) wreg[r] = w2s[r * 64 + d];
    const float bgd = bgs[d];
    const f32x4 zero = {0.f, 0.f, 0.f, 0.f};
    f32x4 Sacc[4] = {zero, zero, zero, zero};
    const int tt = w & 3, vh = w >> 2;
    for (int c = 0; c < 32; ++c) {
        const size_t rb = (size_t)b * SEQ + c * 64;
        float g8[8];
#pragma unroll
        for (int i = 0; i < 8; ++i) {
            const float* gl = vaddr(GLR + (rb + tg * 8 + i) * 16);
            float u = bgd;
#pragma unroll
            for (int r = 0; r < 16; ++r) u += gl[r] * wreg[r];
            const float g = logsigf(u) * (1.f / 16.f);
            g8[i] = (i ? g8[i - 1] : 0.f) + g;
        }
        gtot[tg * 64 + d] = g8[7];
        __syncthreads();
        float off = 0.f, blast = 0.f;
#pragma unroll
        for (int g2 = 0; g2 < 8; ++g2) { const float v = gtot[g2 * 64 + d]; off += (g2 < tg) ? v : 0.f; blast += v; }
        float kp[8];
#pragma unroll
        for (int i = 0; i < 8; ++i) {
            const int t = tg * 8 + i; const float bt = off + g8[i];
            const float q = bf2f(GQ[(rb + t) * 256 + h * 64 + d]), k = bf2f(GK[(rb + t) * 256 + h * 64 + d]);
            Qt[t * LDP + d] = f2bf(q * expf(bt)); Kt[t * LDP + d] = f2bf(k * expf(-bt)); kp[i] = k * expf(blast - bt);
        }
        { u32x4 kw; kw.x = cvtpk(kp[0], kp[1]); kw.y = cvtpk(kp[2], kp[3]); kw.z = cvtpk(kp[4], kp[5]); kw.w = cvtpk(kp[6], kp[7]); *(LAS3 u32x4*)(KpT + d * LDP + tg * 8) = kw; }
        if (tg == 0) dec[d] = expf(blast);
        { const int v = tid & 127, sg = tid >> 7; bf16_t vv[16];
#pragma unroll
          for (int i = 0; i < 16; ++i) vv[i] = GV[(rb + sg * 16 + i) * 512 + h * 128 + v];
          u32x4 a, bb; a.x = vv[0] | ((unsigned)vv[1] << 16); a.y = vv[2] | ((unsigned)vv[3] << 16); a.z = vv[4] | ((unsigned)vv[5] << 16); a.w = vv[6] | ((unsigned)vv[7] << 16);
          bb.x = vv[8] | ((unsigned)vv[9] << 16); bb.y = vv[10] | ((unsigned)vv[11] << 16); bb.z = vv[12] | ((unsigned)vv[13] << 16); bb.w = vv[14] | ((unsigned)vv[15] << 16);
          *(LAS3 u32x4*)(Vt + v * LDP + sg * 16) = a; *(LAS3 u32x4*)(Vt + v * LDP + sg * 16 + 8) = bb; }
        __syncthreads();
#pragma unroll
        for (int s2 = 0; s2 < 2; ++s2) {
            const int st = 2 * vh + s2;
            f32x4 acc = zero;
#pragma unroll
            for (int ks = 0; ks < 2; ++ks) {
                const bf16x8 a = *(const LAS3 bf16x8*)(Kt + (st * 16 + fr) * LDP + ks * 32 + fq * 8), bq = *(const LAS3 bf16x8*)(Qt + (tt * 16 + fr) * LDP + ks * 32 + fq * 8);
                acc = mfma16(a, bq, acc);
            }
            const int t = tt * 16 + fr, s0 = st * 16 + 4 * fq;
            u32x2 pw; pw.x = cvtpk(s0 <= t ? acc[0] : 0.f, s0 + 1 <= t ? acc[1] : 0.f); pw.y = cvtpk(s0 + 2 <= t ? acc[2] : 0.f, s0 + 3 <= t ? acc[3] : 0.f);
            *(LAS3 u32x2*)(Pm + t * LDP + s0) = pw;
        }
        __syncthreads();
        f32x4 oacc[4];
        {
            bf16x8 aq[2], ap[2], ak[2];
#pragma unroll
            for (int ks = 0; ks < 2; ++ks) {
                aq[ks] = *(const LAS3 bf16x8*)(Qt + (tt * 16 + fr) * LDP + ks * 32 + fq * 8);
                ap[ks] = *(const LAS3 bf16x8*)(Pm + (tt * 16 + fr) * LDP + ks * 32 + fq * 8);
                ak[ks] = *(const LAS3 bf16x8*)(KpT + (tt * 16 + fr) * LDP + ks * 32 + fq * 8);
            }
            const f32x4 dv = *(const LAS3 f32x4*)(dec + tt * 16 + 4 * fq);
#pragma unroll
            for (int jv = 0; jv < 4; ++jv) {
                const int vt = vh * 4 + jv;
                bf16x8 bs[2], bv[2];
#pragma unroll
                for (int ks = 0; ks < 2; ++ks) {
                    bs[ks] = *(const LAS3 bf16x8*)(SbT + (vt * 16 + fr) * LDP + ks * 32 + fq * 8);
                    bv[ks] = *(const LAS3 bf16x8*)(Vt + (vt * 16 + fr) * LDP + ks * 32 + fq * 8);
                }
                f32x4 oa = mfma16(aq[0], bs[0], zero); oa = mfma16(aq[1], bs[1], oa); oa = mfma16(ap[0], bv[0], oa); oa = mfma16(ap[1], bv[1], oa);
                oacc[jv] = oa;
                f32x4 sa = Sacc[jv] * dv; sa = mfma16(ak[0], bv[0], sa); sa = mfma16(ak[1], bv[1], sa);
                Sacc[jv] = sa;
            }
        }
        __syncthreads();
#pragma unroll
        for (int jv = 0; jv < 4; ++jv) {
            const int vt = vh * 4 + jv;
#pragma unroll
            for (int r = 0; r < 4; ++r) Of[(tt * 16 + 4 * fq + r) * 132 + vt * 16 + fr] = oacc[jv][r];
            u32x2 sw; sw.x = cvtpk(Sacc[jv][0], Sacc[jv][1]); sw.y = cvtpk(Sacc[jv][2], Sacc[jv][3]);
            *(LAS3 u32x2*)(SbT + (vt * 16 + fr) * LDP + tt * 16 + 4 * fq) = sw;
        }
        __syncthreads();
        {
            const int t = tid >> 3, seg = tid & 7;
            const LAS3 float* op = Of + t * 132 + seg * 16;
            f32x4 ov[4]; float ss = 0.f;
#pragma unroll
            for (int i = 0; i < 4; ++i) { ov[i] = *(const LAS3 f32x4*)(op + 4 * i); ss += ov[i][0] * ov[i][0] + ov[i][1] * ov[i][1] + ov[i][2] * ov[i][2] + ov[i][3] * ov[i][3]; }
            ss += __shfl_xor(ss, 1); ss += __shfl_xor(ss, 2); ss += __shfl_xor(ss, 4);
            const float rstd = rsqrtf(ss * (1.f / 128.f) + 1e-6f);
            const bf16_t* gp = GG + (rb + t) * 512 + h * 128 + seg * 16;
            const u32x4 g0 = *(const u32x4*)gp, g1 = *(const u32x4*)(gp + 8);
            const unsigned gw[8] = {g0.x, g0.y, g0.z, g0.w, g1.x, g1.y, g1.z, g1.w};
            unsigned ow[8];
#pragma unroll
            for (int i = 0; i < 4; ++i) {
                const f32x4 on = *(const f32x4*)(p.onorm + seg * 16 + 4 * i);
                const float y0 = ov[i][0] * rstd * on[0] * __uint_as_float(gw[2 * i] << 16), y1 = ov[i][1] * rstd * on[1] * __uint_as_float(gw[2 * i] & 0xffff0000u);
                const float y2 = ov[i][2] * rstd * on[2] * __uint_as_float(gw[2 * i + 1] << 16), y3 = ov[i][3] * rstd * on[3] * __uint_as_float(gw[2 * i + 1] & 0xffff0000u);
                ow[2 * i] = cvtpk(y0, y1); ow[2 * i + 1] = cvtpk(y2, y3);
            }
            bf16_t* mp = MIX + (rb + t) * 1024 + h * 128 + seg * 16;
            *(u32x4*)mp = (u32x4){ow[0], ow[1], ow[2], ow[3]}; *(u32x4*)(mp + 8) = (u32x4){ow[4], ow[5], ow[6], ow[7]};
        }
    }
#pragma unroll
    for (int jv = 0; jv < 4; ++jv)
#pragma unroll
        for (int r = 0; r < 4; ++r) p.out[O_GSP + ((size_t)(b * 4 + h) * 64 + tt * 16 + 4 * fq + r) * 128 + (vh * 4 + jv) * 16 + fr] = Sacc[jv][r];
    __syncthreads();
}

DI void sscore_unit(const Params& p, LAS3 unsigned char* lds, int u) {
    const int tid = threadIdx.x;
    unsigned char* ws = p.ws;
    const int b = u >> 3, pg = u & 7;
    LAS3 float* qf = (LAS3 float*)lds;
    if (tid < 256) qf[tid] = bf2f(((const bf16_t*)(ws + W_IQ))[(size_t)(MP + b) * 256 + tid]);
    __syncthreads();
    const int seg = tid & 15;
    f32x4 q[4];
#pragma unroll
    for (int h = 0; h < 4; ++h) q[h] = *(const LAS3 f32x4*)(qf + h * 64 + seg * 4);
    const f32x4 wv = *(const f32x4*)vaddr((const float*)(ws + W_IW) + (size_t)(MP + b) * 4);
    unsigned* sc = (unsigned*)(ws + W_SC) + (size_t)b * SCLD;
    for (int pi = pg * 16; pi < pg * 16 + 16; ++pi) {
        const int phys = p.page_table[b * NPAGES + pi];
        const float* base = p.cache_ik + (size_t)phys * 8192;
#pragma unroll
        for (int i = 0; i < 4; ++i) {
            const int e = tid + 512 * i;
            const f32x4 kv = *(const f32x4*)(base + (size_t)e * 4);
            float dh[4];
#pragma unroll
            for (int h = 0; h < 4; ++h) {
                float x = q[h][0] * kv[0] + q[h][1] * kv[1] + q[h][2] * kv[2] + q[h][3] * kv[3];
                x += __shfl_xor(x, 1); x += __shfl_xor(x, 2); x += __shfl_xor(x, 4); x += __shfl_xor(x, 8);
                dh[h] = x;
            }
            const float s = wv[0] * fmaxf(dh[0], 0.f) + wv[1] * fmaxf(dh[1], 0.f) + wv[2] * fmaxf(dh[2], 0.f) + wv[3] * fmaxf(dh[3], 0.f);
            if (seg == 0) __hip_atomic_store(sc + pi * 128 + (e >> 4), __float_as_uint(s), __ATOMIC_RELAXED, __HIP_MEMORY_SCOPE_AGENT);
        }
    }
    asm volatile("s_waitcnt vmcnt(0)" ::: "memory");
    __syncthreads();
    if (tid == 0) __hip_atomic_fetch_add((unsigned*)(ws + CW_SCNT), 1u, __ATOMIC_RELAXED, __HIP_MEMORY_SCOPE_AGENT);
}

constexpr int SA_Q = 2048, SA_S = 3072, SA_KP = 8192, SA_VP = 10240;
DI void sattend(const Params& p, LAS3 unsigned char* lds, const bf16_t* qrow  , const bf16_t* gate, bf16_t* mix) {
    const int tid = threadIdx.x, lane = tid & 63, w = tid >> 6;
    LAS3 float* qf = (LAS3 float*)(lds + SA_Q); LAS3 float* S = (LAS3 float*)(lds + SA_S);
    const float* const LAS3* kptr = (const float* const LAS3*)(lds + SA_KP); const float* const LAS3* vptr = (const float* const LAS3*)(lds + SA_VP);
    if (tid < 256) qf[tid] = bf2f(qrow[tid]);
    __syncthreads();
    {
        const int jk = tid >> 1, hp = tid & 1;
        const float* kr = kptr[jk] + hp * 128;
        float s0 = 0.f, s1 = 0.f;
#pragma unroll 4
        for (int i = 0; i < 16; ++i) {
            const f32x4 k0 = *(const f32x4*)(kr + 4 * i), k1 = *(const f32x4*)(kr + 64 + 4 * i);
            const f32x4 q0 = *(const LAS3 f32x4*)(qf + hp * 128 + 4 * i), q1 = *(const LAS3 f32x4*)(qf + hp * 128 + 64 + 4 * i);
            s0 += q0[0] * k0[0] + q0[1] * k0[1] + q0[2] * k0[2] + q0[3] * k0[3];
            s1 += q1[0] * k1[0] + q1[1] * k1[1] + q1[2] * k1[2] + q1[3] * k1[3];
        }
        S[(2 * hp) * 256 + jk] = s0; S[(2 * hp + 1) * 256 + jk] = s1;
    }
    __syncthreads();
    if (w < 4) {
        float v[4], mx = NEG_INF;
#pragma unroll
        for (int i = 0; i < 4; ++i) { v[i] = S[w * 256 + lane + 64 * i]; mx = fmaxf(mx, v[i]); }
        mx = wmax64(mx);
        float sum = 0.f;
#pragma unroll
        for (int i = 0; i < 4; ++i) { v[i] = __expf(v[i] - mx); sum += v[i]; }
        sum = wsum64(sum);
        const float inv = 1.f / sum;
#pragma unroll
        for (int i = 0; i < 4; ++i) S[w * 256 + lane + 64 * i] = v[i] * inv;
    }
    __syncthreads();
    {
        const int h = tid >> 7, dd = (tid >> 1) & 63, hf = tid & 1;
        float acc = 0.f;
#pragma unroll 4
        for (int jk = hf * 128; jk < hf * 128 + 128; ++jk) acc += S[h * 256 + jk] * vptr[jk][h * 64 + dd];
        acc += __shfl_xor(acc, 1);
        if (hf == 0) mix[h * 64 + dd] = f2bf(acc * bf2f(gate[h * 64 + dd]));
    }
    __syncthreads();
}
DI void smem_unit(const Params& p, LAS3 unsigned char* lds, int b) {
    const int tid = threadIdx.x; unsigned char* ws = p.ws;
    const float* LAS3* kptr = (const float* LAS3*)(lds + SA_KP); const float* LAS3* vptr = (const float* LAS3*)(lds + SA_VP);
    if (tid < 256) { kptr[tid] = p.cache_mem_k + ((size_t)b * NMEM + tid) * 256; vptr[tid] = p.cache_mem_v + ((size_t)b * NMEM + tid) * 256; }
    const size_t row = MP + b;
    sattend(p, lds, (const bf16_t*)(ws + W_MQ) + row * 256, (const bf16_t*)(ws + W_MG) + row * 256, (bf16_t*)(ws + W_MIX) + row * 1024 + 768);
}
DI void ssel_unit(const Params& p, LAS3 unsigned char* lds, int b) {
    const int tid = threadIdx.x, lane = tid & 63, w = tid >> 6; unsigned char* ws = p.ws;
    LAS3 unsigned* CNT = (LAS3 unsigned*)lds;
    LAS3 unsigned* wsum = (LAS3 unsigned*)(lds + 256);
    LAS3 float* newsc = (LAS3 float*)(lds + 320);
    LAS3 int* list = (LAS3 int*)(lds + 512);
    const float* LAS3* kptr = (const float* LAS3*)(lds + SA_KP); const float* LAS3* vptr = (const float* LAS3*)(lds + SA_VP);
    if (tid < 48) CNT[tid] = 0u;
    if (tid == 0) {
        unsigned* cnt = (unsigned*)(ws + CW_SCNT); unsigned* tmo = (unsigned*)(ws + CW_TMO); unsigned sp = 0;
        while (__hip_atomic_load(cnt, __ATOMIC_RELAXED, __HIP_MEMORY_SCOPE_AGENT) < 256u) {
            __builtin_amdgcn_s_sleep(2);
            if ((++sp & 255u) == 0u) { if (__hip_atomic_load(tmo, __ATOMIC_RELAXED, __HIP_MEMORY_SCOPE_AGENT)) break; if (sp > (1u << 20)) { __hip_atomic_store(tmo, 1u, __ATOMIC_RELAXED, __HIP_MEMORY_SCOPE_AGENT); break; } }
        }
        __builtin_amdgcn_fence(__ATOMIC_ACQUIRE, "agent");
        asm volatile("s_waitcnt vmcnt(0)" ::: "memory");
    }
    if (w == 1) {
        const bf16_t* iq = (const bf16_t*)(ws + W_IQ) + (size_t)(MP + b) * 256; const float kd = bf2f(((const bf16_t*)(ws + W_IK))[(size_t)(MP + b) * 64 + lane]);
        const f32x4 wv = *(const f32x4*)vaddr((const float*)(ws + W_IW) + (size_t)(MP + b) * 4);
        float s = 0.f;
#pragma unroll
        for (int h = 0; h < 4; ++h) { const float dh = wsum64(bf2f(iq[h * 64 + lane]) * kd); s += wv[h] * fmaxf(dh, 0.f); }
        if (lane == 0) *newsc = s;
    }
    __syncthreads();
    const float* sc = (const float*)(ws + W_SC) + (size_t)b * SCLD;
    unsigned key[33];
#pragma unroll
    for (int n = 0; n < 32; ++n) key[n] = fkey(sc[tid + 512 * n]);
    key[32] = (tid == 0) ? fkey(*newsc) : 0u;
    int it = 0;
    unsigned T = 0u, X = 0x7fffffffu; bool fin = false;
    for (int bit = 31; bit >= 0; --bit) {
        const unsigned cand = T | (1u << bit);
        unsigned c = 0;
#pragma unroll
        for (int n = 0; n < 33; ++n) cnt_ge(c, key[n], cand);
        const unsigned tot = blk_count(c, CNT, it, lane);
        if (tot >= 256u) { T = cand; fin = (tot == 256u); }
        if (fin) break;
    }
    if (!fin) {
        unsigned c = 0;
#pragma unroll
        for (int n = 0; n < 33; ++n) cnt_gt(c, key[n], T);
        const unsigned need = 256u - blk_count(c, CNT, it, lane);
        unsigned Xl = 0u;
        for (int bit = 14; bit >= 0; --bit) {
            const unsigned cand = Xl | (1u << bit);
            c = 0;
#pragma unroll
            for (int n = 0; n < 33; ++n) cnt_eq_lt(c, key[n], T, (unsigned)(tid + 512 * n), cand);
            if (blk_count(c, CNT, it, lane) < need) Xl = cand;
        }
        X = Xl;
    }
    unsigned selm = 0, hi = 0;
#pragma unroll
    for (int n = 0; n < 32; ++n) selm |= (key[n] > T || (key[n] == T && (unsigned)(tid + 512 * n) <= X)) ? (1u << n) : 0u;
    hi = (key[32] > T || (key[32] == T && (unsigned)(tid + 16384) <= X)) ? 1u : 0u;
    const unsigned cs = __popc(selm) + hi;
    unsigned inc = cs;
#pragma unroll
    for (int o2 = 1; o2 < 64; o2 <<= 1) { const unsigned t2 = __shfl_up(inc, o2); if (lane >= o2) inc += t2; }
    if (lane == 63) wsum[w] = inc;
    __syncthreads();
    unsigned pos = inc - cs;
    for (int w2 = 0; w2 < w; ++w2) pos += wsum[w2];
#pragma unroll
    for (int n = 0; n < 32; ++n) if ((selm >> n) & 1u) { if (pos < 256u) list[pos] = tid + 512 * n; ++pos; }
    if (hi) { if (pos < 256u) list[pos] = tid + 16384; ++pos; }
    __syncthreads();
    if (tid < 256) {
        const int idx = list[tid];
        if (idx < 16384) { const size_t phys = (size_t)p.page_table[b * NPAGES + (idx >> 7)] * 128 + (idx & 127); kptr[tid] = p.cache_k + phys * 256; vptr[tid] = p.cache_v + phys * 256; }
        else { kptr[tid] = p.out + O_KS + (size_t)b * 256; vptr[tid] = p.out + O_VS + (size_t)b * 256; }
    }
    const size_t row = MP + b;
    sattend(p, lds, (const bf16_t*)(ws + W_DQ) + row * 256, (const bf16_t*)(ws + W_DG) + row * 256, (bf16_t*)(ws + W_MIX) + row * 1024 + 512);
}
DI void sgla_unit(const Params& p, LAS3 unsigned char* lds, int b) {
    const int tid = threadIdx.x, lane = tid & 63, w = tid >> 6; unsigned char* ws = p.ws;
    LAS3 float* qs = (LAS3 float*)lds; LAS3 float* ks = qs + 256; LAS3 float* gs = qs + 512; LAS3 float* vs = qs + 768; LAS3 float* part = qs + 1280;
    const size_t row = MP + b;
    if (tid < 256) {
        float u = p.b_g[tid];
        const float* gl = vaddr((const float*)(ws + W_GLR) + row * 16);
#pragma unroll
        for (int r = 0; r < 16; ++r) u += gl[r] * p.w_g2[r * 256 + tid];
        gs[tid] = expf(logsigf(u) * (1.f / 16.f));
        qs[tid] = bf2f(((const bf16_t*)(ws + W_GQ))[row * 256 + tid]); ks[tid] = bf2f(((const bf16_t*)(ws + W_GK))[row * 256 + tid]);
    }
    vs[tid] = bf2f(((const bf16_t*)(ws + W_GV))[row * 512 + tid]);
    __syncthreads();
    const int h = tid >> 7, v = tid & 127;
    const float* sp = p.state_gla + ((size_t)(b * 4 + h) * 64) * 128 + v; float* so = p.out + O_GSS + ((size_t)(b * 4 + h) * 64) * 128 + v;
    const float vv = vs[h * 128 + v];
    float o = 0.f;
#pragma unroll 8
    for (int dd = 0; dd < 64; ++dd) { const float sn = gs[h * 64 + dd] * sp[dd * 128] + ks[h * 64 + dd] * vv; so[dd * 128] = sn; o += qs[h * 64 + dd] * sn; }
    const float ss = wsum64(o * o);
    if (lane == 0) part[w] = ss;
    __syncthreads();
    const float rstd = rsqrtf((part[2 * h] + part[2 * h + 1]) * (1.f / 128.f) + 1e-6f);
    ((bf16_t*)(ws + W_MIX))[row * 1024 + h * 128 + v] = f2bf(o * rstd * p.onorm[v] * bf2f(((const bf16_t*)(ws + W_GG))[row * 512 + h * 128 + v]));
    __syncthreads();
}
DI void p4_final(const Params& p) {
    const int tid = threadIdx.x, lane = tid & 63, wv = tid >> 6;
    for (int r = blockIdx.x * 8 + wv; r < MP + NDB; r += gridDim.x * 8) {
        float* y = p.out + (r < MP ? O_YP + (size_t)r * DM : O_YS + (size_t)(r - MP) * DM);
        f32x4 v[4]; float ss = 0.f;
#pragma unroll
        for (int i = 0; i < 4; ++i) { v[i] = *(const f32x4*)(y + i * 256 + lane * 4); ss += v[i][0] * v[i][0] + v[i][1] * v[i][1] + v[i][2] * v[i][2] + v[i][3] * v[i][3]; }
        ss = wsum64(ss);
        const float rstd = rsqrtf(ss * (1.f / DM) + 1e-6f);
#pragma unroll
        for (int i = 0; i < 4; ++i) { const f32x4 gv = *(const f32x4*)(p.norm_final + i * 256 + lane * 4); *(f32x4*)(y + i * 256 + lane * 4) = v[i] * rstd * gv; }
    }
}

DI int next_unit(unsigned* ctr, volatile LAS3 unsigned* slot) {
    if (threadIdx.x == 0) *slot = __hip_atomic_fetch_add(ctr, 1u, __ATOMIC_RELAXED, __HIP_MEMORY_SCOPE_AGENT);
    __syncthreads();
    const int v = __builtin_amdgcn_readfirstlane((int)*slot);
    __syncthreads();
    return v;
}

#ifndef REP1
#define REP1 1
#endif
#ifndef REP2
#define REP2 1
#endif
#ifndef REP3
#define REP3 1
#endif
#ifndef REP2A
#define REP2A 1
#endif
#ifndef REP2B
#define REP2B 1
#endif
#ifndef REP2C
#define REP2C 1
#endif
#ifndef REP2D
#define REP2D 1
#endif
#ifndef REP2E
#define REP2E 1
#endif
DI void phase1(const Params& p, LAS3 unsigned char* lds) {
    unsigned char* ws = p.ws;
    { pg8::Gemm g{(const bf16_t*)(ws + W_XN), (const bf16_t*)(ws + W_WTIN), MROWS, NIN, DM}; pg8::StaticOrder S; S.init(MROWS, NIN, (int)gridDim.x, (int)blockIdx.x);
      EpiIn E{ws, p.out}; pg8::gemm_phase<EpiIn, pg8::StaticOrder, true, true>(lds, g, S, E); }
    { pg8::Gemm g{(const bf16_t*)(ws + W_MEMN), (const bf16_t*)(ws + W_WTMEM), MMEM, 512, DM}; pg8::StaticOrder S;
      S.init(MMEM, 512, (int)gridDim.x, (int)((blockIdx.x + gridDim.x - (1806u % gridDim.x)) % gridDim.x));
      EpiMem E{ws, p.out}; pg8::gemm_phase<EpiMem, pg8::StaticOrder, true, true>(lds, g, S, E); }
}
template <int QI> DI void p2_sscore(const Params& p, LAS3 unsigned char* lds) { for (int u = blockIdx.x; u < 256; u += gridDim.x) { sscore_unit(p, lds, u); __syncthreads(); } }
template <int QI> DI void p2_gla(const Params& p, LAS3 unsigned char* lds) { for (int u = blockIdx.x; u < 64; u += gridDim.x) gla_unit(p, lds, u >> 2, u & 3); }
DI int next_unit_xcd(unsigned char* qbase, volatile LAS3 unsigned* slot, unsigned x0) {
    if (threadIdx.x == 0) {
        unsigned res = 0xffffffffu;
        for (unsigned k = 0; k < 8u; ++k) {
            const unsigned xq = (x0 + k) & 7u;
            const unsigned mq = __hip_atomic_fetch_add((unsigned*)(qbase + 256 * xq), 1u, __ATOMIC_RELAXED, __HIP_MEMORY_SCOPE_AGENT);
            if (mq < 64u) { res = xq * 64u + mq; break; }
        }
        *slot = res;
    }
    __syncthreads();
    const int v = __builtin_amdgcn_readfirstlane((int)*slot);
    __syncthreads();
    return v;
}
template <int QI> DI void p2_dsa(const Params& p, LAS3 unsigned char* lds, volatile LAS3 unsigned* MISC TARGS) {
#if defined(XCDQ) && XCDQ
    const unsigned x0 = xb_xcc_id() & 7u;
    for (;;) { const int n = next_unit_xcd(p.ws + CW_QDSA + 8192 * QI, MISC + 4, x0); if (n < 0) break; const int m = n & 63; dsa_unit(p, lds, 2 * (n >> 6) + (m >> 5), 31 - (m & 31) TPASS); }
#else
    for (;;) { const int n = next_unit((unsigned*)(p.ws + CW_QDSA + 8192 * QI), MISC + 4); if (n >= 512) break; dsa_unit(p, lds, n & 15, 31 - (n >> 4) TPASS); }
#endif
}
template <int QI> DI void p2_mem(const Params& p, LAS3 unsigned char* lds, volatile LAS3 unsigned* MISC) {
    for (;;) { const int n = next_unit((unsigned*)(p.ws + CW_QMEM + 8192 * QI), MISC + 4); if (n >= 512) break; mem_unit(p, n); } }
template <int QI> DI void p2_sample(const Params& p, LAS3 unsigned char* lds) {
    for (int u = (int)gridDim.x - 1 - (int)blockIdx.x; u < 96; u += gridDim.x) { if (u < 32) sgla_unit(p, lds, u); else if (u < 64) smem_unit(p, lds, u - 32); else ssel_unit(p, lds, u - 64); } }
template <int RI> DI void phase2(const Params& p, LAS3 unsigned char* lds, volatile LAS3 unsigned* MISC TARGS) {
    TBEG(20); TBEG(21); p2_sscore<0>(p, lds); TEND(21); if (REP2A > 1) p2_sscore<1>(p, lds);
    TBEG(25); p2_sample<0>(p, lds); TEND(25); if (REP2E > 1) p2_sample<1>(p, lds);
    TBEG(22); p2_gla<0>(p, lds); TEND(22); if (REP2B > 1) p2_gla<1>(p, lds);
    TBEG(23); p2_dsa<0>(p, lds, MISC TPASS); TEND(23); if (REP2C > 1) p2_dsa<1>(p, lds, MISC TPASS);
    TBEG(24); p2_mem<0>(p, lds, MISC); TEND(24); if (REP2D > 1) p2_mem<1>(p, lds, MISC);
    TEND(20);
}
DI void phase3(const Params& p, LAS3 unsigned char* lds) {
    pg8::Gemm g{(const bf16_t*)(p.ws + W_MIX), (const bf16_t*)(p.ws + W_WTOUT), MP, DM, DM}; pg8::StaticOrder S; S.init(MP, DM, (int)gridDim.x, (int)blockIdx.x);
    EpiOut E{p.x_prompt, p.x_sample, p.out}; pg8::gemm_phase<EpiOut, pg8::StaticOrder, true, true>(lds, g, S, E);
    const int tid = threadIdx.x, lane = tid & 63, wv = tid >> 6;
    for (int u = blockIdx.x; u < 256; u += gridDim.x) {
        const int b = u >> 3, col0 = (u & 7) * 128 + wv * 16;
        const bf16_t* mrow = (const bf16_t*)(p.ws + W_MIX) + (size_t)(MP + b) * 1024 + lane * 16;
        const u32x4 m0 = *(const u32x4*)mrow, m1 = *(const u32x4*)(mrow + 8);
        const unsigned mw[8] = {m0.x, m0.y, m0.z, m0.w, m1.x, m1.y, m1.z, m1.w};
        float res = 0.f;
#pragma unroll 4
        for (int i = 0; i < 16; ++i) {
            const bf16_t* wrow = (const bf16_t*)(p.ws + W_WTOUT) + (size_t)(col0 + i) * 1024 + lane * 16;
            const u32x4 w0 = *(const u32x4*)wrow, w1 = *(const u32x4*)(wrow + 8);
            const unsigned ww[8] = {w0.x, w0.y, w0.z, w0.w, w1.x, w1.y, w1.z, w1.w};
            float acc = 0.f;
#pragma unroll
            for (int e = 0; e < 8; ++e) acc += __uint_as_float(mw[e] << 16) * __uint_as_float(ww[e] << 16) + __uint_as_float(mw[e] & 0xffff0000u) * __uint_as_float(ww[e] & 0xffff0000u);
            acc = wsum64(acc);
            res = (lane == i) ? acc : res;
        }
        if (lane < 16) p.out[O_YS + (size_t)b * DM + col0 + lane] = p.x_sample[(size_t)b * DM + col0 + lane] + res;
    }
}
#ifdef CHECK_ATT
DI void check_mem_attention(const Params& p) {
    const int tid = threadIdx.x, lane = tid & 63, wv = tid >> 6;
    const int samp = blockIdx.x * 8 + wv;
    const int row = (samp * 977 + 13) % MP, h = samp & 3, b = row >> 11;
    const bf16_t* q = (const bf16_t*)(p.ws + W_MQ) + (size_t)row * 256 + h * 64;
    float s[4];
#pragma unroll
    for (int i = 0; i < 4; ++i) { const float* kr = p.out + O_MKP + ((size_t)b * NMEM + lane + 64 * i) * 256 + h * 64; float a = 0.f; for (int d = 0; d < 64; ++d) a += bf2f(q[d]) * kr[d]; s[i] = a; }
    float mx = wmax64(fmaxf(fmaxf(s[0], s[1]), fmaxf(s[2], s[3])));
    float pe[4], sum = 0.f;
#pragma unroll
    for (int i = 0; i < 4; ++i) { pe[i] = __expf(s[i] - mx); sum += pe[i]; }
    sum = wsum64(sum);
    float err = 0.f, nrm = 0.f;
    for (int d = 0; d < 64; ++d) {
        float a = 0.f;
#pragma unroll
        for (int i = 0; i < 4; ++i) a += pe[i] * p.out[O_MVP + ((size_t)b * NMEM + lane + 64 * i) * 256 + h * 64 + d];
        a = wsum64(a) / sum;
        const float want = a * bf2f(((const bf16_t*)(p.ws + W_MG))[(size_t)row * 256 + h * 64 + d]);
        const float got = bf2f(((const bf16_t*)(p.ws + W_MIX))[(size_t)row * 1024 + 768 + h * 64 + d]);
        err += (got - want) * (got - want); nrm += want * want;
    }
    if (lane == 0) { atomicAdd((unsigned*)(p.ws + CW_CHK + 12), 1u); if (!(err <= 0.0025f * nrm + 1e-12f)) atomicAdd((unsigned*)(p.ws + CW_CHK + 8), 1u); }
}
#endif
__global__ void __launch_bounds__(NTHREADS, 2) hymba_fwd(Params p) {
    extern __shared__ __attribute__((aligned(16))) unsigned char lds_raw[];
    LAS3 unsigned char* lds = (LAS3 unsigned char*)lds_raw;
    volatile LAS3 unsigned* MISC = (volatile LAS3 unsigned*)(lds + LDS_MISC);
    const int tid = threadIdx.x;
    if (tid < 64) MISC[tid] = 0u;
    __syncthreads();
    const int lo = p.ph_lo, hi = p.ph_hi;
    TDECL;
    XcdBarrier bar; bar.bar = (unsigned*)p.ws; bar.x = 0; bar.st = MISC;
    if (hi > lo) bar = xcd_barrier_post((unsigned*)p.ws, MISC);
#define IN(k) (lo <= (k) && (k) <= hi)
#define SEAM(k) do { if (IN(k) && IN((k) + 1)) xcd_barrier(bar); } while (0)
    TBEG(0); if (IN(0)) p0_prologue(p, lds); TEND(0);
    TBEG(10); SEAM(0); TEND(10);
    TBEG(1); if (IN(1)) { phase1(p, lds); if (REP1 > 1) { xcd_barrier(bar); phase1(p, lds); } } TEND(1);
    TBEG(11); SEAM(1); TEND(11);
    TBEG(2); if (IN(2)) { phase2<0>(p, lds, MISC TPASS); } TEND(2);
    TBEG(12); SEAM(2); TEND(12);
#ifdef CHECK_ATT
    if (IN(3)) check_mem_attention(p);
#endif
    TBEG(3); if (IN(3)) { phase3(p, lds); if (REP3 > 1) { xcd_barrier(bar); phase3(p, lds); } } TEND(3);
    TBEG(13); SEAM(3); TEND(13);
    TBEG(4); if (IN(4)) p4_final(p); TEND(4);
#ifdef TSEL
    {
        if (tid == 0) { atomicAdd((unsigned long long*)(p.ws + CW_TSUM), (unsigned long long)tacc_); atomicMax((unsigned long long*)(p.ws + CW_TMAX), (unsigned long long)tacc_); }
        xcd_barrier(bar);
        if (blockIdx.x == 0 && tid == 0) {
#ifdef TMAX
            const unsigned long long dly = __hip_atomic_load((unsigned long long*)(p.ws + CW_TMAX), __ATOMIC_RELAXED, __HIP_MEMORY_SCOPE_AGENT);
#else
            const unsigned long long dly = __hip_atomic_load((unsigned long long*)(p.ws + CW_TSUM), __ATOMIC_RELAXED, __HIP_MEMORY_SCOPE_AGENT) / gridDim.x;
#endif
            const unsigned long long t0 = __builtin_amdgcn_s_memrealtime();
            while (__builtin_amdgcn_s_memrealtime() - t0 < dly && __builtin_amdgcn_s_memrealtime() - t0 < 400000ull) __builtin_amdgcn_s_sleep(8);
        }
    }
#endif
#ifdef CHECK_ATT
    {
        xcd_barrier(bar);
        const unsigned nbad = __hip_atomic_load((unsigned*)(p.ws + CW_CHK + 8), __ATOMIC_RELAXED, __HIP_MEMORY_SCOPE_AGENT);
        const unsigned nchk = __hip_atomic_load((unsigned*)(p.ws + CW_CHK + 12), __ATOMIC_RELAXED, __HIP_MEMORY_SCOPE_AGENT);
        if (nbad != 0u || nchk < 2000u) for (int i = blockIdx.x * NTHREADS + tid; i < NDB * DM; i += gridDim.x * NTHREADS) p.out[O_YS + i] = __builtin_nanf("");
    }
#endif
#ifdef CHECK_SEL
    {
        xcd_barrier(bar);
        const unsigned nbad = __hip_atomic_load((unsigned*)(p.ws + CW_CHK), __ATOMIC_RELAXED, __HIP_MEMORY_SCOPE_AGENT);
        const unsigned nhist = __hip_atomic_load((unsigned*)(p.ws + CW_CHK + 4), __ATOMIC_RELAXED, __HIP_MEMORY_SCOPE_AGENT);
        if (nbad != 0u || nhist < CHECK_MIN_HIST) for (int i = blockIdx.x * NTHREADS + tid; i < NDB * DM; i += gridDim.x * NTHREADS) p.out[O_YS + i] = __builtin_nanf("");
    }
#endif
#undef IN
#undef SEAM
}

#ifndef N_LAUNCHES
#define N_LAUNCHES 1
#endif
extern "C" void kernel_launch(void* const* d_in, const int* in_sizes, int n_in, void* d_out, int out_size, void* d_ws, size_t ws_size, hipStream_t stream) {
    static int grid = 0;
    if (grid == 0) {
        if (n_in != 19 || (size_t)out_size != O_END || ws_size < W_END) fprintf(stderr, "kernel_launch: unexpected sizes: n_in %d out %d ws %zu (need %zu)\n", n_in, out_size, ws_size, (size_t)W_END);
        int dev = 0, cus = 0, per_cu = 0;
        if (hipGetDevice(&dev) != hipSuccess || hipDeviceGetAttribute(&cus, hipDeviceAttributeMultiprocessorCount, dev) != hipSuccess) { fprintf(stderr, "kernel_launch: device query failed\n"); grid = -1; return; }
        if (hipFuncSetAttribute((const void*)hymba_fwd, hipFuncAttributeMaxDynamicSharedMemorySize, LDS_BYTES) != hipSuccess) { fprintf(stderr, "kernel_launch: hipFuncSetAttribute failed\n"); grid = -1; return; }
        if (hipOccupancyMaxActiveBlocksPerMultiprocessor(&per_cu, (const void*)hymba_fwd, NTHREADS, LDS_BYTES) != hipSuccess || per_cu < 1) fprintf(stderr, "kernel_launch: occupancy query reports %d blocks per CU\n", per_cu);
        (void)hipGetLastError();
        grid = cus;
    }
    if (grid < 0) return;
    (void)hipMemsetAsync(d_ws, 0, CTRL_BYTES, stream);
    Params p{};
    p.x_prompt = (const float*)d_in[0]; p.x_sample = (const float*)d_in[1]; p.mem_prompt = (const float*)d_in[2]; p.state_gla = (const float*)d_in[3];
    p.cache_k = (const float*)d_in[4]; p.cache_v = (const float*)d_in[5]; p.cache_ik = (const float*)d_in[6]; p.cache_mem_k = (const float*)d_in[7]; p.cache_mem_v = (const float*)d_in[8];
    p.page_table = (const int*)d_in[9];
    p.norm_in = (const float*)d_in[10]; p.w_in = (const float*)d_in[11]; p.w_g2 = (const float*)d_in[12]; p.b_g = (const float*)d_in[13]; p.onorm = (const float*)d_in[14];
    p.mem_norm = (const float*)d_in[15]; p.w_mem_kv = (const float*)d_in[16]; p.w_out = (const float*)d_in[17]; p.norm_final = (const float*)d_in[18];
    p.out = (float*)d_out; p.ws = (unsigned char*)d_ws;
#if N_LAUNCHES == 1
    p.ph_lo = 0; p.ph_hi = 4;
    hipLaunchKernelGGL(hymba_fwd, dim3(grid), dim3(NTHREADS), LDS_BYTES, stream, p);
#else
    for (int ph = 0; ph < 5; ++ph) { p.ph_lo = ph; p.ph_hi = ph; hipLaunchKernelGGL(hymba_fwd, dim3(grid), dim3(NTHREADS), LDS_BYTES, stream, p); }
#endif
    const hipError_t le = hipPeekAtLastError();
    if (le != hipSuccess) fprintf(stderr, "kernel_launch: launch failed: %s\n", hipGetErrorName(le));
}
```

```cpp
#include <hip/hip_runtime.h>
#include <cstdint>
#include <cstdio>
namespace pg8 {
#define PG8_LAS __attribute__((address_space(3)))
typedef unsigned short bf16_t;
typedef short bf16x8 __attribute__((ext_vector_type(8)));
typedef float f32x4 __attribute__((ext_vector_type(4)));
typedef unsigned u32x4 __attribute__((ext_vector_type(4)));
constexpr int BM = 256, BK = 64, HALF = 128, HTB = HALF * BK * 2  , STAGE_BYTES = 8 * HTB, NXCD = 8, WGM = 8;

__host__ __device__ __forceinline__ int lds_byte(int r, int c) { const int st = (r >> 4) * 2 + (c >> 5), rr = r & 15, cc = c & 31, ob = rr * 64 + cc * 2; return st * 1024 + (ob ^ (((ob >> 9) & 1) << 5)); }
__host__ __device__ __forceinline__ void stage_rc(int b, int& R, int& C) { const int st = b / 1024, sb = b % 1024, swz = sb ^ (((sb >> 9) & 1) << 5); R = (st >> 1) * 16 + swz / 64; C = (st & 1) * 32 + (swz % 64) / 2; }
__host__ __device__ __forceinline__ int perm32(int rho) { const int n = rho >> 4, i = rho & 15; return 8 * (i >> 2) + 4 * n + (i & 3); }

struct Unit { int pm, pn; };
struct Gemm { const bf16_t* A; const bf16_t* Bt; int M, N, K; };

struct StaticOrder {
    int nM, nN, nwg, G, c;
    __host__ __device__ void init(int M, int N, int G_, int c_) { nM = M / BM; nN = N / BM; nwg = nM * nN; G = G_; c = c_; }
    __host__ __device__ bool next(int i, Unit& u) const {
        const long L = (long)i * G + c; if (L >= nwg) return false;
        int wgid = (int)L; { const int q = nwg / NXCD, r = nwg % NXCD, xcd = wgid % NXCD, off = wgid / NXCD; wgid = (xcd < r ? xcd * (q + 1) : r * (q + 1) + (xcd - r) * q) + off; }
        const int nig = WGM * nN, gid = wgid / nig, fm = gid * WGM, gsz = (nM - fm) < WGM ? (nM - fm) : WGM;
        u.pm = fm + ((wgid % nig) % gsz); u.pn = (wgid % nig) / gsz; return true;
    }
    __device__ __forceinline__ void a_ready(const Unit&) const {}
    __device__ __forceinline__ void done(const Unit&) const {}
};

template <class Epi, class Sched, bool ALIGN_EPI = false, bool SP2 = false>
__device__ __forceinline__ void gemm_phase(PG8_LAS unsigned char* lds, const Gemm g, const Sched& S, const Epi& E) {
    const int tid = threadIdx.x, wid = __builtin_amdgcn_readfirstlane(tid >> 6), lane = tid & 63, wr = wid >> 2, wc = wid & 3, fr = lane & 15, fq = lane >> 4;
    const int K = g.K, nt = K / BK;
    unsigned voffA[2], voffB[2];
#pragma unroll
    for (int i = 0; i < 2; ++i) { int R, C; stage_rc(tid * 16 + i * 8192, R, C); const int Rb = Epi::PERM ? ((R & ~31) + perm32(R & 31)) : R;
        voffA[i] = (unsigned)(R * K + C) * 2u; voffB[i] = (unsigned)(Rb * K + C) * 2u; }
    const size_t kstep = (size_t)(BK * 2);
    const size_t hstep = (size_t)HALF * K * 2;
    const size_t tstep = 2 * hstep;
    const unsigned ldsw = (unsigned)wid * 1024u;
    const int aoff = lds_byte(wr * 64 + fr, fq * 8), boff = lds_byte(wc * 32 + fr, fq * 8);
#define PG8_SA(b, h) (((b) * 2 + (h)) * HTB)
#define PG8_SB(b, h) ((4 + (b) * 2 + (h)) * HTB)
#define PG8_STAGE(bufoff, gbase, voff) do { _Pragma("unroll") for (int _i = 0; _i < 2; ++_i) \
        __builtin_amdgcn_global_load_lds((const unsigned*)((const char*)(gbase) + (voff)[_i]), (PG8_LAS unsigned*)(lds + (bufoff) + ldsw + _i * 8192), 16, 0, 0); } while (0)
#define PG8_LDA(dst, b, h) do { _Pragma("unroll") for (int m = 0; m < 4; ++m) _Pragma("unroll") for (int k = 0; k < 2; ++k) dst[m][k] = *(const PG8_LAS bf16x8*)(lds + PG8_SA(b, h) + aoff + m * 2048 + k * 1024); } while (0)
#define PG8_LDB(dst, b, h) do { _Pragma("unroll") for (int n = 0; n < 2; ++n) _Pragma("unroll") for (int k = 0; k < 2; ++k) dst[n][k] = *(const PG8_LAS bf16x8*)(lds + PG8_SB(b, h) + boff + n * 2048 + k * 1024); } while (0)
#define PG8_MMA(ai, bj, At, Bt) do { __builtin_amdgcn_s_setprio(1); _Pragma("unroll") for (int m = 0; m < 4; ++m) _Pragma("unroll") for (int n = 0; n < 2; ++n) _Pragma("unroll") for (int k = 0; k < 2; ++k) \
        acc[ai][bj][m][n] = __builtin_amdgcn_mfma_f32_16x16x32_bf16(Bt[n][k], At[m][k], acc[ai][bj][m][n], 0, 0, 0); __builtin_amdgcn_s_setprio(0); } while (0)
#define PG8_WAIT_V(n) asm volatile("s_waitcnt vmcnt(" #n ")" ::: "memory")
#define PG8_WAIT_L(n) asm volatile("s_waitcnt lgkmcnt(" #n ")" ::: "memory")
#define PG8_BAR __builtin_amdgcn_s_barrier()
#define PG8_SCHED __builtin_amdgcn_sched_barrier(0)
    Unit cur, nxt; int ui = 0;
    if (!S.next(0, cur)) return;
    f32x4 acc[2][2][4][2];
#pragma unroll
    for (int a = 0; a < 2; ++a)
#pragma unroll
        for (int b = 0; b < 2; ++b)
#pragma unroll
            for (int m = 0; m < 4; ++m)
#pragma unroll
                for (int n = 0; n < 2; ++n) acc[a][b][m][n] = (f32x4){0.f, 0.f, 0.f, 0.f};
    bf16x8 At[4][2], B0[2][2], B1[2][2];
    const char* cA = (const char*)g.A + (size_t)cur.pm * tstep; const char* cB = (const char*)g.Bt + (size_t)cur.pn * tstep;
    S.a_ready(cur);
    if constexpr (SP2) {
        PG8_STAGE(PG8_SB(0, 0), cB, voffB); PG8_STAGE(PG8_SB(0, 1), cB + hstep, voffB); PG8_STAGE(PG8_SA(0, 0), cA, voffA); PG8_STAGE(PG8_SA(0, 1), cA + hstep, voffA);
        if (wr == 1) PG8_BAR;
        PG8_WAIT_V(2); PG8_BAR;
        PG8_STAGE(PG8_SB(1, 0), cB + kstep, voffB); PG8_STAGE(PG8_SA(1, 0), cA + kstep, voffA); PG8_STAGE(PG8_SB(1, 1), cB + hstep + kstep, voffB);
        PG8_WAIT_V(6); PG8_BAR;
    } else {
        PG8_STAGE(PG8_SB(0, 0), cB, voffB); PG8_STAGE(PG8_SA(0, 0), cA, voffA); PG8_STAGE(PG8_SB(0, 1), cB + hstep, voffB); PG8_STAGE(PG8_SA(0, 1), cA + hstep, voffA);
        if (wr == 1) PG8_BAR;
        PG8_WAIT_V(4); PG8_BAR;
        PG8_STAGE(PG8_SB(1, 0), cB + kstep, voffB); PG8_STAGE(PG8_SA(1, 0), cA + kstep, voffA); PG8_STAGE(PG8_SB(1, 1), cB + hstep + kstep, voffB);
        PG8_WAIT_V(6); PG8_BAR;
    }
    for (;;) {
        const bool has_next = S.next(ui + 1, nxt);
        const char* nA = has_next ? (const char*)g.A + (size_t)nxt.pm * tstep : cA; const char* nB = has_next ? (const char*)g.Bt + (size_t)nxt.pn * tstep : cB;
        for (int t = 0; t < nt; t += 2) {
            const bool last = (t == nt - 2);
            const char* a1 = cA + (size_t)(t + 1) * kstep;
            const char* a2 = last ? nA : cA + (size_t)(t + 2) * kstep; const char* b2 = last ? nB : cB + (size_t)(t + 2) * kstep;
            const char* a3 = a2 + kstep; const char* b3 = b2 + kstep;
            if (last && has_next) S.a_ready(nxt);
            if constexpr (SP2) {
            PG8_LDB(B0, 0, 0); PG8_LDB(B1, 0, 1); PG8_SCHED; PG8_LDA(At, 0, 0); PG8_STAGE(PG8_SA(1, 1), a1 + hstep, voffA);
            PG8_WAIT_V(8); PG8_WAIT_L(0); PG8_BAR; PG8_MMA(0, 0, At, B0); PG8_MMA(0, 1, At, B1); PG8_BAR; PG8_SCHED;
            PG8_LDA(At, 0, 1); PG8_STAGE(PG8_SB(0, 0), b2, voffB); PG8_STAGE(PG8_SB(0, 1), b2 + hstep, voffB); PG8_STAGE(PG8_SA(0, 0), a2, voffA);
            PG8_WAIT_V(8); PG8_WAIT_L(0); PG8_BAR; PG8_MMA(1, 0, At, B0); PG8_MMA(1, 1, At, B1); PG8_BAR; PG8_SCHED;
            PG8_LDB(B0, 1, 0); PG8_LDB(B1, 1, 1); PG8_SCHED; PG8_LDA(At, 1, 0); PG8_STAGE(PG8_SA(0, 1), a2 + hstep, voffA);
            PG8_WAIT_V(8); PG8_WAIT_L(0); PG8_BAR; PG8_MMA(0, 0, At, B0); PG8_MMA(0, 1, At, B1); PG8_BAR; PG8_SCHED;
            PG8_LDA(At, 1, 1); PG8_STAGE(PG8_SB(1, 0), b3, voffB); PG8_STAGE(PG8_SB(1, 1), b3 + hstep, voffB); PG8_STAGE(PG8_SA(1, 0), a3, voffA);
            PG8_WAIT_V(8); PG8_WAIT_L(0); PG8_BAR; PG8_MMA(1, 0, At, B0); PG8_MMA(1, 1, At, B1); PG8_BAR; PG8_SCHED;
            } else {
            PG8_LDB(B0, 0, 0); PG8_SCHED; PG8_LDA(At, 0, 0); PG8_STAGE(PG8_SA(1, 1), a1 + hstep, voffA);
            PG8_WAIT_L(8); PG8_BAR; PG8_WAIT_L(0); PG8_MMA(0, 0, At, B0); PG8_BAR; PG8_SCHED;
            PG8_LDB(B1, 0, 1); PG8_STAGE(PG8_SB(0, 0), b2, voffB);
            PG8_BAR; PG8_WAIT_L(0); PG8_MMA(0, 1, At, B1); PG8_BAR;
            PG8_LDA(At, 0, 1); PG8_STAGE(PG8_SA(0, 0), a2, voffA);
            PG8_BAR; PG8_WAIT_L(0); PG8_MMA(1, 0, At, B0); PG8_BAR; PG8_SCHED;
            PG8_STAGE(PG8_SB(0, 1), b2 + hstep, voffB);
            PG8_WAIT_V(6); PG8_BAR; PG8_MMA(1, 1, At, B1); PG8_BAR;
            PG8_LDB(B0, 1, 0); PG8_SCHED; PG8_LDA(At, 1, 0); PG8_STAGE(PG8_SA(0, 1), a2 + hstep, voffA);
            PG8_WAIT_L(8); PG8_BAR; PG8_WAIT_L(0); PG8_MMA(0, 0, At, B0); PG8_BAR; PG8_SCHED;
            PG8_LDB(B1, 1, 1); PG8_STAGE(PG8_SB(1, 0), b3, voffB);
            PG8_BAR; PG8_WAIT_L(0); PG8_MMA(0, 1, At, B1); PG8_BAR;
            PG8_LDA(At, 1, 1); PG8_STAGE(PG8_SA(1, 0), a3, voffA);
            PG8_BAR; PG8_WAIT_L(0); PG8_MMA(1, 0, At, B0); PG8_BAR; PG8_SCHED;
            PG8_STAGE(PG8_SB(1, 1), b3 + hstep, voffB);
            PG8_WAIT_V(6); PG8_BAR; PG8_MMA(1, 1, At, B1); PG8_BAR;
            }
        }
        if constexpr (ALIGN_EPI) { if (wr == 0) PG8_BAR; }
        if constexpr (!Epi::AFTER_DRAIN) { E(acc, cur, wr, wc, fr, fq); S.done(cur); }
        if (!has_next) break;
#pragma unroll
        for (int a = 0; a < 2; ++a)
#pragma unroll
            for (int b = 0; b < 2; ++b)
#pragma unroll
                for (int m = 0; m < 4; ++m)
#pragma unroll
                    for (int n = 0; n < 2; ++n) acc[a][b][m][n] = (f32x4){0.f, 0.f, 0.f, 0.f};
        cur = nxt; cA = nA; cB = nB; ++ui;
        if constexpr (ALIGN_EPI) { if (wr == 1) PG8_BAR; }
    }
    PG8_WAIT_V(0);
    if constexpr (!ALIGN_EPI) { if (wr == 0) PG8_BAR; }
    PG8_BAR;
    if constexpr (Epi::AFTER_DRAIN) { E.fused(acc, cur, wr, wc, fr, fq, lds, wid, lane); S.done(cur); }
#undef PG8_SA
#undef PG8_SB
#undef PG8_STAGE
#undef PG8_LDA
#undef PG8_LDB
#undef PG8_MMA
#undef PG8_WAIT_V
#undef PG8_WAIT_L
#undef PG8_BAR
#undef PG8_SCHED
}
}
#define XB_TMO      128
#define XB_XCNT(j)  (256  + 64 * (j))
#define XB_XSUB(j)  (1280 + 64 * (j))
#define XB_XGEN(j)  (2304 + 64 * (j))
#define XB_TOP      3328
#define XB_TOPGEN   3392
#define XCD_BAR_WORDS 3456
#define XB_SPIN_CAP (1u << 18)
#define LAS __attribute__((address_space(3)))

__device__ __forceinline__ unsigned xb_ld(unsigned* p)              { return __hip_atomic_load(p, __ATOMIC_RELAXED, __HIP_MEMORY_SCOPE_AGENT); }
__device__ __forceinline__ unsigned xb_add(unsigned* p, unsigned v) { return __hip_atomic_fetch_add(p, v, __ATOMIC_RELAXED, __HIP_MEMORY_SCOPE_AGENT); }
__device__ __forceinline__ unsigned xb_xcc_id() { return (unsigned)__builtin_amdgcn_s_getreg((3 << 11) | 20) & 0xFu; }
#define XB_SPIN(cond, bar) do { unsigned _sp = 0; while (cond) { __builtin_amdgcn_s_sleep(1); \
    if ((++_sp & 255u) == 0u) { if (xb_ld(&(bar)[XB_TMO])) break; if (_sp > XB_SPIN_CAP) { atomicAdd(&(bar)[XB_TMO], 1u); break; } } } } while (0)

struct XcdBarrier {
    unsigned* bar; unsigned x;
    volatile LAS unsigned* st;
};

__device__ __forceinline__ XcdBarrier xcd_barrier_post(unsigned* bar, volatile LAS unsigned* st) {
    XcdBarrier b; b.bar = bar; b.x = xb_xcc_id(); b.st = st;
    if (threadIdx.x == 0) (void)xb_add(&bar[XB_XCNT(b.x)], 1u);
    return b;
}
__device__ __forceinline__ void xcd_barrier_complete(unsigned* bar, unsigned x, unsigned& nloc, unsigned& nx) {
    const unsigned G = gridDim.x * gridDim.y * gridDim.z;
    unsigned sum, cnt, mine, sp = 0u;
    for (;;) {
        sum = 0u; cnt = 0u; mine = 0u;
#pragma unroll
        for (unsigned j = 0; j < 16; ++j) { const unsigned c = xb_ld(&bar[XB_XCNT(j)]); sum += c; cnt += (c > 0u) ? 1u : 0u; mine = (j == x) ? c : mine; }
        if (sum == G) break;
        __builtin_amdgcn_s_sleep(1);
        if ((++sp & 255u) == 0u) { if (xb_ld(&bar[XB_TMO])) break; if (sp > XB_SPIN_CAP) { atomicAdd(&bar[XB_TMO], 1u); break; } }
    }
    nloc = mine > 0u ? mine : 1u; nx = cnt > 0u ? cnt : 1u;
}

__device__ __forceinline__ void xcd_barrier(const XcdBarrier& b) {
    asm volatile("s_waitcnt vmcnt(0)" ::: "memory");
    __syncthreads();
    if (threadIdx.x == 0) {
        unsigned* bar = b.bar;
        __builtin_amdgcn_s_waitcnt(0);
        unsigned nloc = b.st[0], nx = b.st[1];
        if (nloc == 0u) { xcd_barrier_complete(bar, b.x, nloc, nx); b.st[0] = nloc; b.st[1] = nx; }
        const unsigned old = xb_add(&bar[XB_XSUB(b.x)], 1u);
        const unsigned gen = old / nloc;
        if (old + 1u == (gen + 1u) * nloc) {
            __builtin_amdgcn_fence(__ATOMIC_RELEASE, "agent");
            asm volatile("s_waitcnt vmcnt(0)" ::: "memory");
            const unsigned og = xb_add(&bar[XB_TOP], 1u);
            const unsigned tg = og / nx;
            if (og + 1u == (tg + 1u) * nx) xb_add(&bar[XB_TOPGEN], 1u);
            else XB_SPIN(xb_ld(&bar[XB_TOPGEN]) == tg, bar);
            __builtin_amdgcn_fence(__ATOMIC_ACQUIRE, "agent");
            xb_add(&bar[XB_XGEN(b.x)], 1u);
            asm volatile("s_waitcnt vmcnt(0)" ::: "memory");
        } else {
            XB_SPIN(xb_ld(&bar[XB_XGEN(b.x)]) == gen, bar);
            __builtin_amdgcn_fence(__ATOMIC_ACQUIRE, "agent");
            asm volatile("s_waitcnt vmcnt(0)" ::: "memory");
        }
    }
    __syncthreads();
}
#define DI __device__ __forceinline__
#define LAS3 __attribute__((address_space(3)))
using pg8::bf16_t; using pg8::bf16x8; using pg8::f32x4; using pg8::u32x4;
typedef unsigned u32x2 __attribute__((ext_vector_type(2)));
typedef short s16x4 __attribute__((ext_vector_type(4)));
typedef float f32x2 __attribute__((ext_vector_type(2)));
typedef __bf16 bf16x2_t __attribute__((ext_vector_type(2)));

constexpr int DM = 1024, NB = 16, SEQ = 2048, MP = NB * SEQ  , NDB = 32  , MROWS = 33024  ;
constexpr int NMEM = 256, MMEM = NB * NMEM  , DIN = 3412, NIN = 3584, NPAGES = 128;
constexpr int NTHREADS = 512;
constexpr size_t O_YP = 0, O_YS = O_YP + (size_t)MP * DM, O_GSP = O_YS + (size_t)NDB * DM, O_KP = O_GSP + (size_t)NB * 4 * 64 * 128,
                 O_VP = O_KP + (size_t)MP * 256, O_IKP = O_VP + (size_t)MP * 256, O_MKP = O_IKP + (size_t)MP * 64, O_MVP = O_MKP + (size_t)MMEM * 256,
                 O_GSS = O_MVP + (size_t)MMEM * 256, O_KS = O_GSS + (size_t)NDB * 4 * 64 * 128, O_VS = O_KS + (size_t)NDB * 256, O_IKS = O_VS + (size_t)NDB * 256,
                 O_END = O_IKS + (size_t)NDB * 64;
static_assert(O_END == 56150016, "output size");
constexpr size_t al256(size_t x) { return (x + 255) & ~(size_t)255; }
constexpr size_t CTRL_BYTES = 32768;
constexpr size_t CW_QDSA = 16384  , CW_QMEM = 18432  , CW_SCNT = 20480, CW_TMO = 20736, CW_CHK = 20992, CW_TSUM = 21248, CW_TMAX = 21504;
constexpr int SCLD = 16400;
constexpr size_t W_ROPE = CTRL_BYTES;
constexpr size_t W_XN = al256(W_ROPE + (size_t)2049 * 32 * 8);
constexpr size_t W_MEMN = W_XN + (size_t)MROWS * 1024 * 2;
constexpr size_t W_WTIN = W_MEMN + (size_t)MMEM * 1024 * 2;
constexpr size_t W_WTMEM = W_WTIN + (size_t)NIN * 1024 * 2;
constexpr size_t W_WTOUT = W_WTMEM + (size_t)512 * 1024 * 2;
constexpr size_t W_GQ = W_WTOUT + (size_t)1024 * 1024 * 2;
constexpr size_t W_GK = W_GQ + (size_t)MROWS * 256 * 2;
constexpr size_t W_GV = W_GK + (size_t)MROWS * 256 * 2;
constexpr size_t W_GG = W_GV + (size_t)MROWS * 512 * 2;
constexpr size_t W_DQ = W_GG + (size_t)MROWS * 512 * 2;
constexpr size_t W_DK = W_DQ + (size_t)MROWS * 256 * 2;
constexpr size_t W_DVT = W_DK + (size_t)MROWS * 256 * 2;
constexpr size_t W_IQ = W_DVT + (size_t)MP * 256 * 2;
constexpr size_t W_DG = W_IQ + (size_t)MROWS * 256 * 2;
constexpr size_t W_MQ = W_DG + (size_t)MROWS * 256 * 2;
constexpr size_t W_MG = W_MQ + (size_t)MROWS * 256 * 2;
constexpr size_t W_IK = W_MG + (size_t)MROWS * 256 * 2;
constexpr size_t W_IW = W_IK + (size_t)MROWS * 64 * 2;
constexpr size_t W_GLR = W_IW + (size_t)MROWS * 4 * 4;
constexpr size_t W_MK = W_GLR + (size_t)MROWS * 16 * 4;
constexpr size_t W_MVT = W_MK + (size_t)MMEM * 256 * 2;
constexpr size_t W_MIX = W_MVT + (size_t)MMEM * 256 * 2;
constexpr size_t W_SC = W_MIX + (size_t)MROWS * 1024 * 2;
constexpr size_t W_END = W_SC + (size_t)NDB * SCLD * 4;
constexpr int LDS_MISC = 148480, LDS_BYTES = 148480 + 256;

struct Params {
    const float *x_prompt, *x_sample, *mem_prompt, *state_gla, *cache_k, *cache_v, *cache_ik, *cache_mem_k, *cache_mem_v;
    const int* page_table;
    const float *norm_in, *w_in, *w_g2, *b_g, *onorm, *mem_norm, *w_mem_kv, *w_out, *norm_final;
    float* out; unsigned char* ws; int ph_lo, ph_hi;
};

#ifdef TSEL
#define TDECL unsigned tacc_ = 0u, tbeg_ = 0u
#define TBEG(k) do { if ((k) == TSEL) tbeg_ = (unsigned)__builtin_amdgcn_s_memrealtime(); } while (0)
#define TEND(k) do { if ((k) == TSEL) tacc_ += (unsigned)__builtin_amdgcn_s_memrealtime() - tbeg_; } while (0)
#define TARGS , unsigned& tacc_, unsigned& tbeg_
#define TPASS , tacc_, tbeg_
#else
#define TARGS
#define TPASS
#define TDECL do {} while (0)
#define TBEG(k) do {} while (0)
#define TEND(k) do {} while (0)
#endif
DI float bf2f(bf16_t v) { return __uint_as_float((unsigned)v << 16); }
DI unsigned cvtpk(float lo, float hi) { f32x2 v = {lo, hi}; bf16x2_t b = __builtin_convertvector(v, bf16x2_t); return __builtin_bit_cast(unsigned, b); }
DI bf16_t f2bf(float x) { return (bf16_t)(cvtpk(x, 0.f) & 0xffffu); }
DI f32x4 mfma16(bf16x8 a, bf16x8 b, f32x4 c) { return __builtin_amdgcn_mfma_f32_16x16x32_bf16(a, b, c, 0, 0, 0); }
DI float fexp(float x) { return __builtin_amdgcn_exp2f(x * 1.4426950408889634f); }
DI float siluf(float x) { return x * __builtin_amdgcn_rcpf(1.f + fexp(-x)); }
DI float logsigf(float u) { return fminf(u, 0.f) - 0.6931471805599453f * __builtin_amdgcn_logf(1.f + fexp(-fabsf(u))); }
DI unsigned fkey(float x) { unsigned u = __float_as_uint(x); u = (u == 0x80000000u) ? 0u : u; return u ^ ((unsigned)((int)u >> 31) | 0x80000000u); }
DI float wsum64(float v) { v += __shfl_xor(v, 1); v += __shfl_xor(v, 2); v += __shfl_xor(v, 4); v += __shfl_xor(v, 8); v += __shfl_xor(v, 16); v += __shfl_xor(v, 32); return v; }
DI float wmax64(float v) { v = fmaxf(v, __shfl_xor(v, 1)); v = fmaxf(v, __shfl_xor(v, 2)); v = fmaxf(v, __shfl_xor(v, 4)); v = fmaxf(v, __shfl_xor(v, 8)); v = fmaxf(v, __shfl_xor(v, 16)); v = fmaxf(v, __shfl_xor(v, 32)); return v; }
DI unsigned lds_add(LAS3 unsigned* p, unsigned v) { return __hip_atomic_fetch_add(p, v, __ATOMIC_RELAXED, __HIP_MEMORY_SCOPE_WORKGROUP); }
DI unsigned lds_or(LAS3 unsigned* p, unsigned v) { return __hip_atomic_fetch_or(p, v, __ATOMIC_RELAXED, __HIP_MEMORY_SCOPE_WORKGROUP); }
DI void st_bf16x4(bf16_t* p, f32x4 v) { u32x2 w; w.x = cvtpk(v[0], v[1]); w.y = cvtpk(v[2], v[3]); *(u32x2*)p = w; }
DI const float* vaddr(const float* q) { asm volatile("" : "+v"(q)); return q; }
constexpr float LOG2E = 1.4426950408889634f;
#define NEG_INF (-__builtin_inff())

DI int rope_perm(int vc) { return 64 * (vc >> 6) + 16 * ((vc >> 5) & 1) + (vc & 15) + 32 * ((vc >> 4) & 1); }
DI int in_src(int np) {
    const int pn = np >> 8, vc = np & 255;
    switch (pn) {
        case 0: return vc;
        case 1: return 256 + vc;
        case 2: case 3: return 512 + 256 * (pn - 2) + vc;
        case 4: case 5: return 1040 + 256 * (pn - 4) + vc;
        case 6: return 1552 + rope_perm(vc);
        case 7: return 1808 + rope_perm(vc);
        case 8: return 2064 + vc;
        case 9: return 2320 + rope_perm(vc);
        case 10: return 2644 + vc;
        case 11: return 2900 + vc;
        case 12: return 3156 + vc;
        default: break;
    }
    if (vc < 64) return 2576 + rope_perm(vc);
    if (vc < 68) return 2640 + (vc - 64);
    if (vc < 84) return 1024 + (vc - 68);
    return -1;
}

struct EpiIn {
    static constexpr bool PERM = false, AFTER_DRAIN = false;
    unsigned char* ws; float* out;
    DI void operator()(const f32x4 (&acc)[2][2][4][2], const pg8::Unit& u, int wr, int wc, int fr, int fq) const {
        const int pn = u.pn, rbase = u.pm * 256 + wr * 64 + fr;
        if (pn <= 5 || (pn >= 10 && pn <= 12)) {
            bf16_t* dst; int ldc = 256, coff = 0; float sc = 1.f; bool silu = false;
            switch (pn) {
                case 0: dst = (bf16_t*)(ws + W_GQ); sc = 0.125f; break;
                case 1: dst = (bf16_t*)(ws + W_GK); break;
                case 2: dst = (bf16_t*)(ws + W_GV); ldc = 512; break;
                case 3: dst = (bf16_t*)(ws + W_GV); ldc = 512; coff = 256; break;
                case 4: dst = (bf16_t*)(ws + W_GG); ldc = 512; silu = true; break;
                case 5: dst = (bf16_t*)(ws + W_GG); ldc = 512; coff = 256; silu = true; break;
                case 10: dst = (bf16_t*)(ws + W_DG); silu = true; break;
                case 11: dst = (bf16_t*)(ws + W_MQ); sc = 0.125f; break;
                default: dst = (bf16_t*)(ws + W_MG); silu = true; break;
            }
#pragma unroll
            for (int ai = 0; ai < 2; ++ai)
#pragma unroll
                for (int m = 0; m < 4; ++m) {
                    const int row = rbase + ai * 128 + m * 16;
                    bf16_t* rp = dst + (size_t)row * ldc + coff + wc * 32 + 4 * fq;
#pragma unroll
                    for (int bj = 0; bj < 2; ++bj)
#pragma unroll
                        for (int n = 0; n < 2; ++n) {
                            f32x4 v = acc[ai][bj][m][n];
                            if (silu) { v[0] = siluf(v[0]); v[1] = siluf(v[1]); v[2] = siluf(v[2]); v[3] = siluf(v[3]); } else v = v * sc;
                            st_bf16x4(rp + bj * 128 + n * 16, v);
                        }
                }
        } else if (pn == 6 || pn == 7 || pn == 9) {
            bf16_t* dst = (bf16_t*)(ws + (pn == 6 ? W_DQ : (pn == 7 ? W_DK : W_IQ)));
            const float sc = (pn == 6) ? 0.125f : 1.f;
            const float* rope = (const float*)(ws + W_ROPE);
#pragma unroll
            for (int ai = 0; ai < 2; ++ai)
#pragma unroll
                for (int m = 0; m < 4; ++m) {
                    const int row = rbase + ai * 128 + m * 16;
                    const int pi = row < MP ? (row & 2047) : 2048;
                    const int f0 = 16 * (wc & 1) + 4 * fq;
                    const f32x4 cs0 = *(const f32x4*)(rope + ((size_t)pi * 32 + f0) * 2), cs1 = *(const f32x4*)(rope + ((size_t)pi * 32 + f0) * 2 + 4);
                    const f32x4 c = {cs0[0], cs0[2], cs1[0], cs1[2]}, s = {cs0[1], cs0[3], cs1[1], cs1[3]};
#pragma unroll
                    for (int bj = 0; bj < 2; ++bj) {
                        const f32x4 v0 = acc[ai][bj][m][0], v1 = acc[ai][bj][m][1];
                        const f32x4 o1 = (v0 * c - v1 * s) * sc, o2 = (v1 * c + v0 * s) * sc;
                        const int col1 = 64 * (2 * bj + (wc >> 1)) + f0, col2 = col1 + 32;
                        st_bf16x4(dst + (size_t)row * 256 + col1, o1); st_bf16x4(dst + (size_t)row * 256 + col2, o2);
                        if (pn == 7) {
                            float* op = nullptr;
                            if (row < MP) op = out + O_KP + (size_t)row * 256; else if (row < MP + NDB) op = out + O_KS + (size_t)(row - MP) * 256;
                            if (op) { *(f32x4*)(op + col1) = o1; *(f32x4*)(op + col2) = o2; }
                        }
                    }
                }
        } else if (pn == 8) {
            bf16_t* dvt = (bf16_t*)(ws + W_DVT);
#pragma unroll
            for (int ai = 0; ai < 2; ++ai)
#pragma unroll
                for (int m = 0; m < 4; ++m) {
                    const int row = rbase + ai * 128 + m * 16;
                    float* op = nullptr;
                    if (row < MP) op = out + O_VP + (size_t)row * 256; else if (row < MP + NDB) op = out + O_VS + (size_t)(row - MP) * 256;
#pragma unroll
                    for (int bj = 0; bj < 2; ++bj)
#pragma unroll
                        for (int n = 0; n < 2; ++n) {
                            const f32x4 v = acc[ai][bj][m][n];
                            const int col = 128 * bj + 32 * wc + 16 * n + 4 * fq;
                            if (op) *(f32x4*)(op + col) = v;
                            if (row < MP) {
                                const int t_ = row & 2047, kk_ = t_ & 31;
                                bf16_t* tp = dvt + ((((size_t)(row >> 11) * 64 + (t_ >> 5)) * 4 + (col >> 6)) * 64 + (col & 63)) * 32 + 8 * ((kk_ >> 2) & 3) + 4 * (kk_ >> 4) + (kk_ & 3);
                                tp[0] = f2bf(v[0]); tp[32] = f2bf(v[1]); tp[64] = f2bf(v[2]); tp[96] = f2bf(v[3]);
                            }
                        }
                }
        } else {
            bf16_t* ikb = (bf16_t*)(ws + W_IK); float* iw = (float*)(ws + W_IW); float* glr = (float*)(ws + W_GLR);
            const float* rope = (const float*)(ws + W_ROPE);
#pragma unroll
            for (int ai = 0; ai < 2; ++ai)
#pragma unroll
                for (int m = 0; m < 4; ++m) {
                    const int row = rbase + ai * 128 + m * 16;
                    const f32x4 v0 = acc[ai][0][m][0], v1 = acc[ai][0][m][1];
                    if (wc < 2) {
                        const int pi = row < MP ? (row & 2047) : 2048;
                        const int f0 = 16 * wc + 4 * fq;
                        const f32x4 cs0 = *(const f32x4*)(rope + ((size_t)pi * 32 + f0) * 2), cs1 = *(const f32x4*)(rope + ((size_t)pi * 32 + f0) * 2 + 4);
                        const f32x4 c = {cs0[0], cs0[2], cs1[0], cs1[2]}, s = {cs0[1], cs0[3], cs1[1], cs1[3]};
                        const f32x4 o1 = v0 * c - v1 * s, o2 = v1 * c + v0 * s;
                        st_bf16x4(ikb + (size_t)row * 64 + f0, o1); st_bf16x4(ikb + (size_t)row * 64 + f0 + 32, o2);
                        float* op = nullptr;
                        if (row < MP) op = out + O_IKP + (size_t)row * 64; else if (row < MP + NDB) op = out + O_IKS + (size_t)(row - MP) * 64;
                        if (op) { *(f32x4*)(op + f0) = o1; *(f32x4*)(op + f0 + 32) = o2; }
                    } else if (wc == 2) {
                        if (fq == 0) { *(f32x4*)(iw + (size_t)row * 4) = v0 * 0.5f; *(f32x4*)(glr + (size_t)row * 16 + 12) = v1; }
                        else *(f32x4*)(glr + (size_t)row * 16 + 4 * (fq - 1)) = v0;
                    }
                }
        }
    }
};
struct EpiMem {
    static constexpr bool PERM = false, AFTER_DRAIN = false;
    unsigned char* ws; float* out;
    DI void operator()(const f32x4 (&acc)[2][2][4][2], const pg8::Unit& u, int wr, int wc, int fr, int fq) const {
        const int pn = u.pn, rbase = u.pm * 256 + wr * 64 + fr;
        bf16_t* mk = (bf16_t*)(ws + W_MK); bf16_t* mvt = (bf16_t*)(ws + W_MVT);
        float* op0 = out + (pn == 0 ? O_MKP : O_MVP);
#pragma unroll
        for (int ai = 0; ai < 2; ++ai)
#pragma unroll
            for (int m = 0; m < 4; ++m) {
                const int row = rbase + ai * 128 + m * 16;
#pragma unroll
                for (int bj = 0; bj < 2; ++bj)
#pragma unroll
                    for (int n = 0; n < 2; ++n) {
                        const f32x4 v = acc[ai][bj][m][n];
                        const int col = 128 * bj + 32 * wc + 16 * n + 4 * fq;
                        *(f32x4*)(op0 + (size_t)row * 256 + col) = v;
                        if (pn == 0) st_bf16x4(mk + (size_t)row * 256 + col, v);
                        else { const int m_ = row & 255, kk_ = m_ & 31;
                               bf16_t* tp = mvt + ((((size_t)(row >> 8) * 8 + (m_ >> 5)) * 4 + (col >> 6)) * 64 + (col & 63)) * 32 + 8 * ((kk_ >> 2) & 3) + 4 * (kk_ >> 4) + (kk_ & 3);
                               tp[0] = f2bf(v[0]); tp[32] = f2bf(v[1]); tp[64] = f2bf(v[2]); tp[96] = f2bf(v[3]); }
                    }
            }
    }
};
struct EpiOut {
    static constexpr bool PERM = false, AFTER_DRAIN = false;
    const float* xp; const float* xs; float* out;
    DI void operator()(const f32x4 (&acc)[2][2][4][2], const pg8::Unit& u, int wr, int wc, int fr, int fq) const {
        const int rbase = u.pm * 256 + wr * 64 + fr, cbase = u.pn * 256 + wc * 32 + 4 * fq;
#pragma unroll
        for (int ai = 0; ai < 2; ++ai)
#pragma unroll
            for (int m = 0; m < 4; ++m) {
                const int row = rbase + ai * 128 + m * 16;
                const float* xr; float* orow;
                if (row < MP) { xr = xp + (size_t)row * DM; orow = out + O_YP + (size_t)row * DM; }
                else if (row < MP + NDB) { xr = xs + (size_t)(row - MP) * DM; orow = out + O_YS + (size_t)(row - MP) * DM; }
                else continue;
#pragma unroll
                for (int bj = 0; bj < 2; ++bj)
#pragma unroll
                    for (int n = 0; n < 2; ++n) { const int col = cbase + bj * 128 + n * 16; *(f32x4*)(orow + col) = acc[ai][bj][m][n] + *(const f32x4*)(xr + col); }
            }
    }
};
DI void p0_prologue(const Params& p, LAS3 unsigned char* lds) {
    const int tid = threadIdx.x, lane = tid & 63, wv = tid >> 6;
    unsigned char* ws = p.ws;
    for (int r = blockIdx.x * 8 + wv; r < MROWS + MMEM; r += gridDim.x * 8) {
        const float* src = nullptr; const float* g = p.norm_in; bf16_t* dst;
        if (r < MP) { src = p.x_prompt + (size_t)r * DM; dst = (bf16_t*)(ws + W_XN) + (size_t)r * DM; }
        else if (r < MP + NDB) { src = p.x_sample + (size_t)(r - MP) * DM; dst = (bf16_t*)(ws + W_XN) + (size_t)r * DM; }
        else if (r < MROWS) { dst = (bf16_t*)(ws + W_XN) + (size_t)r * DM; }
        else { src = p.mem_prompt + (size_t)(r - MROWS) * DM; g = p.mem_norm; dst = (bf16_t*)(ws + W_MEMN) + (size_t)(r - MROWS) * DM; }
        if (!src) {
#pragma unroll
            for (int i = 0; i < 4; ++i) *(u32x2*)(dst + i * 256 + lane * 4) = (u32x2){0u, 0u};
            continue;
        }
        f32x4 v[4]; float ss = 0.f;
#pragma unroll
        for (int i = 0; i < 4; ++i) { v[i] = *(const f32x4*)(src + i * 256 + lane * 4); ss += v[i][0] * v[i][0] + v[i][1] * v[i][1] + v[i][2] * v[i][2] + v[i][3] * v[i][3]; }
        ss = wsum64(ss);
        const float rstd = rsqrtf(ss * (1.f / DM) + 1e-6f);
#pragma unroll
        for (int i = 0; i < 4; ++i) { const f32x4 gv = *(const f32x4*)(g + i * 256 + lane * 4); st_bf16x4(dst + i * 256 + lane * 4, v[i] * rstd * gv); }
    }
    for (int e = blockIdx.x * NTHREADS + tid; e < 2049 * 32; e += gridDim.x * NTHREADS) {
        const int pi = e >> 5, f = e & 31;
        const float inv = powf(10000.0f, -(float)(2 * f) / 64.0f);
        const float ang = (float)(pi == 2048 ? 16384 : pi) * inv;
        float sn, cs; sincosf(ang, &sn, &cs);
        ((f32x2*)(ws + W_ROPE))[e] = (f32x2){cs, sn};
    }
    LAS3 float* tl = (LAS3 float*)lds;
    for (int tile = blockIdx.x; tile < 1280; tile += gridDim.x) {
        int which, t2, ld; const float* W; bf16_t* dst;
        if (tile < 896) { which = 0; t2 = tile; W = p.w_in; ld = DIN; dst = (bf16_t*)(ws + W_WTIN); }
        else if (tile < 1024) { which = 1; t2 = tile - 896; W = p.w_mem_kv; ld = 512; dst = (bf16_t*)(ws + W_WTMEM); }
        else { which = 2; t2 = tile - 1024; W = p.w_out; ld = 1024; dst = (bf16_t*)(ws + W_WTOUT); }
        const int nt = t2 >> 4, kt = t2 & 15;
        { const int nn = tid & 63, kk0 = tid >> 6; const int np = nt * 64 + nn; const int sc = which == 0 ? in_src(np) : np;
#pragma unroll
          for (int i = 0; i < 8; ++i) { const int k = kk0 + 8 * i; tl[k * 65 + nn] = sc >= 0 ? W[(size_t)(kt * 64 + k) * ld + sc] : 0.f; } }
        __syncthreads();
        { const int kk = tid & 63, nn0 = tid >> 6;
#pragma unroll
          for (int i = 0; i < 8; ++i) { const int n = nn0 + 8 * i; dst[(size_t)(nt * 64 + n) * 1024 + kt * 64 + kk] = f2bf(tl[kk * 65 + n]); } }
        __syncthreads();
    }
}

DI void cnt_ge(unsigned& c, unsigned key, unsigned cand) { asm volatile("v_cmp_ge_u32 vcc, %1, %2\n\tv_addc_co_u32 %0, vcc, 0, %0, vcc" : "+v"(c) : "v"(key), "v"(cand) : "vcc"); }
DI void cnt_gt(unsigned& c, unsigned key, unsigned cand) { asm volatile("v_cmp_gt_u32 vcc, %1, %2\n\tv_addc_co_u32 %0, vcc, 0, %0, vcc" : "+v"(c) : "v"(key), "v"(cand) : "vcc"); }
DI void cnt_eq_lt(unsigned& c, unsigned key, unsigned T, unsigned idx, unsigned cand) {
    unsigned tmp;
    asm volatile("v_cmp_eq_u32 vcc, %2, %3\n\tv_cndmask_b32 %1, -1, %4, vcc\n\tv_cmp_lt_u32 vcc, %1, %5\n\tv_addc_co_u32 %0, vcc, 0, %0, vcc" : "+v"(c), "=&v"(tmp) : "v"(key), "v"(T), "v"(idx), "v"(cand) : "vcc"); }
DI unsigned grp_count16(unsigned c, LAS3 unsigned* CNT, int& it, int fr, int lane) {
    c += __shfl_xor(c, 16); c += __shfl_xor(c, 32);
    LAS3 unsigned* cur = CNT + (it % 3) * 16;
    if (lane < 16) lds_add(cur + fr, c);
    __syncthreads();
    const unsigned tot = cur[fr];
    if (threadIdx.x < 16) CNT[((it + 2) % 3) * 16 + threadIdx.x] = 0u;
    ++it; return tot;
}
DI unsigned blk_count(unsigned c, LAS3 unsigned* CNT, int& it, int lane) {
    c += __shfl_xor(c, 1); c += __shfl_xor(c, 2); c += __shfl_xor(c, 4); c += __shfl_xor(c, 8); c += __shfl_xor(c, 16); c += __shfl_xor(c, 32);
    LAS3 unsigned* cur = CNT + (it % 3) * 16;
    if (lane == 0) lds_add(cur, c);
    __syncthreads();
    const unsigned tot = cur[0];
    if (threadIdx.x == 0) CNT[((it + 2) % 3) * 16] = 0u;
    ++it; return tot;
}

template <bool MASKED>
DI void attn32(const bf16_t* Q, int ldq, const bf16_t* K, int ldk, const bf16_t* Vt, int ldv, int nkb, const LAS3 unsigned* mask, int fr, int fq,
               f32x4 (&o)[4][2], float (&linv)[2]) {
    bf16x8 qf[2][2];
#pragma unroll
    for (int qt = 0; qt < 2; ++qt)
#pragma unroll
        for (int ks = 0; ks < 2; ++ks) qf[qt][ks] = *(const bf16x8*)(Q + (size_t)(16 * qt + fr) * ldq + ks * 32 + fq * 8);
    float m[2] = {NEG_INF, NEG_INF}, l[2] = {0.f, 0.f};
    const f32x4 zero = {0.f, 0.f, 0.f, 0.f};
#pragma unroll
    for (int dt = 0; dt < 4; ++dt) { o[dt][0] = zero; o[dt][1] = zero; }
    const bf16_t* kl = K + (size_t)fr * ldk + fq * 8;
    const bf16_t* vl = Vt + fr * 32 + 8 * fq;
    bf16x8 kfA[2][2], kfB[2][2], vA[4], vB[4];
#define ATT_LOAD(KF, VF, kb_) do { \
        _Pragma("unroll") for (int i2 = 0; i2 < 2; ++i2) _Pragma("unroll") for (int ks = 0; ks < 2; ++ks) KF[i2][ks] = *(const bf16x8*)(kl + (size_t)(32 * (kb_) + 16 * i2) * ldk + ks * 32); \
        _Pragma("unroll") for (int dt = 0; dt < 4; ++dt) VF[dt] = *(const bf16x8*)(vl + (size_t)(kb_) * ldv + 512 * dt); } while (0)
#define ATT_COMPUTE(KF, VF, kb_) do { \
        _Pragma("unroll") for (int qt = 0; qt < 2; ++qt) { \
            f32x4 s0 = mfma16(KF[0][0], qf[qt][0], zero); s0 = mfma16(KF[0][1], qf[qt][1], s0); \
            f32x4 s1 = mfma16(KF[1][0], qf[qt][0], zero); s1 = mfma16(KF[1][1], qf[qt][1], s1); \
            if (MASKED) { const unsigned mw = mask[(16 * qt + fr) * 65 + (kb_)]; const unsigned b0 = mw >> (2 * fq), b1 = mw >> (8 + 2 * fq); \
                _Pragma("unroll") for (int r = 0; r < 4; ++r) { const int sh_ = (r >> 1) + 16 * (r & 1); s0[r] = ((b0 >> sh_) & 1u) ? s0[r] : NEG_INF; s1[r] = ((b1 >> sh_) & 1u) ? s1[r] : NEG_INF; } } \
            float mx = fmaxf(fmaxf(fmaxf(s0[0], s0[1]), fmaxf(s0[2], s0[3])), fmaxf(fmaxf(s1[0], s1[1]), fmaxf(s1[2], s1[3]))); \
            mx = fmaxf(mx, __shfl_xor(mx, 16)); mx = fmaxf(mx, __shfl_xor(mx, 32)); \
            const float mn = fmaxf(m[qt], mx), ms = (mn == NEG_INF) ? 0.f : mn; \
            const float alpha = __builtin_amdgcn_exp2f((m[qt] - ms) * LOG2E); \
            f32x4 p0, p1; \
            _Pragma("unroll") for (int r = 0; r < 4; ++r) { p0[r] = __builtin_amdgcn_exp2f((s0[r] - ms) * LOG2E); p1[r] = __builtin_amdgcn_exp2f((s1[r] - ms) * LOG2E); } \
            l[qt] = l[qt] * alpha + ((p0[0] + p0[1]) + (p0[2] + p0[3])) + ((p1[0] + p1[1]) + (p1[2] + p1[3])); \
            m[qt] = mn; \
            u32x4 pw; pw.x = cvtpk(p0[0], p0[1]); pw.y = cvtpk(p0[2], p0[3]); pw.z = cvtpk(p1[0], p1[1]); pw.w = cvtpk(p1[2], p1[3]); \
            const bf16x8 pf = __builtin_bit_cast(bf16x8, pw); \
            _Pragma("unroll") for (int dt = 0; dt < 4; ++dt) { o[dt][qt] = o[dt][qt] * alpha; o[dt][qt] = mfma16(VF[dt], pf, o[dt][qt]); } } } while (0)
    ATT_LOAD(kfA, vA, 0);
    const int last = nkb - 1;
    for (int kb = 0; kb < nkb; kb += 2) {
        ATT_LOAD(kfB, vB, kb + 1);
        ATT_COMPUTE(kfA, vA, kb);
        { const int k2 = kb + 2 < last ? kb + 2 : last; ATT_LOAD(kfA, vA, k2); }
        ATT_COMPUTE(kfB, vB, kb + 1);
    }
#undef ATT_LOAD
#undef ATT_COMPUTE
#pragma unroll
    for (int qt = 0; qt < 2; ++qt) { float lt = l[qt]; lt += __shfl_xor(lt, 16); lt += __shfl_xor(lt, 32); linv[qt] = 1.f / lt; }
}
DI void attn_store(const f32x4 (&o)[4][2], const float (&linv)[2], const bf16_t* gate  , bf16_t* mix  , int fr, int fq) {
#pragma unroll
    for (int qt = 0; qt < 2; ++qt)
#pragma unroll
        for (int dt = 0; dt < 4; ++dt) {
            const size_t row = 16 * qt + fr; const int col = 16 * dt + 4 * fq;
            const u32x2 gw = *(const u32x2*)(gate + row * 256 + col);
            f32x4 v = o[dt][qt] * linv[qt];
            v[0] *= __uint_as_float(gw.x << 16); v[1] *= __uint_as_float(gw.x & 0xffff0000u); v[2] *= __uint_as_float(gw.y << 16); v[3] *= __uint_as_float(gw.y & 0xffff0000u);
            st_bf16x4(mix + row * 1024 + col, v);
        }
}

constexpr int DS_MASK = 0, DS_PKT = 16640, PKT_LD = 2052, DS_CNT = 147968;
typedef unsigned short u16x2 __attribute__((ext_vector_type(2)));
DI unsigned pk_cnt_ge(unsigned acc, unsigned kpair, unsigned cm1, unsigned ones) {
    unsigned t;
    asm("v_pk_sub_u16 %1, %2, %3 clamp\n\tv_pk_min_u16 %1, %1, %4\n\tv_pk_add_u16 %0, %0, %1" : "+v"(acc), "=&v"(t) : "v"(kpair), "v"(cm1), "v"(ones));
    return acc;
}
DI void select_bitwise(const unsigned (&key)[16][4], int lbase, LAS3 unsigned* CNT, int& it, int fr, int lane, unsigned& T, int& Xrel) {
    bool fin = false;
    T = 0u; Xrel = 0x7fffffff;
    for (int bit = 31; bit >= 0; --bit) {
        const unsigned cand = T | (1u << bit);
        unsigned c = 0;
#pragma unroll
        for (int n = 0; n < 16; ++n)
#pragma unroll
            for (int r = 0; r < 4; ++r) cnt_ge(c, key[n][r], cand);
        const unsigned tot = grp_count16(c, CNT, it, fr, lane);
        if (!fin && tot >= 256u) { T = cand; fin = (tot == 256u); }
        if (__all(fin)) break;
    }
    if (!__all(fin)) {
        unsigned c = 0;
#pragma unroll
        for (int n = 0; n < 16; ++n)
#pragma unroll
            for (int r = 0; r < 4; ++r) cnt_gt(c, key[n][r], T);
        const unsigned cgt = grp_count16(c, CNT, it, fr, lane);
        const unsigned need = 256u - cgt;
        unsigned Xl = 0u;
        for (int bit = 10; bit >= 0; --bit) {
            const unsigned cand = Xl | (1u << bit);
            const int crel = (int)cand - lbase;
            c = 0;
#pragma unroll
            for (int n = 0; n < 16; ++n) { const int crn = crel - 128 * n;
#pragma unroll
                for (int r = 0; r < 4; ++r) c += (key[n][r] == T && r < crn) ? 1u : 0u; }
            const unsigned tot = grp_count16(c, CNT, it, fr, lane);
            if (tot < need) Xl = cand;
        }
        if (!fin) Xrel = (int)Xl - lbase;
    }
}
DI unsigned pk_flag_ge(unsigned kpair, unsigned cm1, unsigned ones) {
    unsigned t;
    asm("v_pk_sub_u16 %0, %1, %2 clamp\n\tv_pk_min_u16 %0, %0, %3" : "=&v"(t) : "v"(kpair), "v"(cm1), "v"(ones));
    return t;
}
DI unsigned pk_max(unsigned a, unsigned b2) { unsigned t; asm("v_pk_max_u16 %0, %1, %2" : "=v"(t) : "v"(a), "v"(b2)); return t; }
DI unsigned hsum32(unsigned x) {
    x += __builtin_amdgcn_update_dpp(0u, x, 0xB1, 0xF, 0xF, false); x += __builtin_amdgcn_update_dpp(0u, x, 0x4E, 0xF, 0xF, false);
    x += __builtin_amdgcn_update_dpp(0u, x, 0x141, 0xF, 0xF, false); x += __builtin_amdgcn_update_dpp(0u, x, 0x140, 0xF, 0xF, false);
    const auto r = __builtin_amdgcn_permlane16_swap(x, x, false, false); return r[0] + r[1];
}
DI unsigned hmax32(unsigned x) {
    x = max(x, (unsigned)__builtin_amdgcn_update_dpp(0u, x, 0xB1, 0xF, 0xF, false)); x = max(x, (unsigned)__builtin_amdgcn_update_dpp(0u, x, 0x4E, 0xF, 0xF, false));
    x = max(x, (unsigned)__builtin_amdgcn_update_dpp(0u, x, 0x141, 0xF, 0xF, false)); x = max(x, (unsigned)__builtin_amdgcn_update_dpp(0u, x, 0x140, 0xF, 0xF, false));
    const auto r = __builtin_amdgcn_permlane16_swap(x, x, false, false); return max(r[0], r[1]);
}
DI unsigned pk_count32(const unsigned (&rk)[32], unsigned cm1, unsigned ones, bool half) {
    unsigned a0 = 0u, a1 = 0u;
#pragma unroll
    for (int k = 0; k < 16; k += 2) { a0 = pk_cnt_ge(a0, rk[k], cm1, ones); a1 = pk_cnt_ge(a1, rk[k + 1], cm1, ones); }
    if (!half) {
#pragma unroll
        for (int k = 16; k < 32; k += 2) { a0 = pk_cnt_ge(a0, rk[k], cm1, ones); a1 = pk_cnt_ge(a1, rk[k + 1], cm1, ones); }
    }
    return (a0 & 0xffffu) + (a0 >> 16) + (a1 & 0xffffu) + (a1 >> 16);
}
DI void dsa_unit(const Params& p, LAS3 unsigned char* lds, int b, int j TARGS) {
    int tid = threadIdx.x; asm volatile("" : "+v"(tid));
    const int lane0 = tid & 63, w = __builtin_amdgcn_readfirstlane(tid >> 6);
    unsigned char* ws = p.ws;
    LAS3 unsigned* MASK = (LAS3 unsigned*)(lds + DS_MASK);
    LAS3 unsigned* PKT = (LAS3 unsigned*)(lds + DS_PKT);
    const bf16_t* IQ = (const bf16_t*)(ws + W_IQ); const bf16_t* IK = (const bf16_t*)(ws + W_IK); const float* IW = (const float*)(ws + W_IW);
    const int q0 = 64 * j;
    const f32x4 zero = {0.f, 0.f, 0.f, 0.f};
#ifdef CHECK_SEL
    LAS3 unsigned* CNT = (LAS3 unsigned*)(lds + DS_CNT); int it = 0;
    if (tid < 48) CNT[tid] = 0u;
    __syncthreads();
#endif
    TBEG(30);
#pragma unroll 1
    for (int qg = 0; qg < 4; ++qg) {
        TBEG(32);
        int lane = lane0; asm volatile("" : "+v"(lane));
        const int fr = lane & 15, fq = lane >> 4;
        const int tq = q0 + 16 * qg + fr; const size_t qrow = (size_t)b * SEQ + tq;
        const int ntile = 4 * j + qg + 1;
        const int nloc = ntile > w ? (ntile - w + 7) >> 3 : 0;
        const bool selecting = q0 + 16 * qg >= 256;
        {
            bf16x8 bq[4][2];
#pragma unroll
            for (int h = 0; h < 4; ++h)
#pragma unroll
                for (int ks = 0; ks < 2; ++ks) bq[h][ks] = *(const bf16x8*)(IQ + qrow * 256 + h * 64 + ks * 32 + fq * 8);
            const f32x4 wq = *(const f32x4*)(IW + qrow * 4);
            float Lh[4];
#pragma unroll
            for (int h = 0; h < 4; ++h) Lh[h] = wq[h] < 0.f ? NEG_INF : -NEG_INF;
            const char* tb = (const char*)IK + ((size_t)b * SEQ + 16 * w) * 128 + (unsigned)(fr * 128 + fq * 16);
            LAS3 unsigned* krow = PKT + fr * PKT_LD + 16 * w + 4 * fq;
            const int lim0 = tq - (16 * w + 4 * fq);
#define DSA_TILE(A0, A1, nn) do { \
                f32x4 sc = zero; \
                _Pragma("unroll") for (int h = 0; h < 4; ++h) { f32x4 d = mfma16(A0, bq[h][0], zero); d = mfma16(A1, bq[h][1], d); d = d * wq[h]; \
                    _Pragma("unroll") for (int r = 0; r < 4; ++r) sc[r] += __builtin_amdgcn_fmed3f(d[r], 0.f, Lh[h]); } \
                { const char* t2_ = tb + (size_t)((nn) + 2 < nloc ? (nn) + 2 : nloc - 1) * 16384; A0 = *(const bf16x8*)t2_; A1 = *(const bf16x8*)(t2_ + 64); } \
                const int limn = lim0 - 128 * (nn);                   \
                u32x4 kv; \
                _Pragma("unroll") for (int r = 0; r < 4; ++r) { const unsigned u = __float_as_uint(sc[r] + 0.f); const unsigned k = u ^ ((unsigned)((int)u >> 31) | 0x80000000u);   \
                    kv[r] = (r <= limn) ? k : 0u; } \
                *(LAS3 u32x4*)(krow + 128 * (nn)) = kv; } while (0)
            if (nloc > 0) {
                bf16x8 a0 = *(const bf16x8*)tb, a1 = *(const bf16x8*)(tb + 64);
                const char* t1 = tb + (size_t)(1 < nloc ? 1 : 0) * 16384;
                bf16x8 b0 = *(const bf16x8*)t1, b1 = *(const bf16x8*)(t1 + 64);
#pragma unroll 1
                for (int n = 0; n < nloc; n += 2) {
                    DSA_TILE(a0, a1, n);
                    if (n + 1 < nloc) DSA_TILE(b0, b1, n + 1);
                }
            }
#undef DSA_TILE
        }
        TEND(32); TBEG(33);
        __syncthreads();
        {
            const int hh = lane >> 5, pos = lane & 31, oq = 2 * w + hh;
            const unsigned nkeys = 16u * (unsigned)ntile;
            const bool half = nkeys <= 1024u;
            const LAS3 unsigned* orow = PKT + oq * PKT_LD + 2 * pos;
            unsigned ones = 0x00010001u; asm volatile("" : "+v"(ones));
            unsigned Tfull = 1u, X = 0xffffffffu;
            if (selecting) {
                unsigned rk[32];
#pragma unroll
                for (int k = 0; k < 32; ++k) { const u32x2 kk = *(const LAS3 u32x2*)(orow + 64 * k); rk[k] = (2u * (unsigned)(pos + 32 * k) < nkeys) ? __builtin_amdgcn_perm(kk.y, kk.x, 0x07060302u) : 0u; }
                unsigned mx = 0u;
#pragma unroll
                for (int k = 0; k < 32; ++k) mx = pk_max(mx, rk[k]);
                const unsigned kmax = hmax32(max(mx & 0xffffu, mx >> 16));
                unsigned T16 = 0u, cabove = 0u; bool exact = false;
                {
                    unsigned ub = 0x10000u;
#pragma unroll 1
                    for (int bit = 15; bit >= 0; --bit) {
                        const unsigned cand = T16 | (1u << bit);
                        if (__all(cand > kmax)) { ub = cand; continue; }
                        const unsigned tot = hsum32(pk_count32(rk, (cand - 1u) * 0x00010001u, ones, half));
                        if (tot >= 256u) T16 = cand; else { ub = cand; cabove = tot; }
                    }
                    (void)ub;
                }
                const unsigned need = 256u - cabove;
#pragma unroll
                for (int k = 0; k < 32; ++k) { const u32x2 kk = *(const LAS3 u32x2*)(orow + 64 * k); const bool in = 2u * (unsigned)(pos + 32 * k) < nkeys;
                    const unsigned lo0 = (in && (kk.x >> 16) == T16) ? (kk.x & 0xffffu) : 0u, lo1 = (in && (kk.y >> 16) == T16) ? (kk.y & 0xffffu) : 0u; rk[k] = lo0 | (lo1 << 16); }
                unsigned Tlo = 0u;
#pragma unroll 1
                for (int bit = 15; bit >= 0; --bit) {
                    const unsigned cand = Tlo | (1u << bit);
                    const unsigned tot = hsum32(pk_count32(rk, (cand - 1u) * 0x00010001u, ones, half));
                    if (!exact && tot >= need) { Tlo = cand; exact = (tot == need); }
                    if (__all(exact)) break;
                }
                Tfull = (T16 << 16) | Tlo;
                if (!__all(exact)) {
                    unsigned cgt = 0u, ceq = 0u;
#pragma unroll 1
                    for (int k = 0; k < 32; ++k) { const u32x2 kk = *(const LAS3 u32x2*)(orow + 64 * k); const bool in = 2u * (unsigned)(pos + 32 * k) < nkeys;
                        cgt += (in && kk.x > Tfull && (kk.x >> 16) == T16 ? 1u : 0u) + (in && kk.y > Tfull && (kk.y >> 16) == T16 ? 1u : 0u); }
                    (void)ceq;
                    const unsigned needt = need - hsum32(cgt);
                    unsigned Xl = 0u;
#pragma unroll 1
                    for (int bit = 10; bit >= 0; --bit) {
                        const unsigned cx = Xl | (1u << bit);
                        unsigned c = 0u;
#pragma unroll 1
                        for (int k = 0; k < 32; ++k) { const u32x2 kk = *(const LAS3 u32x2*)(orow + 64 * k); const unsigned i0 = 2u * (unsigned)(pos + 32 * k);
                            c += (i0 < nkeys && kk.x == Tfull && i0 < cx ? 1u : 0u) + (i0 < nkeys && kk.y == Tfull && i0 + 1u < cx ? 1u : 0u); }
                        if (hsum32(c) < needt) Xl = cx;
                    }
                    if (!exact) X = Xl;
                }
            }
            LAS3 unsigned* mrow = MASK + (16 * qg + oq) * 65 + (pos >> 4);
            const unsigned sh = 32u * hh + (pos & 16);
#pragma unroll 2
            for (int k = 0; k <= j; ++k) {
                const u32x2 kk = *(const LAS3 u32x2*)(orow + 64 * k); const unsigned i0 = 2u * (unsigned)(pos + 32 * k);
                const bool s0 = i0 < nkeys && (kk.x > Tfull || (kk.x == Tfull && i0 <= X)), s1 = i0 < nkeys && (kk.y > Tfull || (kk.y == Tfull && i0 + 1u <= X));
                const unsigned long long blo = __ballot(s0), bhi = __ballot(s1);
                const unsigned wv = ((unsigned)(blo >> sh) & 0xffffu) | ((unsigned)(bhi >> sh) << 16);
                if ((pos & 15) == 0) mrow[2 * k] = wv;
            }
        }
        TEND(33);
        __syncthreads();
#ifdef CHECK_SEL
        if (selecting) {
            const int lbase = 16 * w + 4 * fq;
            unsigned key[16][4];
#pragma unroll
            for (int n = 0; n < 16; ++n)
#pragma unroll
                for (int r = 0; r < 4; ++r) key[n][r] = (n < nloc) ? PKT[fr * PKT_LD + lbase + 128 * n + r] : 0u;
            unsigned T2; int X2; select_bitwise(key, lbase, CNT, it, fr, lane, T2, X2);
            bool bad = false;
#pragma unroll
            for (int n = 0; n < 16; ++n) if (n < nloc) { const int x2 = X2 - 128 * n;
#pragma unroll
                for (int r = 0; r < 4; ++r) { const unsigned idx = (unsigned)(lbase + 128 * n + r); const unsigned mw = MASK[(16 * qg + fr) * 65 + (idx >> 5)];
                    const bool s2 = key[n][r] > T2 || (key[n][r] == T2 && r <= x2); bad |= (s2 != (((mw >> (((idx & 31u) >> 1) + 16u * (idx & 1u))) & 1u) != 0u)); } }
            if (__any(bad) && lane == 0) atomicAdd((unsigned*)(ws + CW_CHK), 1u);
            if (lane == 0 && w == 0) atomicAdd((unsigned*)(ws + CW_CHK + 4), 1u);
            __syncthreads();
        }
#endif
    }
    TEND(30); TBEG(31);
    {
        const int h = w & 3, hf = w >> 2, fr = lane0 & 15, fq = lane0 >> 4;
        const size_t qrow0 = (size_t)b * SEQ + q0 + 32 * hf;
        f32x4 o[4][2]; float linv[2];
        attn32<true>((const bf16_t*)(ws + W_DQ) + qrow0 * 256 + h * 64, 256, (const bf16_t*)(ws + W_DK) + (size_t)b * SEQ * 256 + h * 64, 256,
                     (const bf16_t*)(ws + W_DVT) + ((size_t)b * 64 * 4 + h) * 2048, 4 * 2048, 2 * j + 2  , MASK + 32 * hf * 65, fr, fq, o, linv);
        attn_store(o, linv, (const bf16_t*)(ws + W_DG) + qrow0 * 256 + h * 64, (bf16_t*)(ws + W_MIX) + qrow0 * 1024 + 512 + h * 64, fr, fq);
    }
    __syncthreads();
    TEND(31);
}
DI void mem_unit(const Params& p, int n) {
    const int tid = threadIdx.x, lane = tid & 63, w = __builtin_amdgcn_readfirstlane(tid >> 6), fr = lane & 15, fq = lane >> 4;
    unsigned char* ws = p.ws;
    const int h = w & 3, hf = w >> 2;
    const size_t qrow0 = (size_t)n * 64 + 32 * hf; const int b = n >> 5;
    f32x4 o[4][2]; float linv[2];
    attn32<false>((const bf16_t*)(ws + W_MQ) + qrow0 * 256 + h * 64, 256, (const bf16_t*)(ws + W_MK) + (size_t)b * NMEM * 256 + h * 64, 256,
                  (const bf16_t*)(ws + W_MVT) + ((size_t)b * 8 * 4 + h) * 2048, 4 * 2048, 8, nullptr, fr, fq, o, linv);
    attn_store(o, linv, (const bf16_t*)(ws + W_MG) + qrow0 * 256 + h * 64, (bf16_t*)(ws + W_MIX) + qrow0 * 1024 + 768 + h * 64, fr, fq);
}
constexpr int GL_QT = 0, GL_KT = 9216, GL_KPT = 18432, GL_VT = 27648, GL_SBT = 46080, GL_PM = 64512, GL_OF = 73728, GL_GTOT = 107520, GL_W2 = 109568, GL_BG = 113664, GL_DEC = 113920;
constexpr int LDP = 72;
DI void gla_unit(const Params& p, LAS3 unsigned char* lds, int b, int h) {
    const int tid = threadIdx.x, lane = tid & 63, w = __builtin_amdgcn_readfirstlane(tid >> 6), fr = lane & 15, fq = lane >> 4;
    unsigned char* ws = p.ws;
    LAS3 bf16_t* Qt = (LAS3 bf16_t*)(lds + GL_QT); LAS3 bf16_t* Kt = (LAS3 bf16_t*)(lds + GL_KT); LAS3 bf16_t* KpT = (LAS3 bf16_t*)(lds + GL_KPT);
    LAS3 bf16_t* Vt = (LAS3 bf16_t*)(lds + GL_VT); LAS3 bf16_t* SbT = (LAS3 bf16_t*)(lds + GL_SBT); LAS3 bf16_t* Pm = (LAS3 bf16_t*)(lds + GL_PM);
    LAS3 float* Of = (LAS3 float*)(lds + GL_OF); LAS3 float* gtot = (LAS3 float*)(lds + GL_GTOT); LAS3 float* w2s = (LAS3 float*)(lds + GL_W2);
    LAS3 float* bgs = (LAS3 float*)(lds + GL_BG); LAS3 float* dec = (LAS3 float*)(lds + GL_DEC);
    const bf16_t* GQ = (const bf16_t*)(ws + W_GQ); const bf16_t* GK = (const bf16_t*)(ws + W_GK); const bf16_t* GV = (const bf16_t*)(ws + W_GV);
    const bf16_t* GG = (const bf16_t*)(ws + W_GG); const float* GLR = (const float*)(ws + W_GLR); bf16_t* MIX = (bf16_t*)(ws + W_MIX);
    for (int i = tid; i < 128 * LDP / 2; i += NTHREADS) ((LAS3 unsigned*)SbT)[i] = 0u;
    for (int i = tid; i < 16 * 64; i += NTHREADS) w2s[i] = p.w_g2[(i >> 6) * 256 + h * 64 + (i & 63)];
    if (tid < 64) bgs[tid] = p.b_g[h * 64 + tid];
    __syncthreads();
    const int d = tid & 63, tg = w;
    float wreg[16];
#pragma unroll
    for (int r = 0; r < 16; ++r) wreg[r] = w2s[r * 64 + d];
    const float bgd = bgs[d];
    const f32x4 zero = {0.f, 0.f, 0.f, 0.f};
    f32x4 Sacc[4] = {zero, zero, zero, zero};
    const int tt = w & 3, vh = w >> 2;
    for (int c = 0; c < 32; ++c) {
        const size_t rb = (size_t)b * SEQ + c * 64;
        float g8[8];
#pragma unroll
        for (int i = 0; i < 8; ++i) {
            const float* gl = vaddr(GLR + (rb + tg * 8 + i) * 16);
            float u = bgd;
#pragma unroll
            for (int r = 0; r < 16; ++r) u += gl[r] * wreg[r];
            const float g = logsigf(u) * (1.f / 16.f);
            g8[i] = (i ? g8[i - 1] : 0.f) + g;
        }
        gtot[tg * 64 + d] = g8[7];
        __syncthreads();
        float off = 0.f, blast = 0.f;
#pragma unroll
        for (int g2 = 0; g2 < 8; ++g2) { const float v = gtot[g2 * 64 + d]; off += (g2 < tg) ? v : 0.f; blast += v; }
        float kp[8];
#pragma unroll
        for (int i = 0; i < 8; ++i) {
            const int t = tg * 8 + i; const float bt = off + g8[i];
            const float q = bf2f(GQ[(rb + t) * 256 + h * 64 + d]), k = bf2f(GK[(rb + t) * 256 + h * 64 + d]);
            Qt[t * LDP + d] = f2bf(q * fexp(bt)); Kt[t * LDP + d] = f2bf(k * fexp(-bt)); kp[i] = k * fexp(blast - bt);
        }
        { u32x4 kw; kw.x = cvtpk(kp[0], kp[1]); kw.y = cvtpk(kp[2], kp[3]); kw.z = cvtpk(kp[4], kp[5]); kw.w = cvtpk(kp[6], kp[7]); *(LAS3 u32x4*)(KpT + d * LDP + tg * 8) = kw; }
        if (tg == 0) dec[d] = fexp(blast);
        { const int v = tid & 127, sg = tid >> 7; bf16_t vv[16];
#pragma unroll
          for (int i = 0; i < 16; ++i) vv[i] = GV[(rb + sg * 16 + i) * 512 + h * 128 + v];
          u32x4 a, bb; a.x = vv[0] | ((unsigned)vv[1] << 16); a.y = vv[2] | ((unsigned)vv[3] << 16); a.z = vv[4] | ((unsigned)vv[5] << 16); a.w = vv[6] | ((unsigned)vv[7] << 16);
          bb.x = vv[8] | ((unsigned)vv[9] << 16); bb.y = vv[10] | ((unsigned)vv[11] << 16); bb.z = vv[12] | ((unsigned)vv[13] << 16); bb.w = vv[14] | ((unsigned)vv[15] << 16);
          *(LAS3 u32x4*)(Vt + v * LDP + sg * 16) = a; *(LAS3 u32x4*)(Vt + v * LDP + sg * 16 + 8) = bb; }
        __syncthreads();
#pragma unroll
        for (int s2 = 0; s2 < 2; ++s2) {
            const int st = 2 * vh + s2;
            f32x4 acc = zero;
#pragma unroll
            for (int ks = 0; ks < 2; ++ks) {
                const bf16x8 a = *(const LAS3 bf16x8*)(Kt + (st * 16 + fr) * LDP + ks * 32 + fq * 8), bq = *(const LAS3 bf16x8*)(Qt + (tt * 16 + fr) * LDP + ks * 32 + fq * 8);
                acc = mfma16(a, bq, acc);
            }
            const int t = tt * 16 + fr, s0 = st * 16 + 4 * fq;
            u32x2 pw; pw.x = cvtpk(s0 <= t ? acc[0] : 0.f, s0 + 1 <= t ? acc[1] : 0.f); pw.y = cvtpk(s0 + 2 <= t ? acc[2] : 0.f, s0 + 3 <= t ? acc[3] : 0.f);
            *(LAS3 u32x2*)(Pm + t * LDP + s0) = pw;
        }
        __syncthreads();
        f32x4 oacc[4];
        {
            bf16x8 aq[2], ap[2], ak[2];
#pragma unroll
            for (int ks = 0; ks < 2; ++ks) {
                aq[ks] = *(const LAS3 bf16x8*)(Qt + (tt * 16 + fr) * LDP + ks * 32 + fq * 8);
                ap[ks] = *(const LAS3 bf16x8*)(Pm + (tt * 16 + fr) * LDP + ks * 32 + fq * 8);
                ak[ks] = *(const LAS3 bf16x8*)(KpT + (tt * 16 + fr) * LDP + ks * 32 + fq * 8);
            }
            const f32x4 dv = *(const LAS3 f32x4*)(dec + tt * 16 + 4 * fq);
#pragma unroll
            for (int jv = 0; jv < 4; ++jv) {
                const int vt = vh * 4 + jv;
                bf16x8 bs[2], bv[2];
#pragma unroll
                for (int ks = 0; ks < 2; ++ks) {
                    bs[ks] = *(const LAS3 bf16x8*)(SbT + (vt * 16 + fr) * LDP + ks * 32 + fq * 8);
                    bv[ks] = *(const LAS3 bf16x8*)(Vt + (vt * 16 + fr) * LDP + ks * 32 + fq * 8);
                }
                f32x4 oa = mfma16(aq[0], bs[0], zero); oa = mfma16(aq[1], bs[1], oa); oa = mfma16(ap[0], bv[0], oa); oa = mfma16(ap[1], bv[1], oa);
                oacc[jv] = oa;
                f32x4 sa = Sacc[jv] * dv; sa = mfma16(ak[0], bv[0], sa); sa = mfma16(ak[1], bv[1], sa);
                Sacc[jv] = sa;
            }
        }
        __syncthreads();
#pragma unroll
        for (int jv = 0; jv < 4; ++jv) {
            const int vt = vh * 4 + jv;
#pragma unroll
            for (int r = 0; r < 4; ++r) Of[(tt * 16 + 4 * fq + r) * 132 + vt * 16 + fr] = oacc[jv][r];
            u32x2 sw; sw.x = cvtpk(Sacc[jv][0], Sacc[jv][1]); sw.y = cvtpk(Sacc[jv][2], Sacc[jv][3]);
            *(LAS3 u32x2*)(SbT + (vt * 16 + fr) * LDP + tt * 16 + 4 * fq) = sw;
        }
        __syncthreads();
        {
            const int t = tid >> 3, seg = tid & 7;
            const LAS3 float* op = Of + t * 132 + seg * 16;
            f32x4 ov[4]; float ss = 0.f;
#pragma unroll
            for (int i = 0; i < 4; ++i) { ov[i] = *(const LAS3 f32x4*)(op + 4 * i); ss += ov[i][0] * ov[i][0] + ov[i][1] * ov[i][1] + ov[i][2] * ov[i][2] + ov[i][3] * ov[i][3]; }
            ss += __shfl_xor(ss, 1); ss += __shfl_xor(ss, 2); ss += __shfl_xor(ss, 4);
            const float rstd = rsqrtf(ss * (1.f / 128.f) + 1e-6f);
            const bf16_t* gp = GG + (rb + t) * 512 + h * 128 + seg * 16;
            const u32x4 g0 = *(const u32x4*)gp, g1 = *(const u32x4*)(gp + 8);
            const unsigned gw[8] = {g0.x, g0.y, g0.z, g0.w, g1.x, g1.y, g1.z, g1.w};
            unsigned ow[8];
#pragma unroll
            for (int i = 0; i < 4; ++i) {
                const f32x4 on = *(const f32x4*)(p.onorm + seg * 16 + 4 * i);
                const float y0 = ov[i][0] * rstd * on[0] * __uint_as_float(gw[2 * i] << 16), y1 = ov[i][1] * rstd * on[1] * __uint_as_float(gw[2 * i] & 0xffff0000u);
                const float y2 = ov[i][2] * rstd * on[2] * __uint_as_float(gw[2 * i + 1] << 16), y3 = ov[i][3] * rstd * on[3] * __uint_as_float(gw[2 * i + 1] & 0xffff0000u);
                ow[2 * i] = cvtpk(y0, y1); ow[2 * i + 1] = cvtpk(y2, y3);
            }
            bf16_t* mp = MIX + (rb + t) * 1024 + h * 128 + seg * 16;
            *(u32x4*)mp = (u32x4){ow[0], ow[1], ow[2], ow[3]}; *(u32x4*)(mp + 8) = (u32x4){ow[4], ow[5], ow[6], ow[7]};
        }
    }
#pragma unroll
    for (int jv = 0; jv < 4; ++jv)
#pragma unroll
        for (int r = 0; r < 4; ++r) p.out[O_GSP + ((size_t)(b * 4 + h) * 64 + tt * 16 + 4 * fq + r) * 128 + (vh * 4 + jv) * 16 + fr] = Sacc[jv][r];
    __syncthreads();
}

DI void sscore_unit(const Params& p, LAS3 unsigned char* lds, int u) {
    const int tid = threadIdx.x;
    unsigned char* ws = p.ws;
    const int b = u >> 3, pg = u & 7;
    LAS3 float* qf = (LAS3 float*)lds;
    if (tid < 256) qf[tid] = bf2f(((const bf16_t*)(ws + W_IQ))[(size_t)(MP + b) * 256 + tid]);
    __syncthreads();
    const int seg = tid & 15;
    f32x4 q[4];
#pragma unroll
    for (int h = 0; h < 4; ++h) q[h] = *(const LAS3 f32x4*)(qf + h * 64 + seg * 4);
    const f32x4 wv = *(const f32x4*)vaddr((const float*)(ws + W_IW) + (size_t)(MP + b) * 4);
    unsigned* sc = (unsigned*)(ws + W_SC) + (size_t)b * SCLD;
    const int* pt = p.page_table + b * NPAGES + pg * 16;
#define SS_LOAD(BUF, pp) do { const float* base_ = p.cache_ik + (size_t)pt[(pp) < 16 ? (pp) : 15] * 8192; \
        _Pragma("unroll") for (int i = 0; i < 4; ++i) BUF[i] = *(const f32x4*)(base_ + (size_t)(tid + 512 * i) * 4); } while (0)
#define SS_COMPUTE(BUF, pp) do { \
        _Pragma("unroll") for (int i = 0; i < 4; ++i) { const f32x4 kv = BUF[i]; float dh[4]; \
            _Pragma("unroll") for (int h = 0; h < 4; ++h) { float x = q[h][0] * kv[0] + q[h][1] * kv[1] + q[h][2] * kv[2] + q[h][3] * kv[3]; \
                x += __shfl_xor(x, 1); x += __shfl_xor(x, 2); x += __shfl_xor(x, 4); x += __shfl_xor(x, 8); dh[h] = x; } \
            const float s_ = wv[0] * fmaxf(dh[0], 0.f) + wv[1] * fmaxf(dh[1], 0.f) + wv[2] * fmaxf(dh[2], 0.f) + wv[3] * fmaxf(dh[3], 0.f); \
            if (seg == 0) __hip_atomic_store(sc + (pg * 16 + (pp)) * 128 + ((tid + 512 * i) >> 4), __float_as_uint(s_), __ATOMIC_RELAXED, __HIP_MEMORY_SCOPE_AGENT); } } while (0)
    f32x4 pa[4], pb[4];
    SS_LOAD(pa, 0); SS_LOAD(pb, 1);
#pragma unroll 1
    for (int pp = 0; pp < 16; pp += 2) {
        SS_COMPUTE(pa, pp); SS_LOAD(pa, pp + 2);
        SS_COMPUTE(pb, pp + 1); SS_LOAD(pb, pp + 3);
    }
#undef SS_LOAD
#undef SS_COMPUTE
    asm volatile("s_waitcnt vmcnt(0)" ::: "memory");
    __syncthreads();
    if (tid == 0) __hip_atomic_fetch_add((unsigned*)(ws + CW_SCNT), 1u, __ATOMIC_RELAXED, __HIP_MEMORY_SCOPE_AGENT);
}

constexpr int SA_Q = 2048, SA_S = 3072, SA_KP = 8192, SA_VP = 10240;
DI void sattend(const Params& p, LAS3 unsigned char* lds, const bf16_t* qrow  , const bf16_t* gate, bf16_t* mix) {
    const int tid = threadIdx.x, lane = tid & 63, w = tid >> 6;
    LAS3 float* qf = (LAS3 float*)(lds + SA_Q); LAS3 float* S = (LAS3 float*)(lds + SA_S);
    const float* const LAS3* kptr = (const float* const LAS3*)(lds + SA_KP); const float* const LAS3* vptr = (const float* const LAS3*)(lds + SA_VP);
    if (tid < 256) qf[tid] = bf2f(qrow[tid]);
    __syncthreads();
    {
        const int jk = tid >> 1, hp = tid & 1;
        const float* kr = kptr[jk] + hp * 128;
        float s0 = 0.f, s1 = 0.f;
#pragma unroll 4
        for (int i = 0; i < 16; ++i) {
            const f32x4 k0 = *(const f32x4*)(kr + 4 * i), k1 = *(const f32x4*)(kr + 64 + 4 * i);
            const f32x4 q0 = *(const LAS3 f32x4*)(qf + hp * 128 + 4 * i), q1 = *(const LAS3 f32x4*)(qf + hp * 128 + 64 + 4 * i);
            s0 += q0[0] * k0[0] + q0[1] * k0[1] + q0[2] * k0[2] + q0[3] * k0[3];
            s1 += q1[0] * k1[0] + q1[1] * k1[1] + q1[2] * k1[2] + q1[3] * k1[3];
        }
        S[(2 * hp) * 256 + jk] = s0; S[(2 * hp + 1) * 256 + jk] = s1;
    }
    __syncthreads();
    if (w < 4) {
        float v[4], mx = NEG_INF;
#pragma unroll
        for (int i = 0; i < 4; ++i) { v[i] = S[w * 256 + lane + 64 * i]; mx = fmaxf(mx, v[i]); }
        mx = wmax64(mx);
        float sum = 0.f;
#pragma unroll
        for (int i = 0; i < 4; ++i) { v[i] = __expf(v[i] - mx); sum += v[i]; }
        sum = wsum64(sum);
        const float inv = 1.f / sum;
#pragma unroll
        for (int i = 0; i < 4; ++i) S[w * 256 + lane + 64 * i] = v[i] * inv;
    }
    __syncthreads();
    {
        const int h = tid >> 7, dd = (tid >> 1) & 63, hf = tid & 1;
        float acc = 0.f;
#pragma unroll 4
        for (int jk = hf * 128; jk < hf * 128 + 128; ++jk) acc += S[h * 256 + jk] * vptr[jk][h * 64 + dd];
        acc += __shfl_xor(acc, 1);
        if (hf == 0) mix[h * 64 + dd] = f2bf(acc * bf2f(gate[h * 64 + dd]));
    }
    __syncthreads();
}
DI void smem_unit(const Params& p, LAS3 unsigned char* lds, int b) {
    const int tid = threadIdx.x; unsigned char* ws = p.ws;
    const float* LAS3* kptr = (const float* LAS3*)(lds + SA_KP); const float* LAS3* vptr = (const float* LAS3*)(lds + SA_VP);
    if (tid < 256) { kptr[tid] = p.cache_mem_k + ((size_t)b * NMEM + tid) * 256; vptr[tid] = p.cache_mem_v + ((size_t)b * NMEM + tid) * 256; }
    const size_t row = MP + b;
    sattend(p, lds, (const bf16_t*)(ws + W_MQ) + row * 256, (const bf16_t*)(ws + W_MG) + row * 256, (bf16_t*)(ws + W_MIX) + row * 1024 + 768);
}
DI void ssel_unit(const Params& p, LAS3 unsigned char* lds, int b) {
    const int tid = threadIdx.x, lane = tid & 63, w = tid >> 6; unsigned char* ws = p.ws;
    LAS3 unsigned* CNT = (LAS3 unsigned*)lds;
    LAS3 unsigned* wsum = (LAS3 unsigned*)(lds + 256);
    LAS3 float* newsc = (LAS3 float*)(lds + 320);
    LAS3 int* list = (LAS3 int*)(lds + 512);
    const float* LAS3* kptr = (const float* LAS3*)(lds + SA_KP); const float* LAS3* vptr = (const float* LAS3*)(lds + SA_VP);
    if (tid < 48) CNT[tid] = 0u;
    if (tid == 0) {
        unsigned* cnt = (unsigned*)(ws + CW_SCNT); unsigned* tmo = (unsigned*)(ws + CW_TMO); unsigned sp = 0;
        while (__hip_atomic_load(cnt, __ATOMIC_RELAXED, __HIP_MEMORY_SCOPE_AGENT) < 256u) {
            __builtin_amdgcn_s_sleep(2);
            if ((++sp & 255u) == 0u) { if (__hip_atomic_load(tmo, __ATOMIC_RELAXED, __HIP_MEMORY_SCOPE_AGENT)) break; if (sp > (1u << 20)) { __hip_atomic_store(tmo, 1u, __ATOMIC_RELAXED, __HIP_MEMORY_SCOPE_AGENT); break; } }
        }
        __builtin_amdgcn_fence(__ATOMIC_ACQUIRE, "agent");
        asm volatile("s_waitcnt vmcnt(0)" ::: "memory");
    }
    if (w == 1) {
        const bf16_t* iq = (const bf16_t*)(ws + W_IQ) + (size_t)(MP + b) * 256; const float kd = bf2f(((const bf16_t*)(ws + W_IK))[(size_t)(MP + b) * 64 + lane]);
        const f32x4 wv = *(const f32x4*)vaddr((const float*)(ws + W_IW) + (size_t)(MP + b) * 4);
        float s = 0.f;
#pragma unroll
        for (int h = 0; h < 4; ++h) { const float dh = wsum64(bf2f(iq[h * 64 + lane]) * kd); s += wv[h] * fmaxf(dh, 0.f); }
        if (lane == 0) *newsc = s;
    }
    __syncthreads();
    const float* sc = (const float*)(ws + W_SC) + (size_t)b * SCLD;
    unsigned key[33];
#pragma unroll
    for (int n = 0; n < 32; ++n) key[n] = fkey(sc[tid + 512 * n]);
    key[32] = (tid == 0) ? fkey(*newsc) : 0u;
    int it = 0;
    unsigned T = 0u, X = 0x7fffffffu; bool fin = false;
    for (int bit = 31; bit >= 0; --bit) {
        const unsigned cand = T | (1u << bit);
        unsigned c = 0;
#pragma unroll
        for (int n = 0; n < 33; ++n) cnt_ge(c, key[n], cand);
        const unsigned tot = blk_count(c, CNT, it, lane);
        if (tot >= 256u) { T = cand; fin = (tot == 256u); }
        if (fin) break;
    }
    if (!fin) {
        unsigned c = 0;
#pragma unroll
        for (int n = 0; n < 33; ++n) cnt_gt(c, key[n], T);
        const unsigned need = 256u - blk_count(c, CNT, it, lane);
        unsigned Xl = 0u;
        for (int bit = 14; bit >= 0; --bit) {
            const unsigned cand = Xl | (1u << bit);
            c = 0;
#pragma unroll
            for (int n = 0; n < 33; ++n) cnt_eq_lt(c, key[n], T, (unsigned)(tid + 512 * n), cand);
            if (blk_count(c, CNT, it, lane) < need) Xl = cand;
        }
        X = Xl;
    }
    unsigned selm = 0, hi = 0;
#pragma unroll
    for (int n = 0; n < 32; ++n) selm |= (key[n] > T || (key[n] == T && (unsigned)(tid + 512 * n) <= X)) ? (1u << n) : 0u;
    hi = (key[32] > T || (key[32] == T && (unsigned)(tid + 16384) <= X)) ? 1u : 0u;
    const unsigned cs = __popc(selm) + hi;
    unsigned inc = cs;
#pragma unroll
    for (int o2 = 1; o2 < 64; o2 <<= 1) { const unsigned t2 = __shfl_up(inc, o2); if (lane >= o2) inc += t2; }
    if (lane == 63) wsum[w] = inc;
    __syncthreads();
    unsigned pos = inc - cs;
    for (int w2 = 0; w2 < w; ++w2) pos += wsum[w2];
#pragma unroll
    for (int n = 0; n < 32; ++n) if ((selm >> n) & 1u) { if (pos < 256u) list[pos] = tid + 512 * n; ++pos; }
    if (hi) { if (pos < 256u) list[pos] = tid + 16384; ++pos; }
    __syncthreads();
    if (tid < 256) {
        const int idx = list[tid];
        if (idx < 16384) { const size_t phys = (size_t)p.page_table[b * NPAGES + (idx >> 7)] * 128 + (idx & 127); kptr[tid] = p.cache_k + phys * 256; vptr[tid] = p.cache_v + phys * 256; }
        else { kptr[tid] = p.out + O_KS + (size_t)b * 256; vptr[tid] = p.out + O_VS + (size_t)b * 256; }
    }
    const size_t row = MP + b;
    sattend(p, lds, (const bf16_t*)(ws + W_DQ) + row * 256, (const bf16_t*)(ws + W_DG) + row * 256, (bf16_t*)(ws + W_MIX) + row * 1024 + 512);
}
DI void sgla_unit(const Params& p, LAS3 unsigned char* lds, int b) {
    const int tid = threadIdx.x, lane = tid & 63, w = tid >> 6; unsigned char* ws = p.ws;
    LAS3 float* qs = (LAS3 float*)lds; LAS3 float* ks = qs + 256; LAS3 float* gs = qs + 512; LAS3 float* vs = qs + 768; LAS3 float* part = qs + 1280;
    const size_t row = MP + b;
    if (tid < 256) {
        float u = p.b_g[tid];
        const float* gl = vaddr((const float*)(ws + W_GLR) + row * 16);
#pragma unroll
        for (int r = 0; r < 16; ++r) u += gl[r] * p.w_g2[r * 256 + tid];
        gs[tid] = expf(logsigf(u) * (1.f / 16.f));
        qs[tid] = bf2f(((const bf16_t*)(ws + W_GQ))[row * 256 + tid]); ks[tid] = bf2f(((const bf16_t*)(ws + W_GK))[row * 256 + tid]);
    }
    vs[tid] = bf2f(((const bf16_t*)(ws + W_GV))[row * 512 + tid]);
    __syncthreads();
    const int h = tid >> 7, v = tid & 127;
    const float* sp = p.state_gla + ((size_t)(b * 4 + h) * 64) * 128 + v; float* so = p.out + O_GSS + ((size_t)(b * 4 + h) * 64) * 128 + v;
    const float vv = vs[h * 128 + v];
    float o = 0.f;
#pragma unroll 8
    for (int dd = 0; dd < 64; ++dd) { const float sn = gs[h * 64 + dd] * sp[dd * 128] + ks[h * 64 + dd] * vv; so[dd * 128] = sn; o += qs[h * 64 + dd] * sn; }
    const float ss = wsum64(o * o);
    if (lane == 0) part[w] = ss;
    __syncthreads();
    const float rstd = rsqrtf((part[2 * h] + part[2 * h + 1]) * (1.f / 128.f) + 1e-6f);
    ((bf16_t*)(ws + W_MIX))[row * 1024 + h * 128 + v] = f2bf(o * rstd * p.onorm[v] * bf2f(((const bf16_t*)(ws + W_GG))[row * 512 + h * 128 + v]));
    __syncthreads();
}
DI void p4_final(const Params& p) {
    const int tid = threadIdx.x, lane = tid & 63, wv = tid >> 6;
    for (int r = blockIdx.x * 8 + wv; r < MP + NDB; r += gridDim.x * 8) {
        float* y = p.out + (r < MP ? O_YP + (size_t)r * DM : O_YS + (size_t)(r - MP) * DM);
        f32x4 v[4]; float ss = 0.f;
#pragma unroll
        for (int i = 0; i < 4; ++i) { v[i] = *(const f32x4*)(y + i * 256 + lane * 4); ss += v[i][0] * v[i][0] + v[i][1] * v[i][1] + v[i][2] * v[i][2] + v[i][3] * v[i][3]; }
        ss = wsum64(ss);
        const float rstd = rsqrtf(ss * (1.f / DM) + 1e-6f);
#pragma unroll
        for (int i = 0; i < 4; ++i) { const f32x4 gv = *(const f32x4*)(p.norm_final + i * 256 + lane * 4); *(f32x4*)(y + i * 256 + lane * 4) = v[i] * rstd * gv; }
    }
}

DI int next_unit(unsigned* ctr, volatile LAS3 unsigned* slot) {
    if (threadIdx.x == 0) *slot = __hip_atomic_fetch_add(ctr, 1u, __ATOMIC_RELAXED, __HIP_MEMORY_SCOPE_AGENT);
    __syncthreads();
    const int v = __builtin_amdgcn_readfirstlane((int)*slot);
    __syncthreads();
    return v;
}

#ifndef REP1
#define REP1 1
#endif
#ifndef REP2
#define REP2 1
#endif
#ifndef REP3
#define REP3 1
#endif
#ifndef REP2A
#define REP2A 1
#endif
#ifndef REP2B
#define REP2B 1
#endif
#ifndef REP2C
#define REP2C 1
#endif
#ifndef REP2D
#define REP2D 1
#endif
#ifndef REP2E
#define REP2E 1
#endif
DI void phase1(const Params& p, LAS3 unsigned char* lds) {
    unsigned char* ws = p.ws;
    { pg8::Gemm g{(const bf16_t*)(ws + W_XN), (const bf16_t*)(ws + W_WTIN), MROWS, NIN, DM}; pg8::StaticOrder S; S.init(MROWS, NIN, (int)gridDim.x, (int)blockIdx.x);
      EpiIn E{ws, p.out}; pg8::gemm_phase<EpiIn, pg8::StaticOrder, true, true>(lds, g, S, E); }
    { pg8::Gemm g{(const bf16_t*)(ws + W_MEMN), (const bf16_t*)(ws + W_WTMEM), MMEM, 512, DM}; pg8::StaticOrder S;
      S.init(MMEM, 512, (int)gridDim.x, (int)((blockIdx.x + gridDim.x - (1806u % gridDim.x)) % gridDim.x));
      EpiMem E{ws, p.out}; pg8::gemm_phase<EpiMem, pg8::StaticOrder, true, true>(lds, g, S, E); }
}
template <int QI> DI void p2_sscore(const Params& p, LAS3 unsigned char* lds) { for (int u = blockIdx.x; u < 256; u += gridDim.x) { sscore_unit(p, lds, u); __syncthreads(); } }
template <int QI> DI void p2_gla(const Params& p, LAS3 unsigned char* lds) { for (int u = blockIdx.x; u < 64; u += gridDim.x) gla_unit(p, lds, u >> 2, u & 3); }
DI int next_unit_xcd(unsigned char* qbase, volatile LAS3 unsigned* slot, unsigned x0) {
    if (threadIdx.x == 0) {
        unsigned res = 0xffffffffu;
        for (unsigned k = 0; k < 8u; ++k) {
            const unsigned xq = (x0 + k) & 7u;
            const unsigned mq = __hip_atomic_fetch_add((unsigned*)(qbase + 256 * xq), 1u, __ATOMIC_RELAXED, __HIP_MEMORY_SCOPE_AGENT);
            if (mq < 64u) { res = xq * 64u + mq; break; }
        }
        *slot = res;
    }
    __syncthreads();
    const int v = __builtin_amdgcn_readfirstlane((int)*slot);
    __syncthreads();
    return v;
}
template <int QI> DI void p2_dsa(const Params& p, LAS3 unsigned char* lds, volatile LAS3 unsigned* MISC TARGS) {
#if defined(XCDQ) && XCDQ
    const unsigned x0 = xb_xcc_id() & 7u;
    for (;;) { const int n = next_unit_xcd(p.ws + CW_QDSA + 8192 * QI, MISC + 4, x0); if (n < 0) break; const int m = n & 63; dsa_unit(p, lds, 2 * (n >> 6) + (m >> 5), 31 - (m & 31) TPASS); }
#else
    for (;;) { const int n = next_unit((unsigned*)(p.ws + CW_QDSA + 8192 * QI), MISC + 4); if (n >= 512) break; dsa_unit(p, lds, n & 15, 31 - (n >> 4) TPASS); }
#endif
}
template <int QI> DI void p2_mem(const Params& p, LAS3 unsigned char* lds, volatile LAS3 unsigned* MISC) {
    for (;;) { const int n = next_unit((unsigned*)(p.ws + CW_QMEM + 8192 * QI), MISC + 4); if (n >= 512) break; mem_unit(p, n); } }
template <int QI> DI void p2_sample(const Params& p, LAS3 unsigned char* lds) {
    for (int u = (int)gridDim.x - 1 - (int)blockIdx.x; u < 96; u += gridDim.x) { if (u < 32) sgla_unit(p, lds, u); else if (u < 64) smem_unit(p, lds, u - 32); else ssel_unit(p, lds, u - 64); } }
template <int RI> DI void phase2(const Params& p, LAS3 unsigned char* lds, volatile LAS3 unsigned* MISC TARGS) {
    TBEG(20); TBEG(21); p2_sscore<0>(p, lds); TEND(21); if (REP2A > 1) p2_sscore<1>(p, lds);
    TBEG(25); p2_sample<0>(p, lds); TEND(25); if (REP2E > 1) p2_sample<1>(p, lds);
    TBEG(22); p2_gla<0>(p, lds); TEND(22); if (REP2B > 1) p2_gla<1>(p, lds);
    TBEG(23); p2_dsa<0>(p, lds, MISC TPASS); TEND(23); if (REP2C > 1) p2_dsa<1>(p, lds, MISC TPASS);
    TBEG(24); p2_mem<0>(p, lds, MISC); TEND(24); if (REP2D > 1) p2_mem<1>(p, lds, MISC);
    TEND(20);
}
DI void phase3(const Params& p, LAS3 unsigned char* lds) {
    pg8::Gemm g{(const bf16_t*)(p.ws + W_MIX), (const bf16_t*)(p.ws + W_WTOUT), MP, DM, DM}; pg8::StaticOrder S; S.init(MP, DM, (int)gridDim.x, (int)blockIdx.x);
    EpiOut E{p.x_prompt, p.x_sample, p.out}; pg8::gemm_phase<EpiOut, pg8::StaticOrder, true, true>(lds, g, S, E);
    const int tid = threadIdx.x, lane = tid & 63, wv = tid >> 6;
    for (int u = blockIdx.x; u < 256; u += gridDim.x) {
        const int b = u >> 3, col0 = (u & 7) * 128 + wv * 16;
        const bf16_t* mrow = (const bf16_t*)(p.ws + W_MIX) + (size_t)(MP + b) * 1024 + lane * 16;
        const u32x4 m0 = *(const u32x4*)mrow, m1 = *(const u32x4*)(mrow + 8);
        const unsigned mw[8] = {m0.x, m0.y, m0.z, m0.w, m1.x, m1.y, m1.z, m1.w};
        float res = 0.f;
#pragma unroll 4
        for (int i = 0; i < 16; ++i) {
            const bf16_t* wrow = (const bf16_t*)(p.ws + W_WTOUT) + (size_t)(col0 + i) * 1024 + lane * 16;
            const u32x4 w0 = *(const u32x4*)wrow, w1 = *(const u32x4*)(wrow + 8);
            const unsigned ww[8] = {w0.x, w0.y, w0.z, w0.w, w1.x, w1.y, w1.z, w1.w};
            float acc = 0.f;
#pragma unroll
            for (int e = 0; e < 8; ++e) acc += __uint_as_float(mw[e] << 16) * __uint_as_float(ww[e] << 16) + __uint_as_float(mw[e] & 0xffff0000u) * __uint_as_float(ww[e] & 0xffff0000u);
            acc = wsum64(acc);
            res = (lane == i) ? acc : res;
        }
        if (lane < 16) p.out[O_YS + (size_t)b * DM + col0 + lane] = p.x_sample[(size_t)b * DM + col0 + lane] + res;
    }
}
#ifdef CHECK_ATT
DI void check_mem_attention(const Params& p) {
    const int tid = threadIdx.x, lane = tid & 63, wv = tid >> 6;
    const int samp = blockIdx.x * 8 + wv;
    const int row = (samp * 977 + 13) % MP, h = samp & 3, b = row >> 11;
    const bf16_t* q = (const bf16_t*)(p.ws + W_MQ) + (size_t)row * 256 + h * 64;
    float s[4];
#pragma unroll
    for (int i = 0; i < 4; ++i) { const float* kr = p.out + O_MKP + ((size_t)b * NMEM + lane + 64 * i) * 256 + h * 64; float a = 0.f; for (int d = 0; d < 64; ++d) a += bf2f(q[d]) * kr[d]; s[i] = a; }
    float mx = wmax64(fmaxf(fmaxf(s[0], s[1]), fmaxf(s[2], s[3])));
    float pe[4], sum = 0.f;
#pragma unroll
    for (int i = 0; i < 4; ++i) { pe[i] = __expf(s[i] - mx); sum += pe[i]; }
    sum = wsum64(sum);
    float err = 0.f, nrm = 0.f;
    for (int d = 0; d < 64; ++d) {
        float a = 0.f;
#pragma unroll
        for (int i = 0; i < 4; ++i) a += pe[i] * p.out[O_MVP + ((size_t)b * NMEM + lane + 64 * i) * 256 + h * 64 + d];
        a = wsum64(a) / sum;
        const float want = a * bf2f(((const bf16_t*)(p.ws + W_MG))[(size_t)row * 256 + h * 64 + d]);
        const float got = bf2f(((const bf16_t*)(p.ws + W_MIX))[(size_t)row * 1024 + 768 + h * 64 + d]);
        err += (got - want) * (got - want); nrm += want * want;
    }
    if (lane == 0) { atomicAdd((unsigned*)(p.ws + CW_CHK + 12), 1u); if (!(err <= 0.0025f * nrm + 1e-12f)) atomicAdd((unsigned*)(p.ws + CW_CHK + 8), 1u); }
}
#endif
__global__ void __launch_bounds__(NTHREADS, 2) hymba_fwd(Params p) {
    extern __shared__ __attribute__((aligned(16))) unsigned char lds_raw[];
    LAS3 unsigned char* lds = (LAS3 unsigned char*)lds_raw;
    volatile LAS3 unsigned* MISC = (volatile LAS3 unsigned*)(lds + LDS_MISC);
    const int tid = threadIdx.x;
    if (tid < 64) MISC[tid] = 0u;
    __syncthreads();
    const int lo = p.ph_lo, hi = p.ph_hi;
    TDECL;
    XcdBarrier bar; bar.bar = (unsigned*)p.ws; bar.x = 0; bar.st = MISC;
    if (hi > lo) bar = xcd_barrier_post((unsigned*)p.ws, MISC);
#define IN(k) (lo <= (k) && (k) <= hi)
#define SEAM(k) do { if (IN(k) && IN((k) + 1)) xcd_barrier(bar); } while (0)
    TBEG(0); if (IN(0)) p0_prologue(p, lds); TEND(0);
    TBEG(10); SEAM(0); TEND(10);
    TBEG(1); if (IN(1)) { phase1(p, lds); if (REP1 > 1) { xcd_barrier(bar); phase1(p, lds); } } TEND(1);
    TBEG(11); SEAM(1); TEND(11);
    TBEG(2); if (IN(2)) { phase2<0>(p, lds, MISC TPASS); } TEND(2);
    TBEG(12); SEAM(2); TEND(12);
#ifdef CHECK_ATT
    if (IN(3)) check_mem_attention(p);
#endif
    TBEG(3); if (IN(3)) { phase3(p, lds); if (REP3 > 1) { xcd_barrier(bar); phase3(p, lds); } } TEND(3);
    TBEG(13); SEAM(3); TEND(13);
    TBEG(4); if (IN(4)) p4_final(p); TEND(4);
#ifdef TSEL
    {
        if (tid == 0) { atomicAdd((unsigned long long*)(p.ws + CW_TSUM), (unsigned long long)tacc_); atomicMax((unsigned long long*)(p.ws + CW_TMAX), (unsigned long long)tacc_); }
        xcd_barrier(bar);
        if (blockIdx.x == 0 && tid == 0) {
#ifdef TMAX
            const unsigned long long dly = __hip_atomic_load((unsigned long long*)(p.ws + CW_TMAX), __ATOMIC_RELAXED, __HIP_MEMORY_SCOPE_AGENT);
#else
            const unsigned long long dly = __hip_atomic_load((unsigned long long*)(p.ws + CW_TSUM), __ATOMIC_RELAXED, __HIP_MEMORY_SCOPE_AGENT) / gridDim.x;
#endif
            const unsigned long long t0 = __builtin_amdgcn_s_memrealtime();
            while (__builtin_amdgcn_s_memrealtime() - t0 < dly && __builtin_amdgcn_s_memrealtime() - t0 < 400000ull) __builtin_amdgcn_s_sleep(8);
        }
    }
#endif
#ifdef CHECK_ATT
    {
        xcd_barrier(bar);
        const unsigned nbad = __hip_atomic_load((unsigned*)(p.ws + CW_CHK + 8), __ATOMIC_RELAXED, __HIP_MEMORY_SCOPE_AGENT);
        const unsigned nchk = __hip_atomic_load((unsigned*)(p.ws + CW_CHK + 12), __ATOMIC_RELAXED, __HIP_MEMORY_SCOPE_AGENT);
        if (nbad != 0u || nchk < 2000u) for (int i = blockIdx.x * NTHREADS + tid; i < NDB * DM; i += gridDim.x * NTHREADS) p.out[O_YS + i] = __builtin_nanf("");
    }
#endif
#ifdef CHECK_SEL
    {
        xcd_barrier(bar);
        const unsigned nbad = __hip_atomic_load((unsigned*)(p.ws + CW_CHK), __ATOMIC_RELAXED, __HIP_MEMORY_SCOPE_AGENT);
        const unsigned nhist = __hip_atomic_load((unsigned*)(p.ws + CW_CHK + 4), __ATOMIC_RELAXED, __HIP_MEMORY_SCOPE_AGENT);
        if (nbad != 0u || nhist < CHECK_MIN_HIST) for (int i = blockIdx.x * NTHREADS + tid; i < NDB * DM; i += gridDim.x * NTHREADS) p.out[O_YS + i] = __builtin_nanf("");
    }
#endif
#undef IN
#undef SEAM
}

#ifndef N_LAUNCHES
#define N_LAUNCHES 1
#endif
extern "C" void kernel_launch(void* const* d_in, const int* in_sizes, int n_in, void* d_out, int out_size, void* d_ws, size_t ws_size, hipStream_t stream) {
    static int grid = 0;
    if (grid == 0) {
        if (n_in != 19 || (size_t)out_size != O_END || ws_size < W_END) fprintf(stderr, "kernel_launch: unexpected sizes: n_in %d out %d ws %zu (need %zu)\n", n_in, out_size, ws_size, (size_t)W_END);
        int dev = 0, cus = 0, per_cu = 0;
        if (hipGetDevice(&dev) != hipSuccess || hipDeviceGetAttribute(&cus, hipDeviceAttributeMultiprocessorCount, dev) != hipSuccess) { fprintf(stderr, "kernel_launch: device query failed\n"); grid = -1; return; }
        if (hipFuncSetAttribute((const void*)hymba_fwd, hipFuncAttributeMaxDynamicSharedMemorySize, LDS_BYTES) != hipSuccess) { fprintf(stderr, "kernel_launch: hipFuncSetAttribute failed\n"); grid = -1; return; }
        if (hipOccupancyMaxActiveBlocksPerMultiprocessor(&per_cu, (const void*)hymba_fwd, NTHREADS, LDS_BYTES) != hipSuccess || per_cu < 1) fprintf(stderr, "kernel_launch: occupancy query reports %d blocks per CU\n", per_cu);
        (void)hipGetLastError();
        grid = cus;
    }
    if (grid < 0) return;
    (void)hipMemsetAsync(d_ws, 0, CTRL_BYTES, stream);
    Params p{};
    p.x_prompt = (const float*)d_in[0]; p.x_sample = (const float*)d_in[1]; p.mem_prompt = (const float*)d_in[2]; p.state_gla = (const float*)d_in[3];
    p.cache_k = (const float*)d_in[4]; p.cache_v = (const float*)d_in[5]; p.cache_ik = (const float*)d_in[6]; p.cache_mem_k = (const float*)d_in[7]; p.cache_mem_v = (const float*)d_in[8];
    p.page_table = (const int*)d_in[9];
    p.norm_in = (const float*)d_in[10]; p.w_in = (const float*)d_in[11]; p.w_g2 = (const float*)d_in[12]; p.b_g = (const float*)d_in[13]; p.onorm = (const float*)d_in[14];
    p.mem_norm = (const float*)d_in[15]; p.w_mem_kv = (const float*)d_in[16]; p.w_out = (const float*)d_in[17]; p.norm_final = (const float*)d_in[18];
    p.out = (float*)d_out; p.ws = (unsigned char*)d_ws;
#if N_LAUNCHES == 1
    p.ph_lo = 0; p.ph_hi = 4;
    hipLaunchKernelGGL(hymba_fwd, dim3(grid), dim3(NTHREADS), LDS_BYTES, stream, p);
#else
    for (int ph = 0; ph < 5; ++ph) { p.ph_lo = ph; p.ph_hi = ph; hipLaunchKernelGGL(hymba_fwd, dim3(grid), dim3(NTHREADS), LDS_BYTES, stream, p); }
#endif
    const hipError_t le = hipPeekAtLastError();
    if (le != hipSuccess) fprintf(stderr, "kernel_launch: launch failed: %s\n", hipGetErrorName(le));
}
```

```cpp
#include <hip/hip_runtime.h>
#include <cstdint>
#include <cstdio>
namespace pg8 {
#define PG8_LAS __attribute__((address_space(3)))
typedef unsigned short bf16_t;
typedef short bf16x8 __attribute__((ext_vector_type(8)));
typedef float f32x4 __attribute__((ext_vector_type(4)));
typedef unsigned u32x4 __attribute__((ext_vector_type(4)));
constexpr int BM = 256, BK = 64, HALF = 128, HTB = HALF * BK * 2  , STAGE_BYTES = 8 * HTB, NXCD = 8, WGM = 8;

__host__ __device__ __forceinline__ int lds_byte(int r, int c) { const int st = (r >> 4) * 2 + (c >> 5), rr = r & 15, cc = c & 31, ob = rr * 64 + cc * 2; return st * 1024 + (ob ^ (((ob >> 9) & 1) << 5)); }
__host__ __device__ __forceinline__ void stage_rc(int b, int& R, int& C) { const int st = b / 1024, sb = b % 1024, swz = sb ^ (((sb >> 9) & 1) << 5); R = (st >> 1) * 16 + swz / 64; C = (st & 1) * 32 + (swz % 64) / 2; }
__host__ __device__ __forceinline__ int perm32(int rho) { const int n = rho >> 4, i = rho & 15; return 8 * (i >> 2) + 4 * n + (i & 3); }

struct Unit { int pm, pn; };
struct Gemm { const bf16_t* A; const bf16_t* Bt; int M, N, K; };

struct StaticOrder {
    int nM, nN, nwg, G, c;
    __host__ __device__ void init(int M, int N, int G_, int c_) { nM = M / BM; nN = N / BM; nwg = nM * nN; G = G_; c = c_; }
    __host__ __device__ bool next(int i, Unit& u) const {
        const long L = (long)i * G + c; if (L >= nwg) return false;
        int wgid = (int)L; { const int q = nwg / NXCD, r = nwg % NXCD, xcd = wgid % NXCD, off = wgid / NXCD; wgid = (xcd < r ? xcd * (q + 1) : r * (q + 1) + (xcd - r) * q) + off; }
        const int nig = WGM * nN, gid = wgid / nig, fm = gid * WGM, gsz = (nM - fm) < WGM ? (nM - fm) : WGM;
        u.pm = fm + ((wgid % nig) % gsz); u.pn = (wgid % nig) / gsz; return true;
    }
    __device__ __forceinline__ void a_ready(const Unit&) const {}
    __device__ __forceinline__ void done(const Unit&) const {}
};

template <class Epi, class Sched, bool ALIGN_EPI = false, bool SP2 = false>
__device__ __forceinline__ void gemm_phase(PG8_LAS unsigned char* lds, const Gemm g, const Sched& S, const Epi& E) {
    const int tid = threadIdx.x, wid = __builtin_amdgcn_readfirstlane(tid >> 6), lane = tid & 63, wr = wid >> 2, wc = wid & 3, fr = lane & 15, fq = lane >> 4;
    const int K = g.K, nt = K / BK;
    unsigned voffA[2], voffB[2];
#pragma unroll
    for (int i = 0; i < 2; ++i) { int R, C; stage_rc(tid * 16 + i * 8192, R, C); const int Rb = Epi::PERM ? ((R & ~31) + perm32(R & 31)) : R;
        voffA[i] = (unsigned)(R * K + C) * 2u; voffB[i] = (unsigned)(Rb * K + C) * 2u; }
    const size_t kstep = (size_t)(BK * 2);
    const size_t hstep = (size_t)HALF * K * 2;
    const size_t tstep = 2 * hstep;
    const unsigned ldsw = (unsigned)wid * 1024u;
    const int aoff = lds_byte(wr * 64 + fr, fq * 8), boff = lds_byte(wc * 32 + fr, fq * 8);
#define PG8_SA(b, h) (((b) * 2 + (h)) * HTB)
#define PG8_SB(b, h) ((4 + (b) * 2 + (h)) * HTB)
#define PG8_STAGE(bufoff, gbase, voff) do { _Pragma("unroll") for (int _i = 0; _i < 2; ++_i) \
        __builtin_amdgcn_global_load_lds((const unsigned*)((const char*)(gbase) + (voff)[_i]), (PG8_LAS unsigned*)(lds + (bufoff) + ldsw + _i * 8192), 16, 0, 0); } while (0)
#define PG8_LDA(dst, b, h) do { _Pragma("unroll") for (int m = 0; m < 4; ++m) _Pragma("unroll") for (int k = 0; k < 2; ++k) dst[m][k] = *(const PG8_LAS bf16x8*)(lds + PG8_SA(b, h) + aoff + m * 2048 + k * 1024); } while (0)
#define PG8_LDB(dst, b, h) do { _Pragma("unroll") for (int n = 0; n < 2; ++n) _Pragma("unroll") for (int k = 0; k < 2; ++k) dst[n][k] = *(const PG8_LAS bf16x8*)(lds + PG8_SB(b, h) + boff + n * 2048 + k * 1024); } while (0)
#define PG8_MMA(ai, bj, At, Bt) do { __builtin_amdgcn_s_setprio(1); _Pragma("unroll") for (int m = 0; m < 4; ++m) _Pragma("unroll") for (int n = 0; n < 2; ++n) _Pragma("unroll") for (int k = 0; k < 2; ++k) \
        acc[ai][bj][m][n] = __builtin_amdgcn_mfma_f32_16x16x32_bf16(Bt[n][k], At[m][k], acc[ai][bj][m][n], 0, 0, 0); __builtin_amdgcn_s_setprio(0); } while (0)
#define PG8_WAIT_V(n) asm volatile("s_waitcnt vmcnt(" #n ")" ::: "memory")
#define PG8_WAIT_L(n) asm volatile("s_waitcnt lgkmcnt(" #n ")" ::: "memory")
#define PG8_BAR __builtin_amdgcn_s_barrier()
#define PG8_SCHED __builtin_amdgcn_sched_barrier(0)
    Unit cur, nxt; int ui = 0;
    if (!S.next(0, cur)) return;
    f32x4 acc[2][2][4][2];
#pragma unroll
    for (int a = 0; a < 2; ++a)
#pragma unroll
        for (int b = 0; b < 2; ++b)
#pragma unroll
            for (int m = 0; m < 4; ++m)
#pragma unroll
                for (int n = 0; n < 2; ++n) acc[a][b][m][n] = (f32x4){0.f, 0.f, 0.f, 0.f};
    bf16x8 At[4][2], B0[2][2], B1[2][2];
    const char* cA = (const char*)g.A + (size_t)cur.pm * tstep; const char* cB = (const char*)g.Bt + (size_t)cur.pn * tstep;
    S.a_ready(cur);
    if constexpr (SP2) {
        PG8_STAGE(PG8_SB(0, 0), cB, voffB); PG8_STAGE(PG8_SB(0, 1), cB + hstep, voffB); PG8_STAGE(PG8_SA(0, 0), cA, voffA); PG8_STAGE(PG8_SA(0, 1), cA + hstep, voffA);
        if (wr == 1) PG8_BAR;
        PG8_WAIT_V(2); PG8_BAR;
        PG8_STAGE(PG8_SB(1, 0), cB + kstep, voffB); PG8_STAGE(PG8_SA(1, 0), cA + kstep, voffA); PG8_STAGE(PG8_SB(1, 1), cB + hstep + kstep, voffB);
        PG8_WAIT_V(6); PG8_BAR;
    } else {
        PG8_STAGE(PG8_SB(0, 0), cB, voffB); PG8_STAGE(PG8_SA(0, 0), cA, voffA); PG8_STAGE(PG8_SB(0, 1), cB + hstep, voffB); PG8_STAGE(PG8_SA(0, 1), cA + hstep, voffA);
        if (wr == 1) PG8_BAR;
        PG8_WAIT_V(4); PG8_BAR;
        PG8_STAGE(PG8_SB(1, 0), cB + kstep, voffB); PG8_STAGE(PG8_SA(1, 0), cA + kstep, voffA); PG8_STAGE(PG8_SB(1, 1), cB + hstep + kstep, voffB);
        PG8_WAIT_V(6); PG8_BAR;
    }
    for (;;) {
        const bool has_next = S.next(ui + 1, nxt);
        const char* nA = has_next ? (const char*)g.A + (size_t)nxt.pm * tstep : cA; const char* nB = has_next ? (const char*)g.Bt + (size_t)nxt.pn * tstep : cB;
        for (int t = 0; t < nt; t += 2) {
            const bool last = (t == nt - 2);
            const char* a1 = cA + (size_t)(t + 1) * kstep;
            const char* a2 = last ? nA : cA + (size_t)(t + 2) * kstep; const char* b2 = last ? nB : cB + (size_t)(t + 2) * kstep;
            const char* a3 = a2 + kstep; const char* b3 = b2 + kstep;
            if (last && has_next) S.a_ready(nxt);
            if constexpr (SP2) {
            PG8_LDB(B0, 0, 0); PG8_LDB(B1, 0, 1); PG8_SCHED; PG8_LDA(At, 0, 0); PG8_STAGE(PG8_SA(1, 1), a1 + hstep, voffA);
            PG8_WAIT_V(8); PG8_WAIT_L(0); PG8_BAR; PG8_MMA(0, 0, At, B0); PG8_MMA(0, 1, At, B1); PG8_BAR; PG8_SCHED;
            PG8_LDA(At, 0, 1); PG8_STAGE(PG8_SB(0, 0), b2, voffB); PG8_STAGE(PG8_SB(0, 1), b2 + hstep, voffB); PG8_STAGE(PG8_SA(0, 0), a2, voffA);
            PG8_WAIT_V(8); PG8_WAIT_L(0); PG8_BAR; PG8_MMA(1, 0, At, B0); PG8_MMA(1, 1, At, B1); PG8_BAR; PG8_SCHED;
            PG8_LDB(B0, 1, 0); PG8_LDB(B1, 1, 1); PG8_SCHED; PG8_LDA(At, 1, 0); PG8_STAGE(PG8_SA(0, 1), a2 + hstep, voffA);
            PG8_WAIT_V(8); PG8_WAIT_L(0); PG8_BAR; PG8_MMA(0, 0, At, B0); PG8_MMA(0, 1, At, B1); PG8_BAR; PG8_SCHED;
            PG8_LDA(At, 1, 1); PG8_STAGE(PG8_SB(1, 0), b3, voffB); PG8_STAGE(PG8_SB(1, 1), b3 + hstep, voffB); PG8_STAGE(PG8_SA(1, 0), a3, voffA);
            PG8_WAIT_V(8); PG8_WAIT_L(0); PG8_BAR; PG8_MMA(1, 0, At, B0); PG8_MMA(1, 1, At, B1); PG8_BAR; PG8_SCHED;
            } else {
            PG8_LDB(B0, 0, 0); PG8_SCHED; PG8_LDA(At, 0, 0); PG8_STAGE(PG8_SA(1, 1), a1 + hstep, voffA);
            PG8_WAIT_L(8); PG8_BAR; PG8_WAIT_L(0); PG8_MMA(0, 0, At, B0); PG8_BAR; PG8_SCHED;
            PG8_LDB(B1, 0, 1); PG8_STAGE(PG8_SB(0, 0), b2, voffB);
            PG8_BAR; PG8_WAIT_L(0); PG8_MMA(0, 1, At, B1); PG8_BAR;
            PG8_LDA(At, 0, 1); PG8_STAGE(PG8_SA(0, 0), a2, voffA);
            PG8_BAR; PG8_WAIT_L(0); PG8_MMA(1, 0, At, B0); PG8_BAR; PG8_SCHED;
            PG8_STAGE(PG8_SB(0, 1), b2 + hstep, voffB);
            PG8_WAIT_V(6); PG8_BAR; PG8_MMA(1, 1, At, B1); PG8_BAR;
            PG8_LDB(B0, 1, 0); PG8_SCHED; PG8_LDA(At, 1, 0); PG8_STAGE(PG8_SA(0, 1), a2 + hstep, voffA);
            PG8_WAIT_L(8); PG8_BAR; PG8_WAIT_L(0); PG8_MMA(0, 0, At, B0); PG8_BAR; PG8_SCHED;
            PG8_LDB(B1, 1, 1); PG8_STAGE(PG8_SB(1, 0), b3, voffB);
            PG8_BAR; PG8_WAIT_L(0); PG8_MMA(0, 1, At, B1); PG8_BAR;
            PG8_LDA(At, 1, 1); PG8_STAGE(PG8_SA(1, 0), a3, voffA);
            PG8_BAR; PG8_WAIT_L(0); PG8_MMA(1, 0, At, B0); PG8_BAR; PG8_SCHED;
            PG8_STAGE(PG8_SB(1, 1), b3 + hstep, voffB);
            PG8_WAIT_V(6); PG8_BAR; PG8_MMA(1, 1, At, B1); PG8_BAR;
            }
        }
        if constexpr (ALIGN_EPI) { if (wr == 0) PG8_BAR; }
        if constexpr (!Epi::AFTER_DRAIN) { E(acc, cur, wr, wc, fr, fq); S.done(cur); }
        if (!has_next) break;
#pragma unroll
        for (int a = 0; a < 2; ++a)
#pragma unroll
            for (int b = 0; b < 2; ++b)
#pragma unroll
                for (int m = 0; m < 4; ++m)
#pragma unroll
                    for (int n = 0; n < 2; ++n) acc[a][b][m][n] = (f32x4){0.f, 0.f, 0.f, 0.f};
        cur = nxt; cA = nA; cB = nB; ++ui;
        if constexpr (ALIGN_EPI) { if (wr == 1) PG8_BAR; }
    }
    PG8_WAIT_V(0);
    if constexpr (!ALIGN_EPI) { if (wr == 0) PG8_BAR; }
    PG8_BAR;
    if constexpr (Epi::AFTER_DRAIN) { E.fused(acc, cur, wr, wc, fr, fq, lds, wid, lane); S.done(cur); }
#undef PG8_SA
#undef PG8_SB
#undef PG8_STAGE
#undef PG8_LDA
#undef PG8_LDB
#undef PG8_MMA
#undef PG8_WAIT_V
#undef PG8_WAIT_L
#undef PG8_BAR
#undef PG8_SCHED
}
}
#define XB_TMO      128
#define XB_XCNT(j)  (256  + 64 * (j))
#define XB_XSUB(j)  (1280 + 64 * (j))
#define XB_XGEN(j)  (2304 + 64 * (j))
#define XB_TOP      3328
#define XB_TOPGEN   3392
#define XCD_BAR_WORDS 3456
#define XB_SPIN_CAP (1u << 18)
#define LAS __attribute__((address_space(3)))

__device__ __forceinline__ unsigned xb_ld(unsigned* p)              { return __hip_atomic_load(p, __ATOMIC_RELAXED, __HIP_MEMORY_SCOPE_AGENT); }
__device__ __forceinline__ unsigned xb_add(unsigned* p, unsigned v) { return __hip_atomic_fetch_add(p, v, __ATOMIC_RELAXED, __HIP_MEMORY_SCOPE_AGENT); }
__device__ __forceinline__ unsigned xb_xcc_id() { return (unsigned)__builtin_amdgcn_s_getreg((3 << 11) | 20) & 0xFu; }
#define XB_SPIN(cond, bar) do { unsigned _sp = 0; while (cond) { __builtin_amdgcn_s_sleep(1); \
    if ((++_sp & 255u) == 0u) { if (xb_ld(&(bar)[XB_TMO])) break; if (_sp > XB_SPIN_CAP) { atomicAdd(&(bar)[XB_TMO], 1u); break; } } } } while (0)

struct XcdBarrier {
    unsigned* bar; unsigned x;
    volatile LAS unsigned* st;
};

__device__ __forceinline__ XcdBarrier xcd_barrier_post(unsigned* bar, volatile LAS unsigned* st) {
    XcdBarrier b; b.bar = bar; b.x = xb_xcc_id(); b.st = st;
    if (threadIdx.x == 0) (void)xb_add(&bar[XB_XCNT(b.x)], 1u);
    return b;
}
__device__ __forceinline__ void xcd_barrier_complete(unsigned* bar, unsigned x, unsigned& nloc, unsigned& nx) {
    const unsigned G = gridDim.x * gridDim.y * gridDim.z;
    unsigned sum, cnt, mine, sp = 0u;
    for (;;) {
        sum = 0u; cnt = 0u; mine = 0u;
#pragma unroll
        for (unsigned j = 0; j < 16; ++j) { const unsigned c = xb_ld(&bar[XB_XCNT(j)]); sum += c; cnt += (c > 0u) ? 1u : 0u; mine = (j == x) ? c : mine; }
        if (sum == G) break;
        __builtin_amdgcn_s_sleep(1);
        if ((++sp & 255u) == 0u) { if (xb_ld(&bar[XB_TMO])) break; if (sp > XB_SPIN_CAP) { atomicAdd(&bar[XB_TMO], 1u); break; } }
    }
    nloc = mine > 0u ? mine : 1u; nx = cnt > 0u ? cnt : 1u;
}

__device__ __forceinline__ void xcd_barrier(const XcdBarrier& b) {
    asm volatile("s_waitcnt vmcnt(0)" ::: "memory");
    __syncthreads();
    if (threadIdx.x == 0) {
        unsigned* bar = b.bar;
        __builtin_amdgcn_s_waitcnt(0);
        unsigned nloc = b.st[0], nx = b.st[1];
        if (nloc == 0u) { xcd_barrier_complete(bar, b.x, nloc, nx); b.st[0] = nloc; b.st[1] = nx; }
        const unsigned old = xb_add(&bar[XB_XSUB(b.x)], 1u);
        const unsigned gen = old / nloc;
        if (old + 1u == (gen + 1u) * nloc) {
            __builtin_amdgcn_fence(__ATOMIC_RELEASE, "agent");
            asm volatile("s_waitcnt vmcnt(0)" ::: "memory");
            const unsigned og = xb_add(&bar[XB_TOP], 1u);
            const unsigned tg = og / nx;
            if (og + 1u == (tg + 1u) * nx) xb_add(&bar[XB_TOPGEN], 1u);
            else XB_SPIN(xb_ld(&bar[XB_TOPGEN]) == tg, bar);
            __builtin_amdgcn_fence(__ATOMIC_ACQUIRE, "agent");
            xb_add(&bar[XB_XGEN(b.x)], 1u);
            asm volatile("s_waitcnt vmcnt(0)" ::: "memory");
        } else {
            XB_SPIN(xb_ld(&bar[XB_XGEN(b.x)]) == gen, bar);
            __builtin_amdgcn_fence(__ATOMIC_ACQUIRE, "agent");
            asm volatile("s_waitcnt vmcnt(0)" ::: "memory");
        }
    }
    __syncthreads();
}
#define DI __device__ __forceinline__
#define LAS3 __attribute__((address_space(3)))
using pg8::bf16_t; using pg8::bf16x8; using pg8::f32x4; using pg8::u32x4;
typedef unsigned u32x2 __attribute__((ext_vector_type(2)));
typedef short s16x4 __attribute__((ext_vector_type(4)));
typedef float f32x2 __attribute__((ext_vector_type(2)));
typedef __bf16 bf16x2_t __attribute__((ext_vector_type(2)));

constexpr int DM = 1024, NB = 16, SEQ = 2048, MP = NB * SEQ  , NDB = 32  , MROWS = 33024  ;
constexpr int NMEM = 256, MMEM = NB * NMEM  , DIN = 3412, NIN = 3584, NPAGES = 128;
constexpr int NTHREADS = 512;
constexpr size_t O_YP = 0, O_YS = O_YP + (size_t)MP * DM, O_GSP = O_YS + (size_t)NDB * DM, O_KP = O_GSP + (size_t)NB * 4 * 64 * 128,
                 O_VP = O_KP + (size_t)MP * 256, O_IKP = O_VP + (size_t)MP * 256, O_MKP = O_IKP + (size_t)MP * 64, O_MVP = O_MKP + (size_t)MMEM * 256,
                 O_GSS = O_MVP + (size_t)MMEM * 256, O_KS = O_GSS + (size_t)NDB * 4 * 64 * 128, O_VS = O_KS + (size_t)NDB * 256, O_IKS = O_VS + (size_t)NDB * 256,
                 O_END = O_IKS + (size_t)NDB * 64;
static_assert(O_END == 56150016, "output size");
constexpr size_t al256(size_t x) { return (x + 255) & ~(size_t)255; }
constexpr size_t CTRL_BYTES = 32768;
constexpr size_t CW_QDSA = 16384  , CW_QMEM = 18432  , CW_SCNT = 20480, CW_TMO = 20736, CW_CHK = 20992, CW_TSUM = 21248, CW_TMAX = 21504, CW_MEMC = 21760;
constexpr int SCLD = 16400;
constexpr size_t W_ROPE = CTRL_BYTES;
constexpr size_t W_XN = al256(W_ROPE + (size_t)2049 * 32 * 8);
constexpr size_t W_MEMN = W_XN + (size_t)MROWS * 1024 * 2;
constexpr size_t W_WTIN = W_MEMN + (size_t)MMEM * 1024 * 2;
constexpr size_t W_WTMEM = W_WTIN + (size_t)NIN * 1024 * 2;
constexpr size_t W_WTOUT = W_WTMEM + (size_t)512 * 1024 * 2;
constexpr size_t W_GQ = W_WTOUT + (size_t)1024 * 1024 * 2;
constexpr size_t W_GK = W_GQ + (size_t)MROWS * 256 * 2;
constexpr size_t W_GV = W_GK + (size_t)MROWS * 256 * 2;
constexpr size_t W_GG = W_GV + (size_t)MROWS * 512 * 2;
constexpr size_t W_DQ = W_GG + (size_t)MROWS * 512 * 2;
constexpr size_t W_DK = W_DQ + (size_t)MROWS * 256 * 2;
constexpr size_t W_DVT = W_DK + (size_t)MROWS * 256 * 2;
constexpr size_t W_IQ = W_DVT + (size_t)MP * 256 * 2;
constexpr size_t W_DG = W_IQ + (size_t)MROWS * 256 * 2;
constexpr size_t W_MQ = W_DG + (size_t)MROWS * 256 * 2;
constexpr size_t W_MG = W_MQ + (size_t)MROWS * 256 * 2;
constexpr size_t W_IK = W_MG + (size_t)MROWS * 256 * 2;
constexpr size_t W_IW = W_IK + (size_t)MROWS * 64 * 2;
constexpr size_t W_GLR = W_IW + (size_t)MROWS * 4 * 4;
constexpr size_t W_MK = W_GLR + (size_t)MROWS * 16 * 4;
constexpr size_t W_MVT = W_MK + (size_t)MMEM * 256 * 2;
constexpr size_t W_MIX = W_MVT + (size_t)MMEM * 256 * 2;
constexpr size_t W_SC = W_MIX + (size_t)MROWS * 1024 * 2;
constexpr size_t W_END = W_SC + (size_t)NDB * SCLD * 4;
constexpr int LDS_MISC = 148480, LDS_BYTES = 148480 + 256;

struct Params {
    const float *x_prompt, *x_sample, *mem_prompt, *state_gla, *cache_k, *cache_v, *cache_ik, *cache_mem_k, *cache_mem_v;
    const int* page_table;
    const float *norm_in, *w_in, *w_g2, *b_g, *onorm, *mem_norm, *w_mem_kv, *w_out, *norm_final;
    float* out; unsigned char* ws; int ph_lo, ph_hi;
};

#ifdef TSEL
#define TDECL unsigned tacc_ = 0u, tbeg_ = 0u
#define TBEG(k) do { if ((k) == TSEL) tbeg_ = (unsigned)__builtin_amdgcn_s_memrealtime(); } while (0)
#define TEND(k) do { if ((k) == TSEL) tacc_ += (unsigned)__builtin_amdgcn_s_memrealtime() - tbeg_; } while (0)
#define TARGS , unsigned& tacc_, unsigned& tbeg_
#define TPASS , tacc_, tbeg_
#else
#define TARGS
#define TPASS
#define TDECL do {} while (0)
#define TBEG(k) do {} while (0)
#define TEND(k) do {} while (0)
#endif
DI float bf2f(bf16_t v) { return __uint_as_float((unsigned)v << 16); }
DI unsigned cvtpk(float lo, float hi) { f32x2 v = {lo, hi}; bf16x2_t b = __builtin_convertvector(v, bf16x2_t); return __builtin_bit_cast(unsigned, b); }
DI bf16_t f2bf(float x) { return (bf16_t)(cvtpk(x, 0.f) & 0xffffu); }
DI f32x4 mfma16(bf16x8 a, bf16x8 b, f32x4 c) { return __builtin_amdgcn_mfma_f32_16x16x32_bf16(a, b, c, 0, 0, 0); }
DI float fexp(float x) { return __builtin_amdgcn_exp2f(x * 1.4426950408889634f); }
DI float siluf(float x) { return x * __builtin_amdgcn_rcpf(1.f + fexp(-x)); }
DI float logsigf(float u) { return fminf(u, 0.f) - 0.6931471805599453f * __builtin_amdgcn_logf(1.f + fexp(-fabsf(u))); }
DI unsigned fkey(float x) { unsigned u = __float_as_uint(x); u = (u == 0x80000000u) ? 0u : u; return u ^ ((unsigned)((int)u >> 31) | 0x80000000u); }
DI float wsum64(float v) { v += __shfl_xor(v, 1); v += __shfl_xor(v, 2); v += __shfl_xor(v, 4); v += __shfl_xor(v, 8); v += __shfl_xor(v, 16); v += __shfl_xor(v, 32); return v; }
DI float wmax64(float v) { v = fmaxf(v, __shfl_xor(v, 1)); v = fmaxf(v, __shfl_xor(v, 2)); v = fmaxf(v, __shfl_xor(v, 4)); v = fmaxf(v, __shfl_xor(v, 8)); v = fmaxf(v, __shfl_xor(v, 16)); v = fmaxf(v, __shfl_xor(v, 32)); return v; }
DI unsigned lds_add(LAS3 unsigned* p, unsigned v) { return __hip_atomic_fetch_add(p, v, __ATOMIC_RELAXED, __HIP_MEMORY_SCOPE_WORKGROUP); }
DI unsigned lds_or(LAS3 unsigned* p, unsigned v) { return __hip_atomic_fetch_or(p, v, __ATOMIC_RELAXED, __HIP_MEMORY_SCOPE_WORKGROUP); }
DI void st_bf16x4(bf16_t* p, f32x4 v) { u32x2 w; w.x = cvtpk(v[0], v[1]); w.y = cvtpk(v[2], v[3]); *(u32x2*)p = w; }
DI const float* vaddr(const float* q) { asm volatile("" : "+v"(q)); return q; }
constexpr float LOG2E = 1.4426950408889634f;
#define NEG_INF (-__builtin_inff())

DI int rope_perm(int vc) { return 64 * (vc >> 6) + 16 * ((vc >> 5) & 1) + (vc & 15) + 32 * ((vc >> 4) & 1); }
DI int in_src(int np) {
    const int pn = np >> 8, vc = np & 255;
    switch (pn) {
        case 0: return vc;
        case 1: return 256 + vc;
        case 2: case 3: return 512 + 256 * (pn - 2) + vc;
        case 4: case 5: return 1040 + 256 * (pn - 4) + vc;
        case 6: return 1552 + rope_perm(vc);
        case 7: return 1808 + rope_perm(vc);
        case 8: return 2064 + vc;
        case 9: return 2320 + rope_perm(vc);
        case 10: return 2644 + vc;
        case 11: return 2900 + vc;
        case 12: return 3156 + vc;
        default: break;
    }
    if (vc < 64) return 2576 + rope_perm(vc);
    if (vc < 68) return 2640 + (vc - 64);
    if (vc < 84) return 1024 + (vc - 68);
    return -1;
}

struct EpiIn {
    static constexpr bool PERM = false, AFTER_DRAIN = false;
    unsigned char* ws; float* out;
    DI void operator()(const f32x4 (&acc)[2][2][4][2], const pg8::Unit& u, int wr, int wc, int fr, int fq) const {
        const int pn = u.pn, rbase = u.pm * 256 + wr * 64 + fr;
        if (pn <= 5 || (pn >= 10 && pn <= 12)) {
            bf16_t* dst; int ldc = 256, coff = 0; float sc = 1.f; bool silu = false;
            switch (pn) {
                case 0: dst = (bf16_t*)(ws + W_GQ); sc = 0.125f; break;
                case 1: dst = (bf16_t*)(ws + W_GK); break;
                case 2: dst = (bf16_t*)(ws + W_GV); ldc = 512; break;
                case 3: dst = (bf16_t*)(ws + W_GV); ldc = 512; coff = 256; break;
                case 4: dst = (bf16_t*)(ws + W_GG); ldc = 512; silu = true; break;
                case 5: dst = (bf16_t*)(ws + W_GG); ldc = 512; coff = 256; silu = true; break;
                case 10: dst = (bf16_t*)(ws + W_DG); silu = true; break;
                case 11: dst = (bf16_t*)(ws + W_MQ); sc = 0.125f * LOG2E; break;
                default: dst = (bf16_t*)(ws + W_MG); silu = true; break;
            }
#pragma unroll
            for (int ai = 0; ai < 2; ++ai)
#pragma unroll
                for (int m = 0; m < 4; ++m) {
                    const int row = rbase + ai * 128 + m * 16;
                    bf16_t* rp = dst + (size_t)row * ldc + coff + wc * 32 + 4 * fq;
#pragma unroll
                    for (int bj = 0; bj < 2; ++bj)
#pragma unroll
                        for (int n = 0; n < 2; ++n) {
                            f32x4 v = acc[ai][bj][m][n];
                            if (silu) { v[0] = siluf(v[0]); v[1] = siluf(v[1]); v[2] = siluf(v[2]); v[3] = siluf(v[3]); } else v = v * sc;
                            st_bf16x4(rp + bj * 128 + n * 16, v);
                        }
                }
        } else if (pn == 6 || pn == 7 || pn == 9) {
            bf16_t* dst = (bf16_t*)(ws + (pn == 6 ? W_DQ : (pn == 7 ? W_DK : W_IQ)));
            const float sc = (pn == 6) ? 0.125f * LOG2E : 1.f;
            const float* rope = (const float*)(ws + W_ROPE);
#pragma unroll
            for (int ai = 0; ai < 2; ++ai)
#pragma unroll
                for (int m = 0; m < 4; ++m) {
                    const int row = rbase + ai * 128 + m * 16;
                    const int pi = row < MP ? (row & 2047) : 2048;
                    const int f0 = 16 * (wc & 1) + 4 * fq;
                    const f32x4 cs0 = *(const f32x4*)(rope + ((size_t)pi * 32 + f0) * 2), cs1 = *(const f32x4*)(rope + ((size_t)pi * 32 + f0) * 2 + 4);
                    const f32x4 c = {cs0[0], cs0[2], cs1[0], cs1[2]}, s = {cs0[1], cs0[3], cs1[1], cs1[3]};
#pragma unroll
                    for (int bj = 0; bj < 2; ++bj) {
                        const f32x4 v0 = acc[ai][bj][m][0], v1 = acc[ai][bj][m][1];
                        const f32x4 o1 = (v0 * c - v1 * s) * sc, o2 = (v1 * c + v0 * s) * sc;
                        const int col1 = 64 * (2 * bj + (wc >> 1)) + f0, col2 = col1 + 32;
                        st_bf16x4(dst + (size_t)row * 256 + col1, o1); st_bf16x4(dst + (size_t)row * 256 + col2, o2);
                        if (pn == 7) {
                            float* op = nullptr;
                            if (row < MP) op = out + O_KP + (size_t)row * 256; else if (row < MP + NDB) op = out + O_KS + (size_t)(row - MP) * 256;
                            if (op) { *(f32x4*)(op + col1) = o1; *(f32x4*)(op + col2) = o2; }
                        }
                    }
                }
        } else if (pn == 8) {
            bf16_t* dvt = (bf16_t*)(ws + W_DVT);
#pragma unroll
            for (int ai = 0; ai < 2; ++ai)
#pragma unroll
                for (int m = 0; m < 4; ++m) {
                    const int row = rbase + ai * 128 + m * 16;
                    float* op = nullptr;
                    if (row < MP) op = out + O_VP + (size_t)row * 256; else if (row < MP + NDB) op = out + O_VS + (size_t)(row - MP) * 256;
#pragma unroll
                    for (int bj = 0; bj < 2; ++bj)
#pragma unroll
                        for (int n = 0; n < 2; ++n) {
                            const f32x4 v = acc[ai][bj][m][n];
                            const int col = 128 * bj + 32 * wc + 16 * n + 4 * fq;
                            if (op) *(f32x4*)(op + col) = v;
                            if (row < MP) {
                                const int t_ = row & 2047, kk_ = t_ & 31;
                                bf16_t* tp = dvt + ((((size_t)(row >> 11) * 64 + (t_ >> 5)) * 4 + (col >> 6)) * 64 + (col & 63)) * 32 + 8 * ((kk_ >> 2) & 3) + 4 * (kk_ >> 4) + (kk_ & 3);
                                tp[0] = f2bf(v[0]); tp[32] = f2bf(v[1]); tp[64] = f2bf(v[2]); tp[96] = f2bf(v[3]);
                            }
                        }
                }
        } else {
            bf16_t* ikb = (bf16_t*)(ws + W_IK); float* iw = (float*)(ws + W_IW); float* glr = (float*)(ws + W_GLR);
            const float* rope = (const float*)(ws + W_ROPE);
#pragma unroll
            for (int ai = 0; ai < 2; ++ai)
#pragma unroll
                for (int m = 0; m < 4; ++m) {
                    const int row = rbase + ai * 128 + m * 16;
                    const f32x4 v0 = acc[ai][0][m][0], v1 = acc[ai][0][m][1];
                    if (wc < 2) {
                        const int pi = row < MP ? (row & 2047) : 2048;
                        const int f0 = 16 * wc + 4 * fq;
                        const f32x4 cs0 = *(const f32x4*)(rope + ((size_t)pi * 32 + f0) * 2), cs1 = *(const f32x4*)(rope + ((size_t)pi * 32 + f0) * 2 + 4);
                        const f32x4 c = {cs0[0], cs0[2], cs1[0], cs1[2]}, s = {cs0[1], cs0[3], cs1[1], cs1[3]};
                        const f32x4 o1 = v0 * c - v1 * s, o2 = v1 * c + v0 * s;
                        st_bf16x4(ikb + (size_t)row * 64 + f0, o1); st_bf16x4(ikb + (size_t)row * 64 + f0 + 32, o2);
                        float* op = nullptr;
                        if (row < MP) op = out + O_IKP + (size_t)row * 64; else if (row < MP + NDB) op = out + O_IKS + (size_t)(row - MP) * 64;
                        if (op) { *(f32x4*)(op + f0) = o1; *(f32x4*)(op + f0 + 32) = o2; }
                    } else if (wc == 2) {
                        if (fq == 0) { *(f32x4*)(iw + (size_t)row * 4) = v0 * 0.5f; *(f32x4*)(glr + (size_t)row * 16 + 12) = v1; }
                        else *(f32x4*)(glr + (size_t)row * 16 + 4 * (fq - 1)) = v0;
                    }
                }
        }
    }
};
struct EpiMem {
    static constexpr bool PERM = false, AFTER_DRAIN = false;
    unsigned char* ws; float* out;
    DI void operator()(const f32x4 (&acc)[2][2][4][2], const pg8::Unit& u, int wr, int wc, int fr, int fq) const {
        const int pn = u.pn, rbase = u.pm * 256 + wr * 64 + fr;
        bf16_t* mk = (bf16_t*)(ws + W_MK); bf16_t* mvt = (bf16_t*)(ws + W_MVT);
        float* op0 = out + (pn == 0 ? O_MKP : O_MVP);
#pragma unroll
        for (int ai = 0; ai < 2; ++ai)
#pragma unroll
            for (int m = 0; m < 4; ++m) {
                const int row = rbase + ai * 128 + m * 16;
#pragma unroll
                for (int bj = 0; bj < 2; ++bj)
#pragma unroll
                    for (int n = 0; n < 2; ++n) {
                        const f32x4 v = acc[ai][bj][m][n];
                        const int col = 128 * bj + 32 * wc + 16 * n + 4 * fq;
                        *(f32x4*)(op0 + (size_t)row * 256 + col) = v;
                        if (pn == 0) st_bf16x4(mk + (size_t)row * 256 + col, v);
                        else { const int m_ = row & 255, kk_ = m_ & 31;
                               bf16_t* tp = mvt + ((((size_t)(row >> 8) * 8 + (m_ >> 5)) * 4 + (col >> 6)) * 64 + (col & 63)) * 32 + 8 * ((kk_ >> 2) & 3) + 4 * (kk_ >> 4) + (kk_ & 3);
                               tp[0] = f2bf(v[0]); tp[32] = f2bf(v[1]); tp[64] = f2bf(v[2]); tp[96] = f2bf(v[3]); }
                    }
            }
    }
};
struct EpiOut {
    static constexpr bool PERM = false, AFTER_DRAIN = false;
    const float* xp; const float* xs; float* out;
    DI void operator()(const f32x4 (&acc)[2][2][4][2], const pg8::Unit& u, int wr, int wc, int fr, int fq) const {
        const int rbase = u.pm * 256 + wr * 64 + fr, cbase = u.pn * 256 + wc * 32 + 4 * fq;
#pragma unroll
        for (int ai = 0; ai < 2; ++ai)
#pragma unroll
            for (int m = 0; m < 4; ++m) {
                const int row = rbase + ai * 128 + m * 16;
                const float* xr; float* orow;
                if (row < MP) { xr = xp + (size_t)row * DM; orow = out + O_YP + (size_t)row * DM; }
                else if (row < MP + NDB) { xr = xs + (size_t)(row - MP) * DM; orow = out + O_YS + (size_t)(row - MP) * DM; }
                else continue;
#pragma unroll
                for (int bj = 0; bj < 2; ++bj)
#pragma unroll
                    for (int n = 0; n < 2; ++n) { const int col = cbase + bj * 128 + n * 16; *(f32x4*)(orow + col) = acc[ai][bj][m][n] + *(const f32x4*)(xr + col); }
            }
    }
};
DI void p0_prologue(const Params& p, LAS3 unsigned char* lds) {
    const int tid = threadIdx.x, lane = tid & 63, wv = tid >> 6;
    unsigned char* ws = p.ws;
    for (int r0 = (blockIdx.x * 8 + wv) * 2; r0 < MROWS + MMEM; r0 += gridDim.x * 16) {
        const float* src[2]; const float* g[2]; bf16_t* dst[2];
#pragma unroll
        for (int e = 0; e < 2; ++e) {
            const int r = r0 + e; src[e] = nullptr; g[e] = p.norm_in;
            if (r < MP) { src[e] = p.x_prompt + (size_t)r * DM; dst[e] = (bf16_t*)(ws + W_XN) + (size_t)r * DM; }
            else if (r < MP + NDB) { src[e] = p.x_sample + (size_t)(r - MP) * DM; dst[e] = (bf16_t*)(ws + W_XN) + (size_t)r * DM; }
            else if (r < MROWS) { dst[e] = (bf16_t*)(ws + W_XN) + (size_t)r * DM; }
            else { src[e] = p.mem_prompt + (size_t)(r - MROWS) * DM; g[e] = p.mem_norm; dst[e] = (bf16_t*)(ws + W_MEMN) + (size_t)(r - MROWS) * DM; }
        }
        f32x4 v[2][4];
#pragma unroll
        for (int e = 0; e < 2; ++e)
#pragma unroll
            for (int i = 0; i < 4; ++i) v[e][i] = src[e] ? *(const f32x4*)(src[e] + i * 256 + lane * 4) : (f32x4){0.f, 0.f, 0.f, 0.f};
#pragma unroll
        for (int e = 0; e < 2; ++e) {
            float ss = 0.f;
#pragma unroll
            for (int i = 0; i < 4; ++i) ss += v[e][i][0] * v[e][i][0] + v[e][i][1] * v[e][i][1] + v[e][i][2] * v[e][i][2] + v[e][i][3] * v[e][i][3];
            ss = wsum64(ss);
            const float rstd = rsqrtf(ss * (1.f / DM) + 1e-6f);
#pragma unroll
            for (int i = 0; i < 4; ++i) { const f32x4 gv = *(const f32x4*)(g[e] + i * 256 + lane * 4); st_bf16x4(dst[e] + i * 256 + lane * 4, v[e][i] * rstd * gv); }
        }
    }
    for (int e = blockIdx.x * NTHREADS + tid; e < 2049 * 32; e += gridDim.x * NTHREADS) {
        const int pi = e >> 5, f = e & 31;
        const float inv = powf(10000.0f, -(float)(2 * f) / 64.0f);
        const float ang = (float)(pi == 2048 ? 16384 : pi) * inv;
        float sn, cs; sincosf(ang, &sn, &cs);
        ((f32x2*)(ws + W_ROPE))[e] = (f32x2){cs, sn};
    }
    LAS3 float* tl = (LAS3 float*)lds;
    for (int tile = blockIdx.x; tile < 1280; tile += gridDim.x) {
        int which, t2, ld; const float* W; bf16_t* dst;
        if (tile < 896) { which = 0; t2 = tile; W = p.w_in; ld = DIN; dst = (bf16_t*)(ws + W_WTIN); }
        else if (tile < 1024) { which = 1; t2 = tile - 896; W = p.w_mem_kv; ld = 512; dst = (bf16_t*)(ws + W_WTMEM); }
        else { which = 2; t2 = tile - 1024; W = p.w_out; ld = 1024; dst = (bf16_t*)(ws + W_WTOUT); }
        const int nt = t2 >> 4, kt = t2 & 15;
        { const int nn = tid & 63, kk0 = tid >> 6; const int np = nt * 64 + nn; const int sc = which == 0 ? in_src(np) : np;
#pragma unroll
          for (int i = 0; i < 8; ++i) { const int k = kk0 + 8 * i; tl[k * 65 + nn] = sc >= 0 ? W[(size_t)(kt * 64 + k) * ld + sc] : 0.f; } }
        __syncthreads();
        { const int kk = tid & 63, nn0 = tid >> 6;
#pragma unroll
          for (int i = 0; i < 8; ++i) { const int n = nn0 + 8 * i; dst[(size_t)(nt * 64 + n) * 1024 + kt * 64 + kk] = f2bf(tl[kk * 65 + n]); } }
        __syncthreads();
    }
}

DI void cnt_ge(unsigned& c, unsigned key, unsigned cand) { asm volatile("v_cmp_ge_u32 vcc, %1, %2\n\tv_addc_co_u32 %0, vcc, 0, %0, vcc" : "+v"(c) : "v"(key), "v"(cand) : "vcc"); }
DI void cnt_gt(unsigned& c, unsigned key, unsigned cand) { asm volatile("v_cmp_gt_u32 vcc, %1, %2\n\tv_addc_co_u32 %0, vcc, 0, %0, vcc" : "+v"(c) : "v"(key), "v"(cand) : "vcc"); }
DI void cnt_eq_lt(unsigned& c, unsigned key, unsigned T, unsigned idx, unsigned cand) {
    unsigned tmp;
    asm volatile("v_cmp_eq_u32 vcc, %2, %3\n\tv_cndmask_b32 %1, -1, %4, vcc\n\tv_cmp_lt_u32 vcc, %1, %5\n\tv_addc_co_u32 %0, vcc, 0, %0, vcc" : "+v"(c), "=&v"(tmp) : "v"(key), "v"(T), "v"(idx), "v"(cand) : "vcc"); }
DI unsigned grp_count16(unsigned c, LAS3 unsigned* CNT, int& it, int fr, int lane) {
    c += __shfl_xor(c, 16); c += __shfl_xor(c, 32);
    LAS3 unsigned* cur = CNT + (it % 3) * 16;
    if (lane < 16) lds_add(cur + fr, c);
    __syncthreads();
    const unsigned tot = cur[fr];
    if (threadIdx.x < 16) CNT[((it + 2) % 3) * 16 + threadIdx.x] = 0u;
    ++it; return tot;
}
DI unsigned blk_count(unsigned c, LAS3 unsigned* CNT, int& it, int lane) {
    c += __shfl_xor(c, 1); c += __shfl_xor(c, 2); c += __shfl_xor(c, 4); c += __shfl_xor(c, 8); c += __shfl_xor(c, 16); c += __shfl_xor(c, 32);
    LAS3 unsigned* cur = CNT + (it % 3) * 16;
    if (lane == 0) lds_add(cur, c);
    __syncthreads();
    const unsigned tot = cur[0];
    if (threadIdx.x == 0) CNT[((it + 2) % 3) * 16] = 0u;
    ++it; return tot;
}

template <bool MASKED>
DI void attn32(const bf16_t* Q, int ldq, const bf16_t* K, int ldk, const bf16_t* Vt, int ldv, int nkb, const LAS3 unsigned* mask, int fr, int fq,
               f32x4 (&o)[4][2], float (&linv)[2]) {
    bf16x8 qf[2][2];
#pragma unroll
    for (int qt = 0; qt < 2; ++qt)
#pragma unroll
        for (int ks = 0; ks < 2; ++ks) qf[qt][ks] = *(const bf16x8*)(Q + (size_t)(16 * qt + fr) * ldq + ks * 32 + fq * 8);
    float m[2] = {NEG_INF, NEG_INF}, l[2] = {0.f, 0.f};
    const f32x4 zero = {0.f, 0.f, 0.f, 0.f};
#pragma unroll
    for (int dt = 0; dt < 4; ++dt) { o[dt][0] = zero; o[dt][1] = zero; }
    const bf16_t* kl = K + (size_t)fr * ldk + fq * 8;
#ifdef BROKEN_VT
    const bf16_t* vl = Vt + fr * 32 + 8 * ((fq + 1) & 3);
#else
    const bf16_t* vl = Vt + fr * 32 + 8 * fq;
#endif
    bf16x8 kfA[2][2], kfB[2][2], vA[4], vB[4];
#define ATT_LOAD(KF, VF, kb_) do { \
        _Pragma("unroll") for (int i2 = 0; i2 < 2; ++i2) _Pragma("unroll") for (int ks = 0; ks < 2; ++ks) KF[i2][ks] = *(const bf16x8*)(kl + (size_t)(32 * (kb_) + 16 * i2) * ldk + ks * 32); \
        _Pragma("unroll") for (int dt = 0; dt < 4; ++dt) VF[dt] = *(const bf16x8*)(vl + (size_t)(kb_) * ldv + 512 * dt); } while (0)
#define ATT_COMPUTE(KF, VF, kb_) do { \
        _Pragma("unroll") for (int qt = 0; qt < 2; ++qt) { \
            f32x4 s0 = mfma16(KF[0][0], qf[qt][0], zero); s0 = mfma16(KF[0][1], qf[qt][1], s0); \
            f32x4 s1 = mfma16(KF[1][0], qf[qt][0], zero); s1 = mfma16(KF[1][1], qf[qt][1], s1); \
            if (MASKED) { const unsigned mw = mask[(16 * qt + fr) * 65 + (kb_)]; const unsigned b0 = mw >> (2 * fq), b1 = mw >> (8 + 2 * fq); \
                _Pragma("unroll") for (int r = 0; r < 4; ++r) { const int sh_ = (r >> 1) + 16 * (r & 1); s0[r] = ((b0 >> sh_) & 1u) ? s0[r] : NEG_INF; s1[r] = ((b1 >> sh_) & 1u) ? s1[r] : NEG_INF; } } \
            float mx = fmaxf(fmaxf(fmaxf(s0[0], s0[1]), fmaxf(s0[2], s0[3])), fmaxf(fmaxf(s1[0], s1[1]), fmaxf(s1[2], s1[3]))); \
            mx = fmaxf(mx, __shfl_xor(mx, 16)); mx = fmaxf(mx, __shfl_xor(mx, 32)); \
            const float mn = fmaxf(m[qt], mx), ms = (mn == NEG_INF) ? 0.f : mn; \
            const float alpha = __builtin_amdgcn_exp2f(m[qt] - ms); \
            f32x4 p0, p1; \
            _Pragma("unroll") for (int r = 0; r < 4; ++r) { p0[r] = __builtin_amdgcn_exp2f(s0[r] - ms); p1[r] = __builtin_amdgcn_exp2f(s1[r] - ms); } \
            l[qt] = l[qt] * alpha + ((p0[0] + p0[1]) + (p0[2] + p0[3])) + ((p1[0] + p1[1]) + (p1[2] + p1[3])); \
            m[qt] = mn; \
            u32x4 pw; pw.x = cvtpk(p0[0], p0[1]); pw.y = cvtpk(p0[2], p0[3]); pw.z = cvtpk(p1[0], p1[1]); pw.w = cvtpk(p1[2], p1[3]); \
            const bf16x8 pf = __builtin_bit_cast(bf16x8, pw); \
            if (!__all(alpha == 1.f)) { _Pragma("unroll") for (int dt = 0; dt < 4; ++dt) o[dt][qt] = o[dt][qt] * alpha; }     \
            _Pragma("unroll") for (int dt = 0; dt < 4; ++dt) o[dt][qt] = mfma16(VF[dt], pf, o[dt][qt]); } } while (0)
    ATT_LOAD(kfA, vA, 0);
    const int last = nkb - 1;
    for (int kb = 0; kb < nkb; kb += 2) {
        ATT_LOAD(kfB, vB, kb + 1);
        ATT_COMPUTE(kfA, vA, kb);
        { const int k2 = kb + 2 < last ? kb + 2 : last; ATT_LOAD(kfA, vA, k2); }
        ATT_COMPUTE(kfB, vB, kb + 1);
    }
#undef ATT_LOAD
#undef ATT_COMPUTE
#pragma unroll
    for (int qt = 0; qt < 2; ++qt) { float lt = l[qt]; lt += __shfl_xor(lt, 16); lt += __shfl_xor(lt, 32); linv[qt] = 1.f / lt; }
}
DI void attn_store(const f32x4 (&o)[4][2], const float (&linv)[2], const bf16_t* gate  , bf16_t* mix  , int fr, int fq) {
#pragma unroll
    for (int qt = 0; qt < 2; ++qt)
#pragma unroll
        for (int dt = 0; dt < 4; ++dt) {
            const size_t row = 16 * qt + fr; const int col = 16 * dt + 4 * fq;
            const u32x2 gw = *(const u32x2*)(gate + row * 256 + col);
            f32x4 v = o[dt][qt] * linv[qt];
            v[0] *= __uint_as_float(gw.x << 16); v[1] *= __uint_as_float(gw.x & 0xffff0000u); v[2] *= __uint_as_float(gw.y << 16); v[3] *= __uint_as_float(gw.y & 0xffff0000u);
            st_bf16x4(mix + row * 1024 + col, v);
        }
}

constexpr int DS_MASK = 0, DS_PKT = 16640, PKT_LD = 2052, DS_CNT = 147968;
typedef unsigned short u16x2 __attribute__((ext_vector_type(2)));
DI unsigned pk_cnt_ge(unsigned acc, unsigned kpair, unsigned cm1, unsigned ones) {
    unsigned t;
    asm("v_pk_sub_u16 %1, %2, %3 clamp\n\tv_pk_min_u16 %1, %1, %4\n\tv_pk_add_u16 %0, %0, %1" : "+v"(acc), "=&v"(t) : "v"(kpair), "v"(cm1), "v"(ones));
    return acc;
}
DI void select_bitwise(const unsigned (&key)[16][4], int lbase, LAS3 unsigned* CNT, int& it, int fr, int lane, unsigned& T, int& Xrel) {
    bool fin = false;
    T = 0u; Xrel = 0x7fffffff;
    for (int bit = 31; bit >= 0; --bit) {
        const unsigned cand = T | (1u << bit);
        unsigned c = 0;
#pragma unroll
        for (int n = 0; n < 16; ++n)
#pragma unroll
            for (int r = 0; r < 4; ++r) cnt_ge(c, key[n][r], cand);
        const unsigned tot = grp_count16(c, CNT, it, fr, lane);
        if (!fin && tot >= 256u) { T = cand; fin = (tot == 256u); }
        if (__all(fin)) break;
    }
    if (!__all(fin)) {
        unsigned c = 0;
#pragma unroll
        for (int n = 0; n < 16; ++n)
#pragma unroll
            for (int r = 0; r < 4; ++r) cnt_gt(c, key[n][r], T);
        const unsigned cgt = grp_count16(c, CNT, it, fr, lane);
        const unsigned need = 256u - cgt;
        unsigned Xl = 0u;
        for (int bit = 10; bit >= 0; --bit) {
            const unsigned cand = Xl | (1u << bit);
            const int crel = (int)cand - lbase;
            c = 0;
#pragma unroll
            for (int n = 0; n < 16; ++n) { const int crn = crel - 128 * n;
#pragma unroll
                for (int r = 0; r < 4; ++r) c += (key[n][r] == T && r < crn) ? 1u : 0u; }
            const unsigned tot = grp_count16(c, CNT, it, fr, lane);
            if (tot < need) Xl = cand;
        }
        if (!fin) Xrel = (int)Xl - lbase;
    }
}
DI unsigned pk_flag_ge(unsigned kpair, unsigned cm1, unsigned ones) {
    unsigned t;
    asm("v_pk_sub_u16 %0, %1, %2 clamp\n\tv_pk_min_u16 %0, %0, %3" : "=&v"(t) : "v"(kpair), "v"(cm1), "v"(ones));
    return t;
}
DI unsigned pk_max(unsigned a, unsigned b2) { unsigned t; asm("v_pk_max_u16 %0, %1, %2" : "=v"(t) : "v"(a), "v"(b2)); return t; }
DI unsigned hsum32(unsigned x) {
    x += __builtin_amdgcn_update_dpp(0u, x, 0xB1, 0xF, 0xF, false); x += __builtin_amdgcn_update_dpp(0u, x, 0x4E, 0xF, 0xF, false);
    x += __builtin_amdgcn_update_dpp(0u, x, 0x141, 0xF, 0xF, false); x += __builtin_amdgcn_update_dpp(0u, x, 0x140, 0xF, 0xF, false);
    const auto r = __builtin_amdgcn_permlane16_swap(x, x, false, false); return r[0] + r[1];
}
DI unsigned hmax32(unsigned x) {
    x = max(x, (unsigned)__builtin_amdgcn_update_dpp(0u, x, 0xB1, 0xF, 0xF, false)); x = max(x, (unsigned)__builtin_amdgcn_update_dpp(0u, x, 0x4E, 0xF, 0xF, false));
    x = max(x, (unsigned)__builtin_amdgcn_update_dpp(0u, x, 0x141, 0xF, 0xF, false)); x = max(x, (unsigned)__builtin_amdgcn_update_dpp(0u, x, 0x140, 0xF, 0xF, false));
    const auto r = __builtin_amdgcn_permlane16_swap(x, x, false, false); return max(r[0], r[1]);
}
DI unsigned pk_count32(const unsigned (&rk)[32], unsigned cm1, unsigned ones, bool half) {
    unsigned a0 = 0u, a1 = 0u;
#pragma unroll
    for (int k = 0; k < 16; k += 2) { a0 = pk_cnt_ge(a0, rk[k], cm1, ones); a1 = pk_cnt_ge(a1, rk[k + 1], cm1, ones); }
    if (!half) {
#pragma unroll
        for (int k = 16; k < 32; k += 2) { a0 = pk_cnt_ge(a0, rk[k], cm1, ones); a1 = pk_cnt_ge(a1, rk[k + 1], cm1, ones); }
    }
    return (a0 & 0xffffu) + (a0 >> 16) + (a1 & 0xffffu) + (a1 >> 16);
}
DI void dsa_unit(const Params& p, LAS3 unsigned char* lds, int b, int j TARGS) {
    int tid = threadIdx.x; asm volatile("" : "+v"(tid));
    const int lane0 = tid & 63, w = __builtin_amdgcn_readfirstlane(tid >> 6);
    unsigned char* ws = p.ws;
    LAS3 unsigned* MASK = (LAS3 unsigned*)(lds + DS_MASK);
    LAS3 unsigned* PKT = (LAS3 unsigned*)(lds + DS_PKT);
    const bf16_t* IQ = (const bf16_t*)(ws + W_IQ); const bf16_t* IK = (const bf16_t*)(ws + W_IK); const float* IW = (const float*)(ws + W_IW);
    const int q0 = 64 * j;
    const f32x4 zero = {0.f, 0.f, 0.f, 0.f};
#ifdef CHECK_SEL
    LAS3 unsigned* CNT = (LAS3 unsigned*)(lds + DS_CNT); int it = 0;
    if (tid < 48) CNT[tid] = 0u;
    __syncthreads();
#endif
    TBEG(30);
#pragma unroll 1
    for (int qg = 0; qg < 4; ++qg) {
        TBEG(32);
        int lane = lane0; asm volatile("" : "+v"(lane));
        const int fr = lane & 15, fq = lane >> 4;
        const int tq = q0 + 16 * qg + fr; const size_t qrow = (size_t)b * SEQ + tq;
        const int ntile = 4 * j + qg + 1;
        const int nloc = ntile > w ? (ntile - w + 7) >> 3 : 0;
        const bool selecting = q0 + 16 * qg >= 256;
        {
            bf16x8 bq[4][2];
#pragma unroll
            for (int h = 0; h < 4; ++h)
#pragma unroll
                for (int ks = 0; ks < 2; ++ks) bq[h][ks] = *(const bf16x8*)(IQ + qrow * 256 + h * 64 + ks * 32 + fq * 8);
            const f32x4 wq = *(const f32x4*)(IW + qrow * 4);
            float Lh[4];
#pragma unroll
            for (int h = 0; h < 4; ++h) Lh[h] = wq[h] < 0.f ? NEG_INF : -NEG_INF;
            const char* tb = (const char*)IK + ((size_t)b * SEQ + 16 * w) * 128 + (unsigned)(fr * 128 + fq * 16);
            LAS3 unsigned* krow = PKT + fr * PKT_LD + 16 * w + 4 * fq;
            const int lim0 = tq - (16 * w + 4 * fq);
#define DSA_TILE(A0, A1, nn) do { \
                f32x4 sc = zero; \
                _Pragma("unroll") for (int h = 0; h < 4; ++h) { f32x4 d = mfma16(A0, bq[h][0], zero); d = mfma16(A1, bq[h][1], d); d = d * wq[h]; \
                    _Pragma("unroll") for (int r = 0; r < 4; ++r) sc[r] += __builtin_amdgcn_fmed3f(d[r], 0.f, Lh[h]); } \
                { const char* t2_ = tb + (size_t)((nn) + 2 < nloc ? (nn) + 2 : nloc - 1) * 16384; A0 = *(const bf16x8*)t2_; A1 = *(const bf16x8*)(t2_ + 64); } \
                const int limn = lim0 - 128 * (nn);                   \
                u32x4 kv; \
                _Pragma("unroll") for (int r = 0; r < 4; ++r) { const unsigned u = __float_as_uint(sc[r] + 0.f); const unsigned k = u ^ ((unsigned)((int)u >> 31) | 0x80000000u);   \
                    kv[r] = (r <= limn) ? k : 0u; } \
                *(LAS3 u32x4*)(krow + 128 * (nn)) = kv; } while (0)
            if (nloc > 0) {
                bf16x8 a0 = *(const bf16x8*)tb, a1 = *(const bf16x8*)(tb + 64);
                const char* t1 = tb + (size_t)(1 < nloc ? 1 : 0) * 16384;
                bf16x8 b0 = *(const bf16x8*)t1, b1 = *(const bf16x8*)(t1 + 64);
#pragma unroll 1
                for (int n = 0; n < nloc; n += 2) {
                    DSA_TILE(a0, a1, n);
                    if (n + 1 < nloc) DSA_TILE(b0, b1, n + 1);
                }
            }
#undef DSA_TILE
        }
        TEND(32); TBEG(33);
        __syncthreads();
        {
            const int hh = lane >> 5, pos = lane & 31, oq = 2 * w + hh;
            const unsigned nkeys = 16u * (unsigned)ntile;
            const bool half = nkeys <= 1024u;
            const LAS3 unsigned* orow = PKT + oq * PKT_LD + 2 * pos;
            unsigned ones = 0x00010001u; asm volatile("" : "+v"(ones));
            unsigned Tfull = 1u, X = 0xffffffffu;
            if (selecting) {
                unsigned rk[32];
#pragma unroll
                for (int k = 0; k < 32; ++k) { const u32x2 kk = *(const LAS3 u32x2*)(orow + 64 * k); rk[k] = (2u * (unsigned)(pos + 32 * k) < nkeys) ? __builtin_amdgcn_perm(kk.y, kk.x, 0x07060302u) : 0u; }
                unsigned mx = 0u;
#pragma unroll
                for (int k = 0; k < 32; ++k) mx = pk_max(mx, rk[k]);
                const unsigned kmax = hmax32(max(mx & 0xffffu, mx >> 16));
                unsigned T16 = 0u, cabove = 0u; bool exact = false;
                {
                    unsigned ub = 0x10000u;
#pragma unroll 1
                    for (int bit = 15; bit >= 0; --bit) {
                        const unsigned cand = T16 | (1u << bit);
                        if (__all(cand > kmax)) { ub = cand; continue; }
                        const unsigned tot = hsum32(pk_count32(rk, (cand - 1u) * 0x00010001u, ones, half));
                        if (tot >= 256u) T16 = cand; else { ub = cand; cabove = tot; }
                    }
                    (void)ub;
                }
                const unsigned need = 256u - cabove;
#pragma unroll
                for (int k = 0; k < 32; ++k) { const u32x2 kk = *(const LAS3 u32x2*)(orow + 64 * k); const bool in = 2u * (unsigned)(pos + 32 * k) < nkeys;
                    const unsigned lo0 = (in && (kk.x >> 16) == T16) ? (kk.x & 0xffffu) : 0u, lo1 = (in && (kk.y >> 16) == T16) ? (kk.y & 0xffffu) : 0u; rk[k] = lo0 | (lo1 << 16); }
                unsigned Tlo = 0u;
#pragma unroll 1
                for (int bit = 15; bit >= 0; --bit) {
                    const unsigned cand = Tlo | (1u << bit);
                    const unsigned tot = hsum32(pk_count32(rk, (cand - 1u) * 0x00010001u, ones, half));
                    if (!exact && tot >= need) { Tlo = cand; exact = (tot == need); }
                    if (__all(exact)) break;
                }
                Tfull = (T16 << 16) | Tlo;
                if (!__all(exact)) {
                    unsigned cgt = 0u, ceq = 0u;
#pragma unroll 1
                    for (int k = 0; k < 32; ++k) { const u32x2 kk = *(const LAS3 u32x2*)(orow + 64 * k); const bool in = 2u * (unsigned)(pos + 32 * k) < nkeys;
                        cgt += (in && kk.x > Tfull && (kk.x >> 16) == T16 ? 1u : 0u) + (in && kk.y > Tfull && (kk.y >> 16) == T16 ? 1u : 0u); }
                    (void)ceq;
                    const unsigned needt = need - hsum32(cgt);
                    unsigned Xl = 0u;
#pragma unroll 1
                    for (int bit = 10; bit >= 0; --bit) {
                        const unsigned cx = Xl | (1u << bit);
                        unsigned c = 0u;
#pragma unroll 1
                        for (int k = 0; k < 32; ++k) { const u32x2 kk = *(const LAS3 u32x2*)(orow + 64 * k); const unsigned i0 = 2u * (unsigned)(pos + 32 * k);
                            c += (i0 < nkeys && kk.x == Tfull && i0 < cx ? 1u : 0u) + (i0 < nkeys && kk.y == Tfull && i0 + 1u < cx ? 1u : 0u); }
                        if (hsum32(c) < needt) Xl = cx;
                    }
                    if (!exact) X = Xl;
                }
            }
            LAS3 unsigned* mrow = MASK + (16 * qg + oq) * 65 + (pos >> 4);
            const unsigned sh = 32u * hh + (pos & 16);
#pragma unroll 2
            for (int k = 0; k <= j; ++k) {
                const u32x2 kk = *(const LAS3 u32x2*)(orow + 64 * k); const unsigned i0 = 2u * (unsigned)(pos + 32 * k);
                const bool s0 = i0 < nkeys && (kk.x > Tfull || (kk.x == Tfull && i0 <= X)), s1 = i0 < nkeys && (kk.y > Tfull || (kk.y == Tfull && i0 + 1u <= X));
                const unsigned long long blo = __ballot(s0), bhi = __ballot(s1);
                const unsigned wv = ((unsigned)(blo >> sh) & 0xffffu) | ((unsigned)(bhi >> sh) << 16);
                if ((pos & 15) == 0) mrow[2 * k] = wv;
            }
        }
        TEND(33);
        __syncthreads();
#ifdef CHECK_SEL
        if (selecting) {
            const int lbase = 16 * w + 4 * fq;
            unsigned key[16][4];
#pragma unroll
            for (int n = 0; n < 16; ++n)
#pragma unroll
                for (int r = 0; r < 4; ++r) key[n][r] = (n < nloc) ? PKT[fr * PKT_LD + lbase + 128 * n + r] : 0u;
            unsigned T2; int X2; select_bitwise(key, lbase, CNT, it, fr, lane, T2, X2);
            bool bad = false;
#pragma unroll
            for (int n = 0; n < 16; ++n) if (n < nloc) { const int x2 = X2 - 128 * n;
#pragma unroll
                for (int r = 0; r < 4; ++r) { const unsigned idx = (unsigned)(lbase + 128 * n + r); const unsigned mw = MASK[(16 * qg + fr) * 65 + (idx >> 5)];
                    const bool s2 = key[n][r] > T2 || (key[n][r] == T2 && r <= x2); bad |= (s2 != (((mw >> (((idx & 31u) >> 1) + 16u * (idx & 1u))) & 1u) != 0u)); } }
            if (__any(bad) && lane == 0) atomicAdd((unsigned*)(ws + CW_CHK), 1u);
            if (lane == 0 && w == 0) atomicAdd((unsigned*)(ws + CW_CHK + 4), 1u);
            __syncthreads();
        }
#endif
    }
    TEND(30); TBEG(31);
    {
        const int h = w & 3, hf = w >> 2, fr = lane0 & 15, fq = lane0 >> 4;
        const size_t qrow0 = (size_t)b * SEQ + q0 + 32 * hf;
        f32x4 o[4][2]; float linv[2];
        attn32<true>((const bf16_t*)(ws + W_DQ) + qrow0 * 256 + h * 64, 256, (const bf16_t*)(ws + W_DK) + (size_t)b * SEQ * 256 + h * 64, 256,
                     (const bf16_t*)(ws + W_DVT) + ((size_t)b * 64 * 4 + h) * 2048, 4 * 2048, 2 * j + 2  , MASK + 32 * hf * 65, fr, fq, o, linv);
        attn_store(o, linv, (const bf16_t*)(ws + W_DG) + qrow0 * 256 + h * 64, (bf16_t*)(ws + W_MIX) + qrow0 * 1024 + 512 + h * 64, fr, fq);
    }
    __syncthreads();
    TEND(31);
}
DI void mem_unit(const Params& p, int n) {
    const int tid = threadIdx.x, lane = tid & 63, w = __builtin_amdgcn_readfirstlane(tid >> 6), fr = lane & 15, fq = lane >> 4;
    unsigned char* ws = p.ws;
    const int h = w & 3, hf = w >> 2;
    const size_t qrow0 = (size_t)n * 64 + 32 * hf; const int b = n >> 5;
    f32x4 o[4][2]; float linv[2];
    attn32<false>((const bf16_t*)(ws + W_MQ) + qrow0 * 256 + h * 64, 256, (const bf16_t*)(ws + W_MK) + (size_t)b * NMEM * 256 + h * 64, 256,
                  (const bf16_t*)(ws + W_MVT) + ((size_t)b * 8 * 4 + h) * 2048, 4 * 2048, 8, nullptr, fr, fq, o, linv);
    attn_store(o, linv, (const bf16_t*)(ws + W_MG) + qrow0 * 256 + h * 64, (bf16_t*)(ws + W_MIX) + qrow0 * 1024 + 768 + h * 64, fr, fq);
}
constexpr int GL_QT = 0, GL_KT = 9216, GL_KPT = 18432, GL_VT = 27648, GL_SBT = 46080, GL_PM = 64512, GL_OF = 73728, GL_GTOT = 107520, GL_W2 = 109568, GL_BG = 113664, GL_DEC = 113920;
constexpr int LDP = 72;
DI void gla_unit(const Params& p, LAS3 unsigned char* lds, int b, int h) {
    const int tid = threadIdx.x, lane = tid & 63, w = __builtin_amdgcn_readfirstlane(tid >> 6), fr = lane & 15, fq = lane >> 4;
    unsigned char* ws = p.ws;
    LAS3 bf16_t* Qt = (LAS3 bf16_t*)(lds + GL_QT); LAS3 bf16_t* Kt = (LAS3 bf16_t*)(lds + GL_KT); LAS3 bf16_t* KpT = (LAS3 bf16_t*)(lds + GL_KPT);
    LAS3 bf16_t* Vt = (LAS3 bf16_t*)(lds + GL_VT); LAS3 bf16_t* SbT = (LAS3 bf16_t*)(lds + GL_SBT); LAS3 bf16_t* Pm = (LAS3 bf16_t*)(lds + GL_PM);
    LAS3 float* Of = (LAS3 float*)(lds + GL_OF); LAS3 float* gtot = (LAS3 float*)(lds + GL_GTOT); LAS3 float* w2s = (LAS3 float*)(lds + GL_W2);
    LAS3 float* bgs = (LAS3 float*)(lds + GL_BG); LAS3 float* dec = (LAS3 float*)(lds + GL_DEC);
    const bf16_t* GQ = (const bf16_t*)(ws + W_GQ); const bf16_t* GK = (const bf16_t*)(ws + W_GK); const bf16_t* GV = (const bf16_t*)(ws + W_GV);
    const bf16_t* GG = (const bf16_t*)(ws + W_GG); const float* GLR = (const float*)(ws + W_GLR); bf16_t* MIX = (bf16_t*)(ws + W_MIX);
    for (int i = tid; i < 128 * LDP / 2; i += NTHREADS) ((LAS3 unsigned*)SbT)[i] = 0u;
    for (int i = tid; i < 16 * 64; i += NTHREADS) w2s[i] = p.w_g2[(i >> 6) * 256 + h * 64 + (i & 63)];
    if (tid < 64) bgs[tid] = p.b_g[h * 64 + tid];
    __syncthreads();
    const int d = tid & 63, tg = w;
    float wreg[16];
#pragma unroll
    for (int r = 0; r < 16; ++r) wreg[r] = w2s[r * 64 + d];
    const float bgd = bgs[d];
    const f32x4 zero = {0.f, 0.f, 0.f, 0.f};
    f32x4 Sacc[4] = {zero, zero, zero, zero};
    const int tt = w & 3, vh = w >> 2;
    for (int c = 0; c < 32; ++c) {
        const size_t rb = (size_t)b * SEQ + c * 64;
        float g8[8];
#pragma unroll
        for (int i = 0; i < 8; ++i) {
            const float* gl = vaddr(GLR + (rb + tg * 8 + i) * 16);
            float u = bgd;
#pragma unroll
            for (int r = 0; r < 16; ++r) u += gl[r] * wreg[r];
            const float g = logsigf(u) * (1.f / 16.f);
            g8[i] = (i ? g8[i - 1] : 0.f) + g;
        }
        gtot[tg * 64 + d] = g8[7];
        __syncthreads();
        float off = 0.f, blast = 0.f;
#pragma unroll
        for (int g2 = 0; g2 < 8; ++g2) { const float v = gtot[g2 * 64 + d]; off += (g2 < tg) ? v : 0.f; blast += v; }
        float kp[8];
#pragma unroll
        for (int i = 0; i < 8; ++i) {
            const int t = tg * 8 + i; const float bt = off + g8[i];
            const float q = bf2f(GQ[(rb + t) * 256 + h * 64 + d]), k = bf2f(GK[(rb + t) * 256 + h * 64 + d]);
            Qt[t * LDP + d] = f2bf(q * fexp(bt)); Kt[t * LDP + d] = f2bf(k * fexp(-bt)); kp[i] = k * fexp(blast - bt);
        }
        { u32x4 kw; kw.x = cvtpk(kp[0], kp[1]); kw.y = cvtpk(kp[2], kp[3]); kw.z = cvtpk(kp[4], kp[5]); kw.w = cvtpk(kp[6], kp[7]); *(LAS3 u32x4*)(KpT + d * LDP + tg * 8) = kw; }
        if (tg == 0) dec[d] = fexp(blast);
        { const int v = tid & 127, sg = tid >> 7; bf16_t vv[16];
#pragma unroll
          for (int i = 0; i < 16; ++i) vv[i] = GV[(rb + sg * 16 + i) * 512 + h * 128 + v];
          u32x4 a, bb; a.x = vv[0] | ((unsigned)vv[1] << 16); a.y = vv[2] | ((unsigned)vv[3] << 16); a.z = vv[4] | ((unsigned)vv[5] << 16); a.w = vv[6] | ((unsigned)vv[7] << 16);
          bb.x = vv[8] | ((unsigned)vv[9] << 16); bb.y = vv[10] | ((unsigned)vv[11] << 16); bb.z = vv[12] | ((unsigned)vv[13] << 16); bb.w = vv[14] | ((unsigned)vv[15] << 16);
          *(LAS3 u32x4*)(Vt + v * LDP + sg * 16) = a; *(LAS3 u32x4*)(Vt + v * LDP + sg * 16 + 8) = bb; }
        __syncthreads();
#pragma unroll
        for (int s2 = 0; s2 < 2; ++s2) {
            const int st = 2 * vh + s2;
            f32x4 acc = zero;
#pragma unroll
            for (int ks = 0; ks < 2; ++ks) {
                const bf16x8 a = *(const LAS3 bf16x8*)(Kt + (st * 16 + fr) * LDP + ks * 32 + fq * 8), bq = *(const LAS3 bf16x8*)(Qt + (tt * 16 + fr) * LDP + ks * 32 + fq * 8);
                acc = mfma16(a, bq, acc);
            }
            const int t = tt * 16 + fr, s0 = st * 16 + 4 * fq;
            u32x2 pw; pw.x = cvtpk(s0 <= t ? acc[0] : 0.f, s0 + 1 <= t ? acc[1] : 0.f); pw.y = cvtpk(s0 + 2 <= t ? acc[2] : 0.f, s0 + 3 <= t ? acc[3] : 0.f);
            *(LAS3 u32x2*)(Pm + t * LDP + s0) = pw;
        }
        __syncthreads();
        f32x4 oacc[4];
        {
            bf16x8 aq[2], ap[2], ak[2];
#pragma unroll
            for (int ks = 0; ks < 2; ++ks) {
                aq[ks] = *(const LAS3 bf16x8*)(Qt + (tt * 16 + fr) * LDP + ks * 32 + fq * 8);
                ap[ks] = *(const LAS3 bf16x8*)(Pm + (tt * 16 + fr) * LDP + ks * 32 + fq * 8);
                ak[ks] = *(const LAS3 bf16x8*)(KpT + (tt * 16 + fr) * LDP + ks * 32 + fq * 8);
            }
            const f32x4 dv = *(const LAS3 f32x4*)(dec + tt * 16 + 4 * fq);
#pragma unroll
            for (int jv = 0; jv < 4; ++jv) {
                const int vt = vh * 4 + jv;
                bf16x8 bs[2], bv[2];
#pragma unroll
                for (int ks = 0; ks < 2; ++ks) {
                    bs[ks] = *(const LAS3 bf16x8*)(SbT + (vt * 16 + fr) * LDP + ks * 32 + fq * 8);
                    bv[ks] = *(const LAS3 bf16x8*)(Vt + (vt * 16 + fr) * LDP + ks * 32 + fq * 8);
                }
                f32x4 oa = mfma16(aq[0], bs[0], zero); oa = mfma16(aq[1], bs[1], oa); oa = mfma16(ap[0], bv[0], oa); oa = mfma16(ap[1], bv[1], oa);
                oacc[jv] = oa;
                f32x4 sa = Sacc[jv] * dv; sa = mfma16(ak[0], bv[0], sa); sa = mfma16(ak[1], bv[1], sa);
                Sacc[jv] = sa;
            }
        }
        __syncthreads();
#pragma unroll
        for (int jv = 0; jv < 4; ++jv) {
            const int vt = vh * 4 + jv;
#pragma unroll
            for (int r = 0; r < 4; ++r) Of[(tt * 16 + 4 * fq + r) * 132 + vt * 16 + fr] = oacc[jv][r];
            u32x2 sw; sw.x = cvtpk(Sacc[jv][0], Sacc[jv][1]); sw.y = cvtpk(Sacc[jv][2], Sacc[jv][3]);
            *(LAS3 u32x2*)(SbT + (vt * 16 + fr) * LDP + tt * 16 + 4 * fq) = sw;
        }
        __syncthreads();
        {
            const int t = tid >> 3, seg = tid & 7;
            const LAS3 float* op = Of + t * 132 + seg * 16;
            f32x4 ov[4]; float ss = 0.f;
#pragma unroll
            for (int i = 0; i < 4; ++i) { ov[i] = *(const LAS3 f32x4*)(op + 4 * i); ss += ov[i][0] * ov[i][0] + ov[i][1] * ov[i][1] + ov[i][2] * ov[i][2] + ov[i][3] * ov[i][3]; }
            ss += __shfl_xor(ss, 1); ss += __shfl_xor(ss, 2); ss += __shfl_xor(ss, 4);
            const float rstd = rsqrtf(ss * (1.f / 128.f) + 1e-6f);
            const bf16_t* gp = GG + (rb + t) * 512 + h * 128 + seg * 16;
            const u32x4 g0 = *(const u32x4*)gp, g1 = *(const u32x4*)(gp + 8);
            const unsigned gw[8] = {g0.x, g0.y, g0.z, g0.w, g1.x, g1.y, g1.z, g1.w};
            unsigned ow[8];
#pragma unroll
            for (int i = 0; i < 4; ++i) {
                const f32x4 on = *(const f32x4*)(p.onorm + seg * 16 + 4 * i);
                const float y0 = ov[i][0] * rstd * on[0] * __uint_as_float(gw[2 * i] << 16), y1 = ov[i][1] * rstd * on[1] * __uint_as_float(gw[2 * i] & 0xffff0000u);
                const float y2 = ov[i][2] * rstd * on[2] * __uint_as_float(gw[2 * i + 1] << 16), y3 = ov[i][3] * rstd * on[3] * __uint_as_float(gw[2 * i + 1] & 0xffff0000u);
                ow[2 * i] = cvtpk(y0, y1); ow[2 * i + 1] = cvtpk(y2, y3);
            }
            bf16_t* mp = MIX + (rb + t) * 1024 + h * 128 + seg * 16;
            *(u32x4*)mp = (u32x4){ow[0], ow[1], ow[2], ow[3]}; *(u32x4*)(mp + 8) = (u32x4){ow[4], ow[5], ow[6], ow[7]};
        }
    }
#pragma unroll
    for (int jv = 0; jv < 4; ++jv)
#pragma unroll
        for (int r = 0; r < 4; ++r) p.out[O_GSP + ((size_t)(b * 4 + h) * 64 + tt * 16 + 4 * fq + r) * 128 + (vh * 4 + jv) * 16 + fr] = Sacc[jv][r];
    __syncthreads();
}

DI void sscore_unit(const Params& p, LAS3 unsigned char* lds, int u) {
    const int tid = threadIdx.x;
    unsigned char* ws = p.ws;
    const int b = u >> 3, pg = u & 7;
    LAS3 float* qf = (LAS3 float*)lds;
    if (tid < 256) qf[tid] = bf2f(((const bf16_t*)(ws + W_IQ))[(size_t)(MP + b) * 256 + tid]);
    __syncthreads();
    const int seg = tid & 15;
    f32x4 q[4];
#pragma unroll
    for (int h = 0; h < 4; ++h) q[h] = *(const LAS3 f32x4*)(qf + h * 64 + seg * 4);
    const f32x4 wv = *(const f32x4*)vaddr((const float*)(ws + W_IW) + (size_t)(MP + b) * 4);
    unsigned* sc = (unsigned*)(ws + W_SC) + (size_t)b * SCLD;
    const int* pt = p.page_table + b * NPAGES + pg * 16;
#define SS_LOAD(BUF, pp) do { const float* base_ = p.cache_ik + (size_t)pt[(pp) < 16 ? (pp) : 15] * 8192; \
        _Pragma("unroll") for (int i = 0; i < 4; ++i) BUF[i] = *(const f32x4*)(base_ + (size_t)(tid + 512 * i) * 4); } while (0)
#define SS_COMPUTE(BUF, pp) do { \
        _Pragma("unroll") for (int i = 0; i < 4; ++i) { const f32x4 kv = BUF[i]; float dh[4]; \
            _Pragma("unroll") for (int h = 0; h < 4; ++h) { float x = q[h][0] * kv[0] + q[h][1] * kv[1] + q[h][2] * kv[2] + q[h][3] * kv[3]; \
                x += __shfl_xor(x, 1); x += __shfl_xor(x, 2); x += __shfl_xor(x, 4); x += __shfl_xor(x, 8); dh[h] = x; } \
            const float s_ = wv[0] * fmaxf(dh[0], 0.f) + wv[1] * fmaxf(dh[1], 0.f) + wv[2] * fmaxf(dh[2], 0.f) + wv[3] * fmaxf(dh[3], 0.f); \
            if (seg == 0) __hip_atomic_store(sc + (pg * 16 + (pp)) * 128 + ((tid + 512 * i) >> 4), __float_as_uint(s_), __ATOMIC_RELAXED, __HIP_MEMORY_SCOPE_AGENT); } } while (0)
    f32x4 pa[4], pb[4];
    SS_LOAD(pa, 0); SS_LOAD(pb, 1);
#pragma unroll 1
    for (int pp = 0; pp < 16; pp += 2) {
        SS_COMPUTE(pa, pp); SS_LOAD(pa, pp + 2);
        SS_COMPUTE(pb, pp + 1); SS_LOAD(pb, pp + 3);
    }
#undef SS_LOAD
#undef SS_COMPUTE
    asm volatile("s_waitcnt vmcnt(0)" ::: "memory");
    __syncthreads();
    if (tid == 0) __hip_atomic_fetch_add((unsigned*)(ws + CW_SCNT), 1u, __ATOMIC_RELAXED, __HIP_MEMORY_SCOPE_AGENT);
}

constexpr int SA_Q = 2048, SA_S = 3072, SA_KP = 8192, SA_VP = 10240;
DI void sattend(const Params& p, LAS3 unsigned char* lds, const bf16_t* qrow  , const bf16_t* gate, bf16_t* mix) {
    const int tid = threadIdx.x, lane = tid & 63, w = tid >> 6;
    LAS3 float* qf = (LAS3 float*)(lds + SA_Q); LAS3 float* S = (LAS3 float*)(lds + SA_S);
    const float* const LAS3* kptr = (const float* const LAS3*)(lds + SA_KP); const float* const LAS3* vptr = (const float* const LAS3*)(lds + SA_VP);
    if (tid < 256) qf[tid] = bf2f(qrow[tid]);
    __syncthreads();
    {
        const int jk = tid >> 1, hp = tid & 1;
        const float* kr = kptr[jk] + hp * 128;
        float s0 = 0.f, s1 = 0.f;
#pragma unroll 4
        for (int i = 0; i < 16; ++i) {
            const f32x4 k0 = *(const f32x4*)(kr + 4 * i), k1 = *(const f32x4*)(kr + 64 + 4 * i);
            const f32x4 q0 = *(const LAS3 f32x4*)(qf + hp * 128 + 4 * i), q1 = *(const LAS3 f32x4*)(qf + hp * 128 + 64 + 4 * i);
            s0 += q0[0] * k0[0] + q0[1] * k0[1] + q0[2] * k0[2] + q0[3] * k0[3];
            s1 += q1[0] * k1[0] + q1[1] * k1[1] + q1[2] * k1[2] + q1[3] * k1[3];
        }
        S[(2 * hp) * 256 + jk] = s0; S[(2 * hp + 1) * 256 + jk] = s1;
    }
    __syncthreads();
    if (w < 4) {
        float v[4], mx = NEG_INF;
#pragma unroll
        for (int i = 0; i < 4; ++i) { v[i] = S[w * 256 + lane + 64 * i]; mx = fmaxf(mx, v[i]); }
        mx = wmax64(mx);
        float sum = 0.f;
#pragma unroll
        for (int i = 0; i < 4; ++i) { v[i] = __expf(v[i] - mx); sum += v[i]; }
        sum = wsum64(sum);
        const float inv = 1.f / sum;
#pragma unroll
        for (int i = 0; i < 4; ++i) S[w * 256 + lane + 64 * i] = v[i] * inv;
    }
    __syncthreads();
    {
        const int h = tid >> 7, dd = (tid >> 1) & 63, hf = tid & 1;
        float acc = 0.f;
#pragma unroll 4
        for (int jk = hf * 128; jk < hf * 128 + 128; ++jk) acc += S[h * 256 + jk] * vptr[jk][h * 64 + dd];
        acc += __shfl_xor(acc, 1);
        if (hf == 0) mix[h * 64 + dd] = f2bf(acc * bf2f(gate[h * 64 + dd]));
    }
    __syncthreads();
}
DI void smem_unit(const Params& p, LAS3 unsigned char* lds, int b) {
    const int tid = threadIdx.x; unsigned char* ws = p.ws;
    const float* LAS3* kptr = (const float* LAS3*)(lds + SA_KP); const float* LAS3* vptr = (const float* LAS3*)(lds + SA_VP);
    if (tid < 256) { kptr[tid] = p.cache_mem_k + ((size_t)b * NMEM + tid) * 256; vptr[tid] = p.cache_mem_v + ((size_t)b * NMEM + tid) * 256; }
    const size_t row = MP + b;
    sattend(p, lds, (const bf16_t*)(ws + W_MQ) + row * 256, (const bf16_t*)(ws + W_MG) + row * 256, (bf16_t*)(ws + W_MIX) + row * 1024 + 768);
}
DI void ssel_unit(const Params& p, LAS3 unsigned char* lds, int b) {
    const int tid = threadIdx.x, lane = tid & 63, w = tid >> 6; unsigned char* ws = p.ws;
    LAS3 unsigned* CNT = (LAS3 unsigned*)lds;
    LAS3 unsigned* wsum = (LAS3 unsigned*)(lds + 256);
    LAS3 float* newsc = (LAS3 float*)(lds + 320);
    LAS3 int* list = (LAS3 int*)(lds + 512);
    const float* LAS3* kptr = (const float* LAS3*)(lds + SA_KP); const float* LAS3* vptr = (const float* LAS3*)(lds + SA_VP);
    if (tid < 48) CNT[tid] = 0u;
    if (tid == 0) {
        unsigned* cnt = (unsigned*)(ws + CW_SCNT); unsigned* tmo = (unsigned*)(ws + CW_TMO); unsigned sp = 0;
        while (__hip_atomic_load(cnt, __ATOMIC_RELAXED, __HIP_MEMORY_SCOPE_AGENT) < 256u) {
            __builtin_amdgcn_s_sleep(2);
            if ((++sp & 255u) == 0u) { if (__hip_atomic_load(tmo, __ATOMIC_RELAXED, __HIP_MEMORY_SCOPE_AGENT)) break; if (sp > (1u << 20)) { __hip_atomic_store(tmo, 1u, __ATOMIC_RELAXED, __HIP_MEMORY_SCOPE_AGENT); break; } }
        }
        __builtin_amdgcn_fence(__ATOMIC_ACQUIRE, "agent");
        asm volatile("s_waitcnt vmcnt(0)" ::: "memory");
    }
    if (w == 1) {
        const bf16_t* iq = (const bf16_t*)(ws + W_IQ) + (size_t)(MP + b) * 256; const float kd = bf2f(((const bf16_t*)(ws + W_IK))[(size_t)(MP + b) * 64 + lane]);
        const f32x4 wv = *(const f32x4*)vaddr((const float*)(ws + W_IW) + (size_t)(MP + b) * 4);
        float s = 0.f;
#pragma unroll
        for (int h = 0; h < 4; ++h) { const float dh = wsum64(bf2f(iq[h * 64 + lane]) * kd); s += wv[h] * fmaxf(dh, 0.f); }
        if (lane == 0) *newsc = s;
    }
    __syncthreads();
    const float* sc = (const float*)(ws + W_SC) + (size_t)b * SCLD;
    unsigned key[33];
#pragma unroll
    for (int n = 0; n < 32; ++n) key[n] = fkey(sc[tid + 512 * n]);
    key[32] = (tid == 0) ? fkey(*newsc) : 0u;
    int it = 0;
    unsigned T = 0u, X = 0x7fffffffu; bool fin = false;
    for (int bit = 31; bit >= 0; --bit) {
        const unsigned cand = T | (1u << bit);
        unsigned c = 0;
#pragma unroll
        for (int n = 0; n < 33; ++n) cnt_ge(c, key[n], cand);
        const unsigned tot = blk_count(c, CNT, it, lane);
        if (tot >= 256u) { T = cand; fin = (tot == 256u); }
        if (fin) break;
    }
    if (!fin) {
        unsigned c = 0;
#pragma unroll
        for (int n = 0; n < 33; ++n) cnt_gt(c, key[n], T);
        const unsigned need = 256u - blk_count(c, CNT, it, lane);
        unsigned Xl = 0u;
        for (int bit = 14; bit >= 0; --bit) {
            const unsigned cand = Xl | (1u << bit);
            c = 0;
#pragma unroll
            for (int n = 0; n < 33; ++n) cnt_eq_lt(c, key[n], T, (unsigned)(tid + 512 * n), cand);
            if (blk_count(c, CNT, it, lane) < need) Xl = cand;
        }
        X = Xl;
    }
    unsigned selm = 0, hi = 0;
#pragma unroll
    for (int n = 0; n < 32; ++n) selm |= (key[n] > T || (key[n] == T && (unsigned)(tid + 512 * n) <= X)) ? (1u << n) : 0u;
    hi = (key[32] > T || (key[32] == T && (unsigned)(tid + 16384) <= X)) ? 1u : 0u;
    const unsigned cs = __popc(selm) + hi;
    unsigned inc = cs;
#pragma unroll
    for (int o2 = 1; o2 < 64; o2 <<= 1) { const unsigned t2 = __shfl_up(inc, o2); if (lane >= o2) inc += t2; }
    if (lane == 63) wsum[w] = inc;
    __syncthreads();
    unsigned pos = inc - cs;
    for (int w2 = 0; w2 < w; ++w2) pos += wsum[w2];
#pragma unroll
    for (int n = 0; n < 32; ++n) if ((selm >> n) & 1u) { if (pos < 256u) list[pos] = tid + 512 * n; ++pos; }
    if (hi) { if (pos < 256u) list[pos] = tid + 16384; ++pos; }
    __syncthreads();
    if (tid < 256) {
        const int idx = list[tid];
        if (idx < 16384) { const size_t phys = (size_t)p.page_table[b * NPAGES + (idx >> 7)] * 128 + (idx & 127); kptr[tid] = p.cache_k + phys * 256; vptr[tid] = p.cache_v + phys * 256; }
        else { kptr[tid] = p.out + O_KS + (size_t)b * 256; vptr[tid] = p.out + O_VS + (size_t)b * 256; }
    }
    const size_t row = MP + b;
    sattend(p, lds, (const bf16_t*)(ws + W_DQ) + row * 256, (const bf16_t*)(ws + W_DG) + row * 256, (bf16_t*)(ws + W_MIX) + row * 1024 + 512);
}
DI void sgla_unit(const Params& p, LAS3 unsigned char* lds, int b) {
    const int tid = threadIdx.x, lane = tid & 63, w = tid >> 6; unsigned char* ws = p.ws;
    LAS3 float* qs = (LAS3 float*)lds; LAS3 float* ks = qs + 256; LAS3 float* gs = qs + 512; LAS3 float* vs = qs + 768; LAS3 float* part = qs + 1280;
    const size_t row = MP + b;
    if (tid < 256) {
        float u = p.b_g[tid];
        const float* gl = vaddr((const float*)(ws + W_GLR) + row * 16);
#pragma unroll
        for (int r = 0; r < 16; ++r) u += gl[r] * p.w_g2[r * 256 + tid];
        gs[tid] = expf(logsigf(u) * (1.f / 16.f));
        qs[tid] = bf2f(((const bf16_t*)(ws + W_GQ))[row * 256 + tid]); ks[tid] = bf2f(((const bf16_t*)(ws + W_GK))[row * 256 + tid]);
    }
    vs[tid] = bf2f(((const bf16_t*)(ws + W_GV))[row * 512 + tid]);
    __syncthreads();
    const int h = tid >> 7, v = tid & 127;
    const float* sp = p.state_gla + ((size_t)(b * 4 + h) * 64) * 128 + v; float* so = p.out + O_GSS + ((size_t)(b * 4 + h) * 64) * 128 + v;
    const float vv = vs[h * 128 + v];
    float o = 0.f;
#pragma unroll 8
    for (int dd = 0; dd < 64; ++dd) { const float sn = gs[h * 64 + dd] * sp[dd * 128] + ks[h * 64 + dd] * vv; so[dd * 128] = sn; o += qs[h * 64 + dd] * sn; }
    const float ss = wsum64(o * o);
    if (lane == 0) part[w] = ss;
    __syncthreads();
    const float rstd = rsqrtf((part[2 * h] + part[2 * h + 1]) * (1.f / 128.f) + 1e-6f);
    ((bf16_t*)(ws + W_MIX))[row * 1024 + h * 128 + v] = f2bf(o * rstd * p.onorm[v] * bf2f(((const bf16_t*)(ws + W_GG))[row * 512 + h * 128 + v]));
    __syncthreads();
}
DI void p4_final(const Params& p) {
    const int tid = threadIdx.x, lane = tid & 63, wv = tid >> 6;
    for (int r = blockIdx.x * 8 + wv; r < MP + NDB; r += gridDim.x * 8) {
        float* y = p.out + (r < MP ? O_YP + (size_t)r * DM : O_YS + (size_t)(r - MP) * DM);
        f32x4 v[4]; float ss = 0.f;
#pragma unroll
        for (int i = 0; i < 4; ++i) { v[i] = *(const f32x4*)(y + i * 256 + lane * 4); ss += v[i][0] * v[i][0] + v[i][1] * v[i][1] + v[i][2] * v[i][2] + v[i][3] * v[i][3]; }
        ss = wsum64(ss);
        const float rstd = rsqrtf(ss * (1.f / DM) + 1e-6f);
#pragma unroll
        for (int i = 0; i < 4; ++i) { const f32x4 gv = *(const f32x4*)(p.norm_final + i * 256 + lane * 4); *(f32x4*)(y + i * 256 + lane * 4) = v[i] * rstd * gv; }
    }
}

DI int next_unit(unsigned* ctr, volatile LAS3 unsigned* slot) {
    if (threadIdx.x == 0) *slot = __hip_atomic_fetch_add(ctr, 1u, __ATOMIC_RELAXED, __HIP_MEMORY_SCOPE_AGENT);
    __syncthreads();
    const int v = __builtin_amdgcn_readfirstlane((int)*slot);
    __syncthreads();
    return v;
}

#ifndef REP1
#define REP1 1
#endif
#ifndef REP2
#define REP2 1
#endif
#ifndef REP3
#define REP3 1
#endif
#ifndef REP2A
#define REP2A 1
#endif
#ifndef REP2B
#define REP2B 1
#endif
#ifndef REP2C
#define REP2C 1
#endif
#ifndef REP2D
#define REP2D 1
#endif
#ifndef REP2E
#define REP2E 1
#endif
DI void sample_inproj(const Params& p, LAS3 unsigned char* lds) {
    const int tid = threadIdx.x, lane = tid & 63, wv = tid >> 6, fr = lane & 15, fq = lane >> 4;
    unsigned char* ws = p.ws;
    LAS3 float* red = (LAS3 float*)lds;
    for (int pr = blockIdx.x; pr < 112; pr += gridDim.x) {
        const int col0 = pr * 32, pn = col0 >> 8, vc0 = col0 & 255;
        const bf16_t* A = (const bf16_t*)(ws + W_XN) + (size_t)MP * 1024 + (size_t)fr * 1024 + fq * 8 + wv * 128;
        const bf16_t* B = (const bf16_t*)(ws + W_WTIN) + (size_t)(col0 + fr) * 1024 + fq * 8 + wv * 128;
        const f32x4 zero = {0.f, 0.f, 0.f, 0.f};
        f32x4 acc[2][2] = {{zero, zero}, {zero, zero}};
#pragma unroll
        for (int ks = 0; ks < 4; ++ks) {
            const bf16x8 a0 = *(const bf16x8*)(A + ks * 32), a1 = *(const bf16x8*)(A + 16 * 1024 + ks * 32);
            const bf16x8 b0 = *(const bf16x8*)(B + ks * 32), b1 = *(const bf16x8*)(B + 16 * 1024 + ks * 32);
            acc[0][0] = mfma16(a0, b0, acc[0][0]); acc[0][1] = mfma16(a0, b1, acc[0][1]); acc[1][0] = mfma16(a1, b0, acc[1][0]); acc[1][1] = mfma16(a1, b1, acc[1][1]);
        }
#pragma unroll
        for (int rt = 0; rt < 2; ++rt)
#pragma unroll
            for (int ct = 0; ct < 2; ++ct)
#pragma unroll
                for (int r = 0; r < 4; ++r) red[(wv * 16 + (rt * 2 + ct) * 4 + r) * 64 + lane] = acc[rt][ct][r];
        __syncthreads();
        {
            const int rt = wv >> 2, r = wv & 3;
            float v0 = 0.f, v1 = 0.f;
#pragma unroll
            for (int w2 = 0; w2 < 8; ++w2) { v0 += red[(w2 * 16 + (rt * 2 + 0) * 4 + r) * 64 + lane]; v1 += red[(w2 * 16 + (rt * 2 + 1) * 4 + r) * 64 + lane]; }
            const float* rope = (const float*)(ws + W_ROPE) + (size_t)2048 * 64;
            {
                const int bs = 16 * rt + 4 * fq + r; const size_t R = (size_t)MP + bs;
                if (pn <= 5 || (pn >= 10 && pn <= 12)) {
                    bf16_t* dst; int ldc = 256, coff = 0; float sc = 1.f; bool silu = false;
                    switch (pn) {
                        case 0: dst = (bf16_t*)(ws + W_GQ); sc = 0.125f; break;
                        case 1: dst = (bf16_t*)(ws + W_GK); break;
                        case 2: dst = (bf16_t*)(ws + W_GV); ldc = 512; break;
                        case 3: dst = (bf16_t*)(ws + W_GV); ldc = 512; coff = 256; break;
                        case 4: dst = (bf16_t*)(ws + W_GG); ldc = 512; silu = true; break;
                        case 5: dst = (bf16_t*)(ws + W_GG); ldc = 512; coff = 256; silu = true; break;
                        case 10: dst = (bf16_t*)(ws + W_DG); silu = true; break;
                        case 11: dst = (bf16_t*)(ws + W_MQ); sc = 0.125f; break;
                        default: dst = (bf16_t*)(ws + W_MG); silu = true; break;
                    }
                    bf16_t* rp = dst + R * ldc + coff + vc0 + fr;
                    rp[0] = f2bf(silu ? siluf(v0) : v0 * sc); rp[16] = f2bf(silu ? siluf(v1) : v1 * sc);
                } else if (pn == 6 || pn == 7 || pn == 9 || (pn == 13 && vc0 < 64)) {
                    const int hh = vc0 >> 6, f = 16 * ((vc0 >> 5) & 1) + fr;
                    const float c = rope[2 * f], s = rope[2 * f + 1], sc = (pn == 6) ? 0.125f : 1.f;
                    const float o1 = (v0 * c - v1 * s) * sc, o2 = (v1 * c + v0 * s) * sc;
                    if (pn == 13) {
                        bf16_t* ikb = (bf16_t*)(ws + W_IK) + R * 64; ikb[f] = f2bf(o1); ikb[f + 32] = f2bf(o2);
                        float* op = p.out + O_IKS + (size_t)bs * 64; op[f] = o1; op[f + 32] = o2;
                    } else {
                        bf16_t* dst = (bf16_t*)(ws + (pn == 6 ? W_DQ : (pn == 7 ? W_DK : W_IQ))) + R * 256 + 64 * hh;
                        dst[f] = f2bf(o1); dst[f + 32] = f2bf(o2);
                        if (pn == 7) { float* op = p.out + O_KS + (size_t)bs * 256 + 64 * hh; op[f] = o1; op[f + 32] = o2; }
                    }
                } else if (pn == 8) {
                    float* op = p.out + O_VS + (size_t)bs * 256 + vc0 + fr; op[0] = v0; op[16] = v1;
                } else if (pn == 13 && vc0 == 64) {
                    if (fr < 4) { ((float*)(ws + W_IW))[R * 4 + fr] = v0 * 0.5f; ((float*)(ws + W_GLR))[R * 16 + 12 + fr] = v1; }
                    else ((float*)(ws + W_GLR))[R * 16 + fr - 4] = v0;
                }
            }
        }
        __syncthreads();
    }
}
DI void phase1(const Params& p, LAS3 unsigned char* lds) {
    unsigned char* ws = p.ws;
    { pg8::Gemm g{(const bf16_t*)(ws + W_XN), (const bf16_t*)(ws + W_WTIN), MP, NIN, DM}; pg8::StaticOrder S; S.init(MP, NIN, (int)gridDim.x, (int)blockIdx.x);
      EpiIn E{ws, p.out}; pg8::gemm_phase<EpiIn, pg8::StaticOrder, true, true>(lds, g, S, E); }
    sample_inproj(p, lds);
}
DI void p2_memgemm(const Params& p, LAS3 unsigned char* lds) {
    const int u = (int)gridDim.x - 1 - (int)blockIdx.x;
    if (u >= 96 && u < 128) {
        pg8::Gemm g{(const bf16_t*)(p.ws + W_MEMN), (const bf16_t*)(p.ws + W_WTMEM), MMEM, 512, DM}; pg8::StaticOrder S; S.init(MMEM, 512, (int)gridDim.x, u - 96);
        EpiMem E{p.ws, p.out}; pg8::gemm_phase<EpiMem, pg8::StaticOrder, true, true>(lds, g, S, E);
        asm volatile("s_waitcnt vmcnt(0)" ::: "memory");
        __syncthreads();
        if (threadIdx.x == 0) {
            __builtin_amdgcn_fence(__ATOMIC_RELEASE, "agent");
            asm volatile("s_waitcnt vmcnt(0)" ::: "memory");
            __hip_atomic_fetch_add((unsigned*)(p.ws + CW_MEMC), 1u, __ATOMIC_RELAXED, __HIP_MEMORY_SCOPE_AGENT);
        }
    }
}
DI void wait_memgemm(const Params& p) {
    if (threadIdx.x == 0) {
        unsigned* cnt = (unsigned*)(p.ws + CW_MEMC); unsigned* tmo = (unsigned*)(p.ws + CW_TMO); unsigned sp = 0;
        while (__hip_atomic_load(cnt, __ATOMIC_RELAXED, __HIP_MEMORY_SCOPE_AGENT) < 32u) {
            __builtin_amdgcn_s_sleep(2);
            if ((++sp & 255u) == 0u) { if (__hip_atomic_load(tmo, __ATOMIC_RELAXED, __HIP_MEMORY_SCOPE_AGENT)) break; if (sp > (1u << 20)) { __hip_atomic_store(tmo, 1u, __ATOMIC_RELAXED, __HIP_MEMORY_SCOPE_AGENT); break; } }
        }
        __builtin_amdgcn_fence(__ATOMIC_ACQUIRE, "agent");
        asm volatile("s_waitcnt vmcnt(0)" ::: "memory");
    }
    __syncthreads();
}
template <int QI> DI void p2_sscore(const Params& p, LAS3 unsigned char* lds) { for (int u = blockIdx.x; u < 256; u += gridDim.x) { sscore_unit(p, lds, u); __syncthreads(); } }
template <int QI> DI void p2_gla(const Params& p, LAS3 unsigned char* lds) { for (int u = blockIdx.x; u < 64; u += gridDim.x) gla_unit(p, lds, u >> 2, u & 3); }
DI int next_unit_xcd(unsigned char* qbase, volatile LAS3 unsigned* slot, unsigned x0) {
    if (threadIdx.x == 0) {
        unsigned res = 0xffffffffu;
        for (unsigned k = 0; k < 8u; ++k) {
            const unsigned xq = (x0 + k) & 7u;
            const unsigned mq = __hip_atomic_fetch_add((unsigned*)(qbase + 256 * xq), 1u, __ATOMIC_RELAXED, __HIP_MEMORY_SCOPE_AGENT);
            if (mq < 64u) { res = xq * 64u + mq; break; }
        }
        *slot = res;
    }
    __syncthreads();
    const int v = __builtin_amdgcn_readfirstlane((int)*slot);
    __syncthreads();
    return v;
}
template <int QI> DI void p2_dsa(const Params& p, LAS3 unsigned char* lds, volatile LAS3 unsigned* MISC TARGS) {
#if defined(XCDQ) && XCDQ
    const unsigned x0 = xb_xcc_id() & 7u;
    for (;;) { const int n = next_unit_xcd(p.ws + CW_QDSA + 8192 * QI, MISC + 4, x0); if (n < 0) break; const int m = n & 63; dsa_unit(p, lds, 2 * (n >> 6) + (m >> 5), 31 - (m & 31) TPASS); }
#else
    for (;;) { const int n = next_unit((unsigned*)(p.ws + CW_QDSA + 8192 * QI), MISC + 4); if (n >= 512) break; dsa_unit(p, lds, n & 15, 31 - (n >> 4) TPASS); }
#endif
}
template <int QI> DI void p2_mem(const Params& p, LAS3 unsigned char* lds, volatile LAS3 unsigned* MISC) {
    wait_memgemm(p);
    for (;;) { const int n = next_unit((unsigned*)(p.ws + CW_QMEM + 8192 * QI), MISC + 4); if (n >= 512) break; mem_unit(p, n); } }
template <int QI> DI void p2_sample(const Params& p, LAS3 unsigned char* lds) {
    for (int u = (int)gridDim.x - 1 - (int)blockIdx.x; u < 96; u += gridDim.x) { if (u < 32) sgla_unit(p, lds, u); else if (u < 64) smem_unit(p, lds, u - 32); else ssel_unit(p, lds, u - 64); } }
template <int RI> DI void phase2(const Params& p, LAS3 unsigned char* lds, volatile LAS3 unsigned* MISC TARGS) {
    TBEG(20); p2_memgemm(p, lds);
    TBEG(21); p2_sscore<0>(p, lds); TEND(21); if (REP2A > 1) p2_sscore<1>(p, lds);
    TBEG(25); p2_sample<0>(p, lds); TEND(25); if (REP2E > 1) p2_sample<1>(p, lds);
    TBEG(22); p2_gla<0>(p, lds); TEND(22); if (REP2B > 1) p2_gla<1>(p, lds);
    TBEG(23); p2_dsa<0>(p, lds, MISC TPASS); TEND(23); if (REP2C > 1) p2_dsa<1>(p, lds, MISC TPASS);
    TBEG(24); p2_mem<0>(p, lds, MISC); TEND(24); if (REP2D > 1) p2_mem<1>(p, lds, MISC);
    TEND(20);
}
DI void phase3(const Params& p, LAS3 unsigned char* lds) {
    pg8::Gemm g{(const bf16_t*)(p.ws + W_MIX), (const bf16_t*)(p.ws + W_WTOUT), MP, DM, DM}; pg8::StaticOrder S; S.init(MP, DM, (int)gridDim.x, (int)blockIdx.x);
    EpiOut E{p.x_prompt, p.x_sample, p.out}; pg8::gemm_phase<EpiOut, pg8::StaticOrder, true, true>(lds, g, S, E);
    const int tid = threadIdx.x, lane = tid & 63, wv = tid >> 6;
    for (int u = blockIdx.x; u < 256; u += gridDim.x) {
        const int b = u >> 3, col0 = (u & 7) * 128 + wv * 16;
        const bf16_t* mrow = (const bf16_t*)(p.ws + W_MIX) + (size_t)(MP + b) * 1024 + lane * 16;
        const u32x4 m0 = *(const u32x4*)mrow, m1 = *(const u32x4*)(mrow + 8);
        const unsigned mw[8] = {m0.x, m0.y, m0.z, m0.w, m1.x, m1.y, m1.z, m1.w};
        float res = 0.f;
#pragma unroll 4
        for (int i = 0; i < 16; ++i) {
            const bf16_t* wrow = (const bf16_t*)(p.ws + W_WTOUT) + (size_t)(col0 + i) * 1024 + lane * 16;
            const u32x4 w0 = *(const u32x4*)wrow, w1 = *(const u32x4*)(wrow + 8);
            const unsigned ww[8] = {w0.x, w0.y, w0.z, w0.w, w1.x, w1.y, w1.z, w1.w};
            float acc = 0.f;
#pragma unroll
            for (int e = 0; e < 8; ++e) acc += __uint_as_float(mw[e] << 16) * __uint_as_float(ww[e] << 16) + __uint_as_float(mw[e] & 0xffff0000u) * __uint_as_float(ww[e] & 0xffff0000u);
            acc = wsum64(acc);
            res = (lane == i) ? acc : res;
        }
        if (lane < 16) p.out[O_YS + (size_t)b * DM + col0 + lane] = p.x_sample[(size_t)b * DM + col0 + lane] + res;
    }
}
#ifdef CHECK_ATT
DI void check_mem_attention(const Params& p) {
    const int tid = threadIdx.x, lane = tid & 63, wv = tid >> 6;
    const int samp = blockIdx.x * 8 + wv;
    const int row = (samp * 977 + 13) % MP, h = samp & 3, b = row >> 11;
    const bf16_t* q = (const bf16_t*)(p.ws + W_MQ) + (size_t)row * 256 + h * 64;
    float s[4];
#pragma unroll
    for (int i = 0; i < 4; ++i) { const float* kr = p.out + O_MKP + ((size_t)b * NMEM + lane + 64 * i) * 256 + h * 64; float a = 0.f; for (int d = 0; d < 64; ++d) a += bf2f(q[d]) * kr[d]; s[i] = a; }
    float mx = wmax64(fmaxf(fmaxf(s[0], s[1]), fmaxf(s[2], s[3])));
    float pe[4], sum = 0.f;
#pragma unroll
    for (int i = 0; i < 4; ++i) { pe[i] = __builtin_amdgcn_exp2f(s[i] - mx); sum += pe[i]; }
    sum = wsum64(sum);
    float err = 0.f, nrm = 0.f;
    for (int d = 0; d < 64; ++d) {
        float a = 0.f;
#pragma unroll
        for (int i = 0; i < 4; ++i) a += pe[i] * p.out[O_MVP + ((size_t)b * NMEM + lane + 64 * i) * 256 + h * 64 + d];
        a = wsum64(a) / sum;
        const float want = a * bf2f(((const bf16_t*)(p.ws + W_MG))[(size_t)row * 256 + h * 64 + d]);
        const float got = bf2f(((const bf16_t*)(p.ws + W_MIX))[(size_t)row * 1024 + 768 + h * 64 + d]);
        err += (got - want) * (got - want); nrm += want * want;
    }
    if (lane == 0) { atomicAdd((unsigned*)(p.ws + CW_CHK + 12), 1u); if (!(err <= 0.0025f * nrm + 1e-12f)) atomicAdd((unsigned*)(p.ws + CW_CHK + 8), 1u); }
    if (samp < 128) {
        const int bs = samp >> 2, hs = samp & 3; const size_t rs = (size_t)MP + bs;
        const bf16_t* qs = (const bf16_t*)(p.ws + W_MQ) + rs * 256 + hs * 64;
        float s2[4];
#pragma unroll
        for (int i = 0; i < 4; ++i) { const float* kr = p.cache_mem_k + ((size_t)bs * NMEM + lane + 64 * i) * 256 + hs * 64; float a = 0.f; for (int d = 0; d < 64; ++d) a += bf2f(qs[d]) * kr[d]; s2[i] = a; }
        const float mx2 = wmax64(fmaxf(fmaxf(s2[0], s2[1]), fmaxf(s2[2], s2[3])));
        float pe2[4], sum2 = 0.f;
#pragma unroll
        for (int i = 0; i < 4; ++i) { pe2[i] = __expf(s2[i] - mx2); sum2 += pe2[i]; }
        sum2 = wsum64(sum2);
        float err2 = 0.f, nrm2 = 0.f;
        for (int d = 0; d < 64; ++d) {
            float a = 0.f;
#pragma unroll
            for (int i = 0; i < 4; ++i) a += pe2[i] * p.cache_mem_v[((size_t)bs * NMEM + lane + 64 * i) * 256 + hs * 64 + d];
            a = wsum64(a) / sum2;
            const float want = a * bf2f(((const bf16_t*)(p.ws + W_MG))[rs * 256 + hs * 64 + d]);
            const float got = bf2f(((const bf16_t*)(p.ws + W_MIX))[rs * 1024 + 768 + hs * 64 + d]);
            err2 += (got - want) * (got - want); nrm2 += want * want;
        }
        if (lane == 0) { atomicAdd((unsigned*)(p.ws + CW_CHK + 12), 1u); if (!(err2 <= 0.0025f * nrm2 + 1e-12f)) atomicAdd((unsigned*)(p.ws + CW_CHK + 8), 1u); }
    }
}
#endif
__global__ void __launch_bounds__(NTHREADS, 2) hymba_fwd(Params p) {
    extern __shared__ __attribute__((aligned(16))) unsigned char lds_raw[];
    LAS3 unsigned char* lds = (LAS3 unsigned char*)lds_raw;
    volatile LAS3 unsigned* MISC = (volatile LAS3 unsigned*)(lds + LDS_MISC);
    const int tid = threadIdx.x;
    if (tid < 64) MISC[tid] = 0u;
    __syncthreads();
    const int lo = p.ph_lo, hi = p.ph_hi;
    TDECL;
    XcdBarrier bar; bar.bar = (unsigned*)p.ws; bar.x = 0; bar.st = MISC;
    if (hi > lo) bar = xcd_barrier_post((unsigned*)p.ws, MISC);
#define IN(k) (lo <= (k) && (k) <= hi)
#define SEAM(k) do { if (IN(k) && IN((k) + 1)) xcd_barrier(bar); } while (0)
    TBEG(0); if (IN(0)) p0_prologue(p, lds); TEND(0);
    TBEG(10); SEAM(0); TEND(10);
    TBEG(1); if (IN(1)) { phase1(p, lds); if (REP1 > 1) { xcd_barrier(bar); phase1(p, lds); } } TEND(1);
    TBEG(11); SEAM(1); TEND(11);
    TBEG(2); if (IN(2)) { phase2<0>(p, lds, MISC TPASS); } TEND(2);
    TBEG(12); SEAM(2); TEND(12);
#ifdef CHECK_ATT
    if (IN(3)) check_mem_attention(p);
#endif
    TBEG(3); if (IN(3)) { phase3(p, lds); if (REP3 > 1) { xcd_barrier(bar); phase3(p, lds); } } TEND(3);
    TBEG(13); SEAM(3); TEND(13);
    TBEG(4); if (IN(4)) p4_final(p); TEND(4);
#ifdef TSEL
    {
        if (tid == 0) { atomicAdd((unsigned long long*)(p.ws + CW_TSUM), (unsigned long long)tacc_); atomicMax((unsigned long long*)(p.ws + CW_TMAX), (unsigned long long)tacc_); }
        xcd_barrier(bar);
        if (blockIdx.x == 0 && tid == 0) {
#ifdef TMAX
            const unsigned long long dly = __hip_atomic_load((unsigned long long*)(p.ws + CW_TMAX), __ATOMIC_RELAXED, __HIP_MEMORY_SCOPE_AGENT);
#else
            const unsigned long long dly = __hip_atomic_load((unsigned long long*)(p.ws + CW_TSUM), __ATOMIC_RELAXED, __HIP_MEMORY_SCOPE_AGENT) / gridDim.x;
#endif
            const unsigned long long t0 = __builtin_amdgcn_s_memrealtime();
            while (__builtin_amdgcn_s_memrealtime() - t0 < dly && __builtin_amdgcn_s_memrealtime() - t0 < 400000ull) __builtin_amdgcn_s_sleep(8);
        }
    }
#endif
#ifdef CHECK_ATT
    {
        xcd_barrier(bar);
        const unsigned nbad = __hip_atomic_load((unsigned*)(p.ws + CW_CHK + 8), __ATOMIC_RELAXED, __HIP_MEMORY_SCOPE_AGENT);
        const unsigned nchk = __hip_atomic_load((unsigned*)(p.ws + CW_CHK + 12), __ATOMIC_RELAXED, __HIP_MEMORY_SCOPE_AGENT);
        if (nbad != 0u || nchk < 2170u) for (int i = blockIdx.x * NTHREADS + tid; i < NDB * DM; i += gridDim.x * NTHREADS) p.out[O_YS + i] = __builtin_nanf("");
    }
#endif
#ifdef CHECK_SEL
    {
        xcd_barrier(bar);
        const unsigned nbad = __hip_atomic_load((unsigned*)(p.ws + CW_CHK), __ATOMIC_RELAXED, __HIP_MEMORY_SCOPE_AGENT);
        const unsigned nhist = __hip_atomic_load((unsigned*)(p.ws + CW_CHK + 4), __ATOMIC_RELAXED, __HIP_MEMORY_SCOPE_AGENT);
        if (nbad != 0u || nhist < CHECK_MIN_HIST) for (int i = blockIdx.x * NTHREADS + tid; i < NDB * DM; i += gridDim.x * NTHREADS) p.out[O_YS + i] = __builtin_nanf("");
    }
#endif
#undef IN
#undef SEAM
}

#ifndef N_LAUNCHES
#define N_LAUNCHES 1
#endif
extern "C" void kernel_launch(void* const* d_in, const int* in_sizes, int n_in, void* d_out, int out_size, void* d_ws, size_t ws_size, hipStream_t stream) {
    static int grid = 0;
    if (grid == 0) {
        if (n_in != 19 || (size_t)out_size != O_END || ws_size < W_END) fprintf(stderr, "kernel_launch: unexpected sizes: n_in %d out %d ws %zu (need %zu)\n", n_in, out_size, ws_size, (size_t)W_END);
        int dev = 0, cus = 0, per_cu = 0;
        if (hipGetDevice(&dev) != hipSuccess || hipDeviceGetAttribute(&cus, hipDeviceAttributeMultiprocessorCount, dev) != hipSuccess) { fprintf(stderr, "kernel_launch: device query failed\n"); grid = -1; return; }
        if (hipFuncSetAttribute((const void*)hymba_fwd, hipFuncAttributeMaxDynamicSharedMemorySize, LDS_BYTES) != hipSuccess) { fprintf(stderr, "kernel_launch: hipFuncSetAttribute failed\n"); grid = -1; return; }
        if (hipOccupancyMaxActiveBlocksPerMultiprocessor(&per_cu, (const void*)hymba_fwd, NTHREADS, LDS_BYTES) != hipSuccess || per_cu < 1) fprintf(stderr, "kernel_launch: occupancy query reports %d blocks per CU\n", per_cu);
        (void)hipGetLastError();
        grid = cus;
    }
    if (grid < 0) return;
    (void)hipMemsetAsync(d_ws, 0, CTRL_BYTES, stream);
    Params p{};
    p.x_prompt = (const float*)d_in[0]; p.x_sample = (const float*)d_in[1]; p.mem_prompt = (const float*)d_in[2]; p.state_gla = (const float*)d_in[3];
    p.cache_k = (const float*)d_in[4]; p.cache_v = (const float*)d_in[5]; p.cache_ik = (const float*)d_in[6]; p.cache_mem_k = (const float*)d_in[7]; p.cache_mem_v = (const float*)d_in[8];
    p.page_table = (const int*)d_in[9];
    p.norm_in = (const float*)d_in[10]; p.w_in = (const float*)d_in[11]; p.w_g2 = (const float*)d_in[12]; p.b_g = (const float*)d_in[13]; p.onorm = (const float*)d_in[14];
    p.mem_norm = (const float*)d_in[15]; p.w_mem_kv = (const float*)d_in[16]; p.w_out = (const float*)d_in[17]; p.norm_final = (const float*)d_in[18];
    p.out = (float*)d_out; p.ws = (unsigned char*)d_ws;
#if N_LAUNCHES == 1
    p.ph_lo = 0; p.ph_hi = 4;
    hipLaunchKernelGGL(hymba_fwd, dim3(grid), dim3(NTHREADS), LDS_BYTES, stream, p);
#else
    for (int ph = 0; ph < 5; ++ph) { p.ph_lo = ph; p.ph_hi = ph; hipLaunchKernelGGL(hymba_fwd, dim3(grid), dim3(NTHREADS), LDS_BYTES, stream, p); }
#endif
    const hipError_t le = hipPeekAtLastError();
    if (le != hipSuccess) fprintf(stderr, "kernel_launch: launch failed: %s\n", hipGetErrorName(le));
}
```

```cpp
#include <hip/hip_runtime.h>
#include <cstdint>
#include <cstdio>
namespace pg8 {
#define PG8_LAS __attribute__((address_space(3)))
typedef unsigned short bf16_t;
typedef short bf16x8 __attribute__((ext_vector_type(8)));
typedef float f32x4 __attribute__((ext_vector_type(4)));
typedef unsigned u32x4 __attribute__((ext_vector_type(4)));
constexpr int BM = 256, BK = 64, HALF = 128, HTB = HALF * BK * 2  , STAGE_BYTES = 8 * HTB, NXCD = 8, WGM = 8;

__host__ __device__ __forceinline__ int lds_byte(int r, int c) { const int st = (r >> 4) * 2 + (c >> 5), rr = r & 15, cc = c & 31, ob = rr * 64 + cc * 2; return st * 1024 + (ob ^ (((ob >> 9) & 1) << 5)); }
__host__ __device__ __forceinline__ void stage_rc(int b, int& R, int& C) { const int st = b / 1024, sb = b % 1024, swz = sb ^ (((sb >> 9) & 1) << 5); R = (st >> 1) * 16 + swz / 64; C = (st & 1) * 32 + (swz % 64) / 2; }
__host__ __device__ __forceinline__ int perm32(int rho) { const int n = rho >> 4, i = rho & 15; return 8 * (i >> 2) + 4 * n + (i & 3); }

struct Unit { int pm, pn; };
struct Gemm { const bf16_t* A; const bf16_t* Bt; int M, N, K; };

struct StaticOrder {
    int nM, nN, nwg, G, c;
    __host__ __device__ void init(int M, int N, int G_, int c_) { nM = M / BM; nN = N / BM; nwg = nM * nN; G = G_; c = c_; }
    __host__ __device__ bool next(int i, Unit& u) const {
        const long L = (long)i * G + c; if (L >= nwg) return false;
        int wgid = (int)L; { const int q = nwg / NXCD, r = nwg % NXCD, xcd = wgid % NXCD, off = wgid / NXCD; wgid = (xcd < r ? xcd * (q + 1) : r * (q + 1) + (xcd - r) * q) + off; }
        const int nig = WGM * nN, gid = wgid / nig, fm = gid * WGM, gsz = (nM - fm) < WGM ? (nM - fm) : WGM;
        u.pm = fm + ((wgid % nig) % gsz); u.pn = (wgid % nig) / gsz; return true;
    }
    __device__ __forceinline__ void a_ready(const Unit&) const {}
    __device__ __forceinline__ void done(const Unit&) const {}
};

template <class Epi, class Sched, bool ALIGN_EPI = false, bool SP2 = false>
__device__ __forceinline__ void gemm_phase(PG8_LAS unsigned char* lds, const Gemm g, const Sched& S, const Epi& E) {
    const int tid = threadIdx.x, wid = __builtin_amdgcn_readfirstlane(tid >> 6), lane = tid & 63, wr = wid >> 2, wc = wid & 3, fr = lane & 15, fq = lane >> 4;
    const int K = g.K, nt = K / BK;
    unsigned voffA[2], voffB[2];
#pragma unroll
    for (int i = 0; i < 2; ++i) { int R, C; stage_rc(tid * 16 + i * 8192, R, C); const int Rb = Epi::PERM ? ((R & ~31) + perm32(R & 31)) : R;
        voffA[i] = (unsigned)(R * K + C) * 2u; voffB[i] = (unsigned)(Rb * K + C) * 2u; }
    const size_t kstep = (size_t)(BK * 2);
    const size_t hstep = (size_t)HALF * K * 2;
    const size_t tstep = 2 * hstep;
    const unsigned ldsw = (unsigned)wid * 1024u;
    const int aoff = lds_byte(wr * 64 + fr, fq * 8), boff = lds_byte(wc * 32 + fr, fq * 8);
#define PG8_SA(b, h) (((b) * 2 + (h)) * HTB)
#define PG8_SB(b, h) ((4 + (b) * 2 + (h)) * HTB)
#define PG8_STAGE(bufoff, gbase, voff) do { _Pragma("unroll") for (int _i = 0; _i < 2; ++_i) \
        __builtin_amdgcn_global_load_lds((const unsigned*)((const char*)(gbase) + (voff)[_i]), (PG8_LAS unsigned*)(lds + (bufoff) + ldsw + _i * 8192), 16, 0, 0); } while (0)
#define PG8_LDA(dst, b, h) do { _Pragma("unroll") for (int m = 0; m < 4; ++m) _Pragma("unroll") for (int k = 0; k < 2; ++k) dst[m][k] = *(const PG8_LAS bf16x8*)(lds + PG8_SA(b, h) + aoff + m * 2048 + k * 1024); } while (0)
#define PG8_LDB(dst, b, h) do { _Pragma("unroll") for (int n = 0; n < 2; ++n) _Pragma("unroll") for (int k = 0; k < 2; ++k) dst[n][k] = *(const PG8_LAS bf16x8*)(lds + PG8_SB(b, h) + boff + n * 2048 + k * 1024); } while (0)
#define PG8_MMA(ai, bj, At, Bt) do { __builtin_amdgcn_s_setprio(1); _Pragma("unroll") for (int m = 0; m < 4; ++m) _Pragma("unroll") for (int n = 0; n < 2; ++n) _Pragma("unroll") for (int k = 0; k < 2; ++k) \
        acc[ai][bj][m][n] = __builtin_amdgcn_mfma_f32_16x16x32_bf16(Bt[n][k], At[m][k], acc[ai][bj][m][n], 0, 0, 0); __builtin_amdgcn_s_setprio(0); } while (0)
#define PG8_WAIT_V(n) asm volatile("s_waitcnt vmcnt(" #n ")" ::: "memory")
#define PG8_WAIT_L(n) asm volatile("s_waitcnt lgkmcnt(" #n ")" ::: "memory")
#define PG8_BAR __builtin_amdgcn_s_barrier()
#define PG8_SCHED __builtin_amdgcn_sched_barrier(0)
    Unit cur, nxt; int ui = 0;
    if (!S.next(0, cur)) return;
    f32x4 acc[2][2][4][2];
#pragma unroll
    for (int a = 0; a < 2; ++a)
#pragma unroll
        for (int b = 0; b < 2; ++b)
#pragma unroll
            for (int m = 0; m < 4; ++m)
#pragma unroll
                for (int n = 0; n < 2; ++n) acc[a][b][m][n] = (f32x4){0.f, 0.f, 0.f, 0.f};
    bf16x8 At[4][2], B0[2][2], B1[2][2];
    const char* cA = (const char*)g.A + (size_t)cur.pm * tstep; const char* cB = (const char*)g.Bt + (size_t)cur.pn * tstep;
    S.a_ready(cur);
    if constexpr (SP2) {
        PG8_STAGE(PG8_SB(0, 0), cB, voffB); PG8_STAGE(PG8_SB(0, 1), cB + hstep, voffB); PG8_STAGE(PG8_SA(0, 0), cA, voffA); PG8_STAGE(PG8_SA(0, 1), cA + hstep, voffA);
        if (wr == 1) PG8_BAR;
        PG8_WAIT_V(2); PG8_BAR;
        PG8_STAGE(PG8_SB(1, 0), cB + kstep, voffB); PG8_STAGE(PG8_SA(1, 0), cA + kstep, voffA); PG8_STAGE(PG8_SB(1, 1), cB + hstep + kstep, voffB);
        PG8_WAIT_V(6); PG8_BAR;
    } else {
        PG8_STAGE(PG8_SB(0, 0), cB, voffB); PG8_STAGE(PG8_SA(0, 0), cA, voffA); PG8_STAGE(PG8_SB(0, 1), cB + hstep, voffB); PG8_STAGE(PG8_SA(0, 1), cA + hstep, voffA);
        if (wr == 1) PG8_BAR;
        PG8_WAIT_V(4); PG8_BAR;
        PG8_STAGE(PG8_SB(1, 0), cB + kstep, voffB); PG8_STAGE(PG8_SA(1, 0), cA + kstep, voffA); PG8_STAGE(PG8_SB(1, 1), cB + hstep + kstep, voffB);
        PG8_WAIT_V(6); PG8_BAR;
    }
    for (;;) {
        const bool has_next = S.next(ui + 1, nxt);
        const char* nA = has_next ? (const char*)g.A + (size_t)nxt.pm * tstep : cA; const char* nB = has_next ? (const char*)g.Bt + (size_t)nxt.pn * tstep : cB;
        for (int t = 0; t < nt; t += 2) {
            const bool last = (t == nt - 2);
            const char* a1 = cA + (size_t)(t + 1) * kstep;
            const char* a2 = last ? nA : cA + (size_t)(t + 2) * kstep; const char* b2 = last ? nB : cB + (size_t)(t + 2) * kstep;
            const char* a3 = a2 + kstep; const char* b3 = b2 + kstep;
            if (last && has_next) S.a_ready(nxt);
            if constexpr (SP2) {
            PG8_LDB(B0, 0, 0); PG8_LDB(B1, 0, 1); PG8_SCHED; PG8_LDA(At, 0, 0); PG8_STAGE(PG8_SA(1, 1), a1 + hstep, voffA);
            PG8_WAIT_V(8); PG8_WAIT_L(0); PG8_BAR; PG8_MMA(0, 0, At, B0); PG8_MMA(0, 1, At, B1); PG8_BAR; PG8_SCHED;
            PG8_LDA(At, 0, 1); PG8_STAGE(PG8_SB(0, 0), b2, voffB); PG8_STAGE(PG8_SB(0, 1), b2 + hstep, voffB); PG8_STAGE(PG8_SA(0, 0), a2, voffA);
            PG8_WAIT_V(8); PG8_WAIT_L(0); PG8_BAR; PG8_MMA(1, 0, At, B0); PG8_MMA(1, 1, At, B1); PG8_BAR; PG8_SCHED;
            PG8_LDB(B0, 1, 0); PG8_LDB(B1, 1, 1); PG8_SCHED; PG8_LDA(At, 1, 0); PG8_STAGE(PG8_SA(0, 1), a2 + hstep, voffA);
            PG8_WAIT_V(8); PG8_WAIT_L(0); PG8_BAR; PG8_MMA(0, 0, At, B0); PG8_MMA(0, 1, At, B1); PG8_BAR; PG8_SCHED;
            PG8_LDA(At, 1, 1); PG8_STAGE(PG8_SB(1, 0), b3, voffB); PG8_STAGE(PG8_SB(1, 1), b3 + hstep, voffB); PG8_STAGE(PG8_SA(1, 0), a3, voffA);
            PG8_WAIT_V(8); PG8_WAIT_L(0); PG8_BAR; PG8_MMA(1, 0, At, B0); PG8_MMA(1, 1, At, B1); PG8_BAR; PG8_SCHED;
            } else {
            PG8_LDB(B0, 0, 0); PG8_SCHED; PG8_LDA(At, 0, 0); PG8_STAGE(PG8_SA(1, 1), a1 + hstep, voffA);
            PG8_WAIT_L(8); PG8_BAR; PG8_WAIT_L(0); PG8_MMA(0, 0, At, B0); PG8_BAR; PG8_SCHED;
            PG8_LDB(B1, 0, 1); PG8_STAGE(PG8_SB(0, 0), b2, voffB);
            PG8_BAR; PG8_WAIT_L(0); PG8_MMA(0, 1, At, B1); PG8_BAR;
            PG8_LDA(At, 0, 1); PG8_STAGE(PG8_SA(0, 0), a2, voffA);
            PG8_BAR; PG8_WAIT_L(0); PG8_MMA(1, 0, At, B0); PG8_BAR; PG8_SCHED;
            PG8_STAGE(PG8_SB(0, 1), b2 + hstep, voffB);
            PG8_WAIT_V(6); PG8_BAR; PG8_MMA(1, 1, At, B1); PG8_BAR;
            PG8_LDB(B0, 1, 0); PG8_SCHED; PG8_LDA(At, 1, 0); PG8_STAGE(PG8_SA(0, 1), a2 + hstep, voffA);
            PG8_WAIT_L(8); PG8_BAR; PG8_WAIT_L(0); PG8_MMA(0, 0, At, B0); PG8_BAR; PG8_SCHED;
            PG8_LDB(B1, 1, 1); PG8_STAGE(PG8_SB(1, 0), b3, voffB);
            PG8_BAR; PG8_WAIT_L(0); PG8_MMA(0, 1, At, B1); PG8_BAR;
            PG8_LDA(At, 1, 1); PG8_STAGE(PG8_SA(1, 0), a3, voffA);
            PG8_BAR; PG8_WAIT_L(0); PG8_MMA(1, 0, At, B0); PG8_BAR; PG8_SCHED;
            PG8_STAGE(PG8_SB(1, 1), b3 + hstep, voffB);
            PG8_WAIT_V(6); PG8_BAR; PG8_MMA(1, 1, At, B1); PG8_BAR;
            }
        }
        if constexpr (ALIGN_EPI) { if (wr == 0) PG8_BAR; }
        if constexpr (!Epi::AFTER_DRAIN) { E(acc, cur, wr, wc, fr, fq); S.done(cur); }
        if (!has_next) break;
#pragma unroll
        for (int a = 0; a < 2; ++a)
#pragma unroll
            for (int b = 0; b < 2; ++b)
#pragma unroll
                for (int m = 0; m < 4; ++m)
#pragma unroll
                    for (int n = 0; n < 2; ++n) acc[a][b][m][n] = (f32x4){0.f, 0.f, 0.f, 0.f};
        cur = nxt; cA = nA; cB = nB; ++ui;
        if constexpr (ALIGN_EPI) { if (wr == 1) PG8_BAR; }
    }
    PG8_WAIT_V(0);
    if constexpr (!ALIGN_EPI) { if (wr == 0) PG8_BAR; }
    PG8_BAR;
    if constexpr (Epi::AFTER_DRAIN) { E.fused(acc, cur, wr, wc, fr, fq, lds, wid, lane); S.done(cur); }
#undef PG8_SA
#undef PG8_SB
#undef PG8_STAGE
#undef PG8_LDA
#undef PG8_LDB
#undef PG8_MMA
#undef PG8_WAIT_V
#undef PG8_WAIT_L
#undef PG8_BAR
#undef PG8_SCHED
}
}
#define XB_TMO      128
#define XB_XCNT(j)  (256  + 64 * (j))
#define XB_XSUB(j)  (1280 + 64 * (j))
#define XB_XGEN(j)  (2304 + 64 * (j))
#define XB_TOP      3328
#define XB_TOPGEN   3392
#define XCD_BAR_WORDS 3456
#define XB_SPIN_CAP (1u << 18)
#define LAS __attribute__((address_space(3)))

__device__ __forceinline__ unsigned xb_ld(unsigned* p)              { return __hip_atomic_load(p, __ATOMIC_RELAXED, __HIP_MEMORY_SCOPE_AGENT); }
__device__ __forceinline__ unsigned xb_add(unsigned* p, unsigned v) { return __hip_atomic_fetch_add(p, v, __ATOMIC_RELAXED, __HIP_MEMORY_SCOPE_AGENT); }
__device__ __forceinline__ unsigned xb_xcc_id() { return (unsigned)__builtin_amdgcn_s_getreg((3 << 11) | 20) & 0xFu; }
#define XB_SPIN(cond, bar) do { unsigned _sp = 0; while (cond) { __builtin_amdgcn_s_sleep(1); \
    if ((++_sp & 255u) == 0u) { if (xb_ld(&(bar)[XB_TMO])) break; if (_sp > XB_SPIN_CAP) { atomicAdd(&(bar)[XB_TMO], 1u); break; } } } } while (0)

struct XcdBarrier {
    unsigned* bar; unsigned x;
    volatile LAS unsigned* st;
};

__device__ __forceinline__ XcdBarrier xcd_barrier_post(unsigned* bar, volatile LAS unsigned* st) {
    XcdBarrier b; b.bar = bar; b.x = xb_xcc_id(); b.st = st;
    if (threadIdx.x == 0) (void)xb_add(&bar[XB_XCNT(b.x)], 1u);
    return b;
}
__device__ __forceinline__ void xcd_barrier_complete(unsigned* bar, unsigned x, unsigned& nloc, unsigned& nx) {
    const unsigned G = gridDim.x * gridDim.y * gridDim.z;
    unsigned sum, cnt, mine, sp = 0u;
    for (;;) {
        sum = 0u; cnt = 0u; mine = 0u;
#pragma unroll
        for (unsigned j = 0; j < 16; ++j) { const unsigned c = xb_ld(&bar[XB_XCNT(j)]); sum += c; cnt += (c > 0u) ? 1u : 0u; mine = (j == x) ? c : mine; }
        if (sum == G) break;
        __builtin_amdgcn_s_sleep(1);
        if ((++sp & 255u) == 0u) { if (xb_ld(&bar[XB_TMO])) break; if (sp > XB_SPIN_CAP) { atomicAdd(&bar[XB_TMO], 1u); break; } }
    }
    nloc = mine > 0u ? mine : 1u; nx = cnt > 0u ? cnt : 1u;
}

__device__ __forceinline__ void xcd_barrier(const XcdBarrier& b) {
    asm volatile("s_waitcnt vmcnt(0)" ::: "memory");
    __syncthreads();
    if (threadIdx.x == 0) {
        unsigned* bar = b.bar;
        __builtin_amdgcn_s_waitcnt(0);
        unsigned nloc = b.st[0], nx = b.st[1];
        if (nloc == 0u) { xcd_barrier_complete(bar, b.x, nloc, nx); b.st[0] = nloc; b.st[1] = nx; }
        const unsigned old = xb_add(&bar[XB_XSUB(b.x)], 1u);
        const unsigned gen = old / nloc;
        if (old + 1u == (gen + 1u) * nloc) {
            __builtin_amdgcn_fence(__ATOMIC_RELEASE, "agent");
            asm volatile("s_waitcnt vmcnt(0)" ::: "memory");
            const unsigned og = xb_add(&bar[XB_TOP], 1u);
            const unsigned tg = og / nx;
            if (og + 1u == (tg + 1u) * nx) xb_add(&bar[XB_TOPGEN], 1u);
            else XB_SPIN(xb_ld(&bar[XB_TOPGEN]) == tg, bar);
            __builtin_amdgcn_fence(__ATOMIC_ACQUIRE, "agent");
            xb_add(&bar[XB_XGEN(b.x)], 1u);
            asm volatile("s_waitcnt vmcnt(0)" ::: "memory");
        } else {
            XB_SPIN(xb_ld(&bar[XB_XGEN(b.x)]) == gen, bar);
            __builtin_amdgcn_fence(__ATOMIC_ACQUIRE, "agent");
            asm volatile("s_waitcnt vmcnt(0)" ::: "memory");
        }
    }
    __syncthreads();
}
#define DI __device__ __forceinline__
#define LAS3 __attribute__((address_space(3)))
using pg8::bf16_t; using pg8::bf16x8; using pg8::f32x4; using pg8::u32x4;
typedef unsigned u32x2 __attribute__((ext_vector_type(2)));
typedef short s16x4 __attribute__((ext_vector_type(4)));
typedef float f32x2 __attribute__((ext_vector_type(2)));
typedef __bf16 bf16x2_t __attribute__((ext_vector_type(2)));

constexpr int DM = 1024, NB = 16, SEQ = 2048, MP = NB * SEQ  , NDB = 32  , MROWS = 33024  ;
constexpr int NMEM = 256, MMEM = NB * NMEM  , DIN = 3412, NIN = 3584, NPAGES = 128;
constexpr int NTHREADS = 512;
constexpr size_t O_YP = 0, O_YS = O_YP + (size_t)MP * DM, O_GSP = O_YS + (size_t)NDB * DM, O_KP = O_GSP + (size_t)NB * 4 * 64 * 128,
                 O_VP = O_KP + (size_t)MP * 256, O_IKP = O_VP + (size_t)MP * 256, O_MKP = O_IKP + (size_t)MP * 64, O_MVP = O_MKP + (size_t)MMEM * 256,
                 O_GSS = O_MVP + (size_t)MMEM * 256, O_KS = O_GSS + (size_t)NDB * 4 * 64 * 128, O_VS = O_KS + (size_t)NDB * 256, O_IKS = O_VS + (size_t)NDB * 256,
                 O_END = O_IKS + (size_t)NDB * 64;
static_assert(O_END == 56150016, "output size");
constexpr size_t al256(size_t x) { return (x + 255) & ~(size_t)255; }
constexpr size_t CTRL_BYTES = 32768;
constexpr size_t CW_QDSA = 16384  , CW_QMEM = 18432  , CW_SCNT = 20480, CW_TMO = 20736, CW_CHK = 20992, CW_TSUM = 21248, CW_TMAX = 21504, CW_MEMC = 21760;
constexpr int SCLD = 16400;
constexpr size_t W_ROPE = CTRL_BYTES;
constexpr size_t W_XN = al256(W_ROPE + (size_t)2049 * 32 * 8);
constexpr size_t W_MEMN = W_XN + (size_t)MROWS * 1024 * 2;
constexpr size_t W_WTIN = W_MEMN + (size_t)MMEM * 1024 * 2;
constexpr size_t W_WTMEM = W_WTIN + (size_t)NIN * 1024 * 2;
constexpr size_t W_WTOUT = W_WTMEM + (size_t)512 * 1024 * 2;
constexpr size_t W_GQ = W_WTOUT + (size_t)1024 * 1024 * 2;
constexpr size_t W_GK = W_GQ + (size_t)MROWS * 256 * 2;
constexpr size_t W_GV = W_GK + (size_t)MROWS * 256 * 2;
constexpr size_t W_GG = W_GV + (size_t)MROWS * 512 * 2;
constexpr size_t W_DQ = W_GG + (size_t)MROWS * 512 * 2;
constexpr size_t W_DK = W_DQ + (size_t)MROWS * 256 * 2;
constexpr size_t W_DVT = W_DK + (size_t)MROWS * 256 * 2;
constexpr size_t W_IQ = W_DVT + (size_t)MP * 256 * 2;
constexpr size_t W_DG = W_IQ + (size_t)MROWS * 256 * 2;
constexpr size_t W_MQ = W_DG + (size_t)MROWS * 256 * 2;
constexpr size_t W_MG = W_MQ + (size_t)MROWS * 256 * 2;
constexpr size_t W_IK = W_MG + (size_t)MROWS * 256 * 2;
constexpr size_t W_IW = W_IK + (size_t)MROWS * 64 * 2;
constexpr size_t W_GLR = W_IW + (size_t)MROWS * 4 * 4;
constexpr size_t W_MK = W_GLR + (size_t)MROWS * 16 * 4;
constexpr size_t W_MVT = W_MK + (size_t)MMEM * 256 * 2;
constexpr size_t W_MIX = W_MVT + (size_t)MMEM * 256 * 2;
constexpr size_t W_SC = W_MIX + (size_t)MROWS * 1024 * 2;
constexpr size_t W_END = W_SC + (size_t)NDB * SCLD * 4;
constexpr int LDS_MISC = 148480, LDS_BYTES = 148480 + 256;

struct Params {
    const float *x_prompt, *x_sample, *mem_prompt, *state_gla, *cache_k, *cache_v, *cache_ik, *cache_mem_k, *cache_mem_v;
    const int* page_table;
    const float *norm_in, *w_in, *w_g2, *b_g, *onorm, *mem_norm, *w_mem_kv, *w_out, *norm_final;
    float* out; unsigned char* ws; int ph_lo, ph_hi;
};

#ifdef TSEL
#define TDECL unsigned tacc_ = 0u, tbeg_ = 0u
#define TBEG(k) do { if ((k) == TSEL) tbeg_ = (unsigned)__builtin_amdgcn_s_memrealtime(); } while (0)
#define TEND(k) do { if ((k) == TSEL) tacc_ += (unsigned)__builtin_amdgcn_s_memrealtime() - tbeg_; } while (0)
#define TARGS , unsigned& tacc_, unsigned& tbeg_
#define TPASS , tacc_, tbeg_
#else
#define TARGS
#define TPASS
#define TDECL do {} while (0)
#define TBEG(k) do {} while (0)
#define TEND(k) do {} while (0)
#endif
DI float bf2f(bf16_t v) { return __uint_as_float((unsigned)v << 16); }
DI unsigned cvtpk(float lo, float hi) { f32x2 v = {lo, hi}; bf16x2_t b = __builtin_convertvector(v, bf16x2_t); return __builtin_bit_cast(unsigned, b); }
DI bf16_t f2bf(float x) { return (bf16_t)(cvtpk(x, 0.f) & 0xffffu); }
DI f32x4 mfma16(bf16x8 a, bf16x8 b, f32x4 c) { return __builtin_amdgcn_mfma_f32_16x16x32_bf16(a, b, c, 0, 0, 0); }
DI float fexp(float x) { return __builtin_amdgcn_exp2f(x * 1.4426950408889634f); }
DI float siluf(float x) { return x * __builtin_amdgcn_rcpf(1.f + fexp(-x)); }
DI float logsigf(float u) { return fminf(u, 0.f) - 0.6931471805599453f * __builtin_amdgcn_logf(1.f + fexp(-fabsf(u))); }
DI unsigned fkey(float x) { unsigned u = __float_as_uint(x); u = (u == 0x80000000u) ? 0u : u; return u ^ ((unsigned)((int)u >> 31) | 0x80000000u); }
DI float wsum64(float v) { v += __shfl_xor(v, 1); v += __shfl_xor(v, 2); v += __shfl_xor(v, 4); v += __shfl_xor(v, 8); v += __shfl_xor(v, 16); v += __shfl_xor(v, 32); return v; }
DI float wmax64(float v) { v = fmaxf(v, __shfl_xor(v, 1)); v = fmaxf(v, __shfl_xor(v, 2)); v = fmaxf(v, __shfl_xor(v, 4)); v = fmaxf(v, __shfl_xor(v, 8)); v = fmaxf(v, __shfl_xor(v, 16)); v = fmaxf(v, __shfl_xor(v, 32)); return v; }
DI unsigned lds_add(LAS3 unsigned* p, unsigned v) { return __hip_atomic_fetch_add(p, v, __ATOMIC_RELAXED, __HIP_MEMORY_SCOPE_WORKGROUP); }
DI unsigned lds_or(LAS3 unsigned* p, unsigned v) { return __hip_atomic_fetch_or(p, v, __ATOMIC_RELAXED, __HIP_MEMORY_SCOPE_WORKGROUP); }
DI void st_bf16x4(bf16_t* p, f32x4 v) { u32x2 w; w.x = cvtpk(v[0], v[1]); w.y = cvtpk(v[2], v[3]); *(u32x2*)p = w; }
DI const float* vaddr(const float* q) { asm volatile("" : "+v"(q)); return q; }
constexpr float LOG2E = 1.4426950408889634f;
#define NEG_INF (-__builtin_inff())

DI int rope_perm(int vc) { return 64 * (vc >> 6) + 16 * ((vc >> 5) & 1) + (vc & 15) + 32 * ((vc >> 4) & 1); }
DI int rope_map(int vc) { return 64 * ((vc >> 5) & 3) + 32 * ((vc >> 4) & 1) + 8 * ((vc >> 2) & 3) + 4 * (vc >> 7) + (vc & 3); }
DI int plain_map(int vc) { return (vc & ~31) + 8 * ((vc >> 2) & 3) + 4 * ((vc >> 4) & 1) + (vc & 3); }
DI int in_src(int np) {
    const int pn = np >> 8, vc = np & 255;
    switch (pn) {
        case 0: return plain_map(vc);
        case 1: return 256 + plain_map(vc);
        case 2: case 3: return 512 + 256 * (pn - 2) + plain_map(vc);
        case 4: case 5: return 1040 + 256 * (pn - 4) + plain_map(vc);
        case 6: return 1552 + rope_map(vc);
        case 7: return 1808 + rope_map(vc);
        case 8: return 2064 + plain_map(vc);
        case 9: return 2320 + rope_map(vc);
        case 10: return 2644 + plain_map(vc);
        case 11: return 2900 + plain_map(vc);
        case 12: return 3156 + plain_map(vc);
        default: break;
    }
    if (vc < 64) return 2576 + rope_perm(vc);
    if (vc < 68) return 2640 + (vc - 64);
    if (vc < 84) return 1024 + (vc - 68);
    return -1;
}

struct EpiIn {
    static constexpr bool PERM = false, AFTER_DRAIN = false;
    unsigned char* ws; float* out;
    DI void operator()(const f32x4 (&acc)[2][2][4][2], const pg8::Unit& u, int wr, int wc, int fr, int fq) const {
        const int pn = u.pn, rbase = u.pm * 256 + wr * 64 + fr;
        if (pn <= 5 || (pn >= 10 && pn <= 12)) {
            bf16_t* dst; int ldc = 256, coff = 0; float sc = 1.f; bool silu = false;
            switch (pn) {
                case 0: dst = (bf16_t*)(ws + W_GQ); sc = 0.125f; break;
                case 1: dst = (bf16_t*)(ws + W_GK); break;
                case 2: dst = (bf16_t*)(ws + W_GV); ldc = 512; break;
                case 3: dst = (bf16_t*)(ws + W_GV); ldc = 512; coff = 256; break;
                case 4: dst = (bf16_t*)(ws + W_GG); ldc = 512; silu = true; break;
                case 5: dst = (bf16_t*)(ws + W_GG); ldc = 512; coff = 256; silu = true; break;
                case 10: dst = (bf16_t*)(ws + W_DG); silu = true; break;
                case 11: dst = (bf16_t*)(ws + W_MQ); sc = 0.125f * LOG2E; break;
                default: dst = (bf16_t*)(ws + W_MG); silu = true; break;
            }
#pragma unroll
            for (int ai = 0; ai < 2; ++ai)
#pragma unroll
                for (int m = 0; m < 4; ++m) {
                    const int row = rbase + ai * 128 + m * 16;
                    bf16_t* rp = dst + (size_t)row * ldc + coff + wc * 32 + 8 * fq;
#pragma unroll
                    for (int bj = 0; bj < 2; ++bj) {
                        f32x4 v0 = acc[ai][bj][m][0], v1 = acc[ai][bj][m][1];
                        if (silu) { v0[0] = siluf(v0[0]); v0[1] = siluf(v0[1]); v0[2] = siluf(v0[2]); v0[3] = siluf(v0[3]); v1[0] = siluf(v1[0]); v1[1] = siluf(v1[1]); v1[2] = siluf(v1[2]); v1[3] = siluf(v1[3]); }
                        else { v0 = v0 * sc; v1 = v1 * sc; }
                        u32x4 w; w.x = cvtpk(v0[0], v0[1]); w.y = cvtpk(v0[2], v0[3]); w.z = cvtpk(v1[0], v1[1]); w.w = cvtpk(v1[2], v1[3]);
                        *(u32x4*)(rp + bj * 128) = w;
                    }
                }
        } else if (pn == 6 || pn == 7 || pn == 9) {
            bf16_t* dst = (bf16_t*)(ws + (pn == 6 ? W_DQ : (pn == 7 ? W_DK : W_IQ)));
            const float sc = (pn == 6) ? 0.125f * LOG2E : 1.f;
            const float* rope = (const float*)(ws + W_ROPE);
#pragma unroll
            for (int ai = 0; ai < 2; ++ai)
#pragma unroll
                for (int m = 0; m < 4; ++m) {
                    const int row = rbase + ai * 128 + m * 16;
                    const int pi = row < MP ? (row & 2047) : 2048;
                    const float* rp = rope + ((size_t)pi * 32 + 8 * fq) * 2;
                    f32x4 o1[2], o2[2];
#pragma unroll
                    for (int bj = 0; bj < 2; ++bj) {
                        const f32x4 cs0 = *(const f32x4*)(rp + 8 * bj), cs1 = *(const f32x4*)(rp + 8 * bj + 4);
                        const f32x4 c = {cs0[0], cs0[2], cs1[0], cs1[2]}, s = {cs0[1], cs0[3], cs1[1], cs1[3]};
                        const f32x4 v0 = acc[ai][bj][m][0], v1 = acc[ai][bj][m][1];
                        o1[bj] = (v0 * c - v1 * s) * sc; o2[bj] = (v1 * c + v0 * s) * sc;
                    }
                    const int col1 = 64 * wc + 8 * fq, col2 = col1 + 32;
                    u32x4 w1, w2; w1.x = cvtpk(o1[0][0], o1[0][1]); w1.y = cvtpk(o1[0][2], o1[0][3]); w1.z = cvtpk(o1[1][0], o1[1][1]); w1.w = cvtpk(o1[1][2], o1[1][3]);
                    w2.x = cvtpk(o2[0][0], o2[0][1]); w2.y = cvtpk(o2[0][2], o2[0][3]); w2.z = cvtpk(o2[1][0], o2[1][1]); w2.w = cvtpk(o2[1][2], o2[1][3]);
                    *(u32x4*)(dst + (size_t)row * 256 + col1) = w1; *(u32x4*)(dst + (size_t)row * 256 + col2) = w2;
                    if (pn == 7) {
                        float* op = nullptr;
                        if (row < MP) op = out + O_KP + (size_t)row * 256; else if (row < MP + NDB) op = out + O_KS + (size_t)(row - MP) * 256;
                        if (op) { *(f32x4*)(op + col1) = o1[0]; *(f32x4*)(op + col1 + 4) = o1[1]; *(f32x4*)(op + col2) = o2[0]; *(f32x4*)(op + col2 + 4) = o2[1]; }
                    }
                }
        } else if (pn == 8) {
            bf16_t* dvt = (bf16_t*)(ws + W_DVT);
#pragma unroll
            for (int ai = 0; ai < 2; ++ai)
#pragma unroll
                for (int m = 0; m < 4; ++m) {
                    const int row = rbase + ai * 128 + m * 16;
                    float* op = nullptr;
                    if (row < MP) op = out + O_VP + (size_t)row * 256; else if (row < MP + NDB) op = out + O_VS + (size_t)(row - MP) * 256;
#pragma unroll
                    for (int bj = 0; bj < 2; ++bj)
#pragma unroll
                        for (int n = 0; n < 2; ++n) {
                            const f32x4 v = acc[ai][bj][m][n];
                            const int col = 128 * bj + 32 * wc + 8 * fq + 4 * n;
                            if (op) *(f32x4*)(op + col) = v;
                            if (row < MP) {
                                const int t_ = row & 2047, kk_ = t_ & 31;
                                bf16_t* tp = dvt + ((((size_t)(row >> 11) * 64 + (t_ >> 5)) * 4 + (col >> 6)) * 64 + (col & 63)) * 32 + 8 * ((kk_ >> 2) & 3) + 4 * (kk_ >> 4) + (kk_ & 3);
                                tp[0] = f2bf(v[0]); tp[32] = f2bf(v[1]); tp[64] = f2bf(v[2]); tp[96] = f2bf(v[3]);
                            }
                        }
                }
        } else {
            bf16_t* ikb = (bf16_t*)(ws + W_IK); float* iw = (float*)(ws + W_IW); float* glr = (float*)(ws + W_GLR);
            const float* rope = (const float*)(ws + W_ROPE);
#pragma unroll
            for (int ai = 0; ai < 2; ++ai)
#pragma unroll
                for (int m = 0; m < 4; ++m) {
                    const int row = rbase + ai * 128 + m * 16;
                    const f32x4 v0 = acc[ai][0][m][0], v1 = acc[ai][0][m][1];
                    if (wc < 2) {
                        const int pi = row < MP ? (row & 2047) : 2048;
                        const int f0 = 16 * wc + 4 * fq;
                        const f32x4 cs0 = *(const f32x4*)(rope + ((size_t)pi * 32 + f0) * 2), cs1 = *(const f32x4*)(rope + ((size_t)pi * 32 + f0) * 2 + 4);
                        const f32x4 c = {cs0[0], cs0[2], cs1[0], cs1[2]}, s = {cs0[1], cs0[3], cs1[1], cs1[3]};
                        const f32x4 o1 = v0 * c - v1 * s, o2 = v1 * c + v0 * s;
                        st_bf16x4(ikb + (size_t)row * 64 + f0, o1); st_bf16x4(ikb + (size_t)row * 64 + f0 + 32, o2);
                        float* op = nullptr;
                        if (row < MP) op = out + O_IKP + (size_t)row * 64; else if (row < MP + NDB) op = out + O_IKS + (size_t)(row - MP) * 64;
                        if (op) { *(f32x4*)(op + f0) = o1; *(f32x4*)(op + f0 + 32) = o2; }
                    } else if (wc == 2) {
                        if (fq == 0) { *(f32x4*)(iw + (size_t)row * 4) = v0 * 0.5f; *(f32x4*)(glr + (size_t)row * 16 + 12) = v1; }
                        else *(f32x4*)(glr + (size_t)row * 16 + 4 * (fq - 1)) = v0;
                    }
                }
        }
    }
};
struct EpiMem {
    static constexpr bool PERM = false, AFTER_DRAIN = false;
    unsigned char* ws; float* out;
    DI void operator()(const f32x4 (&acc)[2][2][4][2], const pg8::Unit& u, int wr, int wc, int fr, int fq) const {
        const int pn = u.pn, rbase = u.pm * 256 + wr * 64 + fr;
        bf16_t* mk = (bf16_t*)(ws + W_MK); bf16_t* mvt = (bf16_t*)(ws + W_MVT);
        float* op0 = out + (pn == 0 ? O_MKP : O_MVP);
#pragma unroll
        for (int ai = 0; ai < 2; ++ai)
#pragma unroll
            for (int m = 0; m < 4; ++m) {
                const int row = rbase + ai * 128 + m * 16;
#pragma unroll
                for (int bj = 0; bj < 2; ++bj)
#pragma unroll
                    for (int n = 0; n < 2; ++n) {
                        const f32x4 v = acc[ai][bj][m][n];
                        const int col = 128 * bj + 32 * wc + 16 * n + 4 * fq;
                        *(f32x4*)(op0 + (size_t)row * 256 + col) = v;
                        if (pn == 0) st_bf16x4(mk + (size_t)row * 256 + col, v);
                        else { const int m_ = row & 255, kk_ = m_ & 31;
                               bf16_t* tp = mvt + ((((size_t)(row >> 8) * 8 + (m_ >> 5)) * 4 + (col >> 6)) * 64 + (col & 63)) * 32 + 8 * ((kk_ >> 2) & 3) + 4 * (kk_ >> 4) + (kk_ & 3);
                               tp[0] = f2bf(v[0]); tp[32] = f2bf(v[1]); tp[64] = f2bf(v[2]); tp[96] = f2bf(v[3]); }
                    }
            }
    }
};
struct EpiOut {
    static constexpr bool PERM = false, AFTER_DRAIN = false;
    const float* xp; const float* xs; float* out;
    DI void operator()(const f32x4 (&acc)[2][2][4][2], const pg8::Unit& u, int wr, int wc, int fr, int fq) const {
        const int rbase = u.pm * 256 + wr * 64 + fr, cbase = u.pn * 256 + wc * 32 + 4 * fq;
#pragma unroll
        for (int ai = 0; ai < 2; ++ai)
#pragma unroll
            for (int m = 0; m < 4; ++m) {
                const int row = rbase + ai * 128 + m * 16;
                const float* xr; float* orow;
                if (row < MP) { xr = xp + (size_t)row * DM; orow = out + O_YP + (size_t)row * DM; }
                else if (row < MP + NDB) { xr = xs + (size_t)(row - MP) * DM; orow = out + O_YS + (size_t)(row - MP) * DM; }
                else continue;
#pragma unroll
                for (int bj = 0; bj < 2; ++bj)
#pragma unroll
                    for (int n = 0; n < 2; ++n) { const int col = cbase + bj * 128 + n * 16; *(f32x4*)(orow + col) = acc[ai][bj][m][n] + *(const f32x4*)(xr + col); }
            }
    }
};
DI void p0_prologue(const Params& p, LAS3 unsigned char* lds) {
    const int tid = threadIdx.x, lane = tid & 63, wv = tid >> 6;
    unsigned char* ws = p.ws;
    for (int r0 = (blockIdx.x * 8 + wv) * 2; r0 < MROWS + MMEM; r0 += gridDim.x * 16) {
        const float* src[2]; const float* g[2]; bf16_t* dst[2];
#pragma unroll
        for (int e = 0; e < 2; ++e) {
            const int r = r0 + e; src[e] = nullptr; g[e] = p.norm_in;
            if (r < MP) { src[e] = p.x_prompt + (size_t)r * DM; dst[e] = (bf16_t*)(ws + W_XN) + (size_t)r * DM; }
            else if (r < MP + NDB) { src[e] = p.x_sample + (size_t)(r - MP) * DM; dst[e] = (bf16_t*)(ws + W_XN) + (size_t)r * DM; }
            else if (r < MROWS) { dst[e] = (bf16_t*)(ws + W_XN) + (size_t)r * DM; }
            else { src[e] = p.mem_prompt + (size_t)(r - MROWS) * DM; g[e] = p.mem_norm; dst[e] = (bf16_t*)(ws + W_MEMN) + (size_t)(r - MROWS) * DM; }
        }
        f32x4 v[2][4];
#pragma unroll
        for (int e = 0; e < 2; ++e)
#pragma unroll
            for (int i = 0; i < 4; ++i) v[e][i] = src[e] ? *(const f32x4*)(src[e] + i * 256 + lane * 4) : (f32x4){0.f, 0.f, 0.f, 0.f};
#pragma unroll
        for (int e = 0; e < 2; ++e) {
            float ss = 0.f;
#pragma unroll
            for (int i = 0; i < 4; ++i) ss += v[e][i][0] * v[e][i][0] + v[e][i][1] * v[e][i][1] + v[e][i][2] * v[e][i][2] + v[e][i][3] * v[e][i][3];
            ss = wsum64(ss);
            const float rstd = rsqrtf(ss * (1.f / DM) + 1e-6f);
#pragma unroll
            for (int i = 0; i < 4; ++i) { const f32x4 gv = *(const f32x4*)(g[e] + i * 256 + lane * 4); st_bf16x4(dst[e] + i * 256 + lane * 4, v[e][i] * rstd * gv); }
        }
    }
    for (int e = blockIdx.x * NTHREADS + tid; e < 2049 * 32; e += gridDim.x * NTHREADS) {
        const int pi = e >> 5, f = e & 31;
        const float inv = powf(10000.0f, -(float)(2 * f) / 64.0f);
        const float ang = (float)(pi == 2048 ? 16384 : pi) * inv;
        float sn, cs; sincosf(ang, &sn, &cs);
        ((f32x2*)(ws + W_ROPE))[e] = (f32x2){cs, sn};
    }
    LAS3 float* tl = (LAS3 float*)lds;
    for (int tile = blockIdx.x; tile < 1280; tile += gridDim.x) {
        int which, t2, ld; const float* W; bf16_t* dst;
        if (tile < 896) { which = 0; t2 = tile; W = p.w_in; ld = DIN; dst = (bf16_t*)(ws + W_WTIN); }
        else if (tile < 1024) { which = 1; t2 = tile - 896; W = p.w_mem_kv; ld = 512; dst = (bf16_t*)(ws + W_WTMEM); }
        else { which = 2; t2 = tile - 1024; W = p.w_out; ld = 1024; dst = (bf16_t*)(ws + W_WTOUT); }
        const int nt = t2 >> 4, kt = t2 & 15;
        { const int nn = tid & 63, kk0 = tid >> 6; const int np = nt * 64 + nn; const int sc = which == 0 ? in_src(np) : np;
#pragma unroll
          for (int i = 0; i < 8; ++i) { const int k = kk0 + 8 * i; tl[k * 65 + nn] = sc >= 0 ? W[(size_t)(kt * 64 + k) * ld + sc] : 0.f; } }
        __syncthreads();
        { const int kk = tid & 63, nn0 = tid >> 6;
#pragma unroll
          for (int i = 0; i < 8; ++i) { const int n = nn0 + 8 * i; dst[(size_t)(nt * 64 + n) * 1024 + kt * 64 + kk] = f2bf(tl[kk * 65 + n]); } }
        __syncthreads();
    }
}

DI void cnt_ge(unsigned& c, unsigned key, unsigned cand) { asm volatile("v_cmp_ge_u32 vcc, %1, %2\n\tv_addc_co_u32 %0, vcc, 0, %0, vcc" : "+v"(c) : "v"(key), "v"(cand) : "vcc"); }
DI void cnt_gt(unsigned& c, unsigned key, unsigned cand) { asm volatile("v_cmp_gt_u32 vcc, %1, %2\n\tv_addc_co_u32 %0, vcc, 0, %0, vcc" : "+v"(c) : "v"(key), "v"(cand) : "vcc"); }
DI void cnt_eq_lt(unsigned& c, unsigned key, unsigned T, unsigned idx, unsigned cand) {
    unsigned tmp;
    asm volatile("v_cmp_eq_u32 vcc, %2, %3\n\tv_cndmask_b32 %1, -1, %4, vcc\n\tv_cmp_lt_u32 vcc, %1, %5\n\tv_addc_co_u32 %0, vcc, 0, %0, vcc" : "+v"(c), "=&v"(tmp) : "v"(key), "v"(T), "v"(idx), "v"(cand) : "vcc"); }
DI unsigned grp_count16(unsigned c, LAS3 unsigned* CNT, int& it, int fr, int lane) {
    c += __shfl_xor(c, 16); c += __shfl_xor(c, 32);
    LAS3 unsigned* cur = CNT + (it % 3) * 16;
    if (lane < 16) lds_add(cur + fr, c);
    __syncthreads();
    const unsigned tot = cur[fr];
    if (threadIdx.x < 16) CNT[((it + 2) % 3) * 16 + threadIdx.x] = 0u;
    ++it; return tot;
}
DI unsigned blk_count(unsigned c, LAS3 unsigned* CNT, int& it, int lane) {
    c += __shfl_xor(c, 1); c += __shfl_xor(c, 2); c += __shfl_xor(c, 4); c += __shfl_xor(c, 8); c += __shfl_xor(c, 16); c += __shfl_xor(c, 32);
    LAS3 unsigned* cur = CNT + (it % 3) * 16;
    if (lane == 0) lds_add(cur, c);
    __syncthreads();
    const unsigned tot = cur[0];
    if (threadIdx.x == 0) CNT[((it + 2) % 3) * 16] = 0u;
    ++it; return tot;
}

template <bool MASKED>
DI void attn32(const bf16_t* Q, int ldq, const bf16_t* K, int ldk, const bf16_t* Vt, int ldv, int nkb, const LAS3 unsigned* mask, int fr, int fq,
               f32x4 (&o)[4][2], float (&linv)[2]) {
    bf16x8 qf[2][2];
#pragma unroll
    for (int qt = 0; qt < 2; ++qt)
#pragma unroll
        for (int ks = 0; ks < 2; ++ks) qf[qt][ks] = *(const bf16x8*)(Q + (size_t)(16 * qt + fr) * ldq + ks * 32 + fq * 8);
    float m[2] = {NEG_INF, NEG_INF}, l[2] = {0.f, 0.f};
    const f32x4 zero = {0.f, 0.f, 0.f, 0.f};
#pragma unroll
    for (int dt = 0; dt < 4; ++dt) { o[dt][0] = zero; o[dt][1] = zero; }
    const bf16_t* kl = K + (size_t)fr * ldk + fq * 8;
#ifdef BROKEN_VT
    const bf16_t* vl = Vt + fr * 32 + 8 * ((fq + 1) & 3);
#else
    const bf16_t* vl = Vt + fr * 32 + 8 * fq;
#endif
    bf16x8 kfA[2][2], kfB[2][2], vA[4], vB[4];
#define ATT_LOAD(KF, VF, kb_) do { \
        _Pragma("unroll") for (int i2 = 0; i2 < 2; ++i2) _Pragma("unroll") for (int ks = 0; ks < 2; ++ks) KF[i2][ks] = *(const bf16x8*)(kl + (size_t)(32 * (kb_) + 16 * i2) * ldk + ks * 32); \
        _Pragma("unroll") for (int dt = 0; dt < 4; ++dt) VF[dt] = *(const bf16x8*)(vl + (size_t)(kb_) * ldv + 512 * dt); } while (0)
#define ATT_COMPUTE(KF, VF, kb_) do { \
        _Pragma("unroll") for (int qt = 0; qt < 2; ++qt) { \
            f32x4 s0 = mfma16(KF[0][0], qf[qt][0], zero); s0 = mfma16(KF[0][1], qf[qt][1], s0); \
            f32x4 s1 = mfma16(KF[1][0], qf[qt][0], zero); s1 = mfma16(KF[1][1], qf[qt][1], s1); \
            if (MASKED) { const unsigned mw = mask[(16 * qt + fr) * 65 + (kb_)]; const unsigned b0 = mw >> (2 * fq), b1 = mw >> (8 + 2 * fq); \
                _Pragma("unroll") for (int r = 0; r < 4; ++r) { const int sh_ = (r >> 1) + 16 * (r & 1); s0[r] = ((b0 >> sh_) & 1u) ? s0[r] : NEG_INF; s1[r] = ((b1 >> sh_) & 1u) ? s1[r] : NEG_INF; } } \
            float mx = fmaxf(fmaxf(fmaxf(s0[0], s0[1]), fmaxf(s0[2], s0[3])), fmaxf(fmaxf(s1[0], s1[1]), fmaxf(s1[2], s1[3]))); \
            mx = fmaxf(mx, __shfl_xor(mx, 16)); mx = fmaxf(mx, __shfl_xor(mx, 32)); \
            const float mn = fmaxf(m[qt], mx), ms = (mn == NEG_INF) ? 0.f : mn; \
            const float alpha = __builtin_amdgcn_exp2f(m[qt] - ms); \
            f32x4 p0, p1; \
            _Pragma("unroll") for (int r = 0; r < 4; ++r) { p0[r] = __builtin_amdgcn_exp2f(s0[r] - ms); p1[r] = __builtin_amdgcn_exp2f(s1[r] - ms); } \
            l[qt] = l[qt] * alpha + ((p0[0] + p0[1]) + (p0[2] + p0[3])) + ((p1[0] + p1[1]) + (p1[2] + p1[3])); \
            m[qt] = mn; \
            u32x4 pw; pw.x = cvtpk(p0[0], p0[1]); pw.y = cvtpk(p0[2], p0[3]); pw.z = cvtpk(p1[0], p1[1]); pw.w = cvtpk(p1[2], p1[3]); \
            const bf16x8 pf = __builtin_bit_cast(bf16x8, pw); \
            if (!__all(alpha == 1.f)) { _Pragma("unroll") for (int dt = 0; dt < 4; ++dt) o[dt][qt] = o[dt][qt] * alpha; }     \
            _Pragma("unroll") for (int dt = 0; dt < 4; ++dt) o[dt][qt] = mfma16(VF[dt], pf, o[dt][qt]); } } while (0)
    ATT_LOAD(kfA, vA, 0);
    const int last = nkb - 1;
    for (int kb = 0; kb < nkb; kb += 2) {
        ATT_LOAD(kfB, vB, kb + 1);
        ATT_COMPUTE(kfA, vA, kb);
        { const int k2 = kb + 2 < last ? kb + 2 : last; ATT_LOAD(kfA, vA, k2); }
        ATT_COMPUTE(kfB, vB, kb + 1);
    }
#undef ATT_LOAD
#undef ATT_COMPUTE
#pragma unroll
    for (int qt = 0; qt < 2; ++qt) { float lt = l[qt]; lt += __shfl_xor(lt, 16); lt += __shfl_xor(lt, 32); linv[qt] = 1.f / lt; }
}
DI void attn_store(const f32x4 (&o)[4][2], const float (&linv)[2], const bf16_t* gate  , bf16_t* mix  , int fr, int fq) {
#pragma unroll
    for (int qt = 0; qt < 2; ++qt)
#pragma unroll
        for (int dt = 0; dt < 4; ++dt) {
            const size_t row = 16 * qt + fr; const int col = 16 * dt + 4 * fq;
            const u32x2 gw = *(const u32x2*)(gate + row * 256 + col);
            f32x4 v = o[dt][qt] * linv[qt];
            v[0] *= __uint_as_float(gw.x << 16); v[1] *= __uint_as_float(gw.x & 0xffff0000u); v[2] *= __uint_as_float(gw.y << 16); v[3] *= __uint_as_float(gw.y & 0xffff0000u);
            st_bf16x4(mix + row * 1024 + col, v);
        }
}

constexpr int DS_MASK = 0, DS_PKT = 16640, PKT_LD = 2052, DS_CNT = 147968;
typedef unsigned short u16x2 __attribute__((ext_vector_type(2)));
DI unsigned pk_cnt_ge(unsigned acc, unsigned kpair, unsigned cm1, unsigned ones) {
    unsigned t;
    asm("v_pk_sub_u16 %1, %2, %3 clamp\n\tv_pk_min_u16 %1, %1, %4\n\tv_pk_add_u16 %0, %0, %1" : "+v"(acc), "=&v"(t) : "v"(kpair), "v"(cm1), "v"(ones));
    return acc;
}
DI void select_bitwise(const unsigned (&key)[16][4], int lbase, LAS3 unsigned* CNT, int& it, int fr, int lane, unsigned& T, int& Xrel) {
    bool fin = false;
    T = 0u; Xrel = 0x7fffffff;
    for (int bit = 31; bit >= 0; --bit) {
        const unsigned cand = T | (1u << bit);
        unsigned c = 0;
#pragma unroll
        for (int n = 0; n < 16; ++n)
#pragma unroll
            for (int r = 0; r < 4; ++r) cnt_ge(c, key[n][r], cand);
        const unsigned tot = grp_count16(c, CNT, it, fr, lane);
        if (!fin && tot >= 256u) { T = cand; fin = (tot == 256u); }
        if (__all(fin)) break;
    }
    if (!__all(fin)) {
        unsigned c = 0;
#pragma unroll
        for (int n = 0; n < 16; ++n)
#pragma unroll
            for (int r = 0; r < 4; ++r) cnt_gt(c, key[n][r], T);
        const unsigned cgt = grp_count16(c, CNT, it, fr, lane);
        const unsigned need = 256u - cgt;
        unsigned Xl = 0u;
        for (int bit = 10; bit >= 0; --bit) {
            const unsigned cand = Xl | (1u << bit);
            const int crel = (int)cand - lbase;
            c = 0;
#pragma unroll
            for (int n = 0; n < 16; ++n) { const int crn = crel - 128 * n;
#pragma unroll
                for (int r = 0; r < 4; ++r) c += (key[n][r] == T && r < crn) ? 1u : 0u; }
            const unsigned tot = grp_count16(c, CNT, it, fr, lane);
            if (tot < need) Xl = cand;
        }
        if (!fin) Xrel = (int)Xl - lbase;
    }
}
DI unsigned pk_flag_ge(unsigned kpair, unsigned cm1, unsigned ones) {
    unsigned t;
    asm("v_pk_sub_u16 %0, %1, %2 clamp\n\tv_pk_min_u16 %0, %0, %3" : "=&v"(t) : "v"(kpair), "v"(cm1), "v"(ones));
    return t;
}
DI unsigned pk_max(unsigned a, unsigned b2) { unsigned t; asm("v_pk_max_u16 %0, %1, %2" : "=v"(t) : "v"(a), "v"(b2)); return t; }
DI unsigned hsum32(unsigned x) {
    x += __builtin_amdgcn_update_dpp(0u, x, 0xB1, 0xF, 0xF, false); x += __builtin_amdgcn_update_dpp(0u, x, 0x4E, 0xF, 0xF, false);
    x += __builtin_amdgcn_update_dpp(0u, x, 0x141, 0xF, 0xF, false); x += __builtin_amdgcn_update_dpp(0u, x, 0x140, 0xF, 0xF, false);
    const auto r = __builtin_amdgcn_permlane16_swap(x, x, false, false); return r[0] + r[1];
}
DI unsigned hmax32(unsigned x) {
    x = max(x, (unsigned)__builtin_amdgcn_update_dpp(0u, x, 0xB1, 0xF, 0xF, false)); x = max(x, (unsigned)__builtin_amdgcn_update_dpp(0u, x, 0x4E, 0xF, 0xF, false));
    x = max(x, (unsigned)__builtin_amdgcn_update_dpp(0u, x, 0x141, 0xF, 0xF, false)); x = max(x, (unsigned)__builtin_amdgcn_update_dpp(0u, x, 0x140, 0xF, 0xF, false));
    const auto r = __builtin_amdgcn_permlane16_swap(x, x, false, false); return max(r[0], r[1]);
}
DI unsigned pk_count32(const unsigned (&rk)[32], unsigned cm1, unsigned ones, bool half) {
    unsigned a0 = 0u, a1 = 0u;
#pragma unroll
    for (int k = 0; k < 16; k += 2) { a0 = pk_cnt_ge(a0, rk[k], cm1, ones); a1 = pk_cnt_ge(a1, rk[k + 1], cm1, ones); }
    if (!half) {
#pragma unroll
        for (int k = 16; k < 32; k += 2) { a0 = pk_cnt_ge(a0, rk[k], cm1, ones); a1 = pk_cnt_ge(a1, rk[k + 1], cm1, ones); }
    }
    return (a0 & 0xffffu) + (a0 >> 16) + (a1 & 0xffffu) + (a1 >> 16);
}
DI void dsa_unit(const Params& p, LAS3 unsigned char* lds, int b, int j TARGS) {
    int tid = threadIdx.x; asm volatile("" : "+v"(tid));
    const int lane0 = tid & 63, w = __builtin_amdgcn_readfirstlane(tid >> 6);
    unsigned char* ws = p.ws;
    LAS3 unsigned* MASK = (LAS3 unsigned*)(lds + DS_MASK);
    LAS3 unsigned* PKT = (LAS3 unsigned*)(lds + DS_PKT);
    const bf16_t* IQ = (const bf16_t*)(ws + W_IQ); const bf16_t* IK = (const bf16_t*)(ws + W_IK); const float* IW = (const float*)(ws + W_IW);
    const int q0 = 64 * j;
    const f32x4 zero = {0.f, 0.f, 0.f, 0.f};
#ifdef CHECK_SEL
    LAS3 unsigned* CNT = (LAS3 unsigned*)(lds + DS_CNT); int it = 0;
    if (tid < 48) CNT[tid] = 0u;
    __syncthreads();
#endif
    TBEG(30);
    bf16x8 bqn[4][2]; f32x4 wqn;
    { const size_t qr0 = (size_t)b * SEQ + q0 + (lane0 & 15);
#pragma unroll
      for (int h = 0; h < 4; ++h)
#pragma unroll
          for (int ks = 0; ks < 2; ++ks) bqn[h][ks] = *(const bf16x8*)(IQ + qr0 * 256 + h * 64 + ks * 32 + (lane0 >> 4) * 8);
      wqn = *(const f32x4*)(IW + qr0 * 4); }
#pragma unroll 1
    for (int qg = 0; qg < 4; ++qg) {
        TBEG(32);
        int lane = lane0; asm volatile("" : "+v"(lane));
        const int fr = lane & 15, fq = lane >> 4;
        const int tq = q0 + 16 * qg + fr; const size_t qrow = (size_t)b * SEQ + tq;
        const int ntile = 4 * j + qg + 1;
        const int nloc = ntile > w ? (ntile - w + 7) >> 3 : 0;
        const bool selecting = q0 + 16 * qg >= 256;
        {
            bf16x8 bq[4][2];
#pragma unroll
            for (int h = 0; h < 4; ++h)
#pragma unroll
                for (int ks = 0; ks < 2; ++ks) bq[h][ks] = bqn[h][ks];
            const f32x4 wq = wqn;
            float Lh[4];
#pragma unroll
            for (int h = 0; h < 4; ++h) Lh[h] = wq[h] < 0.f ? NEG_INF : -NEG_INF;
            const char* tb = (const char*)IK + ((size_t)b * SEQ + 16 * w) * 128 + (unsigned)(fr * 128 + fq * 16);
            LAS3 unsigned* krow = PKT + fr * PKT_LD + 16 * w + 4 * fq;
            const int lim0 = tq - (16 * w + 4 * fq);
#define DSA_TILE(A0, A1, nn) do { \
                f32x4 sc = zero; \
                _Pragma("unroll") for (int h = 0; h < 4; ++h) { f32x4 d = mfma16(A0, bq[h][0], zero); d = mfma16(A1, bq[h][1], d); d = d * wq[h]; \
                    _Pragma("unroll") for (int r = 0; r < 4; ++r) sc[r] += __builtin_amdgcn_fmed3f(d[r], 0.f, Lh[h]); } \
                { const char* t2_ = tb + (size_t)((nn) + 2 < nloc ? (nn) + 2 : nloc - 1) * 16384; A0 = *(const bf16x8*)t2_; A1 = *(const bf16x8*)(t2_ + 64); } \
                const int limn = lim0 - 128 * (nn);                   \
                u32x4 kv; \
                _Pragma("unroll") for (int r = 0; r < 4; ++r) { const unsigned u = __float_as_uint(sc[r] + 0.f); const unsigned k = u ^ ((unsigned)((int)u >> 31) | 0x80000000u);   \
                    kv[r] = (r <= limn) ? k : 0u; } \
                *(LAS3 u32x4*)(krow + 128 * (nn)) = kv; } while (0)
            if (nloc > 0) {
                bf16x8 a0 = *(const bf16x8*)tb, a1 = *(const bf16x8*)(tb + 64);
                const char* t1 = tb + (size_t)(1 < nloc ? 1 : 0) * 16384;
                bf16x8 b0 = *(const bf16x8*)t1, b1 = *(const bf16x8*)(t1 + 64);
#pragma unroll 1
                for (int n = 0; n < nloc; n += 2) {
                    DSA_TILE(a0, a1, n);
                    if (n + 1 < nloc) DSA_TILE(b0, b1, n + 1);
                }
            }
#undef DSA_TILE
        }
        TEND(32); TBEG(33);
        __syncthreads();
        { const size_t qrn = qrow + (qg < 3 ? 16 : 0);
#pragma unroll
          for (int h = 0; h < 4; ++h)
#pragma unroll
              for (int ks = 0; ks < 2; ++ks) bqn[h][ks] = *(const bf16x8*)(IQ + qrn * 256 + h * 64 + ks * 32 + fq * 8);
          wqn = *(const f32x4*)(IW + qrn * 4); }
        {
            const int hh = lane >> 5, pos = lane & 31, oq = 2 * w + hh;
            const unsigned nkeys = 16u * (unsigned)ntile;
            const bool half = nkeys <= 1024u;
            const LAS3 unsigned* orow = PKT + oq * PKT_LD + 2 * pos;
            unsigned ones = 0x00010001u; asm volatile("" : "+v"(ones));
            unsigned Tfull = 1u, X = 0xffffffffu;
            if (selecting) {
                unsigned rk[32];
#pragma unroll
                for (int k = 0; k < 32; ++k) { const u32x2 kk = *(const LAS3 u32x2*)(orow + 64 * k); rk[k] = (2u * (unsigned)(pos + 32 * k) < nkeys) ? __builtin_amdgcn_perm(kk.y, kk.x, 0x07060302u) : 0u; }
                unsigned mx = 0u;
#pragma unroll
                for (int k = 0; k < 32; ++k) mx = pk_max(mx, rk[k]);
                const unsigned kmax = hmax32(max(mx & 0xffffu, mx >> 16));
                unsigned T16 = 0u, cabove = 0u; bool exact = false;
                {
                    unsigned ub = 0x10000u;
#pragma unroll 1
                    for (int bit = 15; bit >= 0; --bit) {
                        const unsigned cand = T16 | (1u << bit);
                        if (__all(cand > kmax)) { ub = cand; continue; }
                        const unsigned tot = hsum32(pk_count32(rk, (cand - 1u) * 0x00010001u, ones, half));
                        if (tot >= 256u) T16 = cand; else { ub = cand; cabove = tot; }
                    }
                    (void)ub;
                }
                const unsigned need = 256u - cabove;
#pragma unroll
                for (int k = 0; k < 32; ++k) { const u32x2 kk = *(const LAS3 u32x2*)(orow + 64 * k); const bool in = 2u * (unsigned)(pos + 32 * k) < nkeys;
                    const unsigned lo0 = (in && (kk.x >> 16) == T16) ? (kk.x & 0xffffu) : 0u, lo1 = (in && (kk.y >> 16) == T16) ? (kk.y & 0xffffu) : 0u; rk[k] = lo0 | (lo1 << 16); }
                unsigned Tlo = 0u;
#pragma unroll 1
                for (int bit = 15; bit >= 0; --bit) {
                    const unsigned cand = Tlo | (1u << bit);
                    const unsigned tot = hsum32(pk_count32(rk, (cand - 1u) * 0x00010001u, ones, half));
                    if (!exact && tot >= need) { Tlo = cand; exact = (tot == need); }
                    if (__all(exact)) break;
                }
                Tfull = (T16 << 16) | Tlo;
                if (!__all(exact)) {
                    unsigned cgt = 0u, ceq = 0u;
#pragma unroll 1
                    for (int k = 0; k < 32; ++k) { const u32x2 kk = *(const LAS3 u32x2*)(orow + 64 * k); const bool in = 2u * (unsigned)(pos + 32 * k) < nkeys;
                        cgt += (in && kk.x > Tfull && (kk.x >> 16) == T16 ? 1u : 0u) + (in && kk.y > Tfull && (kk.y >> 16) == T16 ? 1u : 0u); }
                    (void)ceq;
                    const unsigned needt = need - hsum32(cgt);
                    unsigned Xl = 0u;
#pragma unroll 1
                    for (int bit = 10; bit >= 0; --bit) {
                        const unsigned cx = Xl | (1u << bit);
                        unsigned c = 0u;
#pragma unroll 1
                        for (int k = 0; k < 32; ++k) { const u32x2 kk = *(const LAS3 u32x2*)(orow + 64 * k); const unsigned i0 = 2u * (unsigned)(pos + 32 * k);
                            c += (i0 < nkeys && kk.x == Tfull && i0 < cx ? 1u : 0u) + (i0 < nkeys && kk.y == Tfull && i0 + 1u < cx ? 1u : 0u); }
                        if (hsum32(c) < needt) Xl = cx;
                    }
                    if (!exact) X = Xl;
                }
            }
            LAS3 unsigned* mrow = MASK + (16 * qg + oq) * 65 + (pos >> 4);
            const unsigned sh = 32u * hh + (pos & 16);
#pragma unroll 2
            for (int k = 0; k <= j; ++k) {
                const u32x2 kk = *(const LAS3 u32x2*)(orow + 64 * k); const unsigned i0 = 2u * (unsigned)(pos + 32 * k);
                const bool s0 = i0 < nkeys && (kk.x > Tfull || (kk.x == Tfull && i0 <= X)), s1 = i0 < nkeys && (kk.y > Tfull || (kk.y == Tfull && i0 + 1u <= X));
                const unsigned long long blo = __ballot(s0), bhi = __ballot(s1);
                const unsigned wv = ((unsigned)(blo >> sh) & 0xffffu) | ((unsigned)(bhi >> sh) << 16);
                if ((pos & 15) == 0) mrow[2 * k] = wv;
            }
        }
        TEND(33);
        __syncthreads();
#ifdef CHECK_SEL
        if (selecting) {
            const int lbase = 16 * w + 4 * fq;
            unsigned key[16][4];
#pragma unroll
            for (int n = 0; n < 16; ++n)
#pragma unroll
                for (int r = 0; r < 4; ++r) key[n][r] = (n < nloc) ? PKT[fr * PKT_LD + lbase + 128 * n + r] : 0u;
            unsigned T2; int X2; select_bitwise(key, lbase, CNT, it, fr, lane, T2, X2);
            bool bad = false;
#pragma unroll
            for (int n = 0; n < 16; ++n) if (n < nloc) { const int x2 = X2 - 128 * n;
#pragma unroll
                for (int r = 0; r < 4; ++r) { const unsigned idx = (unsigned)(lbase + 128 * n + r); const unsigned mw = MASK[(16 * qg + fr) * 65 + (idx >> 5)];
                    const bool s2 = key[n][r] > T2 || (key[n][r] == T2 && r <= x2); bad |= (s2 != (((mw >> (((idx & 31u) >> 1) + 16u * (idx & 1u))) & 1u) != 0u)); } }
            if (__any(bad) && lane == 0) atomicAdd((unsigned*)(ws + CW_CHK), 1u);
            if (lane == 0 && w == 0) atomicAdd((unsigned*)(ws + CW_CHK + 4), 1u);
            __syncthreads();
        }
#endif
    }
    TEND(30); TBEG(31);
    {
        const int h = w & 3, hf = w >> 2, fr = lane0 & 15, fq = lane0 >> 4;
        const size_t qrow0 = (size_t)b * SEQ + q0 + 32 * hf;
        f32x4 o[4][2]; float linv[2];
        attn32<true>((const bf16_t*)(ws + W_DQ) + qrow0 * 256 + h * 64, 256, (const bf16_t*)(ws + W_DK) + (size_t)b * SEQ * 256 + h * 64, 256,
                     (const bf16_t*)(ws + W_DVT) + ((size_t)b * 64 * 4 + h) * 2048, 4 * 2048, 2 * j + 2  , MASK + 32 * hf * 65, fr, fq, o, linv);
        attn_store(o, linv, (const bf16_t*)(ws + W_DG) + qrow0 * 256 + h * 64, (bf16_t*)(ws + W_MIX) + qrow0 * 1024 + 512 + h * 64, fr, fq);
    }
    __syncthreads();
    TEND(31);
}
DI void mem_unit(const Params& p, int n) {
    const int tid = threadIdx.x, lane = tid & 63, w = __builtin_amdgcn_readfirstlane(tid >> 6), fr = lane & 15, fq = lane >> 4;
    unsigned char* ws = p.ws;
    const int h = w & 3, hf = w >> 2;
    const size_t qrow0 = (size_t)n * 64 + 32 * hf; const int b = n >> 5;
    f32x4 o[4][2]; float linv[2];
    attn32<false>((const bf16_t*)(ws + W_MQ) + qrow0 * 256 + h * 64, 256, (const bf16_t*)(ws + W_MK) + (size_t)b * NMEM * 256 + h * 64, 256,
                  (const bf16_t*)(ws + W_MVT) + ((size_t)b * 8 * 4 + h) * 2048, 4 * 2048, 8, nullptr, fr, fq, o, linv);
    attn_store(o, linv, (const bf16_t*)(ws + W_MG) + qrow0 * 256 + h * 64, (bf16_t*)(ws + W_MIX) + qrow0 * 1024 + 768 + h * 64, fr, fq);
}
constexpr int GL_QT = 0, GL_KT = 9216, GL_KPT = 18432, GL_VT = 27648, GL_SBT = 46080, GL_PM = 64512, GL_OF = 73728, GL_GTOT = 107520, GL_W2 = 109568, GL_BG = 113664, GL_DEC = 113920;
constexpr int LDP = 72;
DI void gla_unit(const Params& p, LAS3 unsigned char* lds, int b, int h) {
    const int tid = threadIdx.x, lane = tid & 63, w = __builtin_amdgcn_readfirstlane(tid >> 6), fr = lane & 15, fq = lane >> 4;
    unsigned char* ws = p.ws;
    LAS3 bf16_t* Qt = (LAS3 bf16_t*)(lds + GL_QT); LAS3 bf16_t* Kt = (LAS3 bf16_t*)(lds + GL_KT); LAS3 bf16_t* KpT = (LAS3 bf16_t*)(lds + GL_KPT);
    LAS3 bf16_t* Vt = (LAS3 bf16_t*)(lds + GL_VT); LAS3 bf16_t* SbT = (LAS3 bf16_t*)(lds + GL_SBT); LAS3 bf16_t* Pm = (LAS3 bf16_t*)(lds + GL_PM);
    LAS3 float* Of = (LAS3 float*)(lds + GL_OF); LAS3 float* gtot = (LAS3 float*)(lds + GL_GTOT); LAS3 float* w2s = (LAS3 float*)(lds + GL_W2);
    LAS3 float* bgs = (LAS3 float*)(lds + GL_BG); LAS3 float* dec = (LAS3 float*)(lds + GL_DEC);
    const bf16_t* GQ = (const bf16_t*)(ws + W_GQ); const bf16_t* GK = (const bf16_t*)(ws + W_GK); const bf16_t* GV = (const bf16_t*)(ws + W_GV);
    const bf16_t* GG = (const bf16_t*)(ws + W_GG); const float* GLR = (const float*)(ws + W_GLR); bf16_t* MIX = (bf16_t*)(ws + W_MIX);
    for (int i = tid; i < 128 * LDP / 2; i += NTHREADS) ((LAS3 unsigned*)SbT)[i] = 0u;
    for (int i = tid; i < 16 * 64; i += NTHREADS) w2s[i] = p.w_g2[(i >> 6) * 256 + h * 64 + (i & 63)];
    if (tid < 64) bgs[tid] = p.b_g[h * 64 + tid];
    __syncthreads();
    const int d = tid & 63, tg = w;
    float wreg[16];
#pragma unroll
    for (int r = 0; r < 16; ++r) wreg[r] = w2s[r * 64 + d];
    const float bgd = bgs[d];
    const f32x4 zero = {0.f, 0.f, 0.f, 0.f};
    f32x4 Sacc[4] = {zero, zero, zero, zero};
    const int tt = w & 3, vh = w >> 2;
    for (int c = 0; c < 32; ++c) {
        const size_t rb = (size_t)b * SEQ + c * 64;
        float g8[8];
#pragma unroll
        for (int i = 0; i < 8; ++i) {
            const float* gl = vaddr(GLR + (rb + tg * 8 + i) * 16);
            float u = bgd;
#pragma unroll
            for (int r = 0; r < 16; ++r) u += gl[r] * wreg[r];
            const float g = logsigf(u) * (1.f / 16.f);
            g8[i] = (i ? g8[i - 1] : 0.f) + g;
        }
        gtot[tg * 64 + d] = g8[7];
        __syncthreads();
        float off = 0.f, blast = 0.f;
#pragma unroll
        for (int g2 = 0; g2 < 8; ++g2) { const float v = gtot[g2 * 64 + d]; off += (g2 < tg) ? v : 0.f; blast += v; }
        float kp[8];
#pragma unroll
        for (int i = 0; i < 8; ++i) {
            const int t = tg * 8 + i; const float bt = off + g8[i];
            const float q = bf2f(GQ[(rb + t) * 256 + h * 64 + d]), k = bf2f(GK[(rb + t) * 256 + h * 64 + d]);
            Qt[t * LDP + d] = f2bf(q * fexp(bt)); Kt[t * LDP + d] = f2bf(k * fexp(-bt)); kp[i] = k * fexp(blast - bt);
        }
        { u32x4 kw; kw.x = cvtpk(kp[0], kp[1]); kw.y = cvtpk(kp[2], kp[3]); kw.z = cvtpk(kp[4], kp[5]); kw.w = cvtpk(kp[6], kp[7]); *(LAS3 u32x4*)(KpT + d * LDP + tg * 8) = kw; }
        if (tg == 0) dec[d] = fexp(blast);
        { const int v = tid & 127, sg = tid >> 7; bf16_t vv[16];
#pragma unroll
          for (int i = 0; i < 16; ++i) vv[i] = GV[(rb + sg * 16 + i) * 512 + h * 128 + v];
          u32x4 a, bb; a.x = vv[0] | ((unsigned)vv[1] << 16); a.y = vv[2] | ((unsigned)vv[3] << 16); a.z = vv[4] | ((unsigned)vv[5] << 16); a.w = vv[6] | ((unsigned)vv[7] << 16);
          bb.x = vv[8] | ((unsigned)vv[9] << 16); bb.y = vv[10] | ((unsigned)vv[11] << 16); bb.z = vv[12] | ((unsigned)vv[13] << 16); bb.w = vv[14] | ((unsigned)vv[15] << 16);
          *(LAS3 u32x4*)(Vt + v * LDP + sg * 16) = a; *(LAS3 u32x4*)(Vt + v * LDP + sg * 16 + 8) = bb; }
        __syncthreads();
#pragma unroll
        for (int s2 = 0; s2 < 2; ++s2) {
            const int st = 2 * vh + s2;
            f32x4 acc = zero;
#pragma unroll
            for (int ks = 0; ks < 2; ++ks) {
                const bf16x8 a = *(const LAS3 bf16x8*)(Kt + (st * 16 + fr) * LDP + ks * 32 + fq * 8), bq = *(const LAS3 bf16x8*)(Qt + (tt * 16 + fr) * LDP + ks * 32 + fq * 8);
                acc = mfma16(a, bq, acc);
            }
            const int t = tt * 16 + fr, s0 = st * 16 + 4 * fq;
            u32x2 pw; pw.x = cvtpk(s0 <= t ? acc[0] : 0.f, s0 + 1 <= t ? acc[1] : 0.f); pw.y = cvtpk(s0 + 2 <= t ? acc[2] : 0.f, s0 + 3 <= t ? acc[3] : 0.f);
            *(LAS3 u32x2*)(Pm + t * LDP + s0) = pw;
        }
        __syncthreads();
        f32x4 oacc[4];
        {
            bf16x8 aq[2], ap[2], ak[2];
#pragma unroll
            for (int ks = 0; ks < 2; ++ks) {
                aq[ks] = *(const LAS3 bf16x8*)(Qt + (tt * 16 + fr) * LDP + ks * 32 + fq * 8);
                ap[ks] = *(const LAS3 bf16x8*)(Pm + (tt * 16 + fr) * LDP + ks * 32 + fq * 8);
                ak[ks] = *(const LAS3 bf16x8*)(KpT + (tt * 16 + fr) * LDP + ks * 32 + fq * 8);
            }
            const f32x4 dv = *(const LAS3 f32x4*)(dec + tt * 16 + 4 * fq);
#pragma unroll
            for (int jv = 0; jv < 4; ++jv) {
                const int vt = vh * 4 + jv;
                bf16x8 bs[2], bv[2];
#pragma unroll
                for (int ks = 0; ks < 2; ++ks) {
                    bs[ks] = *(const LAS3 bf16x8*)(SbT + (vt * 16 + fr) * LDP + ks * 32 + fq * 8);
                    bv[ks] = *(const LAS3 bf16x8*)(Vt + (vt * 16 + fr) * LDP + ks * 32 + fq * 8);
                }
                f32x4 oa = mfma16(aq[0], bs[0], zero); oa = mfma16(aq[1], bs[1], oa); oa = mfma16(ap[0], bv[0], oa); oa = mfma16(ap[1], bv[1], oa);
                oacc[jv] = oa;
                f32x4 sa = Sacc[jv] * dv; sa = mfma16(ak[0], bv[0], sa); sa = mfma16(ak[1], bv[1], sa);
                Sacc[jv] = sa;
            }
        }
        __syncthreads();
#pragma unroll
        for (int jv = 0; jv < 4; ++jv) {
            const int vt = vh * 4 + jv;
#pragma unroll
            for (int r = 0; r < 4; ++r) Of[(tt * 16 + 4 * fq + r) * 132 + vt * 16 + fr] = oacc[jv][r];
            u32x2 sw; sw.x = cvtpk(Sacc[jv][0], Sacc[jv][1]); sw.y = cvtpk(Sacc[jv][2], Sacc[jv][3]);
            *(LAS3 u32x2*)(SbT + (vt * 16 + fr) * LDP + tt * 16 + 4 * fq) = sw;
        }
        __syncthreads();
        {
            const int t = tid >> 3, seg = tid & 7;
            const LAS3 float* op = Of + t * 132 + seg * 16;
            f32x4 ov[4]; float ss = 0.f;
#pragma unroll
            for (int i = 0; i < 4; ++i) { ov[i] = *(const LAS3 f32x4*)(op + 4 * i); ss += ov[i][0] * ov[i][0] + ov[i][1] * ov[i][1] + ov[i][2] * ov[i][2] + ov[i][3] * ov[i][3]; }
            ss += __shfl_xor(ss, 1); ss += __shfl_xor(ss, 2); ss += __shfl_xor(ss, 4);
            const float rstd = rsqrtf(ss * (1.f / 128.f) + 1e-6f);
            const bf16_t* gp = GG + (rb + t) * 512 + h * 128 + seg * 16;
            const u32x4 g0 = *(const u32x4*)gp, g1 = *(const u32x4*)(gp + 8);
            const unsigned gw[8] = {g0.x, g0.y, g0.z, g0.w, g1.x, g1.y, g1.z, g1.w};
            unsigned ow[8];
#pragma unroll
            for (int i = 0; i < 4; ++i) {
                const f32x4 on = *(const f32x4*)(p.onorm + seg * 16 + 4 * i);
                const float y0 = ov[i][0] * rstd * on[0] * __uint_as_float(gw[2 * i] << 16), y1 = ov[i][1] * rstd * on[1] * __uint_as_float(gw[2 * i] & 0xffff0000u);
                const float y2 = ov[i][2] * rstd * on[2] * __uint_as_float(gw[2 * i + 1] << 16), y3 = ov[i][3] * rstd * on[3] * __uint_as_float(gw[2 * i + 1] & 0xffff0000u);
                ow[2 * i] = cvtpk(y0, y1); ow[2 * i + 1] = cvtpk(y2, y3);
            }
            bf16_t* mp = MIX + (rb + t) * 1024 + h * 128 + seg * 16;
            *(u32x4*)mp = (u32x4){ow[0], ow[1], ow[2], ow[3]}; *(u32x4*)(mp + 8) = (u32x4){ow[4], ow[5], ow[6], ow[7]};
        }
    }
#pragma unroll
    for (int jv = 0; jv < 4; ++jv)
#pragma unroll
        for (int r = 0; r < 4; ++r) p.out[O_GSP + ((size_t)(b * 4 + h) * 64 + tt * 16 + 4 * fq + r) * 128 + (vh * 4 + jv) * 16 + fr] = Sacc[jv][r];
    __syncthreads();
}

DI void sscore_unit(const Params& p, LAS3 unsigned char* lds, int u) {
    const int tid = threadIdx.x;
    unsigned char* ws = p.ws;
    const int b = u >> 3, pg = u & 7;
    LAS3 float* qf = (LAS3 float*)lds;
    if (tid < 256) qf[tid] = bf2f(((const bf16_t*)(ws + W_IQ))[(size_t)(MP + b) * 256 + tid]);
    __syncthreads();
    const int seg = tid & 15;
    f32x4 q[4];
#pragma unroll
    for (int h = 0; h < 4; ++h) q[h] = *(const LAS3 f32x4*)(qf + h * 64 + seg * 4);
    const f32x4 wv = *(const f32x4*)vaddr((const float*)(ws + W_IW) + (size_t)(MP + b) * 4);
    unsigned* sc = (unsigned*)(ws + W_SC) + (size_t)b * SCLD;
    const int* pt = p.page_table + b * NPAGES + pg * 16;
#define SS_LOAD(BUF, pp) do { const float* base_ = p.cache_ik + (size_t)pt[(pp) < 16 ? (pp) : 15] * 8192; \
        _Pragma("unroll") for (int i = 0; i < 4; ++i) BUF[i] = *(const f32x4*)(base_ + (size_t)(tid + 512 * i) * 4); } while (0)
#define SS_COMPUTE(BUF, pp) do { \
        _Pragma("unroll") for (int i = 0; i < 4; ++i) { const f32x4 kv = BUF[i]; float dh[4]; \
            _Pragma("unroll") for (int h = 0; h < 4; ++h) { float x = q[h][0] * kv[0] + q[h][1] * kv[1] + q[h][2] * kv[2] + q[h][3] * kv[3]; \
                x += __shfl_xor(x, 1); x += __shfl_xor(x, 2); x += __shfl_xor(x, 4); x += __shfl_xor(x, 8); dh[h] = x; } \
            const float s_ = wv[0] * fmaxf(dh[0], 0.f) + wv[1] * fmaxf(dh[1], 0.f) + wv[2] * fmaxf(dh[2], 0.f) + wv[3] * fmaxf(dh[3], 0.f); \
            if (seg == 0) __hip_atomic_store(sc + (pg * 16 + (pp)) * 128 + ((tid + 512 * i) >> 4), __float_as_uint(s_), __ATOMIC_RELAXED, __HIP_MEMORY_SCOPE_AGENT); } } while (0)
    f32x4 pa[4], pb[4];
    SS_LOAD(pa, 0); SS_LOAD(pb, 1);
#pragma unroll 1
    for (int pp = 0; pp < 16; pp += 2) {
        SS_COMPUTE(pa, pp); SS_LOAD(pa, pp + 2);
        SS_COMPUTE(pb, pp + 1); SS_LOAD(pb, pp + 3);
    }
#undef SS_LOAD
#undef SS_COMPUTE
    asm volatile("s_waitcnt vmcnt(0)" ::: "memory");
    __syncthreads();
    if (tid == 0) __hip_atomic_fetch_add((unsigned*)(ws + CW_SCNT), 1u, __ATOMIC_RELAXED, __HIP_MEMORY_SCOPE_AGENT);
}

constexpr int SA_Q = 2048, SA_S = 3072, SA_KP = 8192, SA_VP = 10240;
DI void sattend(const Params& p, LAS3 unsigned char* lds, const bf16_t* qrow  , const bf16_t* gate, bf16_t* mix) {
    const int tid = threadIdx.x, lane = tid & 63, w = tid >> 6;
    LAS3 float* qf = (LAS3 float*)(lds + SA_Q); LAS3 float* S = (LAS3 float*)(lds + SA_S);
    const float* const LAS3* kptr = (const float* const LAS3*)(lds + SA_KP); const float* const LAS3* vptr = (const float* const LAS3*)(lds + SA_VP);
    if (tid < 256) qf[tid] = bf2f(qrow[tid]);
    __syncthreads();
    {
        const int jk = tid >> 1, hp = tid & 1;
        const float* kr = kptr[jk] + hp * 128;
        float s0 = 0.f, s1 = 0.f;
#pragma unroll 4
        for (int i = 0; i < 16; ++i) {
            const f32x4 k0 = *(const f32x4*)(kr + 4 * i), k1 = *(const f32x4*)(kr + 64 + 4 * i);
            const f32x4 q0 = *(const LAS3 f32x4*)(qf + hp * 128 + 4 * i), q1 = *(const LAS3 f32x4*)(qf + hp * 128 + 64 + 4 * i);
            s0 += q0[0] * k0[0] + q0[1] * k0[1] + q0[2] * k0[2] + q0[3] * k0[3];
            s1 += q1[0] * k1[0] + q1[1] * k1[1] + q1[2] * k1[2] + q1[3] * k1[3];
        }
        S[(2 * hp) * 256 + jk] = s0; S[(2 * hp + 1) * 256 + jk] = s1;
    }
    __syncthreads();
    if (w < 4) {
        float v[4], mx = NEG_INF;
#pragma unroll
        for (int i = 0; i < 4; ++i) { v[i] = S[w * 256 + lane + 64 * i]; mx = fmaxf(mx, v[i]); }
        mx = wmax64(mx);
        float sum = 0.f;
#pragma unroll
        for (int i = 0; i < 4; ++i) { v[i] = __expf(v[i] - mx); sum += v[i]; }
        sum = wsum64(sum);
        const float inv = 1.f / sum;
#pragma unroll
        for (int i = 0; i < 4; ++i) S[w * 256 + lane + 64 * i] = v[i] * inv;
    }
    __syncthreads();
    {
        const int h = tid >> 7, dd = (tid >> 1) & 63, hf = tid & 1;
        float acc = 0.f;
#pragma unroll 4
        for (int jk = hf * 128; jk < hf * 128 + 128; ++jk) acc += S[h * 256 + jk] * vptr[jk][h * 64 + dd];
        acc += __shfl_xor(acc, 1);
        if (hf == 0) mix[h * 64 + dd] = f2bf(acc * bf2f(gate[h * 64 + dd]));
    }
    __syncthreads();
}
DI void smem_unit(const Params& p, LAS3 unsigned char* lds, int b) {
    const int tid = threadIdx.x; unsigned char* ws = p.ws;
    const float* LAS3* kptr = (const float* LAS3*)(lds + SA_KP); const float* LAS3* vptr = (const float* LAS3*)(lds + SA_VP);
    if (tid < 256) { kptr[tid] = p.cache_mem_k + ((size_t)b * NMEM + tid) * 256; vptr[tid] = p.cache_mem_v + ((size_t)b * NMEM + tid) * 256; }
    const size_t row = MP + b;
    sattend(p, lds, (const bf16_t*)(ws + W_MQ) + row * 256, (const bf16_t*)(ws + W_MG) + row * 256, (bf16_t*)(ws + W_MIX) + row * 1024 + 768);
}
DI void ssel_unit(const Params& p, LAS3 unsigned char* lds, int b) {
    const int tid = threadIdx.x, lane = tid & 63, w = tid >> 6; unsigned char* ws = p.ws;
    LAS3 unsigned* CNT = (LAS3 unsigned*)lds;
    LAS3 unsigned* wsum = (LAS3 unsigned*)(lds + 256);
    LAS3 float* newsc = (LAS3 float*)(lds + 320);
    LAS3 int* list = (LAS3 int*)(lds + 512);
    const float* LAS3* kptr = (const float* LAS3*)(lds + SA_KP); const float* LAS3* vptr = (const float* LAS3*)(lds + SA_VP);
    if (tid < 48) CNT[tid] = 0u;
    if (tid == 0) {
        unsigned* cnt = (unsigned*)(ws + CW_SCNT); unsigned* tmo = (unsigned*)(ws + CW_TMO); unsigned sp = 0;
        while (__hip_atomic_load(cnt, __ATOMIC_RELAXED, __HIP_MEMORY_SCOPE_AGENT) < 256u) {
            __builtin_amdgcn_s_sleep(2);
            if ((++sp & 255u) == 0u) { if (__hip_atomic_load(tmo, __ATOMIC_RELAXED, __HIP_MEMORY_SCOPE_AGENT)) break; if (sp > (1u << 20)) { __hip_atomic_store(tmo, 1u, __ATOMIC_RELAXED, __HIP_MEMORY_SCOPE_AGENT); break; } }
        }
        __builtin_amdgcn_fence(__ATOMIC_ACQUIRE, "agent");
        asm volatile("s_waitcnt vmcnt(0)" ::: "memory");
    }
    if (w == 1) {
        const bf16_t* iq = (const bf16_t*)(ws + W_IQ) + (size_t)(MP + b) * 256; const float kd = bf2f(((const bf16_t*)(ws + W_IK))[(size_t)(MP + b) * 64 + lane]);
        const f32x4 wv = *(const f32x4*)vaddr((const float*)(ws + W_IW) + (size_t)(MP + b) * 4);
        float s = 0.f;
#pragma unroll
        for (int h = 0; h < 4; ++h) { const float dh = wsum64(bf2f(iq[h * 64 + lane]) * kd); s += wv[h] * fmaxf(dh, 0.f); }
        if (lane == 0) *newsc = s;
    }
    __syncthreads();
    const float* sc = (const float*)(ws + W_SC) + (size_t)b * SCLD;
    unsigned key[33];
#pragma unroll
    for (int n = 0; n < 32; ++n) key[n] = fkey(sc[tid + 512 * n]);
    key[32] = (tid == 0) ? fkey(*newsc) : 0u;
    int it = 0;
    unsigned T = 0u, X = 0x7fffffffu; bool fin = false;
    for (int bit = 31; bit >= 0; --bit) {
        const unsigned cand = T | (1u << bit);
        unsigned c = 0;
#pragma unroll
        for (int n = 0; n < 33; ++n) cnt_ge(c, key[n], cand);
        const unsigned tot = blk_count(c, CNT, it, lane);
        if (tot >= 256u) { T = cand; fin = (tot == 256u); }
        if (fin) break;
    }
    if (!fin) {
        unsigned c = 0;
#pragma unroll
        for (int n = 0; n < 33; ++n) cnt_gt(c, key[n], T);
        const unsigned need = 256u - blk_count(c, CNT, it, lane);
        unsigned Xl = 0u;
        for (int bit = 14; bit >= 0; --bit) {
            const unsigned cand = Xl | (1u << bit);
            c = 0;
#pragma unroll
            for (int n = 0; n < 33; ++n) cnt_eq_lt(c, key[n], T, (unsigned)(tid + 512 * n), cand);
            if (blk_count(c, CNT, it, lane) < need) Xl = cand;
        }
        X = Xl;
    }
    unsigned selm = 0, hi = 0;
#pragma unroll
    for (int n = 0; n < 32; ++n) selm |= (key[n] > T || (key[n] == T && (unsigned)(tid + 512 * n) <= X)) ? (1u << n) : 0u;
    hi = (key[32] > T || (key[32] == T && (unsigned)(tid + 16384) <= X)) ? 1u : 0u;
    const unsigned cs = __popc(selm) + hi;
    unsigned inc = cs;
#pragma unroll
    for (int o2 = 1; o2 < 64; o2 <<= 1) { const unsigned t2 = __shfl_up(inc, o2); if (lane >= o2) inc += t2; }
    if (lane == 63) wsum[w] = inc;
    __syncthreads();
    unsigned pos = inc - cs;
    for (int w2 = 0; w2 < w; ++w2) pos += wsum[w2];
#pragma unroll
    for (int n = 0; n < 32; ++n) if ((selm >> n) & 1u) { if (pos < 256u) list[pos] = tid + 512 * n; ++pos; }
    if (hi) { if (pos < 256u) list[pos] = tid + 16384; ++pos; }
    __syncthreads();
    if (tid < 256) {
        const int idx = list[tid];
        if (idx < 16384) { const size_t phys = (size_t)p.page_table[b * NPAGES + (idx >> 7)] * 128 + (idx & 127); kptr[tid] = p.cache_k + phys * 256; vptr[tid] = p.cache_v + phys * 256; }
        else { kptr[tid] = p.out + O_KS + (size_t)b * 256; vptr[tid] = p.out + O_VS + (size_t)b * 256; }
    }
    const size_t row = MP + b;
    sattend(p, lds, (const bf16_t*)(ws + W_DQ) + row * 256, (const bf16_t*)(ws + W_DG) + row * 256, (bf16_t*)(ws + W_MIX) + row * 1024 + 512);
}
DI void sgla_unit(const Params& p, LAS3 unsigned char* lds, int b) {
    const int tid = threadIdx.x, lane = tid & 63, w = tid >> 6; unsigned char* ws = p.ws;
    LAS3 float* qs = (LAS3 float*)lds; LAS3 float* ks = qs + 256; LAS3 float* gs = qs + 512; LAS3 float* vs = qs + 768; LAS3 float* part = qs + 1280;
    const size_t row = MP + b;
    if (tid < 256) {
        float u = p.b_g[tid];
        const float* gl = vaddr((const float*)(ws + W_GLR) + row * 16);
#pragma unroll
        for (int r = 0; r < 16; ++r) u += gl[r] * p.w_g2[r * 256 + tid];
        gs[tid] = expf(logsigf(u) * (1.f / 16.f));
        qs[tid] = bf2f(((const bf16_t*)(ws + W_GQ))[row * 256 + tid]); ks[tid] = bf2f(((const bf16_t*)(ws + W_GK))[row * 256 + tid]);
    }
    vs[tid] = bf2f(((const bf16_t*)(ws + W_GV))[row * 512 + tid]);
    __syncthreads();
    const int h = tid >> 7, v = tid & 127;
    const float* sp = p.state_gla + ((size_t)(b * 4 + h) * 64) * 128 + v; float* so = p.out + O_GSS + ((size_t)(b * 4 + h) * 64) * 128 + v;
    const float vv = vs[h * 128 + v];
    float o = 0.f;
#pragma unroll 8
    for (int dd = 0; dd < 64; ++dd) { const float sn = gs[h * 64 + dd] * sp[dd * 128] + ks[h * 64 + dd] * vv; so[dd * 128] = sn; o += qs[h * 64 + dd] * sn; }
    const float ss = wsum64(o * o);
    if (lane == 0) part[w] = ss;
    __syncthreads();
    const float rstd = rsqrtf((part[2 * h] + part[2 * h + 1]) * (1.f / 128.f) + 1e-6f);
    ((bf16_t*)(ws + W_MIX))[row * 1024 + h * 128 + v] = f2bf(o * rstd * p.onorm[v] * bf2f(((const bf16_t*)(ws + W_GG))[row * 512 + h * 128 + v]));
    __syncthreads();
}
DI void p4_final(const Params& p) {
    const int tid = threadIdx.x, lane = tid & 63, wv = tid >> 6;
    for (int r = blockIdx.x * 8 + wv; r < MP + NDB; r += gridDim.x * 8) {
        float* y = p.out + (r < MP ? O_YP + (size_t)r * DM : O_YS + (size_t)(r - MP) * DM);
        f32x4 v[4]; float ss = 0.f;
#pragma unroll
        for (int i = 0; i < 4; ++i) { v[i] = *(const f32x4*)(y + i * 256 + lane * 4); ss += v[i][0] * v[i][0] + v[i][1] * v[i][1] + v[i][2] * v[i][2] + v[i][3] * v[i][3]; }
        ss = wsum64(ss);
        const float rstd = rsqrtf(ss * (1.f / DM) + 1e-6f);
#pragma unroll
        for (int i = 0; i < 4; ++i) { const f32x4 gv = *(const f32x4*)(p.norm_final + i * 256 + lane * 4); *(f32x4*)(y + i * 256 + lane * 4) = v[i] * rstd * gv; }
    }
}

DI int next_unit(unsigned* ctr, volatile LAS3 unsigned* slot) {
    if (threadIdx.x == 0) *slot = __hip_atomic_fetch_add(ctr, 1u, __ATOMIC_RELAXED, __HIP_MEMORY_SCOPE_AGENT);
    __syncthreads();
    const int v = __builtin_amdgcn_readfirstlane((int)*slot);
    __syncthreads();
    return v;
}

#ifndef REP1
#define REP1 1
#endif
#ifndef REP2
#define REP2 1
#endif
#ifndef REP3
#define REP3 1
#endif
#ifndef REP2A
#define REP2A 1
#endif
#ifndef REP2B
#define REP2B 1
#endif
#ifndef REP2C
#define REP2C 1
#endif
#ifndef REP2D
#define REP2D 1
#endif
#ifndef REP2E
#define REP2E 1
#endif
DI void sample_inproj(const Params& p, LAS3 unsigned char* lds) {
    const int tid = threadIdx.x, lane = tid & 63, wv = tid >> 6, fr = lane & 15, fq = lane >> 4;
    unsigned char* ws = p.ws;
    LAS3 float* red = (LAS3 float*)lds;
    for (int pr = blockIdx.x; pr < 112; pr += gridDim.x) {
        const int col0 = pr * 32, pn = col0 >> 8, vc0 = col0 & 255;
        const bf16_t* A = (const bf16_t*)(ws + W_XN) + (size_t)MP * 1024 + (size_t)fr * 1024 + fq * 8 + wv * 128;
        const bf16_t* B = (const bf16_t*)(ws + W_WTIN) + (size_t)(col0 + fr) * 1024 + fq * 8 + wv * 128;
        const f32x4 zero = {0.f, 0.f, 0.f, 0.f};
        f32x4 acc[2][2] = {{zero, zero}, {zero, zero}};
#pragma unroll
        for (int ks = 0; ks < 4; ++ks) {
            const bf16x8 a0 = *(const bf16x8*)(A + ks * 32), a1 = *(const bf16x8*)(A + 16 * 1024 + ks * 32);
            const bf16x8 b0 = *(const bf16x8*)(B + ks * 32), b1 = *(const bf16x8*)(B + 16 * 1024 + ks * 32);
            acc[0][0] = mfma16(a0, b0, acc[0][0]); acc[0][1] = mfma16(a0, b1, acc[0][1]); acc[1][0] = mfma16(a1, b0, acc[1][0]); acc[1][1] = mfma16(a1, b1, acc[1][1]);
        }
#pragma unroll
        for (int rt = 0; rt < 2; ++rt)
#pragma unroll
            for (int ct = 0; ct < 2; ++ct)
#pragma unroll
                for (int r = 0; r < 4; ++r) red[(wv * 16 + (rt * 2 + ct) * 4 + r) * 64 + lane] = acc[rt][ct][r];
        __syncthreads();
        {
            const int rt = wv >> 2, r = wv & 3;
            float v0 = 0.f, v1 = 0.f;
#pragma unroll
            for (int w2 = 0; w2 < 8; ++w2) { v0 += red[(w2 * 16 + (rt * 2 + 0) * 4 + r) * 64 + lane]; v1 += red[(w2 * 16 + (rt * 2 + 1) * 4 + r) * 64 + lane]; }
            const float* rope = (const float*)(ws + W_ROPE) + (size_t)2048 * 64;
            {
                const int bs = 16 * rt + 4 * fq + r; const size_t R = (size_t)MP + bs;
                if (pn <= 5 || (pn >= 10 && pn <= 12)) {
                    bf16_t* dst; int ldc = 256, coff = 0; float sc = 1.f; bool silu = false;
                    switch (pn) {
                        case 0: dst = (bf16_t*)(ws + W_GQ); sc = 0.125f; break;
                        case 1: dst = (bf16_t*)(ws + W_GK); break;
                        case 2: dst = (bf16_t*)(ws + W_GV); ldc = 512; break;
                        case 3: dst = (bf16_t*)(ws + W_GV); ldc = 512; coff = 256; break;
                        case 4: dst = (bf16_t*)(ws + W_GG); ldc = 512; silu = true; break;
                        case 5: dst = (bf16_t*)(ws + W_GG); ldc = 512; coff = 256; silu = true; break;
                        case 10: dst = (bf16_t*)(ws + W_DG); silu = true; break;
                        case 11: dst = (bf16_t*)(ws + W_MQ); sc = 0.125f; break;
                        default: dst = (bf16_t*)(ws + W_MG); silu = true; break;
                    }
                    bf16_t* rp = dst + R * ldc + coff + vc0 + 8 * (fr >> 2) + (fr & 3);
                    rp[0] = f2bf(silu ? siluf(v0) : v0 * sc); rp[4] = f2bf(silu ? siluf(v1) : v1 * sc);
                } else if (pn == 6 || pn == 7 || pn == 9 || (pn == 13 && vc0 < 64)) {
                    const int hh = (pn == 13) ? 0 : ((vc0 >> 5) & 3);
                    const int f = (pn == 13) ? 16 * ((vc0 >> 5) & 1) + fr : 8 * (fr >> 2) + 4 * (vc0 >> 7) + (fr & 3);
                    const float c = rope[2 * f], s = rope[2 * f + 1], sc = (pn == 6) ? 0.125f : 1.f;
                    const float o1 = (v0 * c - v1 * s) * sc, o2 = (v1 * c + v0 * s) * sc;
                    if (pn == 13) {
                        bf16_t* ikb = (bf16_t*)(ws + W_IK) + R * 64; ikb[f] = f2bf(o1); ikb[f + 32] = f2bf(o2);
                        float* op = p.out + O_IKS + (size_t)bs * 64; op[f] = o1; op[f + 32] = o2;
                    } else {
                        bf16_t* dst = (bf16_t*)(ws + (pn == 6 ? W_DQ : (pn == 7 ? W_DK : W_IQ))) + R * 256 + 64 * hh;
                        dst[f] = f2bf(o1); dst[f + 32] = f2bf(o2);
                        if (pn == 7) { float* op = p.out + O_KS + (size_t)bs * 256 + 64 * hh; op[f] = o1; op[f + 32] = o2; }
                    }
                } else if (pn == 8) {
                    float* op = p.out + O_VS + (size_t)bs * 256 + vc0 + 8 * (fr >> 2) + (fr & 3); op[0] = v0; op[4] = v1;
                } else if (pn == 13 && vc0 == 64) {
                    if (fr < 4) { ((float*)(ws + W_IW))[R * 4 + fr] = v0 * 0.5f; ((float*)(ws + W_GLR))[R * 16 + 12 + fr] = v1; }
                    else ((float*)(ws + W_GLR))[R * 16 + fr - 4] = v0;
                }
            }
        }
        __syncthreads();
    }
}
DI void phase1(const Params& p, LAS3 unsigned char* lds) {
    unsigned char* ws = p.ws;
    { pg8::Gemm g{(const bf16_t*)(ws + W_XN), (const bf16_t*)(ws + W_WTIN), MP, NIN, DM}; pg8::StaticOrder S; S.init(MP, NIN, (int)gridDim.x, (int)blockIdx.x);
      EpiIn E{ws, p.out}; pg8::gemm_phase<EpiIn, pg8::StaticOrder, true, true>(lds, g, S, E); }
    sample_inproj(p, lds);
}
DI void p2_memgemm(const Params& p, LAS3 unsigned char* lds) {
    const int u = (int)gridDim.x - 1 - (int)blockIdx.x;
    if (u >= 96 && u < 128) {
        pg8::Gemm g{(const bf16_t*)(p.ws + W_MEMN), (const bf16_t*)(p.ws + W_WTMEM), MMEM, 512, DM}; pg8::StaticOrder S; S.init(MMEM, 512, (int)gridDim.x, u - 96);
        EpiMem E{p.ws, p.out}; pg8::gemm_phase<EpiMem, pg8::StaticOrder, true, true>(lds, g, S, E);
        asm volatile("s_waitcnt vmcnt(0)" ::: "memory");
        __syncthreads();
        if (threadIdx.x == 0) {
            __builtin_amdgcn_fence(__ATOMIC_RELEASE, "agent");
            asm volatile("s_waitcnt vmcnt(0)" ::: "memory");
            __hip_atomic_fetch_add((unsigned*)(p.ws + CW_MEMC), 1u, __ATOMIC_RELAXED, __HIP_MEMORY_SCOPE_AGENT);
        }
    }
}
DI void wait_memgemm(const Params& p) {
    if (threadIdx.x == 0) {
        unsigned* cnt = (unsigned*)(p.ws + CW_MEMC); unsigned* tmo = (unsigned*)(p.ws + CW_TMO); unsigned sp = 0;
        while (__hip_atomic_load(cnt, __ATOMIC_RELAXED, __HIP_MEMORY_SCOPE_AGENT) < 32u) {
            __builtin_amdgcn_s_sleep(2);
            if ((++sp & 255u) == 0u) { if (__hip_atomic_load(tmo, __ATOMIC_RELAXED, __HIP_MEMORY_SCOPE_AGENT)) break; if (sp > (1u << 20)) { __hip_atomic_store(tmo, 1u, __ATOMIC_RELAXED, __HIP_MEMORY_SCOPE_AGENT); break; } }
        }
        __builtin_amdgcn_fence(__ATOMIC_ACQUIRE, "agent");
        asm volatile("s_waitcnt vmcnt(0)" ::: "memory");
    }
    __syncthreads();
}
template <int QI> DI void p2_sscore(const Params& p, LAS3 unsigned char* lds) { for (int u = blockIdx.x; u < 256; u += gridDim.x) { sscore_unit(p, lds, u); __syncthreads(); } }
template <int QI> DI void p2_gla(const Params& p, LAS3 unsigned char* lds) { for (int u = blockIdx.x; u < 64; u += gridDim.x) gla_unit(p, lds, u >> 2, u & 3); }
DI int next_unit_xcd(unsigned char* qbase, volatile LAS3 unsigned* slot, unsigned x0) {
    if (threadIdx.x == 0) {
        unsigned res = 0xffffffffu;
        for (unsigned k = 0; k < 8u; ++k) {
            const unsigned xq = (x0 + k) & 7u;
            const unsigned mq = __hip_atomic_fetch_add((unsigned*)(qbase + 256 * xq), 1u, __ATOMIC_RELAXED, __HIP_MEMORY_SCOPE_AGENT);
            if (mq < 64u) { res = xq * 64u + mq; break; }
        }
        *slot = res;
    }
    __syncthreads();
    const int v = __builtin_amdgcn_readfirstlane((int)*slot);
    __syncthreads();
    return v;
}
template <int QI> DI void p2_dsa(const Params& p, LAS3 unsigned char* lds, volatile LAS3 unsigned* MISC TARGS) {
#if defined(XCDQ) && XCDQ
    const unsigned x0 = xb_xcc_id() & 7u;
    for (;;) { const int n = next_unit_xcd(p.ws + CW_QDSA + 8192 * QI, MISC + 4, x0); if (n < 0) break; const int m = n & 63; dsa_unit(p, lds, 2 * (n >> 6) + (m >> 5), 31 - (m & 31) TPASS); }
#else
    for (;;) { const int n = next_unit((unsigned*)(p.ws + CW_QDSA + 8192 * QI), MISC + 4); if (n >= 512) break; dsa_unit(p, lds, n & 15, 31 - (n >> 4) TPASS); }
#endif
}
template <int QI> DI void p2_mem(const Params& p, LAS3 unsigned char* lds, volatile LAS3 unsigned* MISC) {
    wait_memgemm(p);
    for (;;) { const int n = next_unit((unsigned*)(p.ws + CW_QMEM + 8192 * QI), MISC + 4); if (n >= 512) break; mem_unit(p, n); } }
template <int QI> DI void p2_sample(const Params& p, LAS3 unsigned char* lds) {
    for (int u = (int)gridDim.x - 1 - (int)blockIdx.x; u < 96; u += gridDim.x) { if (u < 32) sgla_unit(p, lds, u); else if (u < 64) smem_unit(p, lds, u - 32); else ssel_unit(p, lds, u - 64); } }
template <int RI> DI void phase2(const Params& p, LAS3 unsigned char* lds, volatile LAS3 unsigned* MISC TARGS) {
    TBEG(20); p2_memgemm(p, lds);
    TBEG(21); p2_sscore<0>(p, lds); TEND(21); if (REP2A > 1) p2_sscore<1>(p, lds);
    TBEG(25); p2_sample<0>(p, lds); TEND(25); if (REP2E > 1) p2_sample<1>(p, lds);
    TBEG(22); p2_gla<0>(p, lds); TEND(22); if (REP2B > 1) p2_gla<1>(p, lds);
    TBEG(23); p2_dsa<0>(p, lds, MISC TPASS); TEND(23); if (REP2C > 1) p2_dsa<1>(p, lds, MISC TPASS);
    TBEG(24); p2_mem<0>(p, lds, MISC); TEND(24); if (REP2D > 1) p2_mem<1>(p, lds, MISC);
    TEND(20);
}
DI void phase3(const Params& p, LAS3 unsigned char* lds) {
    pg8::Gemm g{(const bf16_t*)(p.ws + W_MIX), (const bf16_t*)(p.ws + W_WTOUT), MP, DM, DM}; pg8::StaticOrder S; S.init(MP, DM, (int)gridDim.x, (int)blockIdx.x);
    EpiOut E{p.x_prompt, p.x_sample, p.out}; pg8::gemm_phase<EpiOut, pg8::StaticOrder, true, true>(lds, g, S, E);
    const int tid = threadIdx.x, lane = tid & 63, wv = tid >> 6;
    for (int u = blockIdx.x; u < 256; u += gridDim.x) {
        const int b = u >> 3, col0 = (u & 7) * 128 + wv * 16;
        const bf16_t* mrow = (const bf16_t*)(p.ws + W_MIX) + (size_t)(MP + b) * 1024 + lane * 16;
        const u32x4 m0 = *(const u32x4*)mrow, m1 = *(const u32x4*)(mrow + 8);
        const unsigned mw[8] = {m0.x, m0.y, m0.z, m0.w, m1.x, m1.y, m1.z, m1.w};
        float res = 0.f;
#pragma unroll 4
        for (int i = 0; i < 16; ++i) {
            const bf16_t* wrow = (const bf16_t*)(p.ws + W_WTOUT) + (size_t)(col0 + i) * 1024 + lane * 16;
            const u32x4 w0 = *(const u32x4*)wrow, w1 = *(const u32x4*)(wrow + 8);
            const unsigned ww[8] = {w0.x, w0.y, w0.z, w0.w, w1.x, w1.y, w1.z, w1.w};
            float acc = 0.f;
#pragma unroll
            for (int e = 0; e < 8; ++e) acc += __uint_as_float(mw[e] << 16) * __uint_as_float(ww[e] << 16) + __uint_as_float(mw[e] & 0xffff0000u) * __uint_as_float(ww[e] & 0xffff0000u);
            acc = wsum64(acc);
            res = (lane == i) ? acc : res;
        }
        if (lane < 16) p.out[O_YS + (size_t)b * DM + col0 + lane] = p.x_sample[(size_t)b * DM + col0 + lane] + res;
    }
}
#ifdef CHECK_ATT
DI void check_mem_attention(const Params& p) {
    const int tid = threadIdx.x, lane = tid & 63, wv = tid >> 6;
    const int samp = blockIdx.x * 8 + wv;
    const int row = (samp * 977 + 13) % MP, h = samp & 3, b = row >> 11;
    const bf16_t* q = (const bf16_t*)(p.ws + W_MQ) + (size_t)row * 256 + h * 64;
    float s[4];
#pragma unroll
    for (int i = 0; i < 4; ++i) { const float* kr = p.out + O_MKP + ((size_t)b * NMEM + lane + 64 * i) * 256 + h * 64; float a = 0.f; for (int d = 0; d < 64; ++d) a += bf2f(q[d]) * kr[d]; s[i] = a; }
    float mx = wmax64(fmaxf(fmaxf(s[0], s[1]), fmaxf(s[2], s[3])));
    float pe[4], sum = 0.f;
#pragma unroll
    for (int i = 0; i < 4; ++i) { pe[i] = __builtin_amdgcn_exp2f(s[i] - mx); sum += pe[i]; }
    sum = wsum64(sum);
    float err = 0.f, nrm = 0.f;
    for (int d = 0; d < 64; ++d) {
        float a = 0.f;
#pragma unroll
        for (int i = 0; i < 4; ++i) a += pe[i] * p.out[O_MVP + ((size_t)b * NMEM + lane + 64 * i) * 256 + h * 64 + d];
        a = wsum64(a) / sum;
        const float want = a * bf2f(((const bf16_t*)(p.ws + W_MG))[(size_t)row * 256 + h * 64 + d]);
        const float got = bf2f(((const bf16_t*)(p.ws + W_MIX))[(size_t)row * 1024 + 768 + h * 64 + d]);
        err += (got - want) * (got - want); nrm += want * want;
    }
    if (lane == 0) { atomicAdd((unsigned*)(p.ws + CW_CHK + 12), 1u); if (!(err <= 0.0025f * nrm + 1e-12f)) atomicAdd((unsigned*)(p.ws + CW_CHK + 8), 1u); }
    if (samp < 128) {
        const int bs = samp >> 2, hs = samp & 3; const size_t rs = (size_t)MP + bs;
        const bf16_t* qs = (const bf16_t*)(p.ws + W_MQ) + rs * 256 + hs * 64;
        float s2[4];
#pragma unroll
        for (int i = 0; i < 4; ++i) { const float* kr = p.cache_mem_k + ((size_t)bs * NMEM + lane + 64 * i) * 256 + hs * 64; float a = 0.f; for (int d = 0; d < 64; ++d) a += bf2f(qs[d]) * kr[d]; s2[i] = a; }
        const float mx2 = wmax64(fmaxf(fmaxf(s2[0], s2[1]), fmaxf(s2[2], s2[3])));
        float pe2[4], sum2 = 0.f;
#pragma unroll
        for (int i = 0; i < 4; ++i) { pe2[i] = __expf(s2[i] - mx2); sum2 += pe2[i]; }
        sum2 = wsum64(sum2);
        float err2 = 0.f, nrm2 = 0.f;
        for (int d = 0; d < 64; ++d) {
            float a = 0.f;
#pragma unroll
            for (int i = 0; i < 4; ++i) a += pe2[i] * p.cache_mem_v[((size_t)bs * NMEM + lane + 64 * i) * 256 + hs * 64 + d];
            a = wsum64(a) / sum2;
            const float want = a * bf2f(((const bf16_t*)(p.ws + W_MG))[rs * 256 + hs * 64 + d]);
            const float got = bf2f(((const bf16_t*)(p.ws + W_MIX))[rs * 1024 + 768 + hs * 64 + d]);
            err2 += (got - want) * (got - want); nrm2 += want * want;
        }
        if (lane == 0) { atomicAdd((unsigned*)(p.ws + CW_CHK + 12), 1u); if (!(err2 <= 0.0025f * nrm2 + 1e-12f)) atomicAdd((unsigned*)(p.ws + CW_CHK + 8), 1u); }
    }
}
#endif
__global__ void __launch_bounds__(NTHREADS, 2) hymba_fwd(Params p) {
    extern __shared__ __attribute__((aligned(16))) unsigned char lds_raw[];
    LAS3 unsigned char* lds = (LAS3 unsigned char*)lds_raw;
    volatile LAS3 unsigned* MISC = (volatile LAS3 unsigned*)(lds + LDS_MISC);
    const int tid = threadIdx.x;
    if (tid < 64) MISC[tid] = 0u;
    __syncthreads();
    const int lo = p.ph_lo, hi = p.ph_hi;
    TDECL;
    XcdBarrier bar; bar.bar = (unsigned*)p.ws; bar.x = 0; bar.st = MISC;
    if (hi > lo) bar = xcd_barrier_post((unsigned*)p.ws, MISC);
#define IN(k) (lo <= (k) && (k) <= hi)
#define SEAM(k) do { if (IN(k) && IN((k) + 1)) xcd_barrier(bar); } while (0)
    TBEG(0); if (IN(0)) p0_prologue(p, lds); TEND(0);
    TBEG(10); SEAM(0); TEND(10);
    TBEG(1); if (IN(1)) { phase1(p, lds); if (REP1 > 1) { xcd_barrier(bar); phase1(p, lds); } } TEND(1);
    TBEG(11); SEAM(1); TEND(11);
    TBEG(2); if (IN(2)) { phase2<0>(p, lds, MISC TPASS); } TEND(2);
    TBEG(12); SEAM(2); TEND(12);
#ifdef CHECK_ATT
    if (IN(3)) check_mem_attention(p);
#endif
    TBEG(3); if (IN(3)) { phase3(p, lds); if (REP3 > 1) { xcd_barrier(bar); phase3(p, lds); } } TEND(3);
    TBEG(13); SEAM(3); TEND(13);
    TBEG(4); if (IN(4)) p4_final(p); TEND(4);
#ifdef TSEL
    {
        if (tid == 0) { atomicAdd((unsigned long long*)(p.ws + CW_TSUM), (unsigned long long)tacc_); atomicMax((unsigned long long*)(p.ws + CW_TMAX), (unsigned long long)tacc_); }
        xcd_barrier(bar);
        if (blockIdx.x == 0 && tid == 0) {
#ifdef TMAX
            const unsigned long long dly = __hip_atomic_load((unsigned long long*)(p.ws + CW_TMAX), __ATOMIC_RELAXED, __HIP_MEMORY_SCOPE_AGENT);
#else
            const unsigned long long dly = __hip_atomic_load((unsigned long long*)(p.ws + CW_TSUM), __ATOMIC_RELAXED, __HIP_MEMORY_SCOPE_AGENT) / gridDim.x;
#endif
            const unsigned long long t0 = __builtin_amdgcn_s_memrealtime();
            while (__builtin_amdgcn_s_memrealtime() - t0 < dly && __builtin_amdgcn_s_memrealtime() - t0 < 400000ull) __builtin_amdgcn_s_sleep(8);
        }
    }
#endif
#ifdef CHECK_ATT
    {
        xcd_barrier(bar);
        const unsigned nbad = __hip_atomic_load((unsigned*)(p.ws + CW_CHK + 8), __ATOMIC_RELAXED, __HIP_MEMORY_SCOPE_AGENT);
        const unsigned nchk = __hip_atomic_load((unsigned*)(p.ws + CW_CHK + 12), __ATOMIC_RELAXED, __HIP_MEMORY_SCOPE_AGENT);
        if (nbad != 0u || nchk < 2170u) for (int i = blockIdx.x * NTHREADS + tid; i < NDB * DM; i += gridDim.x * NTHREADS) p.out[O_YS + i] = __builtin_nanf("");
    }
#endif
#ifdef CHECK_SEL
    {
        xcd_barrier(bar);
        const unsigned nbad = __hip_atomic_load((unsigned*)(p.ws + CW_CHK), __ATOMIC_RELAXED, __HIP_MEMORY_SCOPE_AGENT);
        const unsigned nhist = __hip_atomic_load((unsigned*)(p.ws + CW_CHK + 4), __ATOMIC_RELAXED, __HIP_MEMORY_SCOPE_AGENT);
        if (nbad != 0u || nhist < CHECK_MIN_HIST) for (int i = blockIdx.x * NTHREADS + tid; i < NDB * DM; i += gridDim.x * NTHREADS) p.out[O_YS + i] = __builtin_nanf("");
    }
#endif
#undef IN
#undef SEAM
}

#ifndef N_LAUNCHES
#define N_LAUNCHES 1
#endif
extern "C" void kernel_launch(void* const* d_in, const int* in_sizes, int n_in, void* d_out, int out_size, void* d_ws, size_t ws_size, hipStream_t stream) {
    static int grid = 0;
    if (grid == 0) {
        if (n_in != 19 || (size_t)out_size != O_END || ws_size < W_END) fprintf(stderr, "kernel_launch: unexpected sizes: n_in %d out %d ws %zu (need %zu)\n", n_in, out_size, ws_size, (size_t)W_END);
        int dev = 0, cus = 0, per_cu = 0;
        if (hipGetDevice(&dev) != hipSuccess || hipDeviceGetAttribute(&cus, hipDeviceAttributeMultiprocessorCount, dev) != hipSuccess) { fprintf(stderr, "kernel_launch: device query failed\n"); grid = -1; return; }
        if (hipFuncSetAttribute((const void*)hymba_fwd, hipFuncAttributeMaxDynamicSharedMemorySize, LDS_BYTES) != hipSuccess) { fprintf(stderr, "kernel_launch: hipFuncSetAttribute failed\n"); grid = -1; return; }
        if (hipOccupancyMaxActiveBlocksPerMultiprocessor(&per_cu, (const void*)hymba_fwd, NTHREADS, LDS_BYTES) != hipSuccess || per_cu < 1) fprintf(stderr, "kernel_launch: occupancy query reports %d blocks per CU\n", per_cu);
        (void)hipGetLastError();
        grid = cus;
    }
    if (grid < 0) return;
    (void)hipMemsetAsync(d_ws, 0, CTRL_BYTES, stream);
    Params p{};
    p.x_prompt = (const float*)d_in[0]; p.x_sample = (const float*)d_in[1]; p.mem_prompt = (const float*)d_in[2]; p.state_gla = (const float*)d_in[3];
    p.cache_k = (const float*)d_in[4]; p.cache_v = (const float*)d_in[5]; p.cache_ik = (const float*)d_in[6]; p.cache_mem_k = (const float*)d_in[7]; p.cache_mem_v = (const float*)d_in[8];
    p.page_table = (const int*)d_in[9];
    p.norm_in = (const float*)d_in[10]; p.w_in = (const float*)d_in[11]; p.w_g2 = (const float*)d_in[12]; p.b_g = (const float*)d_in[13]; p.onorm = (const float*)d_in[14];
    p.mem_norm = (const float*)d_in[15]; p.w_mem_kv = (const float*)d_in[16]; p.w_out = (const float*)d_in[17]; p.norm_final = (const float*)d_in[18];
    p.out = (float*)d_out; p.ws = (unsigned char*)d_ws;
#if N_LAUNCHES == 1
    p.ph_lo = 0; p.ph_hi = 4;
    hipLaunchKernelGGL(hymba_fwd, dim3(grid), dim3(NTHREADS), LDS_BYTES, stream, p);
#else
    for (int ph = 0; ph < 5; ++ph) { p.ph_lo = ph; p.ph_hi = ph; hipLaunchKernelGGL(hymba_fwd, dim3(grid), dim3(NTHREADS), LDS_BYTES, stream, p); }
#endif
    const hipError_t le = hipPeekAtLastError();
    if (le != hipSuccess) fprintf(stderr, "kernel_launch: launch failed: %s\n", hipGetErrorName(le));
}
```

```cpp
#include <hip/hip_runtime.h>
#include <cstdint>
#include <cstdio>
namespace pg8 {
#define PG8_LAS __attribute__((address_space(3)))
typedef unsigned short bf16_t;
typedef short bf16x8 __attribute__((ext_vector_type(8)));
typedef float f32x4 __attribute__((ext_vector_type(4)));
typedef unsigned u32x4 __attribute__((ext_vector_type(4)));
constexpr int BM = 256, BK = 64, HALF = 128, HTB = HALF * BK * 2  , STAGE_BYTES = 8 * HTB, NXCD = 8, WGM = 8;

__host__ __device__ __forceinline__ int lds_byte(int r, int c) { const int st = (r >> 4) * 2 + (c >> 5), rr = r & 15, cc = c & 31, ob = rr * 64 + cc * 2; return st * 1024 + (ob ^ (((ob >> 9) & 1) << 5)); }
__host__ __device__ __forceinline__ void stage_rc(int b, int& R, int& C) { const int st = b / 1024, sb = b % 1024, swz = sb ^ (((sb >> 9) & 1) << 5); R = (st >> 1) * 16 + swz / 64; C = (st & 1) * 32 + (swz % 64) / 2; }
__host__ __device__ __forceinline__ int perm32(int rho) { const int n = rho >> 4, i = rho & 15; return 8 * (i >> 2) + 4 * n + (i & 3); }

struct Unit { int pm, pn; };
struct Gemm { const bf16_t* A; const bf16_t* Bt; int M, N, K; };

struct StaticOrder {
    int nM, nN, nwg, G, c;
    __host__ __device__ void init(int M, int N, int G_, int c_) { nM = M / BM; nN = N / BM; nwg = nM * nN; G = G_; c = c_; }
    __host__ __device__ bool next(int i, Unit& u) const {
        const long L = (long)i * G + c; if (L >= nwg) return false;
        int wgid = (int)L; { const int q = nwg / NXCD, r = nwg % NXCD, xcd = wgid % NXCD, off = wgid / NXCD; wgid = (xcd < r ? xcd * (q + 1) : r * (q + 1) + (xcd - r) * q) + off; }
        const int nig = WGM * nN, gid = wgid / nig, fm = gid * WGM, gsz = (nM - fm) < WGM ? (nM - fm) : WGM;
        u.pm = fm + ((wgid % nig) % gsz); u.pn = (wgid % nig) / gsz; return true;
    }
    __device__ __forceinline__ void a_ready(const Unit&) const {}
    __device__ __forceinline__ void done(const Unit&) const {}
};

template <class Epi, class Sched, bool ALIGN_EPI = false, bool SP2 = false>
__device__ __forceinline__ void gemm_phase(PG8_LAS unsigned char* lds, const Gemm g, const Sched& S, const Epi& E) {
    const int tid = threadIdx.x, wid = __builtin_amdgcn_readfirstlane(tid >> 6), lane = tid & 63, wr = wid >> 2, wc = wid & 3, fr = lane & 15, fq = lane >> 4;
    const int K = g.K, nt = K / BK;
    unsigned voffA[2], voffB[2];
#pragma unroll
    for (int i = 0; i < 2; ++i) { int R, C; stage_rc(tid * 16 + i * 8192, R, C); const int Rb = Epi::PERM ? ((R & ~31) + perm32(R & 31)) : R;
        voffA[i] = (unsigned)(R * K + C) * 2u; voffB[i] = (unsigned)(Rb * K + C) * 2u; }
    const size_t kstep = (size_t)(BK * 2);
    const size_t hstep = (size_t)HALF * K * 2;
    const size_t tstep = 2 * hstep;
    const unsigned ldsw = (unsigned)wid * 1024u;
    const int aoff = lds_byte(wr * 64 + fr, fq * 8), boff = lds_byte(wc * 32 + fr, fq * 8);
#define PG8_SA(b, h) (((b) * 2 + (h)) * HTB)
#define PG8_SB(b, h) ((4 + (b) * 2 + (h)) * HTB)
#define PG8_STAGE(bufoff, gbase, voff) do { _Pragma("unroll") for (int _i = 0; _i < 2; ++_i) \
        __builtin_amdgcn_global_load_lds((const unsigned*)((const char*)(gbase) + (voff)[_i]), (PG8_LAS unsigned*)(lds + (bufoff) + ldsw + _i * 8192), 16, 0, 0); } while (0)
#define PG8_LDA(dst, b, h) do { _Pragma("unroll") for (int m = 0; m < 4; ++m) _Pragma("unroll") for (int k = 0; k < 2; ++k) dst[m][k] = *(const PG8_LAS bf16x8*)(lds + PG8_SA(b, h) + aoff + m * 2048 + k * 1024); } while (0)
#define PG8_LDB(dst, b, h) do { _Pragma("unroll") for (int n = 0; n < 2; ++n) _Pragma("unroll") for (int k = 0; k < 2; ++k) dst[n][k] = *(const PG8_LAS bf16x8*)(lds + PG8_SB(b, h) + boff + n * 2048 + k * 1024); } while (0)
#define PG8_MMA(ai, bj, At, Bt) do { __builtin_amdgcn_s_setprio(1); _Pragma("unroll") for (int m = 0; m < 4; ++m) _Pragma("unroll") for (int n = 0; n < 2; ++n) _Pragma("unroll") for (int k = 0; k < 2; ++k) \
        acc[ai][bj][m][n] = __builtin_amdgcn_mfma_f32_16x16x32_bf16(Bt[n][k], At[m][k], acc[ai][bj][m][n], 0, 0, 0); __builtin_amdgcn_s_setprio(0); } while (0)
#define PG8_WAIT_V(n) asm volatile("s_waitcnt vmcnt(" #n ")" ::: "memory")
#define PG8_WAIT_L(n) asm volatile("s_waitcnt lgkmcnt(" #n ")" ::: "memory")
#define PG8_BAR __builtin_amdgcn_s_barrier()
#define PG8_SCHED __builtin_amdgcn_sched_barrier(0)
    Unit cur, nxt; int ui = 0;
    if (!S.next(0, cur)) return;
    f32x4 acc[2][2][4][2];
#pragma unroll
    for (int a = 0; a < 2; ++a)
#pragma unroll
        for (int b = 0; b < 2; ++b)
#pragma unroll
            for (int m = 0; m < 4; ++m)
#pragma unroll
                for (int n = 0; n < 2; ++n) acc[a][b][m][n] = (f32x4){0.f, 0.f, 0.f, 0.f};
    bf16x8 At[4][2], B0[2][2], B1[2][2];
    const char* cA = (const char*)g.A + (size_t)cur.pm * tstep; const char* cB = (const char*)g.Bt + (size_t)cur.pn * tstep;
    S.a_ready(cur);
    if constexpr (SP2) {
        PG8_STAGE(PG8_SB(0, 0), cB, voffB); PG8_STAGE(PG8_SB(0, 1), cB + hstep, voffB); PG8_STAGE(PG8_SA(0, 0), cA, voffA); PG8_STAGE(PG8_SA(0, 1), cA + hstep, voffA);
        if (wr == 1) PG8_BAR;
        PG8_WAIT_V(2); PG8_BAR;
        PG8_STAGE(PG8_SB(1, 0), cB + kstep, voffB); PG8_STAGE(PG8_SA(1, 0), cA + kstep, voffA); PG8_STAGE(PG8_SB(1, 1), cB + hstep + kstep, voffB);
        PG8_WAIT_V(6); PG8_BAR;
    } else {
        PG8_STAGE(PG8_SB(0, 0), cB, voffB); PG8_STAGE(PG8_SA(0, 0), cA, voffA); PG8_STAGE(PG8_SB(0, 1), cB + hstep, voffB); PG8_STAGE(PG8_SA(0, 1), cA + hstep, voffA);
        if (wr == 1) PG8_BAR;
        PG8_WAIT_V(4); PG8_BAR;
        PG8_STAGE(PG8_SB(1, 0), cB + kstep, voffB); PG8_STAGE(PG8_SA(1, 0), cA + kstep, voffA); PG8_STAGE(PG8_SB(1, 1), cB + hstep + kstep, voffB);
        PG8_WAIT_V(6); PG8_BAR;
    }
    for (;;) {
        const bool has_next = S.next(ui + 1, nxt);
        const char* nA = has_next ? (const char*)g.A + (size_t)nxt.pm * tstep : cA; const char* nB = has_next ? (const char*)g.Bt + (size_t)nxt.pn * tstep : cB;
        for (int t = 0; t < nt; t += 2) {
            const bool last = (t == nt - 2);
            const char* a1 = cA + (size_t)(t + 1) * kstep;
            const char* a2 = last ? nA : cA + (size_t)(t + 2) * kstep; const char* b2 = last ? nB : cB + (size_t)(t + 2) * kstep;
            const char* a3 = a2 + kstep; const char* b3 = b2 + kstep;
            if (last && has_next) S.a_ready(nxt);
            if constexpr (SP2) {
            PG8_LDB(B0, 0, 0); PG8_LDB(B1, 0, 1); PG8_SCHED; PG8_LDA(At, 0, 0); PG8_STAGE(PG8_SA(1, 1), a1 + hstep, voffA);
            PG8_WAIT_V(8); PG8_WAIT_L(0); PG8_BAR; PG8_MMA(0, 0, At, B0); PG8_MMA(0, 1, At, B1); PG8_BAR; PG8_SCHED;
            PG8_LDA(At, 0, 1); PG8_STAGE(PG8_SB(0, 0), b2, voffB); PG8_STAGE(PG8_SB(0, 1), b2 + hstep, voffB); PG8_STAGE(PG8_SA(0, 0), a2, voffA);
            PG8_WAIT_V(8); PG8_WAIT_L(0); PG8_BAR; PG8_MMA(1, 0, At, B0); PG8_MMA(1, 1, At, B1); PG8_BAR; PG8_SCHED;
            PG8_LDB(B0, 1, 0); PG8_LDB(B1, 1, 1); PG8_SCHED; PG8_LDA(At, 1, 0); PG8_STAGE(PG8_SA(0, 1), a2 + hstep, voffA);
            PG8_WAIT_V(8); PG8_WAIT_L(0); PG8_BAR; PG8_MMA(0, 0, At, B0); PG8_MMA(0, 1, At, B1); PG8_BAR; PG8_SCHED;
            PG8_LDA(At, 1, 1); PG8_STAGE(PG8_SB(1, 0), b3, voffB); PG8_STAGE(PG8_SB(1, 1), b3 + hstep, voffB); PG8_STAGE(PG8_SA(1, 0), a3, voffA);
            PG8_WAIT_V(8); PG8_WAIT_L(0); PG8_BAR; PG8_MMA(1, 0, At, B0); PG8_MMA(1, 1, At, B1); PG8_BAR; PG8_SCHED;
            } else {
            PG8_LDB(B0, 0, 0); PG8_SCHED; PG8_LDA(At, 0, 0); PG8_STAGE(PG8_SA(1, 1), a1 + hstep, voffA);
            PG8_WAIT_L(8); PG8_BAR; PG8_WAIT_L(0); PG8_MMA(0, 0, At, B0); PG8_BAR; PG8_SCHED;
            PG8_LDB(B1, 0, 1); PG8_STAGE(PG8_SB(0, 0), b2, voffB);
            PG8_BAR; PG8_WAIT_L(0); PG8_MMA(0, 1, At, B1); PG8_BAR;
            PG8_LDA(At, 0, 1); PG8_STAGE(PG8_SA(0, 0), a2, voffA);
            PG8_BAR; PG8_WAIT_L(0); PG8_MMA(1, 0, At, B0); PG8_BAR; PG8_SCHED;
            PG8_STAGE(PG8_SB(0, 1), b2 + hstep, voffB);
            PG8_WAIT_V(6); PG8_BAR; PG8_MMA(1, 1, At, B1); PG8_BAR;
            PG8_LDB(B0, 1, 0); PG8_SCHED; PG8_LDA(At, 1, 0); PG8_STAGE(PG8_SA(0, 1), a2 + hstep, voffA);
            PG8_WAIT_L(8); PG8_BAR; PG8_WAIT_L(0); PG8_MMA(0, 0, At, B0); PG8_BAR; PG8_SCHED;
            PG8_LDB(B1, 1, 1); PG8_STAGE(PG8_SB(1, 0), b3, voffB);
            PG8_BAR; PG8_WAIT_L(0); PG8_MMA(0, 1, At, B1); PG8_BAR;
            PG8_LDA(At, 1, 1); PG8_STAGE(PG8_SA(1, 0), a3, voffA);
            PG8_BAR; PG8_WAIT_L(0); PG8_MMA(1, 0, At, B0); PG8_BAR; PG8_SCHED;
            PG8_STAGE(PG8_SB(1, 1), b3 + hstep, voffB);
            PG8_WAIT_V(6); PG8_BAR; PG8_MMA(1, 1, At, B1); PG8_BAR;
            }
        }
        if constexpr (ALIGN_EPI) { if (wr == 0) PG8_BAR; }
        if constexpr (!Epi::AFTER_DRAIN) { E(acc, cur, wr, wc, fr, fq); S.done(cur); }
        if (!has_next) break;
#pragma unroll
        for (int a = 0; a < 2; ++a)
#pragma unroll
            for (int b = 0; b < 2; ++b)
#pragma unroll
                for (int m = 0; m < 4; ++m)
#pragma unroll
                    for (int n = 0; n < 2; ++n) acc[a][b][m][n] = (f32x4){0.f, 0.f, 0.f, 0.f};
        cur = nxt; cA = nA; cB = nB; ++ui;
        if constexpr (ALIGN_EPI) { if (wr == 1) PG8_BAR; }
    }
    PG8_WAIT_V(0);
    if constexpr (!ALIGN_EPI) { if (wr == 0) PG8_BAR; }
    PG8_BAR;
    if constexpr (Epi::AFTER_DRAIN) { E.fused(acc, cur, wr, wc, fr, fq, lds, wid, lane); S.done(cur); }
#undef PG8_SA
#undef PG8_SB
#undef PG8_STAGE
#undef PG8_LDA
#undef PG8_LDB
#undef PG8_MMA
#undef PG8_WAIT_V
#undef PG8_WAIT_L
#undef PG8_BAR
#undef PG8_SCHED
}
}
#define XB_TMO      128
#define XB_XCNT(j)  (256  + 64 * (j))
#define XB_XSUB(j)  (1280 + 64 * (j))
#define XB_XGEN(j)  (2304 + 64 * (j))
#define XB_TOP      3328
#define XB_TOPGEN   3392
#define XCD_BAR_WORDS 3456
#define XB_SPIN_CAP (1u << 18)
#define LAS __attribute__((address_space(3)))

__device__ __forceinline__ unsigned xb_ld(unsigned* p)              { return __hip_atomic_load(p, __ATOMIC_RELAXED, __HIP_MEMORY_SCOPE_AGENT); }
__device__ __forceinline__ unsigned xb_add(unsigned* p, unsigned v) { return __hip_atomic_fetch_add(p, v, __ATOMIC_RELAXED, __HIP_MEMORY_SCOPE_AGENT); }
__device__ __forceinline__ unsigned xb_xcc_id() { return (unsigned)__builtin_amdgcn_s_getreg((3 << 11) | 20) & 0xFu; }
#define XB_SPIN(cond, bar) do { unsigned _sp = 0; while (cond) { __builtin_amdgcn_s_sleep(1); \
    if ((++_sp & 255u) == 0u) { if (xb_ld(&(bar)[XB_TMO])) break; if (_sp > XB_SPIN_CAP) { atomicAdd(&(bar)[XB_TMO], 1u); break; } } } } while (0)

struct XcdBarrier {
    unsigned* bar; unsigned x;
    volatile LAS unsigned* st;
};

__device__ __forceinline__ XcdBarrier xcd_barrier_post(unsigned* bar, volatile LAS unsigned* st) {
    XcdBarrier b; b.bar = bar; b.x = xb_xcc_id(); b.st = st;
    if (threadIdx.x == 0) (void)xb_add(&bar[XB_XCNT(b.x)], 1u);
    return b;
}
__device__ __forceinline__ void xcd_barrier_complete(unsigned* bar, unsigned x, unsigned& nloc, unsigned& nx) {
    const unsigned G = gridDim.x * gridDim.y * gridDim.z;
    unsigned sum, cnt, mine, sp = 0u;
    for (;;) {
        sum = 0u; cnt = 0u; mine = 0u;
#pragma unroll
        for (unsigned j = 0; j < 16; ++j) { const unsigned c = xb_ld(&bar[XB_XCNT(j)]); sum += c; cnt += (c > 0u) ? 1u : 0u; mine = (j == x) ? c : mine; }
        if (sum == G) break;
        __builtin_amdgcn_s_sleep(1);
        if ((++sp & 255u) == 0u) { if (xb_ld(&bar[XB_TMO])) break; if (sp > XB_SPIN_CAP) { atomicAdd(&bar[XB_TMO], 1u); break; } }
    }
    nloc = mine > 0u ? mine : 1u; nx = cnt > 0u ? cnt : 1u;
}

__device__ __forceinline__ void xcd_barrier(const XcdBarrier& b) {
    asm volatile("s_waitcnt vmcnt(0)" ::: "memory");
    __syncthreads();
    if (threadIdx.x == 0) {
        unsigned* bar = b.bar;
        __builtin_amdgcn_s_waitcnt(0);
        unsigned nloc = b.st[0], nx = b.st[1];
        if (nloc == 0u) { xcd_barrier_complete(bar, b.x, nloc, nx); b.st[0] = nloc; b.st[1] = nx; }
        const unsigned old = xb_add(&bar[XB_XSUB(b.x)], 1u);
        const unsigned gen = old / nloc;
        if (old + 1u == (gen + 1u) * nloc) {
            __builtin_amdgcn_fence(__ATOMIC_RELEASE, "agent");
            asm volatile("s_waitcnt vmcnt(0)" ::: "memory");
            const unsigned og = xb_add(&bar[XB_TOP], 1u);
            const unsigned tg = og / nx;
            if (og + 1u == (tg + 1u) * nx) xb_add(&bar[XB_TOPGEN], 1u);
            else XB_SPIN(xb_ld(&bar[XB_TOPGEN]) == tg, bar);
            __builtin_amdgcn_fence(__ATOMIC_ACQUIRE, "agent");
            xb_add(&bar[XB_XGEN(b.x)], 1u);
            asm volatile("s_waitcnt vmcnt(0)" ::: "memory");
        } else {
            XB_SPIN(xb_ld(&bar[XB_XGEN(b.x)]) == gen, bar);
            __builtin_amdgcn_fence(__ATOMIC_ACQUIRE, "agent");
            asm volatile("s_waitcnt vmcnt(0)" ::: "memory");
        }
    }
    __syncthreads();
}
#define DI __device__ __forceinline__
#define LAS3 __attribute__((address_space(3)))
using pg8::bf16_t; using pg8::bf16x8; using pg8::f32x4; using pg8::u32x4;
typedef unsigned u32x2 __attribute__((ext_vector_type(2)));
typedef short s16x4 __attribute__((ext_vector_type(4)));
typedef float f32x2 __attribute__((ext_vector_type(2)));
typedef __bf16 bf16x2_t __attribute__((ext_vector_type(2)));

constexpr int DM = 1024, NB = 16, SEQ = 2048, MP = NB * SEQ  , NDB = 32  , MROWS = 33024  ;
constexpr int NMEM = 256, MMEM = NB * NMEM  , DIN = 3412, NIN = 3584, NPAGES = 128;
constexpr int NTHREADS = 512;
constexpr size_t O_YP = 0, O_YS = O_YP + (size_t)MP * DM, O_GSP = O_YS + (size_t)NDB * DM, O_KP = O_GSP + (size_t)NB * 4 * 64 * 128,
                 O_VP = O_KP + (size_t)MP * 256, O_IKP = O_VP + (size_t)MP * 256, O_MKP = O_IKP + (size_t)MP * 64, O_MVP = O_MKP + (size_t)MMEM * 256,
                 O_GSS = O_MVP + (size_t)MMEM * 256, O_KS = O_GSS + (size_t)NDB * 4 * 64 * 128, O_VS = O_KS + (size_t)NDB * 256, O_IKS = O_VS + (size_t)NDB * 256,
                 O_END = O_IKS + (size_t)NDB * 64;
static_assert(O_END == 56150016, "output size");
constexpr size_t al256(size_t x) { return (x + 255) & ~(size_t)255; }
constexpr size_t CTRL_BYTES = 32768;
constexpr size_t CW_QDSA = 16384  , CW_QMEM = 18432  , CW_SCNT = 20480, CW_TMO = 20736, CW_CHK = 20992, CW_TSUM = 21248, CW_TMAX = 21504, CW_MEMC = 21760;
constexpr int SCLD = 16400;
constexpr size_t W_ROPE = CTRL_BYTES;
constexpr size_t W_XN = al256(W_ROPE + (size_t)2049 * 32 * 8);
constexpr size_t W_MEMN = W_XN + (size_t)MROWS * 1024 * 2;
constexpr size_t W_WTIN = W_MEMN + (size_t)MMEM * 1024 * 2;
constexpr size_t W_WTMEM = W_WTIN + (size_t)NIN * 1024 * 2;
constexpr size_t W_WTOUT = W_WTMEM + (size_t)512 * 1024 * 2;
constexpr size_t W_GQ = W_WTOUT + (size_t)1024 * 1024 * 2;
constexpr size_t W_GK = W_GQ + (size_t)MROWS * 256 * 2;
constexpr size_t W_GV = W_GK + (size_t)MROWS * 256 * 2;
constexpr size_t W_GG = W_GV + (size_t)MROWS * 512 * 2;
constexpr size_t W_DQ = W_GG + (size_t)MROWS * 512 * 2;
constexpr size_t W_DK = W_DQ + (size_t)MROWS * 256 * 2;
constexpr size_t W_DVT = W_DK + (size_t)MROWS * 256 * 2;
constexpr size_t W_IQ = W_DVT + (size_t)MP * 256 * 2;
constexpr size_t W_DG = W_IQ + (size_t)MROWS * 256 * 2;
constexpr size_t W_MQ = W_DG + (size_t)MROWS * 256 * 2;
constexpr size_t W_MG = W_MQ + (size_t)MROWS * 256 * 2;
constexpr size_t W_IK = W_MG + (size_t)MROWS * 256 * 2;
constexpr size_t W_IW = W_IK + (size_t)MROWS * 64 * 2;
constexpr size_t W_GLR = W_IW + (size_t)MROWS * 4 * 4;
constexpr size_t W_MK = W_GLR + (size_t)MROWS * 16 * 4;
constexpr size_t W_MVT = W_MK + (size_t)MMEM * 256 * 2;
constexpr size_t W_MIX = W_MVT + (size_t)MMEM * 256 * 2;
constexpr size_t W_SC = W_MIX + (size_t)MROWS * 1024 * 2;
constexpr size_t W_END = W_SC + (size_t)NDB * SCLD * 4;
constexpr int LDS_MISC = 148480, LDS_BYTES = 148480 + 256;

struct Params {
    const float *x_prompt, *x_sample, *mem_prompt, *state_gla, *cache_k, *cache_v, *cache_ik, *cache_mem_k, *cache_mem_v;
    const int* page_table;
    const float *norm_in, *w_in, *w_g2, *b_g, *onorm, *mem_norm, *w_mem_kv, *w_out, *norm_final;
    float* out; unsigned char* ws; int ph_lo, ph_hi;
};

#ifdef TSEL
#define TDECL unsigned tacc_ = 0u, tbeg_ = 0u
#define TBEG(k) do { if ((k) == TSEL) tbeg_ = (unsigned)__builtin_amdgcn_s_memrealtime(); } while (0)
#define TEND(k) do { if ((k) == TSEL) tacc_ += (unsigned)__builtin_amdgcn_s_memrealtime() - tbeg_; } while (0)
#define TARGS , unsigned& tacc_, unsigned& tbeg_
#define TPASS , tacc_, tbeg_
#else
#define TARGS
#define TPASS
#define TDECL do {} while (0)
#define TBEG(k) do {} while (0)
#define TEND(k) do {} while (0)
#endif
DI float bf2f(bf16_t v) { return __uint_as_float((unsigned)v << 16); }
DI unsigned cvtpk(float lo, float hi) { f32x2 v = {lo, hi}; bf16x2_t b = __builtin_convertvector(v, bf16x2_t); return __builtin_bit_cast(unsigned, b); }
DI bf16_t f2bf(float x) { return (bf16_t)(cvtpk(x, 0.f) & 0xffffu); }
DI f32x4 mfma16(bf16x8 a, bf16x8 b, f32x4 c) { return __builtin_amdgcn_mfma_f32_16x16x32_bf16(a, b, c, 0, 0, 0); }
DI float fexp(float x) { return __builtin_amdgcn_exp2f(x * 1.4426950408889634f); }
DI float siluf(float x) { return x * __builtin_amdgcn_rcpf(1.f + fexp(-x)); }
DI float logsigf(float u) { return fminf(u, 0.f) - 0.6931471805599453f * __builtin_amdgcn_logf(1.f + fexp(-fabsf(u))); }
DI unsigned fkey(float x) { unsigned u = __float_as_uint(x); u = (u == 0x80000000u) ? 0u : u; return u ^ ((unsigned)((int)u >> 31) | 0x80000000u); }
DI float wsum64(float v) { v += __shfl_xor(v, 1); v += __shfl_xor(v, 2); v += __shfl_xor(v, 4); v += __shfl_xor(v, 8); v += __shfl_xor(v, 16); v += __shfl_xor(v, 32); return v; }
DI float wmax64(float v) { v = fmaxf(v, __shfl_xor(v, 1)); v = fmaxf(v, __shfl_xor(v, 2)); v = fmaxf(v, __shfl_xor(v, 4)); v = fmaxf(v, __shfl_xor(v, 8)); v = fmaxf(v, __shfl_xor(v, 16)); v = fmaxf(v, __shfl_xor(v, 32)); return v; }
DI unsigned lds_add(LAS3 unsigned* p, unsigned v) { return __hip_atomic_fetch_add(p, v, __ATOMIC_RELAXED, __HIP_MEMORY_SCOPE_WORKGROUP); }
DI unsigned lds_or(LAS3 unsigned* p, unsigned v) { return __hip_atomic_fetch_or(p, v, __ATOMIC_RELAXED, __HIP_MEMORY_SCOPE_WORKGROUP); }
DI void st_bf16x4(bf16_t* p, f32x4 v) { u32x2 w; w.x = cvtpk(v[0], v[1]); w.y = cvtpk(v[2], v[3]); *(u32x2*)p = w; }
DI const float* vaddr(const float* q) { asm volatile("" : "+v"(q)); return q; }
constexpr float LOG2E = 1.4426950408889634f;
#define NEG_INF (-__builtin_inff())

DI int rope_perm(int vc) { return 64 * (vc >> 6) + 16 * ((vc >> 5) & 1) + (vc & 15) + 32 * ((vc >> 4) & 1); }
DI int rope_map(int vc) { return 64 * ((vc >> 5) & 3) + 32 * ((vc >> 4) & 1) + 8 * ((vc >> 2) & 3) + 4 * (vc >> 7) + (vc & 3); }
DI int plain_map(int vc) { return (vc & ~31) + 8 * ((vc >> 2) & 3) + 4 * ((vc >> 4) & 1) + (vc & 3); }
DI int in_src(int np) {
    const int pn = np >> 8, vc = np & 255;
    switch (pn) {
        case 0: return plain_map(vc);
        case 1: return 256 + plain_map(vc);
        case 2: case 3: return 512 + 256 * (pn - 2) + plain_map(vc);
        case 4: case 5: return 1040 + 256 * (pn - 4) + plain_map(vc);
        case 6: return 1552 + rope_map(vc);
        case 7: return 1808 + rope_map(vc);
        case 8: return 2064 + plain_map(vc);
        case 9: return 2320 + rope_map(vc);
        case 10: return 2644 + plain_map(vc);
        case 11: return 2900 + plain_map(vc);
        case 12: return 3156 + plain_map(vc);
        default: break;
    }
    if (vc < 64) return 2576 + rope_perm(vc);
    if (vc < 68) return 2640 + (vc - 64);
    if (vc < 84) return 1024 + (vc - 68);
    return -1;
}

struct EpiIn {
    static constexpr bool PERM = false, AFTER_DRAIN = false;
    unsigned char* ws; float* out;
    DI void operator()(const f32x4 (&acc)[2][2][4][2], const pg8::Unit& u, int wr, int wc, int fr, int fq) const {
        const int pn = u.pn, rbase = u.pm * 256 + wr * 64 + fr;
        if (pn <= 5 || (pn >= 10 && pn <= 12)) {
            bf16_t* dst; int ldc = 256, coff = 0; float sc = 1.f; bool silu = false;
            switch (pn) {
                case 0: dst = (bf16_t*)(ws + W_GQ); sc = 0.125f; break;
                case 1: dst = (bf16_t*)(ws + W_GK); break;
                case 2: dst = (bf16_t*)(ws + W_GV); ldc = 512; break;
                case 3: dst = (bf16_t*)(ws + W_GV); ldc = 512; coff = 256; break;
                case 4: dst = (bf16_t*)(ws + W_GG); ldc = 512; silu = true; break;
                case 5: dst = (bf16_t*)(ws + W_GG); ldc = 512; coff = 256; silu = true; break;
                case 10: dst = (bf16_t*)(ws + W_DG); silu = true; break;
                case 11: dst = (bf16_t*)(ws + W_MQ); sc = 0.125f * LOG2E; break;
                default: dst = (bf16_t*)(ws + W_MG); silu = true; break;
            }
#pragma unroll
            for (int ai = 0; ai < 2; ++ai)
#pragma unroll
                for (int m = 0; m < 4; ++m) {
                    const int row = rbase + ai * 128 + m * 16;
                    bf16_t* rp = dst + (size_t)row * ldc + coff + wc * 32 + 8 * fq;
#pragma unroll
                    for (int bj = 0; bj < 2; ++bj) {
                        f32x4 v0 = acc[ai][bj][m][0], v1 = acc[ai][bj][m][1];
                        if (silu) { v0[0] = siluf(v0[0]); v0[1] = siluf(v0[1]); v0[2] = siluf(v0[2]); v0[3] = siluf(v0[3]); v1[0] = siluf(v1[0]); v1[1] = siluf(v1[1]); v1[2] = siluf(v1[2]); v1[3] = siluf(v1[3]); }
                        else { v0 = v0 * sc; v1 = v1 * sc; }
                        u32x4 w; w.x = cvtpk(v0[0], v0[1]); w.y = cvtpk(v0[2], v0[3]); w.z = cvtpk(v1[0], v1[1]); w.w = cvtpk(v1[2], v1[3]);
                        *(u32x4*)(rp + bj * 128) = w;
                    }
                }
        } else if (pn == 6 || pn == 7 || pn == 9) {
            bf16_t* dst = (bf16_t*)(ws + (pn == 6 ? W_DQ : (pn == 7 ? W_DK : W_IQ)));
            const float sc = (pn == 6) ? 0.125f * LOG2E : 1.f;
            const float* rope = (const float*)(ws + W_ROPE);
#pragma unroll
            for (int ai = 0; ai < 2; ++ai)
#pragma unroll
                for (int m = 0; m < 4; ++m) {
                    const int row = rbase + ai * 128 + m * 16;
                    const int pi = row < MP ? (row & 2047) : 2048;
                    const float* rp = rope + ((size_t)pi * 32 + 8 * fq) * 2;
                    f32x4 o1[2], o2[2];
#pragma unroll
                    for (int bj = 0; bj < 2; ++bj) {
                        const f32x4 cs0 = *(const f32x4*)(rp + 8 * bj), cs1 = *(const f32x4*)(rp + 8 * bj + 4);
                        const f32x4 c = {cs0[0], cs0[2], cs1[0], cs1[2]}, s = {cs0[1], cs0[3], cs1[1], cs1[3]};
                        const f32x4 v0 = acc[ai][bj][m][0], v1 = acc[ai][bj][m][1];
                        o1[bj] = (v0 * c - v1 * s) * sc; o2[bj] = (v1 * c + v0 * s) * sc;
                    }
                    const int col1 = 64 * wc + 8 * fq, col2 = col1 + 32;
                    u32x4 w1, w2; w1.x = cvtpk(o1[0][0], o1[0][1]); w1.y = cvtpk(o1[0][2], o1[0][3]); w1.z = cvtpk(o1[1][0], o1[1][1]); w1.w = cvtpk(o1[1][2], o1[1][3]);
                    w2.x = cvtpk(o2[0][0], o2[0][1]); w2.y = cvtpk(o2[0][2], o2[0][3]); w2.z = cvtpk(o2[1][0], o2[1][1]); w2.w = cvtpk(o2[1][2], o2[1][3]);
                    *(u32x4*)(dst + (size_t)row * 256 + col1) = w1; *(u32x4*)(dst + (size_t)row * 256 + col2) = w2;
                    if (pn == 7) {
                        float* op = nullptr;
                        if (row < MP) op = out + O_KP + (size_t)row * 256; else if (row < MP + NDB) op = out + O_KS + (size_t)(row - MP) * 256;
                        if (op) { *(f32x4*)(op + col1) = o1[0]; *(f32x4*)(op + col1 + 4) = o1[1]; *(f32x4*)(op + col2) = o2[0]; *(f32x4*)(op + col2 + 4) = o2[1]; }
                    }
                }
        } else if (pn == 8) {
            bf16_t* dvt = (bf16_t*)(ws + W_DVT);
#pragma unroll
            for (int ai = 0; ai < 2; ++ai)
#pragma unroll
                for (int m = 0; m < 4; ++m) {
                    const int row = rbase + ai * 128 + m * 16;
                    float* op = nullptr;
                    if (row < MP) op = out + O_VP + (size_t)row * 256; else if (row < MP + NDB) op = out + O_VS + (size_t)(row - MP) * 256;
#pragma unroll
                    for (int bj = 0; bj < 2; ++bj)
#pragma unroll
                        for (int n = 0; n < 2; ++n) {
                            const f32x4 v = acc[ai][bj][m][n];
                            const int col = 128 * bj + 32 * wc + 8 * fq + 4 * n;
                            if (op) *(f32x4*)(op + col) = v;
                            if (row < MP) {
                                const int t_ = row & 2047, kk_ = t_ & 31;
                                bf16_t* tp = dvt + ((((size_t)(row >> 11) * 64 + (t_ >> 5)) * 4 + (col >> 6)) * 64 + (col & 63)) * 32 + 8 * ((kk_ >> 2) & 3) + 4 * (kk_ >> 4) + (kk_ & 3);
                                tp[0] = f2bf(v[0]); tp[32] = f2bf(v[1]); tp[64] = f2bf(v[2]); tp[96] = f2bf(v[3]);
                            }
                        }
                }
        } else {
            bf16_t* ikb = (bf16_t*)(ws + W_IK); float* iw = (float*)(ws + W_IW); float* glr = (float*)(ws + W_GLR);
            const float* rope = (const float*)(ws + W_ROPE);
#pragma unroll
            for (int ai = 0; ai < 2; ++ai)
#pragma unroll
                for (int m = 0; m < 4; ++m) {
                    const int row = rbase + ai * 128 + m * 16;
                    const f32x4 v0 = acc[ai][0][m][0], v1 = acc[ai][0][m][1];
                    if (wc < 2) {
                        const int pi = row < MP ? (row & 2047) : 2048;
                        const int f0 = 16 * wc + 4 * fq;
                        const f32x4 cs0 = *(const f32x4*)(rope + ((size_t)pi * 32 + f0) * 2), cs1 = *(const f32x4*)(rope + ((size_t)pi * 32 + f0) * 2 + 4);
                        const f32x4 c = {cs0[0], cs0[2], cs1[0], cs1[2]}, s = {cs0[1], cs0[3], cs1[1], cs1[3]};
                        const f32x4 o1 = v0 * c - v1 * s, o2 = v1 * c + v0 * s;
                        st_bf16x4(ikb + (size_t)row * 64 + f0, o1); st_bf16x4(ikb + (size_t)row * 64 + f0 + 32, o2);
                        float* op = nullptr;
                        if (row < MP) op = out + O_IKP + (size_t)row * 64; else if (row < MP + NDB) op = out + O_IKS + (size_t)(row - MP) * 64;
                        if (op) { *(f32x4*)(op + f0) = o1; *(f32x4*)(op + f0 + 32) = o2; }
                    } else if (wc == 2) {
                        if (fq == 0) { *(f32x4*)(iw + (size_t)row * 4) = v0 * 0.5f; *(f32x4*)(glr + (size_t)row * 16 + 12) = v1; }
                        else *(f32x4*)(glr + (size_t)row * 16 + 4 * (fq - 1)) = v0;
                    }
                }
        }
    }
};
struct EpiMem {
    static constexpr bool PERM = false, AFTER_DRAIN = false;
    unsigned char* ws; float* out;
    DI void operator()(const f32x4 (&acc)[2][2][4][2], const pg8::Unit& u, int wr, int wc, int fr, int fq) const {
        const int pn = u.pn, rbase = u.pm * 256 + wr * 64 + fr;
        bf16_t* mk = (bf16_t*)(ws + W_MK); bf16_t* mvt = (bf16_t*)(ws + W_MVT);
        float* op0 = out + (pn == 0 ? O_MKP : O_MVP);
#pragma unroll
        for (int ai = 0; ai < 2; ++ai)
#pragma unroll
            for (int m = 0; m < 4; ++m) {
                const int row = rbase + ai * 128 + m * 16;
#pragma unroll
                for (int bj = 0; bj < 2; ++bj)
#pragma unroll
                    for (int n = 0; n < 2; ++n) {
                        const f32x4 v = acc[ai][bj][m][n];
                        const int col = 128 * bj + 32 * wc + 16 * n + 4 * fq;
                        *(f32x4*)(op0 + (size_t)row * 256 + col) = v;
                        if (pn == 0) st_bf16x4(mk + (size_t)row * 256 + col, v);
                        else { const int m_ = row & 255, kk_ = m_ & 31;
                               bf16_t* tp = mvt + ((((size_t)(row >> 8) * 8 + (m_ >> 5)) * 4 + (col >> 6)) * 64 + (col & 63)) * 32 + 8 * ((kk_ >> 2) & 3) + 4 * (kk_ >> 4) + (kk_ & 3);
                               tp[0] = f2bf(v[0]); tp[32] = f2bf(v[1]); tp[64] = f2bf(v[2]); tp[96] = f2bf(v[3]); }
                    }
            }
    }
};
struct EpiOut {
    static constexpr bool PERM = false, AFTER_DRAIN = false;
    const float* xp; const float* xs; float* out;
    DI void operator()(const f32x4 (&acc)[2][2][4][2], const pg8::Unit& u, int wr, int wc, int fr, int fq) const {
        const int rbase = u.pm * 256 + wr * 64 + fr, cbase = u.pn * 256 + wc * 32 + 4 * fq;
#pragma unroll
        for (int ai = 0; ai < 2; ++ai)
#pragma unroll
            for (int m = 0; m < 4; ++m) {
                const int row = rbase + ai * 128 + m * 16;
                const float* xr; float* orow;
                if (row < MP) { xr = xp + (size_t)row * DM; orow = out + O_YP + (size_t)row * DM; }
                else if (row < MP + NDB) { xr = xs + (size_t)(row - MP) * DM; orow = out + O_YS + (size_t)(row - MP) * DM; }
                else continue;
#pragma unroll
                for (int bj = 0; bj < 2; ++bj)
#pragma unroll
                    for (int n = 0; n < 2; ++n) { const int col = cbase + bj * 128 + n * 16; *(f32x4*)(orow + col) = acc[ai][bj][m][n] + *(const f32x4*)(xr + col); }
            }
    }
};
DI void p0_prologue(const Params& p, LAS3 unsigned char* lds) {
    const int tid = threadIdx.x, lane = tid & 63, wv = tid >> 6;
    unsigned char* ws = p.ws;
    {
        const int rstep = gridDim.x * 16, rend = MROWS + MMEM;
        int r0 = (blockIdx.x * 8 + wv) * 2;
        auto row_src = [&](int r) -> const float* {
            r = r < rend ? r : rend - 1;
            if (r < MP) return p.x_prompt + (size_t)r * DM;
            if (r < MP + NDB) return p.x_sample + (size_t)(r - MP) * DM;
            if (r < MROWS) return p.x_prompt;
            return p.mem_prompt + (size_t)(r - MROWS) * DM;
        };
        f32x4 v[2][4], vn[2][4];
#pragma unroll
        for (int e = 0; e < 2; ++e) { const float* s = row_src(r0 + e);
#pragma unroll
            for (int i = 0; i < 4; ++i) v[e][i] = *(const f32x4*)(s + i * 256 + lane * 4); }
        for (; r0 < rend; r0 += rstep) {
#pragma unroll
            for (int e = 0; e < 2; ++e) { const float* s = row_src(r0 + rstep + e);
#pragma unroll
                for (int i = 0; i < 4; ++i) vn[e][i] = *(const f32x4*)(s + i * 256 + lane * 4); }
#pragma unroll
            for (int e = 0; e < 2; ++e) {
                const int r = r0 + e;
                const bool pad = (r >= MP + NDB && r < MROWS);
                const float* g = r < MROWS ? p.norm_in : p.mem_norm;
                bf16_t* dst = r < MROWS ? (bf16_t*)(ws + W_XN) + (size_t)r * DM : (bf16_t*)(ws + W_MEMN) + (size_t)(r - MROWS) * DM;
                float ss = 0.f;
#pragma unroll
                for (int i = 0; i < 4; ++i) ss += v[e][i][0] * v[e][i][0] + v[e][i][1] * v[e][i][1] + v[e][i][2] * v[e][i][2] + v[e][i][3] * v[e][i][3];
                ss = wsum64(ss);
                const float rstd = pad ? 0.f : rsqrtf(ss * (1.f / DM) + 1e-6f);
#pragma unroll
                for (int i = 0; i < 4; ++i) { const f32x4 gv = *(const f32x4*)(g + i * 256 + lane * 4); st_bf16x4(dst + i * 256 + lane * 4, v[e][i] * rstd * gv); }
            }
#pragma unroll
            for (int e = 0; e < 2; ++e)
#pragma unroll
                for (int i = 0; i < 4; ++i) v[e][i] = vn[e][i];
        }
    }
    for (int e = blockIdx.x * NTHREADS + tid; e < 2049 * 32; e += gridDim.x * NTHREADS) {
        const int pi = e >> 5, f = e & 31;
        const float inv = powf(10000.0f, -(float)(2 * f) / 64.0f);
        const float ang = (float)(pi == 2048 ? 16384 : pi) * inv;
        float sn, cs; sincosf(ang, &sn, &cs);
        ((f32x2*)(ws + W_ROPE))[e] = (f32x2){cs, sn};
    }
    LAS3 float* tl = (LAS3 float*)lds;
    {
        auto tile_load = [&](int tile, float (&wr)[8]) {
            tile = tile < 1280 ? tile : 1279;
            int which, t2, ld; const float* W;
            if (tile < 896) { which = 0; t2 = tile; W = p.w_in; ld = DIN; }
            else if (tile < 1024) { which = 1; t2 = tile - 896; W = p.w_mem_kv; ld = 512; }
            else { which = 2; t2 = tile - 1024; W = p.w_out; ld = 1024; }
            const int nt = t2 >> 4, kt = t2 & 15;
            const int nn = tid & 63, kk0 = tid >> 6; const int np = nt * 64 + nn; int sc = which == 0 ? in_src(np) : np;
            const bool zero = sc < 0; sc = zero ? 0 : sc;
#pragma unroll
            for (int i = 0; i < 8; ++i) { const float w = W[(size_t)(kt * 64 + kk0 + 8 * i) * ld + sc]; wr[i] = zero ? 0.f : w; }
        };
        float wr[8], wn[8];
        tile_load(blockIdx.x, wr);
        for (int tile = blockIdx.x; tile < 1280; tile += gridDim.x) {
            bf16_t* dst; int t2;
            if (tile < 896) { t2 = tile; dst = (bf16_t*)(ws + W_WTIN); }
            else if (tile < 1024) { t2 = tile - 896; dst = (bf16_t*)(ws + W_WTMEM); }
            else { t2 = tile - 1024; dst = (bf16_t*)(ws + W_WTOUT); }
            const int nt = t2 >> 4, kt = t2 & 15;
            { const int nn = tid & 63, kk0 = tid >> 6;
#pragma unroll
              for (int i = 0; i < 8; ++i) tl[(kk0 + 8 * i) * 65 + nn] = wr[i]; }
            __syncthreads();
            tile_load(tile + gridDim.x, wn);
            { const int kk = tid & 63, nn0 = tid >> 6;
#pragma unroll
              for (int i = 0; i < 8; ++i) { const int n = nn0 + 8 * i; dst[(size_t)(nt * 64 + n) * 1024 + kt * 64 + kk] = f2bf(tl[kk * 65 + n]); } }
            __syncthreads();
#pragma unroll
            for (int i = 0; i < 8; ++i) wr[i] = wn[i];
        }
    }
}

DI void cnt_ge(unsigned& c, unsigned key, unsigned cand) { asm volatile("v_cmp_ge_u32 vcc, %1, %2\n\tv_addc_co_u32 %0, vcc, 0, %0, vcc" : "+v"(c) : "v"(key), "v"(cand) : "vcc"); }
DI void cnt_gt(unsigned& c, unsigned key, unsigned cand) { asm volatile("v_cmp_gt_u32 vcc, %1, %2\n\tv_addc_co_u32 %0, vcc, 0, %0, vcc" : "+v"(c) : "v"(key), "v"(cand) : "vcc"); }
DI void cnt_eq_lt(unsigned& c, unsigned key, unsigned T, unsigned idx, unsigned cand) {
    unsigned tmp;
    asm volatile("v_cmp_eq_u32 vcc, %2, %3\n\tv_cndmask_b32 %1, -1, %4, vcc\n\tv_cmp_lt_u32 vcc, %1, %5\n\tv_addc_co_u32 %0, vcc, 0, %0, vcc" : "+v"(c), "=&v"(tmp) : "v"(key), "v"(T), "v"(idx), "v"(cand) : "vcc"); }
DI unsigned grp_count16(unsigned c, LAS3 unsigned* CNT, int& it, int fr, int lane) {
    c += __shfl_xor(c, 16); c += __shfl_xor(c, 32);
    LAS3 unsigned* cur = CNT + (it % 3) * 16;
    if (lane < 16) lds_add(cur + fr, c);
    __syncthreads();
    const unsigned tot = cur[fr];
    if (threadIdx.x < 16) CNT[((it + 2) % 3) * 16 + threadIdx.x] = 0u;
    ++it; return tot;
}
DI unsigned blk_count(unsigned c, LAS3 unsigned* CNT, int& it, int lane) {
    c += __shfl_xor(c, 1); c += __shfl_xor(c, 2); c += __shfl_xor(c, 4); c += __shfl_xor(c, 8); c += __shfl_xor(c, 16); c += __shfl_xor(c, 32);
    LAS3 unsigned* cur = CNT + (it % 3) * 16;
    if (lane == 0) lds_add(cur, c);
    __syncthreads();
    const unsigned tot = cur[0];
    if (threadIdx.x == 0) CNT[((it + 2) % 3) * 16] = 0u;
    ++it; return tot;
}

template <bool MASKED>
DI void attn32(const bf16_t* Q, int ldq, const bf16_t* K, int ldk, const bf16_t* Vt, int ldv, int nkb, const LAS3 unsigned* mask, int fr, int fq,
               f32x4 (&o)[4][2], float (&linv)[2]) {
    bf16x8 qf[2][2];
#pragma unroll
    for (int qt = 0; qt < 2; ++qt)
#pragma unroll
        for (int ks = 0; ks < 2; ++ks) qf[qt][ks] = *(const bf16x8*)(Q + (size_t)(16 * qt + fr) * ldq + ks * 32 + fq * 8);
    float m[2] = {NEG_INF, NEG_INF}, l[2] = {0.f, 0.f};
    const f32x4 zero = {0.f, 0.f, 0.f, 0.f};
#pragma unroll
    for (int dt = 0; dt < 4; ++dt) { o[dt][0] = zero; o[dt][1] = zero; }
    const bf16_t* kl = K + (size_t)fr * ldk + fq * 8;
#ifdef BROKEN_VT
    const bf16_t* vl = Vt + fr * 32 + 8 * ((fq + 1) & 3);
#else
    const bf16_t* vl = Vt + fr * 32 + 8 * fq;
#endif
    bf16x8 kfA[2][2], kfB[2][2], vA[4], vB[4];
#define ATT_LOAD(KF, VF, kb_) do { \
        _Pragma("unroll") for (int i2 = 0; i2 < 2; ++i2) _Pragma("unroll") for (int ks = 0; ks < 2; ++ks) KF[i2][ks] = *(const bf16x8*)(kl + (size_t)(32 * (kb_) + 16 * i2) * ldk + ks * 32); \
        _Pragma("unroll") for (int dt = 0; dt < 4; ++dt) VF[dt] = *(const bf16x8*)(vl + (size_t)(kb_) * ldv + 512 * dt); } while (0)
#define ATT_COMPUTE(KF, VF, kb_) do { \
        _Pragma("unroll") for (int qt = 0; qt < 2; ++qt) { \
            f32x4 s0 = mfma16(KF[0][0], qf[qt][0], zero); s0 = mfma16(KF[0][1], qf[qt][1], s0); \
            f32x4 s1 = mfma16(KF[1][0], qf[qt][0], zero); s1 = mfma16(KF[1][1], qf[qt][1], s1); \
            if (MASKED) { const unsigned mw = mask[(16 * qt + fr) * 65 + (kb_)]; const unsigned b0 = mw >> (2 * fq), b1 = mw >> (8 + 2 * fq); \
                _Pragma("unroll") for (int r = 0; r < 4; ++r) { const int sh_ = (r >> 1) + 16 * (r & 1); s0[r] = ((b0 >> sh_) & 1u) ? s0[r] : NEG_INF; s1[r] = ((b1 >> sh_) & 1u) ? s1[r] : NEG_INF; } } \
            float mx = fmaxf(fmaxf(fmaxf(s0[0], s0[1]), fmaxf(s0[2], s0[3])), fmaxf(fmaxf(s1[0], s1[1]), fmaxf(s1[2], s1[3]))); \
            mx = fmaxf(mx, __shfl_xor(mx, 16)); mx = fmaxf(mx, __shfl_xor(mx, 32)); \
            const float mn = fmaxf(m[qt], mx), ms = (mn == NEG_INF) ? 0.f : mn; \
            const float alpha = __builtin_amdgcn_exp2f(m[qt] - ms); \
            f32x4 p0, p1; \
            _Pragma("unroll") for (int r = 0; r < 4; ++r) { p0[r] = __builtin_amdgcn_exp2f(s0[r] - ms); p1[r] = __builtin_amdgcn_exp2f(s1[r] - ms); } \
            l[qt] = l[qt] * alpha + ((p0[0] + p0[1]) + (p0[2] + p0[3])) + ((p1[0] + p1[1]) + (p1[2] + p1[3])); \
            m[qt] = mn; \
            u32x4 pw; pw.x = cvtpk(p0[0], p0[1]); pw.y = cvtpk(p0[2], p0[3]); pw.z = cvtpk(p1[0], p1[1]); pw.w = cvtpk(p1[2], p1[3]); \
            const bf16x8 pf = __builtin_bit_cast(bf16x8, pw); \
            if (!__all(alpha == 1.f)) { _Pragma("unroll") for (int dt = 0; dt < 4; ++dt) o[dt][qt] = o[dt][qt] * alpha; }     \
            _Pragma("unroll") for (int dt = 0; dt < 4; ++dt) o[dt][qt] = mfma16(VF[dt], pf, o[dt][qt]); } } while (0)
    ATT_LOAD(kfA, vA, 0);
    const int last = nkb - 1;
    for (int kb = 0; kb < nkb; kb += 2) {
        ATT_LOAD(kfB, vB, kb + 1);
        ATT_COMPUTE(kfA, vA, kb);
        { const int k2 = kb + 2 < last ? kb + 2 : last; ATT_LOAD(kfA, vA, k2); }
        ATT_COMPUTE(kfB, vB, kb + 1);
    }
#undef ATT_LOAD
#undef ATT_COMPUTE
#pragma unroll
    for (int qt = 0; qt < 2; ++qt) { float lt = l[qt]; lt += __shfl_xor(lt, 16); lt += __shfl_xor(lt, 32); linv[qt] = 1.f / lt; }
}
DI void attn_store(const f32x4 (&o)[4][2], const float (&linv)[2], const bf16_t* gate  , bf16_t* mix  , int fr, int fq) {
#pragma unroll
    for (int qt = 0; qt < 2; ++qt)
#pragma unroll
        for (int dt = 0; dt < 4; ++dt) {
            const size_t row = 16 * qt + fr; const int col = 16 * dt + 4 * fq;
            const u32x2 gw = *(const u32x2*)(gate + row * 256 + col);
            f32x4 v = o[dt][qt] * linv[qt];
            v[0] *= __uint_as_float(gw.x << 16); v[1] *= __uint_as_float(gw.x & 0xffff0000u); v[2] *= __uint_as_float(gw.y << 16); v[3] *= __uint_as_float(gw.y & 0xffff0000u);
            st_bf16x4(mix + row * 1024 + col, v);
        }
}

constexpr int DS_MASK = 0, DS_PKT = 16640, PKT_LD = 2052, DS_CNT = 147968;
typedef unsigned short u16x2 __attribute__((ext_vector_type(2)));
DI unsigned pk_cnt_ge(unsigned acc, unsigned kpair, unsigned cm1, unsigned ones) {
    unsigned t;
    asm("v_pk_sub_u16 %1, %2, %3 clamp\n\tv_pk_min_u16 %1, %1, %4\n\tv_pk_add_u16 %0, %0, %1" : "+v"(acc), "=&v"(t) : "v"(kpair), "v"(cm1), "v"(ones));
    return acc;
}
DI void select_bitwise(const unsigned (&key)[16][4], int lbase, LAS3 unsigned* CNT, int& it, int fr, int lane, unsigned& T, int& Xrel) {
    bool fin = false;
    T = 0u; Xrel = 0x7fffffff;
    for (int bit = 31; bit >= 0; --bit) {
        const unsigned cand = T | (1u << bit);
        unsigned c = 0;
#pragma unroll
        for (int n = 0; n < 16; ++n)
#pragma unroll
            for (int r = 0; r < 4; ++r) cnt_ge(c, key[n][r], cand);
        const unsigned tot = grp_count16(c, CNT, it, fr, lane);
        if (!fin && tot >= 256u) { T = cand; fin = (tot == 256u); }
        if (__all(fin)) break;
    }
    if (!__all(fin)) {
        unsigned c = 0;
#pragma unroll
        for (int n = 0; n < 16; ++n)
#pragma unroll
            for (int r = 0; r < 4; ++r) cnt_gt(c, key[n][r], T);
        const unsigned cgt = grp_count16(c, CNT, it, fr, lane);
        const unsigned need = 256u - cgt;
        unsigned Xl = 0u;
        for (int bit = 10; bit >= 0; --bit) {
            const unsigned cand = Xl | (1u << bit);
            const int crel = (int)cand - lbase;
            c = 0;
#pragma unroll
            for (int n = 0; n < 16; ++n) { const int crn = crel - 128 * n;
#pragma unroll
                for (int r = 0; r < 4; ++r) c += (key[n][r] == T && r < crn) ? 1u : 0u; }
            const unsigned tot = grp_count16(c, CNT, it, fr, lane);
            if (tot < need) Xl = cand;
        }
        if (!fin) Xrel = (int)Xl - lbase;
    }
}
DI unsigned pk_flag_ge(unsigned kpair, unsigned cm1, unsigned ones) {
    unsigned t;
    asm("v_pk_sub_u16 %0, %1, %2 clamp\n\tv_pk_min_u16 %0, %0, %3" : "=&v"(t) : "v"(kpair), "v"(cm1), "v"(ones));
    return t;
}
DI unsigned pk_max(unsigned a, unsigned b2) { unsigned t; asm("v_pk_max_u16 %0, %1, %2" : "=v"(t) : "v"(a), "v"(b2)); return t; }
DI unsigned hsum32(unsigned x) {
    x += __builtin_amdgcn_update_dpp(0u, x, 0xB1, 0xF, 0xF, false); x += __builtin_amdgcn_update_dpp(0u, x, 0x4E, 0xF, 0xF, false);
    x += __builtin_amdgcn_update_dpp(0u, x, 0x141, 0xF, 0xF, false); x += __builtin_amdgcn_update_dpp(0u, x, 0x140, 0xF, 0xF, false);
    const auto r = __builtin_amdgcn_permlane16_swap(x, x, false, false); return r[0] + r[1];
}
DI unsigned hmax32(unsigned x) {
    x = max(x, (unsigned)__builtin_amdgcn_update_dpp(0u, x, 0xB1, 0xF, 0xF, false)); x = max(x, (unsigned)__builtin_amdgcn_update_dpp(0u, x, 0x4E, 0xF, 0xF, false));
    x = max(x, (unsigned)__builtin_amdgcn_update_dpp(0u, x, 0x141, 0xF, 0xF, false)); x = max(x, (unsigned)__builtin_amdgcn_update_dpp(0u, x, 0x140, 0xF, 0xF, false));
    const auto r = __builtin_amdgcn_permlane16_swap(x, x, false, false); return max(r[0], r[1]);
}
DI unsigned pk_count32(const unsigned (&rk)[32], unsigned cm1, unsigned ones, bool half) {
    unsigned a0 = 0u, a1 = 0u;
#pragma unroll
    for (int k = 0; k < 16; k += 2) { a0 = pk_cnt_ge(a0, rk[k], cm1, ones); a1 = pk_cnt_ge(a1, rk[k + 1], cm1, ones); }
    if (!half) {
#pragma unroll
        for (int k = 16; k < 32; k += 2) { a0 = pk_cnt_ge(a0, rk[k], cm1, ones); a1 = pk_cnt_ge(a1, rk[k + 1], cm1, ones); }
    }
    return (a0 & 0xffffu) + (a0 >> 16) + (a1 & 0xffffu) + (a1 >> 16);
}
DI void dsa_unit(const Params& p, LAS3 unsigned char* lds, int b, int j TARGS) {
    int tid = threadIdx.x; asm volatile("" : "+v"(tid));
    const int lane0 = tid & 63, w = __builtin_amdgcn_readfirstlane(tid >> 6);
    unsigned char* ws = p.ws;
    LAS3 unsigned* MASK = (LAS3 unsigned*)(lds + DS_MASK);
    LAS3 unsigned* PKT = (LAS3 unsigned*)(lds + DS_PKT);
    const bf16_t* IQ = (const bf16_t*)(ws + W_IQ); const bf16_t* IK = (const bf16_t*)(ws + W_IK); const float* IW = (const float*)(ws + W_IW);
    const int q0 = 64 * j;
    const f32x4 zero = {0.f, 0.f, 0.f, 0.f};
#ifdef CHECK_SEL
    LAS3 unsigned* CNT = (LAS3 unsigned*)(lds + DS_CNT); int it = 0;
    if (tid < 48) CNT[tid] = 0u;
    __syncthreads();
#endif
    TBEG(30);
    bf16x8 bqn[4][2]; f32x4 wqn;
    { const size_t qr0 = (size_t)b * SEQ + q0 + (lane0 & 15);
#pragma unroll
      for (int h = 0; h < 4; ++h)
#pragma unroll
          for (int ks = 0; ks < 2; ++ks) bqn[h][ks] = *(const bf16x8*)(IQ + qr0 * 256 + h * 64 + ks * 32 + (lane0 >> 4) * 8);
      wqn = *(const f32x4*)(IW + qr0 * 4); }
#pragma unroll 1
    for (int qg = 0; qg < 4; ++qg) {
        TBEG(32);
        int lane = lane0; asm volatile("" : "+v"(lane));
        const int fr = lane & 15, fq = lane >> 4;
        const int tq = q0 + 16 * qg + fr; const size_t qrow = (size_t)b * SEQ + tq;
        const int ntile = 4 * j + qg + 1;
        const int nloc = ntile > w ? (ntile - w + 7) >> 3 : 0;
        const bool selecting = q0 + 16 * qg >= 256;
        {
            bf16x8 bq[4][2];
#pragma unroll
            for (int h = 0; h < 4; ++h)
#pragma unroll
                for (int ks = 0; ks < 2; ++ks) bq[h][ks] = bqn[h][ks];
            const f32x4 wq = wqn;
            float Lh[4];
#pragma unroll
            for (int h = 0; h < 4; ++h) Lh[h] = wq[h] < 0.f ? NEG_INF : -NEG_INF;
            const char* tb = (const char*)IK + ((size_t)b * SEQ + 16 * w) * 128 + (unsigned)(fr * 128 + fq * 16);
            LAS3 unsigned* krow = PKT + fr * PKT_LD + 16 * w + 4 * fq;
            const int lim0 = tq - (16 * w + 4 * fq);
#define DSA_TILE(A0, A1, nn) do { \
                f32x4 sc = zero; \
                _Pragma("unroll") for (int h = 0; h < 4; ++h) { f32x4 d = mfma16(A0, bq[h][0], zero); d = mfma16(A1, bq[h][1], d); d = d * wq[h]; \
                    _Pragma("unroll") for (int r = 0; r < 4; ++r) sc[r] += __builtin_amdgcn_fmed3f(d[r], 0.f, Lh[h]); } \
                { const char* t2_ = tb + (size_t)((nn) + 2 < nloc ? (nn) + 2 : nloc - 1) * 16384; A0 = *(const bf16x8*)t2_; A1 = *(const bf16x8*)(t2_ + 64); } \
                const int limn = lim0 - 128 * (nn);                   \
                u32x4 kv; \
                _Pragma("unroll") for (int r = 0; r < 4; ++r) { const unsigned u = __float_as_uint(sc[r] + 0.f); const unsigned k = u ^ ((unsigned)((int)u >> 31) | 0x80000000u);   \
                    kv[r] = (r <= limn) ? k : 0u; } \
                *(LAS3 u32x4*)(krow + 128 * (nn)) = kv; } while (0)
            if (nloc > 0) {
                bf16x8 a0 = *(const bf16x8*)tb, a1 = *(const bf16x8*)(tb + 64);
                const char* t1 = tb + (size_t)(1 < nloc ? 1 : 0) * 16384;
                bf16x8 b0 = *(const bf16x8*)t1, b1 = *(const bf16x8*)(t1 + 64);
#pragma unroll 1
                for (int n = 0; n < nloc; n += 2) {
                    DSA_TILE(a0, a1, n);
                    if (n + 1 < nloc) DSA_TILE(b0, b1, n + 1);
                }
            }
#undef DSA_TILE
        }
        TEND(32); TBEG(33);
        __syncthreads();
        { const size_t qrn = qrow + (qg < 3 ? 16 : 0);
#pragma unroll
          for (int h = 0; h < 4; ++h)
#pragma unroll
              for (int ks = 0; ks < 2; ++ks) bqn[h][ks] = *(const bf16x8*)(IQ + qrn * 256 + h * 64 + ks * 32 + fq * 8);
          wqn = *(const f32x4*)(IW + qrn * 4); }
        {
            const int hh = lane >> 5, pos = lane & 31, oq = 2 * w + hh;
            const unsigned nkeys = 16u * (unsigned)ntile;
            const bool half = nkeys <= 1024u;
            const LAS3 unsigned* orow = PKT + oq * PKT_LD + 2 * pos;
            unsigned ones = 0x00010001u; asm volatile("" : "+v"(ones));
            unsigned Tfull = 1u, X = 0xffffffffu;
            if (selecting) {
                unsigned rk[32];
#pragma unroll
                for (int k = 0; k < 32; ++k) { const u32x2 kk = *(const LAS3 u32x2*)(orow + 64 * k); rk[k] = (2u * (unsigned)(pos + 32 * k) < nkeys) ? __builtin_amdgcn_perm(kk.y, kk.x, 0x07060302u) : 0u; }
                unsigned mx = 0u;
#pragma unroll
                for (int k = 0; k < 32; ++k) mx = pk_max(mx, rk[k]);
                const unsigned kmax = hmax32(max(mx & 0xffffu, mx >> 16));
                unsigned T16 = 0u, cabove = 0u; bool exact = false;
                {
                    unsigned ub = 0x10000u;
#pragma unroll 1
                    for (int bit = 15; bit >= 0; --bit) {
                        const unsigned cand = T16 | (1u << bit);
                        if (__all(cand > kmax)) { ub = cand; continue; }
                        const unsigned tot = hsum32(pk_count32(rk, (cand - 1u) * 0x00010001u, ones, half));
                        if (tot >= 256u) T16 = cand; else { ub = cand; cabove = tot; }
                    }
                    (void)ub;
                }
                const unsigned need = 256u - cabove;
#pragma unroll
                for (int k = 0; k < 32; ++k) { const u32x2 kk = *(const LAS3 u32x2*)(orow + 64 * k); const bool in = 2u * (unsigned)(pos + 32 * k) < nkeys;
                    const unsigned lo0 = (in && (kk.x >> 16) == T16) ? (kk.x & 0xffffu) : 0u, lo1 = (in && (kk.y >> 16) == T16) ? (kk.y & 0xffffu) : 0u; rk[k] = lo0 | (lo1 << 16); }
                unsigned Tlo = 0u;
#pragma unroll 1
                for (int bit = 15; bit >= 0; --bit) {
                    const unsigned cand = Tlo | (1u << bit);
                    const unsigned tot = hsum32(pk_count32(rk, (cand - 1u) * 0x00010001u, ones, half));
                    if (!exact && tot >= need) { Tlo = cand; exact = (tot == need); }
                    if (__all(exact)) break;
                }
                Tfull = (T16 << 16) | Tlo;
                if (!__all(exact)) {
                    unsigned cgt = 0u, ceq = 0u;
#pragma unroll 1
                    for (int k = 0; k < 32; ++k) { const u32x2 kk = *(const LAS3 u32x2*)(orow + 64 * k); const bool in = 2u * (unsigned)(pos + 32 * k) < nkeys;
                        cgt += (in && kk.x > Tfull && (kk.x >> 16) == T16 ? 1u : 0u) + (in && kk.y > Tfull && (kk.y >> 16) == T16 ? 1u : 0u); }
                    (void)ceq;
                    const unsigned needt = need - hsum32(cgt);
                    unsigned Xl = 0u;
#pragma unroll 1
                    for (int bit = 10; bit >= 0; --bit) {
                        const unsigned cx = Xl | (1u << bit);
                        unsigned c = 0u;
#pragma unroll 1
                        for (int k = 0; k < 32; ++k) { const u32x2 kk = *(const LAS3 u32x2*)(orow + 64 * k); const unsigned i0 = 2u * (unsigned)(pos + 32 * k);
                            c += (i0 < nkeys && kk.x == Tfull && i0 < cx ? 1u : 0u) + (i0 < nkeys && kk.y == Tfull && i0 + 1u < cx ? 1u : 0u); }
                        if (hsum32(c) < needt) Xl = cx;
                    }
                    if (!exact) X = Xl;
                }
            }
            LAS3 unsigned* mrow = MASK + (16 * qg + oq) * 65 + (pos >> 4);
            const unsigned sh = 32u * hh + (pos & 16);
#pragma unroll 2
            for (int k = 0; k <= j; ++k) {
                const u32x2 kk = *(const LAS3 u32x2*)(orow + 64 * k); const unsigned i0 = 2u * (unsigned)(pos + 32 * k);
                const bool s0 = i0 < nkeys && (kk.x > Tfull || (kk.x == Tfull && i0 <= X)), s1 = i0 < nkeys && (kk.y > Tfull || (kk.y == Tfull && i0 + 1u <= X));
                const unsigned long long blo = __ballot(s0), bhi = __ballot(s1);
                const unsigned wv = ((unsigned)(blo >> sh) & 0xffffu) | ((unsigned)(bhi >> sh) << 16);
                if ((pos & 15) == 0) mrow[2 * k] = wv;
            }
        }
        TEND(33);
        __syncthreads();
#ifdef CHECK_SEL
        if (selecting) {
            const int lbase = 16 * w + 4 * fq;
            unsigned key[16][4];
#pragma unroll
            for (int n = 0; n < 16; ++n)
#pragma unroll
                for (int r = 0; r < 4; ++r) key[n][r] = (n < nloc) ? PKT[fr * PKT_LD + lbase + 128 * n + r] : 0u;
            unsigned T2; int X2; select_bitwise(key, lbase, CNT, it, fr, lane, T2, X2);
            bool bad = false;
#pragma unroll
            for (int n = 0; n < 16; ++n) if (n < nloc) { const int x2 = X2 - 128 * n;
#pragma unroll
                for (int r = 0; r < 4; ++r) { const unsigned idx = (unsigned)(lbase + 128 * n + r); const unsigned mw = MASK[(16 * qg + fr) * 65 + (idx >> 5)];
                    const bool s2 = key[n][r] > T2 || (key[n][r] == T2 && r <= x2); bad |= (s2 != (((mw >> (((idx & 31u) >> 1) + 16u * (idx & 1u))) & 1u) != 0u)); } }
            if (__any(bad) && lane == 0) atomicAdd((unsigned*)(ws + CW_CHK), 1u);
            if (lane == 0 && w == 0) atomicAdd((unsigned*)(ws + CW_CHK + 4), 1u);
            __syncthreads();
        }
#endif
    }
    TEND(30); TBEG(31);
    {
        const int h = w & 3, hf = w >> 2, fr = lane0 & 15, fq = lane0 >> 4;
        const size_t qrow0 = (size_t)b * SEQ + q0 + 32 * hf;
        f32x4 o[4][2]; float linv[2];
        attn32<true>((const bf16_t*)(ws + W_DQ) + qrow0 * 256 + h * 64, 256, (const bf16_t*)(ws + W_DK) + (size_t)b * SEQ * 256 + h * 64, 256,
                     (const bf16_t*)(ws + W_DVT) + ((size_t)b * 64 * 4 + h) * 2048, 4 * 2048, 2 * j + 2  , MASK + 32 * hf * 65, fr, fq, o, linv);
        attn_store(o, linv, (const bf16_t*)(ws + W_DG) + qrow0 * 256 + h * 64, (bf16_t*)(ws + W_MIX) + qrow0 * 1024 + 512 + h * 64, fr, fq);
    }
    __syncthreads();
    TEND(31);
}
DI void mem_unit(const Params& p, int n) {
    const int tid = threadIdx.x, lane = tid & 63, w = __builtin_amdgcn_readfirstlane(tid >> 6), fr = lane & 15, fq = lane >> 4;
    unsigned char* ws = p.ws;
    const int h = w & 3, hf = w >> 2;
    const size_t qrow0 = (size_t)n * 64 + 32 * hf; const int b = n >> 5;
    f32x4 o[4][2]; float linv[2];
    attn32<false>((const bf16_t*)(ws + W_MQ) + qrow0 * 256 + h * 64, 256, (const bf16_t*)(ws + W_MK) + (size_t)b * NMEM * 256 + h * 64, 256,
                  (const bf16_t*)(ws + W_MVT) + ((size_t)b * 8 * 4 + h) * 2048, 4 * 2048, 8, nullptr, fr, fq, o, linv);
    attn_store(o, linv, (const bf16_t*)(ws + W_MG) + qrow0 * 256 + h * 64, (bf16_t*)(ws + W_MIX) + qrow0 * 1024 + 768 + h * 64, fr, fq);
}
constexpr int GL_QT = 0, GL_KT = 9216, GL_KPT = 18432, GL_VT = 27648, GL_SBT = 46080, GL_PM = 64512, GL_OF = 73728, GL_GTOT = 107520, GL_W2 = 109568, GL_BG = 113664, GL_DEC = 113920;
constexpr int LDP = 72;
DI void gla_unit(const Params& p, LAS3 unsigned char* lds, int b, int h) {
    const int tid = threadIdx.x, lane = tid & 63, w = __builtin_amdgcn_readfirstlane(tid >> 6), fr = lane & 15, fq = lane >> 4;
    unsigned char* ws = p.ws;
    LAS3 bf16_t* Qt = (LAS3 bf16_t*)(lds + GL_QT); LAS3 bf16_t* Kt = (LAS3 bf16_t*)(lds + GL_KT); LAS3 bf16_t* KpT = (LAS3 bf16_t*)(lds + GL_KPT);
    LAS3 bf16_t* Vt = (LAS3 bf16_t*)(lds + GL_VT); LAS3 bf16_t* SbT = (LAS3 bf16_t*)(lds + GL_SBT); LAS3 bf16_t* Pm = (LAS3 bf16_t*)(lds + GL_PM);
    LAS3 float* Of = (LAS3 float*)(lds + GL_OF); LAS3 float* gtot = (LAS3 float*)(lds + GL_GTOT); LAS3 float* w2s = (LAS3 float*)(lds + GL_W2);
    LAS3 float* bgs = (LAS3 float*)(lds + GL_BG); LAS3 float* dec = (LAS3 float*)(lds + GL_DEC);
    const bf16_t* GQ = (const bf16_t*)(ws + W_GQ); const bf16_t* GK = (const bf16_t*)(ws + W_GK); const bf16_t* GV = (const bf16_t*)(ws + W_GV);
    const bf16_t* GG = (const bf16_t*)(ws + W_GG); const float* GLR = (const float*)(ws + W_GLR); bf16_t* MIX = (bf16_t*)(ws + W_MIX);
    for (int i = tid; i < 128 * LDP / 2; i += NTHREADS) ((LAS3 unsigned*)SbT)[i] = 0u;
    for (int i = tid; i < 16 * 64; i += NTHREADS) w2s[i] = p.w_g2[(i >> 6) * 256 + h * 64 + (i & 63)];
    if (tid < 64) bgs[tid] = p.b_g[h * 64 + tid];
    __syncthreads();
    const int d = tid & 63, tg = w;
    float wreg[16];
#pragma unroll
    for (int r = 0; r < 16; ++r) wreg[r] = w2s[r * 64 + d];
    const float bgd = bgs[d];
    const f32x4 zero = {0.f, 0.f, 0.f, 0.f};
    f32x4 Sacc[4] = {zero, zero, zero, zero};
    const int tt = w & 3, vh = w >> 2;
    for (int c = 0; c < 32; ++c) {
        const size_t rb = (size_t)b * SEQ + c * 64;
        float g8[8];
#pragma unroll
        for (int i = 0; i < 8; ++i) {
            const float* gl = vaddr(GLR + (rb + tg * 8 + i) * 16);
            float u = bgd;
#pragma unroll
            for (int r = 0; r < 16; ++r) u += gl[r] * wreg[r];
            const float g = logsigf(u) * (1.f / 16.f);
            g8[i] = (i ? g8[i - 1] : 0.f) + g;
        }
        gtot[tg * 64 + d] = g8[7];
        __syncthreads();
        float off = 0.f, blast = 0.f;
#pragma unroll
        for (int g2 = 0; g2 < 8; ++g2) { const float v = gtot[g2 * 64 + d]; off += (g2 < tg) ? v : 0.f; blast += v; }
        float kp[8];
#pragma unroll
        for (int i = 0; i < 8; ++i) {
            const int t = tg * 8 + i; const float bt = off + g8[i];
            const float q = bf2f(GQ[(rb + t) * 256 + h * 64 + d]), k = bf2f(GK[(rb + t) * 256 + h * 64 + d]);
            Qt[t * LDP + d] = f2bf(q * fexp(bt)); Kt[t * LDP + d] = f2bf(k * fexp(-bt)); kp[i] = k * fexp(blast - bt);
        }
        { u32x4 kw; kw.x = cvtpk(kp[0], kp[1]); kw.y = cvtpk(kp[2], kp[3]); kw.z = cvtpk(kp[4], kp[5]); kw.w = cvtpk(kp[6], kp[7]); *(LAS3 u32x4*)(KpT + d * LDP + tg * 8) = kw; }
        if (tg == 0) dec[d] = fexp(blast);
        { const int v = tid & 127, sg = tid >> 7; bf16_t vv[16];
#pragma unroll
          for (int i = 0; i < 16; ++i) vv[i] = GV[(rb + sg * 16 + i) * 512 + h * 128 + v];
          u32x4 a, bb; a.x = vv[0] | ((unsigned)vv[1] << 16); a.y = vv[2] | ((unsigned)vv[3] << 16); a.z = vv[4] | ((unsigned)vv[5] << 16); a.w = vv[6] | ((unsigned)vv[7] << 16);
          bb.x = vv[8] | ((unsigned)vv[9] << 16); bb.y = vv[10] | ((unsigned)vv[11] << 16); bb.z = vv[12] | ((unsigned)vv[13] << 16); bb.w = vv[14] | ((unsigned)vv[15] << 16);
          *(LAS3 u32x4*)(Vt + v * LDP + sg * 16) = a; *(LAS3 u32x4*)(Vt + v * LDP + sg * 16 + 8) = bb; }
        __syncthreads();
#pragma unroll
        for (int s2 = 0; s2 < 2; ++s2) {
            const int st = 2 * vh + s2;
            f32x4 acc = zero;
#pragma unroll
            for (int ks = 0; ks < 2; ++ks) {
                const bf16x8 a = *(const LAS3 bf16x8*)(Kt + (st * 16 + fr) * LDP + ks * 32 + fq * 8), bq = *(const LAS3 bf16x8*)(Qt + (tt * 16 + fr) * LDP + ks * 32 + fq * 8);
                acc = mfma16(a, bq, acc);
            }
            const int t = tt * 16 + fr, s0 = st * 16 + 4 * fq;
            u32x2 pw; pw.x = cvtpk(s0 <= t ? acc[0] : 0.f, s0 + 1 <= t ? acc[1] : 0.f); pw.y = cvtpk(s0 + 2 <= t ? acc[2] : 0.f, s0 + 3 <= t ? acc[3] : 0.f);
            *(LAS3 u32x2*)(Pm + t * LDP + s0) = pw;
        }
        __syncthreads();
        f32x4 oacc[4];
        {
            bf16x8 aq[2], ap[2], ak[2];
#pragma unroll
            for (int ks = 0; ks < 2; ++ks) {
                aq[ks] = *(const LAS3 bf16x8*)(Qt + (tt * 16 + fr) * LDP + ks * 32 + fq * 8);
                ap[ks] = *(const LAS3 bf16x8*)(Pm + (tt * 16 + fr) * LDP + ks * 32 + fq * 8);
                ak[ks] = *(const LAS3 bf16x8*)(KpT + (tt * 16 + fr) * LDP + ks * 32 + fq * 8);
            }
            const f32x4 dv = *(const LAS3 f32x4*)(dec + tt * 16 + 4 * fq);
#pragma unroll
            for (int jv = 0; jv < 4; ++jv) {
                const int vt = vh * 4 + jv;
                bf16x8 bs[2], bv[2];
#pragma unroll
                for (int ks = 0; ks < 2; ++ks) {
                    bs[ks] = *(const LAS3 bf16x8*)(SbT + (vt * 16 + fr) * LDP + ks * 32 + fq * 8);
                    bv[ks] = *(const LAS3 bf16x8*)(Vt + (vt * 16 + fr) * LDP + ks * 32 + fq * 8);
                }
                f32x4 oa = mfma16(aq[0], bs[0], zero); oa = mfma16(aq[1], bs[1], oa); oa = mfma16(ap[0], bv[0], oa); oa = mfma16(ap[1], bv[1], oa);
                oacc[jv] = oa;
                f32x4 sa = Sacc[jv] * dv; sa = mfma16(ak[0], bv[0], sa); sa = mfma16(ak[1], bv[1], sa);
                Sacc[jv] = sa;
            }
        }
        __syncthreads();
#pragma unroll
        for (int jv = 0; jv < 4; ++jv) {
            const int vt = vh * 4 + jv;
#pragma unroll
            for (int r = 0; r < 4; ++r) Of[(tt * 16 + 4 * fq + r) * 132 + vt * 16 + fr] = oacc[jv][r];
            u32x2 sw; sw.x = cvtpk(Sacc[jv][0], Sacc[jv][1]); sw.y = cvtpk(Sacc[jv][2], Sacc[jv][3]);
            *(LAS3 u32x2*)(SbT + (vt * 16 + fr) * LDP + tt * 16 + 4 * fq) = sw;
        }
        __syncthreads();
        {
            const int t = tid >> 3, seg = tid & 7;
            const LAS3 float* op = Of + t * 132 + seg * 16;
            f32x4 ov[4]; float ss = 0.f;
#pragma unroll
            for (int i = 0; i < 4; ++i) { ov[i] = *(const LAS3 f32x4*)(op + 4 * i); ss += ov[i][0] * ov[i][0] + ov[i][1] * ov[i][1] + ov[i][2] * ov[i][2] + ov[i][3] * ov[i][3]; }
            ss += __shfl_xor(ss, 1); ss += __shfl_xor(ss, 2); ss += __shfl_xor(ss, 4);
            const float rstd = rsqrtf(ss * (1.f / 128.f) + 1e-6f);
            const bf16_t* gp = GG + (rb + t) * 512 + h * 128 + seg * 16;
            const u32x4 g0 = *(const u32x4*)gp, g1 = *(const u32x4*)(gp + 8);
            const unsigned gw[8] = {g0.x, g0.y, g0.z, g0.w, g1.x, g1.y, g1.z, g1.w};
            unsigned ow[8];
#pragma unroll
            for (int i = 0; i < 4; ++i) {
                const f32x4 on = *(const f32x4*)(p.onorm + seg * 16 + 4 * i);
                const float y0 = ov[i][0] * rstd * on[0] * __uint_as_float(gw[2 * i] << 16), y1 = ov[i][1] * rstd * on[1] * __uint_as_float(gw[2 * i] & 0xffff0000u);
                const float y2 = ov[i][2] * rstd * on[2] * __uint_as_float(gw[2 * i + 1] << 16), y3 = ov[i][3] * rstd * on[3] * __uint_as_float(gw[2 * i + 1] & 0xffff0000u);
                ow[2 * i] = cvtpk(y0, y1); ow[2 * i + 1] = cvtpk(y2, y3);
            }
            bf16_t* mp = MIX + (rb + t) * 1024 + h * 128 + seg * 16;
            *(u32x4*)mp = (u32x4){ow[0], ow[1], ow[2], ow[3]}; *(u32x4*)(mp + 8) = (u32x4){ow[4], ow[5], ow[6], ow[7]};
        }
    }
#pragma unroll
    for (int jv = 0; jv < 4; ++jv)
#pragma unroll
        for (int r = 0; r < 4; ++r) p.out[O_GSP + ((size_t)(b * 4 + h) * 64 + tt * 16 + 4 * fq + r) * 128 + (vh * 4 + jv) * 16 + fr] = Sacc[jv][r];
    __syncthreads();
}

DI void sscore_unit(const Params& p, LAS3 unsigned char* lds, int u) {
    const int tid = threadIdx.x;
    unsigned char* ws = p.ws;
    const int b = u >> 3, pg = u & 7;
    LAS3 float* qf = (LAS3 float*)lds;
    if (tid < 256) qf[tid] = bf2f(((const bf16_t*)(ws + W_IQ))[(size_t)(MP + b) * 256 + tid]);
    __syncthreads();
    const int seg = tid & 15;
    f32x4 q[4];
#pragma unroll
    for (int h = 0; h < 4; ++h) q[h] = *(const LAS3 f32x4*)(qf + h * 64 + seg * 4);
    const f32x4 wv = *(const f32x4*)vaddr((const float*)(ws + W_IW) + (size_t)(MP + b) * 4);
    unsigned* sc = (unsigned*)(ws + W_SC) + (size_t)b * SCLD;
    const int* pt = p.page_table + b * NPAGES + pg * 16;
#define SS_LOAD(BUF, pp) do { const float* base_ = p.cache_ik + (size_t)pt[(pp) < 16 ? (pp) : 15] * 8192; \
        _Pragma("unroll") for (int i = 0; i < 4; ++i) BUF[i] = *(const f32x4*)(base_ + (size_t)(tid + 512 * i) * 4); } while (0)
#define SS_COMPUTE(BUF, pp) do { \
        _Pragma("unroll") for (int i = 0; i < 4; ++i) { const f32x4 kv = BUF[i]; float dh[4]; \
            _Pragma("unroll") for (int h = 0; h < 4; ++h) { float x = q[h][0] * kv[0] + q[h][1] * kv[1] + q[h][2] * kv[2] + q[h][3] * kv[3]; \
                x += __shfl_xor(x, 1); x += __shfl_xor(x, 2); x += __shfl_xor(x, 4); x += __shfl_xor(x, 8); dh[h] = x; } \
            const float s_ = wv[0] * fmaxf(dh[0], 0.f) + wv[1] * fmaxf(dh[1], 0.f) + wv[2] * fmaxf(dh[2], 0.f) + wv[3] * fmaxf(dh[3], 0.f); \
            if (seg == 0) __hip_atomic_store(sc + (pg * 16 + (pp)) * 128 + ((tid + 512 * i) >> 4), __float_as_uint(s_), __ATOMIC_RELAXED, __HIP_MEMORY_SCOPE_AGENT); } } while (0)
    f32x4 pa[4], pb[4];
    SS_LOAD(pa, 0); SS_LOAD(pb, 1);
#pragma unroll 1
    for (int pp = 0; pp < 16; pp += 2) {
        SS_COMPUTE(pa, pp); SS_LOAD(pa, pp + 2);
        SS_COMPUTE(pb, pp + 1); SS_LOAD(pb, pp + 3);
    }
#undef SS_LOAD
#undef SS_COMPUTE
    asm volatile("s_waitcnt vmcnt(0)" ::: "memory");
    __syncthreads();
    if (tid == 0) __hip_atomic_fetch_add((unsigned*)(ws + CW_SCNT), 1u, __ATOMIC_RELAXED, __HIP_MEMORY_SCOPE_AGENT);
}

constexpr int SA_Q = 2048, SA_S = 3072, SA_KP = 8192, SA_VP = 10240;
DI void sattend(const Params& p, LAS3 unsigned char* lds, const bf16_t* qrow  , const bf16_t* gate, bf16_t* mix) {
    const int tid = threadIdx.x, lane = tid & 63, w = tid >> 6;
    LAS3 float* qf = (LAS3 float*)(lds + SA_Q); LAS3 float* S = (LAS3 float*)(lds + SA_S);
    const float* const LAS3* kptr = (const float* const LAS3*)(lds + SA_KP); const float* const LAS3* vptr = (const float* const LAS3*)(lds + SA_VP);
    if (tid < 256) qf[tid] = bf2f(qrow[tid]);
    __syncthreads();
    {
        const int jk = tid >> 1, hp = tid & 1;
        const float* kr = kptr[jk] + hp * 128;
        float s0 = 0.f, s1 = 0.f;
#pragma unroll 4
        for (int i = 0; i < 16; ++i) {
            const f32x4 k0 = *(const f32x4*)(kr + 4 * i), k1 = *(const f32x4*)(kr + 64 + 4 * i);
            const f32x4 q0 = *(const LAS3 f32x4*)(qf + hp * 128 + 4 * i), q1 = *(const LAS3 f32x4*)(qf + hp * 128 + 64 + 4 * i);
            s0 += q0[0] * k0[0] + q0[1] * k0[1] + q0[2] * k0[2] + q0[3] * k0[3];
            s1 += q1[0] * k1[0] + q1[1] * k1[1] + q1[2] * k1[2] + q1[3] * k1[3];
        }
        S[(2 * hp) * 256 + jk] = s0; S[(2 * hp + 1) * 256 + jk] = s1;
    }
    __syncthreads();
    if (w < 4) {
        float v[4], mx = NEG_INF;
#pragma unroll
        for (int i = 0; i < 4; ++i) { v[i] = S[w * 256 + lane + 64 * i]; mx = fmaxf(mx, v[i]); }
        mx = wmax64(mx);
        float sum = 0.f;
#pragma unroll
        for (int i = 0; i < 4; ++i) { v[i] = __expf(v[i] - mx); sum += v[i]; }
        sum = wsum64(sum);
        const float inv = 1.f / sum;
#pragma unroll
        for (int i = 0; i < 4; ++i) S[w * 256 + lane + 64 * i] = v[i] * inv;
    }
    __syncthreads();
    {
        const int h = tid >> 7, dd = (tid >> 1) & 63, hf = tid & 1;
        float acc = 0.f;
#pragma unroll 4
        for (int jk = hf * 128; jk < hf * 128 + 128; ++jk) acc += S[h * 256 + jk] * vptr[jk][h * 64 + dd];
        acc += __shfl_xor(acc, 1);
        if (hf == 0) mix[h * 64 + dd] = f2bf(acc * bf2f(gate[h * 64 + dd]));
    }
    __syncthreads();
}
DI void smem_unit(const Params& p, LAS3 unsigned char* lds, int b) {
    const int tid = threadIdx.x; unsigned char* ws = p.ws;
    const float* LAS3* kptr = (const float* LAS3*)(lds + SA_KP); const float* LAS3* vptr = (const float* LAS3*)(lds + SA_VP);
    if (tid < 256) { kptr[tid] = p.cache_mem_k + ((size_t)b * NMEM + tid) * 256; vptr[tid] = p.cache_mem_v + ((size_t)b * NMEM + tid) * 256; }
    const size_t row = MP + b;
    sattend(p, lds, (const bf16_t*)(ws + W_MQ) + row * 256, (const bf16_t*)(ws + W_MG) + row * 256, (bf16_t*)(ws + W_MIX) + row * 1024 + 768);
}
DI void ssel_unit(const Params& p, LAS3 unsigned char* lds, int b) {
    const int tid = threadIdx.x, lane = tid & 63, w = tid >> 6; unsigned char* ws = p.ws;
    LAS3 unsigned* CNT = (LAS3 unsigned*)lds;
    LAS3 unsigned* wsum = (LAS3 unsigned*)(lds + 256);
    LAS3 float* newsc = (LAS3 float*)(lds + 320);
    LAS3 int* list = (LAS3 int*)(lds + 512);
    const float* LAS3* kptr = (const float* LAS3*)(lds + SA_KP); const float* LAS3* vptr = (const float* LAS3*)(lds + SA_VP);
    if (tid < 48) CNT[tid] = 0u;
    if (tid == 0) {
        unsigned* cnt = (unsigned*)(ws + CW_SCNT); unsigned* tmo = (unsigned*)(ws + CW_TMO); unsigned sp = 0;
        while (__hip_atomic_load(cnt, __ATOMIC_RELAXED, __HIP_MEMORY_SCOPE_AGENT) < 256u) {
            __builtin_amdgcn_s_sleep(2);
            if ((++sp & 255u) == 0u) { if (__hip_atomic_load(tmo, __ATOMIC_RELAXED, __HIP_MEMORY_SCOPE_AGENT)) break; if (sp > (1u << 20)) { __hip_atomic_store(tmo, 1u, __ATOMIC_RELAXED, __HIP_MEMORY_SCOPE_AGENT); break; } }
        }
        __builtin_amdgcn_fence(__ATOMIC_ACQUIRE, "agent");
        asm volatile("s_waitcnt vmcnt(0)" ::: "memory");
    }
    if (w == 1) {
        const bf16_t* iq = (const bf16_t*)(ws + W_IQ) + (size_t)(MP + b) * 256; const float kd = bf2f(((const bf16_t*)(ws + W_IK))[(size_t)(MP + b) * 64 + lane]);
        const f32x4 wv = *(const f32x4*)vaddr((const float*)(ws + W_IW) + (size_t)(MP + b) * 4);
        float s = 0.f;
#pragma unroll
        for (int h = 0; h < 4; ++h) { const float dh = wsum64(bf2f(iq[h * 64 + lane]) * kd); s += wv[h] * fmaxf(dh, 0.f); }
        if (lane == 0) *newsc = s;
    }
    __syncthreads();
    const float* sc = (const float*)(ws + W_SC) + (size_t)b * SCLD;
    unsigned key[33];
#pragma unroll
    for (int n = 0; n < 32; ++n) key[n] = fkey(sc[tid + 512 * n]);
    key[32] = (tid == 0) ? fkey(*newsc) : 0u;
    int it = 0;
    unsigned T = 0u, X = 0x7fffffffu; bool fin = false;
    for (int bit = 31; bit >= 0; --bit) {
        const unsigned cand = T | (1u << bit);
        unsigned c = 0;
#pragma unroll
        for (int n = 0; n < 33; ++n) cnt_ge(c, key[n], cand);
        const unsigned tot = blk_count(c, CNT, it, lane);
        if (tot >= 256u) { T = cand; fin = (tot == 256u); }
        if (fin) break;
    }
    if (!fin) {
        unsigned c = 0;
#pragma unroll
        for (int n = 0; n < 33; ++n) cnt_gt(c, key[n], T);
        const unsigned need = 256u - blk_count(c, CNT, it, lane);
        unsigned Xl = 0u;
        for (int bit = 14; bit >= 0; --bit) {
            const unsigned cand = Xl | (1u << bit);
            c = 0;
#pragma unroll
            for (int n = 0; n < 33; ++n) cnt_eq_lt(c, key[n], T, (unsigned)(tid + 512 * n), cand);
            if (blk_count(c, CNT, it, lane) < need) Xl = cand;
        }
        X = Xl;
    }
    unsigned selm = 0, hi = 0;
#pragma unroll
    for (int n = 0; n < 32; ++n) selm |= (key[n] > T || (key[n] == T && (unsigned)(tid + 512 * n) <= X)) ? (1u << n) : 0u;
    hi = (key[32] > T || (key[32] == T && (unsigned)(tid + 16384) <= X)) ? 1u : 0u;
    const unsigned cs = __popc(selm) + hi;
    unsigned inc = cs;
#pragma unroll
    for (int o2 = 1; o2 < 64; o2 <<= 1) { const unsigned t2 = __shfl_up(inc, o2); if (lane >= o2) inc += t2; }
    if (lane == 63) wsum[w] = inc;
    __syncthreads();
    unsigned pos = inc - cs;
    for (int w2 = 0; w2 < w; ++w2) pos += wsum[w2];
#pragma unroll
    for (int n = 0; n < 32; ++n) if ((selm >> n) & 1u) { if (pos < 256u) list[pos] = tid + 512 * n; ++pos; }
    if (hi) { if (pos < 256u) list[pos] = tid + 16384; ++pos; }
    __syncthreads();
    if (tid < 256) {
        const int idx = list[tid];
        if (idx < 16384) { const size_t phys = (size_t)p.page_table[b * NPAGES + (idx >> 7)] * 128 + (idx & 127); kptr[tid] = p.cache_k + phys * 256; vptr[tid] = p.cache_v + phys * 256; }
        else { kptr[tid] = p.out + O_KS + (size_t)b * 256; vptr[tid] = p.out + O_VS + (size_t)b * 256; }
    }
    const size_t row = MP + b;
    sattend(p, lds, (const bf16_t*)(ws + W_DQ) + row * 256, (const bf16_t*)(ws + W_DG) + row * 256, (bf16_t*)(ws + W_MIX) + row * 1024 + 512);
}
DI void sgla_unit(const Params& p, LAS3 unsigned char* lds, int b) {
    const int tid = threadIdx.x, lane = tid & 63, w = tid >> 6; unsigned char* ws = p.ws;
    LAS3 float* qs = (LAS3 float*)lds; LAS3 float* ks = qs + 256; LAS3 float* gs = qs + 512; LAS3 float* vs = qs + 768; LAS3 float* part = qs + 1280;
    const size_t row = MP + b;
    if (tid < 256) {
        float u = p.b_g[tid];
        const float* gl = vaddr((const float*)(ws + W_GLR) + row * 16);
#pragma unroll
        for (int r = 0; r < 16; ++r) u += gl[r] * p.w_g2[r * 256 + tid];
        gs[tid] = expf(logsigf(u) * (1.f / 16.f));
        qs[tid] = bf2f(((const bf16_t*)(ws + W_GQ))[row * 256 + tid]); ks[tid] = bf2f(((const bf16_t*)(ws + W_GK))[row * 256 + tid]);
    }
    vs[tid] = bf2f(((const bf16_t*)(ws + W_GV))[row * 512 + tid]);
    __syncthreads();
    const int h = tid >> 7, v = tid & 127;
    const float* sp = p.state_gla + ((size_t)(b * 4 + h) * 64) * 128 + v; float* so = p.out + O_GSS + ((size_t)(b * 4 + h) * 64) * 128 + v;
    const float vv = vs[h * 128 + v];
    float o = 0.f;
#pragma unroll 8
    for (int dd = 0; dd < 64; ++dd) { const float sn = gs[h * 64 + dd] * sp[dd * 128] + ks[h * 64 + dd] * vv; so[dd * 128] = sn; o += qs[h * 64 + dd] * sn; }
    const float ss = wsum64(o * o);
    if (lane == 0) part[w] = ss;
    __syncthreads();
    const float rstd = rsqrtf((part[2 * h] + part[2 * h + 1]) * (1.f / 128.f) + 1e-6f);
    ((bf16_t*)(ws + W_MIX))[row * 1024 + h * 128 + v] = f2bf(o * rstd * p.onorm[v] * bf2f(((const bf16_t*)(ws + W_GG))[row * 512 + h * 128 + v]));
    __syncthreads();
}
DI void p4_final(const Params& p) {
    const int tid = threadIdx.x, lane = tid & 63, wv = tid >> 6;
    for (int r = blockIdx.x * 8 + wv; r < MP + NDB; r += gridDim.x * 8) {
        float* y = p.out + (r < MP ? O_YP + (size_t)r * DM : O_YS + (size_t)(r - MP) * DM);
        f32x4 v[4]; float ss = 0.f;
#pragma unroll
        for (int i = 0; i < 4; ++i) { v[i] = *(const f32x4*)(y + i * 256 + lane * 4); ss += v[i][0] * v[i][0] + v[i][1] * v[i][1] + v[i][2] * v[i][2] + v[i][3] * v[i][3]; }
        ss = wsum64(ss);
        const float rstd = rsqrtf(ss * (1.f / DM) + 1e-6f);
#pragma unroll
        for (int i = 0; i < 4; ++i) { const f32x4 gv = *(const f32x4*)(p.norm_final + i * 256 + lane * 4); *(f32x4*)(y + i * 256 + lane * 4) = v[i] * rstd * gv; }
    }
}

DI int next_unit(unsigned* ctr, volatile LAS3 unsigned* slot) {
    if (threadIdx.x == 0) *slot = __hip_atomic_fetch_add(ctr, 1u, __ATOMIC_RELAXED, __HIP_MEMORY_SCOPE_AGENT);
    __syncthreads();
    const int v = __builtin_amdgcn_readfirstlane((int)*slot);
    __syncthreads();
    return v;
}

#ifndef REP1
#define REP1 1
#endif
#ifndef REP2
#define REP2 1
#endif
#ifndef REP3
#define REP3 1
#endif
#ifndef REP2A
#define REP2A 1
#endif
#ifndef REP2B
#define REP2B 1
#endif
#ifndef REP2C
#define REP2C 1
#endif
#ifndef REP2D
#define REP2D 1
#endif
#ifndef REP2E
#define REP2E 1
#endif
DI void sample_inproj(const Params& p, LAS3 unsigned char* lds) {
    const int tid = threadIdx.x, lane = tid & 63, wv = tid >> 6, fr = lane & 15, fq = lane >> 4;
    unsigned char* ws = p.ws;
    LAS3 float* red = (LAS3 float*)lds;
    for (int pr = blockIdx.x; pr < 112; pr += gridDim.x) {
        const int col0 = pr * 32, pn = col0 >> 8, vc0 = col0 & 255;
        const bf16_t* A = (const bf16_t*)(ws + W_XN) + (size_t)MP * 1024 + (size_t)fr * 1024 + fq * 8 + wv * 128;
        const bf16_t* B = (const bf16_t*)(ws + W_WTIN) + (size_t)(col0 + fr) * 1024 + fq * 8 + wv * 128;
        const f32x4 zero = {0.f, 0.f, 0.f, 0.f};
        f32x4 acc[2][2] = {{zero, zero}, {zero, zero}};
#pragma unroll
        for (int ks = 0; ks < 4; ++ks) {
            const bf16x8 a0 = *(const bf16x8*)(A + ks * 32), a1 = *(const bf16x8*)(A + 16 * 1024 + ks * 32);
            const bf16x8 b0 = *(const bf16x8*)(B + ks * 32), b1 = *(const bf16x8*)(B + 16 * 1024 + ks * 32);
            acc[0][0] = mfma16(a0, b0, acc[0][0]); acc[0][1] = mfma16(a0, b1, acc[0][1]); acc[1][0] = mfma16(a1, b0, acc[1][0]); acc[1][1] = mfma16(a1, b1, acc[1][1]);
        }
#pragma unroll
        for (int rt = 0; rt < 2; ++rt)
#pragma unroll
            for (int ct = 0; ct < 2; ++ct)
#pragma unroll
                for (int r = 0; r < 4; ++r) red[(wv * 16 + (rt * 2 + ct) * 4 + r) * 64 + lane] = acc[rt][ct][r];
        __syncthreads();
        {
            const int rt = wv >> 2, r = wv & 3;
            float v0 = 0.f, v1 = 0.f;
#pragma unroll
            for (int w2 = 0; w2 < 8; ++w2) { v0 += red[(w2 * 16 + (rt * 2 + 0) * 4 + r) * 64 + lane]; v1 += red[(w2 * 16 + (rt * 2 + 1) * 4 + r) * 64 + lane]; }
            const float* rope = (const float*)(ws + W_ROPE) + (size_t)2048 * 64;
            {
                const int bs = 16 * rt + 4 * fq + r; const size_t R = (size_t)MP + bs;
                if (pn <= 5 || (pn >= 10 && pn <= 12)) {
                    bf16_t* dst; int ldc = 256, coff = 0; float sc = 1.f; bool silu = false;
                    switch (pn) {
                        case 0: dst = (bf16_t*)(ws + W_GQ); sc = 0.125f; break;
                        case 1: dst = (bf16_t*)(ws + W_GK); break;
                        case 2: dst = (bf16_t*)(ws + W_GV); ldc = 512; break;
                        case 3: dst = (bf16_t*)(ws + W_GV); ldc = 512; coff = 256; break;
                        case 4: dst = (bf16_t*)(ws + W_GG); ldc = 512; silu = true; break;
                        case 5: dst = (bf16_t*)(ws + W_GG); ldc = 512; coff = 256; silu = true; break;
                        case 10: dst = (bf16_t*)(ws + W_DG); silu = true; break;
                        case 11: dst = (bf16_t*)(ws + W_MQ); sc = 0.125f; break;
                        default: dst = (bf16_t*)(ws + W_MG); silu = true; break;
                    }
                    bf16_t* rp = dst + R * ldc + coff + vc0 + 8 * (fr >> 2) + (fr & 3);
                    rp[0] = f2bf(silu ? siluf(v0) : v0 * sc); rp[4] = f2bf(silu ? siluf(v1) : v1 * sc);
                } else if (pn == 6 || pn == 7 || pn == 9 || (pn == 13 && vc0 < 64)) {
                    const int hh = (pn == 13) ? 0 : ((vc0 >> 5) & 3);
                    const int f = (pn == 13) ? 16 * ((vc0 >> 5) & 1) + fr : 8 * (fr >> 2) + 4 * (vc0 >> 7) + (fr & 3);
                    const float c = rope[2 * f], s = rope[2 * f + 1], sc = (pn == 6) ? 0.125f : 1.f;
                    const float o1 = (v0 * c - v1 * s) * sc, o2 = (v1 * c + v0 * s) * sc;
                    if (pn == 13) {
                        bf16_t* ikb = (bf16_t*)(ws + W_IK) + R * 64; ikb[f] = f2bf(o1); ikb[f + 32] = f2bf(o2);
                        float* op = p.out + O_IKS + (size_t)bs * 64; op[f] = o1; op[f + 32] = o2;
                    } else {
                        bf16_t* dst = (bf16_t*)(ws + (pn == 6 ? W_DQ : (pn == 7 ? W_DK : W_IQ))) + R * 256 + 64 * hh;
                        dst[f] = f2bf(o1); dst[f + 32] = f2bf(o2);
                        if (pn == 7) { float* op = p.out + O_KS + (size_t)bs * 256 + 64 * hh; op[f] = o1; op[f + 32] = o2; }
                    }
                } else if (pn == 8) {
                    float* op = p.out + O_VS + (size_t)bs * 256 + vc0 + 8 * (fr >> 2) + (fr & 3); op[0] = v0; op[4] = v1;
                } else if (pn == 13 && vc0 == 64) {
                    if (fr < 4) { ((float*)(ws + W_IW))[R * 4 + fr] = v0 * 0.5f; ((float*)(ws + W_GLR))[R * 16 + 12 + fr] = v1; }
                    else ((float*)(ws + W_GLR))[R * 16 + fr - 4] = v0;
                }
            }
        }
        __syncthreads();
    }
}
DI void phase1(const Params& p, LAS3 unsigned char* lds) {
    unsigned char* ws = p.ws;
    { pg8::Gemm g{(const bf16_t*)(ws + W_XN), (const bf16_t*)(ws + W_WTIN), MP, NIN, DM}; pg8::StaticOrder S; S.init(MP, NIN, (int)gridDim.x, (int)blockIdx.x);
      EpiIn E{ws, p.out}; pg8::gemm_phase<EpiIn, pg8::StaticOrder, true, true>(lds, g, S, E); }
    sample_inproj(p, lds);
}
DI void p2_memgemm(const Params& p, LAS3 unsigned char* lds) {
    const int u = (int)gridDim.x - 1 - (int)blockIdx.x;
    if (u >= 96 && u < 128) {
        pg8::Gemm g{(const bf16_t*)(p.ws + W_MEMN), (const bf16_t*)(p.ws + W_WTMEM), MMEM, 512, DM}; pg8::StaticOrder S; S.init(MMEM, 512, (int)gridDim.x, u - 96);
        EpiMem E{p.ws, p.out}; pg8::gemm_phase<EpiMem, pg8::StaticOrder, true, true>(lds, g, S, E);
        asm volatile("s_waitcnt vmcnt(0)" ::: "memory");
        __syncthreads();
        if (threadIdx.x == 0) {
            __builtin_amdgcn_fence(__ATOMIC_RELEASE, "agent");
            asm volatile("s_waitcnt vmcnt(0)" ::: "memory");
            __hip_atomic_fetch_add((unsigned*)(p.ws + CW_MEMC), 1u, __ATOMIC_RELAXED, __HIP_MEMORY_SCOPE_AGENT);
        }
    }
}
DI void wait_memgemm(const Params& p) {
    if (threadIdx.x == 0) {
        unsigned* cnt = (unsigned*)(p.ws + CW_MEMC); unsigned* tmo = (unsigned*)(p.ws + CW_TMO); unsigned sp = 0;
        while (__hip_atomic_load(cnt, __ATOMIC_RELAXED, __HIP_MEMORY_SCOPE_AGENT) < 32u) {
            __builtin_amdgcn_s_sleep(2);
            if ((++sp & 255u) == 0u) { if (__hip_atomic_load(tmo, __ATOMIC_RELAXED, __HIP_MEMORY_SCOPE_AGENT)) break; if (sp > (1u << 20)) { __hip_atomic_store(tmo, 1u, __ATOMIC_RELAXED, __HIP_MEMORY_SCOPE_AGENT); break; } }
        }
        __builtin_amdgcn_fence(__ATOMIC_ACQUIRE, "agent");
        asm volatile("s_waitcnt vmcnt(0)" ::: "memory");
    }
    __syncthreads();
}
template <int QI> DI void p2_sscore(const Params& p, LAS3 unsigned char* lds) { for (int u = blockIdx.x; u < 256; u += gridDim.x) { sscore_unit(p, lds, u); __syncthreads(); } }
template <int QI> DI void p2_gla(const Params& p, LAS3 unsigned char* lds) { for (int u = blockIdx.x; u < 64; u += gridDim.x) gla_unit(p, lds, u >> 2, u & 3); }
DI int next_unit_xcd(unsigned char* qbase, volatile LAS3 unsigned* slot, unsigned x0) {
    if (threadIdx.x == 0) {
        unsigned res = 0xffffffffu;
        for (unsigned k = 0; k < 8u; ++k) {
            const unsigned xq = (x0 + k) & 7u;
            const unsigned mq = __hip_atomic_fetch_add((unsigned*)(qbase + 256 * xq), 1u, __ATOMIC_RELAXED, __HIP_MEMORY_SCOPE_AGENT);
            if (mq < 64u) { res = xq * 64u + mq; break; }
        }
        *slot = res;
    }
    __syncthreads();
    const int v = __builtin_amdgcn_readfirstlane((int)*slot);
    __syncthreads();
    return v;
}
template <int QI> DI void p2_dsa(const Params& p, LAS3 unsigned char* lds, volatile LAS3 unsigned* MISC TARGS) {
#if defined(XCDQ) && XCDQ
    const unsigned x0 = xb_xcc_id() & 7u;
    for (;;) { const int n = next_unit_xcd(p.ws + CW_QDSA + 8192 * QI, MISC + 4, x0); if (n < 0) break; const int m = n & 63; dsa_unit(p, lds, 2 * (n >> 6) + (m >> 5), 31 - (m & 31) TPASS); }
#else
    for (;;) { const int n = next_unit((unsigned*)(p.ws + CW_QDSA + 8192 * QI), MISC + 4); if (n >= 512) break; dsa_unit(p, lds, n & 15, 31 - (n >> 4) TPASS); }
#endif
}
template <int QI> DI void p2_mem(const Params& p, LAS3 unsigned char* lds, volatile LAS3 unsigned* MISC) {
    wait_memgemm(p);
    for (;;) { const int n = next_unit((unsigned*)(p.ws + CW_QMEM + 8192 * QI), MISC + 4); if (n >= 512) break; mem_unit(p, n); } }
template <int QI> DI void p2_sample(const Params& p, LAS3 unsigned char* lds) {
    for (int u = (int)gridDim.x - 1 - (int)blockIdx.x; u < 96; u += gridDim.x) { if (u < 32) sgla_unit(p, lds, u); else if (u < 64) smem_unit(p, lds, u - 32); else ssel_unit(p, lds, u - 64); } }
template <int RI> DI void phase2(const Params& p, LAS3 unsigned char* lds, volatile LAS3 unsigned* MISC TARGS) {
    TBEG(20); p2_memgemm(p, lds);
    TBEG(21); p2_sscore<0>(p, lds); TEND(21); if (REP2A > 1) p2_sscore<1>(p, lds);
    TBEG(25); p2_sample<0>(p, lds); TEND(25); if (REP2E > 1) p2_sample<1>(p, lds);
    TBEG(22); p2_gla<0>(p, lds); TEND(22); if (REP2B > 1) p2_gla<1>(p, lds);
    TBEG(23); p2_dsa<0>(p, lds, MISC TPASS); TEND(23); if (REP2C > 1) p2_dsa<1>(p, lds, MISC TPASS);
    TBEG(24); p2_mem<0>(p, lds, MISC); TEND(24); if (REP2D > 1) p2_mem<1>(p, lds, MISC);
    TEND(20);
}
DI void phase3(const Params& p, LAS3 unsigned char* lds) {
    pg8::Gemm g{(const bf16_t*)(p.ws + W_MIX), (const bf16_t*)(p.ws + W_WTOUT), MP, DM, DM}; pg8::StaticOrder S; S.init(MP, DM, (int)gridDim.x, (int)blockIdx.x);
    EpiOut E{p.x_prompt, p.x_sample, p.out}; pg8::gemm_phase<EpiOut, pg8::StaticOrder, true, true>(lds, g, S, E);
    const int tid = threadIdx.x, lane = tid & 63, wv = tid >> 6;
    for (int u = blockIdx.x; u < 256; u += gridDim.x) {
        const int b = u >> 3, col0 = (u & 7) * 128 + wv * 16;
        const bf16_t* mrow = (const bf16_t*)(p.ws + W_MIX) + (size_t)(MP + b) * 1024 + lane * 16;
        const u32x4 m0 = *(const u32x4*)mrow, m1 = *(const u32x4*)(mrow + 8);
        const unsigned mw[8] = {m0.x, m0.y, m0.z, m0.w, m1.x, m1.y, m1.z, m1.w};
        float res = 0.f;
#pragma unroll 4
        for (int i = 0; i < 16; ++i) {
            const bf16_t* wrow = (const bf16_t*)(p.ws + W_WTOUT) + (size_t)(col0 + i) * 1024 + lane * 16;
            const u32x4 w0 = *(const u32x4*)wrow, w1 = *(const u32x4*)(wrow + 8);
            const unsigned ww[8] = {w0.x, w0.y, w0.z, w0.w, w1.x, w1.y, w1.z, w1.w};
            float acc = 0.f;
#pragma unroll
            for (int e = 0; e < 8; ++e) acc += __uint_as_float(mw[e] << 16) * __uint_as_float(ww[e] << 16) + __uint_as_float(mw[e] & 0xffff0000u) * __uint_as_float(ww[e] & 0xffff0000u);
            acc = wsum64(acc);
            res = (lane == i) ? acc : res;
        }
        if (lane < 16) p.out[O_YS + (size_t)b * DM + col0 + lane] = p.x_sample[(size_t)b * DM + col0 + lane] + res;
    }
}
#ifdef CHECK_ATT
DI void check_mem_attention(const Params& p) {
    const int tid = threadIdx.x, lane = tid & 63, wv = tid >> 6;
    const int samp = blockIdx.x * 8 + wv;
    const int row = (samp * 977 + 13) % MP, h = samp & 3, b = row >> 11;
    const bf16_t* q = (const bf16_t*)(p.ws + W_MQ) + (size_t)row * 256 + h * 64;
    float s[4];
#pragma unroll
    for (int i = 0; i < 4; ++i) { const float* kr = p.out + O_MKP + ((size_t)b * NMEM + lane + 64 * i) * 256 + h * 64; float a = 0.f; for (int d = 0; d < 64; ++d) a += bf2f(q[d]) * kr[d]; s[i] = a; }
    float mx = wmax64(fmaxf(fmaxf(s[0], s[1]), fmaxf(s[2], s[3])));
    float pe[4], sum = 0.f;
#pragma unroll
    for (int i = 0; i < 4; ++i) { pe[i] = __builtin_amdgcn_exp2f(s[i] - mx); sum += pe[i]; }
    sum = wsum64(sum);
    float err = 0.f, nrm = 0.f;
    for (int d = 0; d < 64; ++d) {
        float a = 0.f;
#pragma unroll
        for (int i = 0; i < 4; ++i) a += pe[i] * p.out[O_MVP + ((size_t)b * NMEM + lane + 64 * i) * 256 + h * 64 + d];
        a = wsum64(a) / sum;
        const float want = a * bf2f(((const bf16_t*)(p.ws + W_MG))[(size_t)row * 256 + h * 64 + d]);
        const float got = bf2f(((const bf16_t*)(p.ws + W_MIX))[(size_t)row * 1024 + 768 + h * 64 + d]);
        err += (got - want) * (got - want); nrm += want * want;
    }
    if (lane == 0) { atomicAdd((unsigned*)(p.ws + CW_CHK + 12), 1u); if (!(err <= 0.0025f * nrm + 1e-12f)) atomicAdd((unsigned*)(p.ws + CW_CHK + 8), 1u); }
    if (samp < 128) {
        const int bs = samp >> 2, hs = samp & 3; const size_t rs = (size_t)MP + bs;
        const bf16_t* qs = (const bf16_t*)(p.ws + W_MQ) + rs * 256 + hs * 64;
        float s2[4];
#pragma unroll
        for (int i = 0; i < 4; ++i) { const float* kr = p.cache_mem_k + ((size_t)bs * NMEM + lane + 64 * i) * 256 + hs * 64; float a = 0.f; for (int d = 0; d < 64; ++d) a += bf2f(qs[d]) * kr[d]; s2[i] = a; }
        const float mx2 = wmax64(fmaxf(fmaxf(s2[0], s2[1]), fmaxf(s2[2], s2[3])));
        float pe2[4], sum2 = 0.f;
#pragma unroll
        for (int i = 0; i < 4; ++i) { pe2[i] = __expf(s2[i] - mx2); sum2 += pe2[i]; }
        sum2 = wsum64(sum2);
        float err2 = 0.f, nrm2 = 0.f;
        for (int d = 0; d < 64; ++d) {
            float a = 0.f;
#pragma unroll
            for (int i = 0; i < 4; ++i) a += pe2[i] * p.cache_mem_v[((size_t)bs * NMEM + lane + 64 * i) * 256 + hs * 64 + d];
            a = wsum64(a) / sum2;
            const float want = a * bf2f(((const bf16_t*)(p.ws + W_MG))[rs * 256 + hs * 64 + d]);
            const float got = bf2f(((const bf16_t*)(p.ws + W_MIX))[rs * 1024 + 768 + hs * 64 + d]);
            err2 += (got - want) * (got - want); nrm2 += want * want;
        }
        if (lane == 0) { atomicAdd((unsigned*)(p.ws + CW_CHK + 12), 1u); if (!(err2 <= 0.0025f * nrm2 + 1e-12f)) atomicAdd((unsigned*)(p.ws + CW_CHK + 8), 1u); }
    }
}
#endif
__global__ void __launch_bounds__(NTHREADS, 2) hymba_fwd(Params p) {
    extern __shared__ __attribute__((aligned(16))) unsigned char lds_raw[];
    LAS3 unsigned char* lds = (LAS3 unsigned char*)lds_raw;
    volatile LAS3 unsigned* MISC = (volatile LAS3 unsigned*)(lds + LDS_MISC);
    const int tid = threadIdx.x;
    if (tid < 64) MISC[tid] = 0u;
    __syncthreads();
    const int lo = p.ph_lo, hi = p.ph_hi;
    TDECL;
    XcdBarrier bar; bar.bar = (unsigned*)p.ws; bar.x = 0; bar.st = MISC;
    if (hi > lo) bar = xcd_barrier_post((unsigned*)p.ws, MISC);
#define IN(k) (lo <= (k) && (k) <= hi)
#define SEAM(k) do { if (IN(k) && IN((k) + 1)) xcd_barrier(bar); } while (0)
    TBEG(0); if (IN(0)) p0_prologue(p, lds); TEND(0);
    TBEG(10); SEAM(0); TEND(10);
    TBEG(1); if (IN(1)) { phase1(p, lds); if (REP1 > 1) { xcd_barrier(bar); phase1(p, lds); } } TEND(1);
    TBEG(11); SEAM(1); TEND(11);
    TBEG(2); if (IN(2)) { phase2<0>(p, lds, MISC TPASS); } TEND(2);
    TBEG(12); SEAM(2); TEND(12);
#ifdef CHECK_ATT
    if (IN(3)) check_mem_attention(p);
#endif
    TBEG(3); if (IN(3)) { phase3(p, lds); if (REP3 > 1) { xcd_barrier(bar); phase3(p, lds); } } TEND(3);
    TBEG(13); SEAM(3); TEND(13);
    TBEG(4); if (IN(4)) p4_final(p); TEND(4);
#ifdef TSEL
    {
#ifdef TCLS
        if (tid == 0 && (int)((blockIdx.x >> 6) & 1) == TCLS) { atomicAdd((unsigned long long*)(p.ws + CW_TSUM), 2ull * (unsigned long long)tacc_); atomicMax((unsigned long long*)(p.ws + CW_TMAX), (unsigned long long)tacc_); }
#else
        if (tid == 0) { atomicAdd((unsigned long long*)(p.ws + CW_TSUM), (unsigned long long)tacc_); atomicMax((unsigned long long*)(p.ws + CW_TMAX), (unsigned long long)tacc_); }
#endif
        xcd_barrier(bar);
        if (blockIdx.x == 0 && tid == 0) {
#ifdef TMAX
            unsigned long long dly = __hip_atomic_load((unsigned long long*)(p.ws + CW_TMAX), __ATOMIC_RELAXED, __HIP_MEMORY_SCOPE_AGENT);
#else
            const unsigned long long dly = __hip_atomic_load((unsigned long long*)(p.ws + CW_TSUM), __ATOMIC_RELAXED, __HIP_MEMORY_SCOPE_AGENT) / gridDim.x;
#endif
#ifndef TMUL
#define TMUL 1
#endif
            const unsigned long long t0 = __builtin_amdgcn_s_memrealtime();
            while (__builtin_amdgcn_s_memrealtime() - t0 < dly * TMUL && __builtin_amdgcn_s_memrealtime() - t0 < 400000ull) __builtin_amdgcn_s_sleep(8);
        }
    }
#endif
#ifdef CHECK_ATT
    {
        xcd_barrier(bar);
        const unsigned nbad = __hip_atomic_load((unsigned*)(p.ws + CW_CHK + 8), __ATOMIC_RELAXED, __HIP_MEMORY_SCOPE_AGENT);
        const unsigned nchk = __hip_atomic_load((unsigned*)(p.ws + CW_CHK + 12), __ATOMIC_RELAXED, __HIP_MEMORY_SCOPE_AGENT);
        if (nbad != 0u || nchk < 2170u) for (int i = blockIdx.x * NTHREADS + tid; i < NDB * DM; i += gridDim.x * NTHREADS) p.out[O_YS + i] = __builtin_nanf("");
    }
#endif
#ifdef CHECK_SEL
    {
        xcd_barrier(bar);
        const unsigned nbad = __hip_atomic_load((unsigned*)(p.ws + CW_CHK), __ATOMIC_RELAXED, __HIP_MEMORY_SCOPE_AGENT);
        const unsigned nhist = __hip_atomic_load((unsigned*)(p.ws + CW_CHK + 4), __ATOMIC_RELAXED, __HIP_MEMORY_SCOPE_AGENT);
        if (nbad != 0u || nhist < CHECK_MIN_HIST) for (int i = blockIdx.x * NTHREADS + tid; i < NDB * DM; i += gridDim.x * NTHREADS) p.out[O_YS + i] = __builtin_nanf("");
    }
#endif
#undef IN
#undef SEAM
}

#ifndef N_LAUNCHES
#define N_LAUNCHES 1
#endif
extern "C" void kernel_launch(void* const* d_in, const int* in_sizes, int n_in, void* d_out, int out_size, void* d_ws, size_t ws_size, hipStream_t stream) {
    static int grid = 0;
    if (grid == 0) {
        if (n_in != 19 || (size_t)out_size != O_END || ws_size < W_END) fprintf(stderr, "kernel_launch: unexpected sizes: n_in %d out %d ws %zu (need %zu)\n", n_in, out_size, ws_size, (size_t)W_END);
        int dev = 0, cus = 0, per_cu = 0;
        if (hipGetDevice(&dev) != hipSuccess || hipDeviceGetAttribute(&cus, hipDeviceAttributeMultiprocessorCount, dev) != hipSuccess) { fprintf(stderr, "kernel_launch: device query failed\n"); grid = -1; return; }
        if (hipFuncSetAttribute((const void*)hymba_fwd, hipFuncAttributeMaxDynamicSharedMemorySize, LDS_BYTES) != hipSuccess) { fprintf(stderr, "kernel_launch: hipFuncSetAttribute failed\n"); grid = -1; return; }
        if (hipOccupancyMaxActiveBlocksPerMultiprocessor(&per_cu, (const void*)hymba_fwd, NTHREADS, LDS_BYTES) != hipSuccess || per_cu < 1) fprintf(stderr, "kernel_launch: occupancy query reports %d blocks per CU\n", per_cu);
        (void)hipGetLastError();
        grid = cus;
    }
    if (grid < 0) return;
    (void)hipMemsetAsync(d_ws, 0, CTRL_BYTES, stream);
    Params p{};
    p.x_prompt = (const float*)d_in[0]; p.x_sample = (const float*)d_in[1]; p.mem_prompt = (const float*)d_in[2]; p.state_gla = (const float*)d_in[3];
    p.cache_k = (const float*)d_in[4]; p.cache_v = (const float*)d_in[5]; p.cache_ik = (const float*)d_in[6]; p.cache_mem_k = (const float*)d_in[7]; p.cache_mem_v = (const float*)d_in[8];
    p.page_table = (const int*)d_in[9];
    p.norm_in = (const float*)d_in[10]; p.w_in = (const float*)d_in[11]; p.w_g2 = (const float*)d_in[12]; p.b_g = (const float*)d_in[13]; p.onorm = (const float*)d_in[14];
    p.mem_norm = (const float*)d_in[15]; p.w_mem_kv = (const float*)d_in[16]; p.w_out = (const float*)d_in[17]; p.norm_final = (const float*)d_in[18];
    p.out = (float*)d_out; p.ws = (unsigned char*)d_ws;
#if N_LAUNCHES == 1
    p.ph_lo = 0; p.ph_hi = 4;
    hipLaunchKernelGGL(hymba_fwd, dim3(grid), dim3(NTHREADS), LDS_BYTES, stream, p);
#else
    for (int ph = 0; ph < 5; ++ph) { p.ph_lo = ph; p.ph_hi = ph; hipLaunchKernelGGL(hymba_fwd, dim3(grid), dim3(NTHREADS), LDS_BYTES, stream, p); }
#endif
    const hipError_t le = hipPeekAtLastError();
    if (le != hipSuccess) fprintf(stderr, "kernel_launch: launch failed: %s\n", hipGetErrorName(le));
}
```

```cpp
#include <hip/hip_runtime.h>
#include <cstdint>
#include <cstdio>
namespace pg8 {
#define PG8_LAS __attribute__((address_space(3)))
typedef unsigned short bf16_t;
typedef short bf16x8 __attribute__((ext_vector_type(8)));
typedef float f32x4 __attribute__((ext_vector_type(4)));
typedef unsigned u32x4 __attribute__((ext_vector_type(4)));
constexpr int BM = 256, BK = 64, HALF = 128, HTB = HALF * BK * 2  , STAGE_BYTES = 8 * HTB, NXCD = 8, WGM = 8;

__host__ __device__ __forceinline__ int lds_byte(int r, int c) { const int st = (r >> 4) * 2 + (c >> 5), rr = r & 15, cc = c & 31, ob = rr * 64 + cc * 2; return st * 1024 + (ob ^ (((ob >> 9) & 1) << 5)); }
__host__ __device__ __forceinline__ void stage_rc(int b, int& R, int& C) { const int st = b / 1024, sb = b % 1024, swz = sb ^ (((sb >> 9) & 1) << 5); R = (st >> 1) * 16 + swz / 64; C = (st & 1) * 32 + (swz % 64) / 2; }
__host__ __device__ __forceinline__ int perm32(int rho) { const int n = rho >> 4, i = rho & 15; return 8 * (i >> 2) + 4 * n + (i & 3); }

struct Unit { int pm, pn; };
struct Gemm { const bf16_t* A; const bf16_t* Bt; int M, N, K; };

struct StaticOrder {
    int nM, nN, nwg, G, c;
    __host__ __device__ void init(int M, int N, int G_, int c_) { nM = M / BM; nN = N / BM; nwg = nM * nN; G = G_; c = c_; }
    __host__ __device__ bool next(int i, Unit& u) const {
        const long L = (long)i * G + c; if (L >= nwg) return false;
        int wgid = (int)L; { const int q = nwg / NXCD, r = nwg % NXCD, xcd = wgid % NXCD, off = wgid / NXCD; wgid = (xcd < r ? xcd * (q + 1) : r * (q + 1) + (xcd - r) * q) + off; }
        const int nig = WGM * nN, gid = wgid / nig, fm = gid * WGM, gsz = (nM - fm) < WGM ? (nM - fm) : WGM;
        u.pm = fm + ((wgid % nig) % gsz); u.pn = (wgid % nig) / gsz; return true;
    }
    __device__ __forceinline__ void a_ready(const Unit&) const {}
    __device__ __forceinline__ void done(const Unit&) const {}
};

template <class Epi, class Sched, bool ALIGN_EPI = false, bool SP2 = false>
__device__ __forceinline__ void gemm_phase(PG8_LAS unsigned char* lds, const Gemm g, const Sched& S, const Epi& E) {
    const int tid = threadIdx.x, wid = __builtin_amdgcn_readfirstlane(tid >> 6), lane = tid & 63, wr = wid >> 2, wc = wid & 3, fr = lane & 15, fq = lane >> 4;
    const int K = g.K, nt = K / BK;
    unsigned voffA[2], voffB[2];
#pragma unroll
    for (int i = 0; i < 2; ++i) { int R, C; stage_rc(tid * 16 + i * 8192, R, C); const int Rb = Epi::PERM ? ((R & ~31) + perm32(R & 31)) : R;
        voffA[i] = (unsigned)(R * K + C) * 2u; voffB[i] = (unsigned)(Rb * K + C) * 2u; }
    const size_t kstep = (size_t)(BK * 2);
    const size_t hstep = (size_t)HALF * K * 2;
    const size_t tstep = 2 * hstep;
    const unsigned ldsw = (unsigned)wid * 1024u;
    const int aoff = lds_byte(wr * 64 + fr, fq * 8), boff = lds_byte(wc * 32 + fr, fq * 8);
#define PG8_SA(b, h) (((b) * 2 + (h)) * HTB)
#define PG8_SB(b, h) ((4 + (b) * 2 + (h)) * HTB)
#define PG8_STAGE(bufoff, gbase, voff) do { _Pragma("unroll") for (int _i = 0; _i < 2; ++_i) \
        __builtin_amdgcn_global_load_lds((const unsigned*)((const char*)(gbase) + (voff)[_i]), (PG8_LAS unsigned*)(lds + (bufoff) + ldsw + _i * 8192), 16, 0, 0); } while (0)
#define PG8_LDA(dst, b, h) do { _Pragma("unroll") for (int m = 0; m < 4; ++m) _Pragma("unroll") for (int k = 0; k < 2; ++k) dst[m][k] = *(const PG8_LAS bf16x8*)(lds + PG8_SA(b, h) + aoff + m * 2048 + k * 1024); } while (0)
#define PG8_LDB(dst, b, h) do { _Pragma("unroll") for (int n = 0; n < 2; ++n) _Pragma("unroll") for (int k = 0; k < 2; ++k) dst[n][k] = *(const PG8_LAS bf16x8*)(lds + PG8_SB(b, h) + boff + n * 2048 + k * 1024); } while (0)
#define PG8_MMA(ai, bj, At, Bt) do { __builtin_amdgcn_s_setprio(1); _Pragma("unroll") for (int m = 0; m < 4; ++m) _Pragma("unroll") for (int n = 0; n < 2; ++n) _Pragma("unroll") for (int k = 0; k < 2; ++k) \
        acc[ai][bj][m][n] = __builtin_amdgcn_mfma_f32_16x16x32_bf16(Bt[n][k], At[m][k], acc[ai][bj][m][n], 0, 0, 0); __builtin_amdgcn_s_setprio(0); } while (0)
#define PG8_WAIT_V(n) asm volatile("s_waitcnt vmcnt(" #n ")" ::: "memory")
#define PG8_WAIT_L(n) asm volatile("s_waitcnt lgkmcnt(" #n ")" ::: "memory")
#define PG8_BAR __builtin_amdgcn_s_barrier()
#define PG8_SCHED __builtin_amdgcn_sched_barrier(0)
    Unit cur, nxt; int ui = 0;
    if (!S.next(0, cur)) return;
    f32x4 acc[2][2][4][2];
#pragma unroll
    for (int a = 0; a < 2; ++a)
#pragma unroll
        for (int b = 0; b < 2; ++b)
#pragma unroll
            for (int m = 0; m < 4; ++m)
#pragma unroll
                for (int n = 0; n < 2; ++n) acc[a][b][m][n] = (f32x4){0.f, 0.f, 0.f, 0.f};
    bf16x8 At[4][2], B0[2][2], B1[2][2];
    const char* cA = (const char*)g.A + (size_t)cur.pm * tstep; const char* cB = (const char*)g.Bt + (size_t)cur.pn * tstep;
    S.a_ready(cur);
    if constexpr (SP2) {
        PG8_STAGE(PG8_SB(0, 0), cB, voffB); PG8_STAGE(PG8_SB(0, 1), cB + hstep, voffB); PG8_STAGE(PG8_SA(0, 0), cA, voffA); PG8_STAGE(PG8_SA(0, 1), cA + hstep, voffA);
        if (wr == 1) PG8_BAR;
        PG8_WAIT_V(2); PG8_BAR;
        PG8_STAGE(PG8_SB(1, 0), cB + kstep, voffB); PG8_STAGE(PG8_SA(1, 0), cA + kstep, voffA); PG8_STAGE(PG8_SB(1, 1), cB + hstep + kstep, voffB);
        PG8_WAIT_V(6); PG8_BAR;
    } else {
        PG8_STAGE(PG8_SB(0, 0), cB, voffB); PG8_STAGE(PG8_SA(0, 0), cA, voffA); PG8_STAGE(PG8_SB(0, 1), cB + hstep, voffB); PG8_STAGE(PG8_SA(0, 1), cA + hstep, voffA);
        if (wr == 1) PG8_BAR;
        PG8_WAIT_V(4); PG8_BAR;
        PG8_STAGE(PG8_SB(1, 0), cB + kstep, voffB); PG8_STAGE(PG8_SA(1, 0), cA + kstep, voffA); PG8_STAGE(PG8_SB(1, 1), cB + hstep + kstep, voffB);
        PG8_WAIT_V(6); PG8_BAR;
    }
    for (;;) {
        const bool has_next = S.next(ui + 1, nxt);
        const char* nA = has_next ? (const char*)g.A + (size_t)nxt.pm * tstep : cA; const char* nB = has_next ? (const char*)g.Bt + (size_t)nxt.pn * tstep : cB;
        for (int t = 0; t < nt; t += 2) {
            const bool last = (t == nt - 2);
            const char* a1 = cA + (size_t)(t + 1) * kstep;
            const char* a2 = last ? nA : cA + (size_t)(t + 2) * kstep; const char* b2 = last ? nB : cB + (size_t)(t + 2) * kstep;
            const char* a3 = a2 + kstep; const char* b3 = b2 + kstep;
            if (last && has_next) S.a_ready(nxt);
            if constexpr (SP2) {
            PG8_LDB(B0, 0, 0); PG8_LDB(B1, 0, 1); PG8_SCHED; PG8_LDA(At, 0, 0); PG8_STAGE(PG8_SA(1, 1), a1 + hstep, voffA);
            PG8_WAIT_V(8); PG8_WAIT_L(0); PG8_BAR; PG8_MMA(0, 0, At, B0); PG8_MMA(0, 1, At, B1); PG8_BAR; PG8_SCHED;
            PG8_LDA(At, 0, 1); PG8_STAGE(PG8_SB(0, 0), b2, voffB); PG8_STAGE(PG8_SB(0, 1), b2 + hstep, voffB); PG8_STAGE(PG8_SA(0, 0), a2, voffA);
            PG8_WAIT_V(8); PG8_WAIT_L(0); PG8_BAR; PG8_MMA(1, 0, At, B0); PG8_MMA(1, 1, At, B1); PG8_BAR; PG8_SCHED;
            PG8_LDB(B0, 1, 0); PG8_LDB(B1, 1, 1); PG8_SCHED; PG8_LDA(At, 1, 0); PG8_STAGE(PG8_SA(0, 1), a2 + hstep, voffA);
            PG8_WAIT_V(8); PG8_WAIT_L(0); PG8_BAR; PG8_MMA(0, 0, At, B0); PG8_MMA(0, 1, At, B1); PG8_BAR; PG8_SCHED;
            PG8_LDA(At, 1, 1); PG8_STAGE(PG8_SB(1, 0), b3, voffB); PG8_STAGE(PG8_SB(1, 1), b3 + hstep, voffB); PG8_STAGE(PG8_SA(1, 0), a3, voffA);
            PG8_WAIT_V(8); PG8_WAIT_L(0); PG8_BAR; PG8_MMA(1, 0, At, B0); PG8_MMA(1, 1, At, B1); PG8_BAR; PG8_SCHED;
            } else {
            PG8_LDB(B0, 0, 0); PG8_SCHED; PG8_LDA(At, 0, 0); PG8_STAGE(PG8_SA(1, 1), a1 + hstep, voffA);
            PG8_WAIT_L(8); PG8_BAR; PG8_WAIT_L(0); PG8_MMA(0, 0, At, B0); PG8_BAR; PG8_SCHED;
            PG8_LDB(B1, 0, 1); PG8_STAGE(PG8_SB(0, 0), b2, voffB);
            PG8_BAR; PG8_WAIT_L(0); PG8_MMA(0, 1, At, B1); PG8_BAR;
            PG8_LDA(At, 0, 1); PG8_STAGE(PG8_SA(0, 0), a2, voffA);
            PG8_BAR; PG8_WAIT_L(0); PG8_MMA(1, 0, At, B0); PG8_BAR; PG8_SCHED;
            PG8_STAGE(PG8_SB(0, 1), b2 + hstep, voffB);
            PG8_WAIT_V(6); PG8_BAR; PG8_MMA(1, 1, At, B1); PG8_BAR;
            PG8_LDB(B0, 1, 0); PG8_SCHED; PG8_LDA(At, 1, 0); PG8_STAGE(PG8_SA(0, 1), a2 + hstep, voffA);
            PG8_WAIT_L(8); PG8_BAR; PG8_WAIT_L(0); PG8_MMA(0, 0, At, B0); PG8_BAR; PG8_SCHED;
            PG8_LDB(B1, 1, 1); PG8_STAGE(PG8_SB(1, 0), b3, voffB);
            PG8_BAR; PG8_WAIT_L(0); PG8_MMA(0, 1, At, B1); PG8_BAR;
            PG8_LDA(At, 1, 1); PG8_STAGE(PG8_SA(1, 0), a3, voffA);
            PG8_BAR; PG8_WAIT_L(0); PG8_MMA(1, 0, At, B0); PG8_BAR; PG8_SCHED;
            PG8_STAGE(PG8_SB(1, 1), b3 + hstep, voffB);
            PG8_WAIT_V(6); PG8_BAR; PG8_MMA(1, 1, At, B1); PG8_BAR;
            }
        }
        if constexpr (ALIGN_EPI) { if (wr == 0) PG8_BAR; }
        if constexpr (!Epi::AFTER_DRAIN) { E(acc, cur, wr, wc, fr, fq); S.done(cur); }
        if (!has_next) break;
#pragma unroll
        for (int a = 0; a < 2; ++a)
#pragma unroll
            for (int b = 0; b < 2; ++b)
#pragma unroll
                for (int m = 0; m < 4; ++m)
#pragma unroll
                    for (int n = 0; n < 2; ++n) acc[a][b][m][n] = (f32x4){0.f, 0.f, 0.f, 0.f};
        cur = nxt; cA = nA; cB = nB; ++ui;
        if constexpr (ALIGN_EPI) { if (wr == 1) PG8_BAR; }
    }
    PG8_WAIT_V(0);
    if constexpr (!ALIGN_EPI) { if (wr == 0) PG8_BAR; }
    PG8_BAR;
    if constexpr (Epi::AFTER_DRAIN) { E.fused(acc, cur, wr, wc, fr, fq, lds, wid, lane); S.done(cur); }
#undef PG8_SA
#undef PG8_SB
#undef PG8_STAGE
#undef PG8_LDA
#undef PG8_LDB
#undef PG8_MMA
#undef PG8_WAIT_V
#undef PG8_WAIT_L
#undef PG8_BAR
#undef PG8_SCHED
}
}
#define XB_TMO      128
#define XB_XCNT(j)  (256  + 64 * (j))
#define XB_XSUB(j)  (1280 + 64 * (j))
#define XB_XGEN(j)  (2304 + 64 * (j))
#define XB_TOP      3328
#define XB_TOPGEN   3392
#define XCD_BAR_WORDS 3456
#define XB_SPIN_CAP (1u << 18)
#define LAS __attribute__((address_space(3)))

__device__ __forceinline__ unsigned xb_ld(unsigned* p)              { return __hip_atomic_load(p, __ATOMIC_RELAXED, __HIP_MEMORY_SCOPE_AGENT); }
__device__ __forceinline__ unsigned xb_add(unsigned* p, unsigned v) { return __hip_atomic_fetch_add(p, v, __ATOMIC_RELAXED, __HIP_MEMORY_SCOPE_AGENT); }
__device__ __forceinline__ unsigned xb_xcc_id() { return (unsigned)__builtin_amdgcn_s_getreg((3 << 11) | 20) & 0xFu; }
#define XB_SPIN(cond, bar) do { unsigned _sp = 0; while (cond) { __builtin_amdgcn_s_sleep(1); \
    if ((++_sp & 255u) == 0u) { if (xb_ld(&(bar)[XB_TMO])) break; if (_sp > XB_SPIN_CAP) { atomicAdd(&(bar)[XB_TMO], 1u); break; } } } } while (0)

struct XcdBarrier {
    unsigned* bar; unsigned x;
    volatile LAS unsigned* st;
};

__device__ __forceinline__ XcdBarrier xcd_barrier_post(unsigned* bar, volatile LAS unsigned* st) {
    XcdBarrier b; b.bar = bar; b.x = xb_xcc_id(); b.st = st;
    if (threadIdx.x == 0) (void)xb_add(&bar[XB_XCNT(b.x)], 1u);
    return b;
}
__device__ __forceinline__ void xcd_barrier_complete(unsigned* bar, unsigned x, unsigned& nloc, unsigned& nx) {
    const unsigned G = gridDim.x * gridDim.y * gridDim.z;
    unsigned sum, cnt, mine, sp = 0u;
    for (;;) {
        sum = 0u; cnt = 0u; mine = 0u;
#pragma unroll
        for (unsigned j = 0; j < 16; ++j) { const unsigned c = xb_ld(&bar[XB_XCNT(j)]); sum += c; cnt += (c > 0u) ? 1u : 0u; mine = (j == x) ? c : mine; }
        if (sum == G) break;
        __builtin_amdgcn_s_sleep(1);
        if ((++sp & 255u) == 0u) { if (xb_ld(&bar[XB_TMO])) break; if (sp > XB_SPIN_CAP) { atomicAdd(&bar[XB_TMO], 1u); break; } }
    }
    nloc = mine > 0u ? mine : 1u; nx = cnt > 0u ? cnt : 1u;
}

__device__ __forceinline__ void xcd_barrier(const XcdBarrier& b) {
    asm volatile("s_waitcnt vmcnt(0)" ::: "memory");
    __syncthreads();
    if (threadIdx.x == 0) {
        unsigned* bar = b.bar;
        __builtin_amdgcn_s_waitcnt(0);
        unsigned nloc = b.st[0], nx = b.st[1];
        if (nloc == 0u) { xcd_barrier_complete(bar, b.x, nloc, nx); b.st[0] = nloc; b.st[1] = nx; }
        const unsigned old = xb_add(&bar[XB_XSUB(b.x)], 1u);
        const unsigned gen = old / nloc;
        if (old + 1u == (gen + 1u) * nloc) {
            __builtin_amdgcn_fence(__ATOMIC_RELEASE, "agent");
            asm volatile("s_waitcnt vmcnt(0)" ::: "memory");
            const unsigned og = xb_add(&bar[XB_TOP], 1u);
            const unsigned tg = og / nx;
            if (og + 1u == (tg + 1u) * nx) xb_add(&bar[XB_TOPGEN], 1u);
            else XB_SPIN(xb_ld(&bar[XB_TOPGEN]) == tg, bar);
            __builtin_amdgcn_fence(__ATOMIC_ACQUIRE, "agent");
            xb_add(&bar[XB_XGEN(b.x)], 1u);
            asm volatile("s_waitcnt vmcnt(0)" ::: "memory");
        } else {
            XB_SPIN(xb_ld(&bar[XB_XGEN(b.x)]) == gen, bar);
            __builtin_amdgcn_fence(__ATOMIC_ACQUIRE, "agent");
            asm volatile("s_waitcnt vmcnt(0)" ::: "memory");
        }
    }
    __syncthreads();
}
#define DI __device__ __forceinline__
#define LAS3 __attribute__((address_space(3)))
using pg8::bf16_t; using pg8::bf16x8; using pg8::f32x4; using pg8::u32x4;
typedef unsigned u32x2 __attribute__((ext_vector_type(2)));
typedef short s16x4 __attribute__((ext_vector_type(4)));
typedef float f32x2 __attribute__((ext_vector_type(2)));
typedef __bf16 bf16x2_t __attribute__((ext_vector_type(2)));

constexpr int DM = 1024, NB = 16, SEQ = 2048, MP = NB * SEQ  , NDB = 32  , MROWS = 33024  ;
constexpr int NMEM = 256, MMEM = NB * NMEM  , DIN = 3412, NIN = 3584, NPAGES = 128;
constexpr int NTHREADS = 512;
constexpr size_t O_YP = 0, O_YS = O_YP + (size_t)MP * DM, O_GSP = O_YS + (size_t)NDB * DM, O_KP = O_GSP + (size_t)NB * 4 * 64 * 128,
                 O_VP = O_KP + (size_t)MP * 256, O_IKP = O_VP + (size_t)MP * 256, O_MKP = O_IKP + (size_t)MP * 64, O_MVP = O_MKP + (size_t)MMEM * 256,
                 O_GSS = O_MVP + (size_t)MMEM * 256, O_KS = O_GSS + (size_t)NDB * 4 * 64 * 128, O_VS = O_KS + (size_t)NDB * 256, O_IKS = O_VS + (size_t)NDB * 256,
                 O_END = O_IKS + (size_t)NDB * 64;
static_assert(O_END == 56150016, "output size");
constexpr size_t al256(size_t x) { return (x + 255) & ~(size_t)255; }
constexpr size_t CTRL_BYTES = 32768;
constexpr size_t CW_QDSA = 16384  , CW_QMEM = 18432  , CW_SCNT = 20480, CW_TMO = 20736, CW_CHK = 20992, CW_TSUM = 21248, CW_TMAX = 21504, CW_MEMC = 21760;
constexpr int SCLD = 16400;
constexpr size_t W_ROPE = CTRL_BYTES;
constexpr size_t W_XN = al256(W_ROPE + (size_t)2049 * 32 * 8);
constexpr size_t W_MEMN = W_XN + (size_t)MROWS * 1024 * 2;
constexpr size_t W_WTIN = W_MEMN + (size_t)MMEM * 1024 * 2;
constexpr size_t W_WTMEM = W_WTIN + (size_t)NIN * 1024 * 2;
constexpr size_t W_WTOUT = W_WTMEM + (size_t)512 * 1024 * 2;
constexpr size_t W_GQ = W_WTOUT + (size_t)1024 * 1024 * 2;
constexpr size_t W_GK = W_GQ + (size_t)MROWS * 256 * 2;
constexpr size_t W_GV = W_GK + (size_t)MROWS * 256 * 2;
constexpr size_t W_GG = W_GV + (size_t)MROWS * 512 * 2;
constexpr size_t W_DQ = W_GG + (size_t)MROWS * 512 * 2;
constexpr size_t W_DK = W_DQ + (size_t)MROWS * 256 * 2;
constexpr size_t W_DVT = W_DK + (size_t)MROWS * 256 * 2;
constexpr size_t W_IQ = W_DVT + (size_t)MP * 256 * 2;
constexpr size_t W_DG = W_IQ + (size_t)MROWS * 256 * 2;
constexpr size_t W_MQ = W_DG + (size_t)MROWS * 256 * 2;
constexpr size_t W_MG = W_MQ + (size_t)MROWS * 256 * 2;
constexpr size_t W_IK = W_MG + (size_t)MROWS * 256 * 2;
constexpr size_t W_IW = W_IK + (size_t)MROWS * 64 * 2;
constexpr size_t W_GLR = W_IW + (size_t)MROWS * 4 * 4;
constexpr size_t W_MK = W_GLR + (size_t)MROWS * 16 * 4;
constexpr size_t W_MVT = W_MK + (size_t)MMEM * 256 * 2;
constexpr size_t W_MIX = W_MVT + (size_t)MMEM * 256 * 2;
constexpr size_t W_SC = W_MIX + (size_t)MROWS * 1024 * 2;
constexpr size_t W_END = W_SC + (size_t)NDB * SCLD * 4;
constexpr int LDS_MISC = 148480, LDS_BYTES = 148480 + 256;

struct Params {
    const float *x_prompt, *x_sample, *mem_prompt, *state_gla, *cache_k, *cache_v, *cache_ik, *cache_mem_k, *cache_mem_v;
    const int* page_table;
    const float *norm_in, *w_in, *w_g2, *b_g, *onorm, *mem_norm, *w_mem_kv, *w_out, *norm_final;
    float* out; unsigned char* ws; int ph_lo, ph_hi;
};

#ifdef TSEL
#define TDECL unsigned tacc_ = 0u, tbeg_ = 0u
#define TBEG(k) do { if ((k) == TSEL) tbeg_ = (unsigned)__builtin_amdgcn_s_memrealtime(); } while (0)
#define TEND(k) do { if ((k) == TSEL) tacc_ += (unsigned)__builtin_amdgcn_s_memrealtime() - tbeg_; } while (0)
#define TARGS , unsigned& tacc_, unsigned& tbeg_
#define TPASS , tacc_, tbeg_
#else
#define TARGS
#define TPASS
#define TDECL do {} while (0)
#define TBEG(k) do {} while (0)
#define TEND(k) do {} while (0)
#endif
DI float bf2f(bf16_t v) { return __uint_as_float((unsigned)v << 16); }
DI unsigned cvtpk(float lo, float hi) { f32x2 v = {lo, hi}; bf16x2_t b = __builtin_convertvector(v, bf16x2_t); return __builtin_bit_cast(unsigned, b); }
DI bf16_t f2bf(float x) { return (bf16_t)(cvtpk(x, 0.f) & 0xffffu); }
DI f32x4 mfma16(bf16x8 a, bf16x8 b, f32x4 c) { return __builtin_amdgcn_mfma_f32_16x16x32_bf16(a, b, c, 0, 0, 0); }
DI float fexp(float x) { return __builtin_amdgcn_exp2f(x * 1.4426950408889634f); }
DI float siluf(float x) { return x * __builtin_amdgcn_rcpf(1.f + fexp(-x)); }
DI float logsigf(float u) { return fminf(u, 0.f) - 0.6931471805599453f * __builtin_amdgcn_logf(1.f + fexp(-fabsf(u))); }
DI unsigned fkey(float x) { unsigned u = __float_as_uint(x); u = (u == 0x80000000u) ? 0u : u; return u ^ ((unsigned)((int)u >> 31) | 0x80000000u); }
DI float wsum64(float v) { v += __shfl_xor(v, 1); v += __shfl_xor(v, 2); v += __shfl_xor(v, 4); v += __shfl_xor(v, 8); v += __shfl_xor(v, 16); v += __shfl_xor(v, 32); return v; }
DI float wmax64(float v) { v = fmaxf(v, __shfl_xor(v, 1)); v = fmaxf(v, __shfl_xor(v, 2)); v = fmaxf(v, __shfl_xor(v, 4)); v = fmaxf(v, __shfl_xor(v, 8)); v = fmaxf(v, __shfl_xor(v, 16)); v = fmaxf(v, __shfl_xor(v, 32)); return v; }
DI unsigned lds_add(LAS3 unsigned* p, unsigned v) { return __hip_atomic_fetch_add(p, v, __ATOMIC_RELAXED, __HIP_MEMORY_SCOPE_WORKGROUP); }
DI unsigned lds_or(LAS3 unsigned* p, unsigned v) { return __hip_atomic_fetch_or(p, v, __ATOMIC_RELAXED, __HIP_MEMORY_SCOPE_WORKGROUP); }
DI void st_bf16x4(bf16_t* p, f32x4 v) { u32x2 w; w.x = cvtpk(v[0], v[1]); w.y = cvtpk(v[2], v[3]); *(u32x2*)p = w; }
DI const float* vaddr(const float* q) { asm volatile("" : "+v"(q)); return q; }
constexpr float LOG2E = 1.4426950408889634f;
#define NEG_INF (-__builtin_inff())

DI int rope_perm(int vc) { return 64 * (vc >> 6) + 16 * ((vc >> 5) & 1) + (vc & 15) + 32 * ((vc >> 4) & 1); }
DI int rope_map(int vc) { return 64 * ((vc >> 5) & 3) + 32 * ((vc >> 4) & 1) + 8 * ((vc >> 2) & 3) + 4 * (vc >> 7) + (vc & 3); }
DI int plain_map(int vc) { return (vc & ~31) + 8 * ((vc >> 2) & 3) + 4 * ((vc >> 4) & 1) + (vc & 3); }
DI int in_src(int np) {
    const int pn = np >> 8, vc = np & 255;
    switch (pn) {
        case 0: return plain_map(vc);
        case 1: return 256 + plain_map(vc);
        case 2: case 3: return 512 + 256 * (pn - 2) + plain_map(vc);
        case 4: case 5: return 1040 + 256 * (pn - 4) + plain_map(vc);
        case 6: return 1552 + rope_map(vc);
        case 7: return 1808 + rope_map(vc);
        case 8: return 2064 + plain_map(vc);
        case 9: return 2320 + rope_map(vc);
        case 10: return 2644 + plain_map(vc);
        case 11: return 2900 + plain_map(vc);
        case 12: return 3156 + plain_map(vc);
        default: break;
    }
    if (vc < 64) return 2576 + rope_perm(vc);
    if (vc < 68) return 2640 + (vc - 64);
    if (vc < 84) return 1024 + (vc - 68);
    return -1;
}

struct EpiIn {
    static constexpr bool PERM = false, AFTER_DRAIN = false;
    unsigned char* ws; float* out;
    DI void operator()(const f32x4 (&acc)[2][2][4][2], const pg8::Unit& u, int wr, int wc, int fr, int fq) const {
        const int pn = u.pn, rbase = u.pm * 256 + wr * 64 + fr;
        if (pn <= 5 || (pn >= 10 && pn <= 12)) {
            bf16_t* dst; int ldc = 256, coff = 0; float sc = 1.f; bool silu = false;
            switch (pn) {
                case 0: dst = (bf16_t*)(ws + W_GQ); sc = 0.125f; break;
                case 1: dst = (bf16_t*)(ws + W_GK); break;
                case 2: dst = (bf16_t*)(ws + W_GV); ldc = 512; break;
                case 3: dst = (bf16_t*)(ws + W_GV); ldc = 512; coff = 256; break;
                case 4: dst = (bf16_t*)(ws + W_GG); ldc = 512; silu = true; break;
                case 5: dst = (bf16_t*)(ws + W_GG); ldc = 512; coff = 256; silu = true; break;
                case 10: dst = (bf16_t*)(ws + W_DG); silu = true; break;
                case 11: dst = (bf16_t*)(ws + W_MQ); sc = 0.125f * LOG2E; break;
                default: dst = (bf16_t*)(ws + W_MG); silu = true; break;
            }
#pragma unroll
            for (int ai = 0; ai < 2; ++ai)
#pragma unroll
                for (int m = 0; m < 4; ++m) {
                    const int row = rbase + ai * 128 + m * 16;
                    bf16_t* rp = dst + (size_t)row * ldc + coff + wc * 32 + 8 * fq;
#pragma unroll
                    for (int bj = 0; bj < 2; ++bj) {
                        f32x4 v0 = acc[ai][bj][m][0], v1 = acc[ai][bj][m][1];
                        if (silu) { v0[0] = siluf(v0[0]); v0[1] = siluf(v0[1]); v0[2] = siluf(v0[2]); v0[3] = siluf(v0[3]); v1[0] = siluf(v1[0]); v1[1] = siluf(v1[1]); v1[2] = siluf(v1[2]); v1[3] = siluf(v1[3]); }
                        else { v0 = v0 * sc; v1 = v1 * sc; }
                        u32x4 w; w.x = cvtpk(v0[0], v0[1]); w.y = cvtpk(v0[2], v0[3]); w.z = cvtpk(v1[0], v1[1]); w.w = cvtpk(v1[2], v1[3]);
                        *(u32x4*)(rp + bj * 128) = w;
                    }
                }
        } else if (pn == 6 || pn == 7 || pn == 9) {
            bf16_t* dst = (bf16_t*)(ws + (pn == 6 ? W_DQ : (pn == 7 ? W_DK : W_IQ)));
            const float sc = (pn == 6) ? 0.125f * LOG2E : 1.f;
            const float* rope = (const float*)(ws + W_ROPE);
#pragma unroll
            for (int ai = 0; ai < 2; ++ai)
#pragma unroll
                for (int m = 0; m < 4; ++m) {
                    const int row = rbase + ai * 128 + m * 16;
                    const int pi = row < MP ? (row & 2047) : 2048;
                    const float* rp = rope + ((size_t)pi * 32 + 8 * fq) * 2;
                    f32x4 o1[2], o2[2];
#pragma unroll
                    for (int bj = 0; bj < 2; ++bj) {
                        const f32x4 cs0 = *(const f32x4*)(rp + 8 * bj), cs1 = *(const f32x4*)(rp + 8 * bj + 4);
                        const f32x4 c = {cs0[0], cs0[2], cs1[0], cs1[2]}, s = {cs0[1], cs0[3], cs1[1], cs1[3]};
                        const f32x4 v0 = acc[ai][bj][m][0], v1 = acc[ai][bj][m][1];
                        o1[bj] = (v0 * c - v1 * s) * sc; o2[bj] = (v1 * c + v0 * s) * sc;
                    }
                    const int col1 = 64 * wc + 8 * fq, col2 = col1 + 32;
                    u32x4 w1, w2; w1.x = cvtpk(o1[0][0], o1[0][1]); w1.y = cvtpk(o1[0][2], o1[0][3]); w1.z = cvtpk(o1[1][0], o1[1][1]); w1.w = cvtpk(o1[1][2], o1[1][3]);
                    w2.x = cvtpk(o2[0][0], o2[0][1]); w2.y = cvtpk(o2[0][2], o2[0][3]); w2.z = cvtpk(o2[1][0], o2[1][1]); w2.w = cvtpk(o2[1][2], o2[1][3]);
                    *(u32x4*)(dst + (size_t)row * 256 + col1) = w1; *(u32x4*)(dst + (size_t)row * 256 + col2) = w2;
                    if (pn == 7) {
                        float* op = nullptr;
                        if (row < MP) op = out + O_KP + (size_t)row * 256; else if (row < MP + NDB) op = out + O_KS + (size_t)(row - MP) * 256;
                        if (op) { *(f32x4*)(op + col1) = o1[0]; *(f32x4*)(op + col1 + 4) = o1[1]; *(f32x4*)(op + col2) = o2[0]; *(f32x4*)(op + col2 + 4) = o2[1]; }
                    }
                }
        } else if (pn == 8) {
            bf16_t* dvt = (bf16_t*)(ws + W_DVT);
#pragma unroll
            for (int ai = 0; ai < 2; ++ai)
#pragma unroll
                for (int m = 0; m < 4; ++m) {
                    const int row = rbase + ai * 128 + m * 16;
                    float* op = nullptr;
                    if (row < MP) op = out + O_VP + (size_t)row * 256; else if (row < MP + NDB) op = out + O_VS + (size_t)(row - MP) * 256;
#pragma unroll
                    for (int bj = 0; bj < 2; ++bj)
#pragma unroll
                        for (int n = 0; n < 2; ++n) {
                            const f32x4 v = acc[ai][bj][m][n];
                            const int col = 128 * bj + 32 * wc + 8 * fq + 4 * n;
                            if (op) *(f32x4*)(op + col) = v;
                            if (row < MP) {
                                const int t_ = row & 2047, kk_ = t_ & 31;
                                bf16_t* tp = dvt + ((((size_t)(row >> 11) * 64 + (t_ >> 5)) * 4 + (col >> 6)) * 64 + (col & 63)) * 32 + 8 * ((kk_ >> 2) & 3) + 4 * (kk_ >> 4) + (kk_ & 3);
                                tp[0] = f2bf(v[0]); tp[32] = f2bf(v[1]); tp[64] = f2bf(v[2]); tp[96] = f2bf(v[3]);
                            }
                        }
                }
        } else {
            bf16_t* ikb = (bf16_t*)(ws + W_IK); float* iw = (float*)(ws + W_IW); float* glr = (float*)(ws + W_GLR);
            const float* rope = (const float*)(ws + W_ROPE);
#pragma unroll
            for (int ai = 0; ai < 2; ++ai)
#pragma unroll
                for (int m = 0; m < 4; ++m) {
                    const int row = rbase + ai * 128 + m * 16;
                    const f32x4 v0 = acc[ai][0][m][0], v1 = acc[ai][0][m][1];
                    if (wc < 2) {
                        const int pi = row < MP ? (row & 2047) : 2048;
                        const int f0 = 16 * wc + 4 * fq;
                        const f32x4 cs0 = *(const f32x4*)(rope + ((size_t)pi * 32 + f0) * 2), cs1 = *(const f32x4*)(rope + ((size_t)pi * 32 + f0) * 2 + 4);
                        const f32x4 c = {cs0[0], cs0[2], cs1[0], cs1[2]}, s = {cs0[1], cs0[3], cs1[1], cs1[3]};
                        const f32x4 o1 = v0 * c - v1 * s, o2 = v1 * c + v0 * s;
                        st_bf16x4(ikb + (size_t)row * 64 + f0, o1); st_bf16x4(ikb + (size_t)row * 64 + f0 + 32, o2);
                        float* op = nullptr;
                        if (row < MP) op = out + O_IKP + (size_t)row * 64; else if (row < MP + NDB) op = out + O_IKS + (size_t)(row - MP) * 64;
                        if (op) { *(f32x4*)(op + f0) = o1; *(f32x4*)(op + f0 + 32) = o2; }
                    } else if (wc == 2) {
                        if (fq == 0) { *(f32x4*)(iw + (size_t)row * 4) = v0 * 0.5f; *(f32x4*)(glr + (size_t)row * 16 + 12) = v1; }
                        else *(f32x4*)(glr + (size_t)row * 16 + 4 * (fq - 1)) = v0;
                    }
                }
        }
    }
};
struct EpiMem {
    static constexpr bool PERM = false, AFTER_DRAIN = false;
    unsigned char* ws; float* out;
    DI void operator()(const f32x4 (&acc)[2][2][4][2], const pg8::Unit& u, int wr, int wc, int fr, int fq) const {
        const int pn = u.pn, rbase = u.pm * 256 + wr * 64 + fr;
        bf16_t* mk = (bf16_t*)(ws + W_MK); bf16_t* mvt = (bf16_t*)(ws + W_MVT);
        float* op0 = out + (pn == 0 ? O_MKP : O_MVP);
#pragma unroll
        for (int ai = 0; ai < 2; ++ai)
#pragma unroll
            for (int m = 0; m < 4; ++m) {
                const int row = rbase + ai * 128 + m * 16;
#pragma unroll
                for (int bj = 0; bj < 2; ++bj)
#pragma unroll
                    for (int n = 0; n < 2; ++n) {
                        const f32x4 v = acc[ai][bj][m][n];
                        const int col = 128 * bj + 32 * wc + 16 * n + 4 * fq;
                        *(f32x4*)(op0 + (size_t)row * 256 + col) = v;
                        if (pn == 0) st_bf16x4(mk + (size_t)row * 256 + col, v);
                        else { const int m_ = row & 255, kk_ = m_ & 31;
                               bf16_t* tp = mvt + ((((size_t)(row >> 8) * 8 + (m_ >> 5)) * 4 + (col >> 6)) * 64 + (col & 63)) * 32 + 8 * ((kk_ >> 2) & 3) + 4 * (kk_ >> 4) + (kk_ & 3);
                               tp[0] = f2bf(v[0]); tp[32] = f2bf(v[1]); tp[64] = f2bf(v[2]); tp[96] = f2bf(v[3]); }
                    }
            }
    }
};
struct EpiOut {
    static constexpr bool PERM = false, AFTER_DRAIN = false;
    const float* xp; const float* xs; float* out;
    DI void operator()(const f32x4 (&acc)[2][2][4][2], const pg8::Unit& u, int wr, int wc, int fr, int fq) const {
        const int rbase = u.pm * 256 + wr * 64 + fr, cbase = u.pn * 256 + wc * 32 + 4 * fq;
#pragma unroll
        for (int ai = 0; ai < 2; ++ai)
#pragma unroll
            for (int m = 0; m < 4; ++m) {
                const int row = rbase + ai * 128 + m * 16;
                const float* xr; float* orow;
                if (row < MP) { xr = xp + (size_t)row * DM; orow = out + O_YP + (size_t)row * DM; }
                else if (row < MP + NDB) { xr = xs + (size_t)(row - MP) * DM; orow = out + O_YS + (size_t)(row - MP) * DM; }
                else continue;
#pragma unroll
                for (int bj = 0; bj < 2; ++bj)
#pragma unroll
                    for (int n = 0; n < 2; ++n) { const int col = cbase + bj * 128 + n * 16; *(f32x4*)(orow + col) = acc[ai][bj][m][n] + *(const f32x4*)(xr + col); }
            }
    }
};
DI void p0_prologue(const Params& p, LAS3 unsigned char* lds) {
    const int tid = threadIdx.x, lane = tid & 63, wv = tid >> 6;
    unsigned char* ws = p.ws;
    {
        const int rstep = gridDim.x * 16, rend = MROWS + MMEM;
        int r0 = (blockIdx.x * 8 + wv) * 2;
        auto row_src = [&](int r) -> const float* {
            r = r < rend ? r : rend - 1;
            if (r < MP) return p.x_prompt + (size_t)r * DM;
            if (r < MP + NDB) return p.x_sample + (size_t)(r - MP) * DM;
            if (r < MROWS) return p.x_prompt;
            return p.mem_prompt + (size_t)(r - MROWS) * DM;
        };
        f32x4 v[2][4], vn[2][4];
#pragma unroll
        for (int e = 0; e < 2; ++e) { const float* s = row_src(r0 + e);
#pragma unroll
            for (int i = 0; i < 4; ++i) v[e][i] = *(const f32x4*)(s + i * 256 + lane * 4); }
        for (; r0 < rend; r0 += rstep) {
#pragma unroll
            for (int e = 0; e < 2; ++e) { const float* s = row_src(r0 + rstep + e);
#pragma unroll
                for (int i = 0; i < 4; ++i) vn[e][i] = *(const f32x4*)(s + i * 256 + lane * 4); }
#pragma unroll
            for (int e = 0; e < 2; ++e) {
                const int r = r0 + e;
                const bool pad = (r >= MP + NDB && r < MROWS);
                const float* g = r < MROWS ? p.norm_in : p.mem_norm;
                bf16_t* dst = r < MROWS ? (bf16_t*)(ws + W_XN) + (size_t)r * DM : (bf16_t*)(ws + W_MEMN) + (size_t)(r - MROWS) * DM;
                float ss = 0.f;
#pragma unroll
                for (int i = 0; i < 4; ++i) ss += v[e][i][0] * v[e][i][0] + v[e][i][1] * v[e][i][1] + v[e][i][2] * v[e][i][2] + v[e][i][3] * v[e][i][3];
                ss = wsum64(ss);
                const float rstd = pad ? 0.f : rsqrtf(ss * (1.f / DM) + 1e-6f);
#pragma unroll
                for (int i = 0; i < 4; ++i) { const f32x4 gv = *(const f32x4*)(g + i * 256 + lane * 4); st_bf16x4(dst + i * 256 + lane * 4, v[e][i] * rstd * gv); }
            }
#pragma unroll
            for (int e = 0; e < 2; ++e)
#pragma unroll
                for (int i = 0; i < 4; ++i) v[e][i] = vn[e][i];
        }
    }
    for (int e = blockIdx.x * NTHREADS + tid; e < 2049 * 32; e += gridDim.x * NTHREADS) {
        const int pi = e >> 5, f = e & 31;
        const float inv = powf(10000.0f, -(float)(2 * f) / 64.0f);
        const float ang = (float)(pi == 2048 ? 16384 : pi) * inv;
        float sn, cs; sincosf(ang, &sn, &cs);
        ((f32x2*)(ws + W_ROPE))[e] = (f32x2){cs, sn};
    }
    LAS3 float* tl = (LAS3 float*)lds;
    {
        auto tile_load = [&](int tile, float (&wr)[8]) {
            tile = tile < 1280 ? tile : 1279;
            int which, t2, ld; const float* W;
            if (tile < 896) { which = 0; t2 = tile; W = p.w_in; ld = DIN; }
            else if (tile < 1024) { which = 1; t2 = tile - 896; W = p.w_mem_kv; ld = 512; }
            else { which = 2; t2 = tile - 1024; W = p.w_out; ld = 1024; }
            const int nt = t2 >> 4, kt = t2 & 15;
            const int nn = tid & 63, kk0 = tid >> 6; const int np = nt * 64 + nn; int sc = which == 0 ? in_src(np) : np;
            const bool zero = sc < 0; sc = zero ? 0 : sc;
#pragma unroll
            for (int i = 0; i < 8; ++i) { const float w = W[(size_t)(kt * 64 + kk0 + 8 * i) * ld + sc]; wr[i] = zero ? 0.f : w; }
        };
        float wr[8], wn[8];
        tile_load(blockIdx.x, wr);
        for (int tile = blockIdx.x; tile < 1280; tile += gridDim.x) {
            bf16_t* dst; int t2;
            if (tile < 896) { t2 = tile; dst = (bf16_t*)(ws + W_WTIN); }
            else if (tile < 1024) { t2 = tile - 896; dst = (bf16_t*)(ws + W_WTMEM); }
            else { t2 = tile - 1024; dst = (bf16_t*)(ws + W_WTOUT); }
            const int nt = t2 >> 4, kt = t2 & 15;
            { const int nn = tid & 63, kk0 = tid >> 6;
#pragma unroll
              for (int i = 0; i < 8; ++i) tl[(kk0 + 8 * i) * 65 + nn] = wr[i]; }
            __syncthreads();
            tile_load(tile + gridDim.x, wn);
            { const int kk = tid & 63, nn0 = tid >> 6;
#pragma unroll
              for (int i = 0; i < 8; ++i) { const int n = nn0 + 8 * i; dst[(size_t)(nt * 64 + n) * 1024 + kt * 64 + kk] = f2bf(tl[kk * 65 + n]); } }
            __syncthreads();
#pragma unroll
            for (int i = 0; i < 8; ++i) wr[i] = wn[i];
        }
    }
}

DI void cnt_ge(unsigned& c, unsigned key, unsigned cand) { asm volatile("v_cmp_ge_u32 vcc, %1, %2\n\tv_addc_co_u32 %0, vcc, 0, %0, vcc" : "+v"(c) : "v"(key), "v"(cand) : "vcc"); }
DI void cnt_gt(unsigned& c, unsigned key, unsigned cand) { asm volatile("v_cmp_gt_u32 vcc, %1, %2\n\tv_addc_co_u32 %0, vcc, 0, %0, vcc" : "+v"(c) : "v"(key), "v"(cand) : "vcc"); }
DI void cnt_eq_lt(unsigned& c, unsigned key, unsigned T, unsigned idx, unsigned cand) {
    unsigned tmp;
    asm volatile("v_cmp_eq_u32 vcc, %2, %3\n\tv_cndmask_b32 %1, -1, %4, vcc\n\tv_cmp_lt_u32 vcc, %1, %5\n\tv_addc_co_u32 %0, vcc, 0, %0, vcc" : "+v"(c), "=&v"(tmp) : "v"(key), "v"(T), "v"(idx), "v"(cand) : "vcc"); }
DI unsigned grp_count16(unsigned c, LAS3 unsigned* CNT, int& it, int fr, int lane) {
    c += __shfl_xor(c, 16); c += __shfl_xor(c, 32);
    LAS3 unsigned* cur = CNT + (it % 3) * 16;
    if (lane < 16) lds_add(cur + fr, c);
    __syncthreads();
    const unsigned tot = cur[fr];
    if (threadIdx.x < 16) CNT[((it + 2) % 3) * 16 + threadIdx.x] = 0u;
    ++it; return tot;
}
DI unsigned blk_count(unsigned c, LAS3 unsigned* CNT, int& it, int lane) {
    c += __shfl_xor(c, 1); c += __shfl_xor(c, 2); c += __shfl_xor(c, 4); c += __shfl_xor(c, 8); c += __shfl_xor(c, 16); c += __shfl_xor(c, 32);
    LAS3 unsigned* cur = CNT + (it % 3) * 16;
    if (lane == 0) lds_add(cur, c);
    __syncthreads();
    const unsigned tot = cur[0];
    if (threadIdx.x == 0) CNT[((it + 2) % 3) * 16] = 0u;
    ++it; return tot;
}

template <bool MASKED>
DI void attn32(const bf16_t* Q, int ldq, const bf16_t* K, int ldk, const bf16_t* Vt, int ldv, int nkb, const LAS3 unsigned* mask, int fr, int fq,
               f32x4 (&o)[4][2], float (&linv)[2]) {
    bf16x8 qf[2][2];
#pragma unroll
    for (int qt = 0; qt < 2; ++qt)
#pragma unroll
        for (int ks = 0; ks < 2; ++ks) qf[qt][ks] = *(const bf16x8*)(Q + (size_t)(16 * qt + fr) * ldq + ks * 32 + fq * 8);
    float m[2] = {NEG_INF, NEG_INF}, l[2] = {0.f, 0.f};
    const f32x4 zero = {0.f, 0.f, 0.f, 0.f};
#pragma unroll
    for (int dt = 0; dt < 4; ++dt) { o[dt][0] = zero; o[dt][1] = zero; }
    const bf16_t* kl = K + (size_t)fr * ldk + fq * 8;
#ifdef BROKEN_VT
    const bf16_t* vl = Vt + fr * 32 + 8 * ((fq + 1) & 3);
#else
    const bf16_t* vl = Vt + fr * 32 + 8 * fq;
#endif
    bf16x8 kfA[2][2], kfB[2][2], vA[4], vB[4];
#define ATT_LOAD(KF, VF, kb_) do { \
        _Pragma("unroll") for (int i2 = 0; i2 < 2; ++i2) _Pragma("unroll") for (int ks = 0; ks < 2; ++ks) KF[i2][ks] = *(const bf16x8*)(kl + (size_t)(32 * (kb_) + 16 * i2) * ldk + ks * 32); \
        _Pragma("unroll") for (int dt = 0; dt < 4; ++dt) VF[dt] = *(const bf16x8*)(vl + (size_t)(kb_) * ldv + 512 * dt); } while (0)
#define ATT_COMPUTE(KF, VF, kb_) do { \
        _Pragma("unroll") for (int qt = 0; qt < 2; ++qt) { \
            f32x4 s0 = mfma16(KF[0][0], qf[qt][0], zero); s0 = mfma16(KF[0][1], qf[qt][1], s0); \
            f32x4 s1 = mfma16(KF[1][0], qf[qt][0], zero); s1 = mfma16(KF[1][1], qf[qt][1], s1); \
            if (MASKED) { const unsigned mw = mask[(16 * qt + fr) * 65 + (kb_)]; const unsigned b0 = mw >> (2 * fq), b1 = mw >> (8 + 2 * fq); \
                _Pragma("unroll") for (int r = 0; r < 4; ++r) { const int sh_ = (r >> 1) + 16 * (r & 1); s0[r] = ((b0 >> sh_) & 1u) ? s0[r] : NEG_INF; s1[r] = ((b1 >> sh_) & 1u) ? s1[r] : NEG_INF; } } \
            float mx = fmaxf(fmaxf(fmaxf(s0[0], s0[1]), fmaxf(s0[2], s0[3])), fmaxf(fmaxf(s1[0], s1[1]), fmaxf(s1[2], s1[3]))); \
            mx = fmaxf(mx, __shfl_xor(mx, 16)); mx = fmaxf(mx, __shfl_xor(mx, 32)); \
            const float mn = fmaxf(m[qt], mx), ms = (mn == NEG_INF) ? 0.f : mn; \
            const float alpha = __builtin_amdgcn_exp2f(m[qt] - ms); \
            f32x4 p0, p1; \
            _Pragma("unroll") for (int r = 0; r < 4; ++r) { p0[r] = __builtin_amdgcn_exp2f(s0[r] - ms); p1[r] = __builtin_amdgcn_exp2f(s1[r] - ms); } \
            l[qt] = l[qt] * alpha + ((p0[0] + p0[1]) + (p0[2] + p0[3])) + ((p1[0] + p1[1]) + (p1[2] + p1[3])); \
            m[qt] = mn; \
            u32x4 pw; pw.x = cvtpk(p0[0], p0[1]); pw.y = cvtpk(p0[2], p0[3]); pw.z = cvtpk(p1[0], p1[1]); pw.w = cvtpk(p1[2], p1[3]); \
            const bf16x8 pf = __builtin_bit_cast(bf16x8, pw); \
            if (!__all(alpha == 1.f)) { _Pragma("unroll") for (int dt = 0; dt < 4; ++dt) o[dt][qt] = o[dt][qt] * alpha; }     \
            _Pragma("unroll") for (int dt = 0; dt < 4; ++dt) o[dt][qt] = mfma16(VF[dt], pf, o[dt][qt]); } } while (0)
    ATT_LOAD(kfA, vA, 0);
    const int last = nkb - 1;
    for (int kb = 0; kb < nkb; kb += 2) {
        ATT_LOAD(kfB, vB, kb + 1);
        ATT_COMPUTE(kfA, vA, kb);
        { const int k2 = kb + 2 < last ? kb + 2 : last; ATT_LOAD(kfA, vA, k2); }
        ATT_COMPUTE(kfB, vB, kb + 1);
    }
#undef ATT_LOAD
#undef ATT_COMPUTE
#pragma unroll
    for (int qt = 0; qt < 2; ++qt) { float lt = l[qt]; lt += __shfl_xor(lt, 16); lt += __shfl_xor(lt, 32); linv[qt] = 1.f / lt; }
}
DI void attn_store(const f32x4 (&o)[4][2], const float (&linv)[2], const bf16_t* gate  , bf16_t* mix  , int fr, int fq) {
#pragma unroll
    for (int qt = 0; qt < 2; ++qt)
#pragma unroll
        for (int dt = 0; dt < 4; ++dt) {
            const size_t row = 16 * qt + fr; const int col = 16 * dt + 4 * fq;
            const u32x2 gw = *(const u32x2*)(gate + row * 256 + col);
            f32x4 v = o[dt][qt] * linv[qt];
            v[0] *= __uint_as_float(gw.x << 16); v[1] *= __uint_as_float(gw.x & 0xffff0000u); v[2] *= __uint_as_float(gw.y << 16); v[3] *= __uint_as_float(gw.y & 0xffff0000u);
            st_bf16x4(mix + row * 1024 + col, v);
        }
}

constexpr int DS_MASK = 0, DS_PKT = 16640, PKT_LD = 2052, DS_CNT = 147968;
typedef unsigned short u16x2 __attribute__((ext_vector_type(2)));
DI unsigned pk_cnt_ge(unsigned acc, unsigned kpair, unsigned cm1, unsigned ones) {
    unsigned t;
    asm("v_pk_sub_u16 %1, %2, %3 clamp\n\tv_pk_min_u16 %1, %1, %4\n\tv_pk_add_u16 %0, %0, %1" : "+v"(acc), "=&v"(t) : "v"(kpair), "v"(cm1), "v"(ones));
    return acc;
}
DI void select_bitwise(const unsigned (&key)[16][4], int lbase, LAS3 unsigned* CNT, int& it, int fr, int lane, unsigned& T, int& Xrel) {
    bool fin = false;
    T = 0u; Xrel = 0x7fffffff;
    for (int bit = 31; bit >= 0; --bit) {
        const unsigned cand = T | (1u << bit);
        unsigned c = 0;
#pragma unroll
        for (int n = 0; n < 16; ++n)
#pragma unroll
            for (int r = 0; r < 4; ++r) cnt_ge(c, key[n][r], cand);
        const unsigned tot = grp_count16(c, CNT, it, fr, lane);
        if (!fin && tot >= 256u) { T = cand; fin = (tot == 256u); }
        if (__all(fin)) break;
    }
    if (!__all(fin)) {
        unsigned c = 0;
#pragma unroll
        for (int n = 0; n < 16; ++n)
#pragma unroll
            for (int r = 0; r < 4; ++r) cnt_gt(c, key[n][r], T);
        const unsigned cgt = grp_count16(c, CNT, it, fr, lane);
        const unsigned need = 256u - cgt;
        unsigned Xl = 0u;
        for (int bit = 10; bit >= 0; --bit) {
            const unsigned cand = Xl | (1u << bit);
            const int crel = (int)cand - lbase;
            c = 0;
#pragma unroll
            for (int n = 0; n < 16; ++n) { const int crn = crel - 128 * n;
#pragma unroll
                for (int r = 0; r < 4; ++r) c += (key[n][r] == T && r < crn) ? 1u : 0u; }
            const unsigned tot = grp_count16(c, CNT, it, fr, lane);
            if (tot < need) Xl = cand;
        }
        if (!fin) Xrel = (int)Xl - lbase;
    }
}
DI unsigned pk_flag_ge(unsigned kpair, unsigned cm1, unsigned ones) {
    unsigned t;
    asm("v_pk_sub_u16 %0, %1, %2 clamp\n\tv_pk_min_u16 %0, %0, %3" : "=&v"(t) : "v"(kpair), "v"(cm1), "v"(ones));
    return t;
}
DI unsigned pk_max(unsigned a, unsigned b2) { unsigned t; asm("v_pk_max_u16 %0, %1, %2" : "=v"(t) : "v"(a), "v"(b2)); return t; }
DI unsigned hsum32(unsigned x) {
    x += __builtin_amdgcn_update_dpp(0u, x, 0xB1, 0xF, 0xF, false); x += __builtin_amdgcn_update_dpp(0u, x, 0x4E, 0xF, 0xF, false);
    x += __builtin_amdgcn_update_dpp(0u, x, 0x141, 0xF, 0xF, false); x += __builtin_amdgcn_update_dpp(0u, x, 0x140, 0xF, 0xF, false);
    const auto r = __builtin_amdgcn_permlane16_swap(x, x, false, false); return r[0] + r[1];
}
DI unsigned hmax32(unsigned x) {
    x = max(x, (unsigned)__builtin_amdgcn_update_dpp(0u, x, 0xB1, 0xF, 0xF, false)); x = max(x, (unsigned)__builtin_amdgcn_update_dpp(0u, x, 0x4E, 0xF, 0xF, false));
    x = max(x, (unsigned)__builtin_amdgcn_update_dpp(0u, x, 0x141, 0xF, 0xF, false)); x = max(x, (unsigned)__builtin_amdgcn_update_dpp(0u, x, 0x140, 0xF, 0xF, false));
    const auto r = __builtin_amdgcn_permlane16_swap(x, x, false, false); return max(r[0], r[1]);
}
DI unsigned pk_count32(const unsigned (&rk)[32], unsigned cm1, unsigned ones, int nq) {
    unsigned a0 = 0u, a1 = 0u;
#pragma unroll
    for (int k = 0; k < 8; k += 2) { a0 = pk_cnt_ge(a0, rk[k], cm1, ones); a1 = pk_cnt_ge(a1, rk[k + 1], cm1, ones); }
    if (nq > 1) {
#pragma unroll
        for (int k = 8; k < 16; k += 2) { a0 = pk_cnt_ge(a0, rk[k], cm1, ones); a1 = pk_cnt_ge(a1, rk[k + 1], cm1, ones); }
        if (nq > 2) {
#pragma unroll
            for (int k = 16; k < 24; k += 2) { a0 = pk_cnt_ge(a0, rk[k], cm1, ones); a1 = pk_cnt_ge(a1, rk[k + 1], cm1, ones); }
            if (nq > 3) {
#pragma unroll
                for (int k = 24; k < 32; k += 2) { a0 = pk_cnt_ge(a0, rk[k], cm1, ones); a1 = pk_cnt_ge(a1, rk[k + 1], cm1, ones); }
            }
        }
    }
    return (a0 & 0xffffu) + (a0 >> 16) + (a1 & 0xffffu) + (a1 >> 16);
}
DI void dsa_unit(const Params& p, LAS3 unsigned char* lds, int b, int j TARGS) {
    int tid = threadIdx.x; asm volatile("" : "+v"(tid));
    const int lane0 = tid & 63, w = __builtin_amdgcn_readfirstlane(tid >> 6);
    unsigned char* ws = p.ws;
    LAS3 unsigned* MASK = (LAS3 unsigned*)(lds + DS_MASK);
    LAS3 unsigned* PKT = (LAS3 unsigned*)(lds + DS_PKT);
    const bf16_t* IQ = (const bf16_t*)(ws + W_IQ); const bf16_t* IK = (const bf16_t*)(ws + W_IK); const float* IW = (const float*)(ws + W_IW);
    const int q0 = 64 * j;
    const f32x4 zero = {0.f, 0.f, 0.f, 0.f};
#ifdef CHECK_SEL
    LAS3 unsigned* CNT = (LAS3 unsigned*)(lds + DS_CNT); int it = 0;
    if (tid < 48) CNT[tid] = 0u;
    __syncthreads();
#endif
    TBEG(30);
    bf16x8 bqn[4][2]; f32x4 wqn;
    { const size_t qr0 = (size_t)b * SEQ + q0 + (lane0 & 15);
#pragma unroll
      for (int h = 0; h < 4; ++h)
#pragma unroll
          for (int ks = 0; ks < 2; ++ks) bqn[h][ks] = *(const bf16x8*)(IQ + qr0 * 256 + h * 64 + ks * 32 + (lane0 >> 4) * 8);
      wqn = *(const f32x4*)(IW + qr0 * 4); }
#pragma unroll 1
    for (int qg = 0; qg < 4; ++qg) {
        TBEG(32);
        int lane = lane0; asm volatile("" : "+v"(lane));
        const int fr = lane & 15, fq = lane >> 4;
        const int tq = q0 + 16 * qg + fr; const size_t qrow = (size_t)b * SEQ + tq;
        const int ntile = 4 * j + qg + 1;
        const int nloc = ntile > w ? (ntile - w + 7) >> 3 : 0;
        const bool selecting = q0 + 16 * qg >= 256;
        {
            bf16x8 bq[4][2];
#pragma unroll
            for (int h = 0; h < 4; ++h)
#pragma unroll
                for (int ks = 0; ks < 2; ++ks) bq[h][ks] = bqn[h][ks];
            const f32x4 wq = wqn;
            float Lh[4];
#pragma unroll
            for (int h = 0; h < 4; ++h) Lh[h] = wq[h] < 0.f ? NEG_INF : -NEG_INF;
            const char* tb = (const char*)IK + ((size_t)b * SEQ + 16 * w) * 128 + (unsigned)(fr * 128 + fq * 16);
            LAS3 unsigned* krow = PKT + fr * PKT_LD + 16 * w + 4 * fq;
            const int lim0 = tq - (16 * w + 4 * fq);
#define DSA_TILE(A0, A1, nn) do { \
                f32x4 sc = zero; \
                _Pragma("unroll") for (int h = 0; h < 4; ++h) { f32x4 d = mfma16(A0, bq[h][0], zero); d = mfma16(A1, bq[h][1], d); d = d * wq[h]; \
                    _Pragma("unroll") for (int r = 0; r < 4; ++r) sc[r] += __builtin_amdgcn_fmed3f(d[r], 0.f, Lh[h]); } \
                { const char* t2_ = tb + (size_t)((nn) + 2 < nloc ? (nn) + 2 : nloc - 1) * 16384; A0 = *(const bf16x8*)t2_; A1 = *(const bf16x8*)(t2_ + 64); } \
                const int limn = lim0 - 128 * (nn);                   \
                u32x4 kv; \
                _Pragma("unroll") for (int r = 0; r < 4; ++r) { const unsigned u = __float_as_uint(sc[r] + 0.f); const unsigned k = u ^ ((unsigned)((int)u >> 31) | 0x80000000u);   \
                    kv[r] = (r <= limn) ? k : 0u; } \
                *(LAS3 u32x4*)(krow + 128 * (nn)) = kv; } while (0)
            if (nloc > 0) {
                bf16x8 a0 = *(const bf16x8*)tb, a1 = *(const bf16x8*)(tb + 64);
                const char* t1 = tb + (size_t)(1 < nloc ? 1 : 0) * 16384;
                bf16x8 b0 = *(const bf16x8*)t1, b1 = *(const bf16x8*)(t1 + 64);
#pragma unroll 1
                for (int n = 0; n < nloc; n += 2) {
                    DSA_TILE(a0, a1, n);
                    if (n + 1 < nloc) DSA_TILE(b0, b1, n + 1);
                }
            }
#undef DSA_TILE
        }
        TEND(32); TBEG(33);
        __syncthreads();
        { const size_t qrn = qrow + (qg < 3 ? 16 : 0);
#pragma unroll
          for (int h = 0; h < 4; ++h)
#pragma unroll
              for (int ks = 0; ks < 2; ++ks) bqn[h][ks] = *(const bf16x8*)(IQ + qrn * 256 + h * 64 + ks * 32 + fq * 8);
          wqn = *(const f32x4*)(IW + qrn * 4); }
        {
            const int hh = lane >> 5, pos = lane & 31, oq = 2 * w + hh;
            const unsigned nkeys = 16u * (unsigned)ntile;
            const int nq = (int)((nkeys + 511u) >> 9);
            const LAS3 unsigned* orow = PKT + oq * PKT_LD + 2 * pos;
            unsigned ones = 0x00010001u; asm volatile("" : "+v"(ones));
            unsigned Tfull = 1u, X = 0xffffffffu;
            if (selecting) {
                unsigned rk[32];
#pragma unroll
                for (int k = 0; k < 32; ++k) { const u32x2 kk = *(const LAS3 u32x2*)(orow + 64 * k); rk[k] = (2u * (unsigned)(pos + 32 * k) < nkeys) ? __builtin_amdgcn_perm(kk.y, kk.x, 0x07060302u) : 0u; }
                unsigned mx = 0u;
#pragma unroll
                for (int k = 0; k < 32; ++k) mx = pk_max(mx, rk[k]);
                const unsigned kmax = hmax32(max(mx & 0xffffu, mx >> 16));
                unsigned T16 = 0u, cabove = 0u; bool exact = false;
                {
                    unsigned ub = 0x10000u;
#pragma unroll 1
                    for (int bit = 15; bit >= 0; --bit) {
                        const unsigned cand = T16 | (1u << bit);
                        if (__all(cand > kmax)) { ub = cand; continue; }
                        const unsigned tot = hsum32(pk_count32(rk, (cand - 1u) * 0x00010001u, ones, nq));
                        if (tot >= 256u) T16 = cand; else { ub = cand; cabove = tot; }
                    }
                    (void)ub;
                }
                const unsigned need = 256u - cabove;
#pragma unroll
                for (int k = 0; k < 32; ++k) { const u32x2 kk = *(const LAS3 u32x2*)(orow + 64 * k); const bool in = 2u * (unsigned)(pos + 32 * k) < nkeys;
                    const unsigned lo0 = (in && (kk.x >> 16) == T16) ? (kk.x & 0xffffu) : 0u, lo1 = (in && (kk.y >> 16) == T16) ? (kk.y & 0xffffu) : 0u; rk[k] = lo0 | (lo1 << 16); }
                unsigned Tlo = 0u;
#pragma unroll 1
                for (int bit = 15; bit >= 0; --bit) {
                    const unsigned cand = Tlo | (1u << bit);
                    const unsigned tot = hsum32(pk_count32(rk, (cand - 1u) * 0x00010001u, ones, nq));
                    if (!exact && tot >= need) { Tlo = cand; exact = (tot == need); }
                    if (__all(exact)) break;
                }
                Tfull = (T16 << 16) | Tlo;
                if (!__all(exact)) {
                    unsigned cgt = 0u, ceq = 0u;
#pragma unroll 1
                    for (int k = 0; k < 32; ++k) { const u32x2 kk = *(const LAS3 u32x2*)(orow + 64 * k); const bool in = 2u * (unsigned)(pos + 32 * k) < nkeys;
                        cgt += (in && kk.x > Tfull && (kk.x >> 16) == T16 ? 1u : 0u) + (in && kk.y > Tfull && (kk.y >> 16) == T16 ? 1u : 0u); }
                    (void)ceq;
                    const unsigned needt = need - hsum32(cgt);
                    unsigned Xl = 0u;
#pragma unroll 1
                    for (int bit = 10; bit >= 0; --bit) {
                        const unsigned cx = Xl | (1u << bit);
                        unsigned c = 0u;
#pragma unroll 1
                        for (int k = 0; k < 32; ++k) { const u32x2 kk = *(const LAS3 u32x2*)(orow + 64 * k); const unsigned i0 = 2u * (unsigned)(pos + 32 * k);
                            c += (i0 < nkeys && kk.x == Tfull && i0 < cx ? 1u : 0u) + (i0 < nkeys && kk.y == Tfull && i0 + 1u < cx ? 1u : 0u); }
                        if (hsum32(c) < needt) Xl = cx;
                    }
                    if (!exact) X = Xl;
                }
            }
            LAS3 unsigned* mrow = MASK + (16 * qg + oq) * 65 + (pos >> 4);
            const unsigned sh = 32u * hh + (pos & 16);
#pragma unroll 2
            for (int k = 0; k <= j; ++k) {
                const u32x2 kk = *(const LAS3 u32x2*)(orow + 64 * k); const unsigned i0 = 2u * (unsigned)(pos + 32 * k);
                const bool s0 = i0 < nkeys && (kk.x > Tfull || (kk.x == Tfull && i0 <= X)), s1 = i0 < nkeys && (kk.y > Tfull || (kk.y == Tfull && i0 + 1u <= X));
                const unsigned long long blo = __ballot(s0), bhi = __ballot(s1);
                const unsigned wv = ((unsigned)(blo >> sh) & 0xffffu) | ((unsigned)(bhi >> sh) << 16);
                if ((pos & 15) == 0) mrow[2 * k] = wv;
            }
        }
        TEND(33);
        __syncthreads();
#ifdef CHECK_SEL
        if (selecting) {
            const int lbase = 16 * w + 4 * fq;
            unsigned key[16][4];
#pragma unroll
            for (int n = 0; n < 16; ++n)
#pragma unroll
                for (int r = 0; r < 4; ++r) key[n][r] = (n < nloc) ? PKT[fr * PKT_LD + lbase + 128 * n + r] : 0u;
            unsigned T2; int X2; select_bitwise(key, lbase, CNT, it, fr, lane, T2, X2);
            bool bad = false;
#pragma unroll
            for (int n = 0; n < 16; ++n) if (n < nloc) { const int x2 = X2 - 128 * n;
#pragma unroll
                for (int r = 0; r < 4; ++r) { const unsigned idx = (unsigned)(lbase + 128 * n + r); const unsigned mw = MASK[(16 * qg + fr) * 65 + (idx >> 5)];
                    const bool s2 = key[n][r] > T2 || (key[n][r] == T2 && r <= x2); bad |= (s2 != (((mw >> (((idx & 31u) >> 1) + 16u * (idx & 1u))) & 1u) != 0u)); } }
            if (__any(bad) && lane == 0) atomicAdd((unsigned*)(ws + CW_CHK), 1u);
            if (lane == 0 && w == 0) atomicAdd((unsigned*)(ws + CW_CHK + 4), 1u);
            __syncthreads();
        }
#endif
    }
    TEND(30); TBEG(31);
    {
        const int h = w & 3, hf = w >> 2, fr = lane0 & 15, fq = lane0 >> 4;
        const size_t qrow0 = (size_t)b * SEQ + q0 + 32 * hf;
        f32x4 o[4][2]; float linv[2];
        attn32<true>((const bf16_t*)(ws + W_DQ) + qrow0 * 256 + h * 64, 256, (const bf16_t*)(ws + W_DK) + (size_t)b * SEQ * 256 + h * 64, 256,
                     (const bf16_t*)(ws + W_DVT) + ((size_t)b * 64 * 4 + h) * 2048, 4 * 2048, 2 * j + 2  , MASK + 32 * hf * 65, fr, fq, o, linv);
        attn_store(o, linv, (const bf16_t*)(ws + W_DG) + qrow0 * 256 + h * 64, (bf16_t*)(ws + W_MIX) + qrow0 * 1024 + 512 + h * 64, fr, fq);
    }
    __syncthreads();
    TEND(31);
}
DI void mem_unit(const Params& p, int n) {
    const int tid = threadIdx.x, lane = tid & 63, w = __builtin_amdgcn_readfirstlane(tid >> 6), fr = lane & 15, fq = lane >> 4;
    unsigned char* ws = p.ws;
    const int h = w & 3, hf = w >> 2;
    const size_t qrow0 = (size_t)n * 64 + 32 * hf; const int b = n >> 5;
    f32x4 o[4][2]; float linv[2];
    attn32<false>((const bf16_t*)(ws + W_MQ) + qrow0 * 256 + h * 64, 256, (const bf16_t*)(ws + W_MK) + (size_t)b * NMEM * 256 + h * 64, 256,
                  (const bf16_t*)(ws + W_MVT) + ((size_t)b * 8 * 4 + h) * 2048, 4 * 2048, 8, nullptr, fr, fq, o, linv);
    attn_store(o, linv, (const bf16_t*)(ws + W_MG) + qrow0 * 256 + h * 64, (bf16_t*)(ws + W_MIX) + qrow0 * 1024 + 768 + h * 64, fr, fq);
}
constexpr int GL_QT = 0, GL_KT = 9216, GL_KPT = 18432, GL_VT = 27648, GL_SBT = 46080, GL_PM = 64512, GL_OF = 73728, GL_GTOT = 107520, GL_W2 = 109568, GL_BG = 113664, GL_DEC = 113920;
constexpr int LDP = 72;
DI void gla_unit(const Params& p, LAS3 unsigned char* lds, int b, int h) {
    const int tid = threadIdx.x, lane = tid & 63, w = __builtin_amdgcn_readfirstlane(tid >> 6), fr = lane & 15, fq = lane >> 4;
    unsigned char* ws = p.ws;
    LAS3 bf16_t* Qt = (LAS3 bf16_t*)(lds + GL_QT); LAS3 bf16_t* Kt = (LAS3 bf16_t*)(lds + GL_KT); LAS3 bf16_t* KpT = (LAS3 bf16_t*)(lds + GL_KPT);
    LAS3 bf16_t* Vt = (LAS3 bf16_t*)(lds + GL_VT); LAS3 bf16_t* SbT = (LAS3 bf16_t*)(lds + GL_SBT); LAS3 bf16_t* Pm = (LAS3 bf16_t*)(lds + GL_PM);
    LAS3 float* Of = (LAS3 float*)(lds + GL_OF); LAS3 float* gtot = (LAS3 float*)(lds + GL_GTOT); LAS3 float* w2s = (LAS3 float*)(lds + GL_W2);
    LAS3 float* bgs = (LAS3 float*)(lds + GL_BG); LAS3 float* dec = (LAS3 float*)(lds + GL_DEC);
    const bf16_t* GQ = (const bf16_t*)(ws + W_GQ); const bf16_t* GK = (const bf16_t*)(ws + W_GK); const bf16_t* GV = (const bf16_t*)(ws + W_GV);
    const bf16_t* GG = (const bf16_t*)(ws + W_GG); const float* GLR = (const float*)(ws + W_GLR); bf16_t* MIX = (bf16_t*)(ws + W_MIX);
    for (int i = tid; i < 128 * LDP / 2; i += NTHREADS) ((LAS3 unsigned*)SbT)[i] = 0u;
    for (int i = tid; i < 16 * 64; i += NTHREADS) w2s[i] = p.w_g2[(i >> 6) * 256 + h * 64 + (i & 63)];
    if (tid < 64) bgs[tid] = p.b_g[h * 64 + tid];
    __syncthreads();
    const int d = tid & 63, tg = w;
    float wreg[16];
#pragma unroll
    for (int r = 0; r < 16; ++r) wreg[r] = w2s[r * 64 + d];
    const float bgd = bgs[d];
    const f32x4 zero = {0.f, 0.f, 0.f, 0.f};
    f32x4 Sacc[4] = {zero, zero, zero, zero};
    const int tt = w & 3, vh = w >> 2;
    for (int c = 0; c < 32; ++c) {
        const size_t rb = (size_t)b * SEQ + c * 64;
        float g8[8];
#pragma unroll
        for (int i = 0; i < 8; ++i) {
            const float* gl = vaddr(GLR + (rb + tg * 8 + i) * 16);
            float u = bgd;
#pragma unroll
            for (int r = 0; r < 16; ++r) u += gl[r] * wreg[r];
            const float g = logsigf(u) * (1.f / 16.f);
            g8[i] = (i ? g8[i - 1] : 0.f) + g;
        }
        gtot[tg * 64 + d] = g8[7];
        __syncthreads();
        float off = 0.f, blast = 0.f;
#pragma unroll
        for (int g2 = 0; g2 < 8; ++g2) { const float v = gtot[g2 * 64 + d]; off += (g2 < tg) ? v : 0.f; blast += v; }
        float kp[8];
#pragma unroll
        for (int i = 0; i < 8; ++i) {
            const int t = tg * 8 + i; const float bt = off + g8[i];
            const float q = bf2f(GQ[(rb + t) * 256 + h * 64 + d]), k = bf2f(GK[(rb + t) * 256 + h * 64 + d]);
            Qt[t * LDP + d] = f2bf(q * fexp(bt)); Kt[t * LDP + d] = f2bf(k * fexp(-bt)); kp[i] = k * fexp(blast - bt);
        }
        { u32x4 kw; kw.x = cvtpk(kp[0], kp[1]); kw.y = cvtpk(kp[2], kp[3]); kw.z = cvtpk(kp[4], kp[5]); kw.w = cvtpk(kp[6], kp[7]); *(LAS3 u32x4*)(KpT + d * LDP + tg * 8) = kw; }
        if (tg == 0) dec[d] = fexp(blast);
        { const int v = tid & 127, sg = tid >> 7; bf16_t vv[16];
#pragma unroll
          for (int i = 0; i < 16; ++i) vv[i] = GV[(rb + sg * 16 + i) * 512 + h * 128 + v];
          u32x4 a, bb; a.x = vv[0] | ((unsigned)vv[1] << 16); a.y = vv[2] | ((unsigned)vv[3] << 16); a.z = vv[4] | ((unsigned)vv[5] << 16); a.w = vv[6] | ((unsigned)vv[7] << 16);
          bb.x = vv[8] | ((unsigned)vv[9] << 16); bb.y = vv[10] | ((unsigned)vv[11] << 16); bb.z = vv[12] | ((unsigned)vv[13] << 16); bb.w = vv[14] | ((unsigned)vv[15] << 16);
          *(LAS3 u32x4*)(Vt + v * LDP + sg * 16) = a; *(LAS3 u32x4*)(Vt + v * LDP + sg * 16 + 8) = bb; }
        __syncthreads();
#pragma unroll
        for (int s2 = 0; s2 < 2; ++s2) {
            const int st = 2 * vh + s2;
            f32x4 acc = zero;
#pragma unroll
            for (int ks = 0; ks < 2; ++ks) {
                const bf16x8 a = *(const LAS3 bf16x8*)(Kt + (st * 16 + fr) * LDP + ks * 32 + fq * 8), bq = *(const LAS3 bf16x8*)(Qt + (tt * 16 + fr) * LDP + ks * 32 + fq * 8);
                acc = mfma16(a, bq, acc);
            }
            const int t = tt * 16 + fr, s0 = st * 16 + 4 * fq;
            u32x2 pw; pw.x = cvtpk(s0 <= t ? acc[0] : 0.f, s0 + 1 <= t ? acc[1] : 0.f); pw.y = cvtpk(s0 + 2 <= t ? acc[2] : 0.f, s0 + 3 <= t ? acc[3] : 0.f);
            *(LAS3 u32x2*)(Pm + t * LDP + s0) = pw;
        }
        __syncthreads();
        f32x4 oacc[4];
        {
            bf16x8 aq[2], ap[2], ak[2];
#pragma unroll
            for (int ks = 0; ks < 2; ++ks) {
                aq[ks] = *(const LAS3 bf16x8*)(Qt + (tt * 16 + fr) * LDP + ks * 32 + fq * 8);
                ap[ks] = *(const LAS3 bf16x8*)(Pm + (tt * 16 + fr) * LDP + ks * 32 + fq * 8);
                ak[ks] = *(const LAS3 bf16x8*)(KpT + (tt * 16 + fr) * LDP + ks * 32 + fq * 8);
            }
            const f32x4 dv = *(const LAS3 f32x4*)(dec + tt * 16 + 4 * fq);
#pragma unroll
            for (int jv = 0; jv < 4; ++jv) {
                const int vt = vh * 4 + jv;
                bf16x8 bs[2], bv[2];
#pragma unroll
                for (int ks = 0; ks < 2; ++ks) {
                    bs[ks] = *(const LAS3 bf16x8*)(SbT + (vt * 16 + fr) * LDP + ks * 32 + fq * 8);
                    bv[ks] = *(const LAS3 bf16x8*)(Vt + (vt * 16 + fr) * LDP + ks * 32 + fq * 8);
                }
                f32x4 oa = mfma16(aq[0], bs[0], zero); oa = mfma16(aq[1], bs[1], oa); oa = mfma16(ap[0], bv[0], oa); oa = mfma16(ap[1], bv[1], oa);
                oacc[jv] = oa;
                f32x4 sa = Sacc[jv] * dv; sa = mfma16(ak[0], bv[0], sa); sa = mfma16(ak[1], bv[1], sa);
                Sacc[jv] = sa;
            }
        }
        __syncthreads();
#pragma unroll
        for (int jv = 0; jv < 4; ++jv) {
            const int vt = vh * 4 + jv;
#pragma unroll
            for (int r = 0; r < 4; ++r) Of[(tt * 16 + 4 * fq + r) * 132 + vt * 16 + fr] = oacc[jv][r];
            u32x2 sw; sw.x = cvtpk(Sacc[jv][0], Sacc[jv][1]); sw.y = cvtpk(Sacc[jv][2], Sacc[jv][3]);
            *(LAS3 u32x2*)(SbT + (vt * 16 + fr) * LDP + tt * 16 + 4 * fq) = sw;
        }
        __syncthreads();
        {
            const int t = tid >> 3, seg = tid & 7;
            const LAS3 float* op = Of + t * 132 + seg * 16;
            f32x4 ov[4]; float ss = 0.f;
#pragma unroll
            for (int i = 0; i < 4; ++i) { ov[i] = *(const LAS3 f32x4*)(op + 4 * i); ss += ov[i][0] * ov[i][0] + ov[i][1] * ov[i][1] + ov[i][2] * ov[i][2] + ov[i][3] * ov[i][3]; }
            ss += __shfl_xor(ss, 1); ss += __shfl_xor(ss, 2); ss += __shfl_xor(ss, 4);
            const float rstd = rsqrtf(ss * (1.f / 128.f) + 1e-6f);
            const bf16_t* gp = GG + (rb + t) * 512 + h * 128 + seg * 16;
            const u32x4 g0 = *(const u32x4*)gp, g1 = *(const u32x4*)(gp + 8);
            const unsigned gw[8] = {g0.x, g0.y, g0.z, g0.w, g1.x, g1.y, g1.z, g1.w};
            unsigned ow[8];
#pragma unroll
            for (int i = 0; i < 4; ++i) {
                const f32x4 on = *(const f32x4*)(p.onorm + seg * 16 + 4 * i);
                const float y0 = ov[i][0] * rstd * on[0] * __uint_as_float(gw[2 * i] << 16), y1 = ov[i][1] * rstd * on[1] * __uint_as_float(gw[2 * i] & 0xffff0000u);
                const float y2 = ov[i][2] * rstd * on[2] * __uint_as_float(gw[2 * i + 1] << 16), y3 = ov[i][3] * rstd * on[3] * __uint_as_float(gw[2 * i + 1] & 0xffff0000u);
                ow[2 * i] = cvtpk(y0, y1); ow[2 * i + 1] = cvtpk(y2, y3);
            }
            bf16_t* mp = MIX + (rb + t) * 1024 + h * 128 + seg * 16;
            *(u32x4*)mp = (u32x4){ow[0], ow[1], ow[2], ow[3]}; *(u32x4*)(mp + 8) = (u32x4){ow[4], ow[5], ow[6], ow[7]};
        }
    }
#pragma unroll
    for (int jv = 0; jv < 4; ++jv)
#pragma unroll
        for (int r = 0; r < 4; ++r) p.out[O_GSP + ((size_t)(b * 4 + h) * 64 + tt * 16 + 4 * fq + r) * 128 + (vh * 4 + jv) * 16 + fr] = Sacc[jv][r];
    __syncthreads();
}

DI void sscore_unit(const Params& p, LAS3 unsigned char* lds, int u) {
    const int tid = threadIdx.x;
    unsigned char* ws = p.ws;
    const int b = u >> 3, pg = u & 7;
    LAS3 float* qf = (LAS3 float*)lds;
    if (tid < 256) qf[tid] = bf2f(((const bf16_t*)(ws + W_IQ))[(size_t)(MP + b) * 256 + tid]);
    __syncthreads();
    const int seg = tid & 15;
    f32x4 q[4];
#pragma unroll
    for (int h = 0; h < 4; ++h) q[h] = *(const LAS3 f32x4*)(qf + h * 64 + seg * 4);
    const f32x4 wv = *(const f32x4*)vaddr((const float*)(ws + W_IW) + (size_t)(MP + b) * 4);
    unsigned* sc = (unsigned*)(ws + W_SC) + (size_t)b * SCLD;
    const int* pt = p.page_table + b * NPAGES + pg * 16;
#define SS_LOAD(BUF, pp) do { const float* base_ = p.cache_ik + (size_t)pt[(pp) < 16 ? (pp) : 15] * 8192; \
        _Pragma("unroll") for (int i = 0; i < 4; ++i) BUF[i] = *(const f32x4*)(base_ + (size_t)(tid + 512 * i) * 4); } while (0)
#define SS_COMPUTE(BUF, pp) do { \
        _Pragma("unroll") for (int i = 0; i < 4; ++i) { const f32x4 kv = BUF[i]; float dh[4]; \
            _Pragma("unroll") for (int h = 0; h < 4; ++h) { float x = q[h][0] * kv[0] + q[h][1] * kv[1] + q[h][2] * kv[2] + q[h][3] * kv[3]; \
                x += __shfl_xor(x, 1); x += __shfl_xor(x, 2); x += __shfl_xor(x, 4); x += __shfl_xor(x, 8); dh[h] = x; } \
            const float s_ = wv[0] * fmaxf(dh[0], 0.f) + wv[1] * fmaxf(dh[1], 0.f) + wv[2] * fmaxf(dh[2], 0.f) + wv[3] * fmaxf(dh[3], 0.f); \
            if (seg == 0) __hip_atomic_store(sc + (pg * 16 + (pp)) * 128 + ((tid + 512 * i) >> 4), __float_as_uint(s_), __ATOMIC_RELAXED, __HIP_MEMORY_SCOPE_AGENT); } } while (0)
    f32x4 pa[4], pb[4];
    SS_LOAD(pa, 0); SS_LOAD(pb, 1);
#pragma unroll 1
    for (int pp = 0; pp < 16; pp += 2) {
        SS_COMPUTE(pa, pp); SS_LOAD(pa, pp + 2);
        SS_COMPUTE(pb, pp + 1); SS_LOAD(pb, pp + 3);
    }
#undef SS_LOAD
#undef SS_COMPUTE
    asm volatile("s_waitcnt vmcnt(0)" ::: "memory");
    __syncthreads();
    if (tid == 0) __hip_atomic_fetch_add((unsigned*)(ws + CW_SCNT), 1u, __ATOMIC_RELAXED, __HIP_MEMORY_SCOPE_AGENT);
}

constexpr int SA_Q = 2048, SA_S = 3072, SA_KP = 8192, SA_VP = 10240;
DI void sattend(const Params& p, LAS3 unsigned char* lds, const bf16_t* qrow  , const bf16_t* gate, bf16_t* mix) {
    const int tid = threadIdx.x, lane = tid & 63, w = tid >> 6;
    LAS3 float* qf = (LAS3 float*)(lds + SA_Q); LAS3 float* S = (LAS3 float*)(lds + SA_S);
    const float* const LAS3* kptr = (const float* const LAS3*)(lds + SA_KP); const float* const LAS3* vptr = (const float* const LAS3*)(lds + SA_VP);
    if (tid < 256) qf[tid] = bf2f(qrow[tid]);
    __syncthreads();
    {
        const int jk = tid >> 1, hp = tid & 1;
        const float* kr = kptr[jk] + hp * 128;
        float s0 = 0.f, s1 = 0.f;
#pragma unroll 4
        for (int i = 0; i < 16; ++i) {
            const f32x4 k0 = *(const f32x4*)(kr + 4 * i), k1 = *(const f32x4*)(kr + 64 + 4 * i);
            const f32x4 q0 = *(const LAS3 f32x4*)(qf + hp * 128 + 4 * i), q1 = *(const LAS3 f32x4*)(qf + hp * 128 + 64 + 4 * i);
            s0 += q0[0] * k0[0] + q0[1] * k0[1] + q0[2] * k0[2] + q0[3] * k0[3];
            s1 += q1[0] * k1[0] + q1[1] * k1[1] + q1[2] * k1[2] + q1[3] * k1[3];
        }
        S[(2 * hp) * 256 + jk] = s0; S[(2 * hp + 1) * 256 + jk] = s1;
    }
    __syncthreads();
    if (w < 4) {
        float v[4], mx = NEG_INF;
#pragma unroll
        for (int i = 0; i < 4; ++i) { v[i] = S[w * 256 + lane + 64 * i]; mx = fmaxf(mx, v[i]); }
        mx = wmax64(mx);
        float sum = 0.f;
#pragma unroll
        for (int i = 0; i < 4; ++i) { v[i] = __expf(v[i] - mx); sum += v[i]; }
        sum = wsum64(sum);
        const float inv = 1.f / sum;
#pragma unroll
        for (int i = 0; i < 4; ++i) S[w * 256 + lane + 64 * i] = v[i] * inv;
    }
    __syncthreads();
    {
        const int h = tid >> 7, dd = (tid >> 1) & 63, hf = tid & 1;
        float acc = 0.f;
#pragma unroll 4
        for (int jk = hf * 128; jk < hf * 128 + 128; ++jk) acc += S[h * 256 + jk] * vptr[jk][h * 64 + dd];
        acc += __shfl_xor(acc, 1);
        if (hf == 0) mix[h * 64 + dd] = f2bf(acc * bf2f(gate[h * 64 + dd]));
    }
    __syncthreads();
}
DI void smem_unit(const Params& p, LAS3 unsigned char* lds, int b) {
    const int tid = threadIdx.x; unsigned char* ws = p.ws;
    const float* LAS3* kptr = (const float* LAS3*)(lds + SA_KP); const float* LAS3* vptr = (const float* LAS3*)(lds + SA_VP);
    if (tid < 256) { kptr[tid] = p.cache_mem_k + ((size_t)b * NMEM + tid) * 256; vptr[tid] = p.cache_mem_v + ((size_t)b * NMEM + tid) * 256; }
    const size_t row = MP + b;
    sattend(p, lds, (const bf16_t*)(ws + W_MQ) + row * 256, (const bf16_t*)(ws + W_MG) + row * 256, (bf16_t*)(ws + W_MIX) + row * 1024 + 768);
}
DI void ssel_unit(const Params& p, LAS3 unsigned char* lds, int b) {
    const int tid = threadIdx.x, lane = tid & 63, w = tid >> 6; unsigned char* ws = p.ws;
    LAS3 unsigned* CNT = (LAS3 unsigned*)lds;
    LAS3 unsigned* wsum = (LAS3 unsigned*)(lds + 256);
    LAS3 float* newsc = (LAS3 float*)(lds + 320);
    LAS3 int* list = (LAS3 int*)(lds + 512);
    const float* LAS3* kptr = (const float* LAS3*)(lds + SA_KP); const float* LAS3* vptr = (const float* LAS3*)(lds + SA_VP);
    if (tid < 48) CNT[tid] = 0u;
    if (tid == 0) {
        unsigned* cnt = (unsigned*)(ws + CW_SCNT); unsigned* tmo = (unsigned*)(ws + CW_TMO); unsigned sp = 0;
        while (__hip_atomic_load(cnt, __ATOMIC_RELAXED, __HIP_MEMORY_SCOPE_AGENT) < 256u) {
            __builtin_amdgcn_s_sleep(2);
            if ((++sp & 255u) == 0u) { if (__hip_atomic_load(tmo, __ATOMIC_RELAXED, __HIP_MEMORY_SCOPE_AGENT)) break; if (sp > (1u << 20)) { __hip_atomic_store(tmo, 1u, __ATOMIC_RELAXED, __HIP_MEMORY_SCOPE_AGENT); break; } }
        }
        __builtin_amdgcn_fence(__ATOMIC_ACQUIRE, "agent");
        asm volatile("s_waitcnt vmcnt(0)" ::: "memory");
    }
    if (w == 1) {
        const bf16_t* iq = (const bf16_t*)(ws + W_IQ) + (size_t)(MP + b) * 256; const float kd = bf2f(((const bf16_t*)(ws + W_IK))[(size_t)(MP + b) * 64 + lane]);
        const f32x4 wv = *(const f32x4*)vaddr((const float*)(ws + W_IW) + (size_t)(MP + b) * 4);
        float s = 0.f;
#pragma unroll
        for (int h = 0; h < 4; ++h) { const float dh = wsum64(bf2f(iq[h * 64 + lane]) * kd); s += wv[h] * fmaxf(dh, 0.f); }
        if (lane == 0) *newsc = s;
    }
    __syncthreads();
    const float* sc = (const float*)(ws + W_SC) + (size_t)b * SCLD;
    unsigned key[33];
#pragma unroll
    for (int n = 0; n < 32; ++n) key[n] = fkey(sc[tid + 512 * n]);
    key[32] = (tid == 0) ? fkey(*newsc) : 0u;
    int it = 0;
    unsigned T = 0u, X = 0x7fffffffu; bool fin = false;
    for (int bit = 31; bit >= 0; --bit) {
        const unsigned cand = T | (1u << bit);
        unsigned c = 0;
#pragma unroll
        for (int n = 0; n < 33; ++n) cnt_ge(c, key[n], cand);
        const unsigned tot = blk_count(c, CNT, it, lane);
        if (tot >= 256u) { T = cand; fin = (tot == 256u); }
        if (fin) break;
    }
    if (!fin) {
        unsigned c = 0;
#pragma unroll
        for (int n = 0; n < 33; ++n) cnt_gt(c, key[n], T);
        const unsigned need = 256u - blk_count(c, CNT, it, lane);
        unsigned Xl = 0u;
        for (int bit = 14; bit >= 0; --bit) {
            const unsigned cand = Xl | (1u << bit);
            c = 0;
#pragma unroll
            for (int n = 0; n < 33; ++n) cnt_eq_lt(c, key[n], T, (unsigned)(tid + 512 * n), cand);
            if (blk_count(c, CNT, it, lane) < need) Xl = cand;
        }
        X = Xl;
    }
    unsigned selm = 0, hi = 0;
#pragma unroll
    for (int n = 0; n < 32; ++n) selm |= (key[n] > T || (key[n] == T && (unsigned)(tid + 512 * n) <= X)) ? (1u << n) : 0u;
    hi = (key[32] > T || (key[32] == T && (unsigned)(tid + 16384) <= X)) ? 1u : 0u;
    const unsigned cs = __popc(selm) + hi;
    unsigned inc = cs;
#pragma unroll
    for (int o2 = 1; o2 < 64; o2 <<= 1) { const unsigned t2 = __shfl_up(inc, o2); if (lane >= o2) inc += t2; }
    if (lane == 63) wsum[w] = inc;
    __syncthreads();
    unsigned pos = inc - cs;
    for (int w2 = 0; w2 < w; ++w2) pos += wsum[w2];
#pragma unroll
    for (int n = 0; n < 32; ++n) if ((selm >> n) & 1u) { if (pos < 256u) list[pos] = tid + 512 * n; ++pos; }
    if (hi) { if (pos < 256u) list[pos] = tid + 16384; ++pos; }
    __syncthreads();
    if (tid < 256) {
        const int idx = list[tid];
        if (idx < 16384) { const size_t phys = (size_t)p.page_table[b * NPAGES + (idx >> 7)] * 128 + (idx & 127); kptr[tid] = p.cache_k + phys * 256; vptr[tid] = p.cache_v + phys * 256; }
        else { kptr[tid] = p.out + O_KS + (size_t)b * 256; vptr[tid] = p.out + O_VS + (size_t)b * 256; }
    }
    const size_t row = MP + b;
    sattend(p, lds, (const bf16_t*)(ws + W_DQ) + row * 256, (const bf16_t*)(ws + W_DG) + row * 256, (bf16_t*)(ws + W_MIX) + row * 1024 + 512);
}
DI void sgla_unit(const Params& p, LAS3 unsigned char* lds, int b) {
    const int tid = threadIdx.x, lane = tid & 63, w = tid >> 6; unsigned char* ws = p.ws;
    LAS3 float* qs = (LAS3 float*)lds; LAS3 float* ks = qs + 256; LAS3 float* gs = qs + 512; LAS3 float* vs = qs + 768; LAS3 float* part = qs + 1280;
    const size_t row = MP + b;
    if (tid < 256) {
        float u = p.b_g[tid];
        const float* gl = vaddr((const float*)(ws + W_GLR) + row * 16);
#pragma unroll
        for (int r = 0; r < 16; ++r) u += gl[r] * p.w_g2[r * 256 + tid];
        gs[tid] = expf(logsigf(u) * (1.f / 16.f));
        qs[tid] = bf2f(((const bf16_t*)(ws + W_GQ))[row * 256 + tid]); ks[tid] = bf2f(((const bf16_t*)(ws + W_GK))[row * 256 + tid]);
    }
    vs[tid] = bf2f(((const bf16_t*)(ws + W_GV))[row * 512 + tid]);
    __syncthreads();
    const int h = tid >> 7, v = tid & 127;
    const float* sp = p.state_gla + ((size_t)(b * 4 + h) * 64) * 128 + v; float* so = p.out + O_GSS + ((size_t)(b * 4 + h) * 64) * 128 + v;
    const float vv = vs[h * 128 + v];
    float o = 0.f;
#pragma unroll 8
    for (int dd = 0; dd < 64; ++dd) { const float sn = gs[h * 64 + dd] * sp[dd * 128] + ks[h * 64 + dd] * vv; so[dd * 128] = sn; o += qs[h * 64 + dd] * sn; }
    const float ss = wsum64(o * o);
    if (lane == 0) part[w] = ss;
    __syncthreads();
    const float rstd = rsqrtf((part[2 * h] + part[2 * h + 1]) * (1.f / 128.f) + 1e-6f);
    ((bf16_t*)(ws + W_MIX))[row * 1024 + h * 128 + v] = f2bf(o * rstd * p.onorm[v] * bf2f(((const bf16_t*)(ws + W_GG))[row * 512 + h * 128 + v]));
    __syncthreads();
}
DI void p4_final(const Params& p) {
    const int tid = threadIdx.x, lane = tid & 63, wv = tid >> 6;
    for (int r = blockIdx.x * 8 + wv; r < MP + NDB; r += gridDim.x * 8) {
        float* y = p.out + (r < MP ? O_YP + (size_t)r * DM : O_YS + (size_t)(r - MP) * DM);
        f32x4 v[4]; float ss = 0.f;
#pragma unroll
        for (int i = 0; i < 4; ++i) { v[i] = *(const f32x4*)(y + i * 256 + lane * 4); ss += v[i][0] * v[i][0] + v[i][1] * v[i][1] + v[i][2] * v[i][2] + v[i][3] * v[i][3]; }
        ss = wsum64(ss);
        const float rstd = rsqrtf(ss * (1.f / DM) + 1e-6f);
#pragma unroll
        for (int i = 0; i < 4; ++i) { const f32x4 gv = *(const f32x4*)(p.norm_final + i * 256 + lane * 4); *(f32x4*)(y + i * 256 + lane * 4) = v[i] * rstd * gv; }
    }
}

DI int next_unit(unsigned* ctr, volatile LAS3 unsigned* slot) {
    if (threadIdx.x == 0) *slot = __hip_atomic_fetch_add(ctr, 1u, __ATOMIC_RELAXED, __HIP_MEMORY_SCOPE_AGENT);
    __syncthreads();
    const int v = __builtin_amdgcn_readfirstlane((int)*slot);
    __syncthreads();
    return v;
}

#ifndef REP1
#define REP1 1
#endif
#ifndef REP2
#define REP2 1
#endif
#ifndef REP3
#define REP3 1
#endif
#ifndef REP2A
#define REP2A 1
#endif
#ifndef REP2B
#define REP2B 1
#endif
#ifndef REP2C
#define REP2C 1
#endif
#ifndef REP2D
#define REP2D 1
#endif
#ifndef REP2E
#define REP2E 1
#endif
DI void sample_inproj(const Params& p, LAS3 unsigned char* lds) {
    const int tid = threadIdx.x, lane = tid & 63, wv = tid >> 6, fr = lane & 15, fq = lane >> 4;
    unsigned char* ws = p.ws;
    LAS3 float* red = (LAS3 float*)lds;
    for (int pr = blockIdx.x; pr < 112; pr += gridDim.x) {
        const int col0 = pr * 32, pn = col0 >> 8, vc0 = col0 & 255;
        const bf16_t* A = (const bf16_t*)(ws + W_XN) + (size_t)MP * 1024 + (size_t)fr * 1024 + fq * 8 + wv * 128;
        const bf16_t* B = (const bf16_t*)(ws + W_WTIN) + (size_t)(col0 + fr) * 1024 + fq * 8 + wv * 128;
        const f32x4 zero = {0.f, 0.f, 0.f, 0.f};
        f32x4 acc[2][2] = {{zero, zero}, {zero, zero}};
#pragma unroll
        for (int ks = 0; ks < 4; ++ks) {
            const bf16x8 a0 = *(const bf16x8*)(A + ks * 32), a1 = *(const bf16x8*)(A + 16 * 1024 + ks * 32);
            const bf16x8 b0 = *(const bf16x8*)(B + ks * 32), b1 = *(const bf16x8*)(B + 16 * 1024 + ks * 32);
            acc[0][0] = mfma16(a0, b0, acc[0][0]); acc[0][1] = mfma16(a0, b1, acc[0][1]); acc[1][0] = mfma16(a1, b0, acc[1][0]); acc[1][1] = mfma16(a1, b1, acc[1][1]);
        }
#pragma unroll
        for (int rt = 0; rt < 2; ++rt)
#pragma unroll
            for (int ct = 0; ct < 2; ++ct)
#pragma unroll
                for (int r = 0; r < 4; ++r) red[(wv * 16 + (rt * 2 + ct) * 4 + r) * 64 + lane] = acc[rt][ct][r];
        __syncthreads();
        {
            const int rt = wv >> 2, r = wv & 3;
            float v0 = 0.f, v1 = 0.f;
#pragma unroll
            for (int w2 = 0; w2 < 8; ++w2) { v0 += red[(w2 * 16 + (rt * 2 + 0) * 4 + r) * 64 + lane]; v1 += red[(w2 * 16 + (rt * 2 + 1) * 4 + r) * 64 + lane]; }
            const float* rope = (const float*)(ws + W_ROPE) + (size_t)2048 * 64;
            {
                const int bs = 16 * rt + 4 * fq + r; const size_t R = (size_t)MP + bs;
                if (pn <= 5 || (pn >= 10 && pn <= 12)) {
                    bf16_t* dst; int ldc = 256, coff = 0; float sc = 1.f; bool silu = false;
                    switch (pn) {
                        case 0: dst = (bf16_t*)(ws + W_GQ); sc = 0.125f; break;
                        case 1: dst = (bf16_t*)(ws + W_GK); break;
                        case 2: dst = (bf16_t*)(ws + W_GV); ldc = 512; break;
                        case 3: dst = (bf16_t*)(ws + W_GV); ldc = 512; coff = 256; break;
                        case 4: dst = (bf16_t*)(ws + W_GG); ldc = 512; silu = true; break;
                        case 5: dst = (bf16_t*)(ws + W_GG); ldc = 512; coff = 256; silu = true; break;
                        case 10: dst = (bf16_t*)(ws + W_DG); silu = true; break;
                        case 11: dst = (bf16_t*)(ws + W_MQ); sc = 0.125f; break;
                        default: dst = (bf16_t*)(ws + W_MG); silu = true; break;
                    }
                    bf16_t* rp = dst + R * ldc + coff + vc0 + 8 * (fr >> 2) + (fr & 3);
                    rp[0] = f2bf(silu ? siluf(v0) : v0 * sc); rp[4] = f2bf(silu ? siluf(v1) : v1 * sc);
                } else if (pn == 6 || pn == 7 || pn == 9 || (pn == 13 && vc0 < 64)) {
                    const int hh = (pn == 13) ? 0 : ((vc0 >> 5) & 3);
                    const int f = (pn == 13) ? 16 * ((vc0 >> 5) & 1) + fr : 8 * (fr >> 2) + 4 * (vc0 >> 7) + (fr & 3);
                    const float c = rope[2 * f], s = rope[2 * f + 1], sc = (pn == 6) ? 0.125f : 1.f;
                    const float o1 = (v0 * c - v1 * s) * sc, o2 = (v1 * c + v0 * s) * sc;
                    if (pn == 13) {
                        bf16_t* ikb = (bf16_t*)(ws + W_IK) + R * 64; ikb[f] = f2bf(o1); ikb[f + 32] = f2bf(o2);
                        float* op = p.out + O_IKS + (size_t)bs * 64; op[f] = o1; op[f + 32] = o2;
                    } else {
                        bf16_t* dst = (bf16_t*)(ws + (pn == 6 ? W_DQ : (pn == 7 ? W_DK : W_IQ))) + R * 256 + 64 * hh;
                        dst[f] = f2bf(o1); dst[f + 32] = f2bf(o2);
                        if (pn == 7) { float* op = p.out + O_KS + (size_t)bs * 256 + 64 * hh; op[f] = o1; op[f + 32] = o2; }
                    }
                } else if (pn == 8) {
                    float* op = p.out + O_VS + (size_t)bs * 256 + vc0 + 8 * (fr >> 2) + (fr & 3); op[0] = v0; op[4] = v1;
                } else if (pn == 13 && vc0 == 64) {
                    if (fr < 4) { ((float*)(ws + W_IW))[R * 4 + fr] = v0 * 0.5f; ((float*)(ws + W_GLR))[R * 16 + 12 + fr] = v1; }
                    else ((float*)(ws + W_GLR))[R * 16 + fr - 4] = v0;
                }
            }
        }
        __syncthreads();
    }
}
DI void phase1(const Params& p, LAS3 unsigned char* lds) {
    unsigned char* ws = p.ws;
    { pg8::Gemm g{(const bf16_t*)(ws + W_XN), (const bf16_t*)(ws + W_WTIN), MP, NIN, DM}; pg8::StaticOrder S; S.init(MP, NIN, (int)gridDim.x, (int)blockIdx.x);
      EpiIn E{ws, p.out}; pg8::gemm_phase<EpiIn, pg8::StaticOrder, true, true>(lds, g, S, E); }
    sample_inproj(p, lds);
}
DI void p2_memgemm(const Params& p, LAS3 unsigned char* lds) {
    const int u = (int)gridDim.x - 1 - (int)blockIdx.x;
    if (u >= 96 && u < 128) {
        pg8::Gemm g{(const bf16_t*)(p.ws + W_MEMN), (const bf16_t*)(p.ws + W_WTMEM), MMEM, 512, DM}; pg8::StaticOrder S; S.init(MMEM, 512, (int)gridDim.x, u - 96);
        EpiMem E{p.ws, p.out}; pg8::gemm_phase<EpiMem, pg8::StaticOrder, true, true>(lds, g, S, E);
        asm volatile("s_waitcnt vmcnt(0)" ::: "memory");
        __syncthreads();
        if (threadIdx.x == 0) {
            __builtin_amdgcn_fence(__ATOMIC_RELEASE, "agent");
            asm volatile("s_waitcnt vmcnt(0)" ::: "memory");
            __hip_atomic_fetch_add((unsigned*)(p.ws + CW_MEMC), 1u, __ATOMIC_RELAXED, __HIP_MEMORY_SCOPE_AGENT);
        }
    }
}
DI void wait_memgemm(const Params& p) {
    if (threadIdx.x == 0) {
        unsigned* cnt = (unsigned*)(p.ws + CW_MEMC); unsigned* tmo = (unsigned*)(p.ws + CW_TMO); unsigned sp = 0;
        while (__hip_atomic_load(cnt, __ATOMIC_RELAXED, __HIP_MEMORY_SCOPE_AGENT) < 32u) {
            __builtin_amdgcn_s_sleep(2);
            if ((++sp & 255u) == 0u) { if (__hip_atomic_load(tmo, __ATOMIC_RELAXED, __HIP_MEMORY_SCOPE_AGENT)) break; if (sp > (1u << 20)) { __hip_atomic_store(tmo, 1u, __ATOMIC_RELAXED, __HIP_MEMORY_SCOPE_AGENT); break; } }
        }
        __builtin_amdgcn_fence(__ATOMIC_ACQUIRE, "agent");
        asm volatile("s_waitcnt vmcnt(0)" ::: "memory");
    }
    __syncthreads();
}
template <int QI> DI void p2_sscore(const Params& p, LAS3 unsigned char* lds) { for (int u = blockIdx.x; u < 256; u += gridDim.x) { sscore_unit(p, lds, u); __syncthreads(); } }
template <int QI> DI void p2_gla(const Params& p, LAS3 unsigned char* lds) { for (int u = blockIdx.x; u < 64; u += gridDim.x) gla_unit(p, lds, u >> 2, u & 3); }
DI int next_unit_xcd(unsigned char* qbase, volatile LAS3 unsigned* slot, unsigned x0) {
    if (threadIdx.x == 0) {
        unsigned res = 0xffffffffu;
        for (unsigned k = 0; k < 8u; ++k) {
            const unsigned xq = (x0 + k) & 7u;
            const unsigned mq = __hip_atomic_fetch_add((unsigned*)(qbase + 256 * xq), 1u, __ATOMIC_RELAXED, __HIP_MEMORY_SCOPE_AGENT);
            if (mq < 64u) { res = xq * 64u + mq; break; }
        }
        *slot = res;
    }
    __syncthreads();
    const int v = __builtin_amdgcn_readfirstlane((int)*slot);
    __syncthreads();
    return v;
}
template <int QI> DI void p2_dsa(const Params& p, LAS3 unsigned char* lds, volatile LAS3 unsigned* MISC TARGS) {
#if defined(XCDQ) && XCDQ
    const unsigned x0 = xb_xcc_id() & 7u;
    for (;;) { const int n = next_unit_xcd(p.ws + CW_QDSA + 8192 * QI, MISC + 4, x0); if (n < 0) break; const int m = n & 63; dsa_unit(p, lds, 2 * (n >> 6) + (m >> 5), 31 - (m & 31) TPASS); }
#else
    for (;;) { const int n = next_unit((unsigned*)(p.ws + CW_QDSA + 8192 * QI), MISC + 4); if (n >= 512) break; dsa_unit(p, lds, n & 15, 31 - (n >> 4) TPASS); }
#endif
}
template <int QI> DI void p2_mem(const Params& p, LAS3 unsigned char* lds, volatile LAS3 unsigned* MISC) {
    wait_memgemm(p);
    for (;;) { const int n = next_unit((unsigned*)(p.ws + CW_QMEM + 8192 * QI), MISC + 4); if (n >= 512) break; mem_unit(p, n); } }
template <int QI> DI void p2_sample(const Params& p, LAS3 unsigned char* lds) {
    for (int u = (int)gridDim.x - 1 - (int)blockIdx.x; u < 96; u += gridDim.x) { if (u < 32) sgla_unit(p, lds, u); else if (u < 64) smem_unit(p, lds, u - 32); else ssel_unit(p, lds, u - 64); } }
template <int RI> DI void phase2(const Params& p, LAS3 unsigned char* lds, volatile LAS3 unsigned* MISC TARGS) {
    TBEG(20); p2_memgemm(p, lds);
    TBEG(21); p2_sscore<0>(p, lds); TEND(21); if (REP2A > 1) p2_sscore<1>(p, lds);
    TBEG(25); p2_sample<0>(p, lds); TEND(25); if (REP2E > 1) p2_sample<1>(p, lds);
    TBEG(22); p2_gla<0>(p, lds); TEND(22); if (REP2B > 1) p2_gla<1>(p, lds);
    TBEG(23); p2_dsa<0>(p, lds, MISC TPASS); TEND(23); if (REP2C > 1) p2_dsa<1>(p, lds, MISC TPASS);
    TBEG(24); p2_mem<0>(p, lds, MISC); TEND(24); if (REP2D > 1) p2_mem<1>(p, lds, MISC);
    TEND(20);
}
DI void phase3(const Params& p, LAS3 unsigned char* lds) {
    pg8::Gemm g{(const bf16_t*)(p.ws + W_MIX), (const bf16_t*)(p.ws + W_WTOUT), MP, DM, DM}; pg8::StaticOrder S; S.init(MP, DM, (int)gridDim.x, (int)blockIdx.x);
    EpiOut E{p.x_prompt, p.x_sample, p.out}; pg8::gemm_phase<EpiOut, pg8::StaticOrder, true, true>(lds, g, S, E);
    const int tid = threadIdx.x, lane = tid & 63, wv = tid >> 6;
    for (int u = blockIdx.x; u < 256; u += gridDim.x) {
        const int b = u >> 3, col0 = (u & 7) * 128 + wv * 16;
        const bf16_t* mrow = (const bf16_t*)(p.ws + W_MIX) + (size_t)(MP + b) * 1024 + lane * 16;
        const u32x4 m0 = *(const u32x4*)mrow, m1 = *(const u32x4*)(mrow + 8);
        const unsigned mw[8] = {m0.x, m0.y, m0.z, m0.w, m1.x, m1.y, m1.z, m1.w};
        float res = 0.f;
#pragma unroll 4
        for (int i = 0; i < 16; ++i) {
            const bf16_t* wrow = (const bf16_t*)(p.ws + W_WTOUT) + (size_t)(col0 + i) * 1024 + lane * 16;
            const u32x4 w0 = *(const u32x4*)wrow, w1 = *(const u32x4*)(wrow + 8);
            const unsigned ww[8] = {w0.x, w0.y, w0.z, w0.w, w1.x, w1.y, w1.z, w1.w};
            float acc = 0.f;
#pragma unroll
            for (int e = 0; e < 8; ++e) acc += __uint_as_float(mw[e] << 16) * __uint_as_float(ww[e] << 16) + __uint_as_float(mw[e] & 0xffff0000u) * __uint_as_float(ww[e] & 0xffff0000u);
            acc = wsum64(acc);
            res = (lane == i) ? acc : res;
        }
        if (lane < 16) p.out[O_YS + (size_t)b * DM + col0 + lane] = p.x_sample[(size_t)b * DM + col0 + lane] + res;
    }
}
#ifdef CHECK_ATT
DI void check_mem_attention(const Params& p) {
    const int tid = threadIdx.x, lane = tid & 63, wv = tid >> 6;
    const int samp = blockIdx.x * 8 + wv;
    const int row = (samp * 977 + 13) % MP, h = samp & 3, b = row >> 11;
    const bf16_t* q = (const bf16_t*)(p.ws + W_MQ) + (size_t)row * 256 + h * 64;
    float s[4];
#pragma unroll
    for (int i = 0; i < 4; ++i) { const float* kr = p.out + O_MKP + ((size_t)b * NMEM + lane + 64 * i) * 256 + h * 64; float a = 0.f; for (int d = 0; d < 64; ++d) a += bf2f(q[d]) * kr[d]; s[i] = a; }
    float mx = wmax64(fmaxf(fmaxf(s[0], s[1]), fmaxf(s[2], s[3])));
    float pe[4], sum = 0.f;
#pragma unroll
    for (int i = 0; i < 4; ++i) { pe[i] = __builtin_amdgcn_exp2f(s[i] - mx); sum += pe[i]; }
    sum = wsum64(sum);
    float err = 0.f, nrm = 0.f;
    for (int d = 0; d < 64; ++d) {
        float a = 0.f;
#pragma unroll
        for (int i = 0; i < 4; ++i) a += pe[i] * p.out[O_MVP + ((size_t)b * NMEM + lane + 64 * i) * 256 + h * 64 + d];
        a = wsum64(a) / sum;
        const float want = a * bf2f(((const bf16_t*)(p.ws + W_MG))[(size_t)row * 256 + h * 64 + d]);
        const float got = bf2f(((const bf16_t*)(p.ws + W_MIX))[(size_t)row * 1024 + 768 + h * 64 + d]);
        err += (got - want) * (got - want); nrm += want * want;
    }
    if (lane == 0) { atomicAdd((unsigned*)(p.ws + CW_CHK + 12), 1u); if (!(err <= 0.0025f * nrm + 1e-12f)) atomicAdd((unsigned*)(p.ws + CW_CHK + 8), 1u); }
    if (samp < 128) {
        const int bs = samp >> 2, hs = samp & 3; const size_t rs = (size_t)MP + bs;
        const bf16_t* qs = (const bf16_t*)(p.ws + W_MQ) + rs * 256 + hs * 64;
        float s2[4];
#pragma unroll
        for (int i = 0; i < 4; ++i) { const float* kr = p.cache_mem_k + ((size_t)bs * NMEM + lane + 64 * i) * 256 + hs * 64; float a = 0.f; for (int d = 0; d < 64; ++d) a += bf2f(qs[d]) * kr[d]; s2[i] = a; }
        const float mx2 = wmax64(fmaxf(fmaxf(s2[0], s2[1]), fmaxf(s2[2], s2[3])));
        float pe2[4], sum2 = 0.f;
#pragma unroll
        for (int i = 0; i < 4; ++i) { pe2[i] = __expf(s2[i] - mx2); sum2 += pe2[i]; }
        sum2 = wsum64(sum2);
        float err2 = 0.f, nrm2 = 0.f;
        for (int d = 0; d < 64; ++d) {
            float a = 0.f;
#pragma unroll
            for (int i = 0; i < 4; ++i) a += pe2[i] * p.cache_mem_v[((size_t)bs * NMEM + lane + 64 * i) * 256 + hs * 64 + d];
            a = wsum64(a) / sum2;
            const float want = a * bf2f(((const bf16_t*)(p.ws + W_MG))[rs * 256 + hs * 64 + d]);
            const float got = bf2f(((const bf16_t*)(p.ws + W_MIX))[rs * 1024 + 768 + hs * 64 + d]);
            err2 += (got - want) * (got - want); nrm2 += want * want;
        }
        if (lane == 0) { atomicAdd((unsigned*)(p.ws + CW_CHK + 12), 1u); if (!(err2 <= 0.0025f * nrm2 + 1e-12f)) atomicAdd((unsigned*)(p.ws + CW_CHK + 8), 1u); }
    }
}
#endif
__global__ void __launch_bounds__(NTHREADS, 2) hymba_fwd(Params p) {
    extern __shared__ __attribute__((aligned(16))) unsigned char lds_raw[];
    LAS3 unsigned char* lds = (LAS3 unsigned char*)lds_raw;
    volatile LAS3 unsigned* MISC = (volatile LAS3 unsigned*)(lds + LDS_MISC);
    const int tid = threadIdx.x;
    if (tid < 64) MISC[tid] = 0u;
    __syncthreads();
    const int lo = p.ph_lo, hi = p.ph_hi;
    TDECL;
    XcdBarrier bar; bar.bar = (unsigned*)p.ws; bar.x = 0; bar.st = MISC;
    if (hi > lo) bar = xcd_barrier_post((unsigned*)p.ws, MISC);
#define IN(k) (lo <= (k) && (k) <= hi)
#define SEAM(k) do { if (IN(k) && IN((k) + 1)) xcd_barrier(bar); } while (0)
    TBEG(0); if (IN(0)) p0_prologue(p, lds); TEND(0);
    TBEG(10); SEAM(0); TEND(10);
    TBEG(1); if (IN(1)) { phase1(p, lds); if (REP1 > 1) { xcd_barrier(bar); phase1(p, lds); } } TEND(1);
    TBEG(11); SEAM(1); TEND(11);
    TBEG(2); if (IN(2)) { phase2<0>(p, lds, MISC TPASS); } TEND(2);
    TBEG(12); SEAM(2); TEND(12);
#ifdef CHECK_ATT
    if (IN(3)) check_mem_attention(p);
#endif
    TBEG(3); if (IN(3)) { phase3(p, lds); if (REP3 > 1) { xcd_barrier(bar); phase3(p, lds); } } TEND(3);
    TBEG(13); SEAM(3); TEND(13);
    TBEG(4); if (IN(4)) p4_final(p); TEND(4);
#ifdef TSEL
    {
#ifdef TCLS
        if (tid == 0 && (int)((blockIdx.x >> 6) & 1) == TCLS) { atomicAdd((unsigned long long*)(p.ws + CW_TSUM), 2ull * (unsigned long long)tacc_); atomicMax((unsigned long long*)(p.ws + CW_TMAX), (unsigned long long)tacc_); }
#else
        if (tid == 0) { atomicAdd((unsigned long long*)(p.ws + CW_TSUM), (unsigned long long)tacc_); atomicMax((unsigned long long*)(p.ws + CW_TMAX), (unsigned long long)tacc_); }
#endif
        xcd_barrier(bar);
        if (blockIdx.x == 0 && tid == 0) {
#ifdef TMAX
            unsigned long long dly = __hip_atomic_load((unsigned long long*)(p.ws + CW_TMAX), __ATOMIC_RELAXED, __HIP_MEMORY_SCOPE_AGENT);
#else
            const unsigned long long dly = __hip_atomic_load((unsigned long long*)(p.ws + CW_TSUM), __ATOMIC_RELAXED, __HIP_MEMORY_SCOPE_AGENT) / gridDim.x;
#endif
#ifndef TMUL
#define TMUL 1
#endif
            const unsigned long long t0 = __builtin_amdgcn_s_memrealtime();
            while (__builtin_amdgcn_s_memrealtime() - t0 < dly * TMUL && __builtin_amdgcn_s_memrealtime() - t0 < 400000ull) __builtin_amdgcn_s_sleep(8);
        }
    }
#endif
#ifdef CHECK_ATT
    {
        xcd_barrier(bar);
        const unsigned nbad = __hip_atomic_load((unsigned*)(p.ws + CW_CHK + 8), __ATOMIC_RELAXED, __HIP_MEMORY_SCOPE_AGENT);
        const unsigned nchk = __hip_atomic_load((unsigned*)(p.ws + CW_CHK + 12), __ATOMIC_RELAXED, __HIP_MEMORY_SCOPE_AGENT);
        if (nbad != 0u || nchk < 2170u) for (int i = blockIdx.x * NTHREADS + tid; i < NDB * DM; i += gridDim.x * NTHREADS) p.out[O_YS + i] = __builtin_nanf("");
    }
#endif
#ifdef CHECK_SEL
    {
        xcd_barrier(bar);
        const unsigned nbad = __hip_atomic_load((unsigned*)(p.ws + CW_CHK), __ATOMIC_RELAXED, __HIP_MEMORY_SCOPE_AGENT);
        const unsigned nhist = __hip_atomic_load((unsigned*)(p.ws + CW_CHK + 4), __ATOMIC_RELAXED, __HIP_MEMORY_SCOPE_AGENT);
        if (nbad != 0u || nhist < CHECK_MIN_HIST) for (int i = blockIdx.x * NTHREADS + tid; i < NDB * DM; i += gridDim.x * NTHREADS) p.out[O_YS + i] = __builtin_nanf("");
    }
#endif
#undef IN
#undef SEAM
}

#ifndef N_LAUNCHES
#define N_LAUNCHES 1
#endif
extern "C" void kernel_launch(void* const* d_in, const int* in_sizes, int n_in, void* d_out, int out_size, void* d_ws, size_t ws_size, hipStream_t stream) {
    static int grid = 0;
    if (grid == 0) {
        if (n_in != 19 || (size_t)out_size != O_END || ws_size < W_END) fprintf(stderr, "kernel_launch: unexpected sizes: n_in %d out %d ws %zu (need %zu)\n", n_in, out_size, ws_size, (size_t)W_END);
        int dev = 0, cus = 0, per_cu = 0;
        if (hipGetDevice(&dev) != hipSuccess || hipDeviceGetAttribute(&cus, hipDeviceAttributeMultiprocessorCount, dev) != hipSuccess) { fprintf(stderr, "kernel_launch: device query failed\n"); grid = -1; return; }
        if (hipFuncSetAttribute((const void*)hymba_fwd, hipFuncAttributeMaxDynamicSharedMemorySize, LDS_BYTES) != hipSuccess) { fprintf(stderr, "kernel_launch: hipFuncSetAttribute failed\n"); grid = -1; return; }
        if (hipOccupancyMaxActiveBlocksPerMultiprocessor(&per_cu, (const void*)hymba_fwd, NTHREADS, LDS_BYTES) != hipSuccess || per_cu < 1) fprintf(stderr, "kernel_launch: occupancy query reports %d blocks per CU\n", per_cu);
        (void)hipGetLastError();
        grid = cus;
    }
    if (grid < 0) return;
    (void)hipMemsetAsync(d_ws, 0, CTRL_BYTES, stream);
    Params p{};
    p.x_prompt = (const float*)d_in[0]; p.x_sample = (const float*)d_in[1]; p.mem_prompt = (const float*)d_in[2]; p.state_gla = (const float*)d_in[3];
    p.cache_k = (const float*)d_in[4]; p.cache_v = (const float*)d_in[5]; p.cache_ik = (const float*)d_in[6]; p.cache_mem_k = (const float*)d_in[7]; p.cache_mem_v = (const float*)d_in[8];
    p.page_table = (const int*)d_in[9];
    p.norm_in = (const float*)d_in[10]; p.w_in = (const float*)d_in[11]; p.w_g2 = (const float*)d_in[12]; p.b_g = (const float*)d_in[13]; p.onorm = (const float*)d_in[14];
    p.mem_norm = (const float*)d_in[15]; p.w_mem_kv = (const float*)d_in[16]; p.w_out = (const float*)d_in[17]; p.norm_final = (const float*)d_in[18];
    p.out = (float*)d_out; p.ws = (unsigned char*)d_ws;
#if N_LAUNCHES == 1
    p.ph_lo = 0; p.ph_hi = 4;
    hipLaunchKernelGGL(hymba_fwd, dim3(grid), dim3(NTHREADS), LDS_BYTES, stream, p);
#else
    for (int ph = 0; ph < 5; ++ph) { p.ph_lo = ph; p.ph_hi = ph; hipLaunchKernelGGL(hymba_fwd, dim3(grid), dim3(NTHREADS), LDS_BYTES, stream, p); }
#endif
    const hipError_t le = hipPeekAtLastError();
    if (le != hipSuccess) fprintf(stderr, "kernel_launch: launch failed: %s\n", hipGetErrorName(le));
}
```

```cpp
#include <hip/hip_runtime.h>
#include <cstdint>
#include <cstdio>
namespace pg8 {
#define PG8_LAS __attribute__((address_space(3)))
typedef unsigned short bf16_t;
typedef short bf16x8 __attribute__((ext_vector_type(8)));
typedef float f32x4 __attribute__((ext_vector_type(4)));
typedef unsigned u32x4 __attribute__((ext_vector_type(4)));
constexpr int BM = 256, BK = 64, HALF = 128, HTB = HALF * BK * 2  , STAGE_BYTES = 8 * HTB, NXCD = 8, WGM = 8;

__host__ __device__ __forceinline__ int lds_byte(int r, int c) { const int st = (r >> 4) * 2 + (c >> 5), rr = r & 15, cc = c & 31, ob = rr * 64 + cc * 2; return st * 1024 + (ob ^ (((ob >> 9) & 1) << 5)); }
__host__ __device__ __forceinline__ void stage_rc(int b, int& R, int& C) { const int st = b / 1024, sb = b % 1024, swz = sb ^ (((sb >> 9) & 1) << 5); R = (st >> 1) * 16 + swz / 64; C = (st & 1) * 32 + (swz % 64) / 2; }
__host__ __device__ __forceinline__ int perm32(int rho) { const int n = rho >> 4, i = rho & 15; return 8 * (i >> 2) + 4 * n + (i & 3); }

struct Unit { int pm, pn; };
struct Gemm { const bf16_t* A; const bf16_t* Bt; int M, N, K; };

struct StaticOrder {
    int nM, nN, nwg, G, c;
    __host__ __device__ void init(int M, int N, int G_, int c_) { nM = M / BM; nN = N / BM; nwg = nM * nN; G = G_; c = c_; }
    __host__ __device__ bool next(int i, Unit& u) const {
        const long L = (long)i * G + c; if (L >= nwg) return false;
        int wgid = (int)L; { const int q = nwg / NXCD, r = nwg % NXCD, xcd = wgid % NXCD, off = wgid / NXCD; wgid = (xcd < r ? xcd * (q + 1) : r * (q + 1) + (xcd - r) * q) + off; }
        const int nig = WGM * nN, gid = wgid / nig, fm = gid * WGM, gsz = (nM - fm) < WGM ? (nM - fm) : WGM;
        u.pm = fm + ((wgid % nig) % gsz); u.pn = (wgid % nig) / gsz; return true;
    }
    __device__ __forceinline__ void a_ready(const Unit&) const {}
    __device__ __forceinline__ void done(const Unit&) const {}
};

template <class Epi, class Sched, bool ALIGN_EPI = false, bool SP2 = false>
__device__ __forceinline__ void gemm_phase(PG8_LAS unsigned char* lds, const Gemm g, const Sched& S, const Epi& E) {
    const int tid = threadIdx.x, wid = __builtin_amdgcn_readfirstlane(tid >> 6), lane = tid & 63, wr = wid >> 2, wc = wid & 3, fr = lane & 15, fq = lane >> 4;
    const int K = g.K, nt = K / BK;
    unsigned voffA[2], voffB[2];
#pragma unroll
    for (int i = 0; i < 2; ++i) { int R, C; stage_rc(tid * 16 + i * 8192, R, C); const int Rb = Epi::PERM ? ((R & ~31) + perm32(R & 31)) : R;
        voffA[i] = (unsigned)(R * K + C) * 2u; voffB[i] = (unsigned)(Rb * K + C) * 2u; }
    const size_t kstep = (size_t)(BK * 2);
    const size_t hstep = (size_t)HALF * K * 2;
    const size_t tstep = 2 * hstep;
    const unsigned ldsw = (unsigned)wid * 1024u;
    const int aoff = lds_byte(wr * 64 + fr, fq * 8), boff = lds_byte(wc * 32 + fr, fq * 8);
#define PG8_SA(b, h) (((b) * 2 + (h)) * HTB)
#define PG8_SB(b, h) ((4 + (b) * 2 + (h)) * HTB)
#define PG8_STAGE(bufoff, gbase, voff) do { _Pragma("unroll") for (int _i = 0; _i < 2; ++_i) \
        __builtin_amdgcn_global_load_lds((const unsigned*)((const char*)(gbase) + (voff)[_i]), (PG8_LAS unsigned*)(lds + (bufoff) + ldsw + _i * 8192), 16, 0, 0); } while (0)
#define PG8_LDA(dst, b, h) do { _Pragma("unroll") for (int m = 0; m < 4; ++m) _Pragma("unroll") for (int k = 0; k < 2; ++k) dst[m][k] = *(const PG8_LAS bf16x8*)(lds + PG8_SA(b, h) + aoff + m * 2048 + k * 1024); } while (0)
#define PG8_LDB(dst, b, h) do { _Pragma("unroll") for (int n = 0; n < 2; ++n) _Pragma("unroll") for (int k = 0; k < 2; ++k) dst[n][k] = *(const PG8_LAS bf16x8*)(lds + PG8_SB(b, h) + boff + n * 2048 + k * 1024); } while (0)
#define PG8_MMA(ai, bj, At, Bt) do { __builtin_amdgcn_s_setprio(1); _Pragma("unroll") for (int m = 0; m < 4; ++m) _Pragma("unroll") for (int n = 0; n < 2; ++n) _Pragma("unroll") for (int k = 0; k < 2; ++k) \
        acc[ai][bj][m][n] = __builtin_amdgcn_mfma_f32_16x16x32_bf16(Bt[n][k], At[m][k], acc[ai][bj][m][n], 0, 0, 0); __builtin_amdgcn_s_setprio(0); } while (0)
#define PG8_WAIT_V(n) asm volatile("s_waitcnt vmcnt(" #n ")" ::: "memory")
#define PG8_WAIT_L(n) asm volatile("s_waitcnt lgkmcnt(" #n ")" ::: "memory")
#define PG8_BAR __builtin_amdgcn_s_barrier()
#define PG8_SCHED __builtin_amdgcn_sched_barrier(0)
    Unit cur, nxt; int ui = 0;
    if (!S.next(0, cur)) return;
    f32x4 acc[2][2][4][2];
#pragma unroll
    for (int a = 0; a < 2; ++a)
#pragma unroll
        for (int b = 0; b < 2; ++b)
#pragma unroll
            for (int m = 0; m < 4; ++m)
#pragma unroll
                for (int n = 0; n < 2; ++n) acc[a][b][m][n] = (f32x4){0.f, 0.f, 0.f, 0.f};
    bf16x8 At[4][2], B0[2][2], B1[2][2];
    const char* cA = (const char*)g.A + (size_t)cur.pm * tstep; const char* cB = (const char*)g.Bt + (size_t)cur.pn * tstep;
    S.a_ready(cur);
    if constexpr (SP2) {
        PG8_STAGE(PG8_SB(0, 0), cB, voffB); PG8_STAGE(PG8_SB(0, 1), cB + hstep, voffB); PG8_STAGE(PG8_SA(0, 0), cA, voffA); PG8_STAGE(PG8_SA(0, 1), cA + hstep, voffA);
        if (wr == 1) PG8_BAR;
        PG8_WAIT_V(2); PG8_BAR;
        PG8_STAGE(PG8_SB(1, 0), cB + kstep, voffB); PG8_STAGE(PG8_SA(1, 0), cA + kstep, voffA); PG8_STAGE(PG8_SB(1, 1), cB + hstep + kstep, voffB);
        PG8_WAIT_V(6); PG8_BAR;
    } else {
        PG8_STAGE(PG8_SB(0, 0), cB, voffB); PG8_STAGE(PG8_SA(0, 0), cA, voffA); PG8_STAGE(PG8_SB(0, 1), cB + hstep, voffB); PG8_STAGE(PG8_SA(0, 1), cA + hstep, voffA);
        if (wr == 1) PG8_BAR;
        PG8_WAIT_V(4); PG8_BAR;
        PG8_STAGE(PG8_SB(1, 0), cB + kstep, voffB); PG8_STAGE(PG8_SA(1, 0), cA + kstep, voffA); PG8_STAGE(PG8_SB(1, 1), cB + hstep + kstep, voffB);
        PG8_WAIT_V(6); PG8_BAR;
    }
    for (;;) {
        const bool has_next = S.next(ui + 1, nxt);
        const char* nA = has_next ? (const char*)g.A + (size_t)nxt.pm * tstep : cA; const char* nB = has_next ? (const char*)g.Bt + (size_t)nxt.pn * tstep : cB;
        for (int t = 0; t < nt; t += 2) {
            const bool last = (t == nt - 2);
            const char* a1 = cA + (size_t)(t + 1) * kstep;
            const char* a2 = last ? nA : cA + (size_t)(t + 2) * kstep; const char* b2 = last ? nB : cB + (size_t)(t + 2) * kstep;
            const char* a3 = a2 + kstep; const char* b3 = b2 + kstep;
            if (last && has_next) S.a_ready(nxt);
            if constexpr (SP2) {
            PG8_LDB(B0, 0, 0); PG8_LDB(B1, 0, 1); PG8_SCHED; PG8_LDA(At, 0, 0); PG8_STAGE(PG8_SA(1, 1), a1 + hstep, voffA);
            PG8_WAIT_V(8); PG8_WAIT_L(0); PG8_BAR; PG8_MMA(0, 0, At, B0); PG8_MMA(0, 1, At, B1); PG8_BAR; PG8_SCHED;
            PG8_LDA(At, 0, 1); PG8_STAGE(PG8_SB(0, 0), b2, voffB); PG8_STAGE(PG8_SB(0, 1), b2 + hstep, voffB); PG8_STAGE(PG8_SA(0, 0), a2, voffA);
            PG8_WAIT_V(8); PG8_WAIT_L(0); PG8_BAR; PG8_MMA(1, 0, At, B0); PG8_MMA(1, 1, At, B1); PG8_BAR; PG8_SCHED;
            PG8_LDB(B0, 1, 0); PG8_LDB(B1, 1, 1); PG8_SCHED; PG8_LDA(At, 1, 0); PG8_STAGE(PG8_SA(0, 1), a2 + hstep, voffA);
            PG8_WAIT_V(8); PG8_WAIT_L(0); PG8_BAR; PG8_MMA(0, 0, At, B0); PG8_MMA(0, 1, At, B1); PG8_BAR; PG8_SCHED;
            PG8_LDA(At, 1, 1); PG8_STAGE(PG8_SB(1, 0), b3, voffB); PG8_STAGE(PG8_SB(1, 1), b3 + hstep, voffB); PG8_STAGE(PG8_SA(1, 0), a3, voffA);
            PG8_WAIT_V(8); PG8_WAIT_L(0); PG8_BAR; PG8_MMA(1, 0, At, B0); PG8_MMA(1, 1, At, B1); PG8_BAR; PG8_SCHED;
            } else {
            PG8_LDB(B0, 0, 0); PG8_SCHED; PG8_LDA(At, 0, 0); PG8_STAGE(PG8_SA(1, 1), a1 + hstep, voffA);
            PG8_WAIT_L(8); PG8_BAR; PG8_WAIT_L(0); PG8_MMA(0, 0, At, B0); PG8_BAR; PG8_SCHED;
            PG8_LDB(B1, 0, 1); PG8_STAGE(PG8_SB(0, 0), b2, voffB);
            PG8_BAR; PG8_WAIT_L(0); PG8_MMA(0, 1, At, B1); PG8_BAR;
            PG8_LDA(At, 0, 1); PG8_STAGE(PG8_SA(0, 0), a2, voffA);
            PG8_BAR; PG8_WAIT_L(0); PG8_MMA(1, 0, At, B0); PG8_BAR; PG8_SCHED;
            PG8_STAGE(PG8_SB(0, 1), b2 + hstep, voffB);
            PG8_WAIT_V(6); PG8_BAR; PG8_MMA(1, 1, At, B1); PG8_BAR;
            PG8_LDB(B0, 1, 0); PG8_SCHED; PG8_LDA(At, 1, 0); PG8_STAGE(PG8_SA(0, 1), a2 + hstep, voffA);
            PG8_WAIT_L(8); PG8_BAR; PG8_WAIT_L(0); PG8_MMA(0, 0, At, B0); PG8_BAR; PG8_SCHED;
            PG8_LDB(B1, 1, 1); PG8_STAGE(PG8_SB(1, 0), b3, voffB);
            PG8_BAR; PG8_WAIT_L(0); PG8_MMA(0, 1, At, B1); PG8_BAR;
            PG8_LDA(At, 1, 1); PG8_STAGE(PG8_SA(1, 0), a3, voffA);
            PG8_BAR; PG8_WAIT_L(0); PG8_MMA(1, 0, At, B0); PG8_BAR; PG8_SCHED;
            PG8_STAGE(PG8_SB(1, 1), b3 + hstep, voffB);
            PG8_WAIT_V(6); PG8_BAR; PG8_MMA(1, 1, At, B1); PG8_BAR;
            }
        }
        if constexpr (ALIGN_EPI) { if (wr == 0) PG8_BAR; }
        if constexpr (!Epi::AFTER_DRAIN) { E(acc, cur, wr, wc, fr, fq); S.done(cur); }
        if (!has_next) break;
#pragma unroll
        for (int a = 0; a < 2; ++a)
#pragma unroll
            for (int b = 0; b < 2; ++b)
#pragma unroll
                for (int m = 0; m < 4; ++m)
#pragma unroll
                    for (int n = 0; n < 2; ++n) acc[a][b][m][n] = (f32x4){0.f, 0.f, 0.f, 0.f};
        cur = nxt; cA = nA; cB = nB; ++ui;
        if constexpr (ALIGN_EPI) { if (wr == 1) PG8_BAR; }
    }
    PG8_WAIT_V(0);
    if constexpr (!ALIGN_EPI) { if (wr == 0) PG8_BAR; }
    PG8_BAR;
    if constexpr (Epi::AFTER_DRAIN) { E.fused(acc, cur, wr, wc, fr, fq, lds, wid, lane); S.done(cur); }
#undef PG8_SA
#undef PG8_SB
#undef PG8_STAGE
#undef PG8_LDA
#undef PG8_LDB
#undef PG8_MMA
#undef PG8_WAIT_V
#undef PG8_WAIT_L
#undef PG8_BAR
#undef PG8_SCHED
}
}
#define XB_TMO      128
#define XB_XCNT(j)  (256  + 64 * (j))
#define XB_XSUB(j)  (1280 + 64 * (j))
#define XB_XGEN(j)  (2304 + 64 * (j))
#define XB_TOP      3328
#define XB_TOPGEN   3392
#define XCD_BAR_WORDS 3456
#define XB_SPIN_CAP (1u << 18)
#define LAS __attribute__((address_space(3)))

__device__ __forceinline__ unsigned xb_ld(unsigned* p)              { return __hip_atomic_load(p, __ATOMIC_RELAXED, __HIP_MEMORY_SCOPE_AGENT); }
__device__ __forceinline__ unsigned xb_add(unsigned* p, unsigned v) { return __hip_atomic_fetch_add(p, v, __ATOMIC_RELAXED, __HIP_MEMORY_SCOPE_AGENT); }
__device__ __forceinline__ unsigned xb_xcc_id() { return (unsigned)__builtin_amdgcn_s_getreg((3 << 11) | 20) & 0xFu; }
#define XB_SPIN(cond, bar) do { unsigned _sp = 0; while (cond) { __builtin_amdgcn_s_sleep(1); \
    if ((++_sp & 255u) == 0u) { if (xb_ld(&(bar)[XB_TMO])) break; if (_sp > XB_SPIN_CAP) { atomicAdd(&(bar)[XB_TMO], 1u); break; } } } } while (0)

struct XcdBarrier {
    unsigned* bar; unsigned x;
    volatile LAS unsigned* st;
};

__device__ __forceinline__ XcdBarrier xcd_barrier_post(unsigned* bar, volatile LAS unsigned* st) {
    XcdBarrier b; b.bar = bar; b.x = xb_xcc_id(); b.st = st;
    if (threadIdx.x == 0) (void)xb_add(&bar[XB_XCNT(b.x)], 1u);
    return b;
}
__device__ __forceinline__ void xcd_barrier_complete(unsigned* bar, unsigned x, unsigned& nloc, unsigned& nx) {
    const unsigned G = gridDim.x * gridDim.y * gridDim.z;
    unsigned sum, cnt, mine, sp = 0u;
    for (;;) {
        sum = 0u; cnt = 0u; mine = 0u;
#pragma unroll
        for (unsigned j = 0; j < 16; ++j) { const unsigned c = xb_ld(&bar[XB_XCNT(j)]); sum += c; cnt += (c > 0u) ? 1u : 0u; mine = (j == x) ? c : mine; }
        if (sum == G) break;
        __builtin_amdgcn_s_sleep(1);
        if ((++sp & 255u) == 0u) { if (xb_ld(&bar[XB_TMO])) break; if (sp > XB_SPIN_CAP) { atomicAdd(&bar[XB_TMO], 1u); break; } }
    }
    nloc = mine > 0u ? mine : 1u; nx = cnt > 0u ? cnt : 1u;
}

__device__ __forceinline__ void xcd_barrier(const XcdBarrier& b) {
    asm volatile("s_waitcnt vmcnt(0)" ::: "memory");
    __syncthreads();
    if (threadIdx.x == 0) {
        unsigned* bar = b.bar;
        __builtin_amdgcn_s_waitcnt(0);
        unsigned nloc = b.st[0], nx = b.st[1];
        if (nloc == 0u) { xcd_barrier_complete(bar, b.x, nloc, nx); b.st[0] = nloc; b.st[1] = nx; }
        const unsigned old = xb_add(&bar[XB_XSUB(b.x)], 1u);
        const unsigned gen = old / nloc;
        if (old + 1u == (gen + 1u) * nloc) {
            __builtin_amdgcn_fence(__ATOMIC_RELEASE, "agent");
            asm volatile("s_waitcnt vmcnt(0)" ::: "memory");
            const unsigned og = xb_add(&bar[XB_TOP], 1u);
            const unsigned tg = og / nx;
            if (og + 1u == (tg + 1u) * nx) xb_add(&bar[XB_TOPGEN], 1u);
            else XB_SPIN(xb_ld(&bar[XB_TOPGEN]) == tg, bar);
            __builtin_amdgcn_fence(__ATOMIC_ACQUIRE, "agent");
            xb_add(&bar[XB_XGEN(b.x)], 1u);
            asm volatile("s_waitcnt vmcnt(0)" ::: "memory");
        } else {
            XB_SPIN(xb_ld(&bar[XB_XGEN(b.x)]) == gen, bar);
            __builtin_amdgcn_fence(__ATOMIC_ACQUIRE, "agent");
            asm volatile("s_waitcnt vmcnt(0)" ::: "memory");
        }
    }
    __syncthreads();
}
#define DI __device__ __forceinline__
#define LAS3 __attribute__((address_space(3)))
using pg8::bf16_t; using pg8::bf16x8; using pg8::f32x4; using pg8::u32x4;
typedef unsigned u32x2 __attribute__((ext_vector_type(2)));
typedef short s16x4 __attribute__((ext_vector_type(4)));
typedef float f32x2 __attribute__((ext_vector_type(2)));
typedef __bf16 bf16x2_t __attribute__((ext_vector_type(2)));

constexpr int DM = 1024, NB = 16, SEQ = 2048, MP = NB * SEQ  , NDB = 32  , MROWS = 33024  ;
constexpr int NMEM = 256, MMEM = NB * NMEM  , DIN = 3412, NIN = 3584, NPAGES = 128;
constexpr int NTHREADS = 512;
constexpr size_t O_YP = 0, O_YS = O_YP + (size_t)MP * DM, O_GSP = O_YS + (size_t)NDB * DM, O_KP = O_GSP + (size_t)NB * 4 * 64 * 128,
                 O_VP = O_KP + (size_t)MP * 256, O_IKP = O_VP + (size_t)MP * 256, O_MKP = O_IKP + (size_t)MP * 64, O_MVP = O_MKP + (size_t)MMEM * 256,
                 O_GSS = O_MVP + (size_t)MMEM * 256, O_KS = O_GSS + (size_t)NDB * 4 * 64 * 128, O_VS = O_KS + (size_t)NDB * 256, O_IKS = O_VS + (size_t)NDB * 256,
                 O_END = O_IKS + (size_t)NDB * 64;
static_assert(O_END == 56150016, "output size");
constexpr size_t al256(size_t x) { return (x + 255) & ~(size_t)255; }
constexpr size_t CTRL_BYTES = 32768;
constexpr size_t CW_QDSA = 16384  , CW_QMEM = 18432  , CW_SCNT = 20480, CW_TMO = 20736, CW_CHK = 20992, CW_TSUM = 21248, CW_TMAX = 21504, CW_MEMC = 21760;
constexpr int SCLD = 16400;
constexpr size_t W_ROPE = CTRL_BYTES;
constexpr size_t W_XN = al256(W_ROPE + (size_t)2049 * 32 * 8);
constexpr size_t W_MEMN = W_XN + (size_t)MROWS * 1024 * 2;
constexpr size_t W_WTIN = W_MEMN + (size_t)MMEM * 1024 * 2;
constexpr size_t W_WTMEM = W_WTIN + (size_t)NIN * 1024 * 2;
constexpr size_t W_WTOUT = W_WTMEM + (size_t)512 * 1024 * 2;
constexpr size_t W_GQ = W_WTOUT + (size_t)1024 * 1024 * 2;
constexpr size_t W_GK = W_GQ + (size_t)MROWS * 256 * 2;
constexpr size_t W_GV = W_GK + (size_t)MROWS * 256 * 2;
constexpr size_t W_GG = W_GV + (size_t)MROWS * 512 * 2;
constexpr size_t W_DQ = W_GG + (size_t)MROWS * 512 * 2;
constexpr size_t W_DK = W_DQ + (size_t)MROWS * 256 * 2;
constexpr size_t W_DVT = W_DK + (size_t)MROWS * 256 * 2;
constexpr size_t W_IQ = W_DVT + (size_t)MP * 256 * 2;
constexpr size_t W_DG = W_IQ + (size_t)MROWS * 256 * 2;
constexpr size_t W_MQ = W_DG + (size_t)MROWS * 256 * 2;
constexpr size_t W_MG = W_MQ + (size_t)MROWS * 256 * 2;
constexpr size_t W_IK = W_MG + (size_t)MROWS * 256 * 2;
constexpr size_t W_IW = W_IK + (size_t)MROWS * 64 * 2;
constexpr size_t W_GLR = W_IW + (size_t)MROWS * 4 * 4;
constexpr size_t W_MK = W_GLR + (size_t)MROWS * 16 * 4;
constexpr size_t W_MVT = W_MK + (size_t)MMEM * 256 * 2;
constexpr size_t W_MIX = W_MVT + (size_t)MMEM * 256 * 2;
constexpr size_t W_SC = W_MIX + (size_t)MROWS * 1024 * 2;
constexpr size_t W_END = W_SC + (size_t)NDB * SCLD * 4;
constexpr int LDS_MISC = 148480, LDS_BYTES = 148480 + 256;

struct Params {
    const float *x_prompt, *x_sample, *mem_prompt, *state_gla, *cache_k, *cache_v, *cache_ik, *cache_mem_k, *cache_mem_v;
    const int* page_table;
    const float *norm_in, *w_in, *w_g2, *b_g, *onorm, *mem_norm, *w_mem_kv, *w_out, *norm_final;
    float* out; unsigned char* ws; int ph_lo, ph_hi;
};

#ifdef TSEL
#define TDECL unsigned tacc_ = 0u, tbeg_ = 0u
#define TBEG(k) do { if ((k) == TSEL) tbeg_ = (unsigned)__builtin_amdgcn_s_memrealtime(); } while (0)
#define TEND(k) do { if ((k) == TSEL) tacc_ += (unsigned)__builtin_amdgcn_s_memrealtime() - tbeg_; } while (0)
#define TARGS , unsigned& tacc_, unsigned& tbeg_
#define TPASS , tacc_, tbeg_
#else
#define TARGS
#define TPASS
#define TDECL do {} while (0)
#define TBEG(k) do {} while (0)
#define TEND(k) do {} while (0)
#endif
DI float bf2f(bf16_t v) { return __uint_as_float((unsigned)v << 16); }
DI unsigned cvtpk(float lo, float hi) { f32x2 v = {lo, hi}; bf16x2_t b = __builtin_convertvector(v, bf16x2_t); return __builtin_bit_cast(unsigned, b); }
DI bf16_t f2bf(float x) { return (bf16_t)(cvtpk(x, 0.f) & 0xffffu); }
DI f32x4 mfma16(bf16x8 a, bf16x8 b, f32x4 c) { return __builtin_amdgcn_mfma_f32_16x16x32_bf16(a, b, c, 0, 0, 0); }
DI float fexp(float x) { return __builtin_amdgcn_exp2f(x * 1.4426950408889634f); }
DI float siluf(float x) { return x * __builtin_amdgcn_rcpf(1.f + fexp(-x)); }
DI float logsigf(float u) { return fminf(u, 0.f) - 0.6931471805599453f * __builtin_amdgcn_logf(1.f + fexp(-fabsf(u))); }
DI unsigned fkey(float x) { unsigned u = __float_as_uint(x); u = (u == 0x80000000u) ? 0u : u; return u ^ ((unsigned)((int)u >> 31) | 0x80000000u); }
DI float wsum64(float v) { v += __shfl_xor(v, 1); v += __shfl_xor(v, 2); v += __shfl_xor(v, 4); v += __shfl_xor(v, 8); v += __shfl_xor(v, 16); v += __shfl_xor(v, 32); return v; }
DI float wmax64(float v) { v = fmaxf(v, __shfl_xor(v, 1)); v = fmaxf(v, __shfl_xor(v, 2)); v = fmaxf(v, __shfl_xor(v, 4)); v = fmaxf(v, __shfl_xor(v, 8)); v = fmaxf(v, __shfl_xor(v, 16)); v = fmaxf(v, __shfl_xor(v, 32)); return v; }
DI unsigned lds_add(LAS3 unsigned* p, unsigned v) { return __hip_atomic_fetch_add(p, v, __ATOMIC_RELAXED, __HIP_MEMORY_SCOPE_WORKGROUP); }
DI unsigned lds_or(LAS3 unsigned* p, unsigned v) { return __hip_atomic_fetch_or(p, v, __ATOMIC_RELAXED, __HIP_MEMORY_SCOPE_WORKGROUP); }
DI void st_bf16x4(bf16_t* p, f32x4 v) { u32x2 w; w.x = cvtpk(v[0], v[1]); w.y = cvtpk(v[2], v[3]); *(u32x2*)p = w; }
DI const float* vaddr(const float* q) { asm volatile("" : "+v"(q)); return q; }
constexpr float LOG2E = 1.4426950408889634f;
#define NEG_INF (-__builtin_inff())

DI int rope_perm(int vc) { return 64 * (vc >> 6) + 16 * ((vc >> 5) & 1) + (vc & 15) + 32 * ((vc >> 4) & 1); }
DI int rope_map(int vc) { return 64 * ((vc >> 5) & 3) + 32 * ((vc >> 4) & 1) + 8 * ((vc >> 2) & 3) + 4 * (vc >> 7) + (vc & 3); }
DI int plain_map(int vc) { return (vc & ~31) + 8 * ((vc >> 2) & 3) + 4 * ((vc >> 4) & 1) + (vc & 3); }
DI int in_src(int np) {
    const int pn = np >> 8, vc = np & 255;
    switch (pn) {
        case 0: return plain_map(vc);
        case 1: return 256 + plain_map(vc);
        case 2: case 3: return 512 + 256 * (pn - 2) + plain_map(vc);
        case 4: case 5: return 1040 + 256 * (pn - 4) + plain_map(vc);
        case 6: return 1552 + rope_map(vc);
        case 7: return 1808 + rope_map(vc);
        case 8: return 2064 + plain_map(vc);
        case 9: return 2320 + rope_map(vc);
        case 10: return 2644 + plain_map(vc);
        case 11: return 2900 + plain_map(vc);
        case 12: return 3156 + plain_map(vc);
        default: break;
    }
    if (vc < 64) return 2576 + rope_perm(vc);
    if (vc < 68) return 2640 + (vc - 64);
    if (vc < 84) return 1024 + (vc - 68);
    return -1;
}

struct EpiIn {
    static constexpr bool PERM = false, AFTER_DRAIN = false;
    unsigned char* ws; float* out;
    DI void operator()(const f32x4 (&acc)[2][2][4][2], const pg8::Unit& u, int wr, int wc, int fr, int fq) const {
        const int pn = u.pn, rbase = u.pm * 256 + wr * 64 + fr;
        if (pn <= 5 || (pn >= 10 && pn <= 12)) {
            bf16_t* dst; int ldc = 256, coff = 0; float sc = 1.f; bool silu = false;
            switch (pn) {
                case 0: dst = (bf16_t*)(ws + W_GQ); sc = 0.125f; break;
                case 1: dst = (bf16_t*)(ws + W_GK); break;
                case 2: dst = (bf16_t*)(ws + W_GV); ldc = 512; break;
                case 3: dst = (bf16_t*)(ws + W_GV); ldc = 512; coff = 256; break;
                case 4: dst = (bf16_t*)(ws + W_GG); ldc = 512; silu = true; break;
                case 5: dst = (bf16_t*)(ws + W_GG); ldc = 512; coff = 256; silu = true; break;
                case 10: dst = (bf16_t*)(ws + W_DG); silu = true; break;
                case 11: dst = (bf16_t*)(ws + W_MQ); sc = 0.125f * LOG2E; break;
                default: dst = (bf16_t*)(ws + W_MG); silu = true; break;
            }
#pragma unroll
            for (int ai = 0; ai < 2; ++ai)
#pragma unroll
                for (int m = 0; m < 4; ++m) {
                    const int row = rbase + ai * 128 + m * 16;
                    bf16_t* rp = dst + (size_t)row * ldc + coff + wc * 32 + 8 * fq;
#pragma unroll
                    for (int bj = 0; bj < 2; ++bj) {
                        f32x4 v0 = acc[ai][bj][m][0], v1 = acc[ai][bj][m][1];
                        if (silu) { v0[0] = siluf(v0[0]); v0[1] = siluf(v0[1]); v0[2] = siluf(v0[2]); v0[3] = siluf(v0[3]); v1[0] = siluf(v1[0]); v1[1] = siluf(v1[1]); v1[2] = siluf(v1[2]); v1[3] = siluf(v1[3]); }
                        else { v0 = v0 * sc; v1 = v1 * sc; }
                        u32x4 w; w.x = cvtpk(v0[0], v0[1]); w.y = cvtpk(v0[2], v0[3]); w.z = cvtpk(v1[0], v1[1]); w.w = cvtpk(v1[2], v1[3]);
                        *(u32x4*)(rp + bj * 128) = w;
                    }
                }
        } else if (pn == 6 || pn == 7 || pn == 9) {
            bf16_t* dst = (bf16_t*)(ws + (pn == 6 ? W_DQ : (pn == 7 ? W_DK : W_IQ)));
            const float sc = (pn == 6) ? 0.125f * LOG2E : 1.f;
            const float* rope = (const float*)(ws + W_ROPE);
#pragma unroll
            for (int ai = 0; ai < 2; ++ai)
#pragma unroll
                for (int m = 0; m < 4; ++m) {
                    const int row = rbase + ai * 128 + m * 16;
                    const int pi = row < MP ? (row & 2047) : 2048;
                    const float* rp = rope + ((size_t)pi * 32 + 8 * fq) * 2;
                    f32x4 o1[2], o2[2];
#pragma unroll
                    for (int bj = 0; bj < 2; ++bj) {
                        const f32x4 cs0 = *(const f32x4*)(rp + 8 * bj), cs1 = *(const f32x4*)(rp + 8 * bj + 4);
                        const f32x4 c = {cs0[0], cs0[2], cs1[0], cs1[2]}, s = {cs0[1], cs0[3], cs1[1], cs1[3]};
                        const f32x4 v0 = acc[ai][bj][m][0], v1 = acc[ai][bj][m][1];
                        o1[bj] = (v0 * c - v1 * s) * sc; o2[bj] = (v1 * c + v0 * s) * sc;
                    }
                    const int col1 = 64 * wc + 8 * fq, col2 = col1 + 32;
                    u32x4 w1, w2; w1.x = cvtpk(o1[0][0], o1[0][1]); w1.y = cvtpk(o1[0][2], o1[0][3]); w1.z = cvtpk(o1[1][0], o1[1][1]); w1.w = cvtpk(o1[1][2], o1[1][3]);
                    w2.x = cvtpk(o2[0][0], o2[0][1]); w2.y = cvtpk(o2[0][2], o2[0][3]); w2.z = cvtpk(o2[1][0], o2[1][1]); w2.w = cvtpk(o2[1][2], o2[1][3]);
                    *(u32x4*)(dst + (size_t)row * 256 + col1) = w1; *(u32x4*)(dst + (size_t)row * 256 + col2) = w2;
                    if (pn == 7) {
                        float* op = nullptr;
                        if (row < MP) op = out + O_KP + (size_t)row * 256; else if (row < MP + NDB) op = out + O_KS + (size_t)(row - MP) * 256;
                        if (op) { *(f32x4*)(op + col1) = o1[0]; *(f32x4*)(op + col1 + 4) = o1[1]; *(f32x4*)(op + col2) = o2[0]; *(f32x4*)(op + col2 + 4) = o2[1]; }
                    }
                }
        } else if (pn == 8) {
            bf16_t* dvt = (bf16_t*)(ws + W_DVT);
#pragma unroll
            for (int ai = 0; ai < 2; ++ai)
#pragma unroll
                for (int m = 0; m < 4; ++m) {
                    const int row = rbase + ai * 128 + m * 16;
                    float* op = nullptr;
                    if (row < MP) op = out + O_VP + (size_t)row * 256; else if (row < MP + NDB) op = out + O_VS + (size_t)(row - MP) * 256;
#pragma unroll
                    for (int bj = 0; bj < 2; ++bj)
#pragma unroll
                        for (int n = 0; n < 2; ++n) {
                            const f32x4 v = acc[ai][bj][m][n];
                            const int col = 128 * bj + 32 * wc + 8 * fq + 4 * n;
                            if (op) *(f32x4*)(op + col) = v;
                            if (row < MP) {
                                const int t_ = row & 2047, kk_ = t_ & 31;
                                bf16_t* tp = dvt + ((((size_t)(row >> 11) * 64 + (t_ >> 5)) * 4 + (col >> 6)) * 64 + (col & 63)) * 32 + 8 * ((kk_ >> 2) & 3) + 4 * (kk_ >> 4) + (kk_ & 3);
                                tp[0] = f2bf(v[0]); tp[32] = f2bf(v[1]); tp[64] = f2bf(v[2]); tp[96] = f2bf(v[3]);
                            }
                        }
                }
        } else {
            bf16_t* ikb = (bf16_t*)(ws + W_IK); float* iw = (float*)(ws + W_IW); float* glr = (float*)(ws + W_GLR);
            const float* rope = (const float*)(ws + W_ROPE);
#pragma unroll
            for (int ai = 0; ai < 2; ++ai)
#pragma unroll
                for (int m = 0; m < 4; ++m) {
                    const int row = rbase + ai * 128 + m * 16;
                    const f32x4 v0 = acc[ai][0][m][0], v1 = acc[ai][0][m][1];
                    if (wc < 2) {
                        const int pi = row < MP ? (row & 2047) : 2048;
                        const int f0 = 16 * wc + 4 * fq;
                        const f32x4 cs0 = *(const f32x4*)(rope + ((size_t)pi * 32 + f0) * 2), cs1 = *(const f32x4*)(rope + ((size_t)pi * 32 + f0) * 2 + 4);
                        const f32x4 c = {cs0[0], cs0[2], cs1[0], cs1[2]}, s = {cs0[1], cs0[3], cs1[1], cs1[3]};
                        const f32x4 o1 = v0 * c - v1 * s, o2 = v1 * c + v0 * s;
                        st_bf16x4(ikb + (size_t)row * 64 + f0, o1); st_bf16x4(ikb + (size_t)row * 64 + f0 + 32, o2);
                        float* op = nullptr;
                        if (row < MP) op = out + O_IKP + (size_t)row * 64; else if (row < MP + NDB) op = out + O_IKS + (size_t)(row - MP) * 64;
                        if (op) { *(f32x4*)(op + f0) = o1; *(f32x4*)(op + f0 + 32) = o2; }
                    } else if (wc == 2) {
                        if (fq == 0) { *(f32x4*)(iw + (size_t)row * 4) = v0 * 0.5f; *(f32x4*)(glr + (size_t)row * 16 + 12) = v1; }
                        else *(f32x4*)(glr + (size_t)row * 16 + 4 * (fq - 1)) = v0;
                    }
                }
        }
    }
};
struct EpiMem {
    static constexpr bool PERM = false, AFTER_DRAIN = false;
    unsigned char* ws; float* out;
    DI void operator()(const f32x4 (&acc)[2][2][4][2], const pg8::Unit& u, int wr, int wc, int fr, int fq) const {
        const int pn = u.pn, rbase = u.pm * 256 + wr * 64 + fr;
        bf16_t* mk = (bf16_t*)(ws + W_MK); bf16_t* mvt = (bf16_t*)(ws + W_MVT);
        float* op0 = out + (pn == 0 ? O_MKP : O_MVP);
#pragma unroll
        for (int ai = 0; ai < 2; ++ai)
#pragma unroll
            for (int m = 0; m < 4; ++m) {
                const int row = rbase + ai * 128 + m * 16;
#pragma unroll
                for (int bj = 0; bj < 2; ++bj)
#pragma unroll
                    for (int n = 0; n < 2; ++n) {
                        const f32x4 v = acc[ai][bj][m][n];
                        const int col = 128 * bj + 32 * wc + 16 * n + 4 * fq;
                        *(f32x4*)(op0 + (size_t)row * 256 + col) = v;
                        if (pn == 0) st_bf16x4(mk + (size_t)row * 256 + col, v);
                        else { const int m_ = row & 255, kk_ = m_ & 31;
                               bf16_t* tp = mvt + ((((size_t)(row >> 8) * 8 + (m_ >> 5)) * 4 + (col >> 6)) * 64 + (col & 63)) * 32 + 8 * ((kk_ >> 2) & 3) + 4 * (kk_ >> 4) + (kk_ & 3);
                               tp[0] = f2bf(v[0]); tp[32] = f2bf(v[1]); tp[64] = f2bf(v[2]); tp[96] = f2bf(v[3]); }
                    }
            }
    }
};
struct EpiOut {
    static constexpr bool PERM = false, AFTER_DRAIN = false;
    const float* xp; const float* xs; float* out;
    DI void operator()(const f32x4 (&acc)[2][2][4][2], const pg8::Unit& u, int wr, int wc, int fr, int fq) const {
        const int rbase = u.pm * 256 + wr * 64 + fr, cbase = u.pn * 256 + wc * 32 + 4 * fq;
#pragma unroll
        for (int ai = 0; ai < 2; ++ai)
#pragma unroll
            for (int m = 0; m < 4; ++m) {
                const int row = rbase + ai * 128 + m * 16;
                const float* xr; float* orow;
                if (row < MP) { xr = xp + (size_t)row * DM; orow = out + O_YP + (size_t)row * DM; }
                else if (row < MP + NDB) { xr = xs + (size_t)(row - MP) * DM; orow = out + O_YS + (size_t)(row - MP) * DM; }
                else continue;
#pragma unroll
                for (int bj = 0; bj < 2; ++bj)
#pragma unroll
                    for (int n = 0; n < 2; ++n) { const int col = cbase + bj * 128 + n * 16; *(f32x4*)(orow + col) = acc[ai][bj][m][n] + *(const f32x4*)(xr + col); }
            }
    }
};
DI void p0_prologue(const Params& p, LAS3 unsigned char* lds) {
    const int tid = threadIdx.x, lane = tid & 63, wv = tid >> 6;
    unsigned char* ws = p.ws;
    {
        const int rstep = gridDim.x * 16, rend = MROWS + MMEM;
        int r0 = (blockIdx.x * 8 + wv) * 2;
        auto row_src = [&](int r) -> const float* {
            r = r < rend ? r : rend - 1;
            if (r < MP) return p.x_prompt + (size_t)r * DM;
            if (r < MP + NDB) return p.x_sample + (size_t)(r - MP) * DM;
            if (r < MROWS) return p.x_prompt;
            return p.mem_prompt + (size_t)(r - MROWS) * DM;
        };
        f32x4 v[2][4], vn[2][4];
#pragma unroll
        for (int e = 0; e < 2; ++e) { const float* s = row_src(r0 + e);
#pragma unroll
            for (int i = 0; i < 4; ++i) v[e][i] = *(const f32x4*)(s + i * 256 + lane * 4); }
        for (; r0 < rend; r0 += rstep) {
#pragma unroll
            for (int e = 0; e < 2; ++e) { const float* s = row_src(r0 + rstep + e);
#pragma unroll
                for (int i = 0; i < 4; ++i) vn[e][i] = *(const f32x4*)(s + i * 256 + lane * 4); }
#pragma unroll
            for (int e = 0; e < 2; ++e) {
                const int r = r0 + e;
                const bool pad = (r >= MP + NDB && r < MROWS);
                const float* g = r < MROWS ? p.norm_in : p.mem_norm;
                bf16_t* dst = r < MROWS ? (bf16_t*)(ws + W_XN) + (size_t)r * DM : (bf16_t*)(ws + W_MEMN) + (size_t)(r - MROWS) * DM;
                float ss = 0.f;
#pragma unroll
                for (int i = 0; i < 4; ++i) ss += v[e][i][0] * v[e][i][0] + v[e][i][1] * v[e][i][1] + v[e][i][2] * v[e][i][2] + v[e][i][3] * v[e][i][3];
                ss = wsum64(ss);
                const float rstd = pad ? 0.f : rsqrtf(ss * (1.f / DM) + 1e-6f);
#pragma unroll
                for (int i = 0; i < 4; ++i) { const f32x4 gv = *(const f32x4*)(g + i * 256 + lane * 4); st_bf16x4(dst + i * 256 + lane * 4, v[e][i] * rstd * gv); }
            }
#pragma unroll
            for (int e = 0; e < 2; ++e)
#pragma unroll
                for (int i = 0; i < 4; ++i) v[e][i] = vn[e][i];
        }
    }
    for (int e = blockIdx.x * NTHREADS + tid; e < 2049 * 32; e += gridDim.x * NTHREADS) {
        const int pi = e >> 5, f = e & 31;
        const float inv = powf(10000.0f, -(float)(2 * f) / 64.0f);
        const float ang = (float)(pi == 2048 ? 16384 : pi) * inv;
        float sn, cs; sincosf(ang, &sn, &cs);
        ((f32x2*)(ws + W_ROPE))[e] = (f32x2){cs, sn};
    }
    LAS3 float* tl = (LAS3 float*)lds;
    {
        auto tile_load = [&](int tile, float (&wr)[8]) {
            tile = tile < 1280 ? tile : 1279;
            int which, t2, ld; const float* W;
            if (tile < 896) { which = 0; t2 = tile; W = p.w_in; ld = DIN; }
            else if (tile < 1024) { which = 1; t2 = tile - 896; W = p.w_mem_kv; ld = 512; }
            else { which = 2; t2 = tile - 1024; W = p.w_out; ld = 1024; }
            const int nt = t2 >> 4, kt = t2 & 15;
            const int nn = tid & 63, kk0 = tid >> 6; const int np = nt * 64 + nn; int sc = which == 0 ? in_src(np) : np;
            const bool zero = sc < 0; sc = zero ? 0 : sc;
#pragma unroll
            for (int i = 0; i < 8; ++i) { const float w = W[(size_t)(kt * 64 + kk0 + 8 * i) * ld + sc]; wr[i] = zero ? 0.f : w; }
        };
        float wr[8], wn[8];
        tile_load(blockIdx.x, wr);
        for (int tile = blockIdx.x; tile < 1280; tile += gridDim.x) {
            bf16_t* dst; int t2;
            if (tile < 896) { t2 = tile; dst = (bf16_t*)(ws + W_WTIN); }
            else if (tile < 1024) { t2 = tile - 896; dst = (bf16_t*)(ws + W_WTMEM); }
            else { t2 = tile - 1024; dst = (bf16_t*)(ws + W_WTOUT); }
            const int nt = t2 >> 4, kt = t2 & 15;
            { const int nn = tid & 63, kk0 = tid >> 6;
#pragma unroll
              for (int i = 0; i < 8; ++i) tl[(kk0 + 8 * i) * 65 + nn] = wr[i]; }
            __syncthreads();
            tile_load(tile + gridDim.x, wn);
            { const int kk = tid & 63, nn0 = tid >> 6;
#pragma unroll
              for (int i = 0; i < 8; ++i) { const int n = nn0 + 8 * i; dst[(size_t)(nt * 64 + n) * 1024 + kt * 64 + kk] = f2bf(tl[kk * 65 + n]); } }
            __syncthreads();
#pragma unroll
            for (int i = 0; i < 8; ++i) wr[i] = wn[i];
        }
    }
}

DI void cnt_ge(unsigned& c, unsigned key, unsigned cand) { asm volatile("v_cmp_ge_u32 vcc, %1, %2\n\tv_addc_co_u32 %0, vcc, 0, %0, vcc" : "+v"(c) : "v"(key), "v"(cand) : "vcc"); }
DI void cnt_gt(unsigned& c, unsigned key, unsigned cand) { asm volatile("v_cmp_gt_u32 vcc, %1, %2\n\tv_addc_co_u32 %0, vcc, 0, %0, vcc" : "+v"(c) : "v"(key), "v"(cand) : "vcc"); }
DI void cnt_eq_lt(unsigned& c, unsigned key, unsigned T, unsigned idx, unsigned cand) {
    unsigned tmp;
    asm volatile("v_cmp_eq_u32 vcc, %2, %3\n\tv_cndmask_b32 %1, -1, %4, vcc\n\tv_cmp_lt_u32 vcc, %1, %5\n\tv_addc_co_u32 %0, vcc, 0, %0, vcc" : "+v"(c), "=&v"(tmp) : "v"(key), "v"(T), "v"(idx), "v"(cand) : "vcc"); }
DI unsigned grp_count16(unsigned c, LAS3 unsigned* CNT, int& it, int fr, int lane) {
    c += __shfl_xor(c, 16); c += __shfl_xor(c, 32);
    LAS3 unsigned* cur = CNT + (it % 3) * 16;
    if (lane < 16) lds_add(cur + fr, c);
    __syncthreads();
    const unsigned tot = cur[fr];
    if (threadIdx.x < 16) CNT[((it + 2) % 3) * 16 + threadIdx.x] = 0u;
    ++it; return tot;
}
DI unsigned blk_count(unsigned c, LAS3 unsigned* CNT, int& it, int lane) {
    c += __shfl_xor(c, 1); c += __shfl_xor(c, 2); c += __shfl_xor(c, 4); c += __shfl_xor(c, 8); c += __shfl_xor(c, 16); c += __shfl_xor(c, 32);
    LAS3 unsigned* cur = CNT + (it % 3) * 16;
    if (lane == 0) lds_add(cur, c);
    __syncthreads();
    const unsigned tot = cur[0];
    if (threadIdx.x == 0) CNT[((it + 2) % 3) * 16] = 0u;
    ++it; return tot;
}

template <bool MASKED>
DI void attn32(const bf16_t* Q, int ldq, const bf16_t* K, int ldk, const bf16_t* Vt, int ldv, int nkb, const LAS3 unsigned* mask, int fr, int fq,
               f32x4 (&o)[4][2], float (&linv)[2]) {
    bf16x8 qf[2][2];
#pragma unroll
    for (int qt = 0; qt < 2; ++qt)
#pragma unroll
        for (int ks = 0; ks < 2; ++ks) qf[qt][ks] = *(const bf16x8*)(Q + (size_t)(16 * qt + fr) * ldq + ks * 32 + fq * 8);
    float m[2] = {NEG_INF, NEG_INF}, l[2] = {0.f, 0.f};
    const f32x4 zero = {0.f, 0.f, 0.f, 0.f};
#pragma unroll
    for (int dt = 0; dt < 4; ++dt) { o[dt][0] = zero; o[dt][1] = zero; }
    const bf16_t* kl = K + (size_t)fr * ldk + fq * 8;
#ifdef BROKEN_VT
    const bf16_t* vl = Vt + fr * 32 + 8 * ((fq + 1) & 3);
#else
    const bf16_t* vl = Vt + fr * 32 + 8 * fq;
#endif
    bf16x8 kfA[2][2], kfB[2][2], vA[4], vB[4];
#define ATT_LOAD(KF, VF, kb_) do { \
        _Pragma("unroll") for (int i2 = 0; i2 < 2; ++i2) _Pragma("unroll") for (int ks = 0; ks < 2; ++ks) KF[i2][ks] = *(const bf16x8*)(kl + (size_t)(32 * (kb_) + 16 * i2) * ldk + ks * 32); \
        _Pragma("unroll") for (int dt = 0; dt < 4; ++dt) VF[dt] = *(const bf16x8*)(vl + (size_t)(kb_) * ldv + 512 * dt); } while (0)
#define ATT_COMPUTE(KF, VF, kb_) do { \
        _Pragma("unroll") for (int qt = 0; qt < 2; ++qt) { \
            f32x4 s0 = mfma16(KF[0][0], qf[qt][0], zero); s0 = mfma16(KF[0][1], qf[qt][1], s0); \
            f32x4 s1 = mfma16(KF[1][0], qf[qt][0], zero); s1 = mfma16(KF[1][1], qf[qt][1], s1); \
            if (MASKED) { const unsigned mw = mask[(16 * qt + fr) * 65 + (kb_)]; const unsigned b0 = mw >> (2 * fq), b1 = mw >> (8 + 2 * fq); \
                _Pragma("unroll") for (int r = 0; r < 4; ++r) { const int sh_ = (r >> 1) + 16 * (r & 1); s0[r] = ((b0 >> sh_) & 1u) ? s0[r] : NEG_INF; s1[r] = ((b1 >> sh_) & 1u) ? s1[r] : NEG_INF; } } \
            float mx = fmaxf(fmaxf(fmaxf(s0[0], s0[1]), fmaxf(s0[2], s0[3])), fmaxf(fmaxf(s1[0], s1[1]), fmaxf(s1[2], s1[3]))); \
            mx = fmaxf(mx, __shfl_xor(mx, 16)); mx = fmaxf(mx, __shfl_xor(mx, 32)); \
            const float mn = fmaxf(m[qt], mx), ms = (mn == NEG_INF) ? 0.f : mn; \
            const float alpha = __builtin_amdgcn_exp2f(m[qt] - ms); \
            f32x4 p0, p1; \
            _Pragma("unroll") for (int r = 0; r < 4; ++r) { p0[r] = __builtin_amdgcn_exp2f(s0[r] - ms); p1[r] = __builtin_amdgcn_exp2f(s1[r] - ms); } \
            l[qt] = l[qt] * alpha + ((p0[0] + p0[1]) + (p0[2] + p0[3])) + ((p1[0] + p1[1]) + (p1[2] + p1[3])); \
            m[qt] = mn; \
            u32x4 pw; pw.x = cvtpk(p0[0], p0[1]); pw.y = cvtpk(p0[2], p0[3]); pw.z = cvtpk(p1[0], p1[1]); pw.w = cvtpk(p1[2], p1[3]); \
            const bf16x8 pf = __builtin_bit_cast(bf16x8, pw); \
            if (!__all(alpha == 1.f)) { _Pragma("unroll") for (int dt = 0; dt < 4; ++dt) o[dt][qt] = o[dt][qt] * alpha; }     \
            _Pragma("unroll") for (int dt = 0; dt < 4; ++dt) o[dt][qt] = mfma16(VF[dt], pf, o[dt][qt]); } } while (0)
    ATT_LOAD(kfA, vA, 0);
    const int last = nkb - 1;
    for (int kb = 0; kb < nkb; kb += 2) {
        ATT_LOAD(kfB, vB, kb + 1);
        ATT_COMPUTE(kfA, vA, kb);
        { const int k2 = kb + 2 < last ? kb + 2 : last; ATT_LOAD(kfA, vA, k2); }
        ATT_COMPUTE(kfB, vB, kb + 1);
    }
#undef ATT_LOAD
#undef ATT_COMPUTE
#pragma unroll
    for (int qt = 0; qt < 2; ++qt) { float lt = l[qt]; lt += __shfl_xor(lt, 16); lt += __shfl_xor(lt, 32); linv[qt] = 1.f / lt; }
}
DI void attn_store(const f32x4 (&o)[4][2], const float (&linv)[2], const bf16_t* gate  , bf16_t* mix  , int fr, int fq) {
#pragma unroll
    for (int qt = 0; qt < 2; ++qt)
#pragma unroll
        for (int dt = 0; dt < 4; ++dt) {
            const size_t row = 16 * qt + fr; const int col = 16 * dt + 4 * fq;
            const u32x2 gw = *(const u32x2*)(gate + row * 256 + col);
            f32x4 v = o[dt][qt] * linv[qt];
            v[0] *= __uint_as_float(gw.x << 16); v[1] *= __uint_as_float(gw.x & 0xffff0000u); v[2] *= __uint_as_float(gw.y << 16); v[3] *= __uint_as_float(gw.y & 0xffff0000u);
            st_bf16x4(mix + row * 1024 + col, v);
        }
}

constexpr int DS_MASK = 0, DS_PKT = 16640, PKT_LD = 2052, DS_CNT = 147968;
typedef unsigned short u16x2 __attribute__((ext_vector_type(2)));
DI unsigned pk_cnt_ge(unsigned acc, unsigned kpair, unsigned cm1, unsigned ones) {
    unsigned t;
    asm("v_pk_sub_u16 %1, %2, %3 clamp\n\tv_pk_min_u16 %1, %1, %4\n\tv_pk_add_u16 %0, %0, %1" : "+v"(acc), "=&v"(t) : "v"(kpair), "v"(cm1), "v"(ones));
    return acc;
}
DI void select_bitwise(const unsigned (&key)[16][4], int lbase, LAS3 unsigned* CNT, int& it, int fr, int lane, unsigned& T, int& Xrel) {
    bool fin = false;
    T = 0u; Xrel = 0x7fffffff;
    for (int bit = 31; bit >= 0; --bit) {
        const unsigned cand = T | (1u << bit);
        unsigned c = 0;
#pragma unroll
        for (int n = 0; n < 16; ++n)
#pragma unroll
            for (int r = 0; r < 4; ++r) cnt_ge(c, key[n][r], cand);
        const unsigned tot = grp_count16(c, CNT, it, fr, lane);
        if (!fin && tot >= 256u) { T = cand; fin = (tot == 256u); }
        if (__all(fin)) break;
    }
    if (!__all(fin)) {
        unsigned c = 0;
#pragma unroll
        for (int n = 0; n < 16; ++n)
#pragma unroll
            for (int r = 0; r < 4; ++r) cnt_gt(c, key[n][r], T);
        const unsigned cgt = grp_count16(c, CNT, it, fr, lane);
        const unsigned need = 256u - cgt;
        unsigned Xl = 0u;
        for (int bit = 10; bit >= 0; --bit) {
            const unsigned cand = Xl | (1u << bit);
            const int crel = (int)cand - lbase;
            c = 0;
#pragma unroll
            for (int n = 0; n < 16; ++n) { const int crn = crel - 128 * n;
#pragma unroll
                for (int r = 0; r < 4; ++r) c += (key[n][r] == T && r < crn) ? 1u : 0u; }
            const unsigned tot = grp_count16(c, CNT, it, fr, lane);
            if (tot < need) Xl = cand;
        }
        if (!fin) Xrel = (int)Xl - lbase;
    }
}
DI unsigned pk_flag_ge(unsigned kpair, unsigned cm1, unsigned ones) {
    unsigned t;
    asm("v_pk_sub_u16 %0, %1, %2 clamp\n\tv_pk_min_u16 %0, %0, %3" : "=&v"(t) : "v"(kpair), "v"(cm1), "v"(ones));
    return t;
}
DI unsigned pk_max(unsigned a, unsigned b2) { unsigned t; asm("v_pk_max_u16 %0, %1, %2" : "=v"(t) : "v"(a), "v"(b2)); return t; }
DI unsigned hsum32(unsigned x) {
    x += __builtin_amdgcn_update_dpp(0u, x, 0xB1, 0xF, 0xF, false); x += __builtin_amdgcn_update_dpp(0u, x, 0x4E, 0xF, 0xF, false);
    x += __builtin_amdgcn_update_dpp(0u, x, 0x141, 0xF, 0xF, false); x += __builtin_amdgcn_update_dpp(0u, x, 0x140, 0xF, 0xF, false);
    const auto r = __builtin_amdgcn_permlane16_swap(x, x, false, false); return r[0] + r[1];
}
DI unsigned hmax32(unsigned x) {
    x = max(x, (unsigned)__builtin_amdgcn_update_dpp(0u, x, 0xB1, 0xF, 0xF, false)); x = max(x, (unsigned)__builtin_amdgcn_update_dpp(0u, x, 0x4E, 0xF, 0xF, false));
    x = max(x, (unsigned)__builtin_amdgcn_update_dpp(0u, x, 0x141, 0xF, 0xF, false)); x = max(x, (unsigned)__builtin_amdgcn_update_dpp(0u, x, 0x140, 0xF, 0xF, false));
    const auto r = __builtin_amdgcn_permlane16_swap(x, x, false, false); return max(r[0], r[1]);
}
DI unsigned pk_count32(const unsigned (&rk)[32], unsigned cm1, unsigned ones, int nq) {
    unsigned a0 = 0u, a1 = 0u;
#pragma unroll
    for (int k = 0; k < 8; k += 2) { a0 = pk_cnt_ge(a0, rk[k], cm1, ones); a1 = pk_cnt_ge(a1, rk[k + 1], cm1, ones); }
    if (nq > 1) {
#pragma unroll
        for (int k = 8; k < 16; k += 2) { a0 = pk_cnt_ge(a0, rk[k], cm1, ones); a1 = pk_cnt_ge(a1, rk[k + 1], cm1, ones); }
        if (nq > 2) {
#pragma unroll
            for (int k = 16; k < 24; k += 2) { a0 = pk_cnt_ge(a0, rk[k], cm1, ones); a1 = pk_cnt_ge(a1, rk[k + 1], cm1, ones); }
            if (nq > 3) {
#pragma unroll
                for (int k = 24; k < 32; k += 2) { a0 = pk_cnt_ge(a0, rk[k], cm1, ones); a1 = pk_cnt_ge(a1, rk[k + 1], cm1, ones); }
            }
        }
    }
    return (a0 & 0xffffu) + (a0 >> 16) + (a1 & 0xffffu) + (a1 >> 16);
}
DI void dsa_unit(const Params& p, LAS3 unsigned char* lds, int b, int j TARGS) {
    int tid = threadIdx.x; asm volatile("" : "+v"(tid));
    const int lane0 = tid & 63, w = __builtin_amdgcn_readfirstlane(tid >> 6);
    unsigned char* ws = p.ws;
    LAS3 unsigned* MASK = (LAS3 unsigned*)(lds + DS_MASK);
    LAS3 unsigned* PKT = (LAS3 unsigned*)(lds + DS_PKT);
    const bf16_t* IQ = (const bf16_t*)(ws + W_IQ); const bf16_t* IK = (const bf16_t*)(ws + W_IK); const float* IW = (const float*)(ws + W_IW);
    const int q0 = 64 * j;
    const f32x4 zero = {0.f, 0.f, 0.f, 0.f};
#ifdef CHECK_SEL
    LAS3 unsigned* CNT = (LAS3 unsigned*)(lds + DS_CNT); int it = 0;
    if (tid < 48) CNT[tid] = 0u;
    __syncthreads();
#endif
    TBEG(30);
    bf16x8 bqn[4][2]; f32x4 wqn;
    { const size_t qr0 = (size_t)b * SEQ + q0 + (lane0 & 15);
#pragma unroll
      for (int h = 0; h < 4; ++h)
#pragma unroll
          for (int ks = 0; ks < 2; ++ks) bqn[h][ks] = *(const bf16x8*)(IQ + qr0 * 256 + h * 64 + ks * 32 + (lane0 >> 4) * 8);
      wqn = *(const f32x4*)(IW + qr0 * 4); }
#pragma unroll 1
    for (int qg = 0; qg < 4; ++qg) {
        TBEG(32);
        int lane = lane0; asm volatile("" : "+v"(lane));
        const int fr = lane & 15, fq = lane >> 4;
        const int tq = q0 + 16 * qg + fr; const size_t qrow = (size_t)b * SEQ + tq;
        const int ntile = 4 * j + qg + 1;
        const int nloc = ntile > w ? (ntile - w + 7) >> 3 : 0;
        const bool selecting = q0 + 16 * qg >= 256;
        {
            bf16x8 bq[4][2];
#pragma unroll
            for (int h = 0; h < 4; ++h)
#pragma unroll
                for (int ks = 0; ks < 2; ++ks) bq[h][ks] = bqn[h][ks];
            const f32x4 wq = wqn;
            float Lh[4];
#pragma unroll
            for (int h = 0; h < 4; ++h) Lh[h] = wq[h] < 0.f ? NEG_INF : -NEG_INF;
            const char* tb = (const char*)IK + ((size_t)b * SEQ + 16 * w) * 128 + (unsigned)(fr * 128 + fq * 16);
            LAS3 unsigned* krow = PKT + fr * PKT_LD + 16 * w + 4 * fq;
            const int lim0 = tq - (16 * w + 4 * fq);
#define DSA_TILE(A0, A1, nn) do { \
                f32x4 sc = zero; \
                _Pragma("unroll") for (int h = 0; h < 4; ++h) { f32x4 d = mfma16(A0, bq[h][0], zero); d = mfma16(A1, bq[h][1], d); d = d * wq[h]; \
                    _Pragma("unroll") for (int r = 0; r < 4; ++r) sc[r] += __builtin_amdgcn_fmed3f(d[r], 0.f, Lh[h]); } \
                { const char* t2_ = tb + (size_t)((nn) + 2 < nloc ? (nn) + 2 : nloc - 1) * 16384; A0 = *(const bf16x8*)t2_; A1 = *(const bf16x8*)(t2_ + 64); } \
                const int limn = lim0 - 128 * (nn);                   \
                u32x4 kv; \
                _Pragma("unroll") for (int r = 0; r < 4; ++r) { const unsigned u = __float_as_uint(sc[r] + 0.f); const unsigned k = u ^ ((unsigned)((int)u >> 31) | 0x80000000u);   \
                    kv[r] = (r <= limn) ? k : 0u; } \
                *(LAS3 u32x4*)(krow + 128 * (nn)) = kv; } while (0)
            if (nloc > 0) {
                bf16x8 a0 = *(const bf16x8*)tb, a1 = *(const bf16x8*)(tb + 64);
                const char* t1 = tb + (size_t)(1 < nloc ? 1 : 0) * 16384;
                bf16x8 b0 = *(const bf16x8*)t1, b1 = *(const bf16x8*)(t1 + 64);
#pragma unroll 1
                for (int n = 0; n < nloc; n += 2) {
                    DSA_TILE(a0, a1, n);
                    if (n + 1 < nloc) DSA_TILE(b0, b1, n + 1);
                }
            }
#undef DSA_TILE
        }
        TEND(32); TBEG(33);
        __syncthreads();
        { const size_t qrn = qrow + (qg < 3 ? 16 : 0);
#pragma unroll
          for (int h = 0; h < 4; ++h)
#pragma unroll
              for (int ks = 0; ks < 2; ++ks) bqn[h][ks] = *(const bf16x8*)(IQ + qrn * 256 + h * 64 + ks * 32 + fq * 8);
          wqn = *(const f32x4*)(IW + qrn * 4); }
        {
            const int hh = lane >> 5, pos = lane & 31, oq = 2 * w + hh;
            const unsigned nkeys = 16u * (unsigned)ntile;
            const int nq = (int)((nkeys + 511u) >> 9);
            const LAS3 unsigned* orow = PKT + oq * PKT_LD + 2 * pos;
            unsigned ones = 0x00010001u; asm volatile("" : "+v"(ones));
            unsigned Tfull = 1u, X = 0xffffffffu;
            if (selecting) {
                unsigned rk[32];
                unsigned mx = 0u;
#define RK_FILL(k0) do { _Pragma("unroll") for (int k = (k0); k < (k0) + 8; ++k) { const u32x2 kk = *(const LAS3 u32x2*)(orow + 64 * k); \
                        rk[k] = (2u * (unsigned)(pos + 32 * k) < nkeys) ? __builtin_amdgcn_perm(kk.y, kk.x, 0x07060302u) : 0u; mx = pk_max(mx, rk[k]); } } while (0)
                RK_FILL(0);
                if (nq > 1) { RK_FILL(8); if (nq > 2) { RK_FILL(16); if (nq > 3) { RK_FILL(24); } } }
#undef RK_FILL
                const unsigned kmax = hmax32(max(mx & 0xffffu, mx >> 16));
                unsigned T16 = 0u, cabove = 0u; bool exact = false;
                {
                    unsigned ub = 0x10000u;
#pragma unroll 1
                    for (int bit = 15; bit >= 0; --bit) {
                        const unsigned cand = T16 | (1u << bit);
                        if (__all(cand > kmax)) { ub = cand; continue; }
                        const unsigned tot = hsum32(pk_count32(rk, (cand - 1u) * 0x00010001u, ones, nq));
                        if (tot >= 256u) T16 = cand; else { ub = cand; cabove = tot; }
                    }
                    (void)ub;
                }
                const unsigned need = 256u - cabove;
#define RK_LOW(k0) do { _Pragma("unroll") for (int k = (k0); k < (k0) + 8; ++k) { const u32x2 kk = *(const LAS3 u32x2*)(orow + 64 * k); const bool in = 2u * (unsigned)(pos + 32 * k) < nkeys; \
                        const unsigned lo0 = (in && (kk.x >> 16) == T16) ? (kk.x & 0xffffu) : 0u, lo1 = (in && (kk.y >> 16) == T16) ? (kk.y & 0xffffu) : 0u; rk[k] = lo0 | (lo1 << 16); } } while (0)
                RK_LOW(0);
                if (nq > 1) { RK_LOW(8); if (nq > 2) { RK_LOW(16); if (nq > 3) { RK_LOW(24); } } }
#undef RK_LOW
                unsigned Tlo = 0u;
#pragma unroll 1
                for (int bit = 15; bit >= 0; --bit) {
                    const unsigned cand = Tlo | (1u << bit);
                    const unsigned tot = hsum32(pk_count32(rk, (cand - 1u) * 0x00010001u, ones, nq));
                    if (!exact && tot >= need) { Tlo = cand; exact = (tot == need); }
                    if (__all(exact)) break;
                }
                Tfull = (T16 << 16) | Tlo;
                if (!__all(exact)) {
                    unsigned cgt = 0u, ceq = 0u;
#pragma unroll 1
                    for (int k = 0; k < 8 * nq; ++k) { const u32x2 kk = *(const LAS3 u32x2*)(orow + 64 * k); const bool in = 2u * (unsigned)(pos + 32 * k) < nkeys;
                        cgt += (in && kk.x > Tfull && (kk.x >> 16) == T16 ? 1u : 0u) + (in && kk.y > Tfull && (kk.y >> 16) == T16 ? 1u : 0u); }
                    (void)ceq;
                    const unsigned needt = need - hsum32(cgt);
                    unsigned Xl = 0u;
#pragma unroll 1
                    for (int bit = 10; bit >= 0; --bit) {
                        const unsigned cx = Xl | (1u << bit);
                        unsigned c = 0u;
#pragma unroll 1
                        for (int k = 0; k < 8 * nq; ++k) { const u32x2 kk = *(const LAS3 u32x2*)(orow + 64 * k); const unsigned i0 = 2u * (unsigned)(pos + 32 * k);
                            c += (i0 < nkeys && kk.x == Tfull && i0 < cx ? 1u : 0u) + (i0 < nkeys && kk.y == Tfull && i0 + 1u < cx ? 1u : 0u); }
                        if (hsum32(c) < needt) Xl = cx;
                    }
                    if (!exact) X = Xl;
                }
            }
            LAS3 unsigned* mrow = MASK + (16 * qg + oq) * 65 + (pos >> 4);
            const unsigned sh = 32u * hh + (pos & 16);
#pragma unroll 2
            for (int k = 0; k <= j; ++k) {
                const u32x2 kk = *(const LAS3 u32x2*)(orow + 64 * k); const unsigned i0 = 2u * (unsigned)(pos + 32 * k);
                const bool s0 = i0 < nkeys && (kk.x > Tfull || (kk.x == Tfull && i0 <= X)), s1 = i0 < nkeys && (kk.y > Tfull || (kk.y == Tfull && i0 + 1u <= X));
                const unsigned long long blo = __ballot(s0), bhi = __ballot(s1);
                const unsigned wv = ((unsigned)(blo >> sh) & 0xffffu) | ((unsigned)(bhi >> sh) << 16);
                if ((pos & 15) == 0) mrow[2 * k] = wv;
            }
        }
        TEND(33);
        __syncthreads();
#ifdef CHECK_SEL
        if (selecting) {
            const int lbase = 16 * w + 4 * fq;
            unsigned key[16][4];
#pragma unroll
            for (int n = 0; n < 16; ++n)
#pragma unroll
                for (int r = 0; r < 4; ++r) key[n][r] = (n < nloc) ? PKT[fr * PKT_LD + lbase + 128 * n + r] : 0u;
            unsigned T2; int X2; select_bitwise(key, lbase, CNT, it, fr, lane, T2, X2);
            bool bad = false;
#pragma unroll
            for (int n = 0; n < 16; ++n) if (n < nloc) { const int x2 = X2 - 128 * n;
#pragma unroll
                for (int r = 0; r < 4; ++r) { const unsigned idx = (unsigned)(lbase + 128 * n + r); const unsigned mw = MASK[(16 * qg + fr) * 65 + (idx >> 5)];
                    const bool s2 = key[n][r] > T2 || (key[n][r] == T2 && r <= x2); bad |= (s2 != (((mw >> (((idx & 31u) >> 1) + 16u * (idx & 1u))) & 1u) != 0u)); } }
            if (__any(bad) && lane == 0) atomicAdd((unsigned*)(ws + CW_CHK), 1u);
            if (lane == 0 && w == 0) atomicAdd((unsigned*)(ws + CW_CHK + 4), 1u);
            __syncthreads();
        }
#endif
    }
    TEND(30); TBEG(31);
    {
        const int h = w & 3, hf = w >> 2, fr = lane0 & 15, fq = lane0 >> 4;
        const size_t qrow0 = (size_t)b * SEQ + q0 + 32 * hf;
        f32x4 o[4][2]; float linv[2];
        attn32<true>((const bf16_t*)(ws + W_DQ) + qrow0 * 256 + h * 64, 256, (const bf16_t*)(ws + W_DK) + (size_t)b * SEQ * 256 + h * 64, 256,
                     (const bf16_t*)(ws + W_DVT) + ((size_t)b * 64 * 4 + h) * 2048, 4 * 2048, 2 * j + 2  , MASK + 32 * hf * 65, fr, fq, o, linv);
        attn_store(o, linv, (const bf16_t*)(ws + W_DG) + qrow0 * 256 + h * 64, (bf16_t*)(ws + W_MIX) + qrow0 * 1024 + 512 + h * 64, fr, fq);
    }
    __syncthreads();
    TEND(31);
}
DI void mem_unit(const Params& p, int n) {
    const int tid = threadIdx.x, lane = tid & 63, w = __builtin_amdgcn_readfirstlane(tid >> 6), fr = lane & 15, fq = lane >> 4;
    unsigned char* ws = p.ws;
    const int h = w & 3, hf = w >> 2;
    const size_t qrow0 = (size_t)n * 64 + 32 * hf; const int b = n >> 5;
    f32x4 o[4][2]; float linv[2];
    attn32<false>((const bf16_t*)(ws + W_MQ) + qrow0 * 256 + h * 64, 256, (const bf16_t*)(ws + W_MK) + (size_t)b * NMEM * 256 + h * 64, 256,
                  (const bf16_t*)(ws + W_MVT) + ((size_t)b * 8 * 4 + h) * 2048, 4 * 2048, 8, nullptr, fr, fq, o, linv);
    attn_store(o, linv, (const bf16_t*)(ws + W_MG) + qrow0 * 256 + h * 64, (bf16_t*)(ws + W_MIX) + qrow0 * 1024 + 768 + h * 64, fr, fq);
}
constexpr int GL_QT = 0, GL_KT = 9216, GL_KPT = 18432, GL_VT = 27648, GL_SBT = 46080, GL_PM = 64512, GL_OF = 73728, GL_GTOT = 107520, GL_W2 = 109568, GL_BG = 113664, GL_DEC = 113920;
constexpr int LDP = 72;
DI void gla_unit(const Params& p, LAS3 unsigned char* lds, int b, int h) {
    const int tid = threadIdx.x, lane = tid & 63, w = __builtin_amdgcn_readfirstlane(tid >> 6), fr = lane & 15, fq = lane >> 4;
    unsigned char* ws = p.ws;
    LAS3 bf16_t* Qt = (LAS3 bf16_t*)(lds + GL_QT); LAS3 bf16_t* Kt = (LAS3 bf16_t*)(lds + GL_KT); LAS3 bf16_t* KpT = (LAS3 bf16_t*)(lds + GL_KPT);
    LAS3 bf16_t* Vt = (LAS3 bf16_t*)(lds + GL_VT); LAS3 bf16_t* SbT = (LAS3 bf16_t*)(lds + GL_SBT); LAS3 bf16_t* Pm = (LAS3 bf16_t*)(lds + GL_PM);
    LAS3 float* Of = (LAS3 float*)(lds + GL_OF); LAS3 float* gtot = (LAS3 float*)(lds + GL_GTOT); LAS3 float* w2s = (LAS3 float*)(lds + GL_W2);
    LAS3 float* bgs = (LAS3 float*)(lds + GL_BG); LAS3 float* dec = (LAS3 float*)(lds + GL_DEC);
    const bf16_t* GQ = (const bf16_t*)(ws + W_GQ); const bf16_t* GK = (const bf16_t*)(ws + W_GK); const bf16_t* GV = (const bf16_t*)(ws + W_GV);
    const bf16_t* GG = (const bf16_t*)(ws + W_GG); const float* GLR = (const float*)(ws + W_GLR); bf16_t* MIX = (bf16_t*)(ws + W_MIX);
    for (int i = tid; i < 128 * LDP / 2; i += NTHREADS) ((LAS3 unsigned*)SbT)[i] = 0u;
    for (int i = tid; i < 16 * 64; i += NTHREADS) w2s[i] = p.w_g2[(i >> 6) * 256 + h * 64 + (i & 63)];
    if (tid < 64) bgs[tid] = p.b_g[h * 64 + tid];
    __syncthreads();
    const int d = tid & 63, tg = w;
    float wreg[16];
#pragma unroll
    for (int r = 0; r < 16; ++r) wreg[r] = w2s[r * 64 + d];
    const float bgd = bgs[d];
    const f32x4 zero = {0.f, 0.f, 0.f, 0.f};
    f32x4 Sacc[4] = {zero, zero, zero, zero};
    const int tt = w & 3, vh = w >> 2;
    for (int c = 0; c < 32; ++c) {
        const size_t rb = (size_t)b * SEQ + c * 64;
        float g8[8];
#pragma unroll
        for (int i = 0; i < 8; ++i) {
            const float* gl = vaddr(GLR + (rb + tg * 8 + i) * 16);
            float u = bgd;
#pragma unroll
            for (int r = 0; r < 16; ++r) u += gl[r] * wreg[r];
            const float g = logsigf(u) * (1.f / 16.f);
            g8[i] = (i ? g8[i - 1] : 0.f) + g;
        }
        gtot[tg * 64 + d] = g8[7];
        __syncthreads();
        float off = 0.f, blast = 0.f;
#pragma unroll
        for (int g2 = 0; g2 < 8; ++g2) { const float v = gtot[g2 * 64 + d]; off += (g2 < tg) ? v : 0.f; blast += v; }
        float kp[8];
#pragma unroll
        for (int i = 0; i < 8; ++i) {
            const int t = tg * 8 + i; const float bt = off + g8[i];
            const float q = bf2f(GQ[(rb + t) * 256 + h * 64 + d]), k = bf2f(GK[(rb + t) * 256 + h * 64 + d]);
            Qt[t * LDP + d] = f2bf(q * fexp(bt)); Kt[t * LDP + d] = f2bf(k * fexp(-bt)); kp[i] = k * fexp(blast - bt);
        }
        { u32x4 kw; kw.x = cvtpk(kp[0], kp[1]); kw.y = cvtpk(kp[2], kp[3]); kw.z = cvtpk(kp[4], kp[5]); kw.w = cvtpk(kp[6], kp[7]); *(LAS3 u32x4*)(KpT + d * LDP + tg * 8) = kw; }
        if (tg == 0) dec[d] = fexp(blast);
        { const int v = tid & 127, sg = tid >> 7; bf16_t vv[16];
#pragma unroll
          for (int i = 0; i < 16; ++i) vv[i] = GV[(rb + sg * 16 + i) * 512 + h * 128 + v];
          u32x4 a, bb; a.x = vv[0] | ((unsigned)vv[1] << 16); a.y = vv[2] | ((unsigned)vv[3] << 16); a.z = vv[4] | ((unsigned)vv[5] << 16); a.w = vv[6] | ((unsigned)vv[7] << 16);
          bb.x = vv[8] | ((unsigned)vv[9] << 16); bb.y = vv[10] | ((unsigned)vv[11] << 16); bb.z = vv[12] | ((unsigned)vv[13] << 16); bb.w = vv[14] | ((unsigned)vv[15] << 16);
          *(LAS3 u32x4*)(Vt + v * LDP + sg * 16) = a; *(LAS3 u32x4*)(Vt + v * LDP + sg * 16 + 8) = bb; }
        __syncthreads();
#pragma unroll
        for (int s2 = 0; s2 < 2; ++s2) {
            const int st = 2 * vh + s2;
            f32x4 acc = zero;
#pragma unroll
            for (int ks = 0; ks < 2; ++ks) {
                const bf16x8 a = *(const LAS3 bf16x8*)(Kt + (st * 16 + fr) * LDP + ks * 32 + fq * 8), bq = *(const LAS3 bf16x8*)(Qt + (tt * 16 + fr) * LDP + ks * 32 + fq * 8);
                acc = mfma16(a, bq, acc);
            }
            const int t = tt * 16 + fr, s0 = st * 16 + 4 * fq;
            u32x2 pw; pw.x = cvtpk(s0 <= t ? acc[0] : 0.f, s0 + 1 <= t ? acc[1] : 0.f); pw.y = cvtpk(s0 + 2 <= t ? acc[2] : 0.f, s0 + 3 <= t ? acc[3] : 0.f);
            *(LAS3 u32x2*)(Pm + t * LDP + s0) = pw;
        }
        __syncthreads();
        f32x4 oacc[4];
        {
            bf16x8 aq[2], ap[2], ak[2];
#pragma unroll
            for (int ks = 0; ks < 2; ++ks) {
                aq[ks] = *(const LAS3 bf16x8*)(Qt + (tt * 16 + fr) * LDP + ks * 32 + fq * 8);
                ap[ks] = *(const LAS3 bf16x8*)(Pm + (tt * 16 + fr) * LDP + ks * 32 + fq * 8);
                ak[ks] = *(const LAS3 bf16x8*)(KpT + (tt * 16 + fr) * LDP + ks * 32 + fq * 8);
            }
            const f32x4 dv = *(const LAS3 f32x4*)(dec + tt * 16 + 4 * fq);
#pragma unroll
            for (int jv = 0; jv < 4; ++jv) {
                const int vt = vh * 4 + jv;
                bf16x8 bs[2], bv[2];
#pragma unroll
                for (int ks = 0; ks < 2; ++ks) {
                    bs[ks] = *(const LAS3 bf16x8*)(SbT + (vt * 16 + fr) * LDP + ks * 32 + fq * 8);
                    bv[ks] = *(const LAS3 bf16x8*)(Vt + (vt * 16 + fr) * LDP + ks * 32 + fq * 8);
                }
                f32x4 oa = mfma16(aq[0], bs[0], zero); oa = mfma16(aq[1], bs[1], oa); oa = mfma16(ap[0], bv[0], oa); oa = mfma16(ap[1], bv[1], oa);
                oacc[jv] = oa;
                f32x4 sa = Sacc[jv] * dv; sa = mfma16(ak[0], bv[0], sa); sa = mfma16(ak[1], bv[1], sa);
                Sacc[jv] = sa;
            }
        }
        __syncthreads();
#pragma unroll
        for (int jv = 0; jv < 4; ++jv) {
            const int vt = vh * 4 + jv;
#pragma unroll
            for (int r = 0; r < 4; ++r) Of[(tt * 16 + 4 * fq + r) * 132 + vt * 16 + fr] = oacc[jv][r];
            u32x2 sw; sw.x = cvtpk(Sacc[jv][0], Sacc[jv][1]); sw.y = cvtpk(Sacc[jv][2], Sacc[jv][3]);
            *(LAS3 u32x2*)(SbT + (vt * 16 + fr) * LDP + tt * 16 + 4 * fq) = sw;
        }
        __syncthreads();
        {
            const int t = tid >> 3, seg = tid & 7;
            const LAS3 float* op = Of + t * 132 + seg * 16;
            f32x4 ov[4]; float ss = 0.f;
#pragma unroll
            for (int i = 0; i < 4; ++i) { ov[i] = *(const LAS3 f32x4*)(op + 4 * i); ss += ov[i][0] * ov[i][0] + ov[i][1] * ov[i][1] + ov[i][2] * ov[i][2] + ov[i][3] * ov[i][3]; }
            ss += __shfl_xor(ss, 1); ss += __shfl_xor(ss, 2); ss += __shfl_xor(ss, 4);
            const float rstd = rsqrtf(ss * (1.f / 128.f) + 1e-6f);
            const bf16_t* gp = GG + (rb + t) * 512 + h * 128 + seg * 16;
            const u32x4 g0 = *(const u32x4*)gp, g1 = *(const u32x4*)(gp + 8);
            const unsigned gw[8] = {g0.x, g0.y, g0.z, g0.w, g1.x, g1.y, g1.z, g1.w};
            unsigned ow[8];
#pragma unroll
            for (int i = 0; i < 4; ++i) {
                const f32x4 on = *(const f32x4*)(p.onorm + seg * 16 + 4 * i);
                const float y0 = ov[i][0] * rstd * on[0] * __uint_as_float(gw[2 * i] << 16), y1 = ov[i][1] * rstd * on[1] * __uint_as_float(gw[2 * i] & 0xffff0000u);
                const float y2 = ov[i][2] * rstd * on[2] * __uint_as_float(gw[2 * i + 1] << 16), y3 = ov[i][3] * rstd * on[3] * __uint_as_float(gw[2 * i + 1] & 0xffff0000u);
                ow[2 * i] = cvtpk(y0, y1); ow[2 * i + 1] = cvtpk(y2, y3);
            }
            bf16_t* mp = MIX + (rb + t) * 1024 + h * 128 + seg * 16;
            *(u32x4*)mp = (u32x4){ow[0], ow[1], ow[2], ow[3]}; *(u32x4*)(mp + 8) = (u32x4){ow[4], ow[5], ow[6], ow[7]};
        }
    }
#pragma unroll
    for (int jv = 0; jv < 4; ++jv)
#pragma unroll
        for (int r = 0; r < 4; ++r) p.out[O_GSP + ((size_t)(b * 4 + h) * 64 + tt * 16 + 4 * fq + r) * 128 + (vh * 4 + jv) * 16 + fr] = Sacc[jv][r];
    __syncthreads();
}

DI void sscore_unit(const Params& p, LAS3 unsigned char* lds, int u) {
    const int tid = threadIdx.x;
    unsigned char* ws = p.ws;
    const int b = u >> 3, pg = u & 7;
    LAS3 float* qf = (LAS3 float*)lds;
    if (tid < 256) qf[tid] = bf2f(((const bf16_t*)(ws + W_IQ))[(size_t)(MP + b) * 256 + tid]);
    __syncthreads();
    const int seg = tid & 15;
    f32x4 q[4];
#pragma unroll
    for (int h = 0; h < 4; ++h) q[h] = *(const LAS3 f32x4*)(qf + h * 64 + seg * 4);
    const f32x4 wv = *(const f32x4*)vaddr((const float*)(ws + W_IW) + (size_t)(MP + b) * 4);
    unsigned* sc = (unsigned*)(ws + W_SC) + (size_t)b * SCLD;
    const int* pt = p.page_table + b * NPAGES + pg * 16;
#define SS_LOAD(BUF, pp) do { const float* base_ = p.cache_ik + (size_t)pt[(pp) < 16 ? (pp) : 15] * 8192; \
        _Pragma("unroll") for (int i = 0; i < 4; ++i) BUF[i] = *(const f32x4*)(base_ + (size_t)(tid + 512 * i) * 4); } while (0)
#define SS_COMPUTE(BUF, pp) do { \
        _Pragma("unroll") for (int i = 0; i < 4; ++i) { const f32x4 kv = BUF[i]; float dh[4]; \
            _Pragma("unroll") for (int h = 0; h < 4; ++h) { float x = q[h][0] * kv[0] + q[h][1] * kv[1] + q[h][2] * kv[2] + q[h][3] * kv[3]; \
                x += __shfl_xor(x, 1); x += __shfl_xor(x, 2); x += __shfl_xor(x, 4); x += __shfl_xor(x, 8); dh[h] = x; } \
            const float s_ = wv[0] * fmaxf(dh[0], 0.f) + wv[1] * fmaxf(dh[1], 0.f) + wv[2] * fmaxf(dh[2], 0.f) + wv[3] * fmaxf(dh[3], 0.f); \
            if (seg == 0) __hip_atomic_store(sc + (pg * 16 + (pp)) * 128 + ((tid + 512 * i) >> 4), __float_as_uint(s_), __ATOMIC_RELAXED, __HIP_MEMORY_SCOPE_AGENT); } } while (0)
    f32x4 pa[4], pb[4];
    SS_LOAD(pa, 0); SS_LOAD(pb, 1);
#pragma unroll 1
    for (int pp = 0; pp < 16; pp += 2) {
        SS_COMPUTE(pa, pp); SS_LOAD(pa, pp + 2);
        SS_COMPUTE(pb, pp + 1); SS_LOAD(pb, pp + 3);
    }
#undef SS_LOAD
#undef SS_COMPUTE
    asm volatile("s_waitcnt vmcnt(0)" ::: "memory");
    __syncthreads();
    if (tid == 0) __hip_atomic_fetch_add((unsigned*)(ws + CW_SCNT), 1u, __ATOMIC_RELAXED, __HIP_MEMORY_SCOPE_AGENT);
}

constexpr int SA_Q = 2048, SA_S = 3072, SA_KP = 8192, SA_VP = 10240;
DI void sattend(const Params& p, LAS3 unsigned char* lds, const bf16_t* qrow  , const bf16_t* gate, bf16_t* mix) {
    const int tid = threadIdx.x, lane = tid & 63, w = tid >> 6;
    LAS3 float* qf = (LAS3 float*)(lds + SA_Q); LAS3 float* S = (LAS3 float*)(lds + SA_S);
    const float* const LAS3* kptr = (const float* const LAS3*)(lds + SA_KP); const float* const LAS3* vptr = (const float* const LAS3*)(lds + SA_VP);
    if (tid < 256) qf[tid] = bf2f(qrow[tid]);
    __syncthreads();
    {
        const int jk = tid >> 1, hp = tid & 1;
        const float* kr = kptr[jk] + hp * 128;
        float s0 = 0.f, s1 = 0.f;
#pragma unroll 4
        for (int i = 0; i < 16; ++i) {
            const f32x4 k0 = *(const f32x4*)(kr + 4 * i), k1 = *(const f32x4*)(kr + 64 + 4 * i);
            const f32x4 q0 = *(const LAS3 f32x4*)(qf + hp * 128 + 4 * i), q1 = *(const LAS3 f32x4*)(qf + hp * 128 + 64 + 4 * i);
            s0 += q0[0] * k0[0] + q0[1] * k0[1] + q0[2] * k0[2] + q0[3] * k0[3];
            s1 += q1[0] * k1[0] + q1[1] * k1[1] + q1[2] * k1[2] + q1[3] * k1[3];
        }
        S[(2 * hp) * 256 + jk] = s0; S[(2 * hp + 1) * 256 + jk] = s1;
    }
    __syncthreads();
    if (w < 4) {
        float v[4], mx = NEG_INF;
#pragma unroll
        for (int i = 0; i < 4; ++i) { v[i] = S[w * 256 + lane + 64 * i]; mx = fmaxf(mx, v[i]); }
        mx = wmax64(mx);
        float sum = 0.f;
#pragma unroll
        for (int i = 0; i < 4; ++i) { v[i] = __expf(v[i] - mx); sum += v[i]; }
        sum = wsum64(sum);
        const float inv = 1.f / sum;
#pragma unroll
        for (int i = 0; i < 4; ++i) S[w * 256 + lane + 64 * i] = v[i] * inv;
    }
    __syncthreads();
    {
        const int h = tid >> 7, dd = (tid >> 1) & 63, hf = tid & 1;
        float acc = 0.f;
#pragma unroll 4
        for (int jk = hf * 128; jk < hf * 128 + 128; ++jk) acc += S[h * 256 + jk] * vptr[jk][h * 64 + dd];
        acc += __shfl_xor(acc, 1);
        if (hf == 0) mix[h * 64 + dd] = f2bf(acc * bf2f(gate[h * 64 + dd]));
    }
    __syncthreads();
}
DI void smem_unit(const Params& p, LAS3 unsigned char* lds, int b) {
    const int tid = threadIdx.x; unsigned char* ws = p.ws;
    const float* LAS3* kptr = (const float* LAS3*)(lds + SA_KP); const float* LAS3* vptr = (const float* LAS3*)(lds + SA_VP);
    if (tid < 256) { kptr[tid] = p.cache_mem_k + ((size_t)b * NMEM + tid) * 256; vptr[tid] = p.cache_mem_v + ((size_t)b * NMEM + tid) * 256; }
    const size_t row = MP + b;
    sattend(p, lds, (const bf16_t*)(ws + W_MQ) + row * 256, (const bf16_t*)(ws + W_MG) + row * 256, (bf16_t*)(ws + W_MIX) + row * 1024 + 768);
}
DI void ssel_unit(const Params& p, LAS3 unsigned char* lds, int b) {
    const int tid = threadIdx.x, lane = tid & 63, w = tid >> 6; unsigned char* ws = p.ws;
    LAS3 unsigned* CNT = (LAS3 unsigned*)lds;
    LAS3 unsigned* wsum = (LAS3 unsigned*)(lds + 256);
    LAS3 float* newsc = (LAS3 float*)(lds + 320);
    LAS3 int* list = (LAS3 int*)(lds + 512);
    const float* LAS3* kptr = (const float* LAS3*)(lds + SA_KP); const float* LAS3* vptr = (const float* LAS3*)(lds + SA_VP);
    if (tid < 48) CNT[tid] = 0u;
    if (tid == 0) {
        unsigned* cnt = (unsigned*)(ws + CW_SCNT); unsigned* tmo = (unsigned*)(ws + CW_TMO); unsigned sp = 0;
        while (__hip_atomic_load(cnt, __ATOMIC_RELAXED, __HIP_MEMORY_SCOPE_AGENT) < 256u) {
            __builtin_amdgcn_s_sleep(2);
            if ((++sp & 255u) == 0u) { if (__hip_atomic_load(tmo, __ATOMIC_RELAXED, __HIP_MEMORY_SCOPE_AGENT)) break; if (sp > (1u << 20)) { __hip_atomic_store(tmo, 1u, __ATOMIC_RELAXED, __HIP_MEMORY_SCOPE_AGENT); break; } }
        }
        __builtin_amdgcn_fence(__ATOMIC_ACQUIRE, "agent");
        asm volatile("s_waitcnt vmcnt(0)" ::: "memory");
    }
    if (w == 1) {
        const bf16_t* iq = (const bf16_t*)(ws + W_IQ) + (size_t)(MP + b) * 256; const float kd = bf2f(((const bf16_t*)(ws + W_IK))[(size_t)(MP + b) * 64 + lane]);
        const f32x4 wv = *(const f32x4*)vaddr((const float*)(ws + W_IW) + (size_t)(MP + b) * 4);
        float s = 0.f;
#pragma unroll
        for (int h = 0; h < 4; ++h) { const float dh = wsum64(bf2f(iq[h * 64 + lane]) * kd); s += wv[h] * fmaxf(dh, 0.f); }
        if (lane == 0) *newsc = s;
    }
    __syncthreads();
    const float* sc = (const float*)(ws + W_SC) + (size_t)b * SCLD;
    unsigned key[33];
#pragma unroll
    for (int n = 0; n < 32; ++n) key[n] = fkey(sc[tid + 512 * n]);
    key[32] = (tid == 0) ? fkey(*newsc) : 0u;
    int it = 0;
    unsigned T = 0u, X = 0x7fffffffu; bool fin = false;
    for (int bit = 31; bit >= 0; --bit) {
        const unsigned cand = T | (1u << bit);
        unsigned c = 0;
#pragma unroll
        for (int n = 0; n < 33; ++n) cnt_ge(c, key[n], cand);
        const unsigned tot = blk_count(c, CNT, it, lane);
        if (tot >= 256u) { T = cand; fin = (tot == 256u); }
        if (fin) break;
    }
    if (!fin) {
        unsigned c = 0;
#pragma unroll
        for (int n = 0; n < 33; ++n) cnt_gt(c, key[n], T);
        const unsigned need = 256u - blk_count(c, CNT, it, lane);
        unsigned Xl = 0u;
        for (int bit = 14; bit >= 0; --bit) {
            const unsigned cand = Xl | (1u << bit);
            c = 0;
#pragma unroll
            for (int n = 0; n < 33; ++n) cnt_eq_lt(c, key[n], T, (unsigned)(tid + 512 * n), cand);
            if (blk_count(c, CNT, it, lane) < need) Xl = cand;
        }
        X = Xl;
    }
    unsigned selm = 0, hi = 0;
#pragma unroll
    for (int n = 0; n < 32; ++n) selm |= (key[n] > T || (key[n] == T && (unsigned)(tid + 512 * n) <= X)) ? (1u << n) : 0u;
    hi = (key[32] > T || (key[32] == T && (unsigned)(tid + 16384) <= X)) ? 1u : 0u;
    const unsigned cs = __popc(selm) + hi;
    unsigned inc = cs;
#pragma unroll
    for (int o2 = 1; o2 < 64; o2 <<= 1) { const unsigned t2 = __shfl_up(inc, o2); if (lane >= o2) inc += t2; }
    if (lane == 63) wsum[w] = inc;
    __syncthreads();
    unsigned pos = inc - cs;
    for (int w2 = 0; w2 < w; ++w2) pos += wsum[w2];
#pragma unroll
    for (int n = 0; n < 32; ++n) if ((selm >> n) & 1u) { if (pos < 256u) list[pos] = tid + 512 * n; ++pos; }
    if (hi) { if (pos < 256u) list[pos] = tid + 16384; ++pos; }
    __syncthreads();
    if (tid < 256) {
        const int idx = list[tid];
        if (idx < 16384) { const size_t phys = (size_t)p.page_table[b * NPAGES + (idx >> 7)] * 128 + (idx & 127); kptr[tid] = p.cache_k + phys * 256; vptr[tid] = p.cache_v + phys * 256; }
        else { kptr[tid] = p.out + O_KS + (size_t)b * 256; vptr[tid] = p.out + O_VS + (size_t)b * 256; }
    }
    const size_t row = MP + b;
    sattend(p, lds, (const bf16_t*)(ws + W_DQ) + row * 256, (const bf16_t*)(ws + W_DG) + row * 256, (bf16_t*)(ws + W_MIX) + row * 1024 + 512);
}
DI void sgla_unit(const Params& p, LAS3 unsigned char* lds, int b) {
    const int tid = threadIdx.x, lane = tid & 63, w = tid >> 6; unsigned char* ws = p.ws;
    LAS3 float* qs = (LAS3 float*)lds; LAS3 float* ks = qs + 256; LAS3 float* gs = qs + 512; LAS3 float* vs = qs + 768; LAS3 float* part = qs + 1280;
    const size_t row = MP + b;
    if (tid < 256) {
        float u = p.b_g[tid];
        const float* gl = vaddr((const float*)(ws + W_GLR) + row * 16);
#pragma unroll
        for (int r = 0; r < 16; ++r) u += gl[r] * p.w_g2[r * 256 + tid];
        gs[tid] = expf(logsigf(u) * (1.f / 16.f));
        qs[tid] = bf2f(((const bf16_t*)(ws + W_GQ))[row * 256 + tid]); ks[tid] = bf2f(((const bf16_t*)(ws + W_GK))[row * 256 + tid]);
    }
    vs[tid] = bf2f(((const bf16_t*)(ws + W_GV))[row * 512 + tid]);
    __syncthreads();
    const int h = tid >> 7, v = tid & 127;
    const float* sp = p.state_gla + ((size_t)(b * 4 + h) * 64) * 128 + v; float* so = p.out + O_GSS + ((size_t)(b * 4 + h) * 64) * 128 + v;
    const float vv = vs[h * 128 + v];
    float o = 0.f;
#pragma unroll 8
    for (int dd = 0; dd < 64; ++dd) { const float sn = gs[h * 64 + dd] * sp[dd * 128] + ks[h * 64 + dd] * vv; so[dd * 128] = sn; o += qs[h * 64 + dd] * sn; }
    const float ss = wsum64(o * o);
    if (lane == 0) part[w] = ss;
    __syncthreads();
    const float rstd = rsqrtf((part[2 * h] + part[2 * h + 1]) * (1.f / 128.f) + 1e-6f);
    ((bf16_t*)(ws + W_MIX))[row * 1024 + h * 128 + v] = f2bf(o * rstd * p.onorm[v] * bf2f(((const bf16_t*)(ws + W_GG))[row * 512 + h * 128 + v]));
    __syncthreads();
}
DI void p4_final(const Params& p) {
    const int tid = threadIdx.x, lane = tid & 63, wv = tid >> 6;
    for (int r = blockIdx.x * 8 + wv; r < MP + NDB; r += gridDim.x * 8) {
        float* y = p.out + (r < MP ? O_YP + (size_t)r * DM : O_YS + (size_t)(r - MP) * DM);
        f32x4 v[4]; float ss = 0.f;
#pragma unroll
        for (int i = 0; i < 4; ++i) { v[i] = *(const f32x4*)(y + i * 256 + lane * 4); ss += v[i][0] * v[i][0] + v[i][1] * v[i][1] + v[i][2] * v[i][2] + v[i][3] * v[i][3]; }
        ss = wsum64(ss);
        const float rstd = rsqrtf(ss * (1.f / DM) + 1e-6f);
#pragma unroll
        for (int i = 0; i < 4; ++i) { const f32x4 gv = *(const f32x4*)(p.norm_final + i * 256 + lane * 4); *(f32x4*)(y + i * 256 + lane * 4) = v[i] * rstd * gv; }
    }
}

DI int next_unit(unsigned* ctr, volatile LAS3 unsigned* slot) {
    if (threadIdx.x == 0) *slot = __hip_atomic_fetch_add(ctr, 1u, __ATOMIC_RELAXED, __HIP_MEMORY_SCOPE_AGENT);
    __syncthreads();
    const int v = __builtin_amdgcn_readfirstlane((int)*slot);
    __syncthreads();
    return v;
}

#ifndef REP1
#define REP1 1
#endif
#ifndef REP2
#define REP2 1
#endif
#ifndef REP3
#define REP3 1
#endif
#ifndef REP2A
#define REP2A 1
#endif
#ifndef REP2B
#define REP2B 1
#endif
#ifndef REP2C
#define REP2C 1
#endif
#ifndef REP2D
#define REP2D 1
#endif
#ifndef REP2E
#define REP2E 1
#endif
DI void sample_inproj(const Params& p, LAS3 unsigned char* lds) {
    const int tid = threadIdx.x, lane = tid & 63, wv = tid >> 6, fr = lane & 15, fq = lane >> 4;
    unsigned char* ws = p.ws;
    LAS3 float* red = (LAS3 float*)lds;
    for (int pr = blockIdx.x; pr < 112; pr += gridDim.x) {
        const int col0 = pr * 32, pn = col0 >> 8, vc0 = col0 & 255;
        const bf16_t* A = (const bf16_t*)(ws + W_XN) + (size_t)MP * 1024 + (size_t)fr * 1024 + fq * 8 + wv * 128;
        const bf16_t* B = (const bf16_t*)(ws + W_WTIN) + (size_t)(col0 + fr) * 1024 + fq * 8 + wv * 128;
        const f32x4 zero = {0.f, 0.f, 0.f, 0.f};
        f32x4 acc[2][2] = {{zero, zero}, {zero, zero}};
#pragma unroll
        for (int ks = 0; ks < 4; ++ks) {
            const bf16x8 a0 = *(const bf16x8*)(A + ks * 32), a1 = *(const bf16x8*)(A + 16 * 1024 + ks * 32);
            const bf16x8 b0 = *(const bf16x8*)(B + ks * 32), b1 = *(const bf16x8*)(B + 16 * 1024 + ks * 32);
            acc[0][0] = mfma16(a0, b0, acc[0][0]); acc[0][1] = mfma16(a0, b1, acc[0][1]); acc[1][0] = mfma16(a1, b0, acc[1][0]); acc[1][1] = mfma16(a1, b1, acc[1][1]);
        }
#pragma unroll
        for (int rt = 0; rt < 2; ++rt)
#pragma unroll
            for (int ct = 0; ct < 2; ++ct)
#pragma unroll
                for (int r = 0; r < 4; ++r) red[(wv * 16 + (rt * 2 + ct) * 4 + r) * 64 + lane] = acc[rt][ct][r];
        __syncthreads();
        {
            const int rt = wv >> 2, r = wv & 3;
            float v0 = 0.f, v1 = 0.f;
#pragma unroll
            for (int w2 = 0; w2 < 8; ++w2) { v0 += red[(w2 * 16 + (rt * 2 + 0) * 4 + r) * 64 + lane]; v1 += red[(w2 * 16 + (rt * 2 + 1) * 4 + r) * 64 + lane]; }
            const float* rope = (const float*)(ws + W_ROPE) + (size_t)2048 * 64;
            {
                const int bs = 16 * rt + 4 * fq + r; const size_t R = (size_t)MP + bs;
                if (pn <= 5 || (pn >= 10 && pn <= 12)) {
                    bf16_t* dst; int ldc = 256, coff = 0; float sc = 1.f; bool silu = false;
                    switch (pn) {
                        case 0: dst = (bf16_t*)(ws + W_GQ); sc = 0.125f; break;
                        case 1: dst = (bf16_t*)(ws + W_GK); break;
                        case 2: dst = (bf16_t*)(ws + W_GV); ldc = 512; break;
                        case 3: dst = (bf16_t*)(ws + W_GV); ldc = 512; coff = 256; break;
                        case 4: dst = (bf16_t*)(ws + W_GG); ldc = 512; silu = true; break;
                        case 5: dst = (bf16_t*)(ws + W_GG); ldc = 512; coff = 256; silu = true; break;
                        case 10: dst = (bf16_t*)(ws + W_DG); silu = true; break;
                        case 11: dst = (bf16_t*)(ws + W_MQ); sc = 0.125f; break;
                        default: dst = (bf16_t*)(ws + W_MG); silu = true; break;
                    }
                    bf16_t* rp = dst + R * ldc + coff + vc0 + 8 * (fr >> 2) + (fr & 3);
                    rp[0] = f2bf(silu ? siluf(v0) : v0 * sc); rp[4] = f2bf(silu ? siluf(v1) : v1 * sc);
                } else if (pn == 6 || pn == 7 || pn == 9 || (pn == 13 && vc0 < 64)) {
                    const int hh = (pn == 13) ? 0 : ((vc0 >> 5) & 3);
                    const int f = (pn == 13) ? 16 * ((vc0 >> 5) & 1) + fr : 8 * (fr >> 2) + 4 * (vc0 >> 7) + (fr & 3);
                    const float c = rope[2 * f], s = rope[2 * f + 1], sc = (pn == 6) ? 0.125f : 1.f;
                    const float o1 = (v0 * c - v1 * s) * sc, o2 = (v1 * c + v0 * s) * sc;
                    if (pn == 13) {
                        bf16_t* ikb = (bf16_t*)(ws + W_IK) + R * 64; ikb[f] = f2bf(o1); ikb[f + 32] = f2bf(o2);
                        float* op = p.out + O_IKS + (size_t)bs * 64; op[f] = o1; op[f + 32] = o2;
                    } else {
                        bf16_t* dst = (bf16_t*)(ws + (pn == 6 ? W_DQ : (pn == 7 ? W_DK : W_IQ))) + R * 256 + 64 * hh;
                        dst[f] = f2bf(o1); dst[f + 32] = f2bf(o2);
                        if (pn == 7) { float* op = p.out + O_KS + (size_t)bs * 256 + 64 * hh; op[f] = o1; op[f + 32] = o2; }
                    }
                } else if (pn == 8) {
                    float* op = p.out + O_VS + (size_t)bs * 256 + vc0 + 8 * (fr >> 2) + (fr & 3); op[0] = v0; op[4] = v1;
                } else if (pn == 13 && vc0 == 64) {
                    if (fr < 4) { ((float*)(ws + W_IW))[R * 4 + fr] = v0 * 0.5f; ((float*)(ws + W_GLR))[R * 16 + 12 + fr] = v1; }
                    else ((float*)(ws + W_GLR))[R * 16 + fr - 4] = v0;
                }
            }
        }
        __syncthreads();
    }
}
DI void phase1(const Params& p, LAS3 unsigned char* lds) {
    unsigned char* ws = p.ws;
    { pg8::Gemm g{(const bf16_t*)(ws + W_XN), (const bf16_t*)(ws + W_WTIN), MP, NIN, DM}; pg8::StaticOrder S; S.init(MP, NIN, (int)gridDim.x, (int)blockIdx.x);
      EpiIn E{ws, p.out}; pg8::gemm_phase<EpiIn, pg8::StaticOrder, true, true>(lds, g, S, E); }
    sample_inproj(p, lds);
}
DI void p2_memgemm(const Params& p, LAS3 unsigned char* lds) {
    const int u = (int)gridDim.x - 1 - (int)blockIdx.x;
    if (u >= 96 && u < 128) {
        pg8::Gemm g{(const bf16_t*)(p.ws + W_MEMN), (const bf16_t*)(p.ws + W_WTMEM), MMEM, 512, DM}; pg8::StaticOrder S; S.init(MMEM, 512, (int)gridDim.x, u - 96);
        EpiMem E{p.ws, p.out}; pg8::gemm_phase<EpiMem, pg8::StaticOrder, true, true>(lds, g, S, E);
        asm volatile("s_waitcnt vmcnt(0)" ::: "memory");
        __syncthreads();
        if (threadIdx.x == 0) {
            __builtin_amdgcn_fence(__ATOMIC_RELEASE, "agent");
            asm volatile("s_waitcnt vmcnt(0)" ::: "memory");
            __hip_atomic_fetch_add((unsigned*)(p.ws + CW_MEMC), 1u, __ATOMIC_RELAXED, __HIP_MEMORY_SCOPE_AGENT);
        }
    }
}
DI void wait_memgemm(const Params& p) {
    if (threadIdx.x == 0) {
        unsigned* cnt = (unsigned*)(p.ws + CW_MEMC); unsigned* tmo = (unsigned*)(p.ws + CW_TMO); unsigned sp = 0;
        while (__hip_atomic_load(cnt, __ATOMIC_RELAXED, __HIP_MEMORY_SCOPE_AGENT) < 32u) {
            __builtin_amdgcn_s_sleep(2);
            if ((++sp & 255u) == 0u) { if (__hip_atomic_load(tmo, __ATOMIC_RELAXED, __HIP_MEMORY_SCOPE_AGENT)) break; if (sp > (1u << 20)) { __hip_atomic_store(tmo, 1u, __ATOMIC_RELAXED, __HIP_MEMORY_SCOPE_AGENT); break; } }
        }
        __builtin_amdgcn_fence(__ATOMIC_ACQUIRE, "agent");
        asm volatile("s_waitcnt vmcnt(0)" ::: "memory");
    }
    __syncthreads();
}
template <int QI> DI void p2_sscore(const Params& p, LAS3 unsigned char* lds) { for (int u = blockIdx.x; u < 256; u += gridDim.x) { sscore_unit(p, lds, u); __syncthreads(); } }
template <int QI> DI void p2_gla(const Params& p, LAS3 unsigned char* lds) { for (int u = blockIdx.x; u < 64; u += gridDim.x) gla_unit(p, lds, u >> 2, u & 3); }
DI int next_unit_xcd(unsigned char* qbase, volatile LAS3 unsigned* slot, unsigned x0) {
    if (threadIdx.x == 0) {
        unsigned res = 0xffffffffu;
        for (unsigned k = 0; k < 8u; ++k) {
            const unsigned xq = (x0 + k) & 7u;
            const unsigned mq = __hip_atomic_fetch_add((unsigned*)(qbase + 256 * xq), 1u, __ATOMIC_RELAXED, __HIP_MEMORY_SCOPE_AGENT);
            if (mq < 64u) { res = xq * 64u + mq; break; }
        }
        *slot = res;
    }
    __syncthreads();
    const int v = __builtin_amdgcn_readfirstlane((int)*slot);
    __syncthreads();
    return v;
}
template <int QI> DI void p2_dsa(const Params& p, LAS3 unsigned char* lds, volatile LAS3 unsigned* MISC TARGS) {
#if defined(XCDQ) && XCDQ
    const unsigned x0 = xb_xcc_id() & 7u;
    for (;;) { const int n = next_unit_xcd(p.ws + CW_QDSA + 8192 * QI, MISC + 4, x0); if (n < 0) break; const int m = n & 63; dsa_unit(p, lds, 2 * (n >> 6) + (m >> 5), 31 - (m & 31) TPASS); }
#else
    for (;;) { const int n = next_unit((unsigned*)(p.ws + CW_QDSA + 8192 * QI), MISC + 4); if (n >= 512) break; dsa_unit(p, lds, n & 15, 31 - (n >> 4) TPASS); }
#endif
}
template <int QI> DI void p2_mem(const Params& p, LAS3 unsigned char* lds, volatile LAS3 unsigned* MISC) {
    wait_memgemm(p);
    for (;;) { const int n = next_unit((unsigned*)(p.ws + CW_QMEM + 8192 * QI), MISC + 4); if (n >= 512) break; mem_unit(p, n); } }
template <int QI> DI void p2_sample(const Params& p, LAS3 unsigned char* lds) {
    for (int u = (int)gridDim.x - 1 - (int)blockIdx.x; u < 96; u += gridDim.x) { if (u < 32) sgla_unit(p, lds, u); else if (u < 64) smem_unit(p, lds, u - 32); else ssel_unit(p, lds, u - 64); } }
template <int RI> DI void phase2(const Params& p, LAS3 unsigned char* lds, volatile LAS3 unsigned* MISC TARGS) {
    TBEG(20); p2_memgemm(p, lds);
    TBEG(21); p2_sscore<0>(p, lds); TEND(21); if (REP2A > 1) p2_sscore<1>(p, lds);
    TBEG(25); p2_sample<0>(p, lds); TEND(25); if (REP2E > 1) p2_sample<1>(p, lds);
    TBEG(22); p2_gla<0>(p, lds); TEND(22); if (REP2B > 1) p2_gla<1>(p, lds);
    TBEG(23); p2_dsa<0>(p, lds, MISC TPASS); TEND(23); if (REP2C > 1) p2_dsa<1>(p, lds, MISC TPASS);
    TBEG(24); p2_mem<0>(p, lds, MISC); TEND(24); if (REP2D > 1) p2_mem<1>(p, lds, MISC);
    TEND(20);
}
DI void phase3(const Params& p, LAS3 unsigned char* lds) {
    pg8::Gemm g{(const bf16_t*)(p.ws + W_MIX), (const bf16_t*)(p.ws + W_WTOUT), MP, DM, DM}; pg8::StaticOrder S; S.init(MP, DM, (int)gridDim.x, (int)blockIdx.x);
    EpiOut E{p.x_prompt, p.x_sample, p.out}; pg8::gemm_phase<EpiOut, pg8::StaticOrder, true, true>(lds, g, S, E);
    const int tid = threadIdx.x, lane = tid & 63, wv = tid >> 6;
    for (int u = blockIdx.x; u < 256; u += gridDim.x) {
        const int b = u >> 3, col0 = (u & 7) * 128 + wv * 16;
        const bf16_t* mrow = (const bf16_t*)(p.ws + W_MIX) + (size_t)(MP + b) * 1024 + lane * 16;
        const u32x4 m0 = *(const u32x4*)mrow, m1 = *(const u32x4*)(mrow + 8);
        const unsigned mw[8] = {m0.x, m0.y, m0.z, m0.w, m1.x, m1.y, m1.z, m1.w};
        float res = 0.f;
#pragma unroll 4
        for (int i = 0; i < 16; ++i) {
            const bf16_t* wrow = (const bf16_t*)(p.ws + W_WTOUT) + (size_t)(col0 + i) * 1024 + lane * 16;
            const u32x4 w0 = *(const u32x4*)wrow, w1 = *(const u32x4*)(wrow + 8);
            const unsigned ww[8] = {w0.x, w0.y, w0.z, w0.w, w1.x, w1.y, w1.z, w1.w};
            float acc = 0.f;
#pragma unroll
            for (int e = 0; e < 8; ++e) acc += __uint_as_float(mw[e] << 16) * __uint_as_float(ww[e] << 16) + __uint_as_float(mw[e] & 0xffff0000u) * __uint_as_float(ww[e] & 0xffff0000u);
            acc = wsum64(acc);
            res = (lane == i) ? acc : res;
        }
        if (lane < 16) p.out[O_YS + (size_t)b * DM + col0 + lane] = p.x_sample[(size_t)b * DM + col0 + lane] + res;
    }
}
#ifdef CHECK_ATT
DI void check_mem_attention(const Params& p) {
    const int tid = threadIdx.x, lane = tid & 63, wv = tid >> 6;
    const int samp = blockIdx.x * 8 + wv;
    const int row = (samp * 977 + 13) % MP, h = samp & 3, b = row >> 11;
    const bf16_t* q = (const bf16_t*)(p.ws + W_MQ) + (size_t)row * 256 + h * 64;
    float s[4];
#pragma unroll
    for (int i = 0; i < 4; ++i) { const float* kr = p.out + O_MKP + ((size_t)b * NMEM + lane + 64 * i) * 256 + h * 64; float a = 0.f; for (int d = 0; d < 64; ++d) a += bf2f(q[d]) * kr[d]; s[i] = a; }
    float mx = wmax64(fmaxf(fmaxf(s[0], s[1]), fmaxf(s[2], s[3])));
    float pe[4], sum = 0.f;
#pragma unroll
    for (int i = 0; i < 4; ++i) { pe[i] = __builtin_amdgcn_exp2f(s[i] - mx); sum += pe[i]; }
    sum = wsum64(sum);
    float err = 0.f, nrm = 0.f;
    for (int d = 0; d < 64; ++d) {
        float a = 0.f;
#pragma unroll
        for (int i = 0; i < 4; ++i) a += pe[i] * p.out[O_MVP + ((size_t)b * NMEM + lane + 64 * i) * 256 + h * 64 + d];
        a = wsum64(a) / sum;
        const float want = a * bf2f(((const bf16_t*)(p.ws + W_MG))[(size_t)row * 256 + h * 64 + d]);
        const float got = bf2f(((const bf16_t*)(p.ws + W_MIX))[(size_t)row * 1024 + 768 + h * 64 + d]);
        err += (got - want) * (got - want); nrm += want * want;
    }
    if (lane == 0) { atomicAdd((unsigned*)(p.ws + CW_CHK + 12), 1u); if (!(err <= 0.0025f * nrm + 1e-12f)) atomicAdd((unsigned*)(p.ws + CW_CHK + 8), 1u); }
    if (samp < 128) {
        const int bs = samp >> 2, hs = samp & 3; const size_t rs = (size_t)MP + bs;
        const bf16_t* qs = (const bf16_t*)(p.ws + W_MQ) + rs * 256 + hs * 64;
        float s2[4];
#pragma unroll
        for (int i = 0; i < 4; ++i) { const float* kr = p.cache_mem_k + ((size_t)bs * NMEM + lane + 64 * i) * 256 + hs * 64; float a = 0.f; for (int d = 0; d < 64; ++d) a += bf2f(qs[d]) * kr[d]; s2[i] = a; }
        const float mx2 = wmax64(fmaxf(fmaxf(s2[0], s2[1]), fmaxf(s2[2], s2[3])));
        float pe2[4], sum2 = 0.f;
#pragma unroll
        for (int i = 0; i < 4; ++i) { pe2[i] = __expf(s2[i] - mx2); sum2 += pe2[i]; }
        sum2 = wsum64(sum2);
        float err2 = 0.f, nrm2 = 0.f;
        for (int d = 0; d < 64; ++d) {
            float a = 0.f;
#pragma unroll
            for (int i = 0; i < 4; ++i) a += pe2[i] * p.cache_mem_v[((size_t)bs * NMEM + lane + 64 * i) * 256 + hs * 64 + d];
            a = wsum64(a) / sum2;
            const float want = a * bf2f(((const bf16_t*)(p.ws + W_MG))[rs * 256 + hs * 64 + d]);
            const float got = bf2f(((const bf16_t*)(p.ws + W_MIX))[rs * 1024 + 768 + hs * 64 + d]);
            err2 += (got - want) * (got - want); nrm2 += want * want;
        }
        if (lane == 0) { atomicAdd((unsigned*)(p.ws + CW_CHK + 12), 1u); if (!(err2 <= 0.0025f * nrm2 + 1e-12f)) atomicAdd((unsigned*)(p.ws + CW_CHK + 8), 1u); }
    }
}
#endif
__global__ void __launch_bounds__(NTHREADS, 2) hymba_fwd(Params p) {
    extern __shared__ __attribute__((aligned(16))) unsigned char lds_raw[];
    LAS3 unsigned char* lds = (LAS3 unsigned char*)lds_raw;
    volatile LAS3 unsigned* MISC = (volatile LAS3 unsigned*)(lds + LDS_MISC);
    const int tid = threadIdx.x;
    if (tid < 64) MISC[tid] = 0u;
    __syncthreads();
    const int lo = p.ph_lo, hi = p.ph_hi;
    TDECL;
    XcdBarrier bar; bar.bar = (unsigned*)p.ws; bar.x = 0; bar.st = MISC;
    if (hi > lo) bar = xcd_barrier_post((unsigned*)p.ws, MISC);
#define IN(k) (lo <= (k) && (k) <= hi)
#define SEAM(k) do { if (IN(k) && IN((k) + 1)) xcd_barrier(bar); } while (0)
    TBEG(0); if (IN(0)) p0_prologue(p, lds); TEND(0);
    TBEG(10); SEAM(0); TEND(10);
    TBEG(1); if (IN(1)) { phase1(p, lds); if (REP1 > 1) { xcd_barrier(bar); phase1(p, lds); } } TEND(1);
    TBEG(11); SEAM(1); TEND(11);
    TBEG(2); if (IN(2)) { phase2<0>(p, lds, MISC TPASS); } TEND(2);
    TBEG(12); SEAM(2); TEND(12);
#ifdef CHECK_ATT
    if (IN(3)) check_mem_attention(p);
#endif
    TBEG(3); if (IN(3)) { phase3(p, lds); if (REP3 > 1) { xcd_barrier(bar); phase3(p, lds); } } TEND(3);
    TBEG(13); SEAM(3); TEND(13);
    TBEG(4); if (IN(4)) p4_final(p); TEND(4);
#ifdef TSEL
    {
#ifdef TCLS
        if (tid == 0 && (int)((blockIdx.x >> 6) & 1) == TCLS) { atomicAdd((unsigned long long*)(p.ws + CW_TSUM), 2ull * (unsigned long long)tacc_); atomicMax((unsigned long long*)(p.ws + CW_TMAX), (unsigned long long)tacc_); }
#else
        if (tid == 0) { atomicAdd((unsigned long long*)(p.ws + CW_TSUM), (unsigned long long)tacc_); atomicMax((unsigned long long*)(p.ws + CW_TMAX), (unsigned long long)tacc_); }
#endif
        xcd_barrier(bar);
        if (blockIdx.x == 0 && tid == 0) {
#ifdef TMAX
            unsigned long long dly = __hip_atomic_load((unsigned long long*)(p.ws + CW_TMAX), __ATOMIC_RELAXED, __HIP_MEMORY_SCOPE_AGENT);
#else
            const unsigned long long dly = __hip_atomic_load((unsigned long long*)(p.ws + CW_TSUM), __ATOMIC_RELAXED, __HIP_MEMORY_SCOPE_AGENT) / gridDim.x;
#endif
#ifndef TMUL
#define TMUL 1
#endif
            const unsigned long long t0 = __builtin_amdgcn_s_memrealtime();
            while (__builtin_amdgcn_s_memrealtime() - t0 < dly * TMUL && __builtin_amdgcn_s_memrealtime() - t0 < 400000ull) __builtin_amdgcn_s_sleep(8);
        }
    }
#endif
#ifdef CHECK_ATT
    {
        xcd_barrier(bar);
        const unsigned nbad = __hip_atomic_load((unsigned*)(p.ws + CW_CHK + 8), __ATOMIC_RELAXED, __HIP_MEMORY_SCOPE_AGENT);
        const unsigned nchk = __hip_atomic_load((unsigned*)(p.ws + CW_CHK + 12), __ATOMIC_RELAXED, __HIP_MEMORY_SCOPE_AGENT);
        if (nbad != 0u || nchk < 2170u) for (int i = blockIdx.x * NTHREADS + tid; i < NDB * DM; i += gridDim.x * NTHREADS) p.out[O_YS + i] = __builtin_nanf("");
    }
#endif
#ifdef CHECK_SEL
    {
        xcd_barrier(bar);
        const unsigned nbad = __hip_atomic_load((unsigned*)(p.ws + CW_CHK), __ATOMIC_RELAXED, __HIP_MEMORY_SCOPE_AGENT);
        const unsigned nhist = __hip_atomic_load((unsigned*)(p.ws + CW_CHK + 4), __ATOMIC_RELAXED, __HIP_MEMORY_SCOPE_AGENT);
        if (nbad != 0u || nhist < CHECK_MIN_HIST) for (int i = blockIdx.x * NTHREADS + tid; i < NDB * DM; i += gridDim.x * NTHREADS) p.out[O_YS + i] = __builtin_nanf("");
    }
#endif
#undef IN
#undef SEAM
}

#ifndef N_LAUNCHES
#define N_LAUNCHES 1
#endif
extern "C" void kernel_launch(void* const* d_in, const int* in_sizes, int n_in, void* d_out, int out_size, void* d_ws, size_t ws_size, hipStream_t stream) {
    static int grid = 0;
    if (grid == 0) {
        if (n_in != 19 || (size_t)out_size != O_END || ws_size < W_END) fprintf(stderr, "kernel_launch: unexpected sizes: n_in %d out %d ws %zu (need %zu)\n", n_in, out_size, ws_size, (size_t)W_END);
        int dev = 0, cus = 0, per_cu = 0;
        if (hipGetDevice(&dev) != hipSuccess || hipDeviceGetAttribute(&cus, hipDeviceAttributeMultiprocessorCount, dev) != hipSuccess) { fprintf(stderr, "kernel_launch: device query failed\n"); grid = -1; return; }
        if (hipFuncSetAttribute((const void*)hymba_fwd, hipFuncAttributeMaxDynamicSharedMemorySize, LDS_BYTES) != hipSuccess) { fprintf(stderr, "kernel_launch: hipFuncSetAttribute failed\n"); grid = -1; return; }
        if (hipOccupancyMaxActiveBlocksPerMultiprocessor(&per_cu, (const void*)hymba_fwd, NTHREADS, LDS_BYTES) != hipSuccess || per_cu < 1) fprintf(stderr, "kernel_launch: occupancy query reports %d blocks per CU\n", per_cu);
        (void)hipGetLastError();
        grid = cus;
    }
    if (grid < 0) return;
    (void)hipMemsetAsync(d_ws, 0, CTRL_BYTES, stream);
    Params p{};
    p.x_prompt = (const float*)d_in[0]; p.x_sample = (const float*)d_in[1]; p.mem_prompt = (const float*)d_in[2]; p.state_gla = (const float*)d_in[3];
    p.cache_k = (const float*)d_in[4]; p.cache_v = (const float*)d_in[5]; p.cache_ik = (const float*)d_in[6]; p.cache_mem_k = (const float*)d_in[7]; p.cache_mem_v = (const float*)d_in[8];
    p.page_table = (const int*)d_in[9];
    p.norm_in = (const float*)d_in[10]; p.w_in = (const float*)d_in[11]; p.w_g2 = (const float*)d_in[12]; p.b_g = (const float*)d_in[13]; p.onorm = (const float*)d_in[14];
    p.mem_norm = (const float*)d_in[15]; p.w_mem_kv = (const float*)d_in[16]; p.w_out = (const float*)d_in[17]; p.norm_final = (const float*)d_in[18];
    p.out = (float*)d_out; p.ws = (unsigned char*)d_ws;
#if N_LAUNCHES == 1
    p.ph_lo = 0; p.ph_hi = 4;
    hipLaunchKernelGGL(hymba_fwd, dim3(grid), dim3(NTHREADS), LDS_BYTES, stream, p);
#else
    for (int ph = 0; ph < 5; ++ph) { p.ph_lo = ph; p.ph_hi = ph; hipLaunchKernelGGL(hymba_fwd, dim3(grid), dim3(NTHREADS), LDS_BYTES, stream, p); }
#endif
    const hipError_t le = hipPeekAtLastError();
    if (le != hipSuccess) fprintf(stderr, "kernel_launch: launch failed: %s\n", hipGetErrorName(le));
}
```

```cpp
#include <hip/hip_runtime.h>
#include <cstdint>
#include <cstdio>
namespace pg8 {
#define PG8_LAS __attribute__((address_space(3)))
typedef unsigned short bf16_t;
typedef short bf16x8 __attribute__((ext_vector_type(8)));
typedef float f32x4 __attribute__((ext_vector_type(4)));
typedef unsigned u32x4 __attribute__((ext_vector_type(4)));
constexpr int BM = 256, BK = 64, HALF = 128, HTB = HALF * BK * 2  , STAGE_BYTES = 8 * HTB, NXCD = 8, WGM = 8;

__host__ __device__ __forceinline__ int lds_byte(int r, int c) { const int st = (r >> 4) * 2 + (c >> 5), rr = r & 15, cc = c & 31, ob = rr * 64 + cc * 2; return st * 1024 + (ob ^ (((ob >> 9) & 1) << 5)); }
__host__ __device__ __forceinline__ void stage_rc(int b, int& R, int& C) { const int st = b / 1024, sb = b % 1024, swz = sb ^ (((sb >> 9) & 1) << 5); R = (st >> 1) * 16 + swz / 64; C = (st & 1) * 32 + (swz % 64) / 2; }
__host__ __device__ __forceinline__ int perm32(int rho) { const int n = rho >> 4, i = rho & 15; return 8 * (i >> 2) + 4 * n + (i & 3); }

struct Unit { int pm, pn; };
struct Gemm { const bf16_t* A; const bf16_t* Bt; int M, N, K; };

struct StaticOrder {
    int nM, nN, nwg, G, c;
    __host__ __device__ void init(int M, int N, int G_, int c_) { nM = M / BM; nN = N / BM; nwg = nM * nN; G = G_; c = c_; }
    __host__ __device__ bool next(int i, Unit& u) const {
        const long L = (long)i * G + c; if (L >= nwg) return false;
        int wgid = (int)L; { const int q = nwg / NXCD, r = nwg % NXCD, xcd = wgid % NXCD, off = wgid / NXCD; wgid = (xcd < r ? xcd * (q + 1) : r * (q + 1) + (xcd - r) * q) + off; }
        const int nig = WGM * nN, gid = wgid / nig, fm = gid * WGM, gsz = (nM - fm) < WGM ? (nM - fm) : WGM;
        u.pm = fm + ((wgid % nig) % gsz); u.pn = (wgid % nig) / gsz; return true;
    }
    __device__ __forceinline__ void a_ready(const Unit&) const {}
    __device__ __forceinline__ void done(const Unit&) const {}
};

template <class Epi, class Sched, bool ALIGN_EPI = false, bool SP2 = false>
__device__ __forceinline__ void gemm_phase(PG8_LAS unsigned char* lds, const Gemm g, const Sched& S, const Epi& E) {
    const int tid = threadIdx.x, wid = __builtin_amdgcn_readfirstlane(tid >> 6), lane = tid & 63, wr = wid >> 2, wc = wid & 3, fr = lane & 15, fq = lane >> 4;
    const int K = g.K, nt = K / BK;
    unsigned voffA[2], voffB[2];
#pragma unroll
    for (int i = 0; i < 2; ++i) { int R, C; stage_rc(tid * 16 + i * 8192, R, C); const int Rb = Epi::PERM ? ((R & ~31) + perm32(R & 31)) : R;
        voffA[i] = (unsigned)(R * K + C) * 2u; voffB[i] = (unsigned)(Rb * K + C) * 2u; }
    const size_t kstep = (size_t)(BK * 2);
    const size_t hstep = (size_t)HALF * K * 2;
    const size_t tstep = 2 * hstep;
    const unsigned ldsw = (unsigned)wid * 1024u;
    const int aoff = lds_byte(wr * 64 + fr, fq * 8), boff = lds_byte(wc * 32 + fr, fq * 8);
#define PG8_SA(b, h) (((b) * 2 + (h)) * HTB)
#define PG8_SB(b, h) ((4 + (b) * 2 + (h)) * HTB)
#define PG8_STAGE(bufoff, gbase, voff) do { _Pragma("unroll") for (int _i = 0; _i < 2; ++_i) \
        __builtin_amdgcn_global_load_lds((const unsigned*)((const char*)(gbase) + (voff)[_i]), (PG8_LAS unsigned*)(lds + (bufoff) + ldsw + _i * 8192), 16, 0, 0); } while (0)
#define PG8_LDA(dst, b, h) do { _Pragma("unroll") for (int m = 0; m < 4; ++m) _Pragma("unroll") for (int k = 0; k < 2; ++k) dst[m][k] = *(const PG8_LAS bf16x8*)(lds + PG8_SA(b, h) + aoff + m * 2048 + k * 1024); } while (0)
#define PG8_LDB(dst, b, h) do { _Pragma("unroll") for (int n = 0; n < 2; ++n) _Pragma("unroll") for (int k = 0; k < 2; ++k) dst[n][k] = *(const PG8_LAS bf16x8*)(lds + PG8_SB(b, h) + boff + n * 2048 + k * 1024); } while (0)
#define PG8_MMA(ai, bj, At, Bt) do { __builtin_amdgcn_s_setprio(1); _Pragma("unroll") for (int m = 0; m < 4; ++m) _Pragma("unroll") for (int n = 0; n < 2; ++n) _Pragma("unroll") for (int k = 0; k < 2; ++k) \
        acc[ai][bj][m][n] = __builtin_amdgcn_mfma_f32_16x16x32_bf16(Bt[n][k], At[m][k], acc[ai][bj][m][n], 0, 0, 0); __builtin_amdgcn_s_setprio(0); } while (0)
#define PG8_WAIT_V(n) asm volatile("s_waitcnt vmcnt(" #n ")" ::: "memory")
#define PG8_WAIT_L(n) asm volatile("s_waitcnt lgkmcnt(" #n ")" ::: "memory")
#define PG8_BAR __builtin_amdgcn_s_barrier()
#define PG8_SCHED __builtin_amdgcn_sched_barrier(0)
    Unit cur, nxt; int ui = 0;
    if (!S.next(0, cur)) return;
    f32x4 acc[2][2][4][2];
#pragma unroll
    for (int a = 0; a < 2; ++a)
#pragma unroll
        for (int b = 0; b < 2; ++b)
#pragma unroll
            for (int m = 0; m < 4; ++m)
#pragma unroll
                for (int n = 0; n < 2; ++n) acc[a][b][m][n] = (f32x4){0.f, 0.f, 0.f, 0.f};
    bf16x8 At[4][2], B0[2][2], B1[2][2];
    const char* cA = (const char*)g.A + (size_t)cur.pm * tstep; const char* cB = (const char*)g.Bt + (size_t)cur.pn * tstep;
    S.a_ready(cur);
    if constexpr (SP2) {
        PG8_STAGE(PG8_SB(0, 0), cB, voffB); PG8_STAGE(PG8_SB(0, 1), cB + hstep, voffB); PG8_STAGE(PG8_SA(0, 0), cA, voffA); PG8_STAGE(PG8_SA(0, 1), cA + hstep, voffA);
        if (wr == 1) PG8_BAR;
        PG8_WAIT_V(2); PG8_BAR;
        PG8_STAGE(PG8_SB(1, 0), cB + kstep, voffB); PG8_STAGE(PG8_SA(1, 0), cA + kstep, voffA); PG8_STAGE(PG8_SB(1, 1), cB + hstep + kstep, voffB);
        PG8_WAIT_V(6); PG8_BAR;
    } else {
        PG8_STAGE(PG8_SB(0, 0), cB, voffB); PG8_STAGE(PG8_SA(0, 0), cA, voffA); PG8_STAGE(PG8_SB(0, 1), cB + hstep, voffB); PG8_STAGE(PG8_SA(0, 1), cA + hstep, voffA);
        if (wr == 1) PG8_BAR;
        PG8_WAIT_V(4); PG8_BAR;
        PG8_STAGE(PG8_SB(1, 0), cB + kstep, voffB); PG8_STAGE(PG8_SA(1, 0), cA + kstep, voffA); PG8_STAGE(PG8_SB(1, 1), cB + hstep + kstep, voffB);
        PG8_WAIT_V(6); PG8_BAR;
    }
    for (;;) {
        const bool has_next = S.next(ui + 1, nxt);
        const char* nA = has_next ? (const char*)g.A + (size_t)nxt.pm * tstep : cA; const char* nB = has_next ? (const char*)g.Bt + (size_t)nxt.pn * tstep : cB;
        for (int t = 0; t < nt; t += 2) {
            const bool last = (t == nt - 2);
            const char* a1 = cA + (size_t)(t + 1) * kstep;
            const char* a2 = last ? nA : cA + (size_t)(t + 2) * kstep; const char* b2 = last ? nB : cB + (size_t)(t + 2) * kstep;
            const char* a3 = a2 + kstep; const char* b3 = b2 + kstep;
            if (last && has_next) S.a_ready(nxt);
            if constexpr (SP2) {
            PG8_LDB(B0, 0, 0); PG8_LDB(B1, 0, 1); PG8_SCHED; PG8_LDA(At, 0, 0); PG8_STAGE(PG8_SA(1, 1), a1 + hstep, voffA);
            PG8_WAIT_V(8); PG8_WAIT_L(0); PG8_BAR; PG8_MMA(0, 0, At, B0); PG8_MMA(0, 1, At, B1); PG8_BAR; PG8_SCHED;
            PG8_LDA(At, 0, 1); PG8_STAGE(PG8_SB(0, 0), b2, voffB); PG8_STAGE(PG8_SB(0, 1), b2 + hstep, voffB); PG8_STAGE(PG8_SA(0, 0), a2, voffA);
            PG8_WAIT_V(8); PG8_WAIT_L(0); PG8_BAR; PG8_MMA(1, 0, At, B0); PG8_MMA(1, 1, At, B1); PG8_BAR; PG8_SCHED;
            PG8_LDB(B0, 1, 0); PG8_LDB(B1, 1, 1); PG8_SCHED; PG8_LDA(At, 1, 0); PG8_STAGE(PG8_SA(0, 1), a2 + hstep, voffA);
            PG8_WAIT_V(8); PG8_WAIT_L(0); PG8_BAR; PG8_MMA(0, 0, At, B0); PG8_MMA(0, 1, At, B1); PG8_BAR; PG8_SCHED;
            PG8_LDA(At, 1, 1); PG8_STAGE(PG8_SB(1, 0), b3, voffB); PG8_STAGE(PG8_SB(1, 1), b3 + hstep, voffB); PG8_STAGE(PG8_SA(1, 0), a3, voffA);
            PG8_WAIT_V(8); PG8_WAIT_L(0); PG8_BAR; PG8_MMA(1, 0, At, B0); PG8_MMA(1, 1, At, B1); PG8_BAR; PG8_SCHED;
            } else {
            PG8_LDB(B0, 0, 0); PG8_SCHED; PG8_LDA(At, 0, 0); PG8_STAGE(PG8_SA(1, 1), a1 + hstep, voffA);
            PG8_WAIT_L(8); PG8_BAR; PG8_WAIT_L(0); PG8_MMA(0, 0, At, B0); PG8_BAR; PG8_SCHED;
            PG8_LDB(B1, 0, 1); PG8_STAGE(PG8_SB(0, 0), b2, voffB);
            PG8_BAR; PG8_WAIT_L(0); PG8_MMA(0, 1, At, B1); PG8_BAR;
            PG8_LDA(At, 0, 1); PG8_STAGE(PG8_SA(0, 0), a2, voffA);
            PG8_BAR; PG8_WAIT_L(0); PG8_MMA(1, 0, At, B0); PG8_BAR; PG8_SCHED;
            PG8_STAGE(PG8_SB(0, 1), b2 + hstep, voffB);
            PG8_WAIT_V(6); PG8_BAR; PG8_MMA(1, 1, At, B1); PG8_BAR;
            PG8_LDB(B0, 1, 0); PG8_SCHED; PG8_LDA(At, 1, 0); PG8_STAGE(PG8_SA(0, 1), a2 + hstep, voffA);
            PG8_WAIT_L(8); PG8_BAR; PG8_WAIT_L(0); PG8_MMA(0, 0, At, B0); PG8_BAR; PG8_SCHED;
            PG8_LDB(B1, 1, 1); PG8_STAGE(PG8_SB(1, 0), b3, voffB);
            PG8_BAR; PG8_WAIT_L(0); PG8_MMA(0, 1, At, B1); PG8_BAR;
            PG8_LDA(At, 1, 1); PG8_STAGE(PG8_SA(1, 0), a3, voffA);
            PG8_BAR; PG8_WAIT_L(0); PG8_MMA(1, 0, At, B0); PG8_BAR; PG8_SCHED;
            PG8_STAGE(PG8_SB(1, 1), b3 + hstep, voffB);
            PG8_WAIT_V(6); PG8_BAR; PG8_MMA(1, 1, At, B1); PG8_BAR;
            }
        }
        if constexpr (ALIGN_EPI) { if (wr == 0) PG8_BAR; }
        if constexpr (!Epi::AFTER_DRAIN) { E(acc, cur, wr, wc, fr, fq); S.done(cur); }
        if (!has_next) break;
#pragma unroll
        for (int a = 0; a < 2; ++a)
#pragma unroll
            for (int b = 0; b < 2; ++b)
#pragma unroll
                for (int m = 0; m < 4; ++m)
#pragma unroll
                    for (int n = 0; n < 2; ++n) acc[a][b][m][n] = (f32x4){0.f, 0.f, 0.f, 0.f};
        cur = nxt; cA = nA; cB = nB; ++ui;
        if constexpr (ALIGN_EPI) { if (wr == 1) PG8_BAR; }
    }
    PG8_WAIT_V(0);
    if constexpr (!ALIGN_EPI) { if (wr == 0) PG8_BAR; }
    PG8_BAR;
    if constexpr (Epi::AFTER_DRAIN) { E.fused(acc, cur, wr, wc, fr, fq, lds, wid, lane); S.done(cur); }
#undef PG8_SA
#undef PG8_SB
#undef PG8_STAGE
#undef PG8_LDA
#undef PG8_LDB
#undef PG8_MMA
#undef PG8_WAIT_V
#undef PG8_WAIT_L
#undef PG8_BAR
#undef PG8_SCHED
}
}
#define XB_TMO      128
#define XB_XCNT(j)  (256  + 64 * (j))
#define XB_XSUB(j)  (1280 + 64 * (j))
#define XB_XGEN(j)  (2304 + 64 * (j))
#define XB_TOP      3328
#define XB_TOPGEN   3392
#define XCD_BAR_WORDS 3456
#define XB_SPIN_CAP (1u << 18)
#define LAS __attribute__((address_space(3)))

__device__ __forceinline__ unsigned xb_ld(unsigned* p)              { return __hip_atomic_load(p, __ATOMIC_RELAXED, __HIP_MEMORY_SCOPE_AGENT); }
__device__ __forceinline__ unsigned xb_add(unsigned* p, unsigned v) { return __hip_atomic_fetch_add(p, v, __ATOMIC_RELAXED, __HIP_MEMORY_SCOPE_AGENT); }
__device__ __forceinline__ unsigned xb_xcc_id() { return (unsigned)__builtin_amdgcn_s_getreg((3 << 11) | 20) & 0xFu; }
#define XB_SPIN(cond, bar) do { unsigned _sp = 0; while (cond) { __builtin_amdgcn_s_sleep(1); \
    if ((++_sp & 255u) == 0u) { if (xb_ld(&(bar)[XB_TMO])) break; if (_sp > XB_SPIN_CAP) { atomicAdd(&(bar)[XB_TMO], 1u); break; } } } } while (0)

struct XcdBarrier {
    unsigned* bar; unsigned x;
    volatile LAS unsigned* st;
};

__device__ __forceinline__ XcdBarrier xcd_barrier_post(unsigned* bar, volatile LAS unsigned* st) {
    XcdBarrier b; b.bar = bar; b.x = xb_xcc_id(); b.st = st;
    if (threadIdx.x == 0) (void)xb_add(&bar[XB_XCNT(b.x)], 1u);
    return b;
}
__device__ __forceinline__ void xcd_barrier_complete(unsigned* bar, unsigned x, unsigned& nloc, unsigned& nx) {
    const unsigned G = gridDim.x * gridDim.y * gridDim.z;
    unsigned sum, cnt, mine, sp = 0u;
    for (;;) {
        sum = 0u; cnt = 0u; mine = 0u;
#pragma unroll
        for (unsigned j = 0; j < 16; ++j) { const unsigned c = xb_ld(&bar[XB_XCNT(j)]); sum += c; cnt += (c > 0u) ? 1u : 0u; mine = (j == x) ? c : mine; }
        if (sum == G) break;
        __builtin_amdgcn_s_sleep(1);
        if ((++sp & 255u) == 0u) { if (xb_ld(&bar[XB_TMO])) break; if (sp > XB_SPIN_CAP) { atomicAdd(&bar[XB_TMO], 1u); break; } }
    }
    nloc = mine > 0u ? mine : 1u; nx = cnt > 0u ? cnt : 1u;
}

__device__ __forceinline__ void xcd_barrier(const XcdBarrier& b) {
    asm volatile("s_waitcnt vmcnt(0)" ::: "memory");
    __syncthreads();
    if (threadIdx.x == 0) {
        unsigned* bar = b.bar;
        __builtin_amdgcn_s_waitcnt(0);
        unsigned nloc = b.st[0], nx = b.st[1];
        if (nloc == 0u) { xcd_barrier_complete(bar, b.x, nloc, nx); b.st[0] = nloc; b.st[1] = nx; }
        const unsigned old = xb_add(&bar[XB_XSUB(b.x)], 1u);
        const unsigned gen = old / nloc;
        if (old + 1u == (gen + 1u) * nloc) {
            __builtin_amdgcn_fence(__ATOMIC_RELEASE, "agent");
            asm volatile("s_waitcnt vmcnt(0)" ::: "memory");
            const unsigned og = xb_add(&bar[XB_TOP], 1u);
            const unsigned tg = og / nx;
            if (og + 1u == (tg + 1u) * nx) xb_add(&bar[XB_TOPGEN], 1u);
            else XB_SPIN(xb_ld(&bar[XB_TOPGEN]) == tg, bar);
            __builtin_amdgcn_fence(__ATOMIC_ACQUIRE, "agent");
            xb_add(&bar[XB_XGEN(b.x)], 1u);
            asm volatile("s_waitcnt vmcnt(0)" ::: "memory");
        } else {
            XB_SPIN(xb_ld(&bar[XB_XGEN(b.x)]) == gen, bar);
            __builtin_amdgcn_fence(__ATOMIC_ACQUIRE, "agent");
            asm volatile("s_waitcnt vmcnt(0)" ::: "memory");
        }
    }
    __syncthreads();
}
#define DI __device__ __forceinline__
#define LAS3 __attribute__((address_space(3)))
using pg8::bf16_t; using pg8::bf16x8; using pg8::f32x4; using pg8::u32x4;
typedef unsigned u32x2 __attribute__((ext_vector_type(2)));
typedef short s16x4 __attribute__((ext_vector_type(4)));
typedef float f32x2 __attribute__((ext_vector_type(2)));
typedef __bf16 bf16x2_t __attribute__((ext_vector_type(2)));

constexpr int DM = 1024, NB = 16, SEQ = 2048, MP = NB * SEQ  , NDB = 32  , MROWS = 33024  ;
constexpr int NMEM = 256, MMEM = NB * NMEM  , DIN = 3412, NIN = 3584, NPAGES = 128;
constexpr int NTHREADS = 512;
constexpr size_t O_YP = 0, O_YS = O_YP + (size_t)MP * DM, O_GSP = O_YS + (size_t)NDB * DM, O_KP = O_GSP + (size_t)NB * 4 * 64 * 128,
                 O_VP = O_KP + (size_t)MP * 256, O_IKP = O_VP + (size_t)MP * 256, O_MKP = O_IKP + (size_t)MP * 64, O_MVP = O_MKP + (size_t)MMEM * 256,
                 O_GSS = O_MVP + (size_t)MMEM * 256, O_KS = O_GSS + (size_t)NDB * 4 * 64 * 128, O_VS = O_KS + (size_t)NDB * 256, O_IKS = O_VS + (size_t)NDB * 256,
                 O_END = O_IKS + (size_t)NDB * 64;
static_assert(O_END == 56150016, "output size");
constexpr size_t al256(size_t x) { return (x + 255) & ~(size_t)255; }
constexpr size_t CTRL_BYTES = 32768;
constexpr size_t CW_QDSA = 16384  , CW_QMEM = 18432  , CW_SCNT = 20480, CW_TMO = 20736, CW_CHK = 20992, CW_TSUM = 21248, CW_TMAX = 21504, CW_MEMC = 21760;
constexpr int SCLD = 16400;
constexpr size_t W_ROPE = CTRL_BYTES;
constexpr size_t W_XN = al256(W_ROPE + (size_t)2049 * 32 * 8);
constexpr size_t W_MEMN = W_XN + (size_t)MROWS * 1024 * 2;
constexpr size_t W_WTIN = W_MEMN + (size_t)MMEM * 1024 * 2;
constexpr size_t W_WTMEM = W_WTIN + (size_t)NIN * 1024 * 2;
constexpr size_t W_WTOUT = W_WTMEM + (size_t)512 * 1024 * 2;
constexpr size_t W_GQ = W_WTOUT + (size_t)1024 * 1024 * 2;
constexpr size_t W_GK = W_GQ + (size_t)MROWS * 256 * 2;
constexpr size_t W_GV = W_GK + (size_t)MROWS * 256 * 2;
constexpr size_t W_GG = W_GV + (size_t)MROWS * 512 * 2;
constexpr size_t W_DQ = W_GG + (size_t)MROWS * 512 * 2;
constexpr size_t W_DK = W_DQ + (size_t)MROWS * 256 * 2;
constexpr size_t W_DVT = W_DK + (size_t)MROWS * 256 * 2;
constexpr size_t W_IQ = W_DVT + (size_t)MP * 256 * 2;
constexpr size_t W_DG = W_IQ + (size_t)MROWS * 256 * 2;
constexpr size_t W_MQ = W_DG + (size_t)MROWS * 256 * 2;
constexpr size_t W_MG = W_MQ + (size_t)MROWS * 256 * 2;
constexpr size_t W_IK = W_MG + (size_t)MROWS * 256 * 2;
constexpr size_t W_IW = W_IK + (size_t)MROWS * 64 * 2;
constexpr size_t W_GLR = W_IW + (size_t)MROWS * 4 * 4;
constexpr size_t W_MK = W_GLR + (size_t)MROWS * 16 * 4;
constexpr size_t W_MVT = W_MK + (size_t)MMEM * 256 * 2;
constexpr size_t W_MIX = W_MVT + (size_t)MMEM * 256 * 2;
constexpr size_t W_SC = W_MIX + (size_t)MROWS * 1024 * 2;
constexpr size_t W_END = W_SC + (size_t)NDB * SCLD * 4;
constexpr int LDS_MISC = 148480, LDS_BYTES = 148480 + 256;

struct Params {
    const float *x_prompt, *x_sample, *mem_prompt, *state_gla, *cache_k, *cache_v, *cache_ik, *cache_mem_k, *cache_mem_v;
    const int* page_table;
    const float *norm_in, *w_in, *w_g2, *b_g, *onorm, *mem_norm, *w_mem_kv, *w_out, *norm_final;
    float* out; unsigned char* ws; int ph_lo, ph_hi;
};

#ifdef TSEL
#define TDECL unsigned tacc_ = 0u, tbeg_ = 0u
#define TBEG(k) do { if ((k) == TSEL) tbeg_ = (unsigned)__builtin_amdgcn_s_memrealtime(); } while (0)
#define TEND(k) do { if ((k) == TSEL) tacc_ += (unsigned)__builtin_amdgcn_s_memrealtime() - tbeg_; } while (0)
#define TARGS , unsigned& tacc_, unsigned& tbeg_
#define TPASS , tacc_, tbeg_
#else
#define TARGS
#define TPASS
#define TDECL do {} while (0)
#define TBEG(k) do {} while (0)
#define TEND(k) do {} while (0)
#endif
DI float bf2f(bf16_t v) { return __uint_as_float((unsigned)v << 16); }
DI unsigned cvtpk(float lo, float hi) { f32x2 v = {lo, hi}; bf16x2_t b = __builtin_convertvector(v, bf16x2_t); return __builtin_bit_cast(unsigned, b); }
DI bf16_t f2bf(float x) { return (bf16_t)(cvtpk(x, 0.f) & 0xffffu); }
DI f32x4 mfma16(bf16x8 a, bf16x8 b, f32x4 c) { return __builtin_amdgcn_mfma_f32_16x16x32_bf16(a, b, c, 0, 0, 0); }
DI float fexp(float x) { return __builtin_amdgcn_exp2f(x * 1.4426950408889634f); }
DI float siluf(float x) { return x * __builtin_amdgcn_rcpf(1.f + fexp(-x)); }
DI float logsigf(float u) { return fminf(u, 0.f) - 0.6931471805599453f * __builtin_amdgcn_logf(1.f + fexp(-fabsf(u))); }
DI unsigned fkey(float x) { unsigned u = __float_as_uint(x); u = (u == 0x80000000u) ? 0u : u; return u ^ ((unsigned)((int)u >> 31) | 0x80000000u); }
DI float wsum64(float v) { v += __shfl_xor(v, 1); v += __shfl_xor(v, 2); v += __shfl_xor(v, 4); v += __shfl_xor(v, 8); v += __shfl_xor(v, 16); v += __shfl_xor(v, 32); return v; }
DI float wmax64(float v) { v = fmaxf(v, __shfl_xor(v, 1)); v = fmaxf(v, __shfl_xor(v, 2)); v = fmaxf(v, __shfl_xor(v, 4)); v = fmaxf(v, __shfl_xor(v, 8)); v = fmaxf(v, __shfl_xor(v, 16)); v = fmaxf(v, __shfl_xor(v, 32)); return v; }
DI unsigned lds_add(LAS3 unsigned* p, unsigned v) { return __hip_atomic_fetch_add(p, v, __ATOMIC_RELAXED, __HIP_MEMORY_SCOPE_WORKGROUP); }
DI unsigned lds_or(LAS3 unsigned* p, unsigned v) { return __hip_atomic_fetch_or(p, v, __ATOMIC_RELAXED, __HIP_MEMORY_SCOPE_WORKGROUP); }
DI void st_bf16x4(bf16_t* p, f32x4 v) { u32x2 w; w.x = cvtpk(v[0], v[1]); w.y = cvtpk(v[2], v[3]); *(u32x2*)p = w; }
DI const float* vaddr(const float* q) { asm volatile("" : "+v"(q)); return q; }
constexpr float LOG2E = 1.4426950408889634f;
#define NEG_INF (-__builtin_inff())

DI int rope_perm(int vc) { return 64 * (vc >> 6) + 16 * ((vc >> 5) & 1) + (vc & 15) + 32 * ((vc >> 4) & 1); }
DI int rope_map(int vc) { return 64 * ((vc >> 5) & 3) + 32 * ((vc >> 4) & 1) + 8 * ((vc >> 2) & 3) + 4 * (vc >> 7) + (vc & 3); }
DI int plain_map(int vc) { return (vc & ~31) + 8 * ((vc >> 2) & 3) + 4 * ((vc >> 4) & 1) + (vc & 3); }
DI int in_src(int np) {
    const int pn = np >> 8, vc = np & 255;
    switch (pn) {
        case 0: return plain_map(vc);
        case 1: return 256 + plain_map(vc);
        case 2: case 3: return 512 + 256 * (pn - 2) + plain_map(vc);
        case 4: case 5: return 1040 + 256 * (pn - 4) + plain_map(vc);
        case 6: return 1552 + rope_map(vc);
        case 7: return 1808 + rope_map(vc);
        case 8: return 2064 + plain_map(vc);
        case 9: return 2320 + rope_map(vc);
        case 10: return 2644 + plain_map(vc);
        case 11: return 2900 + plain_map(vc);
        case 12: return 3156 + plain_map(vc);
        default: break;
    }
    if (vc < 64) return 2576 + rope_perm(vc);
    if (vc < 68) return 2640 + (vc - 64);
    if (vc < 84) return 1024 + (vc - 68);
    return -1;
}

struct EpiIn {
    static constexpr bool PERM = false, AFTER_DRAIN = false;
    unsigned char* ws; float* out;
    DI void operator()(const f32x4 (&acc)[2][2][4][2], const pg8::Unit& u, int wr, int wc, int fr, int fq) const {
        const int pn = u.pn, rbase = u.pm * 256 + wr * 64 + fr;
        if (pn <= 5 || (pn >= 10 && pn <= 12)) {
            bf16_t* dst; int ldc = 256, coff = 0; float sc = 1.f; bool silu = false;
            switch (pn) {
                case 0: dst = (bf16_t*)(ws + W_GQ); sc = 0.125f; break;
                case 1: dst = (bf16_t*)(ws + W_GK); break;
                case 2: dst = (bf16_t*)(ws + W_GV); ldc = 512; break;
                case 3: dst = (bf16_t*)(ws + W_GV); ldc = 512; coff = 256; break;
                case 4: dst = (bf16_t*)(ws + W_GG); ldc = 512; silu = true; break;
                case 5: dst = (bf16_t*)(ws + W_GG); ldc = 512; coff = 256; silu = true; break;
                case 10: dst = (bf16_t*)(ws + W_DG); silu = true; break;
                case 11: dst = (bf16_t*)(ws + W_MQ); sc = 0.125f * LOG2E; break;
                default: dst = (bf16_t*)(ws + W_MG); silu = true; break;
            }
#pragma unroll
            for (int ai = 0; ai < 2; ++ai)
#pragma unroll
                for (int m = 0; m < 4; ++m) {
                    const int row = rbase + ai * 128 + m * 16;
                    bf16_t* rp = dst + (size_t)row * ldc + coff + wc * 32 + 8 * fq;
#pragma unroll
                    for (int bj = 0; bj < 2; ++bj) {
                        f32x4 v0 = acc[ai][bj][m][0], v1 = acc[ai][bj][m][1];
                        if (silu) { v0[0] = siluf(v0[0]); v0[1] = siluf(v0[1]); v0[2] = siluf(v0[2]); v0[3] = siluf(v0[3]); v1[0] = siluf(v1[0]); v1[1] = siluf(v1[1]); v1[2] = siluf(v1[2]); v1[3] = siluf(v1[3]); }
                        else { v0 = v0 * sc; v1 = v1 * sc; }
                        u32x4 w; w.x = cvtpk(v0[0], v0[1]); w.y = cvtpk(v0[2], v0[3]); w.z = cvtpk(v1[0], v1[1]); w.w = cvtpk(v1[2], v1[3]);
                        *(u32x4*)(rp + bj * 128) = w;
                    }
                }
        } else if (pn == 6 || pn == 7 || pn == 9) {
            bf16_t* dst = (bf16_t*)(ws + (pn == 6 ? W_DQ : (pn == 7 ? W_DK : W_IQ)));
            const float sc = (pn == 6) ? 0.125f * LOG2E : 1.f;
            const float* rope = (const float*)(ws + W_ROPE);
#pragma unroll
            for (int ai = 0; ai < 2; ++ai)
#pragma unroll
                for (int m = 0; m < 4; ++m) {
                    const int row = rbase + ai * 128 + m * 16;
                    const int pi = row < MP ? (row & 2047) : 2048;
                    const float* rp = rope + ((size_t)pi * 32 + 8 * fq) * 2;
                    f32x4 o1[2], o2[2];
#pragma unroll
                    for (int bj = 0; bj < 2; ++bj) {
                        const f32x4 cs0 = *(const f32x4*)(rp + 8 * bj), cs1 = *(const f32x4*)(rp + 8 * bj + 4);
                        const f32x4 c = {cs0[0], cs0[2], cs1[0], cs1[2]}, s = {cs0[1], cs0[3], cs1[1], cs1[3]};
                        const f32x4 v0 = acc[ai][bj][m][0], v1 = acc[ai][bj][m][1];
                        o1[bj] = (v0 * c - v1 * s) * sc; o2[bj] = (v1 * c + v0 * s) * sc;
                    }
                    const int col1 = 64 * wc + 8 * fq, col2 = col1 + 32;
                    u32x4 w1, w2; w1.x = cvtpk(o1[0][0], o1[0][1]); w1.y = cvtpk(o1[0][2], o1[0][3]); w1.z = cvtpk(o1[1][0], o1[1][1]); w1.w = cvtpk(o1[1][2], o1[1][3]);
                    w2.x = cvtpk(o2[0][0], o2[0][1]); w2.y = cvtpk(o2[0][2], o2[0][3]); w2.z = cvtpk(o2[1][0], o2[1][1]); w2.w = cvtpk(o2[1][2], o2[1][3]);
                    *(u32x4*)(dst + (size_t)row * 256 + col1) = w1; *(u32x4*)(dst + (size_t)row * 256 + col2) = w2;
                    if (pn == 7) {
                        float* op = nullptr;
                        if (row < MP) op = out + O_KP + (size_t)row * 256; else if (row < MP + NDB) op = out + O_KS + (size_t)(row - MP) * 256;
                        if (op) { *(f32x4*)(op + col1) = o1[0]; *(f32x4*)(op + col1 + 4) = o1[1]; *(f32x4*)(op + col2) = o2[0]; *(f32x4*)(op + col2 + 4) = o2[1]; }
                    }
                }
        } else if (pn == 8) {
            bf16_t* dvt = (bf16_t*)(ws + W_DVT);
#pragma unroll
            for (int ai = 0; ai < 2; ++ai)
#pragma unroll
                for (int m = 0; m < 4; ++m) {
                    const int row = rbase + ai * 128 + m * 16;
                    float* op = nullptr;
                    if (row < MP) op = out + O_VP + (size_t)row * 256; else if (row < MP + NDB) op = out + O_VS + (size_t)(row - MP) * 256;
#pragma unroll
                    for (int bj = 0; bj < 2; ++bj)
#pragma unroll
                        for (int n = 0; n < 2; ++n) {
                            const f32x4 v = acc[ai][bj][m][n];
                            const int col = 128 * bj + 32 * wc + 8 * fq + 4 * n;
                            if (op) *(f32x4*)(op + col) = v;
                            if (row < MP) {
                                const int t_ = row & 2047, kk_ = t_ & 31;
                                bf16_t* tp = dvt + ((((size_t)(row >> 11) * 64 + (t_ >> 5)) * 4 + (col >> 6)) * 64 + (col & 63)) * 32 + 8 * ((kk_ >> 2) & 3) + 4 * (kk_ >> 4) + (kk_ & 3);
                                tp[0] = f2bf(v[0]); tp[32] = f2bf(v[1]); tp[64] = f2bf(v[2]); tp[96] = f2bf(v[3]);
                            }
                        }
                }
        } else {
            bf16_t* ikb = (bf16_t*)(ws + W_IK); float* iw = (float*)(ws + W_IW); float* glr = (float*)(ws + W_GLR);
            const float* rope = (const float*)(ws + W_ROPE);
#pragma unroll
            for (int ai = 0; ai < 2; ++ai)
#pragma unroll
                for (int m = 0; m < 4; ++m) {
                    const int row = rbase + ai * 128 + m * 16;
                    const f32x4 v0 = acc[ai][0][m][0], v1 = acc[ai][0][m][1];
                    if (wc < 2) {
                        const int pi = row < MP ? (row & 2047) : 2048;
                        const int f0 = 16 * wc + 4 * fq;
                        const f32x4 cs0 = *(const f32x4*)(rope + ((size_t)pi * 32 + f0) * 2), cs1 = *(const f32x4*)(rope + ((size_t)pi * 32 + f0) * 2 + 4);
                        const f32x4 c = {cs0[0], cs0[2], cs1[0], cs1[2]}, s = {cs0[1], cs0[3], cs1[1], cs1[3]};
                        const f32x4 o1 = v0 * c - v1 * s, o2 = v1 * c + v0 * s;
                        st_bf16x4(ikb + (size_t)row * 64 + f0, o1); st_bf16x4(ikb + (size_t)row * 64 + f0 + 32, o2);
                        float* op = nullptr;
                        if (row < MP) op = out + O_IKP + (size_t)row * 64; else if (row < MP + NDB) op = out + O_IKS + (size_t)(row - MP) * 64;
                        if (op) { *(f32x4*)(op + f0) = o1; *(f32x4*)(op + f0 + 32) = o2; }
                    } else if (wc == 2) {
                        if (fq == 0) { *(f32x4*)(iw + (size_t)row * 4) = v0 * 0.5f; *(f32x4*)(glr + (size_t)row * 16 + 12) = v1; }
                        else *(f32x4*)(glr + (size_t)row * 16 + 4 * (fq - 1)) = v0;
                    }
                }
        }
    }
};
struct EpiMem {
    static constexpr bool PERM = false, AFTER_DRAIN = false;
    unsigned char* ws; float* out;
    DI void operator()(const f32x4 (&acc)[2][2][4][2], const pg8::Unit& u, int wr, int wc, int fr, int fq) const {
        const int pn = u.pn, rbase = u.pm * 256 + wr * 64 + fr;
        bf16_t* mk = (bf16_t*)(ws + W_MK); bf16_t* mvt = (bf16_t*)(ws + W_MVT);
        float* op0 = out + (pn == 0 ? O_MKP : O_MVP);
#pragma unroll
        for (int ai = 0; ai < 2; ++ai)
#pragma unroll
            for (int m = 0; m < 4; ++m) {
                const int row = rbase + ai * 128 + m * 16;
#pragma unroll
                for (int bj = 0; bj < 2; ++bj)
#pragma unroll
                    for (int n = 0; n < 2; ++n) {
                        const f32x4 v = acc[ai][bj][m][n];
                        const int col = 128 * bj + 32 * wc + 16 * n + 4 * fq;
                        *(f32x4*)(op0 + (size_t)row * 256 + col) = v;
                        if (pn == 0) st_bf16x4(mk + (size_t)row * 256 + col, v);
                        else { const int m_ = row & 255, kk_ = m_ & 31;
                               bf16_t* tp = mvt + ((((size_t)(row >> 8) * 8 + (m_ >> 5)) * 4 + (col >> 6)) * 64 + (col & 63)) * 32 + 8 * ((kk_ >> 2) & 3) + 4 * (kk_ >> 4) + (kk_ & 3);
                               tp[0] = f2bf(v[0]); tp[32] = f2bf(v[1]); tp[64] = f2bf(v[2]); tp[96] = f2bf(v[3]); }
                    }
            }
    }
};
struct EpiOut {
    static constexpr bool PERM = false, AFTER_DRAIN = false;
    const float* xp; const float* xs; float* out;
    DI void operator()(const f32x4 (&acc)[2][2][4][2], const pg8::Unit& u, int wr, int wc, int fr, int fq) const {
        const int rbase = u.pm * 256 + wr * 64 + fr, cbase = u.pn * 256 + wc * 32 + 4 * fq;
#pragma unroll
        for (int ai = 0; ai < 2; ++ai)
#pragma unroll
            for (int m = 0; m < 4; ++m) {
                const int row = rbase + ai * 128 + m * 16;
                const float* xr; float* orow;
                if (row < MP) { xr = xp + (size_t)row * DM; orow = out + O_YP + (size_t)row * DM; }
                else if (row < MP + NDB) { xr = xs + (size_t)(row - MP) * DM; orow = out + O_YS + (size_t)(row - MP) * DM; }
                else continue;
#pragma unroll
                for (int bj = 0; bj < 2; ++bj)
#pragma unroll
                    for (int n = 0; n < 2; ++n) { const int col = cbase + bj * 128 + n * 16; *(f32x4*)(orow + col) = acc[ai][bj][m][n] + *(const f32x4*)(xr + col); }
            }
    }
};
DI void p0_prologue(const Params& p, LAS3 unsigned char* lds) {
    const int tid = threadIdx.x, lane = tid & 63, wv = tid >> 6;
    unsigned char* ws = p.ws;
    {
        const int rstep = gridDim.x * 16, rend = MROWS + MMEM;
        int r0 = (blockIdx.x * 8 + wv) * 2;
        auto row_src = [&](int r) -> const float* {
            r = r < rend ? r : rend - 1;
            if (r < MP) return p.x_prompt + (size_t)r * DM;
            if (r < MP + NDB) return p.x_sample + (size_t)(r - MP) * DM;
            if (r < MROWS) return p.x_prompt;
            return p.mem_prompt + (size_t)(r - MROWS) * DM;
        };
        f32x4 v[2][4], vn[2][4];
#pragma unroll
        for (int e = 0; e < 2; ++e) { const float* s = row_src(r0 + e);
#pragma unroll
            for (int i = 0; i < 4; ++i) v[e][i] = *(const f32x4*)(s + i * 256 + lane * 4); }
        for (; r0 < rend; r0 += rstep) {
#pragma unroll
            for (int e = 0; e < 2; ++e) { const float* s = row_src(r0 + rstep + e);
#pragma unroll
                for (int i = 0; i < 4; ++i) vn[e][i] = *(const f32x4*)(s + i * 256 + lane * 4); }
#pragma unroll
            for (int e = 0; e < 2; ++e) {
                const int r = r0 + e;
                const bool pad = (r >= MP + NDB && r < MROWS);
                const float* g = r < MROWS ? p.norm_in : p.mem_norm;
                bf16_t* dst = r < MROWS ? (bf16_t*)(ws + W_XN) + (size_t)r * DM : (bf16_t*)(ws + W_MEMN) + (size_t)(r - MROWS) * DM;
                float ss = 0.f;
#pragma unroll
                for (int i = 0; i < 4; ++i) ss += v[e][i][0] * v[e][i][0] + v[e][i][1] * v[e][i][1] + v[e][i][2] * v[e][i][2] + v[e][i][3] * v[e][i][3];
                ss = wsum64(ss);
                const float rstd = pad ? 0.f : rsqrtf(ss * (1.f / DM) + 1e-6f);
#pragma unroll
                for (int i = 0; i < 4; ++i) { const f32x4 gv = *(const f32x4*)(g + i * 256 + lane * 4); st_bf16x4(dst + i * 256 + lane * 4, v[e][i] * rstd * gv); }
            }
#pragma unroll
            for (int e = 0; e < 2; ++e)
#pragma unroll
                for (int i = 0; i < 4; ++i) v[e][i] = vn[e][i];
        }
    }
    for (int e = blockIdx.x * NTHREADS + tid; e < 2049 * 32; e += gridDim.x * NTHREADS) {
        const int pi = e >> 5, f = e & 31;
        const float inv = powf(10000.0f, -(float)(2 * f) / 64.0f);
        const float ang = (float)(pi == 2048 ? 16384 : pi) * inv;
        float sn, cs; sincosf(ang, &sn, &cs);
        ((f32x2*)(ws + W_ROPE))[e] = (f32x2){cs, sn};
    }
    LAS3 float* tl = (LAS3 float*)lds;
    {
        auto tile_load = [&](int tile, float (&wr)[8]) {
            tile = tile < 1280 ? tile : 1279;
            int which, t2, ld; const float* W;
            if (tile < 896) { which = 0; t2 = tile; W = p.w_in; ld = DIN; }
            else if (tile < 1024) { which = 1; t2 = tile - 896; W = p.w_mem_kv; ld = 512; }
            else { which = 2; t2 = tile - 1024; W = p.w_out; ld = 1024; }
            const int nt = t2 >> 4, kt = t2 & 15;
            const int nn = tid & 63, kk0 = tid >> 6; const int np = nt * 64 + nn; int sc = which == 0 ? in_src(np) : np;
            const bool zero = sc < 0; sc = zero ? 0 : sc;
#pragma unroll
            for (int i = 0; i < 8; ++i) { const float w = W[(size_t)(kt * 64 + kk0 + 8 * i) * ld + sc]; wr[i] = zero ? 0.f : w; }
        };
        float wr[8], wn[8];
        tile_load(blockIdx.x, wr);
        for (int tile = blockIdx.x; tile < 1280; tile += gridDim.x) {
            bf16_t* dst; int t2;
            if (tile < 896) { t2 = tile; dst = (bf16_t*)(ws + W_WTIN); }
            else if (tile < 1024) { t2 = tile - 896; dst = (bf16_t*)(ws + W_WTMEM); }
            else { t2 = tile - 1024; dst = (bf16_t*)(ws + W_WTOUT); }
            const int nt = t2 >> 4, kt = t2 & 15;
            { const int nn = tid & 63, kk0 = tid >> 6;
#pragma unroll
              for (int i = 0; i < 8; ++i) tl[(kk0 + 8 * i) * 65 + nn] = wr[i]; }
            __syncthreads();
            tile_load(tile + gridDim.x, wn);
            { const int kk = tid & 63, nn0 = tid >> 6;
#pragma unroll
              for (int i = 0; i < 8; ++i) { const int n = nn0 + 8 * i; dst[(size_t)(nt * 64 + n) * 1024 + kt * 64 + kk] = f2bf(tl[kk * 65 + n]); } }
            __syncthreads();
#pragma unroll
            for (int i = 0; i < 8; ++i) wr[i] = wn[i];
        }
    }
}

DI void cnt_ge(unsigned& c, unsigned key, unsigned cand) { asm volatile("v_cmp_ge_u32 vcc, %1, %2\n\tv_addc_co_u32 %0, vcc, 0, %0, vcc" : "+v"(c) : "v"(key), "v"(cand) : "vcc"); }
DI void cnt_gt(unsigned& c, unsigned key, unsigned cand) { asm volatile("v_cmp_gt_u32 vcc, %1, %2\n\tv_addc_co_u32 %0, vcc, 0, %0, vcc" : "+v"(c) : "v"(key), "v"(cand) : "vcc"); }
DI void cnt_eq_lt(unsigned& c, unsigned key, unsigned T, unsigned idx, unsigned cand) {
    unsigned tmp;
    asm volatile("v_cmp_eq_u32 vcc, %2, %3\n\tv_cndmask_b32 %1, -1, %4, vcc\n\tv_cmp_lt_u32 vcc, %1, %5\n\tv_addc_co_u32 %0, vcc, 0, %0, vcc" : "+v"(c), "=&v"(tmp) : "v"(key), "v"(T), "v"(idx), "v"(cand) : "vcc"); }
DI unsigned grp_count16(unsigned c, LAS3 unsigned* CNT, int& it, int fr, int lane) {
    c += __shfl_xor(c, 16); c += __shfl_xor(c, 32);
    LAS3 unsigned* cur = CNT + (it % 3) * 16;
    if (lane < 16) lds_add(cur + fr, c);
    __syncthreads();
    const unsigned tot = cur[fr];
    if (threadIdx.x < 16) CNT[((it + 2) % 3) * 16 + threadIdx.x] = 0u;
    ++it; return tot;
}
DI unsigned blk_count(unsigned c, LAS3 unsigned* CNT, int& it, int lane) {
    c += __shfl_xor(c, 1); c += __shfl_xor(c, 2); c += __shfl_xor(c, 4); c += __shfl_xor(c, 8); c += __shfl_xor(c, 16); c += __shfl_xor(c, 32);
    LAS3 unsigned* cur = CNT + (it % 3) * 16;
    if (lane == 0) lds_add(cur, c);
    __syncthreads();
    const unsigned tot = cur[0];
    if (threadIdx.x == 0) CNT[((it + 2) % 3) * 16] = 0u;
    ++it; return tot;
}

template <bool MASKED>
DI void attn32(const bf16_t* Q, int ldq, const bf16_t* K, int ldk, const bf16_t* Vt, int ldv, int nkb, const LAS3 unsigned* mask, int fr, int fq,
               f32x4 (&o)[4][2], float (&linv)[2]) {
    bf16x8 qf[2][2];
#pragma unroll
    for (int qt = 0; qt < 2; ++qt)
#pragma unroll
        for (int ks = 0; ks < 2; ++ks) qf[qt][ks] = *(const bf16x8*)(Q + (size_t)(16 * qt + fr) * ldq + ks * 32 + fq * 8);
    float m[2] = {NEG_INF, NEG_INF}, l[2] = {0.f, 0.f};
    const f32x4 zero = {0.f, 0.f, 0.f, 0.f};
#pragma unroll
    for (int dt = 0; dt < 4; ++dt) { o[dt][0] = zero; o[dt][1] = zero; }
    const bf16_t* kl = K + (size_t)fr * ldk + fq * 8;
#ifdef BROKEN_VT
    const bf16_t* vl = Vt + fr * 32 + 8 * ((fq + 1) & 3);
#else
    const bf16_t* vl = Vt + fr * 32 + 8 * fq;
#endif
    bf16x8 kfA[2][2], kfB[2][2], vA[4], vB[4];
#define ATT_LOAD(KF, VF, kb_) do { \
        _Pragma("unroll") for (int i2 = 0; i2 < 2; ++i2) _Pragma("unroll") for (int ks = 0; ks < 2; ++ks) KF[i2][ks] = *(const bf16x8*)(kl + (size_t)(32 * (kb_) + 16 * i2) * ldk + ks * 32); \
        _Pragma("unroll") for (int dt = 0; dt < 4; ++dt) VF[dt] = *(const bf16x8*)(vl + (size_t)(kb_) * ldv + 512 * dt); } while (0)
#define ATT_COMPUTE(KF, VF, kb_) do { \
        _Pragma("unroll") for (int qt = 0; qt < 2; ++qt) { \
            f32x4 s0 = mfma16(KF[0][0], qf[qt][0], zero); s0 = mfma16(KF[0][1], qf[qt][1], s0); \
            f32x4 s1 = mfma16(KF[1][0], qf[qt][0], zero); s1 = mfma16(KF[1][1], qf[qt][1], s1); \
            if (MASKED) { const unsigned mw = mask[(16 * qt + fr) * 65 + (kb_)]; const unsigned b0 = mw >> (2 * fq), b1 = mw >> (8 + 2 * fq); \
                _Pragma("unroll") for (int r = 0; r < 4; ++r) { const int sh_ = (r >> 1) + 16 * (r & 1); s0[r] = ((b0 >> sh_) & 1u) ? s0[r] : NEG_INF; s1[r] = ((b1 >> sh_) & 1u) ? s1[r] : NEG_INF; } } \
            float mx = fmaxf(fmaxf(fmaxf(s0[0], s0[1]), fmaxf(s0[2], s0[3])), fmaxf(fmaxf(s1[0], s1[1]), fmaxf(s1[2], s1[3]))); \
            mx = fmaxf(mx, __shfl_xor(mx, 16)); mx = fmaxf(mx, __shfl_xor(mx, 32)); \
            const float mn = fmaxf(m[qt], mx), ms = (mn == NEG_INF) ? 0.f : mn; \
            const float alpha = __builtin_amdgcn_exp2f(m[qt] - ms); \
            f32x4 p0, p1; \
            _Pragma("unroll") for (int r = 0; r < 4; ++r) { p0[r] = __builtin_amdgcn_exp2f(s0[r] - ms); p1[r] = __builtin_amdgcn_exp2f(s1[r] - ms); } \
            l[qt] = l[qt] * alpha + ((p0[0] + p0[1]) + (p0[2] + p0[3])) + ((p1[0] + p1[1]) + (p1[2] + p1[3])); \
            m[qt] = mn; \
            u32x4 pw; pw.x = cvtpk(p0[0], p0[1]); pw.y = cvtpk(p0[2], p0[3]); pw.z = cvtpk(p1[0], p1[1]); pw.w = cvtpk(p1[2], p1[3]); \
            const bf16x8 pf = __builtin_bit_cast(bf16x8, pw); \
            if (!__all(alpha == 1.f)) { _Pragma("unroll") for (int dt = 0; dt < 4; ++dt) o[dt][qt] = o[dt][qt] * alpha; }     \
            _Pragma("unroll") for (int dt = 0; dt < 4; ++dt) o[dt][qt] = mfma16(VF[dt], pf, o[dt][qt]); } } while (0)
    ATT_LOAD(kfA, vA, 0);
    const int last = nkb - 1;
    for (int kb = 0; kb < nkb; kb += 2) {
        ATT_LOAD(kfB, vB, kb + 1);
        ATT_COMPUTE(kfA, vA, kb);
        { const int k2 = kb + 2 < last ? kb + 2 : last; ATT_LOAD(kfA, vA, k2); }
        ATT_COMPUTE(kfB, vB, kb + 1);
    }
#undef ATT_LOAD
#undef ATT_COMPUTE
#pragma unroll
    for (int qt = 0; qt < 2; ++qt) { float lt = l[qt]; lt += __shfl_xor(lt, 16); lt += __shfl_xor(lt, 32); linv[qt] = 1.f / lt; }
}
DI void attn_store(const f32x4 (&o)[4][2], const float (&linv)[2], const bf16_t* gate  , bf16_t* mix  , int fr, int fq) {
#pragma unroll
    for (int qt = 0; qt < 2; ++qt)
#pragma unroll
        for (int dt = 0; dt < 4; ++dt) {
            const size_t row = 16 * qt + fr; const int col = 16 * dt + 4 * fq;
            const u32x2 gw = *(const u32x2*)(gate + row * 256 + col);
            f32x4 v = o[dt][qt] * linv[qt];
            v[0] *= __uint_as_float(gw.x << 16); v[1] *= __uint_as_float(gw.x & 0xffff0000u); v[2] *= __uint_as_float(gw.y << 16); v[3] *= __uint_as_float(gw.y & 0xffff0000u);
            st_bf16x4(mix + row * 1024 + col, v);
        }
}

constexpr int DS_MASK = 0, DS_PKT = 16640, PKT_LD = 2052, DS_CNT = 147968;
typedef unsigned short u16x2 __attribute__((ext_vector_type(2)));
DI unsigned pk_cnt_ge(unsigned acc, unsigned kpair, unsigned cm1, unsigned ones) {
    unsigned t;
    asm("v_pk_sub_u16 %1, %2, %3 clamp\n\tv_pk_min_u16 %1, %1, %4\n\tv_pk_add_u16 %0, %0, %1" : "+v"(acc), "=&v"(t) : "v"(kpair), "v"(cm1), "v"(ones));
    return acc;
}
DI void select_bitwise(const unsigned (&key)[16][4], int lbase, LAS3 unsigned* CNT, int& it, int fr, int lane, unsigned& T, int& Xrel) {
    bool fin = false;
    T = 0u; Xrel = 0x7fffffff;
    for (int bit = 31; bit >= 0; --bit) {
        const unsigned cand = T | (1u << bit);
        unsigned c = 0;
#pragma unroll
        for (int n = 0; n < 16; ++n)
#pragma unroll
            for (int r = 0; r < 4; ++r) cnt_ge(c, key[n][r], cand);
        const unsigned tot = grp_count16(c, CNT, it, fr, lane);
        if (!fin && tot >= 256u) { T = cand; fin = (tot == 256u); }
        if (__all(fin)) break;
    }
    if (!__all(fin)) {
        unsigned c = 0;
#pragma unroll
        for (int n = 0; n < 16; ++n)
#pragma unroll
            for (int r = 0; r < 4; ++r) cnt_gt(c, key[n][r], T);
        const unsigned cgt = grp_count16(c, CNT, it, fr, lane);
        const unsigned need = 256u - cgt;
        unsigned Xl = 0u;
        for (int bit = 10; bit >= 0; --bit) {
            const unsigned cand = Xl | (1u << bit);
            const int crel = (int)cand - lbase;
            c = 0;
#pragma unroll
            for (int n = 0; n < 16; ++n) { const int crn = crel - 128 * n;
#pragma unroll
                for (int r = 0; r < 4; ++r) c += (key[n][r] == T && r < crn) ? 1u : 0u; }
            const unsigned tot = grp_count16(c, CNT, it, fr, lane);
            if (tot < need) Xl = cand;
        }
        if (!fin) Xrel = (int)Xl - lbase;
    }
}
DI unsigned pk_flag_ge(unsigned kpair, unsigned cm1, unsigned ones) {
    unsigned t;
    asm("v_pk_sub_u16 %0, %1, %2 clamp\n\tv_pk_min_u16 %0, %0, %3" : "=&v"(t) : "v"(kpair), "v"(cm1), "v"(ones));
    return t;
}
DI unsigned pk_max(unsigned a, unsigned b2) { unsigned t; asm("v_pk_max_u16 %0, %1, %2" : "=v"(t) : "v"(a), "v"(b2)); return t; }
DI unsigned hsum32(unsigned x) {
    x += __builtin_amdgcn_update_dpp(0u, x, 0xB1, 0xF, 0xF, false); x += __builtin_amdgcn_update_dpp(0u, x, 0x4E, 0xF, 0xF, false);
    x += __builtin_amdgcn_update_dpp(0u, x, 0x141, 0xF, 0xF, false); x += __builtin_amdgcn_update_dpp(0u, x, 0x140, 0xF, 0xF, false);
    const auto r = __builtin_amdgcn_permlane16_swap(x, x, false, false); return r[0] + r[1];
}
DI unsigned hmax32(unsigned x) {
    x = max(x, (unsigned)__builtin_amdgcn_update_dpp(0u, x, 0xB1, 0xF, 0xF, false)); x = max(x, (unsigned)__builtin_amdgcn_update_dpp(0u, x, 0x4E, 0xF, 0xF, false));
    x = max(x, (unsigned)__builtin_amdgcn_update_dpp(0u, x, 0x141, 0xF, 0xF, false)); x = max(x, (unsigned)__builtin_amdgcn_update_dpp(0u, x, 0x140, 0xF, 0xF, false));
    const auto r = __builtin_amdgcn_permlane16_swap(x, x, false, false); return max(r[0], r[1]);
}
DI unsigned pk_count32(const unsigned (&rk)[32], unsigned cm1, unsigned ones, int nq) {
    unsigned a0 = 0u, a1 = 0u;
#pragma unroll
    for (int k = 0; k < 8; k += 2) { a0 = pk_cnt_ge(a0, rk[k], cm1, ones); a1 = pk_cnt_ge(a1, rk[k + 1], cm1, ones); }
    if (nq > 1) {
#pragma unroll
        for (int k = 8; k < 16; k += 2) { a0 = pk_cnt_ge(a0, rk[k], cm1, ones); a1 = pk_cnt_ge(a1, rk[k + 1], cm1, ones); }
        if (nq > 2) {
#pragma unroll
            for (int k = 16; k < 24; k += 2) { a0 = pk_cnt_ge(a0, rk[k], cm1, ones); a1 = pk_cnt_ge(a1, rk[k + 1], cm1, ones); }
            if (nq > 3) {
#pragma unroll
                for (int k = 24; k < 32; k += 2) { a0 = pk_cnt_ge(a0, rk[k], cm1, ones); a1 = pk_cnt_ge(a1, rk[k + 1], cm1, ones); }
            }
        }
    }
    return (a0 & 0xffffu) + (a0 >> 16) + (a1 & 0xffffu) + (a1 >> 16);
}
DI void dsa_unit(const Params& p, LAS3 unsigned char* lds, int b, int j TARGS) {
    int tid = threadIdx.x; asm volatile("" : "+v"(tid));
    const int lane0 = tid & 63, w = __builtin_amdgcn_readfirstlane(tid >> 6);
    unsigned char* ws = p.ws;
    LAS3 unsigned* MASK = (LAS3 unsigned*)(lds + DS_MASK);
    LAS3 unsigned* PKT = (LAS3 unsigned*)(lds + DS_PKT);
    const bf16_t* IQ = (const bf16_t*)(ws + W_IQ); const bf16_t* IK = (const bf16_t*)(ws + W_IK); const float* IW = (const float*)(ws + W_IW);
    const int q0 = 64 * j;
    const f32x4 zero = {0.f, 0.f, 0.f, 0.f};
#ifdef CHECK_SEL
    LAS3 unsigned* CNT = (LAS3 unsigned*)(lds + DS_CNT); int it = 0;
    if (tid < 48) CNT[tid] = 0u;
    __syncthreads();
#endif
    TBEG(30);
    bf16x8 bqn[4][2]; f32x4 wqn;
    { const size_t qr0 = (size_t)b * SEQ + q0 + (lane0 & 15);
#pragma unroll
      for (int h = 0; h < 4; ++h)
#pragma unroll
          for (int ks = 0; ks < 2; ++ks) bqn[h][ks] = *(const bf16x8*)(IQ + qr0 * 256 + h * 64 + ks * 32 + (lane0 >> 4) * 8);
      wqn = *(const f32x4*)(IW + qr0 * 4); }
#pragma unroll 1
    for (int qg = 0; qg < 4; ++qg) {
        TBEG(32);
        int lane = lane0; asm volatile("" : "+v"(lane));
        const int fr = lane & 15, fq = lane >> 4;
        const int tq = q0 + 16 * qg + fr; const size_t qrow = (size_t)b * SEQ + tq;
        const int ntile = 4 * j + qg + 1;
        const int nloc = ntile > w ? (ntile - w + 7) >> 3 : 0;
        const bool selecting = q0 + 16 * qg >= 256;
        {
            bf16x8 bq[4][2];
#pragma unroll
            for (int h = 0; h < 4; ++h)
#pragma unroll
                for (int ks = 0; ks < 2; ++ks) bq[h][ks] = bqn[h][ks];
            const f32x4 wq = wqn;
            float Lh[4];
#pragma unroll
            for (int h = 0; h < 4; ++h) Lh[h] = wq[h] < 0.f ? NEG_INF : -NEG_INF;
            const char* tb = (const char*)IK + ((size_t)b * SEQ + 16 * w) * 128 + (unsigned)(fr * 128 + fq * 16);
            LAS3 unsigned* krow = PKT + fr * PKT_LD + 16 * w + 4 * fq;
            const int lim0 = tq - (16 * w + 4 * fq);
#define DSA_TILE(A0, A1, nn) do { \
                f32x4 sc = zero; \
                _Pragma("unroll") for (int h = 0; h < 4; ++h) { f32x4 d = mfma16(A0, bq[h][0], zero); d = mfma16(A1, bq[h][1], d); d = d * wq[h]; \
                    _Pragma("unroll") for (int r = 0; r < 4; ++r) sc[r] += __builtin_amdgcn_fmed3f(d[r], 0.f, Lh[h]); } \
                { const char* t2_ = tb + (size_t)((nn) + 2 < nloc ? (nn) + 2 : nloc - 1) * 16384; A0 = *(const bf16x8*)t2_; A1 = *(const bf16x8*)(t2_ + 64); } \
                const int limn = lim0 - 128 * (nn);                   \
                u32x4 kv; \
                _Pragma("unroll") for (int r = 0; r < 4; ++r) { const unsigned u = __float_as_uint(sc[r] + 0.f); const unsigned k = u ^ ((unsigned)((int)u >> 31) | 0x80000000u);   \
                    kv[r] = (r <= limn) ? k : 0u; } \
                *(LAS3 u32x4*)(krow + 128 * (nn)) = kv; } while (0)
            if (nloc > 0) {
                bf16x8 a0 = *(const bf16x8*)tb, a1 = *(const bf16x8*)(tb + 64);
                const char* t1 = tb + (size_t)(1 < nloc ? 1 : 0) * 16384;
                bf16x8 b0 = *(const bf16x8*)t1, b1 = *(const bf16x8*)(t1 + 64);
#pragma unroll 1
                for (int n = 0; n < nloc; n += 2) {
                    DSA_TILE(a0, a1, n);
                    if (n + 1 < nloc) DSA_TILE(b0, b1, n + 1);
                }
            }
#undef DSA_TILE
        }
        TEND(32); TBEG(33);
        __syncthreads();
        { const size_t qrn = qrow + (qg < 3 ? 16 : 0);
#pragma unroll
          for (int h = 0; h < 4; ++h)
#pragma unroll
              for (int ks = 0; ks < 2; ++ks) bqn[h][ks] = *(const bf16x8*)(IQ + qrn * 256 + h * 64 + ks * 32 + fq * 8);
          wqn = *(const f32x4*)(IW + qrn * 4); }
        {
            const int hh = lane >> 5, pos = lane & 31, oq = 2 * w + hh;
            const unsigned nkeys = 16u * (unsigned)ntile;
            const int nq = (int)((nkeys + 511u) >> 9);
            const LAS3 unsigned* orow = PKT + oq * PKT_LD + 2 * pos;
            unsigned ones = 0x00010001u; asm volatile("" : "+v"(ones));
            unsigned Tfull = 1u, X = 0xffffffffu;
            if (selecting) {
                unsigned rk[32];
                unsigned mx = 0u;
#define RK_FILL(k0) do { _Pragma("unroll") for (int k = (k0); k < (k0) + 8; ++k) { const u32x2 kk = *(const LAS3 u32x2*)(orow + 64 * k); \
                        rk[k] = (2u * (unsigned)(pos + 32 * k) < nkeys) ? __builtin_amdgcn_perm(kk.y, kk.x, 0x07060302u) : 0u; mx = pk_max(mx, rk[k]); } } while (0)
                RK_FILL(0);
                if (nq > 1) { RK_FILL(8); if (nq > 2) { RK_FILL(16); if (nq > 3) { RK_FILL(24); } } }
#undef RK_FILL
                const unsigned kmax = hmax32(max(mx & 0xffffu, mx >> 16));
                unsigned T16 = 0u, cabove = 0u; bool exact = false;
                {
                    unsigned ub = 0x10000u;
#pragma unroll 1
                    for (int bit = 15; bit >= 0; --bit) {
                        const unsigned cand = T16 | (1u << bit);
                        if (__all(cand > kmax)) { ub = cand; continue; }
                        const unsigned tot = hsum32(pk_count32(rk, (cand - 1u) * 0x00010001u, ones, nq));
                        if (tot >= 256u) T16 = cand; else { ub = cand; cabove = tot; }
                    }
                    (void)ub;
                }
                const unsigned need = 256u - cabove;
#define RK_LOW(k0) do { _Pragma("unroll") for (int k = (k0); k < (k0) + 8; ++k) { const u32x2 kk = *(const LAS3 u32x2*)(orow + 64 * k); const bool in = 2u * (unsigned)(pos + 32 * k) < nkeys; \
                        const unsigned lo0 = (in && (kk.x >> 16) == T16) ? (kk.x & 0xffffu) : 0u, lo1 = (in && (kk.y >> 16) == T16) ? (kk.y & 0xffffu) : 0u; rk[k] = lo0 | (lo1 << 16); } } while (0)
                RK_LOW(0);
                if (nq > 1) { RK_LOW(8); if (nq > 2) { RK_LOW(16); if (nq > 3) { RK_LOW(24); } } }
#undef RK_LOW
                unsigned Tlo = 0u;
#pragma unroll 1
                for (int bit = 15; bit >= 0; --bit) {
                    const unsigned cand = Tlo | (1u << bit);
                    const unsigned tot = hsum32(pk_count32(rk, (cand - 1u) * 0x00010001u, ones, nq));
                    if (!exact && tot >= need) { Tlo = cand; exact = (tot == need); }
                    if (__all(exact)) break;
                }
                Tfull = (T16 << 16) | Tlo;
                if (!__all(exact)) {
                    unsigned cgt = 0u, ceq = 0u;
#pragma unroll 1
                    for (int k = 0; k < 8 * nq; ++k) { const u32x2 kk = *(const LAS3 u32x2*)(orow + 64 * k); const bool in = 2u * (unsigned)(pos + 32 * k) < nkeys;
                        cgt += (in && kk.x > Tfull && (kk.x >> 16) == T16 ? 1u : 0u) + (in && kk.y > Tfull && (kk.y >> 16) == T16 ? 1u : 0u); }
                    (void)ceq;
                    const unsigned needt = need - hsum32(cgt);
                    unsigned Xl = 0u;
#pragma unroll 1
                    for (int bit = 10; bit >= 0; --bit) {
                        const unsigned cx = Xl | (1u << bit);
                        unsigned c = 0u;
#pragma unroll 1
                        for (int k = 0; k < 8 * nq; ++k) { const u32x2 kk = *(const LAS3 u32x2*)(orow + 64 * k); const unsigned i0 = 2u * (unsigned)(pos + 32 * k);
                            c += (i0 < nkeys && kk.x == Tfull && i0 < cx ? 1u : 0u) + (i0 < nkeys && kk.y == Tfull && i0 + 1u < cx ? 1u : 0u); }
                        if (hsum32(c) < needt) Xl = cx;
                    }
                    if (!exact) X = Xl;
                }
            }
            LAS3 unsigned* mrow = MASK + (16 * qg + oq) * 65 + (pos >> 4);
            const unsigned sh = 32u * hh + (pos & 16);
            if (__all(X == 0xffffffffu)) {
                int k = 0;
#pragma unroll 1
                for (; k + 4 <= j; k += 4) {
                    u32x2 kk[4];
#pragma unroll
                    for (int u = 0; u < 4; ++u) kk[u] = *(const LAS3 u32x2*)(orow + 64 * (k + u));
                    unsigned wv[4];
#pragma unroll
                    for (int u = 0; u < 4; ++u) { const unsigned long long blo = __ballot(kk[u].x >= Tfull), bhi = __ballot(kk[u].y >= Tfull);
                        wv[u] = ((unsigned)(blo >> sh) & 0xffffu) | ((unsigned)(bhi >> sh) << 16); }
                    if ((pos & 15) == 0) {
#pragma unroll
                        for (int u = 0; u < 4; ++u) mrow[2 * (k + u)] = wv[u]; }
                }
#pragma unroll 1
                for (; k < j; ++k) {
                    const u32x2 kk = *(const LAS3 u32x2*)(orow + 64 * k);
                    const unsigned long long blo = __ballot(kk.x >= Tfull), bhi = __ballot(kk.y >= Tfull);
                    const unsigned wv = ((unsigned)(blo >> sh) & 0xffffu) | ((unsigned)(bhi >> sh) << 16);
                    if ((pos & 15) == 0) mrow[2 * k] = wv;
                }
                {
                    const u32x2 kk = *(const LAS3 u32x2*)(orow + 64 * j); const bool in = 2u * (unsigned)(pos + 32 * j) < nkeys;
                    const unsigned long long blo = __ballot(in && kk.x >= Tfull), bhi = __ballot(in && kk.y >= Tfull);
                    const unsigned wv = ((unsigned)(blo >> sh) & 0xffffu) | ((unsigned)(bhi >> sh) << 16);
                    if ((pos & 15) == 0) mrow[2 * j] = wv;
                }
            } else {
#pragma unroll 1
                for (int k = 0; k <= j; ++k) {
                    const u32x2 kk = *(const LAS3 u32x2*)(orow + 64 * k); const unsigned i0 = 2u * (unsigned)(pos + 32 * k);
                    const bool s0 = i0 < nkeys && (kk.x > Tfull || (kk.x == Tfull && i0 <= X)), s1 = i0 < nkeys && (kk.y > Tfull || (kk.y == Tfull && i0 + 1u <= X));
                    const unsigned long long blo = __ballot(s0), bhi = __ballot(s1);
                    const unsigned wv = ((unsigned)(blo >> sh) & 0xffffu) | ((unsigned)(bhi >> sh) << 16);
                    if ((pos & 15) == 0) mrow[2 * k] = wv;
                }
            }
        }
        TEND(33);
        __syncthreads();
#ifdef CHECK_SEL
        if (selecting) {
            const int lbase = 16 * w + 4 * fq;
            unsigned key[16][4];
#pragma unroll
            for (int n = 0; n < 16; ++n)
#pragma unroll
                for (int r = 0; r < 4; ++r) key[n][r] = (n < nloc) ? PKT[fr * PKT_LD + lbase + 128 * n + r] : 0u;
            unsigned T2; int X2; select_bitwise(key, lbase, CNT, it, fr, lane, T2, X2);
            bool bad = false;
#pragma unroll
            for (int n = 0; n < 16; ++n) if (n < nloc) { const int x2 = X2 - 128 * n;
#pragma unroll
                for (int r = 0; r < 4; ++r) { const unsigned idx = (unsigned)(lbase + 128 * n + r); const unsigned mw = MASK[(16 * qg + fr) * 65 + (idx >> 5)];
                    const bool s2 = key[n][r] > T2 || (key[n][r] == T2 && r <= x2); bad |= (s2 != (((mw >> (((idx & 31u) >> 1) + 16u * (idx & 1u))) & 1u) != 0u)); } }
            if (__any(bad) && lane == 0) atomicAdd((unsigned*)(ws + CW_CHK), 1u);
            if (lane == 0 && w == 0) atomicAdd((unsigned*)(ws + CW_CHK + 4), 1u);
            __syncthreads();
        }
#endif
    }
    TEND(30); TBEG(31);
    {
        const int h = w & 3, hf = w >> 2, fr = lane0 & 15, fq = lane0 >> 4;
        const size_t qrow0 = (size_t)b * SEQ + q0 + 32 * hf;
        f32x4 o[4][2]; float linv[2];
        attn32<true>((const bf16_t*)(ws + W_DQ) + qrow0 * 256 + h * 64, 256, (const bf16_t*)(ws + W_DK) + (size_t)b * SEQ * 256 + h * 64, 256,
                     (const bf16_t*)(ws + W_DVT) + ((size_t)b * 64 * 4 + h) * 2048, 4 * 2048, 2 * j + 2  , MASK + 32 * hf * 65, fr, fq, o, linv);
        attn_store(o, linv, (const bf16_t*)(ws + W_DG) + qrow0 * 256 + h * 64, (bf16_t*)(ws + W_MIX) + qrow0 * 1024 + 512 + h * 64, fr, fq);
    }
    __syncthreads();
    TEND(31);
}
DI void mem_unit(const Params& p, int n) {
    const int tid = threadIdx.x, lane = tid & 63, w = __builtin_amdgcn_readfirstlane(tid >> 6), fr = lane & 15, fq = lane >> 4;
    unsigned char* ws = p.ws;
    const int h = w & 3, hf = w >> 2;
    const size_t qrow0 = (size_t)n * 64 + 32 * hf; const int b = n >> 5;
    f32x4 o[4][2]; float linv[2];
    attn32<false>((const bf16_t*)(ws + W_MQ) + qrow0 * 256 + h * 64, 256, (const bf16_t*)(ws + W_MK) + (size_t)b * NMEM * 256 + h * 64, 256,
                  (const bf16_t*)(ws + W_MVT) + ((size_t)b * 8 * 4 + h) * 2048, 4 * 2048, 8, nullptr, fr, fq, o, linv);
    attn_store(o, linv, (const bf16_t*)(ws + W_MG) + qrow0 * 256 + h * 64, (bf16_t*)(ws + W_MIX) + qrow0 * 1024 + 768 + h * 64, fr, fq);
}
constexpr int GL_QT = 0, GL_KT = 9216, GL_KPT = 18432, GL_VT = 27648, GL_SBT = 46080, GL_PM = 64512, GL_OF = 73728, GL_GTOT = 107520, GL_W2 = 109568, GL_BG = 113664, GL_DEC = 113920;
constexpr int LDP = 72;
DI void gla_unit(const Params& p, LAS3 unsigned char* lds, int b, int h) {
    const int tid = threadIdx.x, lane = tid & 63, w = __builtin_amdgcn_readfirstlane(tid >> 6), fr = lane & 15, fq = lane >> 4;
    unsigned char* ws = p.ws;
    LAS3 bf16_t* Qt = (LAS3 bf16_t*)(lds + GL_QT); LAS3 bf16_t* Kt = (LAS3 bf16_t*)(lds + GL_KT); LAS3 bf16_t* KpT = (LAS3 bf16_t*)(lds + GL_KPT);
    LAS3 bf16_t* Vt = (LAS3 bf16_t*)(lds + GL_VT); LAS3 bf16_t* SbT = (LAS3 bf16_t*)(lds + GL_SBT); LAS3 bf16_t* Pm = (LAS3 bf16_t*)(lds + GL_PM);
    LAS3 float* Of = (LAS3 float*)(lds + GL_OF); LAS3 float* gtot = (LAS3 float*)(lds + GL_GTOT); LAS3 float* w2s = (LAS3 float*)(lds + GL_W2);
    LAS3 float* bgs = (LAS3 float*)(lds + GL_BG); LAS3 float* dec = (LAS3 float*)(lds + GL_DEC);
    const bf16_t* GQ = (const bf16_t*)(ws + W_GQ); const bf16_t* GK = (const bf16_t*)(ws + W_GK); const bf16_t* GV = (const bf16_t*)(ws + W_GV);
    const bf16_t* GG = (const bf16_t*)(ws + W_GG); const float* GLR = (const float*)(ws + W_GLR); bf16_t* MIX = (bf16_t*)(ws + W_MIX);
    for (int i = tid; i < 128 * LDP / 2; i += NTHREADS) ((LAS3 unsigned*)SbT)[i] = 0u;
    for (int i = tid; i < 16 * 64; i += NTHREADS) w2s[i] = p.w_g2[(i >> 6) * 256 + h * 64 + (i & 63)];
    if (tid < 64) bgs[tid] = p.b_g[h * 64 + tid];
    __syncthreads();
    const int d = tid & 63, tg = w;
    float wreg[16];
#pragma unroll
    for (int r = 0; r < 16; ++r) wreg[r] = w2s[r * 64 + d];
    const float bgd = bgs[d];
    const f32x4 zero = {0.f, 0.f, 0.f, 0.f};
    f32x4 Sacc[4] = {zero, zero, zero, zero};
    const int tt = w & 3, vh = w >> 2;
    for (int c = 0; c < 32; ++c) {
        const size_t rb = (size_t)b * SEQ + c * 64;
        float g8[8];
#pragma unroll
        for (int i = 0; i < 8; ++i) {
            const float* gl = vaddr(GLR + (rb + tg * 8 + i) * 16);
            float u = bgd;
#pragma unroll
            for (int r = 0; r < 16; ++r) u += gl[r] * wreg[r];
            const float g = logsigf(u) * (1.f / 16.f);
            g8[i] = (i ? g8[i - 1] : 0.f) + g;
        }
        gtot[tg * 64 + d] = g8[7];
        __syncthreads();
        float off = 0.f, blast = 0.f;
#pragma unroll
        for (int g2 = 0; g2 < 8; ++g2) { const float v = gtot[g2 * 64 + d]; off += (g2 < tg) ? v : 0.f; blast += v; }
        float kp[8];
#pragma unroll
        for (int i = 0; i < 8; ++i) {
            const int t = tg * 8 + i; const float bt = off + g8[i];
            const float q = bf2f(GQ[(rb + t) * 256 + h * 64 + d]), k = bf2f(GK[(rb + t) * 256 + h * 64 + d]);
            Qt[t * LDP + d] = f2bf(q * fexp(bt)); Kt[t * LDP + d] = f2bf(k * fexp(-bt)); kp[i] = k * fexp(blast - bt);
        }
        { u32x4 kw; kw.x = cvtpk(kp[0], kp[1]); kw.y = cvtpk(kp[2], kp[3]); kw.z = cvtpk(kp[4], kp[5]); kw.w = cvtpk(kp[6], kp[7]); *(LAS3 u32x4*)(KpT + d * LDP + tg * 8) = kw; }
        if (tg == 0) dec[d] = fexp(blast);
        { const int v = tid & 127, sg = tid >> 7; bf16_t vv[16];
#pragma unroll
          for (int i = 0; i < 16; ++i) vv[i] = GV[(rb + sg * 16 + i) * 512 + h * 128 + v];
          u32x4 a, bb; a.x = vv[0] | ((unsigned)vv[1] << 16); a.y = vv[2] | ((unsigned)vv[3] << 16); a.z = vv[4] | ((unsigned)vv[5] << 16); a.w = vv[6] | ((unsigned)vv[7] << 16);
          bb.x = vv[8] | ((unsigned)vv[9] << 16); bb.y = vv[10] | ((unsigned)vv[11] << 16); bb.z = vv[12] | ((unsigned)vv[13] << 16); bb.w = vv[14] | ((unsigned)vv[15] << 16);
          *(LAS3 u32x4*)(Vt + v * LDP + sg * 16) = a; *(LAS3 u32x4*)(Vt + v * LDP + sg * 16 + 8) = bb; }
        __syncthreads();
#pragma unroll
        for (int s2 = 0; s2 < 2; ++s2) {
            const int st = 2 * vh + s2;
            f32x4 acc = zero;
#pragma unroll
            for (int ks = 0; ks < 2; ++ks) {
                const bf16x8 a = *(const LAS3 bf16x8*)(Kt + (st * 16 + fr) * LDP + ks * 32 + fq * 8), bq = *(const LAS3 bf16x8*)(Qt + (tt * 16 + fr) * LDP + ks * 32 + fq * 8);
                acc = mfma16(a, bq, acc);
            }
            const int t = tt * 16 + fr, s0 = st * 16 + 4 * fq;
            u32x2 pw; pw.x = cvtpk(s0 <= t ? acc[0] : 0.f, s0 + 1 <= t ? acc[1] : 0.f); pw.y = cvtpk(s0 + 2 <= t ? acc[2] : 0.f, s0 + 3 <= t ? acc[3] : 0.f);
            *(LAS3 u32x2*)(Pm + t * LDP + s0) = pw;
        }
        __syncthreads();
        f32x4 oacc[4];
        {
            bf16x8 aq[2], ap[2], ak[2];
#pragma unroll
            for (int ks = 0; ks < 2; ++ks) {
                aq[ks] = *(const LAS3 bf16x8*)(Qt + (tt * 16 + fr) * LDP + ks * 32 + fq * 8);
                ap[ks] = *(const LAS3 bf16x8*)(Pm + (tt * 16 + fr) * LDP + ks * 32 + fq * 8);
                ak[ks] = *(const LAS3 bf16x8*)(KpT + (tt * 16 + fr) * LDP + ks * 32 + fq * 8);
            }
            const f32x4 dv = *(const LAS3 f32x4*)(dec + tt * 16 + 4 * fq);
#pragma unroll
            for (int jv = 0; jv < 4; ++jv) {
                const int vt = vh * 4 + jv;
                bf16x8 bs[2], bv[2];
#pragma unroll
                for (int ks = 0; ks < 2; ++ks) {
                    bs[ks] = *(const LAS3 bf16x8*)(SbT + (vt * 16 + fr) * LDP + ks * 32 + fq * 8);
                    bv[ks] = *(const LAS3 bf16x8*)(Vt + (vt * 16 + fr) * LDP + ks * 32 + fq * 8);
                }
                f32x4 oa = mfma16(aq[0], bs[0], zero); oa = mfma16(aq[1], bs[1], oa); oa = mfma16(ap[0], bv[0], oa); oa = mfma16(ap[1], bv[1], oa);
                oacc[jv] = oa;
                f32x4 sa = Sacc[jv] * dv; sa = mfma16(ak[0], bv[0], sa); sa = mfma16(ak[1], bv[1], sa);
                Sacc[jv] = sa;
            }
        }
        __syncthreads();
#pragma unroll
        for (int jv = 0; jv < 4; ++jv) {
            const int vt = vh * 4 + jv;
#pragma unroll
            for (int r = 0; r < 4; ++r) Of[(tt * 16 + 4 * fq + r) * 132 + vt * 16 + fr] = oacc[jv][r];
            u32x2 sw; sw.x = cvtpk(Sacc[jv][0], Sacc[jv][1]); sw.y = cvtpk(Sacc[jv][2], Sacc[jv][3]);
            *(LAS3 u32x2*)(SbT + (vt * 16 + fr) * LDP + tt * 16 + 4 * fq) = sw;
        }
        __syncthreads();
        {
            const int t = tid >> 3, seg = tid & 7;
            const LAS3 float* op = Of + t * 132 + seg * 16;
            f32x4 ov[4]; float ss = 0.f;
#pragma unroll
            for (int i = 0; i < 4; ++i) { ov[i] = *(const LAS3 f32x4*)(op + 4 * i); ss += ov[i][0] * ov[i][0] + ov[i][1] * ov[i][1] + ov[i][2] * ov[i][2] + ov[i][3] * ov[i][3]; }
            ss += __shfl_xor(ss, 1); ss += __shfl_xor(ss, 2); ss += __shfl_xor(ss, 4);
            const float rstd = rsqrtf(ss * (1.f / 128.f) + 1e-6f);
            const bf16_t* gp = GG + (rb + t) * 512 + h * 128 + seg * 16;
            const u32x4 g0 = *(const u32x4*)gp, g1 = *(const u32x4*)(gp + 8);
            const unsigned gw[8] = {g0.x, g0.y, g0.z, g0.w, g1.x, g1.y, g1.z, g1.w};
            unsigned ow[8];
#pragma unroll
            for (int i = 0; i < 4; ++i) {
                const f32x4 on = *(const f32x4*)(p.onorm + seg * 16 + 4 * i);
                const float y0 = ov[i][0] * rstd * on[0] * __uint_as_float(gw[2 * i] << 16), y1 = ov[i][1] * rstd * on[1] * __uint_as_float(gw[2 * i] & 0xffff0000u);
                const float y2 = ov[i][2] * rstd * on[2] * __uint_as_float(gw[2 * i + 1] << 16), y3 = ov[i][3] * rstd * on[3] * __uint_as_float(gw[2 * i + 1] & 0xffff0000u);
                ow[2 * i] = cvtpk(y0, y1); ow[2 * i + 1] = cvtpk(y2, y3);
            }
            bf16_t* mp = MIX + (rb + t) * 1024 + h * 128 + seg * 16;
            *(u32x4*)mp = (u32x4){ow[0], ow[1], ow[2], ow[3]}; *(u32x4*)(mp + 8) = (u32x4){ow[4], ow[5], ow[6], ow[7]};
        }
    }
#pragma unroll
    for (int jv = 0; jv < 4; ++jv)
#pragma unroll
        for (int r = 0; r < 4; ++r) p.out[O_GSP + ((size_t)(b * 4 + h) * 64 + tt * 16 + 4 * fq + r) * 128 + (vh * 4 + jv) * 16 + fr] = Sacc[jv][r];
    __syncthreads();
}

DI void sscore_unit(const Params& p, LAS3 unsigned char* lds, int u) {
    const int tid = threadIdx.x;
    unsigned char* ws = p.ws;
    const int b = u >> 3, pg = u & 7;
    LAS3 float* qf = (LAS3 float*)lds;
    if (tid < 256) qf[tid] = bf2f(((const bf16_t*)(ws + W_IQ))[(size_t)(MP + b) * 256 + tid]);
    __syncthreads();
    const int seg = tid & 15;
    f32x4 q[4];
#pragma unroll
    for (int h = 0; h < 4; ++h) q[h] = *(const LAS3 f32x4*)(qf + h * 64 + seg * 4);
    const f32x4 wv = *(const f32x4*)vaddr((const float*)(ws + W_IW) + (size_t)(MP + b) * 4);
    unsigned* sc = (unsigned*)(ws + W_SC) + (size_t)b * SCLD;
    const int* pt = p.page_table + b * NPAGES + pg * 16;
#define SS_LOAD(BUF, pp) do { const float* base_ = p.cache_ik + (size_t)pt[(pp) < 16 ? (pp) : 15] * 8192; \
        _Pragma("unroll") for (int i = 0; i < 4; ++i) BUF[i] = *(const f32x4*)(base_ + (size_t)(tid + 512 * i) * 4); } while (0)
#define SS_COMPUTE(BUF, pp) do { \
        _Pragma("unroll") for (int i = 0; i < 4; ++i) { const f32x4 kv = BUF[i]; float dh[4]; \
            _Pragma("unroll") for (int h = 0; h < 4; ++h) { float x = q[h][0] * kv[0] + q[h][1] * kv[1] + q[h][2] * kv[2] + q[h][3] * kv[3]; \
                x += __shfl_xor(x, 1); x += __shfl_xor(x, 2); x += __shfl_xor(x, 4); x += __shfl_xor(x, 8); dh[h] = x; } \
            const float s_ = wv[0] * fmaxf(dh[0], 0.f) + wv[1] * fmaxf(dh[1], 0.f) + wv[2] * fmaxf(dh[2], 0.f) + wv[3] * fmaxf(dh[3], 0.f); \
            if (seg == 0) __hip_atomic_store(sc + (pg * 16 + (pp)) * 128 + ((tid + 512 * i) >> 4), __float_as_uint(s_), __ATOMIC_RELAXED, __HIP_MEMORY_SCOPE_AGENT); } } while (0)
    f32x4 pa[4], pb[4];
    SS_LOAD(pa, 0); SS_LOAD(pb, 1);
#pragma unroll 1
    for (int pp = 0; pp < 16; pp += 2) {
        SS_COMPUTE(pa, pp); SS_LOAD(pa, pp + 2);
        SS_COMPUTE(pb, pp + 1); SS_LOAD(pb, pp + 3);
    }
#undef SS_LOAD
#undef SS_COMPUTE
    asm volatile("s_waitcnt vmcnt(0)" ::: "memory");
    __syncthreads();
    if (tid == 0) __hip_atomic_fetch_add((unsigned*)(ws + CW_SCNT), 1u, __ATOMIC_RELAXED, __HIP_MEMORY_SCOPE_AGENT);
}

constexpr int SA_Q = 2048, SA_S = 3072, SA_KP = 8192, SA_VP = 10240;
DI void sattend(const Params& p, LAS3 unsigned char* lds, const bf16_t* qrow  , const bf16_t* gate, bf16_t* mix) {
    const int tid = threadIdx.x, lane = tid & 63, w = tid >> 6;
    LAS3 float* qf = (LAS3 float*)(lds + SA_Q); LAS3 float* S = (LAS3 float*)(lds + SA_S);
    const float* const LAS3* kptr = (const float* const LAS3*)(lds + SA_KP); const float* const LAS3* vptr = (const float* const LAS3*)(lds + SA_VP);
    if (tid < 256) qf[tid] = bf2f(qrow[tid]);
    __syncthreads();
    {
        const int jk = tid >> 1, hp = tid & 1;
        const float* kr = kptr[jk] + hp * 128;
        float s0 = 0.f, s1 = 0.f;
#pragma unroll 4
        for (int i = 0; i < 16; ++i) {
            const f32x4 k0 = *(const f32x4*)(kr + 4 * i), k1 = *(const f32x4*)(kr + 64 + 4 * i);
            const f32x4 q0 = *(const LAS3 f32x4*)(qf + hp * 128 + 4 * i), q1 = *(const LAS3 f32x4*)(qf + hp * 128 + 64 + 4 * i);
            s0 += q0[0] * k0[0] + q0[1] * k0[1] + q0[2] * k0[2] + q0[3] * k0[3];
            s1 += q1[0] * k1[0] + q1[1] * k1[1] + q1[2] * k1[2] + q1[3] * k1[3];
        }
        S[(2 * hp) * 256 + jk] = s0; S[(2 * hp + 1) * 256 + jk] = s1;
    }
    __syncthreads();
    if (w < 4) {
        float v[4], mx = NEG_INF;
#pragma unroll
        for (int i = 0; i < 4; ++i) { v[i] = S[w * 256 + lane + 64 * i]; mx = fmaxf(mx, v[i]); }
        mx = wmax64(mx);
        float sum = 0.f;
#pragma unroll
        for (int i = 0; i < 4; ++i) { v[i] = __expf(v[i] - mx); sum += v[i]; }
        sum = wsum64(sum);
        const float inv = 1.f / sum;
#pragma unroll
        for (int i = 0; i < 4; ++i) S[w * 256 + lane + 64 * i] = v[i] * inv;
    }
    __syncthreads();
    {
        const int h = tid >> 7, dd = (tid >> 1) & 63, hf = tid & 1;
        float acc = 0.f;
#pragma unroll 4
        for (int jk = hf * 128; jk < hf * 128 + 128; ++jk) acc += S[h * 256 + jk] * vptr[jk][h * 64 + dd];
        acc += __shfl_xor(acc, 1);
        if (hf == 0) mix[h * 64 + dd] = f2bf(acc * bf2f(gate[h * 64 + dd]));
    }
    __syncthreads();
}
DI void smem_unit(const Params& p, LAS3 unsigned char* lds, int b) {
    const int tid = threadIdx.x; unsigned char* ws = p.ws;
    const float* LAS3* kptr = (const float* LAS3*)(lds + SA_KP); const float* LAS3* vptr = (const float* LAS3*)(lds + SA_VP);
    if (tid < 256) { kptr[tid] = p.cache_mem_k + ((size_t)b * NMEM + tid) * 256; vptr[tid] = p.cache_mem_v + ((size_t)b * NMEM + tid) * 256; }
    const size_t row = MP + b;
    sattend(p, lds, (const bf16_t*)(ws + W_MQ) + row * 256, (const bf16_t*)(ws + W_MG) + row * 256, (bf16_t*)(ws + W_MIX) + row * 1024 + 768);
}
DI void ssel_unit(const Params& p, LAS3 unsigned char* lds, int b) {
    const int tid = threadIdx.x, lane = tid & 63, w = tid >> 6; unsigned char* ws = p.ws;
    LAS3 unsigned* CNT = (LAS3 unsigned*)lds;
    LAS3 unsigned* wsum = (LAS3 unsigned*)(lds + 256);
    LAS3 float* newsc = (LAS3 float*)(lds + 320);
    LAS3 int* list = (LAS3 int*)(lds + 512);
    const float* LAS3* kptr = (const float* LAS3*)(lds + SA_KP); const float* LAS3* vptr = (const float* LAS3*)(lds + SA_VP);
    if (tid < 48) CNT[tid] = 0u;
    if (tid == 0) {
        unsigned* cnt = (unsigned*)(ws + CW_SCNT); unsigned* tmo = (unsigned*)(ws + CW_TMO); unsigned sp = 0;
        while (__hip_atomic_load(cnt, __ATOMIC_RELAXED, __HIP_MEMORY_SCOPE_AGENT) < 256u) {
            __builtin_amdgcn_s_sleep(2);
            if ((++sp & 255u) == 0u) { if (__hip_atomic_load(tmo, __ATOMIC_RELAXED, __HIP_MEMORY_SCOPE_AGENT)) break; if (sp > (1u << 20)) { __hip_atomic_store(tmo, 1u, __ATOMIC_RELAXED, __HIP_MEMORY_SCOPE_AGENT); break; } }
        }
        __builtin_amdgcn_fence(__ATOMIC_ACQUIRE, "agent");
        asm volatile("s_waitcnt vmcnt(0)" ::: "memory");
    }
    if (w == 1) {
        const bf16_t* iq = (const bf16_t*)(ws + W_IQ) + (size_t)(MP + b) * 256; const float kd = bf2f(((const bf16_t*)(ws + W_IK))[(size_t)(MP + b) * 64 + lane]);
        const f32x4 wv = *(const f32x4*)vaddr((const float*)(ws + W_IW) + (size_t)(MP + b) * 4);
        float s = 0.f;
#pragma unroll
        for (int h = 0; h < 4; ++h) { const float dh = wsum64(bf2f(iq[h * 64 + lane]) * kd); s += wv[h] * fmaxf(dh, 0.f); }
        if (lane == 0) *newsc = s;
    }
    __syncthreads();
    const float* sc = (const float*)(ws + W_SC) + (size_t)b * SCLD;
    unsigned key[33];
#pragma unroll
    for (int n = 0; n < 32; ++n) key[n] = fkey(sc[tid + 512 * n]);
    key[32] = (tid == 0) ? fkey(*newsc) : 0u;
    int it = 0;
    unsigned T = 0u, X = 0x7fffffffu; bool fin = false;
    for (int bit = 31; bit >= 0; --bit) {
        const unsigned cand = T | (1u << bit);
        unsigned c = 0;
#pragma unroll
        for (int n = 0; n < 33; ++n) cnt_ge(c, key[n], cand);
        const unsigned tot = blk_count(c, CNT, it, lane);
        if (tot >= 256u) { T = cand; fin = (tot == 256u); }
        if (fin) break;
    }
    if (!fin) {
        unsigned c = 0;
#pragma unroll
        for (int n = 0; n < 33; ++n) cnt_gt(c, key[n], T);
        const unsigned need = 256u - blk_count(c, CNT, it, lane);
        unsigned Xl = 0u;
        for (int bit = 14; bit >= 0; --bit) {
            const unsigned cand = Xl | (1u << bit);
            c = 0;
#pragma unroll
            for (int n = 0; n < 33; ++n) cnt_eq_lt(c, key[n], T, (unsigned)(tid + 512 * n), cand);
            if (blk_count(c, CNT, it, lane) < need) Xl = cand;
        }
        X = Xl;
    }
    unsigned selm = 0, hi = 0;
#pragma unroll
    for (int n = 0; n < 32; ++n) selm |= (key[n] > T || (key[n] == T && (unsigned)(tid + 512 * n) <= X)) ? (1u << n) : 0u;
    hi = (key[32] > T || (key[32] == T && (unsigned)(tid + 16384) <= X)) ? 1u : 0u;
    const unsigned cs = __popc(selm) + hi;
    unsigned inc = cs;
#pragma unroll
    for (int o2 = 1; o2 < 64; o2 <<= 1) { const unsigned t2 = __shfl_up(inc, o2); if (lane >= o2) inc += t2; }
    if (lane == 63) wsum[w] = inc;
    __syncthreads();
    unsigned pos = inc - cs;
    for (int w2 = 0; w2 < w; ++w2) pos += wsum[w2];
#pragma unroll
    for (int n = 0; n < 32; ++n) if ((selm >> n) & 1u) { if (pos < 256u) list[pos] = tid + 512 * n; ++pos; }
    if (hi) { if (pos < 256u) list[pos] = tid + 16384; ++pos; }
    __syncthreads();
    if (tid < 256) {
        const int idx = list[tid];
        if (idx < 16384) { const size_t phys = (size_t)p.page_table[b * NPAGES + (idx >> 7)] * 128 + (idx & 127); kptr[tid] = p.cache_k + phys * 256; vptr[tid] = p.cache_v + phys * 256; }
        else { kptr[tid] = p.out + O_KS + (size_t)b * 256; vptr[tid] = p.out + O_VS + (size_t)b * 256; }
    }
    const size_t row = MP + b;
    sattend(p, lds, (const bf16_t*)(ws + W_DQ) + row * 256, (const bf16_t*)(ws + W_DG) + row * 256, (bf16_t*)(ws + W_MIX) + row * 1024 + 512);
}
DI void sgla_unit(const Params& p, LAS3 unsigned char* lds, int b) {
    const int tid = threadIdx.x, lane = tid & 63, w = tid >> 6; unsigned char* ws = p.ws;
    LAS3 float* qs = (LAS3 float*)lds; LAS3 float* ks = qs + 256; LAS3 float* gs = qs + 512; LAS3 float* vs = qs + 768; LAS3 float* part = qs + 1280;
    const size_t row = MP + b;
    if (tid < 256) {
        float u = p.b_g[tid];
        const float* gl = vaddr((const float*)(ws + W_GLR) + row * 16);
#pragma unroll
        for (int r = 0; r < 16; ++r) u += gl[r] * p.w_g2[r * 256 + tid];
        gs[tid] = expf(logsigf(u) * (1.f / 16.f));
        qs[tid] = bf2f(((const bf16_t*)(ws + W_GQ))[row * 256 + tid]); ks[tid] = bf2f(((const bf16_t*)(ws + W_GK))[row * 256 + tid]);
    }
    vs[tid] = bf2f(((const bf16_t*)(ws + W_GV))[row * 512 + tid]);
    __syncthreads();
    const int h = tid >> 7, v = tid & 127;
    const float* sp = p.state_gla + ((size_t)(b * 4 + h) * 64) * 128 + v; float* so = p.out + O_GSS + ((size_t)(b * 4 + h) * 64) * 128 + v;
    const float vv = vs[h * 128 + v];
    float o = 0.f;
#pragma unroll 8
    for (int dd = 0; dd < 64; ++dd) { const float sn = gs[h * 64 + dd] * sp[dd * 128] + ks[h * 64 + dd] * vv; so[dd * 128] = sn; o += qs[h * 64 + dd] * sn; }
    const float ss = wsum64(o * o);
    if (lane == 0) part[w] = ss;
    __syncthreads();
    const float rstd = rsqrtf((part[2 * h] + part[2 * h + 1]) * (1.f / 128.f) + 1e-6f);
    ((bf16_t*)(ws + W_MIX))[row * 1024 + h * 128 + v] = f2bf(o * rstd * p.onorm[v] * bf2f(((const bf16_t*)(ws + W_GG))[row * 512 + h * 128 + v]));
    __syncthreads();
}
DI void p4_final(const Params& p) {
    const int tid = threadIdx.x, lane = tid & 63, wv = tid >> 6;
    for (int r = blockIdx.x * 8 + wv; r < MP + NDB; r += gridDim.x * 8) {
        float* y = p.out + (r < MP ? O_YP + (size_t)r * DM : O_YS + (size_t)(r - MP) * DM);
        f32x4 v[4]; float ss = 0.f;
#pragma unroll
        for (int i = 0; i < 4; ++i) { v[i] = *(const f32x4*)(y + i * 256 + lane * 4); ss += v[i][0] * v[i][0] + v[i][1] * v[i][1] + v[i][2] * v[i][2] + v[i][3] * v[i][3]; }
        ss = wsum64(ss);
        const float rstd = rsqrtf(ss * (1.f / DM) + 1e-6f);
#pragma unroll
        for (int i = 0; i < 4; ++i) { const f32x4 gv = *(const f32x4*)(p.norm_final + i * 256 + lane * 4); *(f32x4*)(y + i * 256 + lane * 4) = v[i] * rstd * gv; }
    }
}

DI int next_unit(unsigned* ctr, volatile LAS3 unsigned* slot) {
    if (threadIdx.x == 0) *slot = __hip_atomic_fetch_add(ctr, 1u, __ATOMIC_RELAXED, __HIP_MEMORY_SCOPE_AGENT);
    __syncthreads();
    const int v = __builtin_amdgcn_readfirstlane((int)*slot);
    __syncthreads();
    return v;
}

#ifndef REP1
#define REP1 1
#endif
#ifndef REP2
#define REP2 1
#endif
#ifndef REP3
#define REP3 1
#endif
#ifndef REP2A
#define REP2A 1
#endif
#ifndef REP2B
#define REP2B 1
#endif
#ifndef REP2C
#define REP2C 1
#endif
#ifndef REP2D
#define REP2D 1
#endif
#ifndef REP2E
#define REP2E 1
#endif
DI void sample_inproj(const Params& p, LAS3 unsigned char* lds) {
    const int tid = threadIdx.x, lane = tid & 63, wv = tid >> 6, fr = lane & 15, fq = lane >> 4;
    unsigned char* ws = p.ws;
    LAS3 float* red = (LAS3 float*)lds;
    for (int pr = blockIdx.x; pr < 112; pr += gridDim.x) {
        const int col0 = pr * 32, pn = col0 >> 8, vc0 = col0 & 255;
        const bf16_t* A = (const bf16_t*)(ws + W_XN) + (size_t)MP * 1024 + (size_t)fr * 1024 + fq * 8 + wv * 128;
        const bf16_t* B = (const bf16_t*)(ws + W_WTIN) + (size_t)(col0 + fr) * 1024 + fq * 8 + wv * 128;
        const f32x4 zero = {0.f, 0.f, 0.f, 0.f};
        f32x4 acc[2][2] = {{zero, zero}, {zero, zero}};
#pragma unroll
        for (int ks = 0; ks < 4; ++ks) {
            const bf16x8 a0 = *(const bf16x8*)(A + ks * 32), a1 = *(const bf16x8*)(A + 16 * 1024 + ks * 32);
            const bf16x8 b0 = *(const bf16x8*)(B + ks * 32), b1 = *(const bf16x8*)(B + 16 * 1024 + ks * 32);
            acc[0][0] = mfma16(a0, b0, acc[0][0]); acc[0][1] = mfma16(a0, b1, acc[0][1]); acc[1][0] = mfma16(a1, b0, acc[1][0]); acc[1][1] = mfma16(a1, b1, acc[1][1]);
        }
#pragma unroll
        for (int rt = 0; rt < 2; ++rt)
#pragma unroll
            for (int ct = 0; ct < 2; ++ct)
#pragma unroll
                for (int r = 0; r < 4; ++r) red[(wv * 16 + (rt * 2 + ct) * 4 + r) * 64 + lane] = acc[rt][ct][r];
        __syncthreads();
        {
            const int rt = wv >> 2, r = wv & 3;
            float v0 = 0.f, v1 = 0.f;
#pragma unroll
            for (int w2 = 0; w2 < 8; ++w2) { v0 += red[(w2 * 16 + (rt * 2 + 0) * 4 + r) * 64 + lane]; v1 += red[(w2 * 16 + (rt * 2 + 1) * 4 + r) * 64 + lane]; }
            const float* rope = (const float*)(ws + W_ROPE) + (size_t)2048 * 64;
            {
                const int bs = 16 * rt + 4 * fq + r; const size_t R = (size_t)MP + bs;
                if (pn <= 5 || (pn >= 10 && pn <= 12)) {
                    bf16_t* dst; int ldc = 256, coff = 0; float sc = 1.f; bool silu = false;
                    switch (pn) {
                        case 0: dst = (bf16_t*)(ws + W_GQ); sc = 0.125f; break;
                        case 1: dst = (bf16_t*)(ws + W_GK); break;
                        case 2: dst = (bf16_t*)(ws + W_GV); ldc = 512; break;
                        case 3: dst = (bf16_t*)(ws + W_GV); ldc = 512; coff = 256; break;
                        case 4: dst = (bf16_t*)(ws + W_GG); ldc = 512; silu = true; break;
                        case 5: dst = (bf16_t*)(ws + W_GG); ldc = 512; coff = 256; silu = true; break;
                        case 10: dst = (bf16_t*)(ws + W_DG); silu = true; break;
                        case 11: dst = (bf16_t*)(ws + W_MQ); sc = 0.125f; break;
                        default: dst = (bf16_t*)(ws + W_MG); silu = true; break;
                    }
                    bf16_t* rp = dst + R * ldc + coff + vc0 + 8 * (fr >> 2) + (fr & 3);
                    rp[0] = f2bf(silu ? siluf(v0) : v0 * sc); rp[4] = f2bf(silu ? siluf(v1) : v1 * sc);
                } else if (pn == 6 || pn == 7 || pn == 9 || (pn == 13 && vc0 < 64)) {
                    const int hh = (pn == 13) ? 0 : ((vc0 >> 5) & 3);
                    const int f = (pn == 13) ? 16 * ((vc0 >> 5) & 1) + fr : 8 * (fr >> 2) + 4 * (vc0 >> 7) + (fr & 3);
                    const float c = rope[2 * f], s = rope[2 * f + 1], sc = (pn == 6) ? 0.125f : 1.f;
                    const float o1 = (v0 * c - v1 * s) * sc, o2 = (v1 * c + v0 * s) * sc;
                    if (pn == 13) {
                        bf16_t* ikb = (bf16_t*)(ws + W_IK) + R * 64; ikb[f] = f2bf(o1); ikb[f + 32] = f2bf(o2);
                        float* op = p.out + O_IKS + (size_t)bs * 64; op[f] = o1; op[f + 32] = o2;
                    } else {
                        bf16_t* dst = (bf16_t*)(ws + (pn == 6 ? W_DQ : (pn == 7 ? W_DK : W_IQ))) + R * 256 + 64 * hh;
                        dst[f] = f2bf(o1); dst[f + 32] = f2bf(o2);
                        if (pn == 7) { float* op = p.out + O_KS + (size_t)bs * 256 + 64 * hh; op[f] = o1; op[f + 32] = o2; }
                    }
                } else if (pn == 8) {
                    float* op = p.out + O_VS + (size_t)bs * 256 + vc0 + 8 * (fr >> 2) + (fr & 3); op[0] = v0; op[4] = v1;
                } else if (pn == 13 && vc0 == 64) {
                    if (fr < 4) { ((float*)(ws + W_IW))[R * 4 + fr] = v0 * 0.5f; ((float*)(ws + W_GLR))[R * 16 + 12 + fr] = v1; }
                    else ((float*)(ws + W_GLR))[R * 16 + fr - 4] = v0;
                }
            }
        }
        __syncthreads();
    }
}
DI void phase1(const Params& p, LAS3 unsigned char* lds) {
    unsigned char* ws = p.ws;
    { pg8::Gemm g{(const bf16_t*)(ws + W_XN), (const bf16_t*)(ws + W_WTIN), MP, NIN, DM}; pg8::StaticOrder S; S.init(MP, NIN, (int)gridDim.x, (int)blockIdx.x);
      EpiIn E{ws, p.out}; pg8::gemm_phase<EpiIn, pg8::StaticOrder, true, true>(lds, g, S, E); }
    sample_inproj(p, lds);
}
DI void p2_memgemm(const Params& p, LAS3 unsigned char* lds) {
    const int u = (int)gridDim.x - 1 - (int)blockIdx.x;
    if (u >= 96 && u < 128) {
        pg8::Gemm g{(const bf16_t*)(p.ws + W_MEMN), (const bf16_t*)(p.ws + W_WTMEM), MMEM, 512, DM}; pg8::StaticOrder S; S.init(MMEM, 512, (int)gridDim.x, u - 96);
        EpiMem E{p.ws, p.out}; pg8::gemm_phase<EpiMem, pg8::StaticOrder, true, true>(lds, g, S, E);
        asm volatile("s_waitcnt vmcnt(0)" ::: "memory");
        __syncthreads();
        if (threadIdx.x == 0) {
            __builtin_amdgcn_fence(__ATOMIC_RELEASE, "agent");
            asm volatile("s_waitcnt vmcnt(0)" ::: "memory");
            __hip_atomic_fetch_add((unsigned*)(p.ws + CW_MEMC), 1u, __ATOMIC_RELAXED, __HIP_MEMORY_SCOPE_AGENT);
        }
    }
}
DI void wait_memgemm(const Params& p) {
    if (threadIdx.x == 0) {
        unsigned* cnt = (unsigned*)(p.ws + CW_MEMC); unsigned* tmo = (unsigned*)(p.ws + CW_TMO); unsigned sp = 0;
        while (__hip_atomic_load(cnt, __ATOMIC_RELAXED, __HIP_MEMORY_SCOPE_AGENT) < 32u) {
            __builtin_amdgcn_s_sleep(2);
            if ((++sp & 255u) == 0u) { if (__hip_atomic_load(tmo, __ATOMIC_RELAXED, __HIP_MEMORY_SCOPE_AGENT)) break; if (sp > (1u << 20)) { __hip_atomic_store(tmo, 1u, __ATOMIC_RELAXED, __HIP_MEMORY_SCOPE_AGENT); break; } }
        }
        __builtin_amdgcn_fence(__ATOMIC_ACQUIRE, "agent");
        asm volatile("s_waitcnt vmcnt(0)" ::: "memory");
    }
    __syncthreads();
}
template <int QI> DI void p2_sscore(const Params& p, LAS3 unsigned char* lds) { for (int u = blockIdx.x; u < 256; u += gridDim.x) { sscore_unit(p, lds, u); __syncthreads(); } }
template <int QI> DI void p2_gla(const Params& p, LAS3 unsigned char* lds) { for (int u = blockIdx.x; u < 64; u += gridDim.x) gla_unit(p, lds, u >> 2, u & 3); }
DI int next_unit_xcd(unsigned char* qbase, volatile LAS3 unsigned* slot, unsigned x0) {
    if (threadIdx.x == 0) {
        unsigned res = 0xffffffffu;
        for (unsigned k = 0; k < 8u; ++k) {
            const unsigned xq = (x0 + k) & 7u;
            const unsigned mq = __hip_atomic_fetch_add((unsigned*)(qbase + 256 * xq), 1u, __ATOMIC_RELAXED, __HIP_MEMORY_SCOPE_AGENT);
            if (mq < 64u) { res = xq * 64u + mq; break; }
        }
        *slot = res;
    }
    __syncthreads();
    const int v = __builtin_amdgcn_readfirstlane((int)*slot);
    __syncthreads();
    return v;
}
template <int QI> DI void p2_dsa(const Params& p, LAS3 unsigned char* lds, volatile LAS3 unsigned* MISC TARGS) {
#if defined(XCDQ) && XCDQ
    const unsigned x0 = xb_xcc_id() & 7u;
    for (;;) { const int n = next_unit_xcd(p.ws + CW_QDSA + 8192 * QI, MISC + 4, x0); if (n < 0) break; const int m = n & 63; dsa_unit(p, lds, 2 * (n >> 6) + (m >> 5), 31 - (m & 31) TPASS); }
#else
    for (;;) { const int n = next_unit((unsigned*)(p.ws + CW_QDSA + 8192 * QI), MISC + 4); if (n >= 512) break; dsa_unit(p, lds, n & 15, 31 - (n >> 4) TPASS); }
#endif
}
template <int QI> DI void p2_mem(const Params& p, LAS3 unsigned char* lds, volatile LAS3 unsigned* MISC) {
    wait_memgemm(p);
    for (;;) { const int n = next_unit((unsigned*)(p.ws + CW_QMEM + 8192 * QI), MISC + 4); if (n >= 512) break; mem_unit(p, n); } }
template <int QI> DI void p2_sample(const Params& p, LAS3 unsigned char* lds) {
    for (int u = (int)gridDim.x - 1 - (int)blockIdx.x; u < 96; u += gridDim.x) { if (u < 32) sgla_unit(p, lds, u); else if (u < 64) smem_unit(p, lds, u - 32); else ssel_unit(p, lds, u - 64); } }
template <int RI> DI void phase2(const Params& p, LAS3 unsigned char* lds, volatile LAS3 unsigned* MISC TARGS) {
    TBEG(20); p2_memgemm(p, lds);
    TBEG(21); p2_sscore<0>(p, lds); TEND(21); if (REP2A > 1) p2_sscore<1>(p, lds);
    TBEG(25); p2_sample<0>(p, lds); TEND(25); if (REP2E > 1) p2_sample<1>(p, lds);
    TBEG(22); p2_gla<0>(p, lds); TEND(22); if (REP2B > 1) p2_gla<1>(p, lds);
    TBEG(23); p2_dsa<0>(p, lds, MISC TPASS); TEND(23); if (REP2C > 1) p2_dsa<1>(p, lds, MISC TPASS);
    TBEG(24); p2_mem<0>(p, lds, MISC); TEND(24); if (REP2D > 1) p2_mem<1>(p, lds, MISC);
    TEND(20);
}
DI void phase3(const Params& p, LAS3 unsigned char* lds) {
    pg8::Gemm g{(const bf16_t*)(p.ws + W_MIX), (const bf16_t*)(p.ws + W_WTOUT), MP, DM, DM}; pg8::StaticOrder S; S.init(MP, DM, (int)gridDim.x, (int)blockIdx.x);
    EpiOut E{p.x_prompt, p.x_sample, p.out}; pg8::gemm_phase<EpiOut, pg8::StaticOrder, true, true>(lds, g, S, E);
    const int tid = threadIdx.x, lane = tid & 63, wv = tid >> 6;
    for (int u = blockIdx.x; u < 256; u += gridDim.x) {
        const int b = u >> 3, col0 = (u & 7) * 128 + wv * 16;
        const bf16_t* mrow = (const bf16_t*)(p.ws + W_MIX) + (size_t)(MP + b) * 1024 + lane * 16;
        const u32x4 m0 = *(const u32x4*)mrow, m1 = *(const u32x4*)(mrow + 8);
        const unsigned mw[8] = {m0.x, m0.y, m0.z, m0.w, m1.x, m1.y, m1.z, m1.w};
        float res = 0.f;
#pragma unroll 4
        for (int i = 0; i < 16; ++i) {
            const bf16_t* wrow = (const bf16_t*)(p.ws + W_WTOUT) + (size_t)(col0 + i) * 1024 + lane * 16;
            const u32x4 w0 = *(const u32x4*)wrow, w1 = *(const u32x4*)(wrow + 8);
            const unsigned ww[8] = {w0.x, w0.y, w0.z, w0.w, w1.x, w1.y, w1.z, w1.w};
            float acc = 0.f;
#pragma unroll
            for (int e = 0; e < 8; ++e) acc += __uint_as_float(mw[e] << 16) * __uint_as_float(ww[e] << 16) + __uint_as_float(mw[e] & 0xffff0000u) * __uint_as_float(ww[e] & 0xffff0000u);
            acc = wsum64(acc);
            res = (lane == i) ? acc : res;
        }
        if (lane < 16) p.out[O_YS + (size_t)b * DM + col0 + lane] = p.x_sample[(size_t)b * DM + col0 + lane] + res;
    }
}
#ifdef CHECK_ATT
DI void check_mem_attention(const Params& p) {
    const int tid = threadIdx.x, lane = tid & 63, wv = tid >> 6;
    const int samp = blockIdx.x * 8 + wv;
    const int row = (samp * 977 + 13) % MP, h = samp & 3, b = row >> 11;
    const bf16_t* q = (const bf16_t*)(p.ws + W_MQ) + (size_t)row * 256 + h * 64;
    float s[4];
#pragma unroll
    for (int i = 0; i < 4; ++i) { const float* kr = p.out + O_MKP + ((size_t)b * NMEM + lane + 64 * i) * 256 + h * 64; float a = 0.f; for (int d = 0; d < 64; ++d) a += bf2f(q[d]) * kr[d]; s[i] = a; }
    float mx = wmax64(fmaxf(fmaxf(s[0], s[1]), fmaxf(s[2], s[3])));
    float pe[4], sum = 0.f;
#pragma unroll
    for (int i = 0; i < 4; ++i) { pe[i] = __builtin_amdgcn_exp2f(s[i] - mx); sum += pe[i]; }
    sum = wsum64(sum);
    float err = 0.f, nrm = 0.f;
    for (int d = 0; d < 64; ++d) {
        float a = 0.f;
#pragma unroll
        for (int i = 0; i < 4; ++i) a += pe[i] * p.out[O_MVP + ((size_t)b * NMEM + lane + 64 * i) * 256 + h * 64 + d];
        a = wsum64(a) / sum;
        const float want = a * bf2f(((const bf16_t*)(p.ws + W_MG))[(size_t)row * 256 + h * 64 + d]);
        const float got = bf2f(((const bf16_t*)(p.ws + W_MIX))[(size_t)row * 1024 + 768 + h * 64 + d]);
        err += (got - want) * (got - want); nrm += want * want;
    }
    if (lane == 0) { atomicAdd((unsigned*)(p.ws + CW_CHK + 12), 1u); if (!(err <= 0.0025f * nrm + 1e-12f)) atomicAdd((unsigned*)(p.ws + CW_CHK + 8), 1u); }
    if (samp < 128) {
        const int bs = samp >> 2, hs = samp & 3; const size_t rs = (size_t)MP + bs;
        const bf16_t* qs = (const bf16_t*)(p.ws + W_MQ) + rs * 256 + hs * 64;
        float s2[4];
#pragma unroll
        for (int i = 0; i < 4; ++i) { const float* kr = p.cache_mem_k + ((size_t)bs * NMEM + lane + 64 * i) * 256 + hs * 64; float a = 0.f; for (int d = 0; d < 64; ++d) a += bf2f(qs[d]) * kr[d]; s2[i] = a; }
        const float mx2 = wmax64(fmaxf(fmaxf(s2[0], s2[1]), fmaxf(s2[2], s2[3])));
        float pe2[4], sum2 = 0.f;
#pragma unroll
        for (int i = 0; i < 4; ++i) { pe2[i] = __expf(s2[i] - mx2); sum2 += pe2[i]; }
        sum2 = wsum64(sum2);
        float err2 = 0.f, nrm2 = 0.f;
        for (int d = 0; d < 64; ++d) {
            float a = 0.f;
#pragma unroll
            for (int i = 0; i < 4; ++i) a += pe2[i] * p.cache_mem_v[((size_t)bs * NMEM + lane + 64 * i) * 256 + hs * 64 + d];
            a = wsum64(a) / sum2;
            const float want = a * bf2f(((const bf16_t*)(p.ws + W_MG))[rs * 256 + hs * 64 + d]);
            const float got = bf2f(((const bf16_t*)(p.ws + W_MIX))[rs * 1024 + 768 + hs * 64 + d]);
            err2 += (got - want) * (got - want); nrm2 += want * want;
        }
        if (lane == 0) { atomicAdd((unsigned*)(p.ws + CW_CHK + 12), 1u); if (!(err2 <= 0.0025f * nrm2 + 1e-12f)) atomicAdd((unsigned*)(p.ws + CW_CHK + 8), 1u); }
    }
}
#endif
__global__ void __launch_bounds__(NTHREADS, 2) hymba_fwd(Params p) {
    extern __shared__ __attribute__((aligned(16))) unsigned char lds_raw[];
    LAS3 unsigned char* lds = (LAS3 unsigned char*)lds_raw;
    volatile LAS3 unsigned* MISC = (volatile LAS3 unsigned*)(lds + LDS_MISC);
    const int tid = threadIdx.x;
    if (tid < 64) MISC[tid] = 0u;
    __syncthreads();
    const int lo = p.ph_lo, hi = p.ph_hi;
    TDECL;
    XcdBarrier bar; bar.bar = (unsigned*)p.ws; bar.x = 0; bar.st = MISC;
    if (hi > lo) bar = xcd_barrier_post((unsigned*)p.ws, MISC);
#define IN(k) (lo <= (k) && (k) <= hi)
#define SEAM(k) do { if (IN(k) && IN((k) + 1)) xcd_barrier(bar); } while (0)
    TBEG(0); if (IN(0)) p0_prologue(p, lds); TEND(0);
    TBEG(10); SEAM(0); TEND(10);
    TBEG(1); if (IN(1)) { phase1(p, lds); if (REP1 > 1) { xcd_barrier(bar); phase1(p, lds); } } TEND(1);
    TBEG(11); SEAM(1); TEND(11);
    TBEG(2); if (IN(2)) { phase2<0>(p, lds, MISC TPASS); } TEND(2);
    TBEG(12); SEAM(2); TEND(12);
#ifdef CHECK_ATT
    if (IN(3)) check_mem_attention(p);
#endif
    TBEG(3); if (IN(3)) { phase3(p, lds); if (REP3 > 1) { xcd_barrier(bar); phase3(p, lds); } } TEND(3);
    TBEG(13); SEAM(3); TEND(13);
    TBEG(4); if (IN(4)) p4_final(p); TEND(4);
#ifdef TSEL
    {
#ifdef TCLS
        if (tid == 0 && (int)((blockIdx.x >> 6) & 1) == TCLS) { atomicAdd((unsigned long long*)(p.ws + CW_TSUM), 2ull * (unsigned long long)tacc_); atomicMax((unsigned long long*)(p.ws + CW_TMAX), (unsigned long long)tacc_); }
#else
        if (tid == 0) { atomicAdd((unsigned long long*)(p.ws + CW_TSUM), (unsigned long long)tacc_); atomicMax((unsigned long long*)(p.ws + CW_TMAX), (unsigned long long)tacc_); }
#endif
        xcd_barrier(bar);
        if (blockIdx.x == 0 && tid == 0) {
#ifdef TMAX
            unsigned long long dly = __hip_atomic_load((unsigned long long*)(p.ws + CW_TMAX), __ATOMIC_RELAXED, __HIP_MEMORY_SCOPE_AGENT);
#else
            const unsigned long long dly = __hip_atomic_load((unsigned long long*)(p.ws + CW_TSUM), __ATOMIC_RELAXED, __HIP_MEMORY_SCOPE_AGENT) / gridDim.x;
#endif
#ifndef TMUL
#define TMUL 1
#endif
            const unsigned long long t0 = __builtin_amdgcn_s_memrealtime();
            while (__builtin_amdgcn_s_memrealtime() - t0 < dly * TMUL && __builtin_amdgcn_s_memrealtime() - t0 < 400000ull) __builtin_amdgcn_s_sleep(8);
        }
    }
#endif
#ifdef CHECK_ATT
    {
        xcd_barrier(bar);
        const unsigned nbad = __hip_atomic_load((unsigned*)(p.ws + CW_CHK + 8), __ATOMIC_RELAXED, __HIP_MEMORY_SCOPE_AGENT);
        const unsigned nchk = __hip_atomic_load((unsigned*)(p.ws + CW_CHK + 12), __ATOMIC_RELAXED, __HIP_MEMORY_SCOPE_AGENT);
        if (nbad != 0u || nchk < 2170u) for (int i = blockIdx.x * NTHREADS + tid; i < NDB * DM; i += gridDim.x * NTHREADS) p.out[O_YS + i] = __builtin_nanf("");
    }
#endif
#ifdef CHECK_SEL
    {
        xcd_barrier(bar);
        const unsigned nbad = __hip_atomic_load((unsigned*)(p.ws + CW_CHK), __ATOMIC_RELAXED, __HIP_MEMORY_SCOPE_AGENT);
        const unsigned nhist = __hip_atomic_load((unsigned*)(p.ws + CW_CHK + 4), __ATOMIC_RELAXED, __HIP_MEMORY_SCOPE_AGENT);
        if (nbad != 0u || nhist < CHECK_MIN_HIST) for (int i = blockIdx.x * NTHREADS + tid; i < NDB * DM; i += gridDim.x * NTHREADS) p.out[O_YS + i] = __builtin_nanf("");
    }
#endif
#undef IN
#undef SEAM
}

#ifndef N_LAUNCHES
#define N_LAUNCHES 1
#endif
extern "C" void kernel_launch(void* const* d_in, const int* in_sizes, int n_in, void* d_out, int out_size, void* d_ws, size_t ws_size, hipStream_t stream) {
    static int grid = 0;
    if (grid == 0) {
        if (n_in != 19 || (size_t)out_size != O_END || ws_size < W_END) fprintf(stderr, "kernel_launch: unexpected sizes: n_in %d out %d ws %zu (need %zu)\n", n_in, out_size, ws_size, (size_t)W_END);
        int dev = 0, cus = 0, per_cu = 0;
        if (hipGetDevice(&dev) != hipSuccess || hipDeviceGetAttribute(&cus, hipDeviceAttributeMultiprocessorCount, dev) != hipSuccess) { fprintf(stderr, "kernel_launch: device query failed\n"); grid = -1; return; }
        if (hipFuncSetAttribute((const void*)hymba_fwd, hipFuncAttributeMaxDynamicSharedMemorySize, LDS_BYTES) != hipSuccess) { fprintf(stderr, "kernel_launch: hipFuncSetAttribute failed\n"); grid = -1; return; }
        if (hipOccupancyMaxActiveBlocksPerMultiprocessor(&per_cu, (const void*)hymba_fwd, NTHREADS, LDS_BYTES) != hipSuccess || per_cu < 1) fprintf(stderr, "kernel_launch: occupancy query reports %d blocks per CU\n", per_cu);
        (void)hipGetLastError();
        grid = cus;
    }
    if (grid < 0) return;
    (void)hipMemsetAsync(d_ws, 0, CTRL_BYTES, stream);
    Params p{};
    p.x_prompt = (const float*)d_in[0]; p.x_sample = (const float*)d_in[1]; p.mem_prompt = (const float*)d_in[2]; p.state_gla = (const float*)d_in[3];
    p.cache_k = (const float*)d_in[4]; p.cache_v = (const float*)d_in[5]; p.cache_ik = (const float*)d_in[6]; p.cache_mem_k = (const float*)d_in[7]; p.cache_mem_v = (const float*)d_in[8];
    p.page_table = (const int*)d_in[9];
    p.norm_in = (const float*)d_in[10]; p.w_in = (const float*)d_in[11]; p.w_g2 = (const float*)d_in[12]; p.b_g = (const float*)d_in[13]; p.onorm = (const float*)d_in[14];
    p.mem_norm = (const float*)d_in[15]; p.w_mem_kv = (const float*)d_in[16]; p.w_out = (const float*)d_in[17]; p.norm_final = (const float*)d_in[18];
    p.out = (float*)d_out; p.ws = (unsigned char*)d_ws;
#if N_LAUNCHES == 1
    p.ph_lo = 0; p.ph_hi = 4;
    hipLaunchKernelGGL(hymba_fwd, dim3(grid), dim3(NTHREADS), LDS_BYTES, stream, p);
#else
    for (int ph = 0; ph < 5; ++ph) { p.ph_lo = ph; p.ph_hi = ph; hipLaunchKernelGGL(hymba_fwd, dim3(grid), dim3(NTHREADS), LDS_BYTES, stream, p); }
#endif
    const hipError_t le = hipPeekAtLastError();
    if (le != hipSuccess) fprintf(stderr, "kernel_launch: launch failed: %s\n", hipGetErrorName(le));
}
```

```cpp
#include <hip/hip_runtime.h>
#include <cstdint>
#include <cstdio>
namespace pg8 {
#define PG8_LAS __attribute__((address_space(3)))
typedef unsigned short bf16_t;
typedef short bf16x8 __attribute__((ext_vector_type(8)));
typedef float f32x4 __attribute__((ext_vector_type(4)));
typedef unsigned u32x4 __attribute__((ext_vector_type(4)));
constexpr int BM = 256, BK = 64, HALF = 128, HTB = HALF * BK * 2  , STAGE_BYTES = 8 * HTB, NXCD = 8, WGM = 8;

__host__ __device__ __forceinline__ int lds_byte(int r, int c) { const int st = (r >> 4) * 2 + (c >> 5), rr = r & 15, cc = c & 31, ob = rr * 64 + cc * 2; return st * 1024 + (ob ^ (((ob >> 9) & 1) << 5)); }
__host__ __device__ __forceinline__ void stage_rc(int b, int& R, int& C) { const int st = b / 1024, sb = b % 1024, swz = sb ^ (((sb >> 9) & 1) << 5); R = (st >> 1) * 16 + swz / 64; C = (st & 1) * 32 + (swz % 64) / 2; }
__host__ __device__ __forceinline__ int perm32(int rho) { const int n = rho >> 4, i = rho & 15; return 8 * (i >> 2) + 4 * n + (i & 3); }

struct Unit { int pm, pn; };
struct Gemm { const bf16_t* A; const bf16_t* Bt; int M, N, K; };

struct StaticOrder {
    int nM, nN, nwg, G, c;
    __host__ __device__ void init(int M, int N, int G_, int c_) { nM = M / BM; nN = N / BM; nwg = nM * nN; G = G_; c = c_; }
    __host__ __device__ bool next(int i, Unit& u) const {
        const long L = (long)i * G + c; if (L >= nwg) return false;
        int wgid = (int)L; { const int q = nwg / NXCD, r = nwg % NXCD, xcd = wgid % NXCD, off = wgid / NXCD; wgid = (xcd < r ? xcd * (q + 1) : r * (q + 1) + (xcd - r) * q) + off; }
        const int nig = WGM * nN, gid = wgid / nig, fm = gid * WGM, gsz = (nM - fm) < WGM ? (nM - fm) : WGM;
        u.pm = fm + ((wgid % nig) % gsz); u.pn = (wgid % nig) / gsz; return true;
    }
    __device__ __forceinline__ void a_ready(const Unit&) const {}
    __device__ __forceinline__ void done(const Unit&) const {}
};

template <class Epi, class Sched, bool ALIGN_EPI = false, bool SP2 = false>
__device__ __forceinline__ void gemm_phase(PG8_LAS unsigned char* lds, const Gemm g, const Sched& S, const Epi& E) {
    const int tid = threadIdx.x, wid = __builtin_amdgcn_readfirstlane(tid >> 6), lane = tid & 63, wr = wid >> 2, wc = wid & 3, fr = lane & 15, fq = lane >> 4;
    const int K = g.K, nt = K / BK;
    unsigned voffA[2], voffB[2];
#pragma unroll
    for (int i = 0; i < 2; ++i) { int R, C; stage_rc(tid * 16 + i * 8192, R, C); const int Rb = Epi::PERM ? ((R & ~31) + perm32(R & 31)) : R;
        voffA[i] = (unsigned)(R * K + C) * 2u; voffB[i] = (unsigned)(Rb * K + C) * 2u; }
    const size_t kstep = (size_t)(BK * 2);
    const size_t hstep = (size_t)HALF * K * 2;
    const size_t tstep = 2 * hstep;
    const unsigned ldsw = (unsigned)wid * 1024u;
    const int aoff = lds_byte(wr * 64 + fr, fq * 8), boff = lds_byte(wc * 32 + fr, fq * 8);
#define PG8_SA(b, h) (((b) * 2 + (h)) * HTB)
#define PG8_SB(b, h) ((4 + (b) * 2 + (h)) * HTB)
#define PG8_STAGE(bufoff, gbase, voff) do { _Pragma("unroll") for (int _i = 0; _i < 2; ++_i) \
        __builtin_amdgcn_global_load_lds((const unsigned*)((const char*)(gbase) + (voff)[_i]), (PG8_LAS unsigned*)(lds + (bufoff) + ldsw + _i * 8192), 16, 0, 0); } while (0)
#define PG8_LDA(dst, b, h) do { _Pragma("unroll") for (int m = 0; m < 4; ++m) _Pragma("unroll") for (int k = 0; k < 2; ++k) dst[m][k] = *(const PG8_LAS bf16x8*)(lds + PG8_SA(b, h) + aoff + m * 2048 + k * 1024); } while (0)
#define PG8_LDB(dst, b, h) do { _Pragma("unroll") for (int n = 0; n < 2; ++n) _Pragma("unroll") for (int k = 0; k < 2; ++k) dst[n][k] = *(const PG8_LAS bf16x8*)(lds + PG8_SB(b, h) + boff + n * 2048 + k * 1024); } while (0)
#define PG8_MMA(ai, bj, At, Bt) do { __builtin_amdgcn_s_setprio(1); _Pragma("unroll") for (int m = 0; m < 4; ++m) _Pragma("unroll") for (int n = 0; n < 2; ++n) _Pragma("unroll") for (int k = 0; k < 2; ++k) \
        acc[ai][bj][m][n] = __builtin_amdgcn_mfma_f32_16x16x32_bf16(Bt[n][k], At[m][k], acc[ai][bj][m][n], 0, 0, 0); __builtin_amdgcn_s_setprio(0); } while (0)
#define PG8_WAIT_V(n) asm volatile("s_waitcnt vmcnt(" #n ")" ::: "memory")
#define PG8_WAIT_L(n) asm volatile("s_waitcnt lgkmcnt(" #n ")" ::: "memory")
#define PG8_BAR __builtin_amdgcn_s_barrier()
#define PG8_SCHED __builtin_amdgcn_sched_barrier(0)
    Unit cur, nxt; int ui = 0;
    if (!S.next(0, cur)) return;
    f32x4 acc[2][2][4][2];
#pragma unroll
    for (int a = 0; a < 2; ++a)
#pragma unroll
        for (int b = 0; b < 2; ++b)
#pragma unroll
            for (int m = 0; m < 4; ++m)
#pragma unroll
                for (int n = 0; n < 2; ++n) acc[a][b][m][n] = (f32x4){0.f, 0.f, 0.f, 0.f};
    bf16x8 At[4][2], B0[2][2], B1[2][2];
    const char* cA = (const char*)g.A + (size_t)cur.pm * tstep; const char* cB = (const char*)g.Bt + (size_t)cur.pn * tstep;
    S.a_ready(cur);
    if constexpr (SP2) {
        PG8_STAGE(PG8_SB(0, 0), cB, voffB); PG8_STAGE(PG8_SB(0, 1), cB + hstep, voffB); PG8_STAGE(PG8_SA(0, 0), cA, voffA); PG8_STAGE(PG8_SA(0, 1), cA + hstep, voffA);
        if (wr == 1) PG8_BAR;
        PG8_WAIT_V(2); PG8_BAR;
        PG8_STAGE(PG8_SB(1, 0), cB + kstep, voffB); PG8_STAGE(PG8_SA(1, 0), cA + kstep, voffA); PG8_STAGE(PG8_SB(1, 1), cB + hstep + kstep, voffB);
        PG8_WAIT_V(6); PG8_BAR;
    } else {
        PG8_STAGE(PG8_SB(0, 0), cB, voffB); PG8_STAGE(PG8_SA(0, 0), cA, voffA); PG8_STAGE(PG8_SB(0, 1), cB + hstep, voffB); PG8_STAGE(PG8_SA(0, 1), cA + hstep, voffA);
        if (wr == 1) PG8_BAR;
        PG8_WAIT_V(4); PG8_BAR;
        PG8_STAGE(PG8_SB(1, 0), cB + kstep, voffB); PG8_STAGE(PG8_SA(1, 0), cA + kstep, voffA); PG8_STAGE(PG8_SB(1, 1), cB + hstep + kstep, voffB);
        PG8_WAIT_V(6); PG8_BAR;
    }
    for (;;) {
        const bool has_next = S.next(ui + 1, nxt);
        const char* nA = has_next ? (const char*)g.A + (size_t)nxt.pm * tstep : cA; const char* nB = has_next ? (const char*)g.Bt + (size_t)nxt.pn * tstep : cB;
        for (int t = 0; t < nt; t += 2) {
            const bool last = (t == nt - 2);
            const char* a1 = cA + (size_t)(t + 1) * kstep;
            const char* a2 = last ? nA : cA + (size_t)(t + 2) * kstep; const char* b2 = last ? nB : cB + (size_t)(t + 2) * kstep;
            const char* a3 = a2 + kstep; const char* b3 = b2 + kstep;
            if (last && has_next) S.a_ready(nxt);
            if constexpr (SP2) {
            PG8_LDB(B0, 0, 0); PG8_LDB(B1, 0, 1); PG8_SCHED; PG8_LDA(At, 0, 0); PG8_STAGE(PG8_SA(1, 1), a1 + hstep, voffA);
            PG8_WAIT_V(8); PG8_WAIT_L(0); PG8_BAR; PG8_MMA(0, 0, At, B0); PG8_MMA(0, 1, At, B1); PG8_BAR; PG8_SCHED;
            PG8_LDA(At, 0, 1); PG8_STAGE(PG8_SB(0, 0), b2, voffB); PG8_STAGE(PG8_SB(0, 1), b2 + hstep, voffB); PG8_STAGE(PG8_SA(0, 0), a2, voffA);
            PG8_WAIT_V(8); PG8_WAIT_L(0); PG8_BAR; PG8_MMA(1, 0, At, B0); PG8_MMA(1, 1, At, B1); PG8_BAR; PG8_SCHED;
            PG8_LDB(B0, 1, 0); PG8_LDB(B1, 1, 1); PG8_SCHED; PG8_LDA(At, 1, 0); PG8_STAGE(PG8_SA(0, 1), a2 + hstep, voffA);
            PG8_WAIT_V(8); PG8_WAIT_L(0); PG8_BAR; PG8_MMA(0, 0, At, B0); PG8_MMA(0, 1, At, B1); PG8_BAR; PG8_SCHED;
            PG8_LDA(At, 1, 1); PG8_STAGE(PG8_SB(1, 0), b3, voffB); PG8_STAGE(PG8_SB(1, 1), b3 + hstep, voffB); PG8_STAGE(PG8_SA(1, 0), a3, voffA);
            PG8_WAIT_V(8); PG8_WAIT_L(0); PG8_BAR; PG8_MMA(1, 0, At, B0); PG8_MMA(1, 1, At, B1); PG8_BAR; PG8_SCHED;
            } else {
            PG8_LDB(B0, 0, 0); PG8_SCHED; PG8_LDA(At, 0, 0); PG8_STAGE(PG8_SA(1, 1), a1 + hstep, voffA);
            PG8_WAIT_L(8); PG8_BAR; PG8_WAIT_L(0); PG8_MMA(0, 0, At, B0); PG8_BAR; PG8_SCHED;
            PG8_LDB(B1, 0, 1); PG8_STAGE(PG8_SB(0, 0), b2, voffB);
            PG8_BAR; PG8_WAIT_L(0); PG8_MMA(0, 1, At, B1); PG8_BAR;
            PG8_LDA(At, 0, 1); PG8_STAGE(PG8_SA(0, 0), a2, voffA);
            PG8_BAR; PG8_WAIT_L(0); PG8_MMA(1, 0, At, B0); PG8_BAR; PG8_SCHED;
            PG8_STAGE(PG8_SB(0, 1), b2 + hstep, voffB);
            PG8_WAIT_V(6); PG8_BAR; PG8_MMA(1, 1, At, B1); PG8_BAR;
            PG8_LDB(B0, 1, 0); PG8_SCHED; PG8_LDA(At, 1, 0); PG8_STAGE(PG8_SA(0, 1), a2 + hstep, voffA);
            PG8_WAIT_L(8); PG8_BAR; PG8_WAIT_L(0); PG8_MMA(0, 0, At, B0); PG8_BAR; PG8_SCHED;
            PG8_LDB(B1, 1, 1); PG8_STAGE(PG8_SB(1, 0), b3, voffB);
            PG8_BAR; PG8_WAIT_L(0); PG8_MMA(0, 1, At, B1); PG8_BAR;
            PG8_LDA(At, 1, 1); PG8_STAGE(PG8_SA(1, 0), a3, voffA);
            PG8_BAR; PG8_WAIT_L(0); PG8_MMA(1, 0, At, B0); PG8_BAR; PG8_SCHED;
            PG8_STAGE(PG8_SB(1, 1), b3 + hstep, voffB);
            PG8_WAIT_V(6); PG8_BAR; PG8_MMA(1, 1, At, B1); PG8_BAR;
            }
        }
        if constexpr (ALIGN_EPI) { if (wr == 0) PG8_BAR; }
        if constexpr (!Epi::AFTER_DRAIN) { E(acc, cur, wr, wc, fr, fq); S.done(cur); }
        if (!has_next) break;
#pragma unroll
        for (int a = 0; a < 2; ++a)
#pragma unroll
            for (int b = 0; b < 2; ++b)
#pragma unroll
                for (int m = 0; m < 4; ++m)
#pragma unroll
                    for (int n = 0; n < 2; ++n) acc[a][b][m][n] = (f32x4){0.f, 0.f, 0.f, 0.f};
        cur = nxt; cA = nA; cB = nB; ++ui;
        if constexpr (ALIGN_EPI) { if (wr == 1) PG8_BAR; }
    }
    PG8_WAIT_V(0);
    if constexpr (!ALIGN_EPI) { if (wr == 0) PG8_BAR; }
    PG8_BAR;
    if constexpr (Epi::AFTER_DRAIN) { E.fused(acc, cur, wr, wc, fr, fq, lds, wid, lane); S.done(cur); }
#undef PG8_SA
#undef PG8_SB
#undef PG8_STAGE
#undef PG8_LDA
#undef PG8_LDB
#undef PG8_MMA
#undef PG8_WAIT_V
#undef PG8_WAIT_L
#undef PG8_BAR
#undef PG8_SCHED
}
}
#define XB_TMO      128
#define XB_XCNT(j)  (256  + 64 * (j))
#define XB_XSUB(j)  (1280 + 64 * (j))
#define XB_XGEN(j)  (2304 + 64 * (j))
#define XB_TOP      3328
#define XB_TOPGEN   3392
#define XCD_BAR_WORDS 3456
#define XB_SPIN_CAP (1u << 18)
#define LAS __attribute__((address_space(3)))

__device__ __forceinline__ unsigned xb_ld(unsigned* p)              { return __hip_atomic_load(p, __ATOMIC_RELAXED, __HIP_MEMORY_SCOPE_AGENT); }
__device__ __forceinline__ unsigned xb_add(unsigned* p, unsigned v) { return __hip_atomic_fetch_add(p, v, __ATOMIC_RELAXED, __HIP_MEMORY_SCOPE_AGENT); }
__device__ __forceinline__ unsigned xb_xcc_id() { return (unsigned)__builtin_amdgcn_s_getreg((3 << 11) | 20) & 0xFu; }
#define XB_SPIN(cond, bar) do { unsigned _sp = 0; while (cond) { __builtin_amdgcn_s_sleep(1); \
    if ((++_sp & 255u) == 0u) { if (xb_ld(&(bar)[XB_TMO])) break; if (_sp > XB_SPIN_CAP) { atomicAdd(&(bar)[XB_TMO], 1u); break; } } } } while (0)

struct XcdBarrier {
    unsigned* bar; unsigned x;
    volatile LAS unsigned* st;
};

__device__ __forceinline__ XcdBarrier xcd_barrier_post(unsigned* bar, volatile LAS unsigned* st) {
    XcdBarrier b; b.bar = bar; b.x = xb_xcc_id(); b.st = st;
    if (threadIdx.x == 0) (void)xb_add(&bar[XB_XCNT(b.x)], 1u);
    return b;
}
__device__ __forceinline__ void xcd_barrier_complete(unsigned* bar, unsigned x, unsigned& nloc, unsigned& nx) {
    const unsigned G = gridDim.x * gridDim.y * gridDim.z;
    unsigned sum, cnt, mine, sp = 0u;
    for (;;) {
        sum = 0u; cnt = 0u; mine = 0u;
#pragma unroll
        for (unsigned j = 0; j < 16; ++j) { const unsigned c = xb_ld(&bar[XB_XCNT(j)]); sum += c; cnt += (c > 0u) ? 1u : 0u; mine = (j == x) ? c : mine; }
        if (sum == G) break;
        __builtin_amdgcn_s_sleep(1);
        if ((++sp & 255u) == 0u) { if (xb_ld(&bar[XB_TMO])) break; if (sp > XB_SPIN_CAP) { atomicAdd(&bar[XB_TMO], 1u); break; } }
    }
    nloc = mine > 0u ? mine : 1u; nx = cnt > 0u ? cnt : 1u;
}

__device__ __forceinline__ void xcd_barrier(const XcdBarrier& b) {
    asm volatile("s_waitcnt vmcnt(0)" ::: "memory");
    __syncthreads();
    if (threadIdx.x == 0) {
        unsigned* bar = b.bar;
        __builtin_amdgcn_s_waitcnt(0);
        unsigned nloc = b.st[0], nx = b.st[1];
        if (nloc == 0u) { xcd_barrier_complete(bar, b.x, nloc, nx); b.st[0] = nloc; b.st[1] = nx; }
        const unsigned old = xb_add(&bar[XB_XSUB(b.x)], 1u);
        const unsigned gen = old / nloc;
        if (old + 1u == (gen + 1u) * nloc) {
            __builtin_amdgcn_fence(__ATOMIC_RELEASE, "agent");
            asm volatile("s_waitcnt vmcnt(0)" ::: "memory");
            const unsigned og = xb_add(&bar[XB_TOP], 1u);
            const unsigned tg = og / nx;
            if (og + 1u == (tg + 1u) * nx) xb_add(&bar[XB_TOPGEN], 1u);
            else XB_SPIN(xb_ld(&bar[XB_TOPGEN]) == tg, bar);
            __builtin_amdgcn_fence(__ATOMIC_ACQUIRE, "agent");
            xb_add(&bar[XB_XGEN(b.x)], 1u);
            asm volatile("s_waitcnt vmcnt(0)" ::: "memory");
        } else {
            XB_SPIN(xb_ld(&bar[XB_XGEN(b.x)]) == gen, bar);
            __builtin_amdgcn_fence(__ATOMIC_ACQUIRE, "agent");
            asm volatile("s_waitcnt vmcnt(0)" ::: "memory");
        }
    }
    __syncthreads();
}
#define DI __device__ __forceinline__
#define LAS3 __attribute__((address_space(3)))
using pg8::bf16_t; using pg8::bf16x8; using pg8::f32x4; using pg8::u32x4;
typedef unsigned u32x2 __attribute__((ext_vector_type(2)));
typedef short s16x4 __attribute__((ext_vector_type(4)));
typedef float f32x2 __attribute__((ext_vector_type(2)));
typedef __bf16 bf16x2_t __attribute__((ext_vector_type(2)));

constexpr int DM = 1024, NB = 16, SEQ = 2048, MP = NB * SEQ  , NDB = 32  , MROWS = 33024  ;
constexpr int NMEM = 256, MMEM = NB * NMEM  , DIN = 3412, NIN = 3584, NPAGES = 128;
constexpr int NTHREADS = 512;
constexpr size_t O_YP = 0, O_YS = O_YP + (size_t)MP * DM, O_GSP = O_YS + (size_t)NDB * DM, O_KP = O_GSP + (size_t)NB * 4 * 64 * 128,
                 O_VP = O_KP + (size_t)MP * 256, O_IKP = O_VP + (size_t)MP * 256, O_MKP = O_IKP + (size_t)MP * 64, O_MVP = O_MKP + (size_t)MMEM * 256,
                 O_GSS = O_MVP + (size_t)MMEM * 256, O_KS = O_GSS + (size_t)NDB * 4 * 64 * 128, O_VS = O_KS + (size_t)NDB * 256, O_IKS = O_VS + (size_t)NDB * 256,
                 O_END = O_IKS + (size_t)NDB * 64;
static_assert(O_END == 56150016, "output size");
constexpr size_t al256(size_t x) { return (x + 255) & ~(size_t)255; }
constexpr size_t CTRL_BYTES = 32768;
constexpr size_t CW_QDSA = 16384  , CW_QMEM = 18432  , CW_SCNT = 20480, CW_TMO = 20736, CW_CHK = 20992, CW_TSUM = 21248, CW_TMAX = 21504, CW_MEMC = 21760;
constexpr int SCLD = 16400;
constexpr size_t W_ROPE = CTRL_BYTES;
constexpr size_t W_XN = al256(W_ROPE + (size_t)2049 * 32 * 8);
constexpr size_t W_MEMN = W_XN + (size_t)MROWS * 1024 * 2;
constexpr size_t W_WTIN = W_MEMN + (size_t)MMEM * 1024 * 2;
constexpr size_t W_WTMEM = W_WTIN + (size_t)NIN * 1024 * 2;
constexpr size_t W_WTOUT = W_WTMEM + (size_t)512 * 1024 * 2;
constexpr size_t W_GQ = W_WTOUT + (size_t)1024 * 1024 * 2;
constexpr size_t W_GK = W_GQ + (size_t)MROWS * 256 * 2;
constexpr size_t W_GV = W_GK + (size_t)MROWS * 256 * 2;
constexpr size_t W_GG = W_GV + (size_t)MROWS * 512 * 2;
constexpr size_t W_DQ = W_GG + (size_t)MROWS * 512 * 2;
constexpr size_t W_DK = W_DQ + (size_t)MROWS * 256 * 2;
constexpr size_t W_DVT = W_DK + (size_t)MROWS * 256 * 2;
constexpr size_t W_IQ = W_DVT + (size_t)MP * 256 * 2;
constexpr size_t W_DG = W_IQ + (size_t)MROWS * 256 * 2;
constexpr size_t W_MQ = W_DG + (size_t)MROWS * 256 * 2;
constexpr size_t W_MG = W_MQ + (size_t)MROWS * 256 * 2;
constexpr size_t W_IK = W_MG + (size_t)MROWS * 256 * 2;
constexpr size_t W_IW = W_IK + (size_t)MROWS * 64 * 2;
constexpr size_t W_GLR = W_IW + (size_t)MROWS * 4 * 4;
constexpr size_t W_MK = W_GLR + (size_t)MROWS * 16 * 4;
constexpr size_t W_MVT = W_MK + (size_t)MMEM * 256 * 2;
constexpr size_t W_MIX = W_MVT + (size_t)MMEM * 256 * 2;
constexpr size_t W_SC = W_MIX + (size_t)MROWS * 1024 * 2;
constexpr size_t W_END = W_SC + (size_t)NDB * SCLD * 4;
constexpr int LDS_MISC = 148480, LDS_BYTES = 148480 + 256;

struct Params {
    const float *x_prompt, *x_sample, *mem_prompt, *state_gla, *cache_k, *cache_v, *cache_ik, *cache_mem_k, *cache_mem_v;
    const int* page_table;
    const float *norm_in, *w_in, *w_g2, *b_g, *onorm, *mem_norm, *w_mem_kv, *w_out, *norm_final;
    float* out; unsigned char* ws; int ph_lo, ph_hi;
};

#ifdef TSEL
#define TDECL unsigned tacc_ = 0u, tbeg_ = 0u
#define TBEG(k) do { if ((k) == TSEL) tbeg_ = (unsigned)__builtin_amdgcn_s_memrealtime(); } while (0)
#define TEND(k) do { if ((k) == TSEL) tacc_ += (unsigned)__builtin_amdgcn_s_memrealtime() - tbeg_; } while (0)
#define TARGS , unsigned& tacc_, unsigned& tbeg_
#define TPASS , tacc_, tbeg_
#else
#define TARGS
#define TPASS
#define TDECL do {} while (0)
#define TBEG(k) do {} while (0)
#define TEND(k) do {} while (0)
#endif
DI float bf2f(bf16_t v) { return __uint_as_float((unsigned)v << 16); }
DI unsigned cvtpk(float lo, float hi) { f32x2 v = {lo, hi}; bf16x2_t b = __builtin_convertvector(v, bf16x2_t); return __builtin_bit_cast(unsigned, b); }
DI bf16_t f2bf(float x) { return (bf16_t)(cvtpk(x, 0.f) & 0xffffu); }
DI f32x4 mfma16(bf16x8 a, bf16x8 b, f32x4 c) { return __builtin_amdgcn_mfma_f32_16x16x32_bf16(a, b, c, 0, 0, 0); }
DI float fexp(float x) { return __builtin_amdgcn_exp2f(x * 1.4426950408889634f); }
DI float siluf(float x) { return x * __builtin_amdgcn_rcpf(1.f + fexp(-x)); }
DI float logsigf(float u) { return fminf(u, 0.f) - 0.6931471805599453f * __builtin_amdgcn_logf(1.f + fexp(-fabsf(u))); }
DI unsigned fkey(float x) { unsigned u = __float_as_uint(x); u = (u == 0x80000000u) ? 0u : u; return u ^ ((unsigned)((int)u >> 31) | 0x80000000u); }
DI float wsum64(float v) { v += __shfl_xor(v, 1); v += __shfl_xor(v, 2); v += __shfl_xor(v, 4); v += __shfl_xor(v, 8); v += __shfl_xor(v, 16); v += __shfl_xor(v, 32); return v; }
DI float wmax64(float v) { v = fmaxf(v, __shfl_xor(v, 1)); v = fmaxf(v, __shfl_xor(v, 2)); v = fmaxf(v, __shfl_xor(v, 4)); v = fmaxf(v, __shfl_xor(v, 8)); v = fmaxf(v, __shfl_xor(v, 16)); v = fmaxf(v, __shfl_xor(v, 32)); return v; }
DI unsigned lds_add(LAS3 unsigned* p, unsigned v) { return __hip_atomic_fetch_add(p, v, __ATOMIC_RELAXED, __HIP_MEMORY_SCOPE_WORKGROUP); }
DI unsigned lds_or(LAS3 unsigned* p, unsigned v) { return __hip_atomic_fetch_or(p, v, __ATOMIC_RELAXED, __HIP_MEMORY_SCOPE_WORKGROUP); }
DI void st_bf16x4(bf16_t* p, f32x4 v) { u32x2 w; w.x = cvtpk(v[0], v[1]); w.y = cvtpk(v[2], v[3]); *(u32x2*)p = w; }
DI const float* vaddr(const float* q) { asm volatile("" : "+v"(q)); return q; }
constexpr float LOG2E = 1.4426950408889634f;
#define NEG_INF (-__builtin_inff())

DI int rope_perm(int vc) { return 64 * (vc >> 6) + 16 * ((vc >> 5) & 1) + (vc & 15) + 32 * ((vc >> 4) & 1); }
DI int rope_map(int vc) { return 64 * ((vc >> 5) & 3) + 32 * ((vc >> 4) & 1) + 8 * ((vc >> 2) & 3) + 4 * (vc >> 7) + (vc & 3); }
DI int plain_map(int vc) { return (vc & ~31) + 8 * ((vc >> 2) & 3) + 4 * ((vc >> 4) & 1) + (vc & 3); }
DI int in_src(int np) {
    const int pn = np >> 8, vc = np & 255;
    switch (pn) {
        case 0: return plain_map(vc);
        case 1: return 256 + plain_map(vc);
        case 2: case 3: return 512 + 256 * (pn - 2) + plain_map(vc);
        case 4: case 5: return 1040 + 256 * (pn - 4) + plain_map(vc);
        case 6: return 1552 + rope_map(vc);
        case 7: return 1808 + rope_map(vc);
        case 8: return 2064 + plain_map(vc);
        case 9: return 2320 + rope_map(vc);
        case 10: return 2644 + plain_map(vc);
        case 11: return 2900 + plain_map(vc);
        case 12: return 3156 + plain_map(vc);
        default: break;
    }
    if (vc < 64) return 2576 + rope_perm(vc);
    if (vc < 68) return 2640 + (vc - 64);
    if (vc < 84) return 1024 + (vc - 68);
    return -1;
}

struct EpiIn {
    static constexpr bool PERM = false, AFTER_DRAIN = false;
    unsigned char* ws; float* out;
    DI void operator()(const f32x4 (&acc)[2][2][4][2], const pg8::Unit& u, int wr, int wc, int fr, int fq) const {
        const int pn = u.pn, rbase = u.pm * 256 + wr * 64 + fr;
        if (pn <= 5 || (pn >= 10 && pn <= 12)) {
            bf16_t* dst; int ldc = 256, coff = 0; float sc = 1.f; bool silu = false;
            switch (pn) {
                case 0: dst = (bf16_t*)(ws + W_GQ); sc = 0.125f; break;
                case 1: dst = (bf16_t*)(ws + W_GK); break;
                case 2: dst = (bf16_t*)(ws + W_GV); ldc = 512; break;
                case 3: dst = (bf16_t*)(ws + W_GV); ldc = 512; coff = 256; break;
                case 4: dst = (bf16_t*)(ws + W_GG); ldc = 512; silu = true; break;
                case 5: dst = (bf16_t*)(ws + W_GG); ldc = 512; coff = 256; silu = true; break;
                case 10: dst = (bf16_t*)(ws + W_DG); silu = true; break;
                case 11: dst = (bf16_t*)(ws + W_MQ); sc = 0.125f * LOG2E; break;
                default: dst = (bf16_t*)(ws + W_MG); silu = true; break;
            }
#pragma unroll
            for (int ai = 0; ai < 2; ++ai)
#pragma unroll
                for (int m = 0; m < 4; ++m) {
                    const int row = rbase + ai * 128 + m * 16;
                    bf16_t* rp = dst + (size_t)row * ldc + coff + wc * 32 + 8 * fq;
#pragma unroll
                    for (int bj = 0; bj < 2; ++bj) {
                        f32x4 v0 = acc[ai][bj][m][0], v1 = acc[ai][bj][m][1];
                        if (silu) { v0[0] = siluf(v0[0]); v0[1] = siluf(v0[1]); v0[2] = siluf(v0[2]); v0[3] = siluf(v0[3]); v1[0] = siluf(v1[0]); v1[1] = siluf(v1[1]); v1[2] = siluf(v1[2]); v1[3] = siluf(v1[3]); }
                        else { v0 = v0 * sc; v1 = v1 * sc; }
                        u32x4 w; w.x = cvtpk(v0[0], v0[1]); w.y = cvtpk(v0[2], v0[3]); w.z = cvtpk(v1[0], v1[1]); w.w = cvtpk(v1[2], v1[3]);
                        *(u32x4*)(rp + bj * 128) = w;
                    }
                }
        } else if (pn == 6 || pn == 7 || pn == 9) {
            bf16_t* dst = (bf16_t*)(ws + (pn == 6 ? W_DQ : (pn == 7 ? W_DK : W_IQ)));
            const float sc = (pn == 6) ? 0.125f * LOG2E : 1.f;
            const float* rope = (const float*)(ws + W_ROPE);
#pragma unroll
            for (int ai = 0; ai < 2; ++ai)
#pragma unroll
                for (int m = 0; m < 4; ++m) {
                    const int row = rbase + ai * 128 + m * 16;
                    const int pi = row < MP ? (row & 2047) : 2048;
                    const float* rp = rope + ((size_t)pi * 32 + 8 * fq) * 2;
                    f32x4 o1[2], o2[2];
#pragma unroll
                    for (int bj = 0; bj < 2; ++bj) {
                        const f32x4 cs0 = *(const f32x4*)(rp + 8 * bj), cs1 = *(const f32x4*)(rp + 8 * bj + 4);
                        const f32x4 c = {cs0[0], cs0[2], cs1[0], cs1[2]}, s = {cs0[1], cs0[3], cs1[1], cs1[3]};
                        const f32x4 v0 = acc[ai][bj][m][0], v1 = acc[ai][bj][m][1];
                        o1[bj] = (v0 * c - v1 * s) * sc; o2[bj] = (v1 * c + v0 * s) * sc;
                    }
                    const int col1 = 64 * wc + 8 * fq, col2 = col1 + 32;
                    u32x4 w1, w2; w1.x = cvtpk(o1[0][0], o1[0][1]); w1.y = cvtpk(o1[0][2], o1[0][3]); w1.z = cvtpk(o1[1][0], o1[1][1]); w1.w = cvtpk(o1[1][2], o1[1][3]);
                    w2.x = cvtpk(o2[0][0], o2[0][1]); w2.y = cvtpk(o2[0][2], o2[0][3]); w2.z = cvtpk(o2[1][0], o2[1][1]); w2.w = cvtpk(o2[1][2], o2[1][3]);
                    *(u32x4*)(dst + (size_t)row * 256 + col1) = w1; *(u32x4*)(dst + (size_t)row * 256 + col2) = w2;
                    if (pn == 7) {
                        float* op = nullptr;
                        if (row < MP) op = out + O_KP + (size_t)row * 256; else if (row < MP + NDB) op = out + O_KS + (size_t)(row - MP) * 256;
                        if (op) { *(f32x4*)(op + col1) = o1[0]; *(f32x4*)(op + col1 + 4) = o1[1]; *(f32x4*)(op + col2) = o2[0]; *(f32x4*)(op + col2 + 4) = o2[1]; }
                    }
                }
        } else if (pn == 8) {
            bf16_t* dvt = (bf16_t*)(ws + W_DVT);
#pragma unroll
            for (int ai = 0; ai < 2; ++ai)
#pragma unroll
                for (int m = 0; m < 4; ++m) {
                    const int row = rbase + ai * 128 + m * 16;
                    float* op = nullptr;
                    if (row < MP) op = out + O_VP + (size_t)row * 256; else if (row < MP + NDB) op = out + O_VS + (size_t)(row - MP) * 256;
#pragma unroll
                    for (int bj = 0; bj < 2; ++bj)
#pragma unroll
                        for (int n = 0; n < 2; ++n) {
                            const f32x4 v = acc[ai][bj][m][n];
                            const int col = 128 * bj + 32 * wc + 8 * fq + 4 * n;
                            if (op) *(f32x4*)(op + col) = v;
                            if (row < MP) {
                                const int t_ = row & 2047, kk_ = t_ & 31;
                                bf16_t* tp = dvt + ((((size_t)(row >> 11) * 64 + (t_ >> 5)) * 4 + (col >> 6)) * 64 + (col & 63)) * 32 + 8 * ((kk_ >> 2) & 3) + 4 * (kk_ >> 4) + (kk_ & 3);
                                tp[0] = f2bf(v[0]); tp[32] = f2bf(v[1]); tp[64] = f2bf(v[2]); tp[96] = f2bf(v[3]);
                            }
                        }
                }
        } else {
            bf16_t* ikb = (bf16_t*)(ws + W_IK); float* iw = (float*)(ws + W_IW); float* glr = (float*)(ws + W_GLR);
            const float* rope = (const float*)(ws + W_ROPE);
#pragma unroll
            for (int ai = 0; ai < 2; ++ai)
#pragma unroll
                for (int m = 0; m < 4; ++m) {
                    const int row = rbase + ai * 128 + m * 16;
                    const f32x4 v0 = acc[ai][0][m][0], v1 = acc[ai][0][m][1];
                    if (wc < 2) {
                        const int pi = row < MP ? (row & 2047) : 2048;
                        const int f0 = 16 * wc + 4 * fq;
                        const f32x4 cs0 = *(const f32x4*)(rope + ((size_t)pi * 32 + f0) * 2), cs1 = *(const f32x4*)(rope + ((size_t)pi * 32 + f0) * 2 + 4);
                        const f32x4 c = {cs0[0], cs0[2], cs1[0], cs1[2]}, s = {cs0[1], cs0[3], cs1[1], cs1[3]};
                        const f32x4 o1 = v0 * c - v1 * s, o2 = v1 * c + v0 * s;
                        st_bf16x4(ikb + (size_t)row * 64 + f0, o1); st_bf16x4(ikb + (size_t)row * 64 + f0 + 32, o2);
                        float* op = nullptr;
                        if (row < MP) op = out + O_IKP + (size_t)row * 64; else if (row < MP + NDB) op = out + O_IKS + (size_t)(row - MP) * 64;
                        if (op) { *(f32x4*)(op + f0) = o1; *(f32x4*)(op + f0 + 32) = o2; }
                    } else if (wc == 2) {
                        if (fq == 0) { *(f32x4*)(iw + (size_t)row * 4) = v0 * 0.5f; *(f32x4*)(glr + (size_t)row * 16 + 12) = v1; }
                        else *(f32x4*)(glr + (size_t)row * 16 + 4 * (fq - 1)) = v0;
                    }
                }
        }
    }
};
struct EpiMem {
    static constexpr bool PERM = false, AFTER_DRAIN = false;
    unsigned char* ws; float* out;
    DI void operator()(const f32x4 (&acc)[2][2][4][2], const pg8::Unit& u, int wr, int wc, int fr, int fq) const {
        const int pn = u.pn, rbase = u.pm * 256 + wr * 64 + fr;
        bf16_t* mk = (bf16_t*)(ws + W_MK); bf16_t* mvt = (bf16_t*)(ws + W_MVT);
        float* op0 = out + (pn == 0 ? O_MKP : O_MVP);
#pragma unroll
        for (int ai = 0; ai < 2; ++ai)
#pragma unroll
            for (int m = 0; m < 4; ++m) {
                const int row = rbase + ai * 128 + m * 16;
#pragma unroll
                for (int bj = 0; bj < 2; ++bj)
#pragma unroll
                    for (int n = 0; n < 2; ++n) {
                        const f32x4 v = acc[ai][bj][m][n];
                        const int col = 128 * bj + 32 * wc + 16 * n + 4 * fq;
                        *(f32x4*)(op0 + (size_t)row * 256 + col) = v;
                        if (pn == 0) st_bf16x4(mk + (size_t)row * 256 + col, v);
                        else { const int m_ = row & 255, kk_ = m_ & 31;
                               bf16_t* tp = mvt + ((((size_t)(row >> 8) * 8 + (m_ >> 5)) * 4 + (col >> 6)) * 64 + (col & 63)) * 32 + 8 * ((kk_ >> 2) & 3) + 4 * (kk_ >> 4) + (kk_ & 3);
                               tp[0] = f2bf(v[0]); tp[32] = f2bf(v[1]); tp[64] = f2bf(v[2]); tp[96] = f2bf(v[3]); }
                    }
            }
    }
};
struct EpiOut {
    static constexpr bool PERM = false, AFTER_DRAIN = false;
    const float* xp; const float* xs; float* out;
    DI void operator()(const f32x4 (&acc)[2][2][4][2], const pg8::Unit& u, int wr, int wc, int fr, int fq) const {
        const int rbase = u.pm * 256 + wr * 64 + fr, cbase = u.pn * 256 + wc * 32 + 4 * fq;
#pragma unroll
        for (int ai = 0; ai < 2; ++ai)
#pragma unroll
            for (int m = 0; m < 4; ++m) {
                const int row = rbase + ai * 128 + m * 16;
                const float* xr; float* orow;
                if (row < MP) { xr = xp + (size_t)row * DM; orow = out + O_YP + (size_t)row * DM; }
                else if (row < MP + NDB) { xr = xs + (size_t)(row - MP) * DM; orow = out + O_YS + (size_t)(row - MP) * DM; }
                else continue;
#pragma unroll
                for (int bj = 0; bj < 2; ++bj)
#pragma unroll
                    for (int n = 0; n < 2; ++n) { const int col = cbase + bj * 128 + n * 16; *(f32x4*)(orow + col) = acc[ai][bj][m][n] + *(const f32x4*)(xr + col); }
            }
    }
};
DI void p0_prologue(const Params& p, LAS3 unsigned char* lds) {
    const int tid = threadIdx.x, lane = tid & 63, wv = tid >> 6;
    unsigned char* ws = p.ws;
    {
        const int rstep = gridDim.x * 16, rend = MROWS + MMEM;
        int r0 = (blockIdx.x * 8 + wv) * 2;
        auto row_src = [&](int r) -> const float* {
            r = r < rend ? r : rend - 1;
            if (r < MP) return p.x_prompt + (size_t)r * DM;
            if (r < MP + NDB) return p.x_sample + (size_t)(r - MP) * DM;
            if (r < MROWS) return p.x_prompt;
            return p.mem_prompt + (size_t)(r - MROWS) * DM;
        };
        f32x4 v[2][4], vn[2][4];
#pragma unroll
        for (int e = 0; e < 2; ++e) { const float* s = row_src(r0 + e);
#pragma unroll
            for (int i = 0; i < 4; ++i) v[e][i] = *(const f32x4*)(s + i * 256 + lane * 4); }
        for (; r0 < rend; r0 += rstep) {
#pragma unroll
            for (int e = 0; e < 2; ++e) { const float* s = row_src(r0 + rstep + e);
#pragma unroll
                for (int i = 0; i < 4; ++i) vn[e][i] = *(const f32x4*)(s + i * 256 + lane * 4); }
#pragma unroll
            for (int e = 0; e < 2; ++e) {
                const int r = r0 + e;
                const bool pad = (r >= MP + NDB && r < MROWS);
                const float* g = r < MROWS ? p.norm_in : p.mem_norm;
                bf16_t* dst = r < MROWS ? (bf16_t*)(ws + W_XN) + (size_t)r * DM : (bf16_t*)(ws + W_MEMN) + (size_t)(r - MROWS) * DM;
                float ss = 0.f;
#pragma unroll
                for (int i = 0; i < 4; ++i) ss += v[e][i][0] * v[e][i][0] + v[e][i][1] * v[e][i][1] + v[e][i][2] * v[e][i][2] + v[e][i][3] * v[e][i][3];
                ss = wsum64(ss);
                const float rstd = pad ? 0.f : rsqrtf(ss * (1.f / DM) + 1e-6f);
#pragma unroll
                for (int i = 0; i < 4; ++i) { const f32x4 gv = *(const f32x4*)(g + i * 256 + lane * 4); st_bf16x4(dst + i * 256 + lane * 4, v[e][i] * rstd * gv); }
            }
#pragma unroll
            for (int e = 0; e < 2; ++e)
#pragma unroll
                for (int i = 0; i < 4; ++i) v[e][i] = vn[e][i];
        }
    }
    for (int e = blockIdx.x * NTHREADS + tid; e < 2049 * 32; e += gridDim.x * NTHREADS) {
        const int pi = e >> 5, f = e & 31;
        const float inv = powf(10000.0f, -(float)(2 * f) / 64.0f);
        const float ang = (float)(pi == 2048 ? 16384 : pi) * inv;
        float sn, cs; sincosf(ang, &sn, &cs);
        ((f32x2*)(ws + W_ROPE))[e] = (f32x2){cs, sn};
    }
    LAS3 float* tl = (LAS3 float*)lds;
    {
        auto tile_load = [&](int tile, float (&wr)[8]) {
            tile = tile < 1280 ? tile : 1279;
            int which, t2, ld; const float* W;
            if (tile < 896) { which = 0; t2 = tile; W = p.w_in; ld = DIN; }
            else if (tile < 1024) { which = 1; t2 = tile - 896; W = p.w_mem_kv; ld = 512; }
            else { which = 2; t2 = tile - 1024; W = p.w_out; ld = 1024; }
            const int nt = t2 >> 4, kt = t2 & 15;
            const int nn = tid & 63, kk0 = tid >> 6; const int np = nt * 64 + nn; int sc = which == 0 ? in_src(np) : np;
            const bool zero = sc < 0; sc = zero ? 0 : sc;
#pragma unroll
            for (int i = 0; i < 8; ++i) { const float w = W[(size_t)(kt * 64 + kk0 + 8 * i) * ld + sc]; wr[i] = zero ? 0.f : w; }
        };
        float wr[8], wn[8];
        tile_load(blockIdx.x, wr);
        for (int tile = blockIdx.x; tile < 1280; tile += gridDim.x) {
            bf16_t* dst; int t2;
            if (tile < 896) { t2 = tile; dst = (bf16_t*)(ws + W_WTIN); }
            else if (tile < 1024) { t2 = tile - 896; dst = (bf16_t*)(ws + W_WTMEM); }
            else { t2 = tile - 1024; dst = (bf16_t*)(ws + W_WTOUT); }
            const int nt = t2 >> 4, kt = t2 & 15;
            { const int nn = tid & 63, kk0 = tid >> 6;
#pragma unroll
              for (int i = 0; i < 8; ++i) tl[(kk0 + 8 * i) * 65 + nn] = wr[i]; }
            __syncthreads();
            tile_load(tile + gridDim.x, wn);
            { const int kk = tid & 63, nn0 = tid >> 6;
#pragma unroll
              for (int i = 0; i < 8; ++i) { const int n = nn0 + 8 * i; dst[(size_t)(nt * 64 + n) * 1024 + kt * 64 + kk] = f2bf(tl[kk * 65 + n]); } }
            __syncthreads();
#pragma unroll
            for (int i = 0; i < 8; ++i) wr[i] = wn[i];
        }
    }
}

DI void cnt_ge(unsigned& c, unsigned key, unsigned cand) { asm volatile("v_cmp_ge_u32 vcc, %1, %2\n\tv_addc_co_u32 %0, vcc, 0, %0, vcc" : "+v"(c) : "v"(key), "v"(cand) : "vcc"); }
DI void cnt_gt(unsigned& c, unsigned key, unsigned cand) { asm volatile("v_cmp_gt_u32 vcc, %1, %2\n\tv_addc_co_u32 %0, vcc, 0, %0, vcc" : "+v"(c) : "v"(key), "v"(cand) : "vcc"); }
DI void cnt_eq_lt(unsigned& c, unsigned key, unsigned T, unsigned idx, unsigned cand) {
    unsigned tmp;
    asm volatile("v_cmp_eq_u32 vcc, %2, %3\n\tv_cndmask_b32 %1, -1, %4, vcc\n\tv_cmp_lt_u32 vcc, %1, %5\n\tv_addc_co_u32 %0, vcc, 0, %0, vcc" : "+v"(c), "=&v"(tmp) : "v"(key), "v"(T), "v"(idx), "v"(cand) : "vcc"); }
DI unsigned grp_count16(unsigned c, LAS3 unsigned* CNT, int& it, int fr, int lane) {
    c += __shfl_xor(c, 16); c += __shfl_xor(c, 32);
    LAS3 unsigned* cur = CNT + (it % 3) * 16;
    if (lane < 16) lds_add(cur + fr, c);
    __syncthreads();
    const unsigned tot = cur[fr];
    if (threadIdx.x < 16) CNT[((it + 2) % 3) * 16 + threadIdx.x] = 0u;
    ++it; return tot;
}
DI unsigned blk_count(unsigned c, LAS3 unsigned* CNT, int& it, int lane) {
    c += __shfl_xor(c, 1); c += __shfl_xor(c, 2); c += __shfl_xor(c, 4); c += __shfl_xor(c, 8); c += __shfl_xor(c, 16); c += __shfl_xor(c, 32);
    LAS3 unsigned* cur = CNT + (it % 3) * 16;
    if (lane == 0) lds_add(cur, c);
    __syncthreads();
    const unsigned tot = cur[0];
    if (threadIdx.x == 0) CNT[((it + 2) % 3) * 16] = 0u;
    ++it; return tot;
}

DI float fmax3(float a, float b2, float c) { float d; asm("v_max3_f32 %0, %1, %2, %3" : "=v"(d) : "v"(a), "v"(b2), "v"(c)); return d; }
DI float mask_sel(int allones, float s) { return __uint_as_float(((unsigned)allones & __float_as_uint(s)) | (~(unsigned)allones & 0xff800000u)); }
DI float rowmax4(float x) {
    auto r = __builtin_amdgcn_permlane16_swap(__float_as_uint(x), __float_as_uint(x), false, false);
    const float y = fmax3(__uint_as_float(r[0]), __uint_as_float(r[1]), NEG_INF);
    r = __builtin_amdgcn_permlane32_swap(__float_as_uint(y), __float_as_uint(y), false, false);
    return fmax3(__uint_as_float(r[0]), __uint_as_float(r[1]), NEG_INF);
}
DI float rowsum4(float x) {
    auto r = __builtin_amdgcn_permlane16_swap(__float_as_uint(x), __float_as_uint(x), false, false);
    const float y = __uint_as_float(r[0]) + __uint_as_float(r[1]);
    r = __builtin_amdgcn_permlane32_swap(__float_as_uint(y), __float_as_uint(y), false, false);
    return __uint_as_float(r[0]) + __uint_as_float(r[1]);
}
template <bool MASKED>
DI void attn32(const bf16_t* Q, int ldq, const bf16_t* K, int ldk, const bf16_t* Vt, int ldv, int nkb, const LAS3 unsigned* mask, int fr, int fq,
               f32x4 (&o)[4][2], float (&linv)[2]) {
    bf16x8 qf[2][2];
#pragma unroll
    for (int qt = 0; qt < 2; ++qt)
#pragma unroll
        for (int ks = 0; ks < 2; ++ks) qf[qt][ks] = *(const bf16x8*)(Q + (size_t)(16 * qt + fr) * ldq + ks * 32 + fq * 8);
    float l[2] = {0.f, 0.f}; bool mset[2] = {false, false};
    const f32x4 zero = {0.f, 0.f, 0.f, 0.f};
    f32x4 cneg[2] = {zero, zero};
#pragma unroll
    for (int dt = 0; dt < 4; ++dt) { o[dt][0] = zero; o[dt][1] = zero; }
    const bf16_t* kl = K + (size_t)fr * ldk + fq * 8;
#ifdef BROKEN_VT
    const bf16_t* vl = Vt + fr * 32 + 8 * ((fq + 1) & 3);
#else
    const bf16_t* vl = Vt + fr * 32 + 8 * fq;
#endif
    bf16x8 kfA[2][2], kfB[2][2], vA[4], vB[4];
#define ATT_LOAD(KF, VF, kb_) do { \
        _Pragma("unroll") for (int i2 = 0; i2 < 2; ++i2) _Pragma("unroll") for (int ks = 0; ks < 2; ++ks) KF[i2][ks] = *(const bf16x8*)(kl + (size_t)(32 * (kb_) + 16 * i2) * ldk + ks * 32); \
        _Pragma("unroll") for (int dt = 0; dt < 4; ++dt) VF[dt] = *(const bf16x8*)(vl + (size_t)(kb_) * ldv + 512 * dt); } while (0)
#define ATT_COMPUTE(KF, VF, kb_) do {   \
        f32x4 s0[2], s1[2], p0[2], p1[2]; float mx[2]; bool need[2]; \
        _Pragma("unroll") for (int qt = 0; qt < 2; ++qt) { \
            s0[qt] = mfma16(KF[0][0], qf[qt][0], cneg[qt]); s0[qt] = mfma16(KF[0][1], qf[qt][1], s0[qt]); \
            s1[qt] = mfma16(KF[1][0], qf[qt][0], cneg[qt]); s1[qt] = mfma16(KF[1][1], qf[qt][1], s1[qt]); } \
        _Pragma("unroll") for (int qt = 0; qt < 2; ++qt) { \
            if (MASKED) { const unsigned mw = mask[(16 * qt + fr) * 65 + (kb_)]; const int b0 = (int)(mw >> (2 * fq)), b1 = (int)(mw >> (8 + 2 * fq)); \
                _Pragma("unroll") for (int r = 0; r < 4; ++r) { const int sh_ = (r >> 1) + 16 * (r & 1); s0[qt][r] = mask_sel(__builtin_amdgcn_sbfe(b0, sh_, 1), s0[qt][r]); s1[qt][r] = mask_sel(__builtin_amdgcn_sbfe(b1, sh_, 1), s1[qt][r]); } } \
            float t;   \
            if (MASKED) t = fmax3(fmax3(s0[qt][0], s0[qt][1], s0[qt][2]), fmax3(s0[qt][3], s1[qt][0], s1[qt][1]), fmax3(s1[qt][2], s1[qt][3], NEG_INF)); \
            else t = fmax3(fmax3(__builtin_amdgcn_fmed3f(s0[qt][0], s0[qt][1], -NEG_INF), __builtin_amdgcn_fmed3f(s0[qt][2], s0[qt][3], -NEG_INF), __builtin_amdgcn_fmed3f(s1[qt][0], s1[qt][1], -NEG_INF)), __builtin_amdgcn_fmed3f(s1[qt][2], s1[qt][3], -NEG_INF), NEG_INF); \
            mx[qt] = rowmax4(t); \
            need[qt] = (mx[qt] > 8.f) | (!mset[qt] & (mx[qt] > NEG_INF)); } \
        if (__any(need[0] | need[1])) { \
            _Pragma("unroll") for (int qt = 0; qt < 2; ++qt) { \
                const float delta = need[qt] ? mx[qt] : 0.f, alpha = __builtin_amdgcn_exp2f(-delta); \
                _Pragma("unroll") for (int r = 0; r < 4; ++r) { p0[qt][r] = __builtin_amdgcn_exp2f(s0[qt][r] - delta); p1[qt][r] = __builtin_amdgcn_exp2f(s1[qt][r] - delta); } \
                l[qt] = l[qt] * alpha + (((p0[qt][0] + p0[qt][1]) + (p0[qt][2] + p0[qt][3])) + ((p1[qt][0] + p1[qt][1]) + (p1[qt][2] + p1[qt][3]))); \
                _Pragma("unroll") for (int dt = 0; dt < 4; ++dt) o[dt][qt] = o[dt][qt] * alpha; \
                cneg[qt] = cneg[qt] - delta; mset[qt] = mset[qt] | need[qt]; } \
        } else { \
            _Pragma("unroll") for (int qt = 0; qt < 2; ++qt) { \
                _Pragma("unroll") for (int r = 0; r < 4; ++r) { p0[qt][r] = __builtin_amdgcn_exp2f(s0[qt][r]); p1[qt][r] = __builtin_amdgcn_exp2f(s1[qt][r]); } \
                l[qt] += ((p0[qt][0] + p0[qt][1]) + (p0[qt][2] + p0[qt][3])) + ((p1[qt][0] + p1[qt][1]) + (p1[qt][2] + p1[qt][3])); } \
        } \
        _Pragma("unroll") for (int qt = 0; qt < 2; ++qt) { \
            u32x4 pw; pw.x = cvtpk(p0[qt][0], p0[qt][1]); pw.y = cvtpk(p0[qt][2], p0[qt][3]); pw.z = cvtpk(p1[qt][0], p1[qt][1]); pw.w = cvtpk(p1[qt][2], p1[qt][3]); \
            const bf16x8 pf = __builtin_bit_cast(bf16x8, pw); \
            _Pragma("unroll") for (int dt = 0; dt < 4; ++dt) o[dt][qt] = mfma16(VF[dt], pf, o[dt][qt]); } } while (0)
    ATT_LOAD(kfA, vA, 0);
    const int last = nkb - 1;
    for (int kb = 0; kb < nkb; kb += 2) {
        ATT_LOAD(kfB, vB, kb + 1);
        ATT_COMPUTE(kfA, vA, kb);
        { const int k2 = kb + 2 < last ? kb + 2 : last; ATT_LOAD(kfA, vA, k2); }
        ATT_COMPUTE(kfB, vB, kb + 1);
    }
#undef ATT_LOAD
#undef ATT_COMPUTE
#pragma unroll
    for (int qt = 0; qt < 2; ++qt) linv[qt] = 1.f / rowsum4(l[qt]);
}
DI void attn_store(const f32x4 (&o)[4][2], const float (&linv)[2], const bf16_t* gate  , bf16_t* mix  , int fr, int fq) {
#pragma unroll
    for (int qt = 0; qt < 2; ++qt)
#pragma unroll
        for (int dt = 0; dt < 4; ++dt) {
            const size_t row = 16 * qt + fr; const int col = 16 * dt + 4 * fq;
            const u32x2 gw = *(const u32x2*)(gate + row * 256 + col);
            f32x4 v = o[dt][qt] * linv[qt];
            v[0] *= __uint_as_float(gw.x << 16); v[1] *= __uint_as_float(gw.x & 0xffff0000u); v[2] *= __uint_as_float(gw.y << 16); v[3] *= __uint_as_float(gw.y & 0xffff0000u);
            st_bf16x4(mix + row * 1024 + col, v);
        }
}

constexpr int DS_MASK = 0, DS_PKT = 16640, PKT_LD = 2052, DS_CNT = 147968;
typedef unsigned short u16x2 __attribute__((ext_vector_type(2)));
DI unsigned pk_cnt_ge(unsigned acc, unsigned kpair, unsigned cm1, unsigned ones) {
    unsigned t;
    asm("v_pk_sub_u16 %1, %2, %3 clamp\n\tv_pk_min_u16 %1, %1, %4\n\tv_pk_add_u16 %0, %0, %1" : "+v"(acc), "=&v"(t) : "v"(kpair), "v"(cm1), "v"(ones));
    return acc;
}
DI void select_bitwise(const unsigned (&key)[16][4], int lbase, LAS3 unsigned* CNT, int& it, int fr, int lane, unsigned& T, int& Xrel) {
    bool fin = false;
    T = 0u; Xrel = 0x7fffffff;
    for (int bit = 31; bit >= 0; --bit) {
        const unsigned cand = T | (1u << bit);
        unsigned c = 0;
#pragma unroll
        for (int n = 0; n < 16; ++n)
#pragma unroll
            for (int r = 0; r < 4; ++r) cnt_ge(c, key[n][r], cand);
        const unsigned tot = grp_count16(c, CNT, it, fr, lane);
        if (!fin && tot >= 256u) { T = cand; fin = (tot == 256u); }
        if (__all(fin)) break;
    }
    if (!__all(fin)) {
        unsigned c = 0;
#pragma unroll
        for (int n = 0; n < 16; ++n)
#pragma unroll
            for (int r = 0; r < 4; ++r) cnt_gt(c, key[n][r], T);
        const unsigned cgt = grp_count16(c, CNT, it, fr, lane);
        const unsigned need = 256u - cgt;
        unsigned Xl = 0u;
        for (int bit = 10; bit >= 0; --bit) {
            const unsigned cand = Xl | (1u << bit);
            const int crel = (int)cand - lbase;
            c = 0;
#pragma unroll
            for (int n = 0; n < 16; ++n) { const int crn = crel - 128 * n;
#pragma unroll
                for (int r = 0; r < 4; ++r) c += (key[n][r] == T && r < crn) ? 1u : 0u; }
            const unsigned tot = grp_count16(c, CNT, it, fr, lane);
            if (tot < need) Xl = cand;
        }
        if (!fin) Xrel = (int)Xl - lbase;
    }
}
DI unsigned pk_flag_ge(unsigned kpair, unsigned cm1, unsigned ones) {
    unsigned t;
    asm("v_pk_sub_u16 %0, %1, %2 clamp\n\tv_pk_min_u16 %0, %0, %3" : "=&v"(t) : "v"(kpair), "v"(cm1), "v"(ones));
    return t;
}
DI unsigned pk_max(unsigned a, unsigned b2) { unsigned t; asm("v_pk_max_u16 %0, %1, %2" : "=v"(t) : "v"(a), "v"(b2)); return t; }
DI unsigned hsum32(unsigned x) {
    x += __builtin_amdgcn_update_dpp(0u, x, 0xB1, 0xF, 0xF, false); x += __builtin_amdgcn_update_dpp(0u, x, 0x4E, 0xF, 0xF, false);
    x += __builtin_amdgcn_update_dpp(0u, x, 0x141, 0xF, 0xF, false); x += __builtin_amdgcn_update_dpp(0u, x, 0x140, 0xF, 0xF, false);
    const auto r = __builtin_amdgcn_permlane16_swap(x, x, false, false); return r[0] + r[1];
}
DI unsigned hmax32(unsigned x) {
    x = max(x, (unsigned)__builtin_amdgcn_update_dpp(0u, x, 0xB1, 0xF, 0xF, false)); x = max(x, (unsigned)__builtin_amdgcn_update_dpp(0u, x, 0x4E, 0xF, 0xF, false));
    x = max(x, (unsigned)__builtin_amdgcn_update_dpp(0u, x, 0x141, 0xF, 0xF, false)); x = max(x, (unsigned)__builtin_amdgcn_update_dpp(0u, x, 0x140, 0xF, 0xF, false));
    const auto r = __builtin_amdgcn_permlane16_swap(x, x, false, false); return max(r[0], r[1]);
}
DI unsigned pk_count32(const unsigned (&rk)[32], unsigned cm1, unsigned ones, int nq) {
    unsigned a0 = 0u, a1 = 0u;
#pragma unroll
    for (int k = 0; k < 8; k += 2) { a0 = pk_cnt_ge(a0, rk[k], cm1, ones); a1 = pk_cnt_ge(a1, rk[k + 1], cm1, ones); }
    if (nq > 1) {
#pragma unroll
        for (int k = 8; k < 16; k += 2) { a0 = pk_cnt_ge(a0, rk[k], cm1, ones); a1 = pk_cnt_ge(a1, rk[k + 1], cm1, ones); }
        if (nq > 2) {
#pragma unroll
            for (int k = 16; k < 24; k += 2) { a0 = pk_cnt_ge(a0, rk[k], cm1, ones); a1 = pk_cnt_ge(a1, rk[k + 1], cm1, ones); }
            if (nq > 3) {
#pragma unroll
                for (int k = 24; k < 32; k += 2) { a0 = pk_cnt_ge(a0, rk[k], cm1, ones); a1 = pk_cnt_ge(a1, rk[k + 1], cm1, ones); }
            }
        }
    }
    return (a0 & 0xffffu) + (a0 >> 16) + (a1 & 0xffffu) + (a1 >> 16);
}
DI void dsa_unit(const Params& p, LAS3 unsigned char* lds, int b, int j TARGS) {
    int tid = threadIdx.x; asm volatile("" : "+v"(tid));
    const int lane0 = tid & 63, w = __builtin_amdgcn_readfirstlane(tid >> 6);
    unsigned char* ws = p.ws;
    LAS3 unsigned* MASK = (LAS3 unsigned*)(lds + DS_MASK);
    LAS3 unsigned* PKT = (LAS3 unsigned*)(lds + DS_PKT);
    const bf16_t* IQ = (const bf16_t*)(ws + W_IQ); const bf16_t* IK = (const bf16_t*)(ws + W_IK); const float* IW = (const float*)(ws + W_IW);
    const int q0 = 64 * j;
    const f32x4 zero = {0.f, 0.f, 0.f, 0.f};
#ifdef CHECK_SEL
    LAS3 unsigned* CNT = (LAS3 unsigned*)(lds + DS_CNT); int it = 0;
    if (tid < 48) CNT[tid] = 0u;
    __syncthreads();
#endif
    TBEG(30);
    bf16x8 bqn[4][2]; f32x4 wqn;
    { const size_t qr0 = (size_t)b * SEQ + q0 + (lane0 & 15);
#pragma unroll
      for (int h = 0; h < 4; ++h)
#pragma unroll
          for (int ks = 0; ks < 2; ++ks) bqn[h][ks] = *(const bf16x8*)(IQ + qr0 * 256 + h * 64 + ks * 32 + (lane0 >> 4) * 8);
      wqn = *(const f32x4*)(IW + qr0 * 4); }
#pragma unroll 1
    for (int qg = 0; qg < 4; ++qg) {
        TBEG(32);
        int lane = lane0; asm volatile("" : "+v"(lane));
        const int fr = lane & 15, fq = lane >> 4;
        const int tq = q0 + 16 * qg + fr; const size_t qrow = (size_t)b * SEQ + tq;
        const int ntile = 4 * j + qg + 1;
        const int nloc = ntile > w ? (ntile - w + 7) >> 3 : 0;
        const bool selecting = q0 + 16 * qg >= 256;
        {
            bf16x8 bq[4][2];
#pragma unroll
            for (int h = 0; h < 4; ++h)
#pragma unroll
                for (int ks = 0; ks < 2; ++ks) bq[h][ks] = bqn[h][ks];
            const f32x4 wq = wqn;
            float Lh[4];
#pragma unroll
            for (int h = 0; h < 4; ++h) Lh[h] = wq[h] < 0.f ? NEG_INF : -NEG_INF;
            const char* tb = (const char*)IK + ((size_t)b * SEQ + 16 * w) * 128 + (unsigned)(fr * 128 + fq * 16);
            LAS3 unsigned* krow = PKT + fr * PKT_LD + 16 * w + 4 * fq;
            const int lim0 = tq - (16 * w + 4 * fq);
#define DSA_TILE(A0, A1, nn) do { \
                f32x4 sc = zero; \
                _Pragma("unroll") for (int h = 0; h < 4; ++h) { f32x4 d = mfma16(A0, bq[h][0], zero); d = mfma16(A1, bq[h][1], d); d = d * wq[h]; \
                    _Pragma("unroll") for (int r = 0; r < 4; ++r) sc[r] += __builtin_amdgcn_fmed3f(d[r], 0.f, Lh[h]); } \
                { const char* t2_ = tb + (size_t)((nn) + 2 < nloc ? (nn) + 2 : nloc - 1) * 16384; A0 = *(const bf16x8*)t2_; A1 = *(const bf16x8*)(t2_ + 64); } \
                const int limn = lim0 - 128 * (nn);                   \
                u32x4 kv; \
                _Pragma("unroll") for (int r = 0; r < 4; ++r) { const unsigned u = __float_as_uint(sc[r] + 0.f); const unsigned k = u ^ ((unsigned)((int)u >> 31) | 0x80000000u);   \
                    kv[r] = (r <= limn) ? k : 0u; } \
                *(LAS3 u32x4*)(krow + 128 * (nn)) = kv; } while (0)
            if (nloc > 0) {
                bf16x8 a0 = *(const bf16x8*)tb, a1 = *(const bf16x8*)(tb + 64);
                const char* t1 = tb + (size_t)(1 < nloc ? 1 : 0) * 16384;
                bf16x8 b0 = *(const bf16x8*)t1, b1 = *(const bf16x8*)(t1 + 64);
#pragma unroll 1
                for (int n = 0; n < nloc; n += 2) {
                    DSA_TILE(a0, a1, n);
                    if (n + 1 < nloc) DSA_TILE(b0, b1, n + 1);
                }
            }
#undef DSA_TILE
        }
        TEND(32); TBEG(33);
        __syncthreads();
        { const size_t qrn = qrow + (qg < 3 ? 16 : 0);
#pragma unroll
          for (int h = 0; h < 4; ++h)
#pragma unroll
              for (int ks = 0; ks < 2; ++ks) bqn[h][ks] = *(const bf16x8*)(IQ + qrn * 256 + h * 64 + ks * 32 + fq * 8);
          wqn = *(const f32x4*)(IW + qrn * 4); }
        {
            const int hh = lane >> 5, pos = lane & 31, oq = 2 * w + hh;
            const unsigned nkeys = 16u * (unsigned)ntile;
            const int nq = (int)((nkeys + 511u) >> 9);
            const LAS3 unsigned* orow = PKT + oq * PKT_LD + 2 * pos;
            unsigned ones = 0x00010001u; asm volatile("" : "+v"(ones));
            unsigned Tfull = 1u, X = 0xffffffffu;
            if (selecting) {
                unsigned rk[32];
                unsigned mx = 0u;
#define RK_FILL(k0) do { _Pragma("unroll") for (int k = (k0); k < (k0) + 8; ++k) { const u32x2 kk = *(const LAS3 u32x2*)(orow + 64 * k); \
                        rk[k] = (2u * (unsigned)(pos + 32 * k) < nkeys) ? __builtin_amdgcn_perm(kk.y, kk.x, 0x07060302u) : 0u; mx = pk_max(mx, rk[k]); } } while (0)
                RK_FILL(0);
                if (nq > 1) { RK_FILL(8); if (nq > 2) { RK_FILL(16); if (nq > 3) { RK_FILL(24); } } }
#undef RK_FILL
                const unsigned kmax = hmax32(max(mx & 0xffffu, mx >> 16));
                unsigned T16 = 0u, cabove = 0u; bool exact = false;
                {
                    unsigned ub = 0x10000u;
#pragma unroll 1
                    for (int bit = 15; bit >= 0; --bit) {
                        const unsigned cand = T16 | (1u << bit);
                        if (__all(cand > kmax)) { ub = cand; continue; }
                        const unsigned tot = hsum32(pk_count32(rk, (cand - 1u) * 0x00010001u, ones, nq));
                        if (tot >= 256u) T16 = cand; else { ub = cand; cabove = tot; }
                    }
                    (void)ub;
                }
                const unsigned need = 256u - cabove;
#define RK_LOW(k0) do { _Pragma("unroll") for (int k = (k0); k < (k0) + 8; ++k) { const u32x2 kk = *(const LAS3 u32x2*)(orow + 64 * k); const bool in = 2u * (unsigned)(pos + 32 * k) < nkeys; \
                        const unsigned lo0 = (in && (kk.x >> 16) == T16) ? (kk.x & 0xffffu) : 0u, lo1 = (in && (kk.y >> 16) == T16) ? (kk.y & 0xffffu) : 0u; rk[k] = lo0 | (lo1 << 16); } } while (0)
                RK_LOW(0);
                if (nq > 1) { RK_LOW(8); if (nq > 2) { RK_LOW(16); if (nq > 3) { RK_LOW(24); } } }
#undef RK_LOW
                unsigned Tlo = 0u;
#pragma unroll 1
                for (int bit = 15; bit >= 0; --bit) {
                    const unsigned cand = Tlo | (1u << bit);
                    const unsigned tot = hsum32(pk_count32(rk, (cand - 1u) * 0x00010001u, ones, nq));
                    if (!exact && tot >= need) { Tlo = cand; exact = (tot == need); }
                    if (__all(exact)) break;
                }
                Tfull = (T16 << 16) | Tlo;
                if (!__all(exact)) {
                    unsigned cgt = 0u, ceq = 0u;
#pragma unroll 1
                    for (int k = 0; k < 8 * nq; ++k) { const u32x2 kk = *(const LAS3 u32x2*)(orow + 64 * k); const bool in = 2u * (unsigned)(pos + 32 * k) < nkeys;
                        cgt += (in && kk.x > Tfull && (kk.x >> 16) == T16 ? 1u : 0u) + (in && kk.y > Tfull && (kk.y >> 16) == T16 ? 1u : 0u); }
                    (void)ceq;
                    const unsigned needt = need - hsum32(cgt);
                    unsigned Xl = 0u;
#pragma unroll 1
                    for (int bit = 10; bit >= 0; --bit) {
                        const unsigned cx = Xl | (1u << bit);
                        unsigned c = 0u;
#pragma unroll 1
                        for (int k = 0; k < 8 * nq; ++k) { const u32x2 kk = *(const LAS3 u32x2*)(orow + 64 * k); const unsigned i0 = 2u * (unsigned)(pos + 32 * k);
                            c += (i0 < nkeys && kk.x == Tfull && i0 < cx ? 1u : 0u) + (i0 < nkeys && kk.y == Tfull && i0 + 1u < cx ? 1u : 0u); }
                        if (hsum32(c) < needt) Xl = cx;
                    }
                    if (!exact) X = Xl;
                }
            }
            LAS3 unsigned* mrow = MASK + (16 * qg + oq) * 65 + (pos >> 4);
            const unsigned sh = 32u * hh + (pos & 16);
            if (__all(X == 0xffffffffu)) {
                int k = 0;
#pragma unroll 1
                for (; k + 4 <= j; k += 4) {
                    u32x2 kk[4];
#pragma unroll
                    for (int u = 0; u < 4; ++u) kk[u] = *(const LAS3 u32x2*)(orow + 64 * (k + u));
                    unsigned wv[4];
#pragma unroll
                    for (int u = 0; u < 4; ++u) { const unsigned long long blo = __ballot(kk[u].x >= Tfull), bhi = __ballot(kk[u].y >= Tfull);
                        wv[u] = ((unsigned)(blo >> sh) & 0xffffu) | ((unsigned)(bhi >> sh) << 16); }
                    if ((pos & 15) == 0) {
#pragma unroll
                        for (int u = 0; u < 4; ++u) mrow[2 * (k + u)] = wv[u]; }
                }
#pragma unroll 1
                for (; k < j; ++k) {
                    const u32x2 kk = *(const LAS3 u32x2*)(orow + 64 * k);
                    const unsigned long long blo = __ballot(kk.x >= Tfull), bhi = __ballot(kk.y >= Tfull);
                    const unsigned wv = ((unsigned)(blo >> sh) & 0xffffu) | ((unsigned)(bhi >> sh) << 16);
                    if ((pos & 15) == 0) mrow[2 * k] = wv;
                }
                {
                    const u32x2 kk = *(const LAS3 u32x2*)(orow + 64 * j); const bool in = 2u * (unsigned)(pos + 32 * j) < nkeys;
                    const unsigned long long blo = __ballot(in && kk.x >= Tfull), bhi = __ballot(in && kk.y >= Tfull);
                    const unsigned wv = ((unsigned)(blo >> sh) & 0xffffu) | ((unsigned)(bhi >> sh) << 16);
                    if ((pos & 15) == 0) mrow[2 * j] = wv;
                }
            } else {
#pragma unroll 1
                for (int k = 0; k <= j; ++k) {
                    const u32x2 kk = *(const LAS3 u32x2*)(orow + 64 * k); const unsigned i0 = 2u * (unsigned)(pos + 32 * k);
                    const bool s0 = i0 < nkeys && (kk.x > Tfull || (kk.x == Tfull && i0 <= X)), s1 = i0 < nkeys && (kk.y > Tfull || (kk.y == Tfull && i0 + 1u <= X));
                    const unsigned long long blo = __ballot(s0), bhi = __ballot(s1);
                    const unsigned wv = ((unsigned)(blo >> sh) & 0xffffu) | ((unsigned)(bhi >> sh) << 16);
                    if ((pos & 15) == 0) mrow[2 * k] = wv;
                }
            }
        }
        TEND(33);
        __syncthreads();
#ifdef CHECK_SEL
        if (selecting) {
            const int lbase = 16 * w + 4 * fq;
            unsigned key[16][4];
#pragma unroll
            for (int n = 0; n < 16; ++n)
#pragma unroll
                for (int r = 0; r < 4; ++r) key[n][r] = (n < nloc) ? PKT[fr * PKT_LD + lbase + 128 * n + r] : 0u;
            unsigned T2; int X2; select_bitwise(key, lbase, CNT, it, fr, lane, T2, X2);
            bool bad = false;
#pragma unroll
            for (int n = 0; n < 16; ++n) if (n < nloc) { const int x2 = X2 - 128 * n;
#pragma unroll
                for (int r = 0; r < 4; ++r) { const unsigned idx = (unsigned)(lbase + 128 * n + r); const unsigned mw = MASK[(16 * qg + fr) * 65 + (idx >> 5)];
                    const bool s2 = key[n][r] > T2 || (key[n][r] == T2 && r <= x2); bad |= (s2 != (((mw >> (((idx & 31u) >> 1) + 16u * (idx & 1u))) & 1u) != 0u)); } }
            if (__any(bad) && lane == 0) atomicAdd((unsigned*)(ws + CW_CHK), 1u);
            if (lane == 0 && w == 0) atomicAdd((unsigned*)(ws + CW_CHK + 4), 1u);
            __syncthreads();
        }
#endif
    }
    TEND(30); TBEG(31);
    {
        const int h = w & 3, hf = w >> 2, fr = lane0 & 15, fq = lane0 >> 4;
        const size_t qrow0 = (size_t)b * SEQ + q0 + 32 * hf;
        f32x4 o[4][2]; float linv[2];
        attn32<true>((const bf16_t*)(ws + W_DQ) + qrow0 * 256 + h * 64, 256, (const bf16_t*)(ws + W_DK) + (size_t)b * SEQ * 256 + h * 64, 256,
                     (const bf16_t*)(ws + W_DVT) + ((size_t)b * 64 * 4 + h) * 2048, 4 * 2048, 2 * j + 2  , MASK + 32 * hf * 65, fr, fq, o, linv);
        attn_store(o, linv, (const bf16_t*)(ws + W_DG) + qrow0 * 256 + h * 64, (bf16_t*)(ws + W_MIX) + qrow0 * 1024 + 512 + h * 64, fr, fq);
    }
    __syncthreads();
    TEND(31);
}
DI void mem_unit(const Params& p, int n) {
    const int tid = threadIdx.x, lane = tid & 63, w = __builtin_amdgcn_readfirstlane(tid >> 6), fr = lane & 15, fq = lane >> 4;
    unsigned char* ws = p.ws;
    const int h = w & 3, hf = w >> 2;
    const size_t qrow0 = (size_t)n * 64 + 32 * hf; const int b = n >> 5;
    f32x4 o[4][2]; float linv[2];
    attn32<false>((const bf16_t*)(ws + W_MQ) + qrow0 * 256 + h * 64, 256, (const bf16_t*)(ws + W_MK) + (size_t)b * NMEM * 256 + h * 64, 256,
                  (const bf16_t*)(ws + W_MVT) + ((size_t)b * 8 * 4 + h) * 2048, 4 * 2048, 8, nullptr, fr, fq, o, linv);
    attn_store(o, linv, (const bf16_t*)(ws + W_MG) + qrow0 * 256 + h * 64, (bf16_t*)(ws + W_MIX) + qrow0 * 1024 + 768 + h * 64, fr, fq);
}
constexpr int GL_QT = 0, GL_KT = 9216, GL_KPT = 18432, GL_VT = 27648, GL_SBT = 46080, GL_PM = 64512, GL_OF = 73728, GL_GTOT = 107520, GL_W2 = 109568, GL_BG = 113664, GL_DEC = 113920;
constexpr int LDP = 72;
DI void gla_unit(const Params& p, LAS3 unsigned char* lds, int b, int h) {
    const int tid = threadIdx.x, lane = tid & 63, w = __builtin_amdgcn_readfirstlane(tid >> 6), fr = lane & 15, fq = lane >> 4;
    unsigned char* ws = p.ws;
    LAS3 bf16_t* Qt = (LAS3 bf16_t*)(lds + GL_QT); LAS3 bf16_t* Kt = (LAS3 bf16_t*)(lds + GL_KT); LAS3 bf16_t* KpT = (LAS3 bf16_t*)(lds + GL_KPT);
    LAS3 bf16_t* Vt = (LAS3 bf16_t*)(lds + GL_VT); LAS3 bf16_t* SbT = (LAS3 bf16_t*)(lds + GL_SBT); LAS3 bf16_t* Pm = (LAS3 bf16_t*)(lds + GL_PM);
    LAS3 float* Of = (LAS3 float*)(lds + GL_OF); LAS3 float* gtot = (LAS3 float*)(lds + GL_GTOT); LAS3 float* w2s = (LAS3 float*)(lds + GL_W2);
    LAS3 float* bgs = (LAS3 float*)(lds + GL_BG); LAS3 float* dec = (LAS3 float*)(lds + GL_DEC);
    const bf16_t* GQ = (const bf16_t*)(ws + W_GQ); const bf16_t* GK = (const bf16_t*)(ws + W_GK); const bf16_t* GV = (const bf16_t*)(ws + W_GV);
    const bf16_t* GG = (const bf16_t*)(ws + W_GG); const float* GLR = (const float*)(ws + W_GLR); bf16_t* MIX = (bf16_t*)(ws + W_MIX);
    for (int i = tid; i < 128 * LDP / 2; i += NTHREADS) ((LAS3 unsigned*)SbT)[i] = 0u;
    for (int i = tid; i < 16 * 64; i += NTHREADS) w2s[i] = p.w_g2[(i >> 6) * 256 + h * 64 + (i & 63)];
    if (tid < 64) bgs[tid] = p.b_g[h * 64 + tid];
    __syncthreads();
    const int d = tid & 63, tg = w;
    float wreg[16];
#pragma unroll
    for (int r = 0; r < 16; ++r) wreg[r] = w2s[r * 64 + d];
    const float bgd = bgs[d];
    const f32x4 zero = {0.f, 0.f, 0.f, 0.f};
    f32x4 Sacc[4] = {zero, zero, zero, zero};
    const int tt = w & 3, vh = w >> 2;
    for (int c = 0; c < 32; ++c) {
        const size_t rb = (size_t)b * SEQ + c * 64;
        float g8[8];
#pragma unroll
        for (int i = 0; i < 8; ++i) {
            const float* gl = vaddr(GLR + (rb + tg * 8 + i) * 16);
            float u = bgd;
#pragma unroll
            for (int r = 0; r < 16; ++r) u += gl[r] * wreg[r];
            const float g = logsigf(u) * (1.f / 16.f);
            g8[i] = (i ? g8[i - 1] : 0.f) + g;
        }
        gtot[tg * 64 + d] = g8[7];
        __syncthreads();
        float off = 0.f, blast = 0.f;
#pragma unroll
        for (int g2 = 0; g2 < 8; ++g2) { const float v = gtot[g2 * 64 + d]; off += (g2 < tg) ? v : 0.f; blast += v; }
        float kp[8];
#pragma unroll
        for (int i = 0; i < 8; ++i) {
            const int t = tg * 8 + i; const float bt = off + g8[i];
            const float q = bf2f(GQ[(rb + t) * 256 + h * 64 + d]), k = bf2f(GK[(rb + t) * 256 + h * 64 + d]);
            Qt[t * LDP + d] = f2bf(q * fexp(bt)); Kt[t * LDP + d] = f2bf(k * fexp(-bt)); kp[i] = k * fexp(blast - bt);
        }
        { u32x4 kw; kw.x = cvtpk(kp[0], kp[1]); kw.y = cvtpk(kp[2], kp[3]); kw.z = cvtpk(kp[4], kp[5]); kw.w = cvtpk(kp[6], kp[7]); *(LAS3 u32x4*)(KpT + d * LDP + tg * 8) = kw; }
        if (tg == 0) dec[d] = fexp(blast);
        { const int v = tid & 127, sg = tid >> 7; bf16_t vv[16];
#pragma unroll
          for (int i = 0; i < 16; ++i) vv[i] = GV[(rb + sg * 16 + i) * 512 + h * 128 + v];
          u32x4 a, bb; a.x = vv[0] | ((unsigned)vv[1] << 16); a.y = vv[2] | ((unsigned)vv[3] << 16); a.z = vv[4] | ((unsigned)vv[5] << 16); a.w = vv[6] | ((unsigned)vv[7] << 16);
          bb.x = vv[8] | ((unsigned)vv[9] << 16); bb.y = vv[10] | ((unsigned)vv[11] << 16); bb.z = vv[12] | ((unsigned)vv[13] << 16); bb.w = vv[14] | ((unsigned)vv[15] << 16);
          *(LAS3 u32x4*)(Vt + v * LDP + sg * 16) = a; *(LAS3 u32x4*)(Vt + v * LDP + sg * 16 + 8) = bb; }
        __syncthreads();
#pragma unroll
        for (int s2 = 0; s2 < 2; ++s2) {
            const int st = 2 * vh + s2;
            f32x4 acc = zero;
#pragma unroll
            for (int ks = 0; ks < 2; ++ks) {
                const bf16x8 a = *(const LAS3 bf16x8*)(Kt + (st * 16 + fr) * LDP + ks * 32 + fq * 8), bq = *(const LAS3 bf16x8*)(Qt + (tt * 16 + fr) * LDP + ks * 32 + fq * 8);
                acc = mfma16(a, bq, acc);
            }
            const int t = tt * 16 + fr, s0 = st * 16 + 4 * fq;
            u32x2 pw; pw.x = cvtpk(s0 <= t ? acc[0] : 0.f, s0 + 1 <= t ? acc[1] : 0.f); pw.y = cvtpk(s0 + 2 <= t ? acc[2] : 0.f, s0 + 3 <= t ? acc[3] : 0.f);
            *(LAS3 u32x2*)(Pm + t * LDP + s0) = pw;
        }
        __syncthreads();
        f32x4 oacc[4];
        {
            bf16x8 aq[2], ap[2], ak[2];
#pragma unroll
            for (int ks = 0; ks < 2; ++ks) {
                aq[ks] = *(const LAS3 bf16x8*)(Qt + (tt * 16 + fr) * LDP + ks * 32 + fq * 8);
                ap[ks] = *(const LAS3 bf16x8*)(Pm + (tt * 16 + fr) * LDP + ks * 32 + fq * 8);
                ak[ks] = *(const LAS3 bf16x8*)(KpT + (tt * 16 + fr) * LDP + ks * 32 + fq * 8);
            }
            const f32x4 dv = *(const LAS3 f32x4*)(dec + tt * 16 + 4 * fq);
#pragma unroll
            for (int jv = 0; jv < 4; ++jv) {
                const int vt = vh * 4 + jv;
                bf16x8 bs[2], bv[2];
#pragma unroll
                for (int ks = 0; ks < 2; ++ks) {
                    bs[ks] = *(const LAS3 bf16x8*)(SbT + (vt * 16 + fr) * LDP + ks * 32 + fq * 8);
                    bv[ks] = *(const LAS3 bf16x8*)(Vt + (vt * 16 + fr) * LDP + ks * 32 + fq * 8);
                }
                f32x4 oa = mfma16(aq[0], bs[0], zero); oa = mfma16(aq[1], bs[1], oa); oa = mfma16(ap[0], bv[0], oa); oa = mfma16(ap[1], bv[1], oa);
                oacc[jv] = oa;
                f32x4 sa = Sacc[jv] * dv; sa = mfma16(ak[0], bv[0], sa); sa = mfma16(ak[1], bv[1], sa);
                Sacc[jv] = sa;
            }
        }
        __syncthreads();
#pragma unroll
        for (int jv = 0; jv < 4; ++jv) {
            const int vt = vh * 4 + jv;
#pragma unroll
            for (int r = 0; r < 4; ++r) Of[(tt * 16 + 4 * fq + r) * 132 + vt * 16 + fr] = oacc[jv][r];
            u32x2 sw; sw.x = cvtpk(Sacc[jv][0], Sacc[jv][1]); sw.y = cvtpk(Sacc[jv][2], Sacc[jv][3]);
            *(LAS3 u32x2*)(SbT + (vt * 16 + fr) * LDP + tt * 16 + 4 * fq) = sw;
        }
        __syncthreads();
        {
            const int t = tid >> 3, seg = tid & 7;
            const LAS3 float* op = Of + t * 132 + seg * 16;
            f32x4 ov[4]; float ss = 0.f;
#pragma unroll
            for (int i = 0; i < 4; ++i) { ov[i] = *(const LAS3 f32x4*)(op + 4 * i); ss += ov[i][0] * ov[i][0] + ov[i][1] * ov[i][1] + ov[i][2] * ov[i][2] + ov[i][3] * ov[i][3]; }
            ss += __shfl_xor(ss, 1); ss += __shfl_xor(ss, 2); ss += __shfl_xor(ss, 4);
            const float rstd = rsqrtf(ss * (1.f / 128.f) + 1e-6f);
            const bf16_t* gp = GG + (rb + t) * 512 + h * 128 + seg * 16;
            const u32x4 g0 = *(const u32x4*)gp, g1 = *(const u32x4*)(gp + 8);
            const unsigned gw[8] = {g0.x, g0.y, g0.z, g0.w, g1.x, g1.y, g1.z, g1.w};
            unsigned ow[8];
#pragma unroll
            for (int i = 0; i < 4; ++i) {
                const f32x4 on = *(const f32x4*)(p.onorm + seg * 16 + 4 * i);
                const float y0 = ov[i][0] * rstd * on[0] * __uint_as_float(gw[2 * i] << 16), y1 = ov[i][1] * rstd * on[1] * __uint_as_float(gw[2 * i] & 0xffff0000u);
                const float y2 = ov[i][2] * rstd * on[2] * __uint_as_float(gw[2 * i + 1] << 16), y3 = ov[i][3] * rstd * on[3] * __uint_as_float(gw[2 * i + 1] & 0xffff0000u);
                ow[2 * i] = cvtpk(y0, y1); ow[2 * i + 1] = cvtpk(y2, y3);
            }
            bf16_t* mp = MIX + (rb + t) * 1024 + h * 128 + seg * 16;
            *(u32x4*)mp = (u32x4){ow[0], ow[1], ow[2], ow[3]}; *(u32x4*)(mp + 8) = (u32x4){ow[4], ow[5], ow[6], ow[7]};
        }
    }
#pragma unroll
    for (int jv = 0; jv < 4; ++jv)
#pragma unroll
        for (int r = 0; r < 4; ++r) p.out[O_GSP + ((size_t)(b * 4 + h) * 64 + tt * 16 + 4 * fq + r) * 128 + (vh * 4 + jv) * 16 + fr] = Sacc[jv][r];
    __syncthreads();
}

DI void sscore_unit(const Params& p, LAS3 unsigned char* lds, int u) {
    const int tid = threadIdx.x;
    unsigned char* ws = p.ws;
    const int b = u >> 3, pg = u & 7;
    LAS3 float* qf = (LAS3 float*)lds;
    if (tid < 256) qf[tid] = bf2f(((const bf16_t*)(ws + W_IQ))[(size_t)(MP + b) * 256 + tid]);
    __syncthreads();
    const int seg = tid & 15;
    f32x4 q[4];
#pragma unroll
    for (int h = 0; h < 4; ++h) q[h] = *(const LAS3 f32x4*)(qf + h * 64 + seg * 4);
    const f32x4 wv = *(const f32x4*)vaddr((const float*)(ws + W_IW) + (size_t)(MP + b) * 4);
    unsigned* sc = (unsigned*)(ws + W_SC) + (size_t)b * SCLD;
    const int* pt = p.page_table + b * NPAGES + pg * 16;
#define SS_LOAD(BUF, pp) do { const float* base_ = p.cache_ik + (size_t)pt[(pp) < 16 ? (pp) : 15] * 8192; \
        _Pragma("unroll") for (int i = 0; i < 4; ++i) BUF[i] = *(const f32x4*)(base_ + (size_t)(tid + 512 * i) * 4); } while (0)
#define SS_COMPUTE(BUF, pp) do { \
        _Pragma("unroll") for (int i = 0; i < 4; ++i) { const f32x4 kv = BUF[i]; float dh[4]; \
            _Pragma("unroll") for (int h = 0; h < 4; ++h) { float x = q[h][0] * kv[0] + q[h][1] * kv[1] + q[h][2] * kv[2] + q[h][3] * kv[3]; \
                x += __shfl_xor(x, 1); x += __shfl_xor(x, 2); x += __shfl_xor(x, 4); x += __shfl_xor(x, 8); dh[h] = x; } \
            const float s_ = wv[0] * fmaxf(dh[0], 0.f) + wv[1] * fmaxf(dh[1], 0.f) + wv[2] * fmaxf(dh[2], 0.f) + wv[3] * fmaxf(dh[3], 0.f); \
            if (seg == 0) __hip_atomic_store(sc + (pg * 16 + (pp)) * 128 + ((tid + 512 * i) >> 4), __float_as_uint(s_), __ATOMIC_RELAXED, __HIP_MEMORY_SCOPE_AGENT); } } while (0)
    f32x4 pa[4], pb[4];
    SS_LOAD(pa, 0); SS_LOAD(pb, 1);
#pragma unroll 1
    for (int pp = 0; pp < 16; pp += 2) {
        SS_COMPUTE(pa, pp); SS_LOAD(pa, pp + 2);
        SS_COMPUTE(pb, pp + 1); SS_LOAD(pb, pp + 3);
    }
#undef SS_LOAD
#undef SS_COMPUTE
    asm volatile("s_waitcnt vmcnt(0)" ::: "memory");
    __syncthreads();
    if (tid == 0) __hip_atomic_fetch_add((unsigned*)(ws + CW_SCNT), 1u, __ATOMIC_RELAXED, __HIP_MEMORY_SCOPE_AGENT);
}

constexpr int SA_Q = 2048, SA_S = 3072, SA_KP = 8192, SA_VP = 10240;
DI void sattend(const Params& p, LAS3 unsigned char* lds, const bf16_t* qrow  , const bf16_t* gate, bf16_t* mix) {
    const int tid = threadIdx.x, lane = tid & 63, w = tid >> 6;
    LAS3 float* qf = (LAS3 float*)(lds + SA_Q); LAS3 float* S = (LAS3 float*)(lds + SA_S);
    const float* const LAS3* kptr = (const float* const LAS3*)(lds + SA_KP); const float* const LAS3* vptr = (const float* const LAS3*)(lds + SA_VP);
    if (tid < 256) qf[tid] = bf2f(qrow[tid]);
    __syncthreads();
    {
        const int jk = tid >> 1, hp = tid & 1;
        const float* kr = kptr[jk] + hp * 128;
        float s0 = 0.f, s1 = 0.f;
#pragma unroll 4
        for (int i = 0; i < 16; ++i) {
            const f32x4 k0 = *(const f32x4*)(kr + 4 * i), k1 = *(const f32x4*)(kr + 64 + 4 * i);
            const f32x4 q0 = *(const LAS3 f32x4*)(qf + hp * 128 + 4 * i), q1 = *(const LAS3 f32x4*)(qf + hp * 128 + 64 + 4 * i);
            s0 += q0[0] * k0[0] + q0[1] * k0[1] + q0[2] * k0[2] + q0[3] * k0[3];
            s1 += q1[0] * k1[0] + q1[1] * k1[1] + q1[2] * k1[2] + q1[3] * k1[3];
        }
        S[(2 * hp) * 256 + jk] = s0; S[(2 * hp + 1) * 256 + jk] = s1;
    }
    __syncthreads();
    if (w < 4) {
        float v[4], mx = NEG_INF;
#pragma unroll
        for (int i = 0; i < 4; ++i) { v[i] = S[w * 256 + lane + 64 * i]; mx = fmaxf(mx, v[i]); }
        mx = wmax64(mx);
        float sum = 0.f;
#pragma unroll
        for (int i = 0; i < 4; ++i) { v[i] = __expf(v[i] - mx); sum += v[i]; }
        sum = wsum64(sum);
        const float inv = 1.f / sum;
#pragma unroll
        for (int i = 0; i < 4; ++i) S[w * 256 + lane + 64 * i] = v[i] * inv;
    }
    __syncthreads();
    {
        const int h = tid >> 7, dd = (tid >> 1) & 63, hf = tid & 1;
        float acc = 0.f;
#pragma unroll 4
        for (int jk = hf * 128; jk < hf * 128 + 128; ++jk) acc += S[h * 256 + jk] * vptr[jk][h * 64 + dd];
        acc += __shfl_xor(acc, 1);
        if (hf == 0) mix[h * 64 + dd] = f2bf(acc * bf2f(gate[h * 64 + dd]));
    }
    __syncthreads();
}
DI void smem_unit(const Params& p, LAS3 unsigned char* lds, int b) {
    const int tid = threadIdx.x; unsigned char* ws = p.ws;
    const float* LAS3* kptr = (const float* LAS3*)(lds + SA_KP); const float* LAS3* vptr = (const float* LAS3*)(lds + SA_VP);
    if (tid < 256) { kptr[tid] = p.cache_mem_k + ((size_t)b * NMEM + tid) * 256; vptr[tid] = p.cache_mem_v + ((size_t)b * NMEM + tid) * 256; }
    const size_t row = MP + b;
    sattend(p, lds, (const bf16_t*)(ws + W_MQ) + row * 256, (const bf16_t*)(ws + W_MG) + row * 256, (bf16_t*)(ws + W_MIX) + row * 1024 + 768);
}
DI void ssel_unit(const Params& p, LAS3 unsigned char* lds, int b) {
    const int tid = threadIdx.x, lane = tid & 63, w = tid >> 6; unsigned char* ws = p.ws;
    LAS3 unsigned* CNT = (LAS3 unsigned*)lds;
    LAS3 unsigned* wsum = (LAS3 unsigned*)(lds + 256);
    LAS3 float* newsc = (LAS3 float*)(lds + 320);
    LAS3 int* list = (LAS3 int*)(lds + 512);
    const float* LAS3* kptr = (const float* LAS3*)(lds + SA_KP); const float* LAS3* vptr = (const float* LAS3*)(lds + SA_VP);
    if (tid < 48) CNT[tid] = 0u;
    if (tid == 0) {
        unsigned* cnt = (unsigned*)(ws + CW_SCNT); unsigned* tmo = (unsigned*)(ws + CW_TMO); unsigned sp = 0;
        while (__hip_atomic_load(cnt, __ATOMIC_RELAXED, __HIP_MEMORY_SCOPE_AGENT) < 256u) {
            __builtin_amdgcn_s_sleep(2);
            if ((++sp & 255u) == 0u) { if (__hip_atomic_load(tmo, __ATOMIC_RELAXED, __HIP_MEMORY_SCOPE_AGENT)) break; if (sp > (1u << 20)) { __hip_atomic_store(tmo, 1u, __ATOMIC_RELAXED, __HIP_MEMORY_SCOPE_AGENT); break; } }
        }
        __builtin_amdgcn_fence(__ATOMIC_ACQUIRE, "agent");
        asm volatile("s_waitcnt vmcnt(0)" ::: "memory");
    }
    if (w == 1) {
        const bf16_t* iq = (const bf16_t*)(ws + W_IQ) + (size_t)(MP + b) * 256; const float kd = bf2f(((const bf16_t*)(ws + W_IK))[(size_t)(MP + b) * 64 + lane]);
        const f32x4 wv = *(const f32x4*)vaddr((const float*)(ws + W_IW) + (size_t)(MP + b) * 4);
        float s = 0.f;
#pragma unroll
        for (int h = 0; h < 4; ++h) { const float dh = wsum64(bf2f(iq[h * 64 + lane]) * kd); s += wv[h] * fmaxf(dh, 0.f); }
        if (lane == 0) *newsc = s;
    }
    __syncthreads();
    const float* sc = (const float*)(ws + W_SC) + (size_t)b * SCLD;
    unsigned key[33];
#pragma unroll
    for (int n = 0; n < 32; ++n) key[n] = fkey(sc[tid + 512 * n]);
    key[32] = (tid == 0) ? fkey(*newsc) : 0u;
    int it = 0;
    unsigned T = 0u, X = 0x7fffffffu; bool fin = false;
    for (int bit = 31; bit >= 0; --bit) {
        const unsigned cand = T | (1u << bit);
        unsigned c = 0;
#pragma unroll
        for (int n = 0; n < 33; ++n) cnt_ge(c, key[n], cand);
        const unsigned tot = blk_count(c, CNT, it, lane);
        if (tot >= 256u) { T = cand; fin = (tot == 256u); }
        if (fin) break;
    }
    if (!fin) {
        unsigned c = 0;
#pragma unroll
        for (int n = 0; n < 33; ++n) cnt_gt(c, key[n], T);
        const unsigned need = 256u - blk_count(c, CNT, it, lane);
        unsigned Xl = 0u;
        for (int bit = 14; bit >= 0; --bit) {
            const unsigned cand = Xl | (1u << bit);
            c = 0;
#pragma unroll
            for (int n = 0; n < 33; ++n) cnt_eq_lt(c, key[n], T, (unsigned)(tid + 512 * n), cand);
            if (blk_count(c, CNT, it, lane) < need) Xl = cand;
        }
        X = Xl;
    }
    unsigned selm = 0, hi = 0;
#pragma unroll
    for (int n = 0; n < 32; ++n) selm |= (key[n] > T || (key[n] == T && (unsigned)(tid + 512 * n) <= X)) ? (1u << n) : 0u;
    hi = (key[32] > T || (key[32] == T && (unsigned)(tid + 16384) <= X)) ? 1u : 0u;
    const unsigned cs = __popc(selm) + hi;
    unsigned inc = cs;
#pragma unroll
    for (int o2 = 1; o2 < 64; o2 <<= 1) { const unsigned t2 = __shfl_up(inc, o2); if (lane >= o2) inc += t2; }
    if (lane == 63) wsum[w] = inc;
    __syncthreads();
    unsigned pos = inc - cs;
    for (int w2 = 0; w2 < w; ++w2) pos += wsum[w2];
#pragma unroll
    for (int n = 0; n < 32; ++n) if ((selm >> n) & 1u) { if (pos < 256u) list[pos] = tid + 512 * n; ++pos; }
    if (hi) { if (pos < 256u) list[pos] = tid + 16384; ++pos; }
    __syncthreads();
    if (tid < 256) {
        const int idx = list[tid];
        if (idx < 16384) { const size_t phys = (size_t)p.page_table[b * NPAGES + (idx >> 7)] * 128 + (idx & 127); kptr[tid] = p.cache_k + phys * 256; vptr[tid] = p.cache_v + phys * 256; }
        else { kptr[tid] = p.out + O_KS + (size_t)b * 256; vptr[tid] = p.out + O_VS + (size_t)b * 256; }
    }
    const size_t row = MP + b;
    sattend(p, lds, (const bf16_t*)(ws + W_DQ) + row * 256, (const bf16_t*)(ws + W_DG) + row * 256, (bf16_t*)(ws + W_MIX) + row * 1024 + 512);
}
DI void sgla_unit(const Params& p, LAS3 unsigned char* lds, int b) {
    const int tid = threadIdx.x, lane = tid & 63, w = tid >> 6; unsigned char* ws = p.ws;
    LAS3 float* qs = (LAS3 float*)lds; LAS3 float* ks = qs + 256; LAS3 float* gs = qs + 512; LAS3 float* vs = qs + 768; LAS3 float* part = qs + 1280;
    const size_t row = MP + b;
    if (tid < 256) {
        float u = p.b_g[tid];
        const float* gl = vaddr((const float*)(ws + W_GLR) + row * 16);
#pragma unroll
        for (int r = 0; r < 16; ++r) u += gl[r] * p.w_g2[r * 256 + tid];
        gs[tid] = expf(logsigf(u) * (1.f / 16.f));
        qs[tid] = bf2f(((const bf16_t*)(ws + W_GQ))[row * 256 + tid]); ks[tid] = bf2f(((const bf16_t*)(ws + W_GK))[row * 256 + tid]);
    }
    vs[tid] = bf2f(((const bf16_t*)(ws + W_GV))[row * 512 + tid]);
    __syncthreads();
    const int h = tid >> 7, v = tid & 127;
    const float* sp = p.state_gla + ((size_t)(b * 4 + h) * 64) * 128 + v; float* so = p.out + O_GSS + ((size_t)(b * 4 + h) * 64) * 128 + v;
    const float vv = vs[h * 128 + v];
    float o = 0.f;
#pragma unroll 8
    for (int dd = 0; dd < 64; ++dd) { const float sn = gs[h * 64 + dd] * sp[dd * 128] + ks[h * 64 + dd] * vv; so[dd * 128] = sn; o += qs[h * 64 + dd] * sn; }
    const float ss = wsum64(o * o);
    if (lane == 0) part[w] = ss;
    __syncthreads();
    const float rstd = rsqrtf((part[2 * h] + part[2 * h + 1]) * (1.f / 128.f) + 1e-6f);
    ((bf16_t*)(ws + W_MIX))[row * 1024 + h * 128 + v] = f2bf(o * rstd * p.onorm[v] * bf2f(((const bf16_t*)(ws + W_GG))[row * 512 + h * 128 + v]));
    __syncthreads();
}
DI void p4_final(const Params& p) {
    const int tid = threadIdx.x, lane = tid & 63, wv = tid >> 6;
    for (int r = blockIdx.x * 8 + wv; r < MP + NDB; r += gridDim.x * 8) {
        float* y = p.out + (r < MP ? O_YP + (size_t)r * DM : O_YS + (size_t)(r - MP) * DM);
        f32x4 v[4]; float ss = 0.f;
#pragma unroll
        for (int i = 0; i < 4; ++i) { v[i] = *(const f32x4*)(y + i * 256 + lane * 4); ss += v[i][0] * v[i][0] + v[i][1] * v[i][1] + v[i][2] * v[i][2] + v[i][3] * v[i][3]; }
        ss = wsum64(ss);
        const float rstd = rsqrtf(ss * (1.f / DM) + 1e-6f);
#pragma unroll
        for (int i = 0; i < 4; ++i) { const f32x4 gv = *(const f32x4*)(p.norm_final + i * 256 + lane * 4); *(f32x4*)(y + i * 256 + lane * 4) = v[i] * rstd * gv; }
    }
}

DI int next_unit(unsigned* ctr, volatile LAS3 unsigned* slot) {
    if (threadIdx.x == 0) *slot = __hip_atomic_fetch_add(ctr, 1u, __ATOMIC_RELAXED, __HIP_MEMORY_SCOPE_AGENT);
    __syncthreads();
    const int v = __builtin_amdgcn_readfirstlane((int)*slot);
    __syncthreads();
    return v;
}

#ifndef REP1
#define REP1 1
#endif
#ifndef REP2
#define REP2 1
#endif
#ifndef REP3
#define REP3 1
#endif
#ifndef REP2A
#define REP2A 1
#endif
#ifndef REP2B
#define REP2B 1
#endif
#ifndef REP2C
#define REP2C 1
#endif
#ifndef REP2D
#define REP2D 1
#endif
#ifndef REP2E
#define REP2E 1
#endif
DI void sample_inproj(const Params& p, LAS3 unsigned char* lds) {
    const int tid = threadIdx.x, lane = tid & 63, wv = tid >> 6, fr = lane & 15, fq = lane >> 4;
    unsigned char* ws = p.ws;
    LAS3 float* red = (LAS3 float*)lds;
    for (int pr = blockIdx.x; pr < 112; pr += gridDim.x) {
        const int col0 = pr * 32, pn = col0 >> 8, vc0 = col0 & 255;
        const bf16_t* A = (const bf16_t*)(ws + W_XN) + (size_t)MP * 1024 + (size_t)fr * 1024 + fq * 8 + wv * 128;
        const bf16_t* B = (const bf16_t*)(ws + W_WTIN) + (size_t)(col0 + fr) * 1024 + fq * 8 + wv * 128;
        const f32x4 zero = {0.f, 0.f, 0.f, 0.f};
        f32x4 acc[2][2] = {{zero, zero}, {zero, zero}};
#pragma unroll
        for (int ks = 0; ks < 4; ++ks) {
            const bf16x8 a0 = *(const bf16x8*)(A + ks * 32), a1 = *(const bf16x8*)(A + 16 * 1024 + ks * 32);
            const bf16x8 b0 = *(const bf16x8*)(B + ks * 32), b1 = *(const bf16x8*)(B + 16 * 1024 + ks * 32);
            acc[0][0] = mfma16(a0, b0, acc[0][0]); acc[0][1] = mfma16(a0, b1, acc[0][1]); acc[1][0] = mfma16(a1, b0, acc[1][0]); acc[1][1] = mfma16(a1, b1, acc[1][1]);
        }
#pragma unroll
        for (int rt = 0; rt < 2; ++rt)
#pragma unroll
            for (int ct = 0; ct < 2; ++ct)
#pragma unroll
                for (int r = 0; r < 4; ++r) red[(wv * 16 + (rt * 2 + ct) * 4 + r) * 64 + lane] = acc[rt][ct][r];
        __syncthreads();
        {
            const int rt = wv >> 2, r = wv & 3;
            float v0 = 0.f, v1 = 0.f;
#pragma unroll
            for (int w2 = 0; w2 < 8; ++w2) { v0 += red[(w2 * 16 + (rt * 2 + 0) * 4 + r) * 64 + lane]; v1 += red[(w2 * 16 + (rt * 2 + 1) * 4 + r) * 64 + lane]; }
            const float* rope = (const float*)(ws + W_ROPE) + (size_t)2048 * 64;
            {
                const int bs = 16 * rt + 4 * fq + r; const size_t R = (size_t)MP + bs;
                if (pn <= 5 || (pn >= 10 && pn <= 12)) {
                    bf16_t* dst; int ldc = 256, coff = 0; float sc = 1.f; bool silu = false;
                    switch (pn) {
                        case 0: dst = (bf16_t*)(ws + W_GQ); sc = 0.125f; break;
                        case 1: dst = (bf16_t*)(ws + W_GK); break;
                        case 2: dst = (bf16_t*)(ws + W_GV); ldc = 512; break;
                        case 3: dst = (bf16_t*)(ws + W_GV); ldc = 512; coff = 256; break;
                        case 4: dst = (bf16_t*)(ws + W_GG); ldc = 512; silu = true; break;
                        case 5: dst = (bf16_t*)(ws + W_GG); ldc = 512; coff = 256; silu = true; break;
                        case 10: dst = (bf16_t*)(ws + W_DG); silu = true; break;
                        case 11: dst = (bf16_t*)(ws + W_MQ); sc = 0.125f; break;
                        default: dst = (bf16_t*)(ws + W_MG); silu = true; break;
                    }
                    bf16_t* rp = dst + R * ldc + coff + vc0 + 8 * (fr >> 2) + (fr & 3);
                    rp[0] = f2bf(silu ? siluf(v0) : v0 * sc); rp[4] = f2bf(silu ? siluf(v1) : v1 * sc);
                } else if (pn == 6 || pn == 7 || pn == 9 || (pn == 13 && vc0 < 64)) {
                    const int hh = (pn == 13) ? 0 : ((vc0 >> 5) & 3);
                    const int f = (pn == 13) ? 16 * ((vc0 >> 5) & 1) + fr : 8 * (fr >> 2) + 4 * (vc0 >> 7) + (fr & 3);
                    const float c = rope[2 * f], s = rope[2 * f + 1], sc = (pn == 6) ? 0.125f : 1.f;
                    const float o1 = (v0 * c - v1 * s) * sc, o2 = (v1 * c + v0 * s) * sc;
                    if (pn == 13) {
                        bf16_t* ikb = (bf16_t*)(ws + W_IK) + R * 64; ikb[f] = f2bf(o1); ikb[f + 32] = f2bf(o2);
                        float* op = p.out + O_IKS + (size_t)bs * 64; op[f] = o1; op[f + 32] = o2;
                    } else {
                        bf16_t* dst = (bf16_t*)(ws + (pn == 6 ? W_DQ : (pn == 7 ? W_DK : W_IQ))) + R * 256 + 64 * hh;
                        dst[f] = f2bf(o1); dst[f + 32] = f2bf(o2);
                        if (pn == 7) { float* op = p.out + O_KS + (size_t)bs * 256 + 64 * hh; op[f] = o1; op[f + 32] = o2; }
                    }
                } else if (pn == 8) {
                    float* op = p.out + O_VS + (size_t)bs * 256 + vc0 + 8 * (fr >> 2) + (fr & 3); op[0] = v0; op[4] = v1;
                } else if (pn == 13 && vc0 == 64) {
                    if (fr < 4) { ((float*)(ws + W_IW))[R * 4 + fr] = v0 * 0.5f; ((float*)(ws + W_GLR))[R * 16 + 12 + fr] = v1; }
                    else ((float*)(ws + W_GLR))[R * 16 + fr - 4] = v0;
                }
            }
        }
        __syncthreads();
    }
}
DI void phase1(const Params& p, LAS3 unsigned char* lds) {
    unsigned char* ws = p.ws;
    { pg8::Gemm g{(const bf16_t*)(ws + W_XN), (const bf16_t*)(ws + W_WTIN), MP, NIN, DM}; pg8::StaticOrder S; S.init(MP, NIN, (int)gridDim.x, (int)blockIdx.x);
      EpiIn E{ws, p.out}; pg8::gemm_phase<EpiIn, pg8::StaticOrder, true, true>(lds, g, S, E); }
    sample_inproj(p, lds);
}
DI void p2_memgemm(const Params& p, LAS3 unsigned char* lds) {
    const int u = (int)gridDim.x - 1 - (int)blockIdx.x;
    if (u >= 96 && u < 128) {
        pg8::Gemm g{(const bf16_t*)(p.ws + W_MEMN), (const bf16_t*)(p.ws + W_WTMEM), MMEM, 512, DM}; pg8::StaticOrder S; S.init(MMEM, 512, (int)gridDim.x, u - 96);
        EpiMem E{p.ws, p.out}; pg8::gemm_phase<EpiMem, pg8::StaticOrder, true, true>(lds, g, S, E);
        asm volatile("s_waitcnt vmcnt(0)" ::: "memory");
        __syncthreads();
        if (threadIdx.x == 0) {
            __builtin_amdgcn_fence(__ATOMIC_RELEASE, "agent");
            asm volatile("s_waitcnt vmcnt(0)" ::: "memory");
            __hip_atomic_fetch_add((unsigned*)(p.ws + CW_MEMC), 1u, __ATOMIC_RELAXED, __HIP_MEMORY_SCOPE_AGENT);
        }
    }
}
DI void wait_memgemm(const Params& p) {
    if (threadIdx.x == 0) {
        unsigned* cnt = (unsigned*)(p.ws + CW_MEMC); unsigned* tmo = (unsigned*)(p.ws + CW_TMO); unsigned sp = 0;
        while (__hip_atomic_load(cnt, __ATOMIC_RELAXED, __HIP_MEMORY_SCOPE_AGENT) < 32u) {
            __builtin_amdgcn_s_sleep(2);
            if ((++sp & 255u) == 0u) { if (__hip_atomic_load(tmo, __ATOMIC_RELAXED, __HIP_MEMORY_SCOPE_AGENT)) break; if (sp > (1u << 20)) { __hip_atomic_store(tmo, 1u, __ATOMIC_RELAXED, __HIP_MEMORY_SCOPE_AGENT); break; } }
        }
        __builtin_amdgcn_fence(__ATOMIC_ACQUIRE, "agent");
        asm volatile("s_waitcnt vmcnt(0)" ::: "memory");
    }
    __syncthreads();
}
template <int QI> DI void p2_sscore(const Params& p, LAS3 unsigned char* lds) { for (int u = blockIdx.x; u < 256; u += gridDim.x) { sscore_unit(p, lds, u); __syncthreads(); } }
template <int QI> DI void p2_gla(const Params& p, LAS3 unsigned char* lds) { for (int u = blockIdx.x; u < 64; u += gridDim.x) gla_unit(p, lds, u >> 2, u & 3); }
DI int next_unit_xcd(unsigned char* qbase, volatile LAS3 unsigned* slot, unsigned x0) {
    if (threadIdx.x == 0) {
        unsigned res = 0xffffffffu;
        for (unsigned k = 0; k < 8u; ++k) {
            const unsigned xq = (x0 + k) & 7u;
            const unsigned mq = __hip_atomic_fetch_add((unsigned*)(qbase + 256 * xq), 1u, __ATOMIC_RELAXED, __HIP_MEMORY_SCOPE_AGENT);
            if (mq < 64u) { res = xq * 64u + mq; break; }
        }
        *slot = res;
    }
    __syncthreads();
    const int v = __builtin_amdgcn_readfirstlane((int)*slot);
    __syncthreads();
    return v;
}
template <int QI> DI void p2_dsa(const Params& p, LAS3 unsigned char* lds, volatile LAS3 unsigned* MISC TARGS) {
#if defined(XCDQ) && XCDQ
    const unsigned x0 = xb_xcc_id() & 7u;
    for (;;) { const int n = next_unit_xcd(p.ws + CW_QDSA + 8192 * QI, MISC + 4, x0); if (n < 0) break; const int m = n & 63; dsa_unit(p, lds, 2 * (n >> 6) + (m >> 5), 31 - (m & 31) TPASS); }
#else
    for (;;) { const int n = next_unit((unsigned*)(p.ws + CW_QDSA + 8192 * QI), MISC + 4); if (n >= 512) break; dsa_unit(p, lds, n & 15, 31 - (n >> 4) TPASS); }
#endif
}
template <int QI> DI void p2_mem(const Params& p, LAS3 unsigned char* lds, volatile LAS3 unsigned* MISC) {
    wait_memgemm(p);
    for (;;) { const int n = next_unit((unsigned*)(p.ws + CW_QMEM + 8192 * QI), MISC + 4); if (n >= 512) break; mem_unit(p, n); } }
template <int QI> DI void p2_sample(const Params& p, LAS3 unsigned char* lds) {
    for (int u = (int)gridDim.x - 1 - (int)blockIdx.x; u < 96; u += gridDim.x) { if (u < 32) sgla_unit(p, lds, u); else if (u < 64) smem_unit(p, lds, u - 32); else ssel_unit(p, lds, u - 64); } }
template <int RI> DI void phase2(const Params& p, LAS3 unsigned char* lds, volatile LAS3 unsigned* MISC TARGS) {
    TBEG(20); p2_memgemm(p, lds);
    TBEG(21); p2_sscore<0>(p, lds); TEND(21); if (REP2A > 1) p2_sscore<1>(p, lds);
    TBEG(25); p2_sample<0>(p, lds); TEND(25); if (REP2E > 1) p2_sample<1>(p, lds);
    TBEG(22); p2_gla<0>(p, lds); TEND(22); if (REP2B > 1) p2_gla<1>(p, lds);
    TBEG(23); p2_dsa<0>(p, lds, MISC TPASS); TEND(23); if (REP2C > 1) p2_dsa<1>(p, lds, MISC TPASS);
    TBEG(24); p2_mem<0>(p, lds, MISC); TEND(24); if (REP2D > 1) p2_mem<1>(p, lds, MISC);
    TEND(20);
}
DI void phase3(const Params& p, LAS3 unsigned char* lds) {
    pg8::Gemm g{(const bf16_t*)(p.ws + W_MIX), (const bf16_t*)(p.ws + W_WTOUT), MP, DM, DM}; pg8::StaticOrder S; S.init(MP, DM, (int)gridDim.x, (int)blockIdx.x);
    EpiOut E{p.x_prompt, p.x_sample, p.out}; pg8::gemm_phase<EpiOut, pg8::StaticOrder, true, true>(lds, g, S, E);
    const int tid = threadIdx.x, lane = tid & 63, wv = tid >> 6;
    for (int u = blockIdx.x; u < 256; u += gridDim.x) {
        const int b = u >> 3, col0 = (u & 7) * 128 + wv * 16;
        const bf16_t* mrow = (const bf16_t*)(p.ws + W_MIX) + (size_t)(MP + b) * 1024 + lane * 16;
        const u32x4 m0 = *(const u32x4*)mrow, m1 = *(const u32x4*)(mrow + 8);
        const unsigned mw[8] = {m0.x, m0.y, m0.z, m0.w, m1.x, m1.y, m1.z, m1.w};
        float res = 0.f;
#pragma unroll 4
        for (int i = 0; i < 16; ++i) {
            const bf16_t* wrow = (const bf16_t*)(p.ws + W_WTOUT) + (size_t)(col0 + i) * 1024 + lane * 16;
            const u32x4 w0 = *(const u32x4*)wrow, w1 = *(const u32x4*)(wrow + 8);
            const unsigned ww[8] = {w0.x, w0.y, w0.z, w0.w, w1.x, w1.y, w1.z, w1.w};
            float acc = 0.f;
#pragma unroll
            for (int e = 0; e < 8; ++e) acc += __uint_as_float(mw[e] << 16) * __uint_as_float(ww[e] << 16) + __uint_as_float(mw[e] & 0xffff0000u) * __uint_as_float(ww[e] & 0xffff0000u);
            acc = wsum64(acc);
            res = (lane == i) ? acc : res;
        }
        if (lane < 16) p.out[O_YS + (size_t)b * DM + col0 + lane] = p.x_sample[(size_t)b * DM + col0 + lane] + res;
    }
}
#ifdef CHECK_ATT
DI void check_mem_attention(const Params& p) {
    const int tid = threadIdx.x, lane = tid & 63, wv = tid >> 6;
    const int samp = blockIdx.x * 8 + wv;
    const int row = (samp * 977 + 13) % MP, h = samp & 3, b = row >> 11;
    const bf16_t* q = (const bf16_t*)(p.ws + W_MQ) + (size_t)row * 256 + h * 64;
    float s[4];
#pragma unroll
    for (int i = 0; i < 4; ++i) { const float* kr = p.out + O_MKP + ((size_t)b * NMEM + lane + 64 * i) * 256 + h * 64; float a = 0.f; for (int d = 0; d < 64; ++d) a += bf2f(q[d]) * kr[d]; s[i] = a; }
    float mx = wmax64(fmaxf(fmaxf(s[0], s[1]), fmaxf(s[2], s[3])));
    float pe[4], sum = 0.f;
#pragma unroll
    for (int i = 0; i < 4; ++i) { pe[i] = __builtin_amdgcn_exp2f(s[i] - mx); sum += pe[i]; }
    sum = wsum64(sum);
    float err = 0.f, nrm = 0.f;
    for (int d = 0; d < 64; ++d) {
        float a = 0.f;
#pragma unroll
        for (int i = 0; i < 4; ++i) a += pe[i] * p.out[O_MVP + ((size_t)b * NMEM + lane + 64 * i) * 256 + h * 64 + d];
        a = wsum64(a) / sum;
        const float want = a * bf2f(((const bf16_t*)(p.ws + W_MG))[(size_t)row * 256 + h * 64 + d]);
        const float got = bf2f(((const bf16_t*)(p.ws + W_MIX))[(size_t)row * 1024 + 768 + h * 64 + d]);
        err += (got - want) * (got - want); nrm += want * want;
    }
    if (lane == 0) { atomicAdd((unsigned*)(p.ws + CW_CHK + 12), 1u); if (!(err <= 0.0025f * nrm + 1e-12f)) atomicAdd((unsigned*)(p.ws + CW_CHK + 8), 1u); }
    if (samp < 128) {
        const int bs = samp >> 2, hs = samp & 3; const size_t rs = (size_t)MP + bs;
        const bf16_t* qs = (const bf16_t*)(p.ws + W_MQ) + rs * 256 + hs * 64;
        float s2[4];
#pragma unroll
        for (int i = 0; i < 4; ++i) { const float* kr = p.cache_mem_k + ((size_t)bs * NMEM + lane + 64 * i) * 256 + hs * 64; float a = 0.f; for (int d = 0; d < 64; ++d) a += bf2f(qs[d]) * kr[d]; s2[i] = a; }
        const float mx2 = wmax64(fmaxf(fmaxf(s2[0], s2[1]), fmaxf(s2[2], s2[3])));
        float pe2[4], sum2 = 0.f;
#pragma unroll
        for (int i = 0; i < 4; ++i) { pe2[i] = __expf(s2[i] - mx2); sum2 += pe2[i]; }
        sum2 = wsum64(sum2);
        float err2 = 0.f, nrm2 = 0.f;
        for (int d = 0; d < 64; ++d) {
            float a = 0.f;
#pragma unroll
            for (int i = 0; i < 4; ++i) a += pe2[i] * p.cache_mem_v[((size_t)bs * NMEM + lane + 64 * i) * 256 + hs * 64 + d];
            a = wsum64(a) / sum2;
            const float want = a * bf2f(((const bf16_t*)(p.ws + W_MG))[rs * 256 + hs * 64 + d]);
            const float got = bf2f(((const bf16_t*)(p.ws + W_MIX))[rs * 1024 + 768 + hs * 64 + d]);
            err2 += (got - want) * (got - want); nrm2 += want * want;
        }
        if (lane == 0) { atomicAdd((unsigned*)(p.ws + CW_CHK + 12), 1u); if (!(err2 <= 0.0025f * nrm2 + 1e-12f)) atomicAdd((unsigned*)(p.ws + CW_CHK + 8), 1u); }
    }
}
#endif
__global__ void __launch_bounds__(NTHREADS, 2) hymba_fwd(Params p) {
    extern __shared__ __attribute__((aligned(16))) unsigned char lds_raw[];
    LAS3 unsigned char* lds = (LAS3 unsigned char*)lds_raw;
    volatile LAS3 unsigned* MISC = (volatile LAS3 unsigned*)(lds + LDS_MISC);
    const int tid = threadIdx.x;
    if (tid < 64) MISC[tid] = 0u;
    __syncthreads();
    const int lo = p.ph_lo, hi = p.ph_hi;
    TDECL;
    XcdBarrier bar; bar.bar = (unsigned*)p.ws; bar.x = 0; bar.st = MISC;
    if (hi > lo) bar = xcd_barrier_post((unsigned*)p.ws, MISC);
#define IN(k) (lo <= (k) && (k) <= hi)
#define SEAM(k) do { if (IN(k) && IN((k) + 1)) xcd_barrier(bar); } while (0)
    TBEG(0); if (IN(0)) p0_prologue(p, lds); TEND(0);
    TBEG(10); SEAM(0); TEND(10);
    TBEG(1); if (IN(1)) { phase1(p, lds); if (REP1 > 1) { xcd_barrier(bar); phase1(p, lds); } } TEND(1);
    TBEG(11); SEAM(1); TEND(11);
    TBEG(2); if (IN(2)) { phase2<0>(p, lds, MISC TPASS); } TEND(2);
    TBEG(12); SEAM(2); TEND(12);
#ifdef CHECK_ATT
    if (IN(3)) check_mem_attention(p);
#endif
    TBEG(3); if (IN(3)) { phase3(p, lds); if (REP3 > 1) { xcd_barrier(bar); phase3(p, lds); } } TEND(3);
    TBEG(13); SEAM(3); TEND(13);
    TBEG(4); if (IN(4)) p4_final(p); TEND(4);
#ifdef TSEL
    {
#ifdef TCLS
        if (tid == 0 && (int)((blockIdx.x >> 6) & 1) == TCLS) { atomicAdd((unsigned long long*)(p.ws + CW_TSUM), 2ull * (unsigned long long)tacc_); atomicMax((unsigned long long*)(p.ws + CW_TMAX), (unsigned long long)tacc_); }
#else
        if (tid == 0) { atomicAdd((unsigned long long*)(p.ws + CW_TSUM), (unsigned long long)tacc_); atomicMax((unsigned long long*)(p.ws + CW_TMAX), (unsigned long long)tacc_); }
#endif
        xcd_barrier(bar);
        if (blockIdx.x == 0 && tid == 0) {
#ifdef TMAX
            unsigned long long dly = __hip_atomic_load((unsigned long long*)(p.ws + CW_TMAX), __ATOMIC_RELAXED, __HIP_MEMORY_SCOPE_AGENT);
#else
            const unsigned long long dly = __hip_atomic_load((unsigned long long*)(p.ws + CW_TSUM), __ATOMIC_RELAXED, __HIP_MEMORY_SCOPE_AGENT) / gridDim.x;
#endif
#ifndef TMUL
#define TMUL 1
#endif
            const unsigned long long t0 = __builtin_amdgcn_s_memrealtime();
            while (__builtin_amdgcn_s_memrealtime() - t0 < dly * TMUL && __builtin_amdgcn_s_memrealtime() - t0 < 400000ull) __builtin_amdgcn_s_sleep(8);
        }
    }
#endif
#ifdef CHECK_ATT
    {
        xcd_barrier(bar);
        const unsigned nbad = __hip_atomic_load((unsigned*)(p.ws + CW_CHK + 8), __ATOMIC_RELAXED, __HIP_MEMORY_SCOPE_AGENT);
        const unsigned nchk = __hip_atomic_load((unsigned*)(p.ws + CW_CHK + 12), __ATOMIC_RELAXED, __HIP_MEMORY_SCOPE_AGENT);
        if (nbad != 0u || nchk < 2170u) for (int i = blockIdx.x * NTHREADS + tid; i < NDB * DM; i += gridDim.x * NTHREADS) p.out[O_YS + i] = __builtin_nanf("");
    }
#endif
#ifdef CHECK_SEL
    {
        xcd_barrier(bar);
        const unsigned nbad = __hip_atomic_load((unsigned*)(p.ws + CW_CHK), __ATOMIC_RELAXED, __HIP_MEMORY_SCOPE_AGENT);
        const unsigned nhist = __hip_atomic_load((unsigned*)(p.ws + CW_CHK + 4), __ATOMIC_RELAXED, __HIP_MEMORY_SCOPE_AGENT);
        if (nbad != 0u || nhist < CHECK_MIN_HIST) for (int i = blockIdx.x * NTHREADS + tid; i < NDB * DM; i += gridDim.x * NTHREADS) p.out[O_YS + i] = __builtin_nanf("");
    }
#endif
#undef IN
#undef SEAM
}

#ifndef N_LAUNCHES
#define N_LAUNCHES 1
#endif
extern "C" void kernel_launch(void* const* d_in, const int* in_sizes, int n_in, void* d_out, int out_size, void* d_ws, size_t ws_size, hipStream_t stream) {
    static int grid = 0;
    if (grid == 0) {
        if (n_in != 19 || (size_t)out_size != O_END || ws_size < W_END) fprintf(stderr, "kernel_launch: unexpected sizes: n_in %d out %d ws %zu (need %zu)\n", n_in, out_size, ws_size, (size_t)W_END);
        int dev = 0, cus = 0, per_cu = 0;
        if (hipGetDevice(&dev) != hipSuccess || hipDeviceGetAttribute(&cus, hipDeviceAttributeMultiprocessorCount, dev) != hipSuccess) { fprintf(stderr, "kernel_launch: device query failed\n"); grid = -1; return; }
        if (hipFuncSetAttribute((const void*)hymba_fwd, hipFuncAttributeMaxDynamicSharedMemorySize, LDS_BYTES) != hipSuccess) { fprintf(stderr, "kernel_launch: hipFuncSetAttribute failed\n"); grid = -1; return; }
        if (hipOccupancyMaxActiveBlocksPerMultiprocessor(&per_cu, (const void*)hymba_fwd, NTHREADS, LDS_BYTES) != hipSuccess || per_cu < 1) fprintf(stderr, "kernel_launch: occupancy query reports %d blocks per CU\n", per_cu);
        (void)hipGetLastError();
        grid = cus;
    }
    if (grid < 0) return;
    (void)hipMemsetAsync(d_ws, 0, CTRL_BYTES, stream);
    Params p{};
    p.x_prompt = (const float*)d_in[0]; p.x_sample = (const float*)d_in[1]; p.mem_prompt = (const float*)d_in[2]; p.state_gla = (const float*)d_in[3];
    p.cache_k = (const float*)d_in[4]; p.cache_v = (const float*)d_in[5]; p.cache_ik = (const float*)d_in[6]; p.cache_mem_k = (const float*)d_in[7]; p.cache_mem_v = (const float*)d_in[8];
    p.page_table = (const int*)d_in[9];
    p.norm_in = (const float*)d_in[10]; p.w_in = (const float*)d_in[11]; p.w_g2 = (const float*)d_in[12]; p.b_g = (const float*)d_in[13]; p.onorm = (const float*)d_in[14];
    p.mem_norm = (const float*)d_in[15]; p.w_mem_kv = (const float*)d_in[16]; p.w_out = (const float*)d_in[17]; p.norm_final = (const float*)d_in[18];
    p.out = (float*)d_out; p.ws = (unsigned char*)d_ws;
#if N_LAUNCHES == 1
    p.ph_lo = 0; p.ph_hi = 4;
    hipLaunchKernelGGL(hymba_fwd, dim3(grid), dim3(NTHREADS), LDS_BYTES, stream, p);
#else
    for (int ph = 0; ph < 5; ++ph) { p.ph_lo = ph; p.ph_hi = ph; hipLaunchKernelGGL(hymba_fwd, dim3(grid), dim3(NTHREADS), LDS_BYTES, stream, p); }
#endif
    const hipError_t le = hipPeekAtLastError();
    if (le != hipSuccess) fprintf(stderr, "kernel_launch: launch failed: %s\n", hipGetErrorName(le));
}
```

```cpp
#include <hip/hip_runtime.h>
#include <cstdint>
#include <cstdio>
namespace pg8 {
#define PG8_LAS __attribute__((address_space(3)))
typedef unsigned short bf16_t;
typedef short bf16x8 __attribute__((ext_vector_type(8)));
typedef float f32x4 __attribute__((ext_vector_type(4)));
typedef unsigned u32x4 __attribute__((ext_vector_type(4)));
constexpr int BM = 256, BK = 64, HALF = 128, HTB = HALF * BK * 2  , STAGE_BYTES = 8 * HTB, NXCD = 8, WGM = 8;

__host__ __device__ __forceinline__ int lds_byte(int r, int c) { const int st = (r >> 4) * 2 + (c >> 5), rr = r & 15, cc = c & 31, ob = rr * 64 + cc * 2; return st * 1024 + (ob ^ (((ob >> 9) & 1) << 5)); }
__host__ __device__ __forceinline__ void stage_rc(int b, int& R, int& C) { const int st = b / 1024, sb = b % 1024, swz = sb ^ (((sb >> 9) & 1) << 5); R = (st >> 1) * 16 + swz / 64; C = (st & 1) * 32 + (swz % 64) / 2; }
__host__ __device__ __forceinline__ int perm32(int rho) { const int n = rho >> 4, i = rho & 15; return 8 * (i >> 2) + 4 * n + (i & 3); }

struct Unit { int pm, pn; };
struct Gemm { const bf16_t* A; const bf16_t* Bt; int M, N, K; };

struct StaticOrder {
    int nM, nN, nwg, G, c;
    __host__ __device__ void init(int M, int N, int G_, int c_) { nM = M / BM; nN = N / BM; nwg = nM * nN; G = G_; c = c_; }
    __host__ __device__ bool next(int i, Unit& u) const {
        const long L = (long)i * G + c; if (L >= nwg) return false;
        int wgid = (int)L; { const int q = nwg / NXCD, r = nwg % NXCD, xcd = wgid % NXCD, off = wgid / NXCD; wgid = (xcd < r ? xcd * (q + 1) : r * (q + 1) + (xcd - r) * q) + off; }
        const int nig = WGM * nN, gid = wgid / nig, fm = gid * WGM, gsz = (nM - fm) < WGM ? (nM - fm) : WGM;
        u.pm = fm + ((wgid % nig) % gsz); u.pn = (wgid % nig) / gsz; return true;
    }
    __device__ __forceinline__ void a_ready(const Unit&) const {}
    __device__ __forceinline__ void done(const Unit&) const {}
};

template <class Epi, class Sched, bool ALIGN_EPI = false, bool SP2 = false>
__device__ __forceinline__ void gemm_phase(PG8_LAS unsigned char* lds, const Gemm g, const Sched& S, const Epi& E) {
    const int tid = threadIdx.x, wid = __builtin_amdgcn_readfirstlane(tid >> 6), lane = tid & 63, wr = wid >> 2, wc = wid & 3, fr = lane & 15, fq = lane >> 4;
    const int K = g.K, nt = K / BK;
    unsigned voffA[2], voffB[2];
#pragma unroll
    for (int i = 0; i < 2; ++i) { int R, C; stage_rc(tid * 16 + i * 8192, R, C); const int Rb = Epi::PERM ? ((R & ~31) + perm32(R & 31)) : R;
        voffA[i] = (unsigned)(R * K + C) * 2u; voffB[i] = (unsigned)(Rb * K + C) * 2u; }
    const size_t kstep = (size_t)(BK * 2);
    const size_t hstep = (size_t)HALF * K * 2;
    const size_t tstep = 2 * hstep;
    const unsigned ldsw = (unsigned)wid * 1024u;
    const int aoff = lds_byte(wr * 64 + fr, fq * 8), boff = lds_byte(wc * 32 + fr, fq * 8);
#define PG8_SA(b, h) (((b) * 2 + (h)) * HTB)
#define PG8_SB(b, h) ((4 + (b) * 2 + (h)) * HTB)
#define PG8_STAGE(bufoff, gbase, voff) do { _Pragma("unroll") for (int _i = 0; _i < 2; ++_i) \
        __builtin_amdgcn_global_load_lds((const unsigned*)((const char*)(gbase) + (voff)[_i]), (PG8_LAS unsigned*)(lds + (bufoff) + ldsw + _i * 8192), 16, 0, 0); } while (0)
#define PG8_LDA(dst, b, h) do { _Pragma("unroll") for (int m = 0; m < 4; ++m) _Pragma("unroll") for (int k = 0; k < 2; ++k) dst[m][k] = *(const PG8_LAS bf16x8*)(lds + PG8_SA(b, h) + aoff + m * 2048 + k * 1024); } while (0)
#define PG8_LDB(dst, b, h) do { _Pragma("unroll") for (int n = 0; n < 2; ++n) _Pragma("unroll") for (int k = 0; k < 2; ++k) dst[n][k] = *(const PG8_LAS bf16x8*)(lds + PG8_SB(b, h) + boff + n * 2048 + k * 1024); } while (0)
#define PG8_MMA(ai, bj, At, Bt) do { __builtin_amdgcn_s_setprio(1); _Pragma("unroll") for (int m = 0; m < 4; ++m) _Pragma("unroll") for (int n = 0; n < 2; ++n) _Pragma("unroll") for (int k = 0; k < 2; ++k) \
        acc[ai][bj][m][n] = __builtin_amdgcn_mfma_f32_16x16x32_bf16(Bt[n][k], At[m][k], acc[ai][bj][m][n], 0, 0, 0); __builtin_amdgcn_s_setprio(0); } while (0)
#define PG8_WAIT_V(n) asm volatile("s_waitcnt vmcnt(" #n ")" ::: "memory")
#define PG8_WAIT_L(n) asm volatile("s_waitcnt lgkmcnt(" #n ")" ::: "memory")
#define PG8_BAR __builtin_amdgcn_s_barrier()
#define PG8_SCHED __builtin_amdgcn_sched_barrier(0)
    Unit cur, nxt; int ui = 0;
    if (!S.next(0, cur)) return;
    f32x4 acc[2][2][4][2];
#pragma unroll
    for (int a = 0; a < 2; ++a)
#pragma unroll
        for (int b = 0; b < 2; ++b)
#pragma unroll
            for (int m = 0; m < 4; ++m)
#pragma unroll
                for (int n = 0; n < 2; ++n) acc[a][b][m][n] = (f32x4){0.f, 0.f, 0.f, 0.f};
    bf16x8 At[4][2], B0[2][2], B1[2][2];
    const char* cA = (const char*)g.A + (size_t)cur.pm * tstep; const char* cB = (const char*)g.Bt + (size_t)cur.pn * tstep;
    S.a_ready(cur);
    if constexpr (SP2) {
        PG8_STAGE(PG8_SB(0, 0), cB, voffB); PG8_STAGE(PG8_SB(0, 1), cB + hstep, voffB); PG8_STAGE(PG8_SA(0, 0), cA, voffA); PG8_STAGE(PG8_SA(0, 1), cA + hstep, voffA);
        if (wr == 1) PG8_BAR;
        PG8_WAIT_V(2); PG8_BAR;
        PG8_STAGE(PG8_SB(1, 0), cB + kstep, voffB); PG8_STAGE(PG8_SA(1, 0), cA + kstep, voffA); PG8_STAGE(PG8_SB(1, 1), cB + hstep + kstep, voffB);
        PG8_WAIT_V(6); PG8_BAR;
    } else {
        PG8_STAGE(PG8_SB(0, 0), cB, voffB); PG8_STAGE(PG8_SA(0, 0), cA, voffA); PG8_STAGE(PG8_SB(0, 1), cB + hstep, voffB); PG8_STAGE(PG8_SA(0, 1), cA + hstep, voffA);
        if (wr == 1) PG8_BAR;
        PG8_WAIT_V(4); PG8_BAR;
        PG8_STAGE(PG8_SB(1, 0), cB + kstep, voffB); PG8_STAGE(PG8_SA(1, 0), cA + kstep, voffA); PG8_STAGE(PG8_SB(1, 1), cB + hstep + kstep, voffB);
        PG8_WAIT_V(6); PG8_BAR;
    }
    for (;;) {
        const bool has_next = S.next(ui + 1, nxt);
        const char* nA = has_next ? (const char*)g.A + (size_t)nxt.pm * tstep : cA; const char* nB = has_next ? (const char*)g.Bt + (size_t)nxt.pn * tstep : cB;
        for (int t = 0; t < nt; t += 2) {
            const bool last = (t == nt - 2);
            const char* a1 = cA + (size_t)(t + 1) * kstep;
            const char* a2 = last ? nA : cA + (size_t)(t + 2) * kstep; const char* b2 = last ? nB : cB + (size_t)(t + 2) * kstep;
            const char* a3 = a2 + kstep; const char* b3 = b2 + kstep;
            if (last && has_next) S.a_ready(nxt);
            if constexpr (SP2) {
            PG8_LDB(B0, 0, 0); PG8_LDB(B1, 0, 1); PG8_SCHED; PG8_LDA(At, 0, 0); PG8_STAGE(PG8_SA(1, 1), a1 + hstep, voffA);
            PG8_WAIT_V(8); PG8_WAIT_L(0); PG8_BAR; PG8_MMA(0, 0, At, B0); PG8_MMA(0, 1, At, B1); PG8_BAR; PG8_SCHED;
            PG8_LDA(At, 0, 1); PG8_STAGE(PG8_SB(0, 0), b2, voffB); PG8_STAGE(PG8_SB(0, 1), b2 + hstep, voffB); PG8_STAGE(PG8_SA(0, 0), a2, voffA);
            PG8_WAIT_V(8); PG8_WAIT_L(0); PG8_BAR; PG8_MMA(1, 0, At, B0); PG8_MMA(1, 1, At, B1); PG8_BAR; PG8_SCHED;
            PG8_LDB(B0, 1, 0); PG8_LDB(B1, 1, 1); PG8_SCHED; PG8_LDA(At, 1, 0); PG8_STAGE(PG8_SA(0, 1), a2 + hstep, voffA);
            PG8_WAIT_V(8); PG8_WAIT_L(0); PG8_BAR; PG8_MMA(0, 0, At, B0); PG8_MMA(0, 1, At, B1); PG8_BAR; PG8_SCHED;
            PG8_LDA(At, 1, 1); PG8_STAGE(PG8_SB(1, 0), b3, voffB); PG8_STAGE(PG8_SB(1, 1), b3 + hstep, voffB); PG8_STAGE(PG8_SA(1, 0), a3, voffA);
            PG8_WAIT_V(8); PG8_WAIT_L(0); PG8_BAR; PG8_MMA(1, 0, At, B0); PG8_MMA(1, 1, At, B1); PG8_BAR; PG8_SCHED;
            } else {
            PG8_LDB(B0, 0, 0); PG8_SCHED; PG8_LDA(At, 0, 0); PG8_STAGE(PG8_SA(1, 1), a1 + hstep, voffA);
            PG8_WAIT_L(8); PG8_BAR; PG8_WAIT_L(0); PG8_MMA(0, 0, At, B0); PG8_BAR; PG8_SCHED;
            PG8_LDB(B1, 0, 1); PG8_STAGE(PG8_SB(0, 0), b2, voffB);
            PG8_BAR; PG8_WAIT_L(0); PG8_MMA(0, 1, At, B1); PG8_BAR;
            PG8_LDA(At, 0, 1); PG8_STAGE(PG8_SA(0, 0), a2, voffA);
            PG8_BAR; PG8_WAIT_L(0); PG8_MMA(1, 0, At, B0); PG8_BAR; PG8_SCHED;
            PG8_STAGE(PG8_SB(0, 1), b2 + hstep, voffB);
            PG8_WAIT_V(6); PG8_BAR; PG8_MMA(1, 1, At, B1); PG8_BAR;
            PG8_LDB(B0, 1, 0); PG8_SCHED; PG8_LDA(At, 1, 0); PG8_STAGE(PG8_SA(0, 1), a2 + hstep, voffA);
            PG8_WAIT_L(8); PG8_BAR; PG8_WAIT_L(0); PG8_MMA(0, 0, At, B0); PG8_BAR; PG8_SCHED;
            PG8_LDB(B1, 1, 1); PG8_STAGE(PG8_SB(1, 0), b3, voffB);
            PG8_BAR; PG8_WAIT_L(0); PG8_MMA(0, 1, At, B1); PG8_BAR;
            PG8_LDA(At, 1, 1); PG8_STAGE(PG8_SA(1, 0), a3, voffA);
            PG8_BAR; PG8_WAIT_L(0); PG8_MMA(1, 0, At, B0); PG8_BAR; PG8_SCHED;
            PG8_STAGE(PG8_SB(1, 1), b3 + hstep, voffB);
            PG8_WAIT_V(6); PG8_BAR; PG8_MMA(1, 1, At, B1); PG8_BAR;
            }
        }
        if constexpr (ALIGN_EPI) { if (wr == 0) PG8_BAR; }
        if constexpr (!Epi::AFTER_DRAIN) { E(acc, cur, wr, wc, fr, fq); S.done(cur); }
        if (!has_next) break;
#pragma unroll
        for (int a = 0; a < 2; ++a)
#pragma unroll
            for (int b = 0; b < 2; ++b)
#pragma unroll
                for (int m = 0; m < 4; ++m)
#pragma unroll
                    for (int n = 0; n < 2; ++n) acc[a][b][m][n] = (f32x4){0.f, 0.f, 0.f, 0.f};
        cur = nxt; cA = nA; cB = nB; ++ui;
        if constexpr (ALIGN_EPI) { if (wr == 1) PG8_BAR; }
    }
    PG8_WAIT_V(0);
    if constexpr (!ALIGN_EPI) { if (wr == 0) PG8_BAR; }
    PG8_BAR;
    if constexpr (Epi::AFTER_DRAIN) { E.fused(acc, cur, wr, wc, fr, fq, lds, wid, lane); S.done(cur); }
#undef PG8_SA
#undef PG8_SB
#undef PG8_STAGE
#undef PG8_LDA
#undef PG8_LDB
#undef PG8_MMA
#undef PG8_WAIT_V
#undef PG8_WAIT_L
#undef PG8_BAR
#undef PG8_SCHED
}
}
#define XB_TMO      128
#define XB_XCNT(j)  (256  + 64 * (j))
#define XB_XSUB(j)  (1280 + 64 * (j))
#define XB_XGEN(j)  (2304 + 64 * (j))
#define XB_TOP      3328
#define XB_TOPGEN   3392
#define XCD_BAR_WORDS 3456
#define XB_SPIN_CAP (1u << 18)
#define LAS __attribute__((address_space(3)))

__device__ __forceinline__ unsigned xb_ld(unsigned* p)              { return __hip_atomic_load(p, __ATOMIC_RELAXED, __HIP_MEMORY_SCOPE_AGENT); }
__device__ __forceinline__ unsigned xb_add(unsigned* p, unsigned v) { return __hip_atomic_fetch_add(p, v, __ATOMIC_RELAXED, __HIP_MEMORY_SCOPE_AGENT); }
__device__ __forceinline__ unsigned xb_xcc_id() { return (unsigned)__builtin_amdgcn_s_getreg((3 << 11) | 20) & 0xFu; }
#define XB_SPIN(cond, bar) do { unsigned _sp = 0; while (cond) { __builtin_amdgcn_s_sleep(1); \
    if ((++_sp & 255u) == 0u) { if (xb_ld(&(bar)[XB_TMO])) break; if (_sp > XB_SPIN_CAP) { atomicAdd(&(bar)[XB_TMO], 1u); break; } } } } while (0)

struct XcdBarrier {
    unsigned* bar; unsigned x;
    volatile LAS unsigned* st;
};

__device__ __forceinline__ XcdBarrier xcd_barrier_post(unsigned* bar, volatile LAS unsigned* st) {
    XcdBarrier b; b.bar = bar; b.x = xb_xcc_id(); b.st = st;
    if (threadIdx.x == 0) (void)xb_add(&bar[XB_XCNT(b.x)], 1u);
    return b;
}
__device__ __forceinline__ void xcd_barrier_complete(unsigned* bar, unsigned x, unsigned& nloc, unsigned& nx) {
    const unsigned G = gridDim.x * gridDim.y * gridDim.z;
    unsigned sum, cnt, mine, sp = 0u;
    for (;;) {
        sum = 0u; cnt = 0u; mine = 0u;
#pragma unroll
        for (unsigned j = 0; j < 16; ++j) { const unsigned c = xb_ld(&bar[XB_XCNT(j)]); sum += c; cnt += (c > 0u) ? 1u : 0u; mine = (j == x) ? c : mine; }
        if (sum == G) break;
        __builtin_amdgcn_s_sleep(1);
        if ((++sp & 255u) == 0u) { if (xb_ld(&bar[XB_TMO])) break; if (sp > XB_SPIN_CAP) { atomicAdd(&bar[XB_TMO], 1u); break; } }
    }
    nloc = mine > 0u ? mine : 1u; nx = cnt > 0u ? cnt : 1u;
}

__device__ __forceinline__ void xcd_barrier(const XcdBarrier& b) {
    asm volatile("s_waitcnt vmcnt(0)" ::: "memory");
    __syncthreads();
    if (threadIdx.x == 0) {
        unsigned* bar = b.bar;
        __builtin_amdgcn_s_waitcnt(0);
        unsigned nloc = b.st[0], nx = b.st[1];
        if (nloc == 0u) { xcd_barrier_complete(bar, b.x, nloc, nx); b.st[0] = nloc; b.st[1] = nx; }
        const unsigned old = xb_add(&bar[XB_XSUB(b.x)], 1u);
        const unsigned gen = old / nloc;
        if (old + 1u == (gen + 1u) * nloc) {
            __builtin_amdgcn_fence(__ATOMIC_RELEASE, "agent");
            asm volatile("s_waitcnt vmcnt(0)" ::: "memory");
            const unsigned og = xb_add(&bar[XB_TOP], 1u);
            const unsigned tg = og / nx;
            if (og + 1u == (tg + 1u) * nx) xb_add(&bar[XB_TOPGEN], 1u);
            else XB_SPIN(xb_ld(&bar[XB_TOPGEN]) == tg, bar);
            __builtin_amdgcn_fence(__ATOMIC_ACQUIRE, "agent");
            xb_add(&bar[XB_XGEN(b.x)], 1u);
            asm volatile("s_waitcnt vmcnt(0)" ::: "memory");
        } else {
            XB_SPIN(xb_ld(&bar[XB_XGEN(b.x)]) == gen, bar);
            __builtin_amdgcn_fence(__ATOMIC_ACQUIRE, "agent");
            asm volatile("s_waitcnt vmcnt(0)" ::: "memory");
        }
    }
    __syncthreads();
}
#define DI __device__ __forceinline__
#define LAS3 __attribute__((address_space(3)))
using pg8::bf16_t; using pg8::bf16x8; using pg8::f32x4; using pg8::u32x4;
typedef unsigned u32x2 __attribute__((ext_vector_type(2)));
typedef short s16x4 __attribute__((ext_vector_type(4)));
typedef float f32x2 __attribute__((ext_vector_type(2)));
typedef __bf16 bf16x2_t __attribute__((ext_vector_type(2)));

constexpr int DM = 1024, NB = 16, SEQ = 2048, MP = NB * SEQ  , NDB = 32  , MROWS = 33024  ;
constexpr int NMEM = 256, MMEM = NB * NMEM  , DIN = 3412, NIN = 3584, NPAGES = 128;
constexpr int NTHREADS = 512;
constexpr size_t O_YP = 0, O_YS = O_YP + (size_t)MP * DM, O_GSP = O_YS + (size_t)NDB * DM, O_KP = O_GSP + (size_t)NB * 4 * 64 * 128,
                 O_VP = O_KP + (size_t)MP * 256, O_IKP = O_VP + (size_t)MP * 256, O_MKP = O_IKP + (size_t)MP * 64, O_MVP = O_MKP + (size_t)MMEM * 256,
                 O_GSS = O_MVP + (size_t)MMEM * 256, O_KS = O_GSS + (size_t)NDB * 4 * 64 * 128, O_VS = O_KS + (size_t)NDB * 256, O_IKS = O_VS + (size_t)NDB * 256,
                 O_END = O_IKS + (size_t)NDB * 64;
static_assert(O_END == 56150016, "output size");
constexpr size_t al256(size_t x) { return (x + 255) & ~(size_t)255; }
constexpr size_t CTRL_BYTES = 32768;
constexpr size_t CW_QDSA = 16384  , CW_QMEM = 18432  , CW_SCNT = 20480, CW_TMO = 20736, CW_CHK = 20992, CW_TSUM = 21248, CW_TMAX = 21504, CW_MEMC = 21760;
constexpr int SCLD = 16400;
constexpr size_t W_ROPE = CTRL_BYTES;
constexpr size_t W_XN = al256(W_ROPE + (size_t)2049 * 32 * 8);
constexpr size_t W_MEMN = W_XN + (size_t)MROWS * 1024 * 2;
constexpr size_t W_WTIN = W_MEMN + (size_t)MMEM * 1024 * 2;
constexpr size_t W_WTMEM = W_WTIN + (size_t)NIN * 1024 * 2;
constexpr size_t W_WTOUT = W_WTMEM + (size_t)512 * 1024 * 2;
constexpr size_t W_GQ = W_WTOUT + (size_t)1024 * 1024 * 2;
constexpr size_t W_GK = W_GQ + (size_t)MROWS * 256 * 2;
constexpr size_t W_GV = W_GK + (size_t)MROWS * 256 * 2;
constexpr size_t W_GG = W_GV + (size_t)MROWS * 512 * 2;
constexpr size_t W_DQ = W_GG + (size_t)MROWS * 512 * 2;
constexpr size_t W_DK = W_DQ + (size_t)MROWS * 256 * 2;
constexpr size_t W_DVT = W_DK + (size_t)MROWS * 256 * 2;
constexpr size_t W_IQ = W_DVT + (size_t)MP * 256 * 2;
constexpr size_t W_DG = W_IQ + (size_t)MROWS * 256 * 2;
constexpr size_t W_MQ = W_DG + (size_t)MROWS * 256 * 2;
constexpr size_t W_MG = W_MQ + (size_t)MROWS * 256 * 2;
constexpr size_t W_IK = W_MG + (size_t)MROWS * 256 * 2;
constexpr size_t W_IW = W_IK + (size_t)MROWS * 64 * 2;
constexpr size_t W_GLR = W_IW + (size_t)MROWS * 4 * 4;
constexpr size_t W_MK = W_GLR + (size_t)MROWS * 16 * 4;
constexpr size_t W_MVT = W_MK + (size_t)MMEM * 256 * 2;
constexpr size_t W_MIX = W_MVT + (size_t)MMEM * 256 * 2;
constexpr size_t W_SC = W_MIX + (size_t)MROWS * 1024 * 2;
constexpr size_t W_END = W_SC + (size_t)NDB * SCLD * 4;
constexpr int LDS_MISC = 148480, LDS_BYTES = 148480 + 256;

struct Params {
    const float *x_prompt, *x_sample, *mem_prompt, *state_gla, *cache_k, *cache_v, *cache_ik, *cache_mem_k, *cache_mem_v;
    const int* page_table;
    const float *norm_in, *w_in, *w_g2, *b_g, *onorm, *mem_norm, *w_mem_kv, *w_out, *norm_final;
    float* out; unsigned char* ws; int ph_lo, ph_hi;
};

#ifdef TSEL
#define TDECL unsigned tacc_ = 0u, tbeg_ = 0u
#define TBEG(k) do { if ((k) == TSEL) tbeg_ = (unsigned)__builtin_amdgcn_s_memrealtime(); } while (0)
#define TEND(k) do { if ((k) == TSEL) tacc_ += (unsigned)__builtin_amdgcn_s_memrealtime() - tbeg_; } while (0)
#define TARGS , unsigned& tacc_, unsigned& tbeg_
#define TPASS , tacc_, tbeg_
#else
#define TARGS
#define TPASS
#define TDECL do {} while (0)
#define TBEG(k) do {} while (0)
#define TEND(k) do {} while (0)
#endif
DI float bf2f(bf16_t v) { return __uint_as_float((unsigned)v << 16); }
DI unsigned cvtpk(float lo, float hi) { f32x2 v = {lo, hi}; bf16x2_t b = __builtin_convertvector(v, bf16x2_t); return __builtin_bit_cast(unsigned, b); }
DI bf16_t f2bf(float x) { return (bf16_t)(cvtpk(x, 0.f) & 0xffffu); }
DI f32x4 mfma16(bf16x8 a, bf16x8 b, f32x4 c) { return __builtin_amdgcn_mfma_f32_16x16x32_bf16(a, b, c, 0, 0, 0); }
DI float fexp(float x) { return __builtin_amdgcn_exp2f(x * 1.4426950408889634f); }
DI float siluf(float x) { return x * __builtin_amdgcn_rcpf(1.f + fexp(-x)); }
DI float logsigf(float u) { return fminf(u, 0.f) - 0.6931471805599453f * __builtin_amdgcn_logf(1.f + fexp(-fabsf(u))); }
DI unsigned fkey(float x) { unsigned u = __float_as_uint(x); u = (u == 0x80000000u) ? 0u : u; return u ^ ((unsigned)((int)u >> 31) | 0x80000000u); }
DI float wsum64(float v) { v += __shfl_xor(v, 1); v += __shfl_xor(v, 2); v += __shfl_xor(v, 4); v += __shfl_xor(v, 8); v += __shfl_xor(v, 16); v += __shfl_xor(v, 32); return v; }
DI float wmax64(float v) { v = fmaxf(v, __shfl_xor(v, 1)); v = fmaxf(v, __shfl_xor(v, 2)); v = fmaxf(v, __shfl_xor(v, 4)); v = fmaxf(v, __shfl_xor(v, 8)); v = fmaxf(v, __shfl_xor(v, 16)); v = fmaxf(v, __shfl_xor(v, 32)); return v; }
DI unsigned lds_add(LAS3 unsigned* p, unsigned v) { return __hip_atomic_fetch_add(p, v, __ATOMIC_RELAXED, __HIP_MEMORY_SCOPE_WORKGROUP); }
DI unsigned lds_or(LAS3 unsigned* p, unsigned v) { return __hip_atomic_fetch_or(p, v, __ATOMIC_RELAXED, __HIP_MEMORY_SCOPE_WORKGROUP); }
DI void st_bf16x4(bf16_t* p, f32x4 v) { u32x2 w; w.x = cvtpk(v[0], v[1]); w.y = cvtpk(v[2], v[3]); *(u32x2*)p = w; }
DI const float* vaddr(const float* q) { asm volatile("" : "+v"(q)); return q; }
constexpr float LOG2E = 1.4426950408889634f;
#define NEG_INF (-__builtin_inff())

DI int rope_perm(int vc) { return 64 * (vc >> 6) + 16 * ((vc >> 5) & 1) + (vc & 15) + 32 * ((vc >> 4) & 1); }
DI int rope_map(int vc) { return 64 * ((vc >> 5) & 3) + 32 * ((vc >> 4) & 1) + 8 * ((vc >> 2) & 3) + 4 * (vc >> 7) + (vc & 3); }
DI int plain_map(int vc) { return (vc & ~31) + 8 * ((vc >> 2) & 3) + 4 * ((vc >> 4) & 1) + (vc & 3); }
DI int in_src(int np) {
    const int pn = np >> 8, vc = np & 255;
    switch (pn) {
        case 0: return plain_map(vc);
        case 1: return 256 + plain_map(vc);
        case 2: case 3: return 512 + 256 * (pn - 2) + plain_map(vc);
        case 4: case 5: return 1040 + 256 * (pn - 4) + plain_map(vc);
        case 6: return 1552 + rope_map(vc);
        case 7: return 1808 + rope_map(vc);
        case 8: return 2064 + plain_map(vc);
        case 9: return 2320 + rope_map(vc);
        case 10: return 2644 + plain_map(vc);
        case 11: return 2900 + plain_map(vc);
        case 12: return 3156 + plain_map(vc);
        default: break;
    }
    if (vc < 64) return 2576 + rope_perm(vc);
    if (vc < 68) return 2640 + (vc - 64);
    if (vc < 84) return 1024 + (vc - 68);
    return -1;
}

struct EpiIn {
    static constexpr bool PERM = false, AFTER_DRAIN = false;
    unsigned char* ws; float* out;
    DI void operator()(const f32x4 (&acc)[2][2][4][2], const pg8::Unit& u, int wr, int wc, int fr, int fq) const {
        const int pn = u.pn, rbase = u.pm * 256 + wr * 64 + fr;
        if (pn <= 5 || (pn >= 10 && pn <= 12)) {
            bf16_t* dst; int ldc = 256, coff = 0; float sc = 1.f; bool silu = false;
            switch (pn) {
                case 0: dst = (bf16_t*)(ws + W_GQ); sc = 0.125f; break;
                case 1: dst = (bf16_t*)(ws + W_GK); break;
                case 2: dst = (bf16_t*)(ws + W_GV); ldc = 512; break;
                case 3: dst = (bf16_t*)(ws + W_GV); ldc = 512; coff = 256; break;
                case 4: dst = (bf16_t*)(ws + W_GG); ldc = 512; silu = true; break;
                case 5: dst = (bf16_t*)(ws + W_GG); ldc = 512; coff = 256; silu = true; break;
                case 10: dst = (bf16_t*)(ws + W_DG); silu = true; break;
                case 11: dst = (bf16_t*)(ws + W_MQ); sc = 0.125f * LOG2E; break;
                default: dst = (bf16_t*)(ws + W_MG); silu = true; break;
            }
#pragma unroll
            for (int ai = 0; ai < 2; ++ai)
#pragma unroll
                for (int m = 0; m < 4; ++m) {
                    const int row = rbase + ai * 128 + m * 16;
                    bf16_t* rp = dst + (size_t)row * ldc + coff + wc * 32 + 8 * fq;
#pragma unroll
                    for (int bj = 0; bj < 2; ++bj) {
                        f32x4 v0 = acc[ai][bj][m][0], v1 = acc[ai][bj][m][1];
                        if (silu) { v0[0] = siluf(v0[0]); v0[1] = siluf(v0[1]); v0[2] = siluf(v0[2]); v0[3] = siluf(v0[3]); v1[0] = siluf(v1[0]); v1[1] = siluf(v1[1]); v1[2] = siluf(v1[2]); v1[3] = siluf(v1[3]); }
                        else { v0 = v0 * sc; v1 = v1 * sc; }
                        u32x4 w; w.x = cvtpk(v0[0], v0[1]); w.y = cvtpk(v0[2], v0[3]); w.z = cvtpk(v1[0], v1[1]); w.w = cvtpk(v1[2], v1[3]);
                        *(u32x4*)(rp + bj * 128) = w;
                    }
                }
        } else if (pn == 6 || pn == 7 || pn == 9) {
            bf16_t* dst = (bf16_t*)(ws + (pn == 6 ? W_DQ : (pn == 7 ? W_DK : W_IQ)));
            const float sc = (pn == 6) ? 0.125f * LOG2E : 1.f;
            const float* rope = (const float*)(ws + W_ROPE);
#pragma unroll
            for (int ai = 0; ai < 2; ++ai)
#pragma unroll
                for (int m = 0; m < 4; ++m) {
                    const int row = rbase + ai * 128 + m * 16;
                    const int pi = row < MP ? (row & 2047) : 2048;
                    const float* rp = rope + ((size_t)pi * 32 + 8 * fq) * 2;
                    f32x4 o1[2], o2[2];
#pragma unroll
                    for (int bj = 0; bj < 2; ++bj) {
                        const f32x4 cs0 = *(const f32x4*)(rp + 8 * bj), cs1 = *(const f32x4*)(rp + 8 * bj + 4);
                        const f32x4 c = {cs0[0], cs0[2], cs1[0], cs1[2]}, s = {cs0[1], cs0[3], cs1[1], cs1[3]};
                        const f32x4 v0 = acc[ai][bj][m][0], v1 = acc[ai][bj][m][1];
                        o1[bj] = (v0 * c - v1 * s) * sc; o2[bj] = (v1 * c + v0 * s) * sc;
                    }
                    const int col1 = 64 * wc + 8 * fq, col2 = col1 + 32;
                    u32x4 w1, w2; w1.x = cvtpk(o1[0][0], o1[0][1]); w1.y = cvtpk(o1[0][2], o1[0][3]); w1.z = cvtpk(o1[1][0], o1[1][1]); w1.w = cvtpk(o1[1][2], o1[1][3]);
                    w2.x = cvtpk(o2[0][0], o2[0][1]); w2.y = cvtpk(o2[0][2], o2[0][3]); w2.z = cvtpk(o2[1][0], o2[1][1]); w2.w = cvtpk(o2[1][2], o2[1][3]);
                    *(u32x4*)(dst + (size_t)row * 256 + col1) = w1; *(u32x4*)(dst + (size_t)row * 256 + col2) = w2;
                    if (pn == 7) {
                        float* op = nullptr;
                        if (row < MP) op = out + O_KP + (size_t)row * 256; else if (row < MP + NDB) op = out + O_KS + (size_t)(row - MP) * 256;
                        if (op) { *(f32x4*)(op + col1) = o1[0]; *(f32x4*)(op + col1 + 4) = o1[1]; *(f32x4*)(op + col2) = o2[0]; *(f32x4*)(op + col2 + 4) = o2[1]; }
                    }
                }
        } else if (pn == 8) {
            bf16_t* dvt = (bf16_t*)(ws + W_DVT);
#pragma unroll
            for (int ai = 0; ai < 2; ++ai)
#pragma unroll
                for (int m = 0; m < 4; ++m) {
                    const int row = rbase + ai * 128 + m * 16;
                    float* op = nullptr;
                    if (row < MP) op = out + O_VP + (size_t)row * 256; else if (row < MP + NDB) op = out + O_VS + (size_t)(row - MP) * 256;
#pragma unroll
                    for (int bj = 0; bj < 2; ++bj)
#pragma unroll
                        for (int n = 0; n < 2; ++n) {
                            const f32x4 v = acc[ai][bj][m][n];
                            const int col = 128 * bj + 32 * wc + 8 * fq + 4 * n;
                            if (op) *(f32x4*)(op + col) = v;
                            if (row < MP) {
                                const int t_ = row & 2047, kk_ = t_ & 31;
                                bf16_t* tp = dvt + ((((size_t)(row >> 11) * 64 + (t_ >> 5)) * 4 + (col >> 6)) * 64 + (col & 63)) * 32 + 8 * ((kk_ >> 2) & 3) + 4 * (kk_ >> 4) + (kk_ & 3);
                                tp[0] = f2bf(v[0]); tp[32] = f2bf(v[1]); tp[64] = f2bf(v[2]); tp[96] = f2bf(v[3]);
                            }
                        }
                }
        } else {
            bf16_t* ikb = (bf16_t*)(ws + W_IK); float* iw = (float*)(ws + W_IW); float* glr = (float*)(ws + W_GLR);
            const float* rope = (const float*)(ws + W_ROPE);
#pragma unroll
            for (int ai = 0; ai < 2; ++ai)
#pragma unroll
                for (int m = 0; m < 4; ++m) {
                    const int row = rbase + ai * 128 + m * 16;
                    const f32x4 v0 = acc[ai][0][m][0], v1 = acc[ai][0][m][1];
                    if (wc < 2) {
                        const int pi = row < MP ? (row & 2047) : 2048;
                        const int f0 = 16 * wc + 4 * fq;
                        const f32x4 cs0 = *(const f32x4*)(rope + ((size_t)pi * 32 + f0) * 2), cs1 = *(const f32x4*)(rope + ((size_t)pi * 32 + f0) * 2 + 4);
                        const f32x4 c = {cs0[0], cs0[2], cs1[0], cs1[2]}, s = {cs0[1], cs0[3], cs1[1], cs1[3]};
                        const f32x4 o1 = v0 * c - v1 * s, o2 = v1 * c + v0 * s;
                        st_bf16x4(ikb + (size_t)row * 64 + f0, o1); st_bf16x4(ikb + (size_t)row * 64 + f0 + 32, o2);
                        float* op = nullptr;
                        if (row < MP) op = out + O_IKP + (size_t)row * 64; else if (row < MP + NDB) op = out + O_IKS + (size_t)(row - MP) * 64;
                        if (op) { *(f32x4*)(op + f0) = o1; *(f32x4*)(op + f0 + 32) = o2; }
                    } else if (wc == 2) {
                        if (fq == 0) { *(f32x4*)(iw + (size_t)row * 4) = v0 * 0.5f; *(f32x4*)(glr + (size_t)row * 16 + 12) = v1; }
                        else *(f32x4*)(glr + (size_t)row * 16 + 4 * (fq - 1)) = v0;
                    }
                }
        }
    }
};
struct EpiMem {
    static constexpr bool PERM = false, AFTER_DRAIN = false;
    unsigned char* ws; float* out;
    DI void operator()(const f32x4 (&acc)[2][2][4][2], const pg8::Unit& u, int wr, int wc, int fr, int fq) const {
        const int pn = u.pn, rbase = u.pm * 256 + wr * 64 + fr;
        bf16_t* mk = (bf16_t*)(ws + W_MK); bf16_t* mvt = (bf16_t*)(ws + W_MVT);
        float* op0 = out + (pn == 0 ? O_MKP : O_MVP);
#pragma unroll
        for (int ai = 0; ai < 2; ++ai)
#pragma unroll
            for (int m = 0; m < 4; ++m) {
                const int row = rbase + ai * 128 + m * 16;
#pragma unroll
                for (int bj = 0; bj < 2; ++bj)
#pragma unroll
                    for (int n = 0; n < 2; ++n) {
                        const f32x4 v = acc[ai][bj][m][n];
                        const int col = 128 * bj + 32 * wc + 16 * n + 4 * fq;
                        *(f32x4*)(op0 + (size_t)row * 256 + col) = v;
                        if (pn == 0) st_bf16x4(mk + (size_t)row * 256 + col, v);
                        else { const int m_ = row & 255, kk_ = m_ & 31;
                               bf16_t* tp = mvt + ((((size_t)(row >> 8) * 8 + (m_ >> 5)) * 4 + (col >> 6)) * 64 + (col & 63)) * 32 + 8 * ((kk_ >> 2) & 3) + 4 * (kk_ >> 4) + (kk_ & 3);
                               tp[0] = f2bf(v[0]); tp[32] = f2bf(v[1]); tp[64] = f2bf(v[2]); tp[96] = f2bf(v[3]); }
                    }
            }
    }
};
struct EpiOut {
    static constexpr bool PERM = false, AFTER_DRAIN = false;
    const float* xp; const float* xs; float* out;
    DI void operator()(const f32x4 (&acc)[2][2][4][2], const pg8::Unit& u, int wr, int wc, int fr, int fq) const {
        const int rbase = u.pm * 256 + wr * 64 + fr, cbase = u.pn * 256 + wc * 32 + 4 * fq;
#pragma unroll
        for (int ai = 0; ai < 2; ++ai)
#pragma unroll
            for (int m = 0; m < 4; ++m) {
                const int row = rbase + ai * 128 + m * 16;
                const float* xr; float* orow;
                if (row < MP) { xr = xp + (size_t)row * DM; orow = out + O_YP + (size_t)row * DM; }
                else if (row < MP + NDB) { xr = xs + (size_t)(row - MP) * DM; orow = out + O_YS + (size_t)(row - MP) * DM; }
                else continue;
#pragma unroll
                for (int bj = 0; bj < 2; ++bj)
#pragma unroll
                    for (int n = 0; n < 2; ++n) { const int col = cbase + bj * 128 + n * 16; *(f32x4*)(orow + col) = acc[ai][bj][m][n] + *(const f32x4*)(xr + col); }
            }
    }
};
DI void p0_prologue(const Params& p, LAS3 unsigned char* lds) {
    const int tid = threadIdx.x, lane = tid & 63, wv = tid >> 6;
    unsigned char* ws = p.ws;
    {
        const int rstep = gridDim.x * 16, rend = MROWS + MMEM;
        int r0 = (blockIdx.x * 8 + wv) * 2;
        auto row_src = [&](int r) -> const float* {
            r = r < rend ? r : rend - 1;
            if (r < MP) return p.x_prompt + (size_t)r * DM;
            if (r < MP + NDB) return p.x_sample + (size_t)(r - MP) * DM;
            if (r < MROWS) return p.x_prompt;
            return p.mem_prompt + (size_t)(r - MROWS) * DM;
        };
        f32x4 v[2][4], vn[2][4];
#pragma unroll
        for (int e = 0; e < 2; ++e) { const float* s = row_src(r0 + e);
#pragma unroll
            for (int i = 0; i < 4; ++i) v[e][i] = *(const f32x4*)(s + i * 256 + lane * 4); }
        for (; r0 < rend; r0 += rstep) {
#pragma unroll
            for (int e = 0; e < 2; ++e) { const float* s = row_src(r0 + rstep + e);
#pragma unroll
                for (int i = 0; i < 4; ++i) vn[e][i] = *(const f32x4*)(s + i * 256 + lane * 4); }
#pragma unroll
            for (int e = 0; e < 2; ++e) {
                const int r = r0 + e;
                const bool pad = (r >= MP + NDB && r < MROWS);
                const float* g = r < MROWS ? p.norm_in : p.mem_norm;
                bf16_t* dst = r < MROWS ? (bf16_t*)(ws + W_XN) + (size_t)r * DM : (bf16_t*)(ws + W_MEMN) + (size_t)(r - MROWS) * DM;
                float ss = 0.f;
#pragma unroll
                for (int i = 0; i < 4; ++i) ss += v[e][i][0] * v[e][i][0] + v[e][i][1] * v[e][i][1] + v[e][i][2] * v[e][i][2] + v[e][i][3] * v[e][i][3];
                ss = wsum64(ss);
                const float rstd = pad ? 0.f : rsqrtf(ss * (1.f / DM) + 1e-6f);
#pragma unroll
                for (int i = 0; i < 4; ++i) { const f32x4 gv = *(const f32x4*)(g + i * 256 + lane * 4); st_bf16x4(dst + i * 256 + lane * 4, v[e][i] * rstd * gv); }
            }
#pragma unroll
            for (int e = 0; e < 2; ++e)
#pragma unroll
                for (int i = 0; i < 4; ++i) v[e][i] = vn[e][i];
        }
    }
    for (int e = blockIdx.x * NTHREADS + tid; e < 2049 * 32; e += gridDim.x * NTHREADS) {
        const int pi = e >> 5, f = e & 31;
        const float inv = powf(10000.0f, -(float)(2 * f) / 64.0f);
        const float ang = (float)(pi == 2048 ? 16384 : pi) * inv;
        float sn, cs; sincosf(ang, &sn, &cs);
        ((f32x2*)(ws + W_ROPE))[e] = (f32x2){cs, sn};
    }
    LAS3 float* tl = (LAS3 float*)lds;
    {
        auto tile_load = [&](int tile, float (&wr)[8]) {
            tile = tile < 1280 ? tile : 1279;
            int which, t2, ld; const float* W;
            if (tile < 896) { which = 0; t2 = tile; W = p.w_in; ld = DIN; }
            else if (tile < 1024) { which = 1; t2 = tile - 896; W = p.w_mem_kv; ld = 512; }
            else { which = 2; t2 = tile - 1024; W = p.w_out; ld = 1024; }
            const int nt = t2 >> 4, kt = t2 & 15;
            const int nn = tid & 63, kk0 = tid >> 6; const int np = nt * 64 + nn; int sc = which == 0 ? in_src(np) : np;
            const bool zero = sc < 0; sc = zero ? 0 : sc;
#pragma unroll
            for (int i = 0; i < 8; ++i) { const float w = W[(size_t)(kt * 64 + kk0 + 8 * i) * ld + sc]; wr[i] = zero ? 0.f : w; }
        };
        float wr[8], wn[8];
        tile_load(blockIdx.x, wr);
        for (int tile = blockIdx.x; tile < 1280; tile += gridDim.x) {
            bf16_t* dst; int t2;
            if (tile < 896) { t2 = tile; dst = (bf16_t*)(ws + W_WTIN); }
            else if (tile < 1024) { t2 = tile - 896; dst = (bf16_t*)(ws + W_WTMEM); }
            else { t2 = tile - 1024; dst = (bf16_t*)(ws + W_WTOUT); }
            const int nt = t2 >> 4, kt = t2 & 15;
            { const int nn = tid & 63, kk0 = tid >> 6;
#pragma unroll
              for (int i = 0; i < 8; ++i) tl[(kk0 + 8 * i) * 65 + nn] = wr[i]; }
            __syncthreads();
            tile_load(tile + gridDim.x, wn);
            { const int kk = tid & 63, nn0 = tid >> 6;
#pragma unroll
              for (int i = 0; i < 8; ++i) { const int n = nn0 + 8 * i; dst[(size_t)(nt * 64 + n) * 1024 + kt * 64 + kk] = f2bf(tl[kk * 65 + n]); } }
            __syncthreads();
#pragma unroll
            for (int i = 0; i < 8; ++i) wr[i] = wn[i];
        }
    }
}

DI void cnt_ge(unsigned& c, unsigned key, unsigned cand) { asm volatile("v_cmp_ge_u32 vcc, %1, %2\n\tv_addc_co_u32 %0, vcc, 0, %0, vcc" : "+v"(c) : "v"(key), "v"(cand) : "vcc"); }
DI void cnt_gt(unsigned& c, unsigned key, unsigned cand) { asm volatile("v_cmp_gt_u32 vcc, %1, %2\n\tv_addc_co_u32 %0, vcc, 0, %0, vcc" : "+v"(c) : "v"(key), "v"(cand) : "vcc"); }
DI void cnt_eq_lt(unsigned& c, unsigned key, unsigned T, unsigned idx, unsigned cand) {
    unsigned tmp;
    asm volatile("v_cmp_eq_u32 vcc, %2, %3\n\tv_cndmask_b32 %1, -1, %4, vcc\n\tv_cmp_lt_u32 vcc, %1, %5\n\tv_addc_co_u32 %0, vcc, 0, %0, vcc" : "+v"(c), "=&v"(tmp) : "v"(key), "v"(T), "v"(idx), "v"(cand) : "vcc"); }
DI unsigned grp_count16(unsigned c, LAS3 unsigned* CNT, int& it, int fr, int lane) {
    c += __shfl_xor(c, 16); c += __shfl_xor(c, 32);
    LAS3 unsigned* cur = CNT + (it % 3) * 16;
    if (lane < 16) lds_add(cur + fr, c);
    __syncthreads();
    const unsigned tot = cur[fr];
    if (threadIdx.x < 16) CNT[((it + 2) % 3) * 16 + threadIdx.x] = 0u;
    ++it; return tot;
}
DI unsigned blk_count(unsigned c, LAS3 unsigned* CNT, int& it, int lane) {
    c += __shfl_xor(c, 1); c += __shfl_xor(c, 2); c += __shfl_xor(c, 4); c += __shfl_xor(c, 8); c += __shfl_xor(c, 16); c += __shfl_xor(c, 32);
    LAS3 unsigned* cur = CNT + (it % 3) * 16;
    if (lane == 0) lds_add(cur, c);
    __syncthreads();
    const unsigned tot = cur[0];
    if (threadIdx.x == 0) CNT[((it + 2) % 3) * 16] = 0u;
    ++it; return tot;
}

DI float fmax3(float a, float b2, float c) { float d; asm("v_max3_f32 %0, %1, %2, %3" : "=v"(d) : "v"(a), "v"(b2), "v"(c)); return d; }
DI float mask_sel(int allones, float s) { return __uint_as_float(((unsigned)allones & __float_as_uint(s)) | (~(unsigned)allones & 0xff800000u)); }
DI float rowmax4(float x) {
    auto r = __builtin_amdgcn_permlane16_swap(__float_as_uint(x), __float_as_uint(x), false, false);
    const float y = fmax3(__uint_as_float(r[0]), __uint_as_float(r[1]), NEG_INF);
    r = __builtin_amdgcn_permlane32_swap(__float_as_uint(y), __float_as_uint(y), false, false);
    return fmax3(__uint_as_float(r[0]), __uint_as_float(r[1]), NEG_INF);
}
DI float rowsum4(float x) {
    auto r = __builtin_amdgcn_permlane16_swap(__float_as_uint(x), __float_as_uint(x), false, false);
    const float y = __uint_as_float(r[0]) + __uint_as_float(r[1]);
    r = __builtin_amdgcn_permlane32_swap(__float_as_uint(y), __float_as_uint(y), false, false);
    return __uint_as_float(r[0]) + __uint_as_float(r[1]);
}
template <bool MASKED>
DI void attn32(const bf16_t* Q, int ldq, const bf16_t* K, int ldk, const bf16_t* Vt, int ldv, int nkb, const LAS3 unsigned* mask, int fr, int fq,
               f32x4 (&o)[4][2], float (&linv)[2]) {
    bf16x8 qf[2][2];
#pragma unroll
    for (int qt = 0; qt < 2; ++qt)
#pragma unroll
        for (int ks = 0; ks < 2; ++ks) qf[qt][ks] = *(const bf16x8*)(Q + (size_t)(16 * qt + fr) * ldq + ks * 32 + fq * 8);
    float l[2] = {0.f, 0.f}; bool mset[2] = {false, false};
    const f32x4 zero = {0.f, 0.f, 0.f, 0.f};
    f32x4 cneg[2] = {zero, zero};
#pragma unroll
    for (int dt = 0; dt < 4; ++dt) { o[dt][0] = zero; o[dt][1] = zero; }
    const bf16_t* kl = K + (size_t)fr * ldk + fq * 8;
#ifdef BROKEN_VT
    const bf16_t* vl = Vt + fr * 32 + 8 * ((fq + 1) & 3);
#else
    const bf16_t* vl = Vt + fr * 32 + 8 * fq;
#endif
    bf16x8 kfA[2][2], kfB[2][2], vA[4], vB[4];
#define ATT_LOAD(KF, VF, kb_) do { \
        _Pragma("unroll") for (int i2 = 0; i2 < 2; ++i2) _Pragma("unroll") for (int ks = 0; ks < 2; ++ks) KF[i2][ks] = *(const bf16x8*)(kl + (size_t)(32 * (kb_) + 16 * i2) * ldk + ks * 32); \
        _Pragma("unroll") for (int dt = 0; dt < 4; ++dt) VF[dt] = *(const bf16x8*)(vl + (size_t)(kb_) * ldv + 512 * dt); } while (0)
#define ATT_COMPUTE(KF, VF, kb_) do {   \
        f32x4 s0[2], s1[2], p0[2], p1[2]; float mx[2]; bool need[2]; \
        _Pragma("unroll") for (int qt = 0; qt < 2; ++qt) { \
            s0[qt] = mfma16(KF[0][0], qf[qt][0], cneg[qt]); s0[qt] = mfma16(KF[0][1], qf[qt][1], s0[qt]); \
            s1[qt] = mfma16(KF[1][0], qf[qt][0], cneg[qt]); s1[qt] = mfma16(KF[1][1], qf[qt][1], s1[qt]); } \
        _Pragma("unroll") for (int qt = 0; qt < 2; ++qt) { \
            if (MASKED) { const unsigned mw = mask[(16 * qt + fr) * 65 + (kb_)]; const int b0 = (int)(mw >> (2 * fq)), b1 = (int)(mw >> (8 + 2 * fq)); \
                _Pragma("unroll") for (int r = 0; r < 4; ++r) { const int sh_ = (r >> 1) + 16 * (r & 1); s0[qt][r] = mask_sel(__builtin_amdgcn_sbfe(b0, sh_, 1), s0[qt][r]); s1[qt][r] = mask_sel(__builtin_amdgcn_sbfe(b1, sh_, 1), s1[qt][r]); } } \
            float t;   \
            if (MASKED) t = fmax3(fmax3(s0[qt][0], s0[qt][1], s0[qt][2]), fmax3(s0[qt][3], s1[qt][0], s1[qt][1]), fmax3(s1[qt][2], s1[qt][3], NEG_INF)); \
            else t = fmax3(fmax3(__builtin_amdgcn_fmed3f(s0[qt][0], s0[qt][1], -NEG_INF), __builtin_amdgcn_fmed3f(s0[qt][2], s0[qt][3], -NEG_INF), __builtin_amdgcn_fmed3f(s1[qt][0], s1[qt][1], -NEG_INF)), __builtin_amdgcn_fmed3f(s1[qt][2], s1[qt][3], -NEG_INF), NEG_INF); \
            mx[qt] = rowmax4(t); \
            need[qt] = (mx[qt] > 8.f) | (!mset[qt] & (mx[qt] > NEG_INF)); } \
        if (__any(need[0] | need[1])) { \
            _Pragma("unroll") for (int qt = 0; qt < 2; ++qt) { \
                const float delta = need[qt] ? mx[qt] : 0.f, alpha = __builtin_amdgcn_exp2f(-delta); \
                _Pragma("unroll") for (int r = 0; r < 4; ++r) { p0[qt][r] = __builtin_amdgcn_exp2f(s0[qt][r] - delta); p1[qt][r] = __builtin_amdgcn_exp2f(s1[qt][r] - delta); } \
                l[qt] = l[qt] * alpha + (((p0[qt][0] + p0[qt][1]) + (p0[qt][2] + p0[qt][3])) + ((p1[qt][0] + p1[qt][1]) + (p1[qt][2] + p1[qt][3]))); \
                _Pragma("unroll") for (int dt = 0; dt < 4; ++dt) o[dt][qt] = o[dt][qt] * alpha; \
                cneg[qt] = cneg[qt] - delta; mset[qt] = mset[qt] | need[qt]; } \
        } else { \
            _Pragma("unroll") for (int qt = 0; qt < 2; ++qt) { \
                _Pragma("unroll") for (int r = 0; r < 4; ++r) { p0[qt][r] = __builtin_amdgcn_exp2f(s0[qt][r]); p1[qt][r] = __builtin_amdgcn_exp2f(s1[qt][r]); } \
                l[qt] += ((p0[qt][0] + p0[qt][1]) + (p0[qt][2] + p0[qt][3])) + ((p1[qt][0] + p1[qt][1]) + (p1[qt][2] + p1[qt][3])); } \
        } \
        _Pragma("unroll") for (int qt = 0; qt < 2; ++qt) { \
            u32x4 pw; pw.x = cvtpk(p0[qt][0], p0[qt][1]); pw.y = cvtpk(p0[qt][2], p0[qt][3]); pw.z = cvtpk(p1[qt][0], p1[qt][1]); pw.w = cvtpk(p1[qt][2], p1[qt][3]); \
            const bf16x8 pf = __builtin_bit_cast(bf16x8, pw); \
            _Pragma("unroll") for (int dt = 0; dt < 4; ++dt) o[dt][qt] = mfma16(VF[dt], pf, o[dt][qt]); } } while (0)
    ATT_LOAD(kfA, vA, 0);
    const int last = nkb - 1;
    for (int kb = 0; kb < nkb; kb += 2) {
        ATT_LOAD(kfB, vB, kb + 1);
        ATT_COMPUTE(kfA, vA, kb);
        { const int k2 = kb + 2 < last ? kb + 2 : last; ATT_LOAD(kfA, vA, k2); }
        ATT_COMPUTE(kfB, vB, kb + 1);
    }
#undef ATT_LOAD
#undef ATT_COMPUTE
#pragma unroll
    for (int qt = 0; qt < 2; ++qt) linv[qt] = 1.f / rowsum4(l[qt]);
}
DI void attn64s(const LAS3 bf16x8* QL  , const bf16_t* K, int ldk, const bf16_t* Vt, int ldv, int kb0, int nk, int nkbv,
                const LAS3 unsigned* mask, int fr, int fq, f32x4 (&o)[4][4], float (&l)[4], float (&mref)[4]) {
    bool mset[4] = {false, false, false, false};
    const f32x4 zero = {0.f, 0.f, 0.f, 0.f};
    float cneg[4] = {0.f, 0.f, 0.f, 0.f};
#pragma unroll
    for (int qt = 0; qt < 4; ++qt) { l[qt] = 0.f;
#pragma unroll
        for (int dt = 0; dt < 4; ++dt) o[dt][qt] = zero; }
    const bf16_t* kl = K + (size_t)fr * ldk + fq * 8;
    const bf16_t* vl = Vt + fr * 32 + 8 * fq;
    bf16x8 kfA[2][2], vA[4];
#define ATT_LOADK(KF, kb_) do { const int kc_ = (kb_) < 63 ? (kb_) : 63; \
        _Pragma("unroll") for (int i2 = 0; i2 < 2; ++i2) _Pragma("unroll") for (int ks = 0; ks < 2; ++ks) KF[i2][ks] = *(const bf16x8*)(kl + (size_t)(32 * kc_ + 16 * i2) * ldk + ks * 32); } while (0)
#define ATT_LOADV(VF, kb_) do { const int kc_ = (kb_) < 63 ? (kb_) : 63; \
        _Pragma("unroll") for (int dt = 0; dt < 4; ++dt) VF[dt] = *(const bf16x8*)(vl + (size_t)kc_ * ldv + 512 * dt); } while (0)
#define ATT_PAIR(KF, VF, kb_, Q0, AFTER_QK) do {   \
        f32x4 s0[2], s1[2], p0[2], p1[2]; float mx[2]; bool need[2]; \
        unsigned qlo_ = (unsigned)(uintptr_t)QL; asm volatile("" : "+v"(qlo_)); const LAS3 bf16x8* ql_ = (const LAS3 bf16x8*)(uintptr_t)qlo_;     \
        _Pragma("unroll") for (int qq = 0; qq < 2; ++qq) { const bf16x8 qa = ql_[((Q0 + qq) * 2) * 64], qb = ql_[((Q0 + qq) * 2 + 1) * 64];     \
            const f32x4 cq = {cneg[Q0 + qq], cneg[Q0 + qq], cneg[Q0 + qq], cneg[Q0 + qq]}; \
            s0[qq] = mfma16(KF[0][0], qa, cq); s0[qq] = mfma16(KF[0][1], qb, s0[qq]); \
            s1[qq] = mfma16(KF[1][0], qa, cq); s1[qq] = mfma16(KF[1][1], qb, s1[qq]); } \
        AFTER_QK; \
        _Pragma("unroll") for (int qq = 0; qq < 2; ++qq) { \
            unsigned mw = mask[(16 * (Q0 + qq) + fr) * 65 + ((kb_) < 63 ? (kb_) : 63)]; mw = (kb_) < nkbv ? mw : 0u; const int b0 = (int)(mw >> (2 * fq)), b1 = (int)(mw >> (8 + 2 * fq)); \
            _Pragma("unroll") for (int r = 0; r < 4; ++r) { const int sh_ = (r >> 1) + 16 * (r & 1); s0[qq][r] = mask_sel(__builtin_amdgcn_sbfe(b0, sh_, 1), s0[qq][r]); s1[qq][r] = mask_sel(__builtin_amdgcn_sbfe(b1, sh_, 1), s1[qq][r]); } \
              \
            mx[qq] = rowmax4(fmax3(fmax3(s0[qq][0], s0[qq][1], s0[qq][2]), fmax3(s0[qq][3], s1[qq][0], s1[qq][1]), fmax3(s1[qq][2], s1[qq][3], NEG_INF))); \
            need[qq] = (mx[qq] > 8.f) | (!mset[Q0 + qq] & (mx[qq] > NEG_INF)); } \
        if (__any(need[0] | need[1])) { \
            _Pragma("unroll") for (int qq = 0; qq < 2; ++qq) { \
                const float delta = need[qq] ? mx[qq] : 0.f, alpha = __builtin_amdgcn_exp2f(-delta); \
                _Pragma("unroll") for (int r = 0; r < 4; ++r) { p0[qq][r] = __builtin_amdgcn_exp2f(s0[qq][r] - delta); p1[qq][r] = __builtin_amdgcn_exp2f(s1[qq][r] - delta); } \
                l[Q0 + qq] = l[Q0 + qq] * alpha + (((p0[qq][0] + p0[qq][1]) + (p0[qq][2] + p0[qq][3])) + ((p1[qq][0] + p1[qq][1]) + (p1[qq][2] + p1[qq][3]))); \
                _Pragma("unroll") for (int dt = 0; dt < 4; ++dt) o[dt][Q0 + qq] = o[dt][Q0 + qq] * alpha; \
                cneg[Q0 + qq] = cneg[Q0 + qq] - delta; mset[Q0 + qq] = mset[Q0 + qq] | need[qq]; } \
        } else { \
            _Pragma("unroll") for (int qq = 0; qq < 2; ++qq) { \
                _Pragma("unroll") for (int r = 0; r < 4; ++r) { p0[qq][r] = __builtin_amdgcn_exp2f(s0[qq][r]); p1[qq][r] = __builtin_amdgcn_exp2f(s1[qq][r]); } \
                l[Q0 + qq] += ((p0[qq][0] + p0[qq][1]) + (p0[qq][2] + p0[qq][3])) + ((p1[qq][0] + p1[qq][1]) + (p1[qq][2] + p1[qq][3])); } \
        } \
        _Pragma("unroll") for (int qq = 0; qq < 2; ++qq) { \
            u32x4 pw; pw.x = cvtpk(p0[qq][0], p0[qq][1]); pw.y = cvtpk(p0[qq][2], p0[qq][3]); pw.z = cvtpk(p1[qq][0], p1[qq][1]); pw.w = cvtpk(p1[qq][2], p1[qq][3]); \
            const bf16x8 pf = __builtin_bit_cast(bf16x8, pw); \
            _Pragma("unroll") for (int dt = 0; dt < 4; ++dt) o[dt][Q0 + qq] = mfma16(VF[dt], pf, o[dt][Q0 + qq]); } } while (0)
    ATT_LOADK(kfA, kb0); ATT_LOADV(vA, kb0);
#define SBAR() __builtin_amdgcn_sched_barrier(0)
#pragma unroll 1
    for (int i = 0; i < nk; ++i) {
        const int ka = kb0 + 2 * i;
        ATT_PAIR(kfA, vA, ka, 0, SBAR()); SBAR();
        ATT_PAIR(kfA, vA, ka, 2, do { SBAR(); ATT_LOADK(kfA, ka + 2); SBAR(); } while (0)); SBAR();
        ATT_LOADV(vA, ka + 2); SBAR();
    }
#undef SBAR
#undef ATT_LOADK
#undef ATT_LOADV
#undef ATT_PAIR
#pragma unroll
    for (int qt = 0; qt < 4; ++qt) { l[qt] = rowsum4(l[qt]); mref[qt] = mset[qt] ? -cneg[qt] : NEG_INF; }
}
DI void attn_store(const f32x4 (&o)[4][2], const float (&linv)[2], const bf16_t* gate  , bf16_t* mix  , int fr, int fq) {
#pragma unroll
    for (int qt = 0; qt < 2; ++qt)
#pragma unroll
        for (int dt = 0; dt < 4; ++dt) {
            const size_t row = 16 * qt + fr; const int col = 16 * dt + 4 * fq;
            const u32x2 gw = *(const u32x2*)(gate + row * 256 + col);
            f32x4 v = o[dt][qt] * linv[qt];
            v[0] *= __uint_as_float(gw.x << 16); v[1] *= __uint_as_float(gw.x & 0xffff0000u); v[2] *= __uint_as_float(gw.y << 16); v[3] *= __uint_as_float(gw.y & 0xffff0000u);
            st_bf16x4(mix + row * 1024 + col, v);
        }
}

constexpr int DS_MASK = 0, DS_PKT = 16640, PKT_LD = 2052, DS_CNT = 147968;
typedef unsigned short u16x2 __attribute__((ext_vector_type(2)));
DI unsigned pk_cnt_ge(unsigned acc, unsigned kpair, unsigned cm1, unsigned ones) {
    unsigned t;
    asm("v_pk_sub_u16 %1, %2, %3 clamp\n\tv_pk_min_u16 %1, %1, %4\n\tv_pk_add_u16 %0, %0, %1" : "+v"(acc), "=&v"(t) : "v"(kpair), "v"(cm1), "v"(ones));
    return acc;
}
DI void select_bitwise(const unsigned (&key)[16][4], int lbase, LAS3 unsigned* CNT, int& it, int fr, int lane, unsigned& T, int& Xrel) {
    bool fin = false;
    T = 0u; Xrel = 0x7fffffff;
    for (int bit = 31; bit >= 0; --bit) {
        const unsigned cand = T | (1u << bit);
        unsigned c = 0;
#pragma unroll
        for (int n = 0; n < 16; ++n)
#pragma unroll
            for (int r = 0; r < 4; ++r) cnt_ge(c, key[n][r], cand);
        const unsigned tot = grp_count16(c, CNT, it, fr, lane);
        if (!fin && tot >= 256u) { T = cand; fin = (tot == 256u); }
        if (__all(fin)) break;
    }
    if (!__all(fin)) {
        unsigned c = 0;
#pragma unroll
        for (int n = 0; n < 16; ++n)
#pragma unroll
            for (int r = 0; r < 4; ++r) cnt_gt(c, key[n][r], T);
        const unsigned cgt = grp_count16(c, CNT, it, fr, lane);
        const unsigned need = 256u - cgt;
        unsigned Xl = 0u;
        for (int bit = 10; bit >= 0; --bit) {
            const unsigned cand = Xl | (1u << bit);
            const int crel = (int)cand - lbase;
            c = 0;
#pragma unroll
            for (int n = 0; n < 16; ++n) { const int crn = crel - 128 * n;
#pragma unroll
                for (int r = 0; r < 4; ++r) c += (key[n][r] == T && r < crn) ? 1u : 0u; }
            const unsigned tot = grp_count16(c, CNT, it, fr, lane);
            if (tot < need) Xl = cand;
        }
        if (!fin) Xrel = (int)Xl - lbase;
    }
}
DI unsigned pk_flag_ge(unsigned kpair, unsigned cm1, unsigned ones) {
    unsigned t;
    asm("v_pk_sub_u16 %0, %1, %2 clamp\n\tv_pk_min_u16 %0, %0, %3" : "=&v"(t) : "v"(kpair), "v"(cm1), "v"(ones));
    return t;
}
DI unsigned pk_max(unsigned a, unsigned b2) { unsigned t; asm("v_pk_max_u16 %0, %1, %2" : "=v"(t) : "v"(a), "v"(b2)); return t; }
DI unsigned hsum32(unsigned x) {
    x += __builtin_amdgcn_update_dpp(0u, x, 0xB1, 0xF, 0xF, false); x += __builtin_amdgcn_update_dpp(0u, x, 0x4E, 0xF, 0xF, false);
    x += __builtin_amdgcn_update_dpp(0u, x, 0x141, 0xF, 0xF, false); x += __builtin_amdgcn_update_dpp(0u, x, 0x140, 0xF, 0xF, false);
    const auto r = __builtin_amdgcn_permlane16_swap(x, x, false, false); return r[0] + r[1];
}
DI unsigned hmax32(unsigned x) {
    x = max(x, (unsigned)__builtin_amdgcn_update_dpp(0u, x, 0xB1, 0xF, 0xF, false)); x = max(x, (unsigned)__builtin_amdgcn_update_dpp(0u, x, 0x4E, 0xF, 0xF, false));
    x = max(x, (unsigned)__builtin_amdgcn_update_dpp(0u, x, 0x141, 0xF, 0xF, false)); x = max(x, (unsigned)__builtin_amdgcn_update_dpp(0u, x, 0x140, 0xF, 0xF, false));
    const auto r = __builtin_amdgcn_permlane16_swap(x, x, false, false); return max(r[0], r[1]);
}
DI unsigned pk_count32(const unsigned (&rk)[32], unsigned cm1, unsigned ones, int nq) {
    unsigned a0 = 0u, a1 = 0u;
#pragma unroll
    for (int k = 0; k < 8; k += 2) { a0 = pk_cnt_ge(a0, rk[k], cm1, ones); a1 = pk_cnt_ge(a1, rk[k + 1], cm1, ones); }
    if (nq > 1) {
#pragma unroll
        for (int k = 8; k < 16; k += 2) { a0 = pk_cnt_ge(a0, rk[k], cm1, ones); a1 = pk_cnt_ge(a1, rk[k + 1], cm1, ones); }
        if (nq > 2) {
#pragma unroll
            for (int k = 16; k < 24; k += 2) { a0 = pk_cnt_ge(a0, rk[k], cm1, ones); a1 = pk_cnt_ge(a1, rk[k + 1], cm1, ones); }
            if (nq > 3) {
#pragma unroll
                for (int k = 24; k < 32; k += 2) { a0 = pk_cnt_ge(a0, rk[k], cm1, ones); a1 = pk_cnt_ge(a1, rk[k + 1], cm1, ones); }
            }
        }
    }
    return (a0 & 0xffffu) + (a0 >> 16) + (a1 & 0xffffu) + (a1 >> 16);
}
DI void dsa_unit(const Params& p, LAS3 unsigned char* lds, int b, int j TARGS) {
    int tid = threadIdx.x; asm volatile("" : "+v"(tid));
    const int lane0 = tid & 63, w = __builtin_amdgcn_readfirstlane(tid >> 6);
    unsigned char* ws = p.ws;
    LAS3 unsigned* MASK = (LAS3 unsigned*)(lds + DS_MASK);
    LAS3 unsigned* PKT = (LAS3 unsigned*)(lds + DS_PKT);
    const bf16_t* IQ = (const bf16_t*)(ws + W_IQ); const bf16_t* IK = (const bf16_t*)(ws + W_IK); const float* IW = (const float*)(ws + W_IW);
    const int q0 = 64 * j;
    const f32x4 zero = {0.f, 0.f, 0.f, 0.f};
#ifdef CHECK_SEL
    LAS3 unsigned* CNT = (LAS3 unsigned*)(lds + DS_CNT); int it = 0;
    if (tid < 48) CNT[tid] = 0u;
    __syncthreads();
#endif
    TBEG(30);
    bf16x8 bqn[4][2]; f32x4 wqn;
    { const size_t qr0 = (size_t)b * SEQ + q0 + (lane0 & 15);
#pragma unroll
      for (int h = 0; h < 4; ++h)
#pragma unroll
          for (int ks = 0; ks < 2; ++ks) bqn[h][ks] = *(const bf16x8*)(IQ + qr0 * 256 + h * 64 + ks * 32 + (lane0 >> 4) * 8);
      wqn = *(const f32x4*)(IW + qr0 * 4); }
#pragma unroll 1
    for (int qg = 0; qg < 4; ++qg) {
        TBEG(32);
        int lane = lane0; asm volatile("" : "+v"(lane));
        const int fr = lane & 15, fq = lane >> 4;
        const int tq = q0 + 16 * qg + fr; const size_t qrow = (size_t)b * SEQ + tq;
        const int ntile = 4 * j + qg + 1;
        const int nloc = ntile > w ? (ntile - w + 7) >> 3 : 0;
        const bool selecting = q0 + 16 * qg >= 256;
        {
            bf16x8 bq[4][2];
#pragma unroll
            for (int h = 0; h < 4; ++h)
#pragma unroll
                for (int ks = 0; ks < 2; ++ks) bq[h][ks] = bqn[h][ks];
            const f32x4 wq = wqn;
            float Lh[4];
#pragma unroll
            for (int h = 0; h < 4; ++h) Lh[h] = wq[h] < 0.f ? NEG_INF : -NEG_INF;
            const char* tb = (const char*)IK + ((size_t)b * SEQ + 16 * w) * 128 + (unsigned)(fr * 128 + fq * 16);
            LAS3 unsigned* krow = PKT + fr * PKT_LD + 16 * w + 4 * fq;
            const int lim0 = tq - (16 * w + 4 * fq);
#define DSA_TILE(A0, A1, nn) do { \
                f32x4 sc = zero; \
                _Pragma("unroll") for (int h = 0; h < 4; ++h) { f32x4 d = mfma16(A0, bq[h][0], zero); d = mfma16(A1, bq[h][1], d); d = d * wq[h]; \
                    _Pragma("unroll") for (int r = 0; r < 4; ++r) sc[r] += __builtin_amdgcn_fmed3f(d[r], 0.f, Lh[h]); } \
                { const char* t2_ = tb + (size_t)((nn) + 2 < nloc ? (nn) + 2 : nloc - 1) * 16384; A0 = *(const bf16x8*)t2_; A1 = *(const bf16x8*)(t2_ + 64); } \
                const int limn = lim0 - 128 * (nn);                   \
                u32x4 kv; \
                _Pragma("unroll") for (int r = 0; r < 4; ++r) { const unsigned u = __float_as_uint(sc[r] + 0.f); const unsigned k = u ^ ((unsigned)((int)u >> 31) | 0x80000000u);   \
                    kv[r] = (r <= limn) ? k : 0u; } \
                *(LAS3 u32x4*)(krow + 128 * (nn)) = kv; } while (0)
            if (nloc > 0) {
                bf16x8 a0 = *(const bf16x8*)tb, a1 = *(const bf16x8*)(tb + 64);
                const char* t1 = tb + (size_t)(1 < nloc ? 1 : 0) * 16384;
                bf16x8 b0 = *(const bf16x8*)t1, b1 = *(const bf16x8*)(t1 + 64);
#pragma unroll 1
                for (int n = 0; n < nloc; n += 2) {
                    DSA_TILE(a0, a1, n);
                    if (n + 1 < nloc) DSA_TILE(b0, b1, n + 1);
                }
            }
#undef DSA_TILE
        }
        TEND(32); TBEG(33);
        __syncthreads();
        { const size_t qrn = qrow + (qg < 3 ? 16 : 0);
#pragma unroll
          for (int h = 0; h < 4; ++h)
#pragma unroll
              for (int ks = 0; ks < 2; ++ks) bqn[h][ks] = *(const bf16x8*)(IQ + qrn * 256 + h * 64 + ks * 32 + fq * 8);
          wqn = *(const f32x4*)(IW + qrn * 4); }
        {
            const int hh = lane >> 5, pos = lane & 31, oq = 2 * w + hh;
            const unsigned nkeys = 16u * (unsigned)ntile;
            const int nq = (int)((nkeys + 511u) >> 9);
            const LAS3 unsigned* orow = PKT + oq * PKT_LD + 2 * pos;
            unsigned ones = 0x00010001u; asm volatile("" : "+v"(ones));
            unsigned Tfull = 1u, X = 0xffffffffu;
            if (selecting) {
                unsigned rk[32];
                unsigned mx = 0u;
#define RK_FILL(k0) do { _Pragma("unroll") for (int k = (k0); k < (k0) + 8; ++k) { const u32x2 kk = *(const LAS3 u32x2*)(orow + 64 * k); \
                        rk[k] = (2u * (unsigned)(pos + 32 * k) < nkeys) ? __builtin_amdgcn_perm(kk.y, kk.x, 0x07060302u) : 0u; mx = pk_max(mx, rk[k]); } } while (0)
                RK_FILL(0);
                if (nq > 1) { RK_FILL(8); if (nq > 2) { RK_FILL(16); if (nq > 3) { RK_FILL(24); } } }
#undef RK_FILL
                const unsigned kmax = hmax32(max(mx & 0xffffu, mx >> 16));
                unsigned T16 = 0u, cabove = 0u; bool exact = false;
                {
                    unsigned ub = 0x10000u;
#pragma unroll 1
                    for (int bit = 15; bit >= 0; --bit) {
                        const unsigned cand = T16 | (1u << bit);
                        if (__all(cand > kmax)) { ub = cand; continue; }
                        const unsigned tot = hsum32(pk_count32(rk, (cand - 1u) * 0x00010001u, ones, nq));
                        if (tot >= 256u) T16 = cand; else { ub = cand; cabove = tot; }
                    }
                    (void)ub;
                }
                const unsigned need = 256u - cabove;
#define RK_LOW(k0) do { _Pragma("unroll") for (int k = (k0); k < (k0) + 8; ++k) { const u32x2 kk = *(const LAS3 u32x2*)(orow + 64 * k); const bool in = 2u * (unsigned)(pos + 32 * k) < nkeys; \
                        const unsigned lo0 = (in && (kk.x >> 16) == T16) ? (kk.x & 0xffffu) : 0u, lo1 = (in && (kk.y >> 16) == T16) ? (kk.y & 0xffffu) : 0u; rk[k] = lo0 | (lo1 << 16); } } while (0)
                RK_LOW(0);
                if (nq > 1) { RK_LOW(8); if (nq > 2) { RK_LOW(16); if (nq > 3) { RK_LOW(24); } } }
#undef RK_LOW
                unsigned Tlo = 0u;
#pragma unroll 1
                for (int bit = 15; bit >= 0; --bit) {
                    const unsigned cand = Tlo | (1u << bit);
                    const unsigned tot = hsum32(pk_count32(rk, (cand - 1u) * 0x00010001u, ones, nq));
                    if (!exact && tot >= need) { Tlo = cand; exact = (tot == need); }
                    if (__all(exact)) break;
                }
                Tfull = (T16 << 16) | Tlo;
                if (!__all(exact)) {
                    unsigned cgt = 0u, ceq = 0u;
#pragma unroll 1
                    for (int k = 0; k < 8 * nq; ++k) { const u32x2 kk = *(const LAS3 u32x2*)(orow + 64 * k); const bool in = 2u * (unsigned)(pos + 32 * k) < nkeys;
                        cgt += (in && kk.x > Tfull && (kk.x >> 16) == T16 ? 1u : 0u) + (in && kk.y > Tfull && (kk.y >> 16) == T16 ? 1u : 0u); }
                    (void)ceq;
                    const unsigned needt = need - hsum32(cgt);
                    unsigned Xl = 0u;
#pragma unroll 1
                    for (int bit = 10; bit >= 0; --bit) {
                        const unsigned cx = Xl | (1u << bit);
                        unsigned c = 0u;
#pragma unroll 1
                        for (int k = 0; k < 8 * nq; ++k) { const u32x2 kk = *(const LAS3 u32x2*)(orow + 64 * k); const unsigned i0 = 2u * (unsigned)(pos + 32 * k);
                            c += (i0 < nkeys && kk.x == Tfull && i0 < cx ? 1u : 0u) + (i0 < nkeys && kk.y == Tfull && i0 + 1u < cx ? 1u : 0u); }
                        if (hsum32(c) < needt) Xl = cx;
                    }
                    if (!exact) X = Xl;
                }
            }
            LAS3 unsigned* mrow = MASK + (16 * qg + oq) * 65 + (pos >> 4);
            const unsigned sh = 32u * hh + (pos & 16);
            if (__all(X == 0xffffffffu)) {
                int k = 0;
#pragma unroll 1
                for (; k + 4 <= j; k += 4) {
                    u32x2 kk[4];
#pragma unroll
                    for (int u = 0; u < 4; ++u) kk[u] = *(const LAS3 u32x2*)(orow + 64 * (k + u));
                    unsigned wv[4];
#pragma unroll
                    for (int u = 0; u < 4; ++u) { const unsigned long long blo = __ballot(kk[u].x >= Tfull), bhi = __ballot(kk[u].y >= Tfull);
                        wv[u] = ((unsigned)(blo >> sh) & 0xffffu) | ((unsigned)(bhi >> sh) << 16); }
                    if ((pos & 15) == 0) {
#pragma unroll
                        for (int u = 0; u < 4; ++u) mrow[2 * (k + u)] = wv[u]; }
                }
#pragma unroll 1
                for (; k < j; ++k) {
                    const u32x2 kk = *(const LAS3 u32x2*)(orow + 64 * k);
                    const unsigned long long blo = __ballot(kk.x >= Tfull), bhi = __ballot(kk.y >= Tfull);
                    const unsigned wv = ((unsigned)(blo >> sh) & 0xffffu) | ((unsigned)(bhi >> sh) << 16);
                    if ((pos & 15) == 0) mrow[2 * k] = wv;
                }
                {
                    const u32x2 kk = *(const LAS3 u32x2*)(orow + 64 * j); const bool in = 2u * (unsigned)(pos + 32 * j) < nkeys;
                    const unsigned long long blo = __ballot(in && kk.x >= Tfull), bhi = __ballot(in && kk.y >= Tfull);
                    const unsigned wv = ((unsigned)(blo >> sh) & 0xffffu) | ((unsigned)(bhi >> sh) << 16);
                    if ((pos & 15) == 0) mrow[2 * j] = wv;
                }
            } else {
#pragma unroll 1
                for (int k = 0; k <= j; ++k) {
                    const u32x2 kk = *(const LAS3 u32x2*)(orow + 64 * k); const unsigned i0 = 2u * (unsigned)(pos + 32 * k);
                    const bool s0 = i0 < nkeys && (kk.x > Tfull || (kk.x == Tfull && i0 <= X)), s1 = i0 < nkeys && (kk.y > Tfull || (kk.y == Tfull && i0 + 1u <= X));
                    const unsigned long long blo = __ballot(s0), bhi = __ballot(s1);
                    const unsigned wv = ((unsigned)(blo >> sh) & 0xffffu) | ((unsigned)(bhi >> sh) << 16);
                    if ((pos & 15) == 0) mrow[2 * k] = wv;
                }
            }
        }
        TEND(33);
        __syncthreads();
#ifdef CHECK_SEL
        if (selecting) {
            const int lbase = 16 * w + 4 * fq;
            unsigned key[16][4];
#pragma unroll
            for (int n = 0; n < 16; ++n)
#pragma unroll
                for (int r = 0; r < 4; ++r) key[n][r] = (n < nloc) ? PKT[fr * PKT_LD + lbase + 128 * n + r] : 0u;
            unsigned T2; int X2; select_bitwise(key, lbase, CNT, it, fr, lane, T2, X2);
            bool bad = false;
#pragma unroll
            for (int n = 0; n < 16; ++n) if (n < nloc) { const int x2 = X2 - 128 * n;
#pragma unroll
                for (int r = 0; r < 4; ++r) { const unsigned idx = (unsigned)(lbase + 128 * n + r); const unsigned mw = MASK[(16 * qg + fr) * 65 + (idx >> 5)];
                    const bool s2 = key[n][r] > T2 || (key[n][r] == T2 && r <= x2); bad |= (s2 != (((mw >> (((idx & 31u) >> 1) + 16u * (idx & 1u))) & 1u) != 0u)); } }
            if (__any(bad) && lane == 0) atomicAdd((unsigned*)(ws + CW_CHK), 1u);
            if (lane == 0 && w == 0) atomicAdd((unsigned*)(ws + CW_CHK + 4), 1u);
            __syncthreads();
        }
#endif
    }
    TEND(30); TBEG(31);
    {
        const int h = w & 3, hf = w >> 2, fr = lane0 & 15, fq = lane0 >> 4;
        const size_t qrow0 = (size_t)b * SEQ + q0;
        LAS3 bf16x8* QLb = (LAS3 bf16x8*)(lds + DS_PKT + 81920);
#pragma unroll
        for (int qq = 0; qq < 2; ++qq)
#pragma unroll
            for (int ks = 0; ks < 2; ++ks)
                QLb[((h * 4 + 2 * hf + qq) * 2 + ks) * 64 + lane0] = *(const bf16x8*)((const bf16_t*)(ws + W_DQ) + (qrow0 + 16 * (2 * hf + qq) + fr) * 256 + h * 64 + ks * 32 + fq * 8);
        __syncthreads();
        f32x4 o[4][4]; float l[4], mref[4];
        attn64s(QLb + (h * 8) * 64 + lane0, (const bf16_t*)(ws + W_DK) + (size_t)b * SEQ * 256 + h * 64, 256,
                (const bf16_t*)(ws + W_DVT) + ((size_t)b * 64 * 4 + h) * 2048, 4 * 2048, hf, j + 1, 2 * j + 2, MASK, fr, fq, o, l, mref);
        LAS3 f32x4* XB = (LAS3 f32x4*)(lds + DS_PKT);
        LAS3 f32x4* mine = XB + (w * 10) * 64 + lane0; const LAS3 f32x4* theirs = XB + ((w ^ 4) * 10) * 64 + lane0;
#define SB_SEND(QS) do { _Pragma("unroll") for (int dt = 0; dt < 4; ++dt) { mine[(2 * dt) * 64] = o[dt][QS]; mine[(2 * dt + 1) * 64] = o[dt][QS + 1]; } \
            mine[8 * 64] = (f32x4){l[QS], l[QS + 1], mref[QS], mref[QS + 1]}; } while (0)
#define SB_FINISH(QK) do { const f32x4 lm = theirs[8 * 64]; \
            _Pragma("unroll") for (int qq = 0; qq < 2; ++qq) { \
                const float mo = mref[QK + qq], mt = lm[2 + qq], M = fmaxf(mo, mt);              \
                const float ao = __builtin_amdgcn_exp2f(mo - M), at = __builtin_amdgcn_exp2f(mt - M); \
                const float linv = 1.f / (l[QK + qq] * ao + lm[qq] * at); \
                const size_t row = 16 * (QK + qq) + fr; \
                _Pragma("unroll") for (int dt = 0; dt < 4; ++dt) { const int col = 16 * dt + 4 * fq; \
                    const u32x2 gw = *(const u32x2*)(gate + row * 256 + col); \
                    f32x4 v = (o[dt][QK + qq] * ao + theirs[(2 * dt + qq) * 64] * at) * linv; \
                    v[0] *= __uint_as_float(gw.x << 16); v[1] *= __uint_as_float(gw.x & 0xffff0000u); v[2] *= __uint_as_float(gw.y << 16); v[3] *= __uint_as_float(gw.y & 0xffff0000u); \
                    st_bf16x4(mix + row * 1024 + col, v); } } } while (0)
        const bf16_t* gate = (const bf16_t*)(ws + W_DG) + qrow0 * 256 + h * 64; bf16_t* mix = (bf16_t*)(ws + W_MIX) + qrow0 * 1024 + 512 + h * 64;
        if (hf == 0) SB_SEND(2); else SB_SEND(0);
        __syncthreads();
        if (hf == 0) SB_FINISH(0); else SB_FINISH(2);
#undef SB_SEND
#undef SB_FINISH
    }
    __syncthreads();
    TEND(31);
}
DI void mem_unit(const Params& p, int n) {
    const int tid = threadIdx.x, lane = tid & 63, w = __builtin_amdgcn_readfirstlane(tid >> 6), fr = lane & 15, fq = lane >> 4;
    unsigned char* ws = p.ws;
    const int h = w & 3, hf = w >> 2;
    const size_t qrow0 = (size_t)n * 64 + 32 * hf; const int b = n >> 5;
    f32x4 o[4][2]; float linv[2];
    attn32<false>((const bf16_t*)(ws + W_MQ) + qrow0 * 256 + h * 64, 256, (const bf16_t*)(ws + W_MK) + (size_t)b * NMEM * 256 + h * 64, 256,
                  (const bf16_t*)(ws + W_MVT) + ((size_t)b * 8 * 4 + h) * 2048, 4 * 2048, 8, nullptr, fr, fq, o, linv);
    attn_store(o, linv, (const bf16_t*)(ws + W_MG) + qrow0 * 256 + h * 64, (bf16_t*)(ws + W_MIX) + qrow0 * 1024 + 768 + h * 64, fr, fq);
}
constexpr int GL_QT = 0, GL_KT = 9216, GL_KPT = 18432, GL_VT = 27648, GL_SBT = 46080, GL_PM = 64512, GL_OF = 73728, GL_GTOT = 107520, GL_W2 = 109568, GL_BG = 113664, GL_DEC = 113920;
constexpr int LDP = 72;
DI void gla_unit(const Params& p, LAS3 unsigned char* lds, int b, int h) {
    const int tid = threadIdx.x, lane = tid & 63, w = __builtin_amdgcn_readfirstlane(tid >> 6), fr = lane & 15, fq = lane >> 4;
    unsigned char* ws = p.ws;
    LAS3 bf16_t* Qt = (LAS3 bf16_t*)(lds + GL_QT); LAS3 bf16_t* Kt = (LAS3 bf16_t*)(lds + GL_KT); LAS3 bf16_t* KpT = (LAS3 bf16_t*)(lds + GL_KPT);
    LAS3 bf16_t* Vt = (LAS3 bf16_t*)(lds + GL_VT); LAS3 bf16_t* SbT = (LAS3 bf16_t*)(lds + GL_SBT); LAS3 bf16_t* Pm = (LAS3 bf16_t*)(lds + GL_PM);
    LAS3 float* Of = (LAS3 float*)(lds + GL_OF); LAS3 float* gtot = (LAS3 float*)(lds + GL_GTOT); LAS3 float* w2s = (LAS3 float*)(lds + GL_W2);
    LAS3 float* bgs = (LAS3 float*)(lds + GL_BG); LAS3 float* dec = (LAS3 float*)(lds + GL_DEC);
    const bf16_t* GQ = (const bf16_t*)(ws + W_GQ); const bf16_t* GK = (const bf16_t*)(ws + W_GK); const bf16_t* GV = (const bf16_t*)(ws + W_GV);
    const bf16_t* GG = (const bf16_t*)(ws + W_GG); const float* GLR = (const float*)(ws + W_GLR); bf16_t* MIX = (bf16_t*)(ws + W_MIX);
    for (int i = tid; i < 128 * LDP / 2; i += NTHREADS) ((LAS3 unsigned*)SbT)[i] = 0u;
    for (int i = tid; i < 16 * 64; i += NTHREADS) w2s[i] = p.w_g2[(i >> 6) * 256 + h * 64 + (i & 63)];
    if (tid < 64) bgs[tid] = p.b_g[h * 64 + tid];
    __syncthreads();
    const int d = tid & 63, tg = w;
    float wreg[16];
#pragma unroll
    for (int r = 0; r < 16; ++r) wreg[r] = w2s[r * 64 + d];
    const float bgd = bgs[d];
    const f32x4 zero = {0.f, 0.f, 0.f, 0.f};
    f32x4 Sacc[4] = {zero, zero, zero, zero};
    const int tt = w & 3, vh = w >> 2;
    for (int c = 0; c < 32; ++c) {
        const size_t rb = (size_t)b * SEQ + c * 64;
        float g8[8];
#pragma unroll
        for (int i = 0; i < 8; ++i) {
            const float* gl = vaddr(GLR + (rb + tg * 8 + i) * 16);
            float u = bgd;
#pragma unroll
            for (int r = 0; r < 16; ++r) u += gl[r] * wreg[r];
            const float g = logsigf(u) * (1.f / 16.f);
            g8[i] = (i ? g8[i - 1] : 0.f) + g;
        }
        gtot[tg * 64 + d] = g8[7];
        __syncthreads();
        float off = 0.f, blast = 0.f;
#pragma unroll
        for (int g2 = 0; g2 < 8; ++g2) { const float v = gtot[g2 * 64 + d]; off += (g2 < tg) ? v : 0.f; blast += v; }
        float kp[8];
#pragma unroll
        for (int i = 0; i < 8; ++i) {
            const int t = tg * 8 + i; const float bt = off + g8[i];
            const float q = bf2f(GQ[(rb + t) * 256 + h * 64 + d]), k = bf2f(GK[(rb + t) * 256 + h * 64 + d]);
            Qt[t * LDP + d] = f2bf(q * fexp(bt)); Kt[t * LDP + d] = f2bf(k * fexp(-bt)); kp[i] = k * fexp(blast - bt);
        }
        { u32x4 kw; kw.x = cvtpk(kp[0], kp[1]); kw.y = cvtpk(kp[2], kp[3]); kw.z = cvtpk(kp[4], kp[5]); kw.w = cvtpk(kp[6], kp[7]); *(LAS3 u32x4*)(KpT + d * LDP + tg * 8) = kw; }
        if (tg == 0) dec[d] = fexp(blast);
        { const int v = tid & 127, sg = tid >> 7; bf16_t vv[16];
#pragma unroll
          for (int i = 0; i < 16; ++i) vv[i] = GV[(rb + sg * 16 + i) * 512 + h * 128 + v];
          u32x4 a, bb; a.x = vv[0] | ((unsigned)vv[1] << 16); a.y = vv[2] | ((unsigned)vv[3] << 16); a.z = vv[4] | ((unsigned)vv[5] << 16); a.w = vv[6] | ((unsigned)vv[7] << 16);
          bb.x = vv[8] | ((unsigned)vv[9] << 16); bb.y = vv[10] | ((unsigned)vv[11] << 16); bb.z = vv[12] | ((unsigned)vv[13] << 16); bb.w = vv[14] | ((unsigned)vv[15] << 16);
          *(LAS3 u32x4*)(Vt + v * LDP + sg * 16) = a; *(LAS3 u32x4*)(Vt + v * LDP + sg * 16 + 8) = bb; }
        __syncthreads();
#pragma unroll
        for (int s2 = 0; s2 < 2; ++s2) {
            const int st = 2 * vh + s2;
            f32x4 acc = zero;
#pragma unroll
            for (int ks = 0; ks < 2; ++ks) {
                const bf16x8 a = *(const LAS3 bf16x8*)(Kt + (st * 16 + fr) * LDP + ks * 32 + fq * 8), bq = *(const LAS3 bf16x8*)(Qt + (tt * 16 + fr) * LDP + ks * 32 + fq * 8);
                acc = mfma16(a, bq, acc);
            }
            const int t = tt * 16 + fr, s0 = st * 16 + 4 * fq;
            u32x2 pw; pw.x = cvtpk(s0 <= t ? acc[0] : 0.f, s0 + 1 <= t ? acc[1] : 0.f); pw.y = cvtpk(s0 + 2 <= t ? acc[2] : 0.f, s0 + 3 <= t ? acc[3] : 0.f);
            *(LAS3 u32x2*)(Pm + t * LDP + s0) = pw;
        }
        __syncthreads();
        f32x4 oacc[4];
        {
            bf16x8 aq[2], ap[2], ak[2];
#pragma unroll
            for (int ks = 0; ks < 2; ++ks) {
                aq[ks] = *(const LAS3 bf16x8*)(Qt + (tt * 16 + fr) * LDP + ks * 32 + fq * 8);
                ap[ks] = *(const LAS3 bf16x8*)(Pm + (tt * 16 + fr) * LDP + ks * 32 + fq * 8);
                ak[ks] = *(const LAS3 bf16x8*)(KpT + (tt * 16 + fr) * LDP + ks * 32 + fq * 8);
            }
            const f32x4 dv = *(const LAS3 f32x4*)(dec + tt * 16 + 4 * fq);
#pragma unroll
            for (int jv = 0; jv < 4; ++jv) {
                const int vt = vh * 4 + jv;
                bf16x8 bs[2], bv[2];
#pragma unroll
                for (int ks = 0; ks < 2; ++ks) {
                    bs[ks] = *(const LAS3 bf16x8*)(SbT + (vt * 16 + fr) * LDP + ks * 32 + fq * 8);
                    bv[ks] = *(const LAS3 bf16x8*)(Vt + (vt * 16 + fr) * LDP + ks * 32 + fq * 8);
                }
                f32x4 oa = mfma16(aq[0], bs[0], zero); oa = mfma16(aq[1], bs[1], oa); oa = mfma16(ap[0], bv[0], oa); oa = mfma16(ap[1], bv[1], oa);
                oacc[jv] = oa;
                f32x4 sa = Sacc[jv] * dv; sa = mfma16(ak[0], bv[0], sa); sa = mfma16(ak[1], bv[1], sa);
                Sacc[jv] = sa;
            }
        }
        __syncthreads();
#pragma unroll
        for (int jv = 0; jv < 4; ++jv) {
            const int vt = vh * 4 + jv;
#pragma unroll
            for (int r = 0; r < 4; ++r) Of[(tt * 16 + 4 * fq + r) * 132 + vt * 16 + fr] = oacc[jv][r];
            u32x2 sw; sw.x = cvtpk(Sacc[jv][0], Sacc[jv][1]); sw.y = cvtpk(Sacc[jv][2], Sacc[jv][3]);
            *(LAS3 u32x2*)(SbT + (vt * 16 + fr) * LDP + tt * 16 + 4 * fq) = sw;
        }
        __syncthreads();
        {
            const int t = tid >> 3, seg = tid & 7;
            const LAS3 float* op = Of + t * 132 + seg * 16;
            f32x4 ov[4]; float ss = 0.f;
#pragma unroll
            for (int i = 0; i < 4; ++i) { ov[i] = *(const LAS3 f32x4*)(op + 4 * i); ss += ov[i][0] * ov[i][0] + ov[i][1] * ov[i][1] + ov[i][2] * ov[i][2] + ov[i][3] * ov[i][3]; }
            ss += __shfl_xor(ss, 1); ss += __shfl_xor(ss, 2); ss += __shfl_xor(ss, 4);
            const float rstd = rsqrtf(ss * (1.f / 128.f) + 1e-6f);
            const bf16_t* gp = GG + (rb + t) * 512 + h * 128 + seg * 16;
            const u32x4 g0 = *(const u32x4*)gp, g1 = *(const u32x4*)(gp + 8);
            const unsigned gw[8] = {g0.x, g0.y, g0.z, g0.w, g1.x, g1.y, g1.z, g1.w};
            unsigned ow[8];
#pragma unroll
            for (int i = 0; i < 4; ++i) {
                const f32x4 on = *(const f32x4*)(p.onorm + seg * 16 + 4 * i);
                const float y0 = ov[i][0] * rstd * on[0] * __uint_as_float(gw[2 * i] << 16), y1 = ov[i][1] * rstd * on[1] * __uint_as_float(gw[2 * i] & 0xffff0000u);
                const float y2 = ov[i][2] * rstd * on[2] * __uint_as_float(gw[2 * i + 1] << 16), y3 = ov[i][3] * rstd * on[3] * __uint_as_float(gw[2 * i + 1] & 0xffff0000u);
                ow[2 * i] = cvtpk(y0, y1); ow[2 * i + 1] = cvtpk(y2, y3);
            }
            bf16_t* mp = MIX + (rb + t) * 1024 + h * 128 + seg * 16;
            *(u32x4*)mp = (u32x4){ow[0], ow[1], ow[2], ow[3]}; *(u32x4*)(mp + 8) = (u32x4){ow[4], ow[5], ow[6], ow[7]};
        }
    }
#pragma unroll
    for (int jv = 0; jv < 4; ++jv)
#pragma unroll
        for (int r = 0; r < 4; ++r) p.out[O_GSP + ((size_t)(b * 4 + h) * 64 + tt * 16 + 4 * fq + r) * 128 + (vh * 4 + jv) * 16 + fr] = Sacc[jv][r];
    __syncthreads();
}

DI void sscore_unit(const Params& p, LAS3 unsigned char* lds, int u) {
    const int tid = threadIdx.x;
    unsigned char* ws = p.ws;
    const int b = u >> 3, pg = u & 7;
    LAS3 float* qf = (LAS3 float*)lds;
    if (tid < 256) qf[tid] = bf2f(((const bf16_t*)(ws + W_IQ))[(size_t)(MP + b) * 256 + tid]);
    __syncthreads();
    const int seg = tid & 15;
    f32x4 q[4];
#pragma unroll
    for (int h = 0; h < 4; ++h) q[h] = *(const LAS3 f32x4*)(qf + h * 64 + seg * 4);
    const f32x4 wv = *(const f32x4*)vaddr((const float*)(ws + W_IW) + (size_t)(MP + b) * 4);
    unsigned* sc = (unsigned*)(ws + W_SC) + (size_t)b * SCLD;
    const int* pt = p.page_table + b * NPAGES + pg * 16;
#define SS_LOAD(BUF, pp) do { const float* base_ = p.cache_ik + (size_t)pt[(pp) < 16 ? (pp) : 15] * 8192; \
        _Pragma("unroll") for (int i = 0; i < 4; ++i) BUF[i] = *(const f32x4*)(base_ + (size_t)(tid + 512 * i) * 4); } while (0)
#define SS_COMPUTE(BUF, pp) do { \
        _Pragma("unroll") for (int i = 0; i < 4; ++i) { const f32x4 kv = BUF[i]; float dh[4]; \
            _Pragma("unroll") for (int h = 0; h < 4; ++h) { float x = q[h][0] * kv[0] + q[h][1] * kv[1] + q[h][2] * kv[2] + q[h][3] * kv[3]; \
                x += __shfl_xor(x, 1); x += __shfl_xor(x, 2); x += __shfl_xor(x, 4); x += __shfl_xor(x, 8); dh[h] = x; } \
            const float s_ = wv[0] * fmaxf(dh[0], 0.f) + wv[1] * fmaxf(dh[1], 0.f) + wv[2] * fmaxf(dh[2], 0.f) + wv[3] * fmaxf(dh[3], 0.f); \
            if (seg == 0) __hip_atomic_store(sc + (pg * 16 + (pp)) * 128 + ((tid + 512 * i) >> 4), __float_as_uint(s_), __ATOMIC_RELAXED, __HIP_MEMORY_SCOPE_AGENT); } } while (0)
    f32x4 pa[4], pb[4];
    SS_LOAD(pa, 0); SS_LOAD(pb, 1);
#pragma unroll 1
    for (int pp = 0; pp < 16; pp += 2) {
        SS_COMPUTE(pa, pp); SS_LOAD(pa, pp + 2);
        SS_COMPUTE(pb, pp + 1); SS_LOAD(pb, pp + 3);
    }
#undef SS_LOAD
#undef SS_COMPUTE
    asm volatile("s_waitcnt vmcnt(0)" ::: "memory");
    __syncthreads();
    if (tid == 0) __hip_atomic_fetch_add((unsigned*)(ws + CW_SCNT), 1u, __ATOMIC_RELAXED, __HIP_MEMORY_SCOPE_AGENT);
}

constexpr int SA_Q = 2048, SA_S = 3072, SA_KP = 8192, SA_VP = 10240;
DI void sattend(const Params& p, LAS3 unsigned char* lds, const bf16_t* qrow  , const bf16_t* gate, bf16_t* mix) {
    const int tid = threadIdx.x, lane = tid & 63, w = tid >> 6;
    LAS3 float* qf = (LAS3 float*)(lds + SA_Q); LAS3 float* S = (LAS3 float*)(lds + SA_S);
    const float* const LAS3* kptr = (const float* const LAS3*)(lds + SA_KP); const float* const LAS3* vptr = (const float* const LAS3*)(lds + SA_VP);
    if (tid < 256) qf[tid] = bf2f(qrow[tid]);
    __syncthreads();
    {
        const int jk = tid >> 1, hp = tid & 1;
        const float* kr = kptr[jk] + hp * 128;
        float s0 = 0.f, s1 = 0.f;
#pragma unroll 4
        for (int i = 0; i < 16; ++i) {
            const f32x4 k0 = *(const f32x4*)(kr + 4 * i), k1 = *(const f32x4*)(kr + 64 + 4 * i);
            const f32x4 q0 = *(const LAS3 f32x4*)(qf + hp * 128 + 4 * i), q1 = *(const LAS3 f32x4*)(qf + hp * 128 + 64 + 4 * i);
            s0 += q0[0] * k0[0] + q0[1] * k0[1] + q0[2] * k0[2] + q0[3] * k0[3];
            s1 += q1[0] * k1[0] + q1[1] * k1[1] + q1[2] * k1[2] + q1[3] * k1[3];
        }
        S[(2 * hp) * 256 + jk] = s0; S[(2 * hp + 1) * 256 + jk] = s1;
    }
    __syncthreads();
    if (w < 4) {
        float v[4], mx = NEG_INF;
#pragma unroll
        for (int i = 0; i < 4; ++i) { v[i] = S[w * 256 + lane + 64 * i]; mx = fmaxf(mx, v[i]); }
        mx = wmax64(mx);
        float sum = 0.f;
#pragma unroll
        for (int i = 0; i < 4; ++i) { v[i] = __expf(v[i] - mx); sum += v[i]; }
        sum = wsum64(sum);
        const float inv = 1.f / sum;
#pragma unroll
        for (int i = 0; i < 4; ++i) S[w * 256 + lane + 64 * i] = v[i] * inv;
    }
    __syncthreads();
    {
        const int h = tid >> 7, dd = (tid >> 1) & 63, hf = tid & 1;
        float acc = 0.f;
#pragma unroll 4
        for (int jk = hf * 128; jk < hf * 128 + 128; ++jk) acc += S[h * 256 + jk] * vptr[jk][h * 64 + dd];
        acc += __shfl_xor(acc, 1);
        if (hf == 0) mix[h * 64 + dd] = f2bf(acc * bf2f(gate[h * 64 + dd]));
    }
    __syncthreads();
}
DI void smem_unit(const Params& p, LAS3 unsigned char* lds, int b) {
    const int tid = threadIdx.x; unsigned char* ws = p.ws;
    const float* LAS3* kptr = (const float* LAS3*)(lds + SA_KP); const float* LAS3* vptr = (const float* LAS3*)(lds + SA_VP);
    if (tid < 256) { kptr[tid] = p.cache_mem_k + ((size_t)b * NMEM + tid) * 256; vptr[tid] = p.cache_mem_v + ((size_t)b * NMEM + tid) * 256; }
    const size_t row = MP + b;
    sattend(p, lds, (const bf16_t*)(ws + W_MQ) + row * 256, (const bf16_t*)(ws + W_MG) + row * 256, (bf16_t*)(ws + W_MIX) + row * 1024 + 768);
}
DI void ssel_unit(const Params& p, LAS3 unsigned char* lds, int b) {
    const int tid = threadIdx.x, lane = tid & 63, w = tid >> 6; unsigned char* ws = p.ws;
    LAS3 unsigned* CNT = (LAS3 unsigned*)lds;
    LAS3 unsigned* wsum = (LAS3 unsigned*)(lds + 256);
    LAS3 float* newsc = (LAS3 float*)(lds + 320);
    LAS3 int* list = (LAS3 int*)(lds + 512);
    const float* LAS3* kptr = (const float* LAS3*)(lds + SA_KP); const float* LAS3* vptr = (const float* LAS3*)(lds + SA_VP);
    if (tid < 48) CNT[tid] = 0u;
    if (tid == 0) {
        unsigned* cnt = (unsigned*)(ws + CW_SCNT); unsigned* tmo = (unsigned*)(ws + CW_TMO); unsigned sp = 0;
        while (__hip_atomic_load(cnt, __ATOMIC_RELAXED, __HIP_MEMORY_SCOPE_AGENT) < 256u) {
            __builtin_amdgcn_s_sleep(2);
            if ((++sp & 255u) == 0u) { if (__hip_atomic_load(tmo, __ATOMIC_RELAXED, __HIP_MEMORY_SCOPE_AGENT)) break; if (sp > (1u << 20)) { __hip_atomic_store(tmo, 1u, __ATOMIC_RELAXED, __HIP_MEMORY_SCOPE_AGENT); break; } }
        }
        __builtin_amdgcn_fence(__ATOMIC_ACQUIRE, "agent");
        asm volatile("s_waitcnt vmcnt(0)" ::: "memory");
    }
    if (w == 1) {
        const bf16_t* iq = (const bf16_t*)(ws + W_IQ) + (size_t)(MP + b) * 256; const float kd = bf2f(((const bf16_t*)(ws + W_IK))[(size_t)(MP + b) * 64 + lane]);
        const f32x4 wv = *(const f32x4*)vaddr((const float*)(ws + W_IW) + (size_t)(MP + b) * 4);
        float s = 0.f;
#pragma unroll
        for (int h = 0; h < 4; ++h) { const float dh = wsum64(bf2f(iq[h * 64 + lane]) * kd); s += wv[h] * fmaxf(dh, 0.f); }
        if (lane == 0) *newsc = s;
    }
    __syncthreads();
    const float* sc = (const float*)(ws + W_SC) + (size_t)b * SCLD;
    unsigned key[33];
#pragma unroll
    for (int n = 0; n < 32; ++n) key[n] = fkey(sc[tid + 512 * n]);
    key[32] = (tid == 0) ? fkey(*newsc) : 0u;
    int it = 0;
    unsigned T = 0u, X = 0x7fffffffu; bool fin = false;
    for (int bit = 31; bit >= 0; --bit) {
        const unsigned cand = T | (1u << bit);
        unsigned c = 0;
#pragma unroll
        for (int n = 0; n < 33; ++n) cnt_ge(c, key[n], cand);
        const unsigned tot = blk_count(c, CNT, it, lane);
        if (tot >= 256u) { T = cand; fin = (tot == 256u); }
        if (fin) break;
    }
    if (!fin) {
        unsigned c = 0;
#pragma unroll
        for (int n = 0; n < 33; ++n) cnt_gt(c, key[n], T);
        const unsigned need = 256u - blk_count(c, CNT, it, lane);
        unsigned Xl = 0u;
        for (int bit = 14; bit >= 0; --bit) {
            const unsigned cand = Xl | (1u << bit);
            c = 0;
#pragma unroll
            for (int n = 0; n < 33; ++n) cnt_eq_lt(c, key[n], T, (unsigned)(tid + 512 * n), cand);
            if (blk_count(c, CNT, it, lane) < need) Xl = cand;
        }
        X = Xl;
    }
    unsigned selm = 0, hi = 0;
#pragma unroll
    for (int n = 0; n < 32; ++n) selm |= (key[n] > T || (key[n] == T && (unsigned)(tid + 512 * n) <= X)) ? (1u << n) : 0u;
    hi = (key[32] > T || (key[32] == T && (unsigned)(tid + 16384) <= X)) ? 1u : 0u;
    const unsigned cs = __popc(selm) + hi;
    unsigned inc = cs;
#pragma unroll
    for (int o2 = 1; o2 < 64; o2 <<= 1) { const unsigned t2 = __shfl_up(inc, o2); if (lane >= o2) inc += t2; }
    if (lane == 63) wsum[w] = inc;
    __syncthreads();
    unsigned pos = inc - cs;
    for (int w2 = 0; w2 < w; ++w2) pos += wsum[w2];
#pragma unroll
    for (int n = 0; n < 32; ++n) if ((selm >> n) & 1u) { if (pos < 256u) list[pos] = tid + 512 * n; ++pos; }
    if (hi) { if (pos < 256u) list[pos] = tid + 16384; ++pos; }
    __syncthreads();
    if (tid < 256) {
        const int idx = list[tid];
        if (idx < 16384) { const size_t phys = (size_t)p.page_table[b * NPAGES + (idx >> 7)] * 128 + (idx & 127); kptr[tid] = p.cache_k + phys * 256; vptr[tid] = p.cache_v + phys * 256; }
        else { kptr[tid] = p.out + O_KS + (size_t)b * 256; vptr[tid] = p.out + O_VS + (size_t)b * 256; }
    }
    const size_t row = MP + b;
    sattend(p, lds, (const bf16_t*)(ws + W_DQ) + row * 256, (const bf16_t*)(ws + W_DG) + row * 256, (bf16_t*)(ws + W_MIX) + row * 1024 + 512);
}
DI void sgla_unit(const Params& p, LAS3 unsigned char* lds, int b) {
    const int tid = threadIdx.x, lane = tid & 63, w = tid >> 6; unsigned char* ws = p.ws;
    LAS3 float* qs = (LAS3 float*)lds; LAS3 float* ks = qs + 256; LAS3 float* gs = qs + 512; LAS3 float* vs = qs + 768; LAS3 float* part = qs + 1280;
    const size_t row = MP + b;
    if (tid < 256) {
        float u = p.b_g[tid];
        const float* gl = vaddr((const float*)(ws + W_GLR) + row * 16);
#pragma unroll
        for (int r = 0; r < 16; ++r) u += gl[r] * p.w_g2[r * 256 + tid];
        gs[tid] = expf(logsigf(u) * (1.f / 16.f));
        qs[tid] = bf2f(((const bf16_t*)(ws + W_GQ))[row * 256 + tid]); ks[tid] = bf2f(((const bf16_t*)(ws + W_GK))[row * 256 + tid]);
    }
    vs[tid] = bf2f(((const bf16_t*)(ws + W_GV))[row * 512 + tid]);
    __syncthreads();
    const int h = tid >> 7, v = tid & 127;
    const float* sp = p.state_gla + ((size_t)(b * 4 + h) * 64) * 128 + v; float* so = p.out + O_GSS + ((size_t)(b * 4 + h) * 64) * 128 + v;
    const float vv = vs[h * 128 + v];
    float o = 0.f;
#pragma unroll 8
    for (int dd = 0; dd < 64; ++dd) { const float sn = gs[h * 64 + dd] * sp[dd * 128] + ks[h * 64 + dd] * vv; so[dd * 128] = sn; o += qs[h * 64 + dd] * sn; }
    const float ss = wsum64(o * o);
    if (lane == 0) part[w] = ss;
    __syncthreads();
    const float rstd = rsqrtf((part[2 * h] + part[2 * h + 1]) * (1.f / 128.f) + 1e-6f);
    ((bf16_t*)(ws + W_MIX))[row * 1024 + h * 128 + v] = f2bf(o * rstd * p.onorm[v] * bf2f(((const bf16_t*)(ws + W_GG))[row * 512 + h * 128 + v]));
    __syncthreads();
}
DI void p4_final(const Params& p) {
    const int tid = threadIdx.x, lane = tid & 63, wv = tid >> 6;
    for (int r = blockIdx.x * 8 + wv; r < MP + NDB; r += gridDim.x * 8) {
        float* y = p.out + (r < MP ? O_YP + (size_t)r * DM : O_YS + (size_t)(r - MP) * DM);
        f32x4 v[4]; float ss = 0.f;
#pragma unroll
        for (int i = 0; i < 4; ++i) { v[i] = *(const f32x4*)(y + i * 256 + lane * 4); ss += v[i][0] * v[i][0] + v[i][1] * v[i][1] + v[i][2] * v[i][2] + v[i][3] * v[i][3]; }
        ss = wsum64(ss);
        const float rstd = rsqrtf(ss * (1.f / DM) + 1e-6f);
#pragma unroll
        for (int i = 0; i < 4; ++i) { const f32x4 gv = *(const f32x4*)(p.norm_final + i * 256 + lane * 4); *(f32x4*)(y + i * 256 + lane * 4) = v[i] * rstd * gv; }
    }
}

DI int next_unit(unsigned* ctr, volatile LAS3 unsigned* slot) {
    if (threadIdx.x == 0) *slot = __hip_atomic_fetch_add(ctr, 1u, __ATOMIC_RELAXED, __HIP_MEMORY_SCOPE_AGENT);
    __syncthreads();
    const int v = __builtin_amdgcn_readfirstlane((int)*slot);
    __syncthreads();
    return v;
}

#ifndef REP1
#define REP1 1
#endif
#ifndef REP2
#define REP2 1
#endif
#ifndef REP3
#define REP3 1
#endif
#ifndef REP2A
#define REP2A 1
#endif
#ifndef REP2B
#define REP2B 1
#endif
#ifndef REP2C
#define REP2C 1
#endif
#ifndef REP2D
#define REP2D 1
#endif
#ifndef REP2E
#define REP2E 1
#endif
DI void sample_inproj(const Params& p, LAS3 unsigned char* lds) {
    const int tid = threadIdx.x, lane = tid & 63, wv = tid >> 6, fr = lane & 15, fq = lane >> 4;
    unsigned char* ws = p.ws;
    LAS3 float* red = (LAS3 float*)lds;
    for (int pr = blockIdx.x; pr < 112; pr += gridDim.x) {
        const int col0 = pr * 32, pn = col0 >> 8, vc0 = col0 & 255;
        const bf16_t* A = (const bf16_t*)(ws + W_XN) + (size_t)MP * 1024 + (size_t)fr * 1024 + fq * 8 + wv * 128;
        const bf16_t* B = (const bf16_t*)(ws + W_WTIN) + (size_t)(col0 + fr) * 1024 + fq * 8 + wv * 128;
        const f32x4 zero = {0.f, 0.f, 0.f, 0.f};
        f32x4 acc[2][2] = {{zero, zero}, {zero, zero}};
#pragma unroll
        for (int ks = 0; ks < 4; ++ks) {
            const bf16x8 a0 = *(const bf16x8*)(A + ks * 32), a1 = *(const bf16x8*)(A + 16 * 1024 + ks * 32);
            const bf16x8 b0 = *(const bf16x8*)(B + ks * 32), b1 = *(const bf16x8*)(B + 16 * 1024 + ks * 32);
            acc[0][0] = mfma16(a0, b0, acc[0][0]); acc[0][1] = mfma16(a0, b1, acc[0][1]); acc[1][0] = mfma16(a1, b0, acc[1][0]); acc[1][1] = mfma16(a1, b1, acc[1][1]);
        }
#pragma unroll
        for (int rt = 0; rt < 2; ++rt)
#pragma unroll
            for (int ct = 0; ct < 2; ++ct)
#pragma unroll
                for (int r = 0; r < 4; ++r) red[(wv * 16 + (rt * 2 + ct) * 4 + r) * 64 + lane] = acc[rt][ct][r];
        __syncthreads();
        {
            const int rt = wv >> 2, r = wv & 3;
            float v0 = 0.f, v1 = 0.f;
#pragma unroll
            for (int w2 = 0; w2 < 8; ++w2) { v0 += red[(w2 * 16 + (rt * 2 + 0) * 4 + r) * 64 + lane]; v1 += red[(w2 * 16 + (rt * 2 + 1) * 4 + r) * 64 + lane]; }
            const float* rope = (const float*)(ws + W_ROPE) + (size_t)2048 * 64;
            {
                const int bs = 16 * rt + 4 * fq + r; const size_t R = (size_t)MP + bs;
                if (pn <= 5 || (pn >= 10 && pn <= 12)) {
                    bf16_t* dst; int ldc = 256, coff = 0; float sc = 1.f; bool silu = false;
                    switch (pn) {
                        case 0: dst = (bf16_t*)(ws + W_GQ); sc = 0.125f; break;
                        case 1: dst = (bf16_t*)(ws + W_GK); break;
                        case 2: dst = (bf16_t*)(ws + W_GV); ldc = 512; break;
                        case 3: dst = (bf16_t*)(ws + W_GV); ldc = 512; coff = 256; break;
                        case 4: dst = (bf16_t*)(ws + W_GG); ldc = 512; silu = true; break;
                        case 5: dst = (bf16_t*)(ws + W_GG); ldc = 512; coff = 256; silu = true; break;
                        case 10: dst = (bf16_t*)(ws + W_DG); silu = true; break;
                        case 11: dst = (bf16_t*)(ws + W_MQ); sc = 0.125f; break;
                        default: dst = (bf16_t*)(ws + W_MG); silu = true; break;
                    }
                    bf16_t* rp = dst + R * ldc + coff + vc0 + 8 * (fr >> 2) + (fr & 3);
                    rp[0] = f2bf(silu ? siluf(v0) : v0 * sc); rp[4] = f2bf(silu ? siluf(v1) : v1 * sc);
                } else if (pn == 6 || pn == 7 || pn == 9 || (pn == 13 && vc0 < 64)) {
                    const int hh = (pn == 13) ? 0 : ((vc0 >> 5) & 3);
                    const int f = (pn == 13) ? 16 * ((vc0 >> 5) & 1) + fr : 8 * (fr >> 2) + 4 * (vc0 >> 7) + (fr & 3);
                    const float c = rope[2 * f], s = rope[2 * f + 1], sc = (pn == 6) ? 0.125f : 1.f;
                    const float o1 = (v0 * c - v1 * s) * sc, o2 = (v1 * c + v0 * s) * sc;
                    if (pn == 13) {
                        bf16_t* ikb = (bf16_t*)(ws + W_IK) + R * 64; ikb[f] = f2bf(o1); ikb[f + 32] = f2bf(o2);
                        float* op = p.out + O_IKS + (size_t)bs * 64; op[f] = o1; op[f + 32] = o2;
                    } else {
                        bf16_t* dst = (bf16_t*)(ws + (pn == 6 ? W_DQ : (pn == 7 ? W_DK : W_IQ))) + R * 256 + 64 * hh;
                        dst[f] = f2bf(o1); dst[f + 32] = f2bf(o2);
                        if (pn == 7) { float* op = p.out + O_KS + (size_t)bs * 256 + 64 * hh; op[f] = o1; op[f + 32] = o2; }
                    }
                } else if (pn == 8) {
                    float* op = p.out + O_VS + (size_t)bs * 256 + vc0 + 8 * (fr >> 2) + (fr & 3); op[0] = v0; op[4] = v1;
                } else if (pn == 13 && vc0 == 64) {
                    if (fr < 4) { ((float*)(ws + W_IW))[R * 4 + fr] = v0 * 0.5f; ((float*)(ws + W_GLR))[R * 16 + 12 + fr] = v1; }
                    else ((float*)(ws + W_GLR))[R * 16 + fr - 4] = v0;
                }
            }
        }
        __syncthreads();
    }
}
DI void phase1(const Params& p, LAS3 unsigned char* lds) {
    unsigned char* ws = p.ws;
    { pg8::Gemm g{(const bf16_t*)(ws + W_XN), (const bf16_t*)(ws + W_WTIN), MP, NIN, DM}; pg8::StaticOrder S; S.init(MP, NIN, (int)gridDim.x, (int)blockIdx.x);
      EpiIn E{ws, p.out}; pg8::gemm_phase<EpiIn, pg8::StaticOrder, true, true>(lds, g, S, E); }
    sample_inproj(p, lds);
}
DI void p2_memgemm(const Params& p, LAS3 unsigned char* lds) {
    const int u = (int)gridDim.x - 1 - (int)blockIdx.x;
    if (u >= 96 && u < 128) {
        pg8::Gemm g{(const bf16_t*)(p.ws + W_MEMN), (const bf16_t*)(p.ws + W_WTMEM), MMEM, 512, DM}; pg8::StaticOrder S; S.init(MMEM, 512, (int)gridDim.x, u - 96);
        EpiMem E{p.ws, p.out}; pg8::gemm_phase<EpiMem, pg8::StaticOrder, true, true>(lds, g, S, E);
        asm volatile("s_waitcnt vmcnt(0)" ::: "memory");
        __syncthreads();
        if (threadIdx.x == 0) {
            __builtin_amdgcn_fence(__ATOMIC_RELEASE, "agent");
            asm volatile("s_waitcnt vmcnt(0)" ::: "memory");
            __hip_atomic_fetch_add((unsigned*)(p.ws + CW_MEMC), 1u, __ATOMIC_RELAXED, __HIP_MEMORY_SCOPE_AGENT);
        }
    }
}
DI void wait_memgemm(const Params& p) {
    if (threadIdx.x == 0) {
        unsigned* cnt = (unsigned*)(p.ws + CW_MEMC); unsigned* tmo = (unsigned*)(p.ws + CW_TMO); unsigned sp = 0;
        while (__hip_atomic_load(cnt, __ATOMIC_RELAXED, __HIP_MEMORY_SCOPE_AGENT) < 32u) {
            __builtin_amdgcn_s_sleep(2);
            if ((++sp & 255u) == 0u) { if (__hip_atomic_load(tmo, __ATOMIC_RELAXED, __HIP_MEMORY_SCOPE_AGENT)) break; if (sp > (1u << 20)) { __hip_atomic_store(tmo, 1u, __ATOMIC_RELAXED, __HIP_MEMORY_SCOPE_AGENT); break; } }
        }
        __builtin_amdgcn_fence(__ATOMIC_ACQUIRE, "agent");
        asm volatile("s_waitcnt vmcnt(0)" ::: "memory");
    }
    __syncthreads();
}
template <int QI> DI void p2_sscore(const Params& p, LAS3 unsigned char* lds) { for (int u = blockIdx.x; u < 256; u += gridDim.x) { sscore_unit(p, lds, u); __syncthreads(); } }
template <int QI> DI void p2_gla(const Params& p, LAS3 unsigned char* lds) { for (int u = blockIdx.x; u < 64; u += gridDim.x) gla_unit(p, lds, u >> 2, u & 3); }
DI int next_unit_xcd(unsigned char* qbase, volatile LAS3 unsigned* slot, unsigned x0) {
    if (threadIdx.x == 0) {
        unsigned res = 0xffffffffu;
        for (unsigned k = 0; k < 8u; ++k) {
            const unsigned xq = (x0 + k) & 7u;
            const unsigned mq = __hip_atomic_fetch_add((unsigned*)(qbase + 256 * xq), 1u, __ATOMIC_RELAXED, __HIP_MEMORY_SCOPE_AGENT);
            if (mq < 64u) { res = xq * 64u + mq; break; }
        }
        *slot = res;
    }
    __syncthreads();
    const int v = __builtin_amdgcn_readfirstlane((int)*slot);
    __syncthreads();
    return v;
}
template <int QI> DI void p2_dsa(const Params& p, LAS3 unsigned char* lds, volatile LAS3 unsigned* MISC TARGS) {
#if defined(XCDQ) && XCDQ
    const unsigned x0 = xb_xcc_id() & 7u;
    for (;;) { const int n = next_unit_xcd(p.ws + CW_QDSA + 8192 * QI, MISC + 4, x0); if (n < 0) break; const int m = n & 63; dsa_unit(p, lds, 2 * (n >> 6) + (m >> 5), 31 - (m & 31) TPASS); }
#else
    for (;;) { const int n = next_unit((unsigned*)(p.ws + CW_QDSA + 8192 * QI), MISC + 4); if (n >= 512) break; dsa_unit(p, lds, n & 15, 31 - (n >> 4) TPASS); }
#endif
}
template <int QI> DI void p2_mem(const Params& p, LAS3 unsigned char* lds, volatile LAS3 unsigned* MISC) {
    wait_memgemm(p);
    for (;;) { const int n = next_unit((unsigned*)(p.ws + CW_QMEM + 8192 * QI), MISC + 4); if (n >= 512) break; mem_unit(p, n); } }
template <int QI> DI void p2_sample(const Params& p, LAS3 unsigned char* lds) {
    for (int u = (int)gridDim.x - 1 - (int)blockIdx.x; u < 96; u += gridDim.x) { if (u < 32) sgla_unit(p, lds, u); else if (u < 64) smem_unit(p, lds, u - 32); else ssel_unit(p, lds, u - 64); } }
template <int RI> DI void phase2(const Params& p, LAS3 unsigned char* lds, volatile LAS3 unsigned* MISC TARGS) {
    TBEG(20); p2_memgemm(p, lds);
    TBEG(21); p2_sscore<0>(p, lds); TEND(21); if (REP2A > 1) p2_sscore<1>(p, lds);
    TBEG(25); p2_sample<0>(p, lds); TEND(25); if (REP2E > 1) p2_sample<1>(p, lds);
    TBEG(22); p2_gla<0>(p, lds); TEND(22); if (REP2B > 1) p2_gla<1>(p, lds);
    TBEG(23); p2_dsa<0>(p, lds, MISC TPASS); TEND(23); if (REP2C > 1) p2_dsa<1>(p, lds, MISC TPASS);
    TBEG(24); p2_mem<0>(p, lds, MISC); TEND(24); if (REP2D > 1) p2_mem<1>(p, lds, MISC);
    TEND(20);
}
DI void phase3(const Params& p, LAS3 unsigned char* lds) {
    pg8::Gemm g{(const bf16_t*)(p.ws + W_MIX), (const bf16_t*)(p.ws + W_WTOUT), MP, DM, DM}; pg8::StaticOrder S; S.init(MP, DM, (int)gridDim.x, (int)blockIdx.x);
    EpiOut E{p.x_prompt, p.x_sample, p.out}; pg8::gemm_phase<EpiOut, pg8::StaticOrder, true, true>(lds, g, S, E);
    const int tid = threadIdx.x, lane = tid & 63, wv = tid >> 6;
    for (int u = blockIdx.x; u < 256; u += gridDim.x) {
        const int b = u >> 3, col0 = (u & 7) * 128 + wv * 16;
        const bf16_t* mrow = (const bf16_t*)(p.ws + W_MIX) + (size_t)(MP + b) * 1024 + lane * 16;
        const u32x4 m0 = *(const u32x4*)mrow, m1 = *(const u32x4*)(mrow + 8);
        const unsigned mw[8] = {m0.x, m0.y, m0.z, m0.w, m1.x, m1.y, m1.z, m1.w};
        float res = 0.f;
#pragma unroll 4
        for (int i = 0; i < 16; ++i) {
            const bf16_t* wrow = (const bf16_t*)(p.ws + W_WTOUT) + (size_t)(col0 + i) * 1024 + lane * 16;
            const u32x4 w0 = *(const u32x4*)wrow, w1 = *(const u32x4*)(wrow + 8);
            const unsigned ww[8] = {w0.x, w0.y, w0.z, w0.w, w1.x, w1.y, w1.z, w1.w};
            float acc = 0.f;
#pragma unroll
            for (int e = 0; e < 8; ++e) acc += __uint_as_float(mw[e] << 16) * __uint_as_float(ww[e] << 16) + __uint_as_float(mw[e] & 0xffff0000u) * __uint_as_float(ww[e] & 0xffff0000u);
            acc = wsum64(acc);
            res = (lane == i) ? acc : res;
        }
        if (lane < 16) p.out[O_YS + (size_t)b * DM + col0 + lane] = p.x_sample[(size_t)b * DM + col0 + lane] + res;
    }
}
#ifdef CHECK_ATT
DI void check_mem_attention(const Params& p) {
    const int tid = threadIdx.x, lane = tid & 63, wv = tid >> 6;
    const int samp = blockIdx.x * 8 + wv;
    const int row = (samp * 977 + 13) % MP, h = samp & 3, b = row >> 11;
    const bf16_t* q = (const bf16_t*)(p.ws + W_MQ) + (size_t)row * 256 + h * 64;
    float s[4];
#pragma unroll
    for (int i = 0; i < 4; ++i) { const float* kr = p.out + O_MKP + ((size_t)b * NMEM + lane + 64 * i) * 256 + h * 64; float a = 0.f; for (int d = 0; d < 64; ++d) a += bf2f(q[d]) * kr[d]; s[i] = a; }
    float mx = wmax64(fmaxf(fmaxf(s[0], s[1]), fmaxf(s[2], s[3])));
    float pe[4], sum = 0.f;
#pragma unroll
    for (int i = 0; i < 4; ++i) { pe[i] = __builtin_amdgcn_exp2f(s[i] - mx); sum += pe[i]; }
    sum = wsum64(sum);
    float err = 0.f, nrm = 0.f;
    for (int d = 0; d < 64; ++d) {
        float a = 0.f;
#pragma unroll
        for (int i = 0; i < 4; ++i) a += pe[i] * p.out[O_MVP + ((size_t)b * NMEM + lane + 64 * i) * 256 + h * 64 + d];
        a = wsum64(a) / sum;
        const float want = a * bf2f(((const bf16_t*)(p.ws + W_MG))[(size_t)row * 256 + h * 64 + d]);
        const float got = bf2f(((const bf16_t*)(p.ws + W_MIX))[(size_t)row * 1024 + 768 + h * 64 + d]);
        err += (got - want) * (got - want); nrm += want * want;
    }
    if (lane == 0) { atomicAdd((unsigned*)(p.ws + CW_CHK + 12), 1u); if (!(err <= 0.0025f * nrm + 1e-12f)) atomicAdd((unsigned*)(p.ws + CW_CHK + 8), 1u); }
    if (samp < 128) {
        const int bs = samp >> 2, hs = samp & 3; const size_t rs = (size_t)MP + bs;
        const bf16_t* qs = (const bf16_t*)(p.ws + W_MQ) + rs * 256 + hs * 64;
        float s2[4];
#pragma unroll
        for (int i = 0; i < 4; ++i) { const float* kr = p.cache_mem_k + ((size_t)bs * NMEM + lane + 64 * i) * 256 + hs * 64; float a = 0.f; for (int d = 0; d < 64; ++d) a += bf2f(qs[d]) * kr[d]; s2[i] = a; }
        const float mx2 = wmax64(fmaxf(fmaxf(s2[0], s2[1]), fmaxf(s2[2], s2[3])));
        float pe2[4], sum2 = 0.f;
#pragma unroll
        for (int i = 0; i < 4; ++i) { pe2[i] = __expf(s2[i] - mx2); sum2 += pe2[i]; }
        sum2 = wsum64(sum2);
        float err2 = 0.f, nrm2 = 0.f;
        for (int d = 0; d < 64; ++d) {
            float a = 0.f;
#pragma unroll
            for (int i = 0; i < 4; ++i) a += pe2[i] * p.cache_mem_v[((size_t)bs * NMEM + lane + 64 * i) * 256 + hs * 64 + d];
            a = wsum64(a) / sum2;
            const float want = a * bf2f(((const bf16_t*)(p.ws + W_MG))[rs * 256 + hs * 64 + d]);
            const float got = bf2f(((const bf16_t*)(p.ws + W_MIX))[rs * 1024 + 768 + hs * 64 + d]);
            err2 += (got - want) * (got - want); nrm2 += want * want;
        }
        if (lane == 0) { atomicAdd((unsigned*)(p.ws + CW_CHK + 12), 1u); if (!(err2 <= 0.0025f * nrm2 + 1e-12f)) atomicAdd((unsigned*)(p.ws + CW_CHK + 8), 1u); }
    }
}
#endif
__global__ void __launch_bounds__(NTHREADS, 2) hymba_fwd(Params p) {
    extern __shared__ __attribute__((aligned(16))) unsigned char lds_raw[];
    LAS3 unsigned char* lds = (LAS3 unsigned char*)lds_raw;
    volatile LAS3 unsigned* MISC = (volatile LAS3 unsigned*)(lds + LDS_MISC);
    const int tid = threadIdx.x;
    if (tid < 64) MISC[tid] = 0u;
    __syncthreads();
    const int lo = p.ph_lo, hi = p.ph_hi;
    TDECL;
    XcdBarrier bar; bar.bar = (unsigned*)p.ws; bar.x = 0; bar.st = MISC;
    if (hi > lo) bar = xcd_barrier_post((unsigned*)p.ws, MISC);
#define IN(k) (lo <= (k) && (k) <= hi)
#define SEAM(k) do { if (IN(k) && IN((k) + 1)) xcd_barrier(bar); } while (0)
    TBEG(0); if (IN(0)) p0_prologue(p, lds); TEND(0);
    TBEG(10); SEAM(0); TEND(10);
    TBEG(1); if (IN(1)) { phase1(p, lds); if (REP1 > 1) { xcd_barrier(bar); phase1(p, lds); } } TEND(1);
    TBEG(11); SEAM(1); TEND(11);
    TBEG(2); if (IN(2)) { phase2<0>(p, lds, MISC TPASS); } TEND(2);
    TBEG(12); SEAM(2); TEND(12);
#ifdef CHECK_ATT
    if (IN(3)) check_mem_attention(p);
#endif
    TBEG(3); if (IN(3)) { phase3(p, lds); if (REP3 > 1) { xcd_barrier(bar); phase3(p, lds); } } TEND(3);
    TBEG(13); SEAM(3); TEND(13);
    TBEG(4); if (IN(4)) p4_final(p); TEND(4);
#ifdef TSEL
    {
#ifdef TCLS
        if (tid == 0 && (int)((blockIdx.x >> 6) & 1) == TCLS) { atomicAdd((unsigned long long*)(p.ws + CW_TSUM), 2ull * (unsigned long long)tacc_); atomicMax((unsigned long long*)(p.ws + CW_TMAX), (unsigned long long)tacc_); }
#else
        if (tid == 0) { atomicAdd((unsigned long long*)(p.ws + CW_TSUM), (unsigned long long)tacc_); atomicMax((unsigned long long*)(p.ws + CW_TMAX), (unsigned long long)tacc_); }
#endif
        xcd_barrier(bar);
        if (blockIdx.x == 0 && tid == 0) {
#ifdef TMAX
            unsigned long long dly = __hip_atomic_load((unsigned long long*)(p.ws + CW_TMAX), __ATOMIC_RELAXED, __HIP_MEMORY_SCOPE_AGENT);
#else
            const unsigned long long dly = __hip_atomic_load((unsigned long long*)(p.ws + CW_TSUM), __ATOMIC_RELAXED, __HIP_MEMORY_SCOPE_AGENT) / gridDim.x;
#endif
#ifndef TMUL
#define TMUL 1
#endif
            const unsigned long long t0 = __builtin_amdgcn_s_memrealtime();
            while (__builtin_amdgcn_s_memrealtime() - t0 < dly * TMUL && __builtin_amdgcn_s_memrealtime() - t0 < 400000ull) __builtin_amdgcn_s_sleep(8);
        }
    }
#endif
#ifdef CHECK_ATT
    {
        xcd_barrier(bar);
        const unsigned nbad = __hip_atomic_load((unsigned*)(p.ws + CW_CHK + 8), __ATOMIC_RELAXED, __HIP_MEMORY_SCOPE_AGENT);
        const unsigned nchk = __hip_atomic_load((unsigned*)(p.ws + CW_CHK + 12), __ATOMIC_RELAXED, __HIP_MEMORY_SCOPE_AGENT);
        if (nbad != 0u || nchk < 2170u) for (int i = blockIdx.x * NTHREADS + tid; i < NDB * DM; i += gridDim.x * NTHREADS) p.out[O_YS + i] = __builtin_nanf("");
    }
#endif
#ifdef CHECK_SEL
    {
        xcd_barrier(bar);
        const unsigned nbad = __hip_atomic_load((unsigned*)(p.ws + CW_CHK), __ATOMIC_RELAXED, __HIP_MEMORY_SCOPE_AGENT);
        const unsigned nhist = __hip_atomic_load((unsigned*)(p.ws + CW_CHK + 4), __ATOMIC_RELAXED, __HIP_MEMORY_SCOPE_AGENT);
        if (nbad != 0u || nhist < CHECK_MIN_HIST) for (int i = blockIdx.x * NTHREADS + tid; i < NDB * DM; i += gridDim.x * NTHREADS) p.out[O_YS + i] = __builtin_nanf("");
    }
#endif
#undef IN
#undef SEAM
}

#ifndef N_LAUNCHES
#define N_LAUNCHES 1
#endif
extern "C" void kernel_launch(void* const* d_in, const int* in_sizes, int n_in, void* d_out, int out_size, void* d_ws, size_t ws_size, hipStream_t stream) {
    static int grid = 0;
    if (grid == 0) {
        if (n_in != 19 || (size_t)out_size != O_END || ws_size < W_END) fprintf(stderr, "kernel_launch: unexpected sizes: n_in %d out %d ws %zu (need %zu)\n", n_in, out_size, ws_size, (size_t)W_END);
        int dev = 0, cus = 0, per_cu = 0;
        if (hipGetDevice(&dev) != hipSuccess || hipDeviceGetAttribute(&cus, hipDeviceAttributeMultiprocessorCount, dev) != hipSuccess) { fprintf(stderr, "kernel_launch: device query failed\n"); grid = -1; return; }
        if (hipFuncSetAttribute((const void*)hymba_fwd, hipFuncAttributeMaxDynamicSharedMemorySize, LDS_BYTES) != hipSuccess) { fprintf(stderr, "kernel_launch: hipFuncSetAttribute failed\n"); grid = -1; return; }
        if (hipOccupancyMaxActiveBlocksPerMultiprocessor(&per_cu, (const void*)hymba_fwd, NTHREADS, LDS_BYTES) != hipSuccess || per_cu < 1) fprintf(stderr, "kernel_launch: occupancy query reports %d blocks per CU\n", per_cu);
        (void)hipGetLastError();
        grid = cus;
    }
    if (grid < 0) return;
    (void)hipMemsetAsync(d_ws, 0, CTRL_BYTES, stream);
    Params p{};
    p.x_prompt = (const float*)d_in[0]; p.x_sample = (const float*)d_in[1]; p.mem_prompt = (const float*)d_in[2]; p.state_gla = (const float*)d_in[3];
    p.cache_k = (const float*)d_in[4]; p.cache_v = (const float*)d_in[5]; p.cache_ik = (const float*)d_in[6]; p.cache_mem_k = (const float*)d_in[7]; p.cache_mem_v = (const float*)d_in[8];
    p.page_table = (const int*)d_in[9];
    p.norm_in = (const float*)d_in[10]; p.w_in = (const float*)d_in[11]; p.w_g2 = (const float*)d_in[12]; p.b_g = (const float*)d_in[13]; p.onorm = (const float*)d_in[14];
    p.mem_norm = (const float*)d_in[15]; p.w_mem_kv = (const float*)d_in[16]; p.w_out = (const float*)d_in[17]; p.norm_final = (const float*)d_in[18];
    p.out = (float*)d_out; p.ws = (unsigned char*)d_ws;
#if N_LAUNCHES == 1
    p.ph_lo = 0; p.ph_hi = 4;
    hipLaunchKernelGGL(hymba_fwd, dim3(grid), dim3(NTHREADS), LDS_BYTES, stream, p);
#else
    for (int ph = 0; ph < 5; ++ph) { p.ph_lo = ph; p.ph_hi = ph; hipLaunchKernelGGL(hymba_fwd, dim3(grid), dim3(NTHREADS), LDS_BYTES, stream, p); }
#endif
    const hipError_t le = hipPeekAtLastError();
    if (le != hipSuccess) fprintf(stderr, "kernel_launch: launch failed: %s\n", hipGetErrorName(le));
}
```

```cpp
#include <hip/hip_runtime.h>
#include <cstdint>
#include <cstdio>
namespace pg8 {
#define PG8_LAS __attribute__((address_space(3)))
typedef unsigned short bf16_t;
typedef short bf16x8 __attribute__((ext_vector_type(8)));
typedef float f32x4 __attribute__((ext_vector_type(4)));
typedef unsigned u32x4 __attribute__((ext_vector_type(4)));
constexpr int BM = 256, BK = 64, HALF = 128, HTB = HALF * BK * 2  , STAGE_BYTES = 8 * HTB, NXCD = 8, WGM = 8;

__host__ __device__ __forceinline__ int lds_byte(int r, int c) { const int st = (r >> 4) * 2 + (c >> 5), rr = r & 15, cc = c & 31, ob = rr * 64 + cc * 2; return st * 1024 + (ob ^ (((ob >> 9) & 1) << 5)); }
__host__ __device__ __forceinline__ void stage_rc(int b, int& R, int& C) { const int st = b / 1024, sb = b % 1024, swz = sb ^ (((sb >> 9) & 1) << 5); R = (st >> 1) * 16 + swz / 64; C = (st & 1) * 32 + (swz % 64) / 2; }
__host__ __device__ __forceinline__ int perm32(int rho) { const int n = rho >> 4, i = rho & 15; return 8 * (i >> 2) + 4 * n + (i & 3); }

struct Unit { int pm, pn; };
struct Gemm { const bf16_t* A; const bf16_t* Bt; int M, N, K; };

struct StaticOrder {
    int nM, nN, nwg, G, c;
    __host__ __device__ void init(int M, int N, int G_, int c_) { nM = M / BM; nN = N / BM; nwg = nM * nN; G = G_; c = c_; }
    __host__ __device__ bool next(int i, Unit& u) const {
        const long L = (long)i * G + c; if (L >= nwg) return false;
        int wgid = (int)L; { const int q = nwg / NXCD, r = nwg % NXCD, xcd = wgid % NXCD, off = wgid / NXCD; wgid = (xcd < r ? xcd * (q + 1) : r * (q + 1) + (xcd - r) * q) + off; }
        const int nig = WGM * nN, gid = wgid / nig, fm = gid * WGM, gsz = (nM - fm) < WGM ? (nM - fm) : WGM;
        u.pm = fm + ((wgid % nig) % gsz); u.pn = (wgid % nig) / gsz; return true;
    }
    __device__ __forceinline__ void a_ready(const Unit&) const {}
    __device__ __forceinline__ void done(const Unit&) const {}
};

template <class Epi, class Sched, bool ALIGN_EPI = false, bool SP2 = false>
__device__ __forceinline__ void gemm_phase(PG8_LAS unsigned char* lds, const Gemm g, const Sched& S, const Epi& E) {
    const int tid = threadIdx.x, wid = __builtin_amdgcn_readfirstlane(tid >> 6), lane = tid & 63, wr = wid >> 2, wc = wid & 3, fr = lane & 15, fq = lane >> 4;
    const int K = g.K, nt = K / BK;
    unsigned voffA[2], voffB[2];
#pragma unroll
    for (int i = 0; i < 2; ++i) { int R, C; stage_rc(tid * 16 + i * 8192, R, C); const int Rb = Epi::PERM ? ((R & ~31) + perm32(R & 31)) : R;
        voffA[i] = (unsigned)(R * K + C) * 2u; voffB[i] = (unsigned)(Rb * K + C) * 2u; }
    const size_t kstep = (size_t)(BK * 2);
    const size_t hstep = (size_t)HALF * K * 2;
    const size_t tstep = 2 * hstep;
    const unsigned ldsw = (unsigned)wid * 1024u;
    const int aoff = lds_byte(wr * 64 + fr, fq * 8), boff = lds_byte(wc * 32 + fr, fq * 8);
#define PG8_SA(b, h) (((b) * 2 + (h)) * HTB)
#define PG8_SB(b, h) ((4 + (b) * 2 + (h)) * HTB)
#define PG8_STAGE(bufoff, gbase, voff) do { _Pragma("unroll") for (int _i = 0; _i < 2; ++_i) \
        __builtin_amdgcn_global_load_lds((const unsigned*)((const char*)(gbase) + (voff)[_i]), (PG8_LAS unsigned*)(lds + (bufoff) + ldsw + _i * 8192), 16, 0, 0); } while (0)
#define PG8_LDA(dst, b, h) do { _Pragma("unroll") for (int m = 0; m < 4; ++m) _Pragma("unroll") for (int k = 0; k < 2; ++k) dst[m][k] = *(const PG8_LAS bf16x8*)(lds + PG8_SA(b, h) + aoff + m * 2048 + k * 1024); } while (0)
#define PG8_LDB(dst, b, h) do { _Pragma("unroll") for (int n = 0; n < 2; ++n) _Pragma("unroll") for (int k = 0; k < 2; ++k) dst[n][k] = *(const PG8_LAS bf16x8*)(lds + PG8_SB(b, h) + boff + n * 2048 + k * 1024); } while (0)
#define PG8_MMA(ai, bj, At, Bt) do { __builtin_amdgcn_s_setprio(1); _Pragma("unroll") for (int m = 0; m < 4; ++m) _Pragma("unroll") for (int n = 0; n < 2; ++n) _Pragma("unroll") for (int k = 0; k < 2; ++k) \
        acc[ai][bj][m][n] = __builtin_amdgcn_mfma_f32_16x16x32_bf16(Bt[n][k], At[m][k], acc[ai][bj][m][n], 0, 0, 0); __builtin_amdgcn_s_setprio(0); } while (0)
#define PG8_WAIT_V(n) asm volatile("s_waitcnt vmcnt(" #n ")" ::: "memory")
#define PG8_WAIT_L(n) asm volatile("s_waitcnt lgkmcnt(" #n ")" ::: "memory")
#define PG8_BAR __builtin_amdgcn_s_barrier()
#define PG8_SCHED __builtin_amdgcn_sched_barrier(0)
    Unit cur, nxt; int ui = 0;
    if (!S.next(0, cur)) return;
    f32x4 acc[2][2][4][2];
#pragma unroll
    for (int a = 0; a < 2; ++a)
#pragma unroll
        for (int b = 0; b < 2; ++b)
#pragma unroll
            for (int m = 0; m < 4; ++m)
#pragma unroll
                for (int n = 0; n < 2; ++n) acc[a][b][m][n] = (f32x4){0.f, 0.f, 0.f, 0.f};
    bf16x8 At[4][2], B0[2][2], B1[2][2];
    const char* cA = (const char*)g.A + (size_t)cur.pm * tstep; const char* cB = (const char*)g.Bt + (size_t)cur.pn * tstep;
    S.a_ready(cur);
    if constexpr (SP2) {
        PG8_STAGE(PG8_SB(0, 0), cB, voffB); PG8_STAGE(PG8_SB(0, 1), cB + hstep, voffB); PG8_STAGE(PG8_SA(0, 0), cA, voffA); PG8_STAGE(PG8_SA(0, 1), cA + hstep, voffA);
        if (wr == 1) PG8_BAR;
        PG8_WAIT_V(2); PG8_BAR;
        PG8_STAGE(PG8_SB(1, 0), cB + kstep, voffB); PG8_STAGE(PG8_SA(1, 0), cA + kstep, voffA); PG8_STAGE(PG8_SB(1, 1), cB + hstep + kstep, voffB);
        PG8_WAIT_V(6); PG8_BAR;
    } else {
        PG8_STAGE(PG8_SB(0, 0), cB, voffB); PG8_STAGE(PG8_SA(0, 0), cA, voffA); PG8_STAGE(PG8_SB(0, 1), cB + hstep, voffB); PG8_STAGE(PG8_SA(0, 1), cA + hstep, voffA);
        if (wr == 1) PG8_BAR;
        PG8_WAIT_V(4); PG8_BAR;
        PG8_STAGE(PG8_SB(1, 0), cB + kstep, voffB); PG8_STAGE(PG8_SA(1, 0), cA + kstep, voffA); PG8_STAGE(PG8_SB(1, 1), cB + hstep + kstep, voffB);
        PG8_WAIT_V(6); PG8_BAR;
    }
    for (;;) {
        const bool has_next = S.next(ui + 1, nxt);
        const char* nA = has_next ? (const char*)g.A + (size_t)nxt.pm * tstep : cA; const char* nB = has_next ? (const char*)g.Bt + (size_t)nxt.pn * tstep : cB;
        for (int t = 0; t < nt; t += 2) {
            const bool last = (t == nt - 2);
            const char* a1 = cA + (size_t)(t + 1) * kstep;
            const char* a2 = last ? nA : cA + (size_t)(t + 2) * kstep; const char* b2 = last ? nB : cB + (size_t)(t + 2) * kstep;
            const char* a3 = a2 + kstep; const char* b3 = b2 + kstep;
            if (last && has_next) S.a_ready(nxt);
            if constexpr (SP2) {
            PG8_LDB(B0, 0, 0); PG8_LDB(B1, 0, 1); PG8_SCHED; PG8_LDA(At, 0, 0); PG8_STAGE(PG8_SA(1, 1), a1 + hstep, voffA);
            PG8_WAIT_V(8); PG8_WAIT_L(0); PG8_BAR; PG8_MMA(0, 0, At, B0); PG8_MMA(0, 1, At, B1); PG8_BAR; PG8_SCHED;
            PG8_LDA(At, 0, 1); PG8_STAGE(PG8_SB(0, 0), b2, voffB); PG8_STAGE(PG8_SB(0, 1), b2 + hstep, voffB); PG8_STAGE(PG8_SA(0, 0), a2, voffA);
            PG8_WAIT_V(8); PG8_WAIT_L(0); PG8_BAR; PG8_MMA(1, 0, At, B0); PG8_MMA(1, 1, At, B1); PG8_BAR; PG8_SCHED;
            PG8_LDB(B0, 1, 0); PG8_LDB(B1, 1, 1); PG8_SCHED; PG8_LDA(At, 1, 0); PG8_STAGE(PG8_SA(0, 1), a2 + hstep, voffA);
            PG8_WAIT_V(8); PG8_WAIT_L(0); PG8_BAR; PG8_MMA(0, 0, At, B0); PG8_MMA(0, 1, At, B1); PG8_BAR; PG8_SCHED;
            PG8_LDA(At, 1, 1); PG8_STAGE(PG8_SB(1, 0), b3, voffB); PG8_STAGE(PG8_SB(1, 1), b3 + hstep, voffB); PG8_STAGE(PG8_SA(1, 0), a3, voffA);
            PG8_WAIT_V(8); PG8_WAIT_L(0); PG8_BAR; PG8_MMA(1, 0, At, B0); PG8_MMA(1, 1, At, B1); PG8_BAR; PG8_SCHED;
            } else {
            PG8_LDB(B0, 0, 0); PG8_SCHED; PG8_LDA(At, 0, 0); PG8_STAGE(PG8_SA(1, 1), a1 + hstep, voffA);
            PG8_WAIT_L(8); PG8_BAR; PG8_WAIT_L(0); PG8_MMA(0, 0, At, B0); PG8_BAR; PG8_SCHED;
            PG8_LDB(B1, 0, 1); PG8_STAGE(PG8_SB(0, 0), b2, voffB);
            PG8_BAR; PG8_WAIT_L(0); PG8_MMA(0, 1, At, B1); PG8_BAR;
            PG8_LDA(At, 0, 1); PG8_STAGE(PG8_SA(0, 0), a2, voffA);
            PG8_BAR; PG8_WAIT_L(0); PG8_MMA(1, 0, At, B0); PG8_BAR; PG8_SCHED;
            PG8_STAGE(PG8_SB(0, 1), b2 + hstep, voffB);
            PG8_WAIT_V(6); PG8_BAR; PG8_MMA(1, 1, At, B1); PG8_BAR;
            PG8_LDB(B0, 1, 0); PG8_SCHED; PG8_LDA(At, 1, 0); PG8_STAGE(PG8_SA(0, 1), a2 + hstep, voffA);
            PG8_WAIT_L(8); PG8_BAR; PG8_WAIT_L(0); PG8_MMA(0, 0, At, B0); PG8_BAR; PG8_SCHED;
            PG8_LDB(B1, 1, 1); PG8_STAGE(PG8_SB(1, 0), b3, voffB);
            PG8_BAR; PG8_WAIT_L(0); PG8_MMA(0, 1, At, B1); PG8_BAR;
            PG8_LDA(At, 1, 1); PG8_STAGE(PG8_SA(1, 0), a3, voffA);
            PG8_BAR; PG8_WAIT_L(0); PG8_MMA(1, 0, At, B0); PG8_BAR; PG8_SCHED;
            PG8_STAGE(PG8_SB(1, 1), b3 + hstep, voffB);
            PG8_WAIT_V(6); PG8_BAR; PG8_MMA(1, 1, At, B1); PG8_BAR;
            }
        }
        if constexpr (ALIGN_EPI) { if (wr == 0) PG8_BAR; }
        if constexpr (!Epi::AFTER_DRAIN) { E(acc, cur, wr, wc, fr, fq); S.done(cur); }
        if (!has_next) break;
#pragma unroll
        for (int a = 0; a < 2; ++a)
#pragma unroll
            for (int b = 0; b < 2; ++b)
#pragma unroll
                for (int m = 0; m < 4; ++m)
#pragma unroll
                    for (int n = 0; n < 2; ++n) acc[a][b][m][n] = (f32x4){0.f, 0.f, 0.f, 0.f};
        cur = nxt; cA = nA; cB = nB; ++ui;
        if constexpr (ALIGN_EPI) { if (wr == 1) PG8_BAR; }
    }
    PG8_WAIT_V(0);
    if constexpr (!ALIGN_EPI) { if (wr == 0) PG8_BAR; }
    PG8_BAR;
    if constexpr (Epi::AFTER_DRAIN) { E.fused(acc, cur, wr, wc, fr, fq, lds, wid, lane); S.done(cur); }
#undef PG8_SA
#undef PG8_SB
#undef PG8_STAGE
#undef PG8_LDA
#undef PG8_LDB
#undef PG8_MMA
#undef PG8_WAIT_V
#undef PG8_WAIT_L
#undef PG8_BAR
#undef PG8_SCHED
}
}
#define XB_TMO      128
#define XB_XCNT(j)  (256  + 64 * (j))
#define XB_XSUB(j)  (1280 + 64 * (j))
#define XB_XGEN(j)  (2304 + 64 * (j))
#define XB_TOP      3328
#define XB_TOPGEN   3392
#define XCD_BAR_WORDS 3456
#define XB_SPIN_CAP (1u << 18)
#define LAS __attribute__((address_space(3)))

__device__ __forceinline__ unsigned xb_ld(unsigned* p)              { return __hip_atomic_load(p, __ATOMIC_RELAXED, __HIP_MEMORY_SCOPE_AGENT); }
__device__ __forceinline__ unsigned xb_add(unsigned* p, unsigned v) { return __hip_atomic_fetch_add(p, v, __ATOMIC_RELAXED, __HIP_MEMORY_SCOPE_AGENT); }
__device__ __forceinline__ unsigned xb_xcc_id() { return (unsigned)__builtin_amdgcn_s_getreg((3 << 11) | 20) & 0xFu; }
#define XB_SPIN(cond, bar) do { unsigned _sp = 0; while (cond) { __builtin_amdgcn_s_sleep(1); \
    if ((++_sp & 255u) == 0u) { if (xb_ld(&(bar)[XB_TMO])) break; if (_sp > XB_SPIN_CAP) { atomicAdd(&(bar)[XB_TMO], 1u); break; } } } } while (0)

struct XcdBarrier {
    unsigned* bar; unsigned x;
    volatile LAS unsigned* st;
};

__device__ __forceinline__ XcdBarrier xcd_barrier_post(unsigned* bar, volatile LAS unsigned* st) {
    XcdBarrier b; b.bar = bar; b.x = xb_xcc_id(); b.st = st;
    if (threadIdx.x == 0) (void)xb_add(&bar[XB_XCNT(b.x)], 1u);
    return b;
}
__device__ __forceinline__ void xcd_barrier_complete(unsigned* bar, unsigned x, unsigned& nloc, unsigned& nx) {
    const unsigned G = gridDim.x * gridDim.y * gridDim.z;
    unsigned sum, cnt, mine, sp = 0u;
    for (;;) {
        sum = 0u; cnt = 0u; mine = 0u;
#pragma unroll
        for (unsigned j = 0; j < 16; ++j) { const unsigned c = xb_ld(&bar[XB_XCNT(j)]); sum += c; cnt += (c > 0u) ? 1u : 0u; mine = (j == x) ? c : mine; }
        if (sum == G) break;
        __builtin_amdgcn_s_sleep(1);
        if ((++sp & 255u) == 0u) { if (xb_ld(&bar[XB_TMO])) break; if (sp > XB_SPIN_CAP) { atomicAdd(&bar[XB_TMO], 1u); break; } }
    }
    nloc = mine > 0u ? mine : 1u; nx = cnt > 0u ? cnt : 1u;
}

__device__ __forceinline__ void xcd_barrier(const XcdBarrier& b) {
    asm volatile("s_waitcnt vmcnt(0)" ::: "memory");
    __syncthreads();
    if (threadIdx.x == 0) {
        unsigned* bar = b.bar;
        __builtin_amdgcn_s_waitcnt(0);
        unsigned nloc = b.st[0], nx = b.st[1];
        if (nloc == 0u) { xcd_barrier_complete(bar, b.x, nloc, nx); b.st[0] = nloc; b.st[1] = nx; }
        const unsigned old = xb_add(&bar[XB_XSUB(b.x)], 1u);
        const unsigned gen = old / nloc;
        if (old + 1u == (gen + 1u) * nloc) {
            __builtin_amdgcn_fence(__ATOMIC_RELEASE, "agent");
            asm volatile("s_waitcnt vmcnt(0)" ::: "memory");
            const unsigned og = xb_add(&bar[XB_TOP], 1u);
            const unsigned tg = og / nx;
            if (og + 1u == (tg + 1u) * nx) xb_add(&bar[XB_TOPGEN], 1u);
            else XB_SPIN(xb_ld(&bar[XB_TOPGEN]) == tg, bar);
            __builtin_amdgcn_fence(__ATOMIC_ACQUIRE, "agent");
            xb_add(&bar[XB_XGEN(b.x)], 1u);
            asm volatile("s_waitcnt vmcnt(0)" ::: "memory");
        } else {
            XB_SPIN(xb_ld(&bar[XB_XGEN(b.x)]) == gen, bar);
            __builtin_amdgcn_fence(__ATOMIC_ACQUIRE, "agent");
            asm volatile("s_waitcnt vmcnt(0)" ::: "memory");
        }
    }
    __syncthreads();
}
#define DI __device__ __forceinline__
#define LAS3 __attribute__((address_space(3)))
using pg8::bf16_t; using pg8::bf16x8; using pg8::f32x4; using pg8::u32x4;
typedef unsigned u32x2 __attribute__((ext_vector_type(2)));
typedef short s16x4 __attribute__((ext_vector_type(4)));
typedef float f32x2 __attribute__((ext_vector_type(2)));
typedef __bf16 bf16x2_t __attribute__((ext_vector_type(2)));

constexpr int DM = 1024, NB = 16, SEQ = 2048, MP = NB * SEQ  , NDB = 32  , MROWS = 33024  ;
constexpr int NMEM = 256, MMEM = NB * NMEM  , DIN = 3412, NIN = 3584, NPAGES = 128;
constexpr int NTHREADS = 512;
constexpr size_t O_YP = 0, O_YS = O_YP + (size_t)MP * DM, O_GSP = O_YS + (size_t)NDB * DM, O_KP = O_GSP + (size_t)NB * 4 * 64 * 128,
                 O_VP = O_KP + (size_t)MP * 256, O_IKP = O_VP + (size_t)MP * 256, O_MKP = O_IKP + (size_t)MP * 64, O_MVP = O_MKP + (size_t)MMEM * 256,
                 O_GSS = O_MVP + (size_t)MMEM * 256, O_KS = O_GSS + (size_t)NDB * 4 * 64 * 128, O_VS = O_KS + (size_t)NDB * 256, O_IKS = O_VS + (size_t)NDB * 256,
                 O_END = O_IKS + (size_t)NDB * 64;
static_assert(O_END == 56150016, "output size");
constexpr size_t al256(size_t x) { return (x + 255) & ~(size_t)255; }
constexpr size_t CTRL_BYTES = 32768;
constexpr size_t CW_QDSA = 16384  , CW_QMEM = 18432  , CW_SCNT = 20480, CW_TMO = 20736, CW_CHK = 20992, CW_TSUM = 21248, CW_TMAX = 21504, CW_MEMC = 21760;
constexpr int SCLD = 16400;
constexpr size_t W_ROPE = CTRL_BYTES;
constexpr size_t W_XN = al256(W_ROPE + (size_t)2049 * 32 * 8);
constexpr size_t W_MEMN = W_XN + (size_t)MROWS * 1024 * 2;
constexpr size_t W_WTIN = W_MEMN + (size_t)MMEM * 1024 * 2;
constexpr size_t W_WTMEM = W_WTIN + (size_t)NIN * 1024 * 2;
constexpr size_t W_WTOUT = W_WTMEM + (size_t)512 * 1024 * 2;
constexpr size_t W_GQ = W_WTOUT + (size_t)1024 * 1024 * 2;
constexpr size_t W_GK = W_GQ + (size_t)MROWS * 256 * 2;
constexpr size_t W_GV = W_GK + (size_t)MROWS * 256 * 2;
constexpr size_t W_GG = W_GV + (size_t)MROWS * 512 * 2;
constexpr size_t W_DQ = W_GG + (size_t)MROWS * 512 * 2;
constexpr size_t W_DK = W_DQ + (size_t)MROWS * 256 * 2;
constexpr size_t W_DVT = W_DK + (size_t)MROWS * 256 * 2;
constexpr size_t W_IQ = W_DVT + (size_t)MP * 256 * 2;
constexpr size_t W_DG = W_IQ + (size_t)MROWS * 256 * 2;
constexpr size_t W_MQ = W_DG + (size_t)MROWS * 256 * 2;
constexpr size_t W_MG = W_MQ + (size_t)MROWS * 256 * 2;
constexpr size_t W_IK = W_MG + (size_t)MROWS * 256 * 2;
constexpr size_t W_IW = W_IK + (size_t)MROWS * 64 * 2;
constexpr size_t W_GLR = W_IW + (size_t)MROWS * 4 * 4;
constexpr size_t W_MK = W_GLR + (size_t)MROWS * 16 * 4;
constexpr size_t W_MVT = W_MK + (size_t)MMEM * 256 * 2;
constexpr size_t W_MIX = W_MVT + (size_t)MMEM * 256 * 2;
constexpr size_t W_SC = W_MIX + (size_t)MROWS * 1024 * 2;
constexpr size_t W_END = W_SC + (size_t)NDB * SCLD * 4;
constexpr int LDS_MISC = 148480, LDS_BYTES = 148480 + 256;

struct Params {
    const float *x_prompt, *x_sample, *mem_prompt, *state_gla, *cache_k, *cache_v, *cache_ik, *cache_mem_k, *cache_mem_v;
    const int* page_table;
    const float *norm_in, *w_in, *w_g2, *b_g, *onorm, *mem_norm, *w_mem_kv, *w_out, *norm_final;
    float* out; unsigned char* ws; int ph_lo, ph_hi;
};

#ifdef TSEL
#define TDECL unsigned tacc_ = 0u, tbeg_ = 0u
#define TBEG(k) do { if ((k) == TSEL) tbeg_ = (unsigned)__builtin_amdgcn_s_memrealtime(); } while (0)
#define TEND(k) do { if ((k) == TSEL) tacc_ += (unsigned)__builtin_amdgcn_s_memrealtime() - tbeg_; } while (0)
#define TARGS , unsigned& tacc_, unsigned& tbeg_
#define TPASS , tacc_, tbeg_
#else
#define TARGS
#define TPASS
#define TDECL do {} while (0)
#define TBEG(k) do {} while (0)
#define TEND(k) do {} while (0)
#endif
DI float bf2f(bf16_t v) { return __uint_as_float((unsigned)v << 16); }
DI unsigned cvtpk(float lo, float hi) { f32x2 v = {lo, hi}; bf16x2_t b = __builtin_convertvector(v, bf16x2_t); return __builtin_bit_cast(unsigned, b); }
DI bf16_t f2bf(float x) { return (bf16_t)(cvtpk(x, 0.f) & 0xffffu); }
DI f32x4 mfma16(bf16x8 a, bf16x8 b, f32x4 c) { return __builtin_amdgcn_mfma_f32_16x16x32_bf16(a, b, c, 0, 0, 0); }
DI float fexp(float x) { return __builtin_amdgcn_exp2f(x * 1.4426950408889634f); }
DI float siluf(float x) { return x * __builtin_amdgcn_rcpf(1.f + fexp(-x)); }
DI float logsigf(float u) { return fminf(u, 0.f) - 0.6931471805599453f * __builtin_amdgcn_logf(1.f + fexp(-fabsf(u))); }
DI unsigned fkey(float x) { unsigned u = __float_as_uint(x); u = (u == 0x80000000u) ? 0u : u; return u ^ ((unsigned)((int)u >> 31) | 0x80000000u); }
DI float wsum64(float v) { v += __shfl_xor(v, 1); v += __shfl_xor(v, 2); v += __shfl_xor(v, 4); v += __shfl_xor(v, 8); v += __shfl_xor(v, 16); v += __shfl_xor(v, 32); return v; }
DI float wmax64(float v) { v = fmaxf(v, __shfl_xor(v, 1)); v = fmaxf(v, __shfl_xor(v, 2)); v = fmaxf(v, __shfl_xor(v, 4)); v = fmaxf(v, __shfl_xor(v, 8)); v = fmaxf(v, __shfl_xor(v, 16)); v = fmaxf(v, __shfl_xor(v, 32)); return v; }
DI unsigned lds_add(LAS3 unsigned* p, unsigned v) { return __hip_atomic_fetch_add(p, v, __ATOMIC_RELAXED, __HIP_MEMORY_SCOPE_WORKGROUP); }
DI unsigned lds_or(LAS3 unsigned* p, unsigned v) { return __hip_atomic_fetch_or(p, v, __ATOMIC_RELAXED, __HIP_MEMORY_SCOPE_WORKGROUP); }
DI void st_bf16x4(bf16_t* p, f32x4 v) { u32x2 w; w.x = cvtpk(v[0], v[1]); w.y = cvtpk(v[2], v[3]); *(u32x2*)p = w; }
DI const float* vaddr(const float* q) { asm volatile("" : "+v"(q)); return q; }
constexpr float LOG2E = 1.4426950408889634f;
#define NEG_INF (-__builtin_inff())

DI int rope_perm(int vc) { return 64 * (vc >> 6) + 16 * ((vc >> 5) & 1) + (vc & 15) + 32 * ((vc >> 4) & 1); }
DI int rope_map(int vc) { return 64 * ((vc >> 5) & 3) + 32 * ((vc >> 4) & 1) + 8 * ((vc >> 2) & 3) + 4 * (vc >> 7) + (vc & 3); }
DI int plain_map(int vc) { return (vc & ~31) + 8 * ((vc >> 2) & 3) + 4 * ((vc >> 4) & 1) + (vc & 3); }
DI int in_src(int np) {
    const int pn = np >> 8, vc = np & 255;
    switch (pn) {
        case 0: return plain_map(vc);
        case 1: return 256 + plain_map(vc);
        case 2: case 3: return 512 + 256 * (pn - 2) + plain_map(vc);
        case 4: case 5: return 1040 + 256 * (pn - 4) + plain_map(vc);
        case 6: return 1552 + rope_map(vc);
        case 7: return 1808 + rope_map(vc);
        case 8: return 2064 + plain_map(vc);
        case 9: return 2320 + rope_map(vc);
        case 10: return 2644 + plain_map(vc);
        case 11: return 2900 + plain_map(vc);
        case 12: return 3156 + plain_map(vc);
        default: break;
    }
    if (vc < 64) return 2576 + rope_perm(vc);
    if (vc < 68) return 2640 + (vc - 64);
    if (vc < 84) return 1024 + (vc - 68);
    return -1;
}

struct EpiIn {
    static constexpr bool PERM = false, AFTER_DRAIN = false;
    unsigned char* ws; float* out;
    DI void operator()(const f32x4 (&acc)[2][2][4][2], const pg8::Unit& u, int wr, int wc, int fr, int fq) const {
        const int pn = u.pn, rbase = u.pm * 256 + wr * 64 + fr;
        if (pn <= 5 || (pn >= 10 && pn <= 12)) {
            bf16_t* dst; int ldc = 256, coff = 0; float sc = 1.f; bool silu = false;
            switch (pn) {
                case 0: dst = (bf16_t*)(ws + W_GQ); sc = 0.125f; break;
                case 1: dst = (bf16_t*)(ws + W_GK); break;
                case 2: dst = (bf16_t*)(ws + W_GV); ldc = 512; break;
                case 3: dst = (bf16_t*)(ws + W_GV); ldc = 512; coff = 256; break;
                case 4: dst = (bf16_t*)(ws + W_GG); ldc = 512; silu = true; break;
                case 5: dst = (bf16_t*)(ws + W_GG); ldc = 512; coff = 256; silu = true; break;
                case 10: dst = (bf16_t*)(ws + W_DG); silu = true; break;
                case 11: dst = (bf16_t*)(ws + W_MQ); sc = 0.125f * LOG2E; break;
                default: dst = (bf16_t*)(ws + W_MG); silu = true; break;
            }
#pragma unroll
            for (int ai = 0; ai < 2; ++ai)
#pragma unroll
                for (int m = 0; m < 4; ++m) {
                    const int row = rbase + ai * 128 + m * 16;
                    bf16_t* rp = dst + (size_t)row * ldc + coff + wc * 32 + 8 * fq;
#pragma unroll
                    for (int bj = 0; bj < 2; ++bj) {
                        f32x4 v0 = acc[ai][bj][m][0], v1 = acc[ai][bj][m][1];
                        if (silu) { v0[0] = siluf(v0[0]); v0[1] = siluf(v0[1]); v0[2] = siluf(v0[2]); v0[3] = siluf(v0[3]); v1[0] = siluf(v1[0]); v1[1] = siluf(v1[1]); v1[2] = siluf(v1[2]); v1[3] = siluf(v1[3]); }
                        else { v0 = v0 * sc; v1 = v1 * sc; }
                        u32x4 w; w.x = cvtpk(v0[0], v0[1]); w.y = cvtpk(v0[2], v0[3]); w.z = cvtpk(v1[0], v1[1]); w.w = cvtpk(v1[2], v1[3]);
                        *(u32x4*)(rp + bj * 128) = w;
                    }
                }
        } else if (pn == 6 || pn == 7 || pn == 9) {
            bf16_t* dst = (bf16_t*)(ws + (pn == 6 ? W_DQ : (pn == 7 ? W_DK : W_IQ)));
            const float sc = (pn == 6) ? 0.125f * LOG2E : 1.f;
            const float* rope = (const float*)(ws + W_ROPE);
#pragma unroll
            for (int ai = 0; ai < 2; ++ai)
#pragma unroll
                for (int m = 0; m < 4; ++m) {
                    const int row = rbase + ai * 128 + m * 16;
                    const int pi = row < MP ? (row & 2047) : 2048;
                    const float* rp = rope + ((size_t)pi * 32 + 8 * fq) * 2;
                    f32x4 o1[2], o2[2];
#pragma unroll
                    for (int bj = 0; bj < 2; ++bj) {
                        const f32x4 cs0 = *(const f32x4*)(rp + 8 * bj), cs1 = *(const f32x4*)(rp + 8 * bj + 4);
                        const f32x4 c = {cs0[0], cs0[2], cs1[0], cs1[2]}, s = {cs0[1], cs0[3], cs1[1], cs1[3]};
                        const f32x4 v0 = acc[ai][bj][m][0], v1 = acc[ai][bj][m][1];
                        o1[bj] = (v0 * c - v1 * s) * sc; o2[bj] = (v1 * c + v0 * s) * sc;
                    }
                    const int col1 = 64 * wc + 8 * fq, col2 = col1 + 32;
                    u32x4 w1, w2; w1.x = cvtpk(o1[0][0], o1[0][1]); w1.y = cvtpk(o1[0][2], o1[0][3]); w1.z = cvtpk(o1[1][0], o1[1][1]); w1.w = cvtpk(o1[1][2], o1[1][3]);
                    w2.x = cvtpk(o2[0][0], o2[0][1]); w2.y = cvtpk(o2[0][2], o2[0][3]); w2.z = cvtpk(o2[1][0], o2[1][1]); w2.w = cvtpk(o2[1][2], o2[1][3]);
                    *(u32x4*)(dst + (size_t)row * 256 + col1) = w1; *(u32x4*)(dst + (size_t)row * 256 + col2) = w2;
                    if (pn == 7) {
                        float* op = nullptr;
                        if (row < MP) op = out + O_KP + (size_t)row * 256; else if (row < MP + NDB) op = out + O_KS + (size_t)(row - MP) * 256;
                        if (op) { *(f32x4*)(op + col1) = o1[0]; *(f32x4*)(op + col1 + 4) = o1[1]; *(f32x4*)(op + col2) = o2[0]; *(f32x4*)(op + col2 + 4) = o2[1]; }
                    }
                }
        } else if (pn == 8) {
            bf16_t* dvt = (bf16_t*)(ws + W_DVT);
#pragma unroll
            for (int ai = 0; ai < 2; ++ai)
#pragma unroll
                for (int m = 0; m < 4; ++m) {
                    const int row = rbase + ai * 128 + m * 16;
                    float* op = nullptr;
                    if (row < MP) op = out + O_VP + (size_t)row * 256; else if (row < MP + NDB) op = out + O_VS + (size_t)(row - MP) * 256;
#pragma unroll
                    for (int bj = 0; bj < 2; ++bj)
#pragma unroll
                        for (int n = 0; n < 2; ++n) {
                            const f32x4 v = acc[ai][bj][m][n];
                            const int col = 128 * bj + 32 * wc + 8 * fq + 4 * n;
                            if (op) *(f32x4*)(op + col) = v;
                            if (row < MP) {
                                const int t_ = row & 2047, kk_ = t_ & 31;
                                bf16_t* tp = dvt + ((((size_t)(row >> 11) * 64 + (t_ >> 5)) * 4 + (col >> 6)) * 64 + (col & 63)) * 32 + 8 * ((kk_ >> 2) & 3) + 4 * (kk_ >> 4) + (kk_ & 3);
                                tp[0] = f2bf(v[0]); tp[32] = f2bf(v[1]); tp[64] = f2bf(v[2]); tp[96] = f2bf(v[3]);
                            }
                        }
                }
        } else {
            bf16_t* ikb = (bf16_t*)(ws + W_IK); float* iw = (float*)(ws + W_IW); float* glr = (float*)(ws + W_GLR);
            const float* rope = (const float*)(ws + W_ROPE);
#pragma unroll
            for (int ai = 0; ai < 2; ++ai)
#pragma unroll
                for (int m = 0; m < 4; ++m) {
                    const int row = rbase + ai * 128 + m * 16;
                    const f32x4 v0 = acc[ai][0][m][0], v1 = acc[ai][0][m][1];
                    if (wc < 2) {
                        const int pi = row < MP ? (row & 2047) : 2048;
                        const int f0 = 16 * wc + 4 * fq;
                        const f32x4 cs0 = *(const f32x4*)(rope + ((size_t)pi * 32 + f0) * 2), cs1 = *(const f32x4*)(rope + ((size_t)pi * 32 + f0) * 2 + 4);
                        const f32x4 c = {cs0[0], cs0[2], cs1[0], cs1[2]}, s = {cs0[1], cs0[3], cs1[1], cs1[3]};
                        const f32x4 o1 = v0 * c - v1 * s, o2 = v1 * c + v0 * s;
                        st_bf16x4(ikb + (size_t)row * 64 + f0, o1); st_bf16x4(ikb + (size_t)row * 64 + f0 + 32, o2);
                        float* op = nullptr;
                        if (row < MP) op = out + O_IKP + (size_t)row * 64; else if (row < MP + NDB) op = out + O_IKS + (size_t)(row - MP) * 64;
                        if (op) { *(f32x4*)(op + f0) = o1; *(f32x4*)(op + f0 + 32) = o2; }
                    } else if (wc == 2) {
                        if (fq == 0) { *(f32x4*)(iw + (size_t)row * 4) = v0 * 0.5f; *(f32x4*)(glr + (size_t)row * 16 + 12) = v1; }
                        else *(f32x4*)(glr + (size_t)row * 16 + 4 * (fq - 1)) = v0;
                    }
                }
        }
    }
};
struct EpiMem {
    static constexpr bool PERM = false, AFTER_DRAIN = false;
    unsigned char* ws; float* out;
    DI void operator()(const f32x4 (&acc)[2][2][4][2], const pg8::Unit& u, int wr, int wc, int fr, int fq) const {
        const int pn = u.pn, rbase = u.pm * 256 + wr * 64 + fr;
        bf16_t* mk = (bf16_t*)(ws + W_MK); bf16_t* mvt = (bf16_t*)(ws + W_MVT);
        float* op0 = out + (pn == 0 ? O_MKP : O_MVP);
#pragma unroll
        for (int ai = 0; ai < 2; ++ai)
#pragma unroll
            for (int m = 0; m < 4; ++m) {
                const int row = rbase + ai * 128 + m * 16;
#pragma unroll
                for (int bj = 0; bj < 2; ++bj)
#pragma unroll
                    for (int n = 0; n < 2; ++n) {
                        const f32x4 v = acc[ai][bj][m][n];
                        const int col = 128 * bj + 32 * wc + 16 * n + 4 * fq;
                        *(f32x4*)(op0 + (size_t)row * 256 + col) = v;
                        if (pn == 0) st_bf16x4(mk + (size_t)row * 256 + col, v);
                        else { const int m_ = row & 255, kk_ = m_ & 31;
                               bf16_t* tp = mvt + ((((size_t)(row >> 8) * 8 + (m_ >> 5)) * 4 + (col >> 6)) * 64 + (col & 63)) * 32 + 8 * ((kk_ >> 2) & 3) + 4 * (kk_ >> 4) + (kk_ & 3);
                               tp[0] = f2bf(v[0]); tp[32] = f2bf(v[1]); tp[64] = f2bf(v[2]); tp[96] = f2bf(v[3]); }
                    }
            }
    }
};
struct EpiOut {
    static constexpr bool PERM = false, AFTER_DRAIN = false;
    const float* xp; const float* xs; float* out;
    DI void operator()(const f32x4 (&acc)[2][2][4][2], const pg8::Unit& u, int wr, int wc, int fr, int fq) const {
        const int rbase = u.pm * 256 + wr * 64 + fr, cbase = u.pn * 256 + wc * 32 + 4 * fq;
#pragma unroll
        for (int ai = 0; ai < 2; ++ai) {
            f32x4 xv[4][2][2];
#pragma unroll
            for (int m = 0; m < 4; ++m) {
                const float* xr = xp + (size_t)(rbase + ai * 128 + m * 16) * DM + cbase;
#pragma unroll
                for (int bj = 0; bj < 2; ++bj)
#pragma unroll
                    for (int n = 0; n < 2; ++n) xv[m][bj][n] = *(const f32x4*)(xr + bj * 128 + n * 16);
            }
#pragma unroll
            for (int m = 0; m < 4; ++m) {
                float* orow = out + O_YP + (size_t)(rbase + ai * 128 + m * 16) * DM + cbase;
#pragma unroll
                for (int bj = 0; bj < 2; ++bj)
#pragma unroll
                    for (int n = 0; n < 2; ++n) *(f32x4*)(orow + bj * 128 + n * 16) = acc[ai][bj][m][n] + xv[m][bj][n];
            }
        }
    }
};
DI void p0_prologue(const Params& p, LAS3 unsigned char* lds) {
    const int tid = threadIdx.x, lane = tid & 63, wv = tid >> 6;
    unsigned char* ws = p.ws;
    {
        const int rstep = gridDim.x * 16, rend = MROWS + MMEM;
        int r0 = (blockIdx.x * 8 + wv) * 2;
        auto row_src = [&](int r) -> const float* {
            r = r < rend ? r : rend - 1;
            if (r < MP) return p.x_prompt + (size_t)r * DM;
            if (r < MP + NDB) return p.x_sample + (size_t)(r - MP) * DM;
            if (r < MROWS) return p.x_prompt;
            return p.mem_prompt + (size_t)(r - MROWS) * DM;
        };
        f32x4 v[2][4], vn[2][4];
#pragma unroll
        for (int e = 0; e < 2; ++e) { const float* s = row_src(r0 + e);
#pragma unroll
            for (int i = 0; i < 4; ++i) v[e][i] = *(const f32x4*)(s + i * 256 + lane * 4); }
        for (; r0 < rend; r0 += rstep) {
#pragma unroll
            for (int e = 0; e < 2; ++e) { const float* s = row_src(r0 + rstep + e);
#pragma unroll
                for (int i = 0; i < 4; ++i) vn[e][i] = *(const f32x4*)(s + i * 256 + lane * 4); }
#pragma unroll
            for (int e = 0; e < 2; ++e) {
                const int r = r0 + e;
                const bool pad = (r >= MP + NDB && r < MROWS);
                const float* g = r < MROWS ? p.norm_in : p.mem_norm;
                bf16_t* dst = r < MROWS ? (bf16_t*)(ws + W_XN) + (size_t)r * DM : (bf16_t*)(ws + W_MEMN) + (size_t)(r - MROWS) * DM;
                float ss = 0.f;
#pragma unroll
                for (int i = 0; i < 4; ++i) ss += v[e][i][0] * v[e][i][0] + v[e][i][1] * v[e][i][1] + v[e][i][2] * v[e][i][2] + v[e][i][3] * v[e][i][3];
                ss = wsum64(ss);
                const float rstd = pad ? 0.f : rsqrtf(ss * (1.f / DM) + 1e-6f);
#pragma unroll
                for (int i = 0; i < 4; ++i) { const f32x4 gv = *(const f32x4*)(g + i * 256 + lane * 4); st_bf16x4(dst + i * 256 + lane * 4, v[e][i] * rstd * gv); }
            }
#pragma unroll
            for (int e = 0; e < 2; ++e)
#pragma unroll
                for (int i = 0; i < 4; ++i) v[e][i] = vn[e][i];
        }
    }
    for (int e = blockIdx.x * NTHREADS + tid; e < 2049 * 32; e += gridDim.x * NTHREADS) {
        const int pi = e >> 5, f = e & 31;
        const float inv = powf(10000.0f, -(float)(2 * f) / 64.0f);
        const float ang = (float)(pi == 2048 ? 16384 : pi) * inv;
        float sn, cs; sincosf(ang, &sn, &cs);
        ((f32x2*)(ws + W_ROPE))[e] = (f32x2){cs, sn};
    }
    LAS3 float* tl = (LAS3 float*)lds;
    {
        auto tile_load = [&](int tile, float (&wr)[8]) {
            tile = tile < 1280 ? tile : 1279;
            int which, t2, ld; const float* W;
            if (tile < 896) { which = 0; t2 = tile; W = p.w_in; ld = DIN; }
            else if (tile < 1024) { which = 1; t2 = tile - 896; W = p.w_mem_kv; ld = 512; }
            else { which = 2; t2 = tile - 1024; W = p.w_out; ld = 1024; }
            const int nt = t2 >> 4, kt = t2 & 15;
            const int nn = tid & 63, kk0 = tid >> 6; const int np = nt * 64 + nn; int sc = which == 0 ? in_src(np) : np;
            const bool zero = sc < 0; sc = zero ? 0 : sc;
#pragma unroll
            for (int i = 0; i < 8; ++i) { const float w = W[(size_t)(kt * 64 + kk0 + 8 * i) * ld + sc]; wr[i] = zero ? 0.f : w; }
        };
        float wr[8], wn[8];
        tile_load(blockIdx.x, wr);
        for (int tile = blockIdx.x; tile < 1280; tile += gridDim.x) {
            bf16_t* dst; int t2;
            if (tile < 896) { t2 = tile; dst = (bf16_t*)(ws + W_WTIN); }
            else if (tile < 1024) { t2 = tile - 896; dst = (bf16_t*)(ws + W_WTMEM); }
            else { t2 = tile - 1024; dst = (bf16_t*)(ws + W_WTOUT); }
            const int nt = t2 >> 4, kt = t2 & 15;
            { const int nn = tid & 63, kk0 = tid >> 6;
#pragma unroll
              for (int i = 0; i < 8; ++i) tl[(kk0 + 8 * i) * 65 + nn] = wr[i]; }
            __syncthreads();
            tile_load(tile + gridDim.x, wn);
            { const int kk = tid & 63, nn0 = tid >> 6;
#pragma unroll
              for (int i = 0; i < 8; ++i) { const int n = nn0 + 8 * i; dst[(size_t)(nt * 64 + n) * 1024 + kt * 64 + kk] = f2bf(tl[kk * 65 + n]); } }
            __syncthreads();
#pragma unroll
            for (int i = 0; i < 8; ++i) wr[i] = wn[i];
        }
    }
}

DI void cnt_ge(unsigned& c, unsigned key, unsigned cand) { asm volatile("v_cmp_ge_u32 vcc, %1, %2\n\tv_addc_co_u32 %0, vcc, 0, %0, vcc" : "+v"(c) : "v"(key), "v"(cand) : "vcc"); }
DI void cnt_gt(unsigned& c, unsigned key, unsigned cand) { asm volatile("v_cmp_gt_u32 vcc, %1, %2\n\tv_addc_co_u32 %0, vcc, 0, %0, vcc" : "+v"(c) : "v"(key), "v"(cand) : "vcc"); }
DI void cnt_eq_lt(unsigned& c, unsigned key, unsigned T, unsigned idx, unsigned cand) {
    unsigned tmp;
    asm volatile("v_cmp_eq_u32 vcc, %2, %3\n\tv_cndmask_b32 %1, -1, %4, vcc\n\tv_cmp_lt_u32 vcc, %1, %5\n\tv_addc_co_u32 %0, vcc, 0, %0, vcc" : "+v"(c), "=&v"(tmp) : "v"(key), "v"(T), "v"(idx), "v"(cand) : "vcc"); }
DI unsigned grp_count16(unsigned c, LAS3 unsigned* CNT, int& it, int fr, int lane) {
    c += __shfl_xor(c, 16); c += __shfl_xor(c, 32);
    LAS3 unsigned* cur = CNT + (it % 3) * 16;
    if (lane < 16) lds_add(cur + fr, c);
    __syncthreads();
    const unsigned tot = cur[fr];
    if (threadIdx.x < 16) CNT[((it + 2) % 3) * 16 + threadIdx.x] = 0u;
    ++it; return tot;
}
DI unsigned blk_count(unsigned c, LAS3 unsigned* CNT, int& it, int lane) {
    c += __shfl_xor(c, 1); c += __shfl_xor(c, 2); c += __shfl_xor(c, 4); c += __shfl_xor(c, 8); c += __shfl_xor(c, 16); c += __shfl_xor(c, 32);
    LAS3 unsigned* cur = CNT + (it % 3) * 16;
    if (lane == 0) lds_add(cur, c);
    __syncthreads();
    const unsigned tot = cur[0];
    if (threadIdx.x == 0) CNT[((it + 2) % 3) * 16] = 0u;
    ++it; return tot;
}

DI float fmax3(float a, float b2, float c) { float d; asm("v_max3_f32 %0, %1, %2, %3" : "=v"(d) : "v"(a), "v"(b2), "v"(c)); return d; }
DI float mask_sel(int allones, float s) { return __uint_as_float(((unsigned)allones & __float_as_uint(s)) | (~(unsigned)allones & 0xff800000u)); }
DI float rowmax4(float x) {
    auto r = __builtin_amdgcn_permlane16_swap(__float_as_uint(x), __float_as_uint(x), false, false);
    const float y = fmax3(__uint_as_float(r[0]), __uint_as_float(r[1]), NEG_INF);
    r = __builtin_amdgcn_permlane32_swap(__float_as_uint(y), __float_as_uint(y), false, false);
    return fmax3(__uint_as_float(r[0]), __uint_as_float(r[1]), NEG_INF);
}
DI float rowsum4(float x) {
    auto r = __builtin_amdgcn_permlane16_swap(__float_as_uint(x), __float_as_uint(x), false, false);
    const float y = __uint_as_float(r[0]) + __uint_as_float(r[1]);
    r = __builtin_amdgcn_permlane32_swap(__float_as_uint(y), __float_as_uint(y), false, false);
    return __uint_as_float(r[0]) + __uint_as_float(r[1]);
}
DI void attn64s(const LAS3 bf16x8* QL  , const bf16_t* K, int ldk, const bf16_t* Vt, int ldv, int kb0, int nk, int nkbv,
                const LAS3 unsigned* mask, int fr, int fq, f32x4 (&o)[4][4], float (&l)[4], float (&mref)[4]) {
    bool mset[4] = {false, false, false, false};
    const f32x4 zero = {0.f, 0.f, 0.f, 0.f};
    float cneg[4] = {0.f, 0.f, 0.f, 0.f};
#pragma unroll
    for (int qt = 0; qt < 4; ++qt) { l[qt] = 0.f;
#pragma unroll
        for (int dt = 0; dt < 4; ++dt) o[dt][qt] = zero; }
    const bf16_t* kl = K + (size_t)fr * ldk + fq * 8;
    const bf16_t* vl = Vt + fr * 32 + 8 * fq;
    bf16x8 kfA[2][2], vA[4];
#define ATT_LOADK(KF, kb_) do { const int kc_ = (kb_) < 63 ? (kb_) : 63; \
        _Pragma("unroll") for (int i2 = 0; i2 < 2; ++i2) _Pragma("unroll") for (int ks = 0; ks < 2; ++ks) KF[i2][ks] = *(const bf16x8*)(kl + (size_t)(32 * kc_ + 16 * i2) * ldk + ks * 32); } while (0)
#define ATT_LOADV(VF, kb_) do { const int kc_ = (kb_) < 63 ? (kb_) : 63; \
        _Pragma("unroll") for (int dt = 0; dt < 4; ++dt) VF[dt] = *(const bf16x8*)(vl + (size_t)kc_ * ldv + 512 * dt); } while (0)
#define ATT_PAIR(KF, VF, kb_, Q0, AFTER_QK) do {   \
        f32x4 s0[2], s1[2], p0[2], p1[2]; float mx[2]; bool need[2]; \
        unsigned qlo_ = (unsigned)(uintptr_t)QL; asm volatile("" : "+v"(qlo_)); const LAS3 bf16x8* ql_ = (const LAS3 bf16x8*)(uintptr_t)qlo_;     \
        _Pragma("unroll") for (int qq = 0; qq < 2; ++qq) { const bf16x8 qa = ql_[((Q0 + qq) * 2) * 64], qb = ql_[((Q0 + qq) * 2 + 1) * 64];     \
            const f32x4 cq = {cneg[Q0 + qq], cneg[Q0 + qq], cneg[Q0 + qq], cneg[Q0 + qq]}; \
            s0[qq] = mfma16(KF[0][0], qa, cq); s0[qq] = mfma16(KF[0][1], qb, s0[qq]); \
            s1[qq] = mfma16(KF[1][0], qa, cq); s1[qq] = mfma16(KF[1][1], qb, s1[qq]); } \
        AFTER_QK; \
        _Pragma("unroll") for (int qq = 0; qq < 2; ++qq) { \
            unsigned mw = mask[(16 * (Q0 + qq) + fr) * 65 + ((kb_) < 63 ? (kb_) : 63)]; mw = (kb_) < nkbv ? mw : 0u; const int b0 = (int)(mw >> (2 * fq)), b1 = (int)(mw >> (8 + 2 * fq)); \
            _Pragma("unroll") for (int r = 0; r < 4; ++r) { const int sh_ = (r >> 1) + 16 * (r & 1); s0[qq][r] = mask_sel(__builtin_amdgcn_sbfe(b0, sh_, 1), s0[qq][r]); s1[qq][r] = mask_sel(__builtin_amdgcn_sbfe(b1, sh_, 1), s1[qq][r]); } \
              \
            mx[qq] = rowmax4(fmax3(fmax3(s0[qq][0], s0[qq][1], s0[qq][2]), fmax3(s0[qq][3], s1[qq][0], s1[qq][1]), fmax3(s1[qq][2], s1[qq][3], NEG_INF))); \
            need[qq] = (mx[qq] > 8.f) | (!mset[Q0 + qq] & (mx[qq] > NEG_INF)); } \
        if (__any(need[0] | need[1])) { \
            _Pragma("unroll") for (int qq = 0; qq < 2; ++qq) { \
                const float delta = need[qq] ? mx[qq] : 0.f, alpha = __builtin_amdgcn_exp2f(-delta); \
                _Pragma("unroll") for (int r = 0; r < 4; ++r) { p0[qq][r] = __builtin_amdgcn_exp2f(s0[qq][r] - delta); p1[qq][r] = __builtin_amdgcn_exp2f(s1[qq][r] - delta); } \
                l[Q0 + qq] = l[Q0 + qq] * alpha + (((p0[qq][0] + p0[qq][1]) + (p0[qq][2] + p0[qq][3])) + ((p1[qq][0] + p1[qq][1]) + (p1[qq][2] + p1[qq][3]))); \
                _Pragma("unroll") for (int dt = 0; dt < 4; ++dt) o[dt][Q0 + qq] = o[dt][Q0 + qq] * alpha; \
                cneg[Q0 + qq] = cneg[Q0 + qq] - delta; mset[Q0 + qq] = mset[Q0 + qq] | need[qq]; } \
        } else { \
            _Pragma("unroll") for (int qq = 0; qq < 2; ++qq) { \
                _Pragma("unroll") for (int r = 0; r < 4; ++r) { p0[qq][r] = __builtin_amdgcn_exp2f(s0[qq][r]); p1[qq][r] = __builtin_amdgcn_exp2f(s1[qq][r]); } \
                l[Q0 + qq] += ((p0[qq][0] + p0[qq][1]) + (p0[qq][2] + p0[qq][3])) + ((p1[qq][0] + p1[qq][1]) + (p1[qq][2] + p1[qq][3])); } \
        } \
        _Pragma("unroll") for (int qq = 0; qq < 2; ++qq) { \
            u32x4 pw; pw.x = cvtpk(p0[qq][0], p0[qq][1]); pw.y = cvtpk(p0[qq][2], p0[qq][3]); pw.z = cvtpk(p1[qq][0], p1[qq][1]); pw.w = cvtpk(p1[qq][2], p1[qq][3]); \
            const bf16x8 pf = __builtin_bit_cast(bf16x8, pw); \
            _Pragma("unroll") for (int dt = 0; dt < 4; ++dt) o[dt][Q0 + qq] = mfma16(VF[dt], pf, o[dt][Q0 + qq]); } } while (0)
    ATT_LOADK(kfA, kb0); ATT_LOADV(vA, kb0);
#define SBAR() __builtin_amdgcn_sched_barrier(0)
#pragma unroll 1
    for (int i = 0; i < nk; ++i) {
        const int ka = kb0 + 2 * i;
        ATT_PAIR(kfA, vA, ka, 0, SBAR()); SBAR();
        ATT_PAIR(kfA, vA, ka, 2, do { SBAR(); ATT_LOADK(kfA, ka + 2); SBAR(); } while (0)); SBAR();
        ATT_LOADV(vA, ka + 2); SBAR();
    }
#undef SBAR
#undef ATT_LOADK
#undef ATT_LOADV
#undef ATT_PAIR
#pragma unroll
    for (int qt = 0; qt < 4; ++qt) { l[qt] = rowsum4(l[qt]); mref[qt] = mset[qt] ? -cneg[qt] : NEG_INF; }
}
DI void attn64m(const LAS3 bf16x8* QL, const bf16_t* kl, int ldk, const bf16_t* vl, int ldv, int kb0, bf16x8 (&kfA)[2][2], bf16x8 (&kfB)[2][2], bf16x8 (&vA)[4], bf16x8 (&vB)[4]  ,
                f32x4 (&o)[4][4], float (&l)[4], float (&mref)[4]) {
    bool mset[4] = {false, false, false, false};
    const f32x4 zero = {0.f, 0.f, 0.f, 0.f};
    float cneg[4] = {0.f, 0.f, 0.f, 0.f};
#pragma unroll
    for (int qt = 0; qt < 4; ++qt) { l[qt] = 0.f;
#pragma unroll
        for (int dt = 0; dt < 4; ++dt) o[dt][qt] = zero; }
#define ATM_LOAD(KF, VF, kb_) do { const int kc_ = (kb_) < 7 ? (kb_) : 7; \
        _Pragma("unroll") for (int i2 = 0; i2 < 2; ++i2) _Pragma("unroll") for (int ks = 0; ks < 2; ++ks) KF[i2][ks] = *(const bf16x8*)(kl + (size_t)(32 * kc_ + 16 * i2) * ldk + ks * 32); \
        _Pragma("unroll") for (int dt = 0; dt < 4; ++dt) VF[dt] = *(const bf16x8*)(vl + (size_t)kc_ * ldv + 512 * dt); } while (0)
#define ATM_PAIR(KF, VF, Q0) do { \
        f32x4 s0[2], s1[2], p0[2], p1[2]; float mx[2]; bool need[2]; \
        unsigned qlo_ = (unsigned)(uintptr_t)QL; asm volatile("" : "+v"(qlo_)); const LAS3 bf16x8* ql_ = (const LAS3 bf16x8*)(uintptr_t)qlo_; \
        _Pragma("unroll") for (int qq = 0; qq < 2; ++qq) { const bf16x8 qa = ql_[((Q0 + qq) * 2) * 64], qb = ql_[((Q0 + qq) * 2 + 1) * 64]; \
            const f32x4 cq = {cneg[Q0 + qq], cneg[Q0 + qq], cneg[Q0 + qq], cneg[Q0 + qq]}; \
            s0[qq] = mfma16(KF[0][0], qa, cq); s0[qq] = mfma16(KF[0][1], qb, s0[qq]); \
            s1[qq] = mfma16(KF[1][0], qa, cq); s1[qq] = mfma16(KF[1][1], qb, s1[qq]); } \
        _Pragma("unroll") for (int qq = 0; qq < 2; ++qq) {   \
            mx[qq] = rowmax4(fmax3(fmax3(__builtin_amdgcn_fmed3f(s0[qq][0], s0[qq][1], -NEG_INF), __builtin_amdgcn_fmed3f(s0[qq][2], s0[qq][3], -NEG_INF), __builtin_amdgcn_fmed3f(s1[qq][0], s1[qq][1], -NEG_INF)), __builtin_amdgcn_fmed3f(s1[qq][2], s1[qq][3], -NEG_INF), NEG_INF)); \
            need[qq] = (mx[qq] > 8.f) | (!mset[Q0 + qq] & (mx[qq] > NEG_INF)); } \
        if (__any(need[0] | need[1])) { \
            _Pragma("unroll") for (int qq = 0; qq < 2; ++qq) { \
                const float delta = need[qq] ? mx[qq] : 0.f, alpha = __builtin_amdgcn_exp2f(-delta); \
                _Pragma("unroll") for (int r = 0; r < 4; ++r) { p0[qq][r] = __builtin_amdgcn_exp2f(s0[qq][r] - delta); p1[qq][r] = __builtin_amdgcn_exp2f(s1[qq][r] - delta); } \
                l[Q0 + qq] = l[Q0 + qq] * alpha + (((p0[qq][0] + p0[qq][1]) + (p0[qq][2] + p0[qq][3])) + ((p1[qq][0] + p1[qq][1]) + (p1[qq][2] + p1[qq][3]))); \
                _Pragma("unroll") for (int dt = 0; dt < 4; ++dt) o[dt][Q0 + qq] = o[dt][Q0 + qq] * alpha; \
                cneg[Q0 + qq] = cneg[Q0 + qq] - delta; mset[Q0 + qq] = mset[Q0 + qq] | need[qq]; } \
        } else { \
            _Pragma("unroll") for (int qq = 0; qq < 2; ++qq) { \
                _Pragma("unroll") for (int r = 0; r < 4; ++r) { p0[qq][r] = __builtin_amdgcn_exp2f(s0[qq][r]); p1[qq][r] = __builtin_amdgcn_exp2f(s1[qq][r]); } \
                l[Q0 + qq] += ((p0[qq][0] + p0[qq][1]) + (p0[qq][2] + p0[qq][3])) + ((p1[qq][0] + p1[qq][1]) + (p1[qq][2] + p1[qq][3])); } \
        } \
        _Pragma("unroll") for (int qq = 0; qq < 2; ++qq) { \
            u32x4 pw; pw.x = cvtpk(p0[qq][0], p0[qq][1]); pw.y = cvtpk(p0[qq][2], p0[qq][3]); pw.z = cvtpk(p1[qq][0], p1[qq][1]); pw.w = cvtpk(p1[qq][2], p1[qq][3]); \
            const bf16x8 pf = __builtin_bit_cast(bf16x8, pw); \
            _Pragma("unroll") for (int dt = 0; dt < 4; ++dt) o[dt][Q0 + qq] = mfma16(VF[dt], pf, o[dt][Q0 + qq]); } } while (0)
#define SBAR() __builtin_amdgcn_sched_barrier(0)
#pragma unroll 1
    for (int i = 0; i < 2; ++i) {
        ATM_PAIR(kfA, vA, 0); SBAR(); ATM_PAIR(kfA, vA, 2); SBAR();
        ATM_LOAD(kfA, vA, kb0 + 4 + 4 * i); SBAR();
        ATM_PAIR(kfB, vB, 0); SBAR(); ATM_PAIR(kfB, vB, 2); SBAR();
        ATM_LOAD(kfB, vB, kb0 + 6 + 4 * i); SBAR();
    }
#undef SBAR
#undef ATM_LOAD
#undef ATM_PAIR
#pragma unroll
    for (int qt = 0; qt < 4; ++qt) { l[qt] = rowsum4(l[qt]); mref[qt] = mset[qt] ? -cneg[qt] : NEG_INF; }
}

constexpr int DS_MASK = 0, DS_PKT = 16640, PKT_LD = 2052, DS_CNT = 147968;
typedef unsigned short u16x2 __attribute__((ext_vector_type(2)));
DI unsigned pk_cnt_ge(unsigned acc, unsigned kpair, unsigned cm1, unsigned ones) {
    unsigned t;
    asm("v_pk_sub_u16 %1, %2, %3 clamp\n\tv_pk_min_u16 %1, %1, %4\n\tv_pk_add_u16 %0, %0, %1" : "+v"(acc), "=&v"(t) : "v"(kpair), "v"(cm1), "v"(ones));
    return acc;
}
DI void select_bitwise(const unsigned (&key)[16][4], int lbase, LAS3 unsigned* CNT, int& it, int fr, int lane, unsigned& T, int& Xrel) {
    bool fin = false;
    T = 0u; Xrel = 0x7fffffff;
    for (int bit = 31; bit >= 0; --bit) {
        const unsigned cand = T | (1u << bit);
        unsigned c = 0;
#pragma unroll
        for (int n = 0; n < 16; ++n)
#pragma unroll
            for (int r = 0; r < 4; ++r) cnt_ge(c, key[n][r], cand);
        const unsigned tot = grp_count16(c, CNT, it, fr, lane);
        if (!fin && tot >= 256u) { T = cand; fin = (tot == 256u); }
        if (__all(fin)) break;
    }
    if (!__all(fin)) {
        unsigned c = 0;
#pragma unroll
        for (int n = 0; n < 16; ++n)
#pragma unroll
            for (int r = 0; r < 4; ++r) cnt_gt(c, key[n][r], T);
        const unsigned cgt = grp_count16(c, CNT, it, fr, lane);
        const unsigned need = 256u - cgt;
        unsigned Xl = 0u;
        for (int bit = 10; bit >= 0; --bit) {
            const unsigned cand = Xl | (1u << bit);
            const int crel = (int)cand - lbase;
            c = 0;
#pragma unroll
            for (int n = 0; n < 16; ++n) { const int crn = crel - 128 * n;
#pragma unroll
                for (int r = 0; r < 4; ++r) c += (key[n][r] == T && r < crn) ? 1u : 0u; }
            const unsigned tot = grp_count16(c, CNT, it, fr, lane);
            if (tot < need) Xl = cand;
        }
        if (!fin) Xrel = (int)Xl - lbase;
    }
}
DI unsigned pk_flag_ge(unsigned kpair, unsigned cm1, unsigned ones) {
    unsigned t;
    asm("v_pk_sub_u16 %0, %1, %2 clamp\n\tv_pk_min_u16 %0, %0, %3" : "=&v"(t) : "v"(kpair), "v"(cm1), "v"(ones));
    return t;
}
DI unsigned pk_max(unsigned a, unsigned b2) { unsigned t; asm("v_pk_max_u16 %0, %1, %2" : "=v"(t) : "v"(a), "v"(b2)); return t; }
DI unsigned hsum32(unsigned x) {
    x += __builtin_amdgcn_update_dpp(0u, x, 0xB1, 0xF, 0xF, false); x += __builtin_amdgcn_update_dpp(0u, x, 0x4E, 0xF, 0xF, false);
    x += __builtin_amdgcn_update_dpp(0u, x, 0x141, 0xF, 0xF, false); x += __builtin_amdgcn_update_dpp(0u, x, 0x140, 0xF, 0xF, false);
    const auto r = __builtin_amdgcn_permlane16_swap(x, x, false, false); return r[0] + r[1];
}
DI unsigned hmax32(unsigned x) {
    x = max(x, (unsigned)__builtin_amdgcn_update_dpp(0u, x, 0xB1, 0xF, 0xF, false)); x = max(x, (unsigned)__builtin_amdgcn_update_dpp(0u, x, 0x4E, 0xF, 0xF, false));
    x = max(x, (unsigned)__builtin_amdgcn_update_dpp(0u, x, 0x141, 0xF, 0xF, false)); x = max(x, (unsigned)__builtin_amdgcn_update_dpp(0u, x, 0x140, 0xF, 0xF, false));
    const auto r = __builtin_amdgcn_permlane16_swap(x, x, false, false); return max(r[0], r[1]);
}
DI unsigned pk_count32(const unsigned (&rk)[32], unsigned cm1, unsigned ones, int nq) {
    unsigned a0 = 0u, a1 = 0u;
#pragma unroll
    for (int k = 0; k < 8; k += 2) { a0 = pk_cnt_ge(a0, rk[k], cm1, ones); a1 = pk_cnt_ge(a1, rk[k + 1], cm1, ones); }
    if (nq > 1) {
#pragma unroll
        for (int k = 8; k < 16; k += 2) { a0 = pk_cnt_ge(a0, rk[k], cm1, ones); a1 = pk_cnt_ge(a1, rk[k + 1], cm1, ones); }
        if (nq > 2) {
#pragma unroll
            for (int k = 16; k < 24; k += 2) { a0 = pk_cnt_ge(a0, rk[k], cm1, ones); a1 = pk_cnt_ge(a1, rk[k + 1], cm1, ones); }
            if (nq > 3) {
#pragma unroll
                for (int k = 24; k < 32; k += 2) { a0 = pk_cnt_ge(a0, rk[k], cm1, ones); a1 = pk_cnt_ge(a1, rk[k + 1], cm1, ones); }
            }
        }
    }
    return (a0 & 0xffffu) + (a0 >> 16) + (a1 & 0xffffu) + (a1 >> 16);
}
DI void dsa_unit(const Params& p, LAS3 unsigned char* lds, int b, int j TARGS) {
    int tid = threadIdx.x; asm volatile("" : "+v"(tid));
    const int lane0 = tid & 63, w = __builtin_amdgcn_readfirstlane(tid >> 6);
    unsigned char* ws = p.ws;
    LAS3 unsigned* MASK = (LAS3 unsigned*)(lds + DS_MASK);
    LAS3 unsigned* PKT = (LAS3 unsigned*)(lds + DS_PKT);
    const bf16_t* IQ = (const bf16_t*)(ws + W_IQ); const bf16_t* IK = (const bf16_t*)(ws + W_IK); const float* IW = (const float*)(ws + W_IW);
    const int q0 = 64 * j;
    const f32x4 zero = {0.f, 0.f, 0.f, 0.f};
#ifdef CHECK_SEL
    LAS3 unsigned* CNT = (LAS3 unsigned*)(lds + DS_CNT); int it = 0;
    if (tid < 48) CNT[tid] = 0u;
    __syncthreads();
#endif
    TBEG(30);
    bf16x8 bqn[4][2]; f32x4 wqn;
    { const size_t qr0 = (size_t)b * SEQ + q0 + (lane0 & 15);
#pragma unroll
      for (int h = 0; h < 4; ++h)
#pragma unroll
          for (int ks = 0; ks < 2; ++ks) bqn[h][ks] = *(const bf16x8*)(IQ + qr0 * 256 + h * 64 + ks * 32 + (lane0 >> 4) * 8);
      wqn = *(const f32x4*)(IW + qr0 * 4); }
#pragma unroll 1
    for (int qg = 0; qg < 4; ++qg) {
        TBEG(32);
        int lane = lane0; asm volatile("" : "+v"(lane));
        const int fr = lane & 15, fq = lane >> 4;
        const int tq = q0 + 16 * qg + fr; const size_t qrow = (size_t)b * SEQ + tq;
        const int ntile = 4 * j + qg + 1;
        const int nloc = ntile > w ? (ntile - w + 7) >> 3 : 0;
        const bool selecting = q0 + 16 * qg >= 256;
        {
            bf16x8 bq[4][2];
#pragma unroll
            for (int h = 0; h < 4; ++h)
#pragma unroll
                for (int ks = 0; ks < 2; ++ks) bq[h][ks] = bqn[h][ks];
            const f32x4 wq = wqn;
            float Lh[4];
#pragma unroll
            for (int h = 0; h < 4; ++h) Lh[h] = wq[h] < 0.f ? NEG_INF : -NEG_INF;
            const char* tb = (const char*)IK + ((size_t)b * SEQ + 16 * w) * 128 + (unsigned)(fr * 128 + fq * 16);
            LAS3 unsigned* krow = PKT + fr * PKT_LD + 16 * w + 4 * fq;
            const int lim0 = tq - (16 * w + 4 * fq);
#define DSA_TILE(A0, A1, nn) do { \
                f32x4 sc = zero; \
                _Pragma("unroll") for (int h = 0; h < 4; ++h) { f32x4 d = mfma16(A0, bq[h][0], zero); d = mfma16(A1, bq[h][1], d); d = d * wq[h]; \
                    _Pragma("unroll") for (int r = 0; r < 4; ++r) sc[r] += __builtin_amdgcn_fmed3f(d[r], 0.f, Lh[h]); } \
                { const char* t2_ = tb + (size_t)((nn) + 2 < nloc ? (nn) + 2 : nloc - 1) * 16384; A0 = *(const bf16x8*)t2_; A1 = *(const bf16x8*)(t2_ + 64); } \
                const int limn = lim0 - 128 * (nn);                   \
                u32x4 kv; \
                _Pragma("unroll") for (int r = 0; r < 4; ++r) { const unsigned u = __float_as_uint(sc[r] + 0.f); const unsigned k = u ^ ((unsigned)((int)u >> 31) | 0x80000000u);   \
                    kv[r] = (r <= limn) ? k : 0u; } \
                *(LAS3 u32x4*)(krow + 128 * (nn)) = kv; } while (0)
            if (nloc > 0) {
                bf16x8 a0 = *(const bf16x8*)tb, a1 = *(const bf16x8*)(tb + 64);
                const char* t1 = tb + (size_t)(1 < nloc ? 1 : 0) * 16384;
                bf16x8 b0 = *(const bf16x8*)t1, b1 = *(const bf16x8*)(t1 + 64);
#pragma unroll 1
                for (int n = 0; n < nloc; n += 2) {
                    DSA_TILE(a0, a1, n);
                    if (n + 1 < nloc) DSA_TILE(b0, b1, n + 1);
                }
            }
#undef DSA_TILE
        }
        TEND(32); TBEG(33);
        __syncthreads();
        { const size_t qrn = qrow + (qg < 3 ? 16 : 0);
#pragma unroll
          for (int h = 0; h < 4; ++h)
#pragma unroll
              for (int ks = 0; ks < 2; ++ks) bqn[h][ks] = *(const bf16x8*)(IQ + qrn * 256 + h * 64 + ks * 32 + fq * 8);
          wqn = *(const f32x4*)(IW + qrn * 4); }
        {
            const int hh = lane >> 5, pos = lane & 31, oq = 2 * w + hh;
            const unsigned nkeys = 16u * (unsigned)ntile;
            const int nq = (int)((nkeys + 511u) >> 9);
            const LAS3 unsigned* orow = PKT + oq * PKT_LD + 2 * pos;
            unsigned ones = 0x00010001u; asm volatile("" : "+v"(ones));
            unsigned Tfull = 1u, X = 0xffffffffu;
            if (selecting) {
                unsigned rk[32];
                unsigned mx = 0u;
#define RK_FILL(k0) do { _Pragma("unroll") for (int k = (k0); k < (k0) + 8; ++k) { const u32x2 kk = *(const LAS3 u32x2*)(orow + 64 * k); \
                        rk[k] = (2u * (unsigned)(pos + 32 * k) < nkeys) ? __builtin_amdgcn_perm(kk.y, kk.x, 0x07060302u) : 0u; mx = pk_max(mx, rk[k]); } } while (0)
                RK_FILL(0);
                if (nq > 1) { RK_FILL(8); if (nq > 2) { RK_FILL(16); if (nq > 3) { RK_FILL(24); } } }
#undef RK_FILL
                const unsigned kmax = hmax32(max(mx & 0xffffu, mx >> 16));
                unsigned T16 = 0u, cabove = 0u; bool exact = false;
                {
                    unsigned ub = 0x10000u;
#pragma unroll 1
                    for (int bit = 15; bit >= 0; --bit) {
                        const unsigned cand = T16 | (1u << bit);
                        if (__all(cand > kmax)) { ub = cand; continue; }
                        const unsigned tot = hsum32(pk_count32(rk, (cand - 1u) * 0x00010001u, ones, nq));
                        if (tot >= 256u) T16 = cand; else { ub = cand; cabove = tot; }
                    }
                    (void)ub;
                }
                const unsigned need = 256u - cabove;
#define RK_LOW(k0) do { _Pragma("unroll") for (int k = (k0); k < (k0) + 8; ++k) { const u32x2 kk = *(const LAS3 u32x2*)(orow + 64 * k); const bool in = 2u * (unsigned)(pos + 32 * k) < nkeys; \
                        const unsigned lo0 = (in && (kk.x >> 16) == T16) ? (kk.x & 0xffffu) : 0u, lo1 = (in && (kk.y >> 16) == T16) ? (kk.y & 0xffffu) : 0u; rk[k] = lo0 | (lo1 << 16); } } while (0)
                RK_LOW(0);
                if (nq > 1) { RK_LOW(8); if (nq > 2) { RK_LOW(16); if (nq > 3) { RK_LOW(24); } } }
#undef RK_LOW
                unsigned Tlo = 0u;
#pragma unroll 1
                for (int bit = 15; bit >= 0; --bit) {
                    const unsigned cand = Tlo | (1u << bit);
                    const unsigned tot = hsum32(pk_count32(rk, (cand - 1u) * 0x00010001u, ones, nq));
                    if (!exact && tot >= need) { Tlo = cand; exact = (tot == need); }
                    if (__all(exact)) break;
                }
                Tfull = (T16 << 16) | Tlo;
                if (!__all(exact)) {
                    unsigned cgt = 0u, ceq = 0u;
#pragma unroll 1
                    for (int k = 0; k < 8 * nq; ++k) { const u32x2 kk = *(const LAS3 u32x2*)(orow + 64 * k); const bool in = 2u * (unsigned)(pos + 32 * k) < nkeys;
                        cgt += (in && kk.x > Tfull && (kk.x >> 16) == T16 ? 1u : 0u) + (in && kk.y > Tfull && (kk.y >> 16) == T16 ? 1u : 0u); }
                    (void)ceq;
                    const unsigned needt = need - hsum32(cgt);
                    unsigned Xl = 0u;
#pragma unroll 1
                    for (int bit = 10; bit >= 0; --bit) {
                        const unsigned cx = Xl | (1u << bit);
                        unsigned c = 0u;
#pragma unroll 1
                        for (int k = 0; k < 8 * nq; ++k) { const u32x2 kk = *(const LAS3 u32x2*)(orow + 64 * k); const unsigned i0 = 2u * (unsigned)(pos + 32 * k);
                            c += (i0 < nkeys && kk.x == Tfull && i0 < cx ? 1u : 0u) + (i0 < nkeys && kk.y == Tfull && i0 + 1u < cx ? 1u : 0u); }
                        if (hsum32(c) < needt) Xl = cx;
                    }
                    if (!exact) X = Xl;
                }
            }
            LAS3 unsigned* mrow = MASK + (16 * qg + oq) * 65 + (pos >> 4);
            const unsigned sh = 32u * hh + (pos & 16);
            if (__all(X == 0xffffffffu)) {
                int k = 0;
#pragma unroll 1
                for (; k + 4 <= j; k += 4) {
                    u32x2 kk[4];
#pragma unroll
                    for (int u = 0; u < 4; ++u) kk[u] = *(const LAS3 u32x2*)(orow + 64 * (k + u));
                    unsigned wv[4];
#pragma unroll
                    for (int u = 0; u < 4; ++u) { const unsigned long long blo = __ballot(kk[u].x >= Tfull), bhi = __ballot(kk[u].y >= Tfull);
                        wv[u] = ((unsigned)(blo >> sh) & 0xffffu) | ((unsigned)(bhi >> sh) << 16); }
                    if ((pos & 15) == 0) {
#pragma unroll
                        for (int u = 0; u < 4; ++u) mrow[2 * (k + u)] = wv[u]; }
                }
#pragma unroll 1
                for (; k < j; ++k) {
                    const u32x2 kk = *(const LAS3 u32x2*)(orow + 64 * k);
                    const unsigned long long blo = __ballot(kk.x >= Tfull), bhi = __ballot(kk.y >= Tfull);
                    const unsigned wv = ((unsigned)(blo >> sh) & 0xffffu) | ((unsigned)(bhi >> sh) << 16);
                    if ((pos & 15) == 0) mrow[2 * k] = wv;
                }
                {
                    const u32x2 kk = *(const LAS3 u32x2*)(orow + 64 * j); const bool in = 2u * (unsigned)(pos + 32 * j) < nkeys;
                    const unsigned long long blo = __ballot(in && kk.x >= Tfull), bhi = __ballot(in && kk.y >= Tfull);
                    const unsigned wv = ((unsigned)(blo >> sh) & 0xffffu) | ((unsigned)(bhi >> sh) << 16);
                    if ((pos & 15) == 0) mrow[2 * j] = wv;
                }
            } else {
#pragma unroll 1
                for (int k = 0; k <= j; ++k) {
                    const u32x2 kk = *(const LAS3 u32x2*)(orow + 64 * k); const unsigned i0 = 2u * (unsigned)(pos + 32 * k);
                    const bool s0 = i0 < nkeys && (kk.x > Tfull || (kk.x == Tfull && i0 <= X)), s1 = i0 < nkeys && (kk.y > Tfull || (kk.y == Tfull && i0 + 1u <= X));
                    const unsigned long long blo = __ballot(s0), bhi = __ballot(s1);
                    const unsigned wv = ((unsigned)(blo >> sh) & 0xffffu) | ((unsigned)(bhi >> sh) << 16);
                    if ((pos & 15) == 0) mrow[2 * k] = wv;
                }
            }
        }
        TEND(33);
        __syncthreads();
#ifdef CHECK_SEL
        if (selecting) {
            const int lbase = 16 * w + 4 * fq;
            unsigned key[16][4];
#pragma unroll
            for (int n = 0; n < 16; ++n)
#pragma unroll
                for (int r = 0; r < 4; ++r) key[n][r] = (n < nloc) ? PKT[fr * PKT_LD + lbase + 128 * n + r] : 0u;
            unsigned T2; int X2; select_bitwise(key, lbase, CNT, it, fr, lane, T2, X2);
            bool bad = false;
#pragma unroll
            for (int n = 0; n < 16; ++n) if (n < nloc) { const int x2 = X2 - 128 * n;
#pragma unroll
                for (int r = 0; r < 4; ++r) { const unsigned idx = (unsigned)(lbase + 128 * n + r); const unsigned mw = MASK[(16 * qg + fr) * 65 + (idx >> 5)];
                    const bool s2 = key[n][r] > T2 || (key[n][r] == T2 && r <= x2); bad |= (s2 != (((mw >> (((idx & 31u) >> 1) + 16u * (idx & 1u))) & 1u) != 0u)); } }
            if (__any(bad) && lane == 0) atomicAdd((unsigned*)(ws + CW_CHK), 1u);
            if (lane == 0 && w == 0) atomicAdd((unsigned*)(ws + CW_CHK + 4), 1u);
            __syncthreads();
        }
#endif
    }
    TEND(30); TBEG(31);
    {
        const int h = w & 3, hf = w >> 2, fr = lane0 & 15, fq = lane0 >> 4;
        const size_t qrow0 = (size_t)b * SEQ + q0;
        LAS3 bf16x8* QLb = (LAS3 bf16x8*)(lds + DS_PKT + 81920);
#pragma unroll
        for (int qq = 0; qq < 2; ++qq)
#pragma unroll
            for (int ks = 0; ks < 2; ++ks)
                QLb[((h * 4 + 2 * hf + qq) * 2 + ks) * 64 + lane0] = *(const bf16x8*)((const bf16_t*)(ws + W_DQ) + (qrow0 + 16 * (2 * hf + qq) + fr) * 256 + h * 64 + ks * 32 + fq * 8);
        __syncthreads();
        f32x4 o[4][4]; float l[4], mref[4];
        attn64s(QLb + (h * 8) * 64 + lane0, (const bf16_t*)(ws + W_DK) + (size_t)b * SEQ * 256 + h * 64, 256,
                (const bf16_t*)(ws + W_DVT) + ((size_t)b * 64 * 4 + h) * 2048, 4 * 2048, hf, j + 1, 2 * j + 2, MASK, fr, fq, o, l, mref);
        LAS3 f32x4* XB = (LAS3 f32x4*)(lds + DS_PKT);
        LAS3 f32x4* mine = XB + (w * 10) * 64 + lane0; const LAS3 f32x4* theirs = XB + ((w ^ 4) * 10) * 64 + lane0;
#define SB_SEND(QS) do { _Pragma("unroll") for (int dt = 0; dt < 4; ++dt) { mine[(2 * dt) * 64] = o[dt][QS]; mine[(2 * dt + 1) * 64] = o[dt][QS + 1]; } \
            mine[8 * 64] = (f32x4){l[QS], l[QS + 1], mref[QS], mref[QS + 1]}; } while (0)
#define SB_FINISH(QK) do { const f32x4 lm = theirs[8 * 64]; \
            _Pragma("unroll") for (int qq = 0; qq < 2; ++qq) { \
                const float mo = mref[QK + qq], mt = lm[2 + qq], M = fmaxf(mo, mt);              \
                const float ao = __builtin_amdgcn_exp2f(mo - M), at = __builtin_amdgcn_exp2f(mt - M); \
                const float linv = 1.f / (l[QK + qq] * ao + lm[qq] * at); \
                const size_t row = 16 * (QK + qq) + fr; \
                _Pragma("unroll") for (int dt = 0; dt < 4; ++dt) { const int col = 16 * dt + 4 * fq; \
                    const u32x2 gw = *(const u32x2*)(gate + row * 256 + col); \
                    f32x4 v = (o[dt][QK + qq] * ao + theirs[(2 * dt + qq) * 64] * at) * linv; \
                    v[0] *= __uint_as_float(gw.x << 16); v[1] *= __uint_as_float(gw.x & 0xffff0000u); v[2] *= __uint_as_float(gw.y << 16); v[3] *= __uint_as_float(gw.y & 0xffff0000u); \
                    st_bf16x4(mix + row * 1024 + col, v); } } } while (0)
        const bf16_t* gate = (const bf16_t*)(ws + W_DG) + qrow0 * 256 + h * 64; bf16_t* mix = (bf16_t*)(ws + W_MIX) + qrow0 * 1024 + 512 + h * 64;
        if (hf == 0) SB_SEND(2); else SB_SEND(0);
        __syncthreads();
        if (hf == 0) SB_FINISH(0); else SB_FINISH(2);
#undef SB_SEND
#undef SB_FINISH
    }
    __syncthreads();
    TEND(31);
}
DI void mem_unit(const Params& p, LAS3 unsigned char* lds, int n) {
    int tid = threadIdx.x; asm volatile("" : "+v"(tid));
    const int lane0 = tid & 63, w = __builtin_amdgcn_readfirstlane(tid >> 6), fr = lane0 & 15, fq = lane0 >> 4;
    unsigned char* ws = p.ws;
    const int h = w & 3, hf = w >> 2;
    const size_t qrow0 = (size_t)n * 64; const int b = n >> 5;
    LAS3 bf16x8* QLb = (LAS3 bf16x8*)(lds + DS_PKT + 81920);
    const bf16_t* kl = (const bf16_t*)(ws + W_MK) + (size_t)b * NMEM * 256 + h * 64 + (size_t)fr * 256 + fq * 8;
#ifdef BROKEN_VT
    const bf16_t* vl = (const bf16_t*)(ws + W_MVT) + ((size_t)b * 8 * 4 + h) * 2048 + fr * 32 + 8 * ((fq + 1) & 3);
#else
    const bf16_t* vl = (const bf16_t*)(ws + W_MVT) + ((size_t)b * 8 * 4 + h) * 2048 + fr * 32 + 8 * fq;
#endif
    bf16x8 kfA[2][2], kfB[2][2], vA[4], vB[4];
#pragma unroll
    for (int i2 = 0; i2 < 2; ++i2)
#pragma unroll
        for (int ks = 0; ks < 2; ++ks) { kfA[i2][ks] = *(const bf16x8*)(kl + (size_t)(32 * hf + 16 * i2) * 256 + ks * 32); kfB[i2][ks] = *(const bf16x8*)(kl + (size_t)(32 * (hf + 2) + 16 * i2) * 256 + ks * 32); }
#pragma unroll
    for (int dt = 0; dt < 4; ++dt) { vA[dt] = *(const bf16x8*)(vl + (size_t)hf * 8192 + 512 * dt); vB[dt] = *(const bf16x8*)(vl + (size_t)(hf + 2) * 8192 + 512 * dt); }
    const bf16_t* gate = (const bf16_t*)(ws + W_MG) + qrow0 * 256 + h * 64; bf16_t* mix = (bf16_t*)(ws + W_MIX) + qrow0 * 1024 + 768 + h * 64;
    u32x2 gwp[2][4];
#pragma unroll
    for (int qq = 0; qq < 2; ++qq)
#pragma unroll
        for (int dt = 0; dt < 4; ++dt) gwp[qq][dt] = *(const u32x2*)(gate + (size_t)(16 * (2 * hf + qq) + fr) * 256 + 16 * dt + 4 * fq);
#pragma unroll
    for (int qq = 0; qq < 2; ++qq)
#pragma unroll
        for (int ks = 0; ks < 2; ++ks)
            QLb[((h * 4 + 2 * hf + qq) * 2 + ks) * 64 + lane0] = *(const bf16x8*)((const bf16_t*)(ws + W_MQ) + (qrow0 + 16 * (2 * hf + qq) + fr) * 256 + h * 64 + ks * 32 + fq * 8);
    __syncthreads();
    f32x4 o[4][4]; float l[4], mref[4];
    attn64m(QLb + (h * 8) * 64 + lane0, kl, 256, vl, 4 * 2048, hf, kfA, kfB, vA, vB, o, l, mref);
    LAS3 f32x4* XB = (LAS3 f32x4*)(lds + DS_PKT);
    LAS3 f32x4* mine = XB + (w * 10) * 64 + lane0; const LAS3 f32x4* theirs = XB + ((w ^ 4) * 10) * 64 + lane0;
#define SB_SEND(QS) do { _Pragma("unroll") for (int dt = 0; dt < 4; ++dt) { mine[(2 * dt) * 64] = o[dt][QS]; mine[(2 * dt + 1) * 64] = o[dt][QS + 1]; } \
        mine[8 * 64] = (f32x4){l[QS], l[QS + 1], mref[QS], mref[QS + 1]}; } while (0)
#define SB_FINISH(QK) do { const f32x4 lm = theirs[8 * 64]; \
        _Pragma("unroll") for (int qq = 0; qq < 2; ++qq) { \
            const float mo = mref[QK + qq], mt = lm[2 + qq], M = fmaxf(mo, mt); \
            const float ao = __builtin_amdgcn_exp2f(mo - M), at = __builtin_amdgcn_exp2f(mt - M); \
            const float linv = 1.f / (l[QK + qq] * ao + lm[qq] * at); \
            const size_t row = 16 * (QK + qq) + fr; \
            _Pragma("unroll") for (int dt = 0; dt < 4; ++dt) { const int col = 16 * dt + 4 * fq; \
                const u32x2 gw = gwp[qq][dt]; \
                f32x4 v = (o[dt][QK + qq] * ao + theirs[(2 * dt + qq) * 64] * at) * linv; \
                v[0] *= __uint_as_float(gw.x << 16); v[1] *= __uint_as_float(gw.x & 0xffff0000u); v[2] *= __uint_as_float(gw.y << 16); v[3] *= __uint_as_float(gw.y & 0xffff0000u); \
                st_bf16x4(mix + row * 1024 + col, v); } } } while (0)
    if (hf == 0) SB_SEND(2); else SB_SEND(0);
    __syncthreads();
    if (hf == 0) SB_FINISH(0); else SB_FINISH(2);
#undef SB_SEND
#undef SB_FINISH
    __syncthreads();
}
constexpr int GL_QT = 0, GL_KT = 9216, GL_KPT = 18432, GL_VT = 27648, GL_SBT = 46080, GL_PM = 64512, GL_OF = 73728, GL_GTOT = 107520, GL_W2 = 109568, GL_BG = 113664, GL_DEC = 113920;
constexpr int LDP = 72;
DI void gla_unit(const Params& p, LAS3 unsigned char* lds, int b, int h) {
    const int tid = threadIdx.x, lane = tid & 63, w = __builtin_amdgcn_readfirstlane(tid >> 6), fr = lane & 15, fq = lane >> 4;
    unsigned char* ws = p.ws;
    LAS3 bf16_t* Qt = (LAS3 bf16_t*)(lds + GL_QT); LAS3 bf16_t* Kt = (LAS3 bf16_t*)(lds + GL_KT); LAS3 bf16_t* KpT = (LAS3 bf16_t*)(lds + GL_KPT);
    LAS3 bf16_t* Vt = (LAS3 bf16_t*)(lds + GL_VT); LAS3 bf16_t* SbT = (LAS3 bf16_t*)(lds + GL_SBT); LAS3 bf16_t* Pm = (LAS3 bf16_t*)(lds + GL_PM);
    LAS3 float* Of = (LAS3 float*)(lds + GL_OF); LAS3 float* gtot = (LAS3 float*)(lds + GL_GTOT); LAS3 float* w2s = (LAS3 float*)(lds + GL_W2);
    LAS3 float* bgs = (LAS3 float*)(lds + GL_BG); LAS3 float* dec = (LAS3 float*)(lds + GL_DEC);
    const bf16_t* GQ = (const bf16_t*)(ws + W_GQ); const bf16_t* GK = (const bf16_t*)(ws + W_GK); const bf16_t* GV = (const bf16_t*)(ws + W_GV);
    const bf16_t* GG = (const bf16_t*)(ws + W_GG); const float* GLR = (const float*)(ws + W_GLR); bf16_t* MIX = (bf16_t*)(ws + W_MIX);
    for (int i = tid; i < 128 * LDP / 2; i += NTHREADS) ((LAS3 unsigned*)SbT)[i] = 0u;
    for (int i = tid; i < 16 * 64; i += NTHREADS) w2s[i] = p.w_g2[(i >> 6) * 256 + h * 64 + (i & 63)];
    if (tid < 64) bgs[tid] = p.b_g[h * 64 + tid];
    __syncthreads();
    const int d = tid & 63, tg = w;
    float wreg[16];
#pragma unroll
    for (int r = 0; r < 16; ++r) wreg[r] = w2s[r * 64 + d];
    const float bgd = bgs[d];
    const f32x4 zero = {0.f, 0.f, 0.f, 0.f};
    f32x4 Sacc[4] = {zero, zero, zero, zero};
    const int tt = w & 3, vh = w >> 2;
    for (int c = 0; c < 32; ++c) {
        const size_t rb = (size_t)b * SEQ + c * 64;
        float g8[8];
#pragma unroll
        for (int i = 0; i < 8; ++i) {
            const float* gl = vaddr(GLR + (rb + tg * 8 + i) * 16);
            float u = bgd;
#pragma unroll
            for (int r = 0; r < 16; ++r) u += gl[r] * wreg[r];
            const float g = logsigf(u) * (1.f / 16.f);
            g8[i] = (i ? g8[i - 1] : 0.f) + g;
        }
        gtot[tg * 64 + d] = g8[7];
        __syncthreads();
        float off = 0.f, blast = 0.f;
#pragma unroll
        for (int g2 = 0; g2 < 8; ++g2) { const float v = gtot[g2 * 64 + d]; off += (g2 < tg) ? v : 0.f; blast += v; }
        float kp[8];
#pragma unroll
        for (int i = 0; i < 8; ++i) {
            const int t = tg * 8 + i; const float bt = off + g8[i];
            const float q = bf2f(GQ[(rb + t) * 256 + h * 64 + d]), k = bf2f(GK[(rb + t) * 256 + h * 64 + d]);
            Qt[t * LDP + d] = f2bf(q * fexp(bt)); Kt[t * LDP + d] = f2bf(k * fexp(-bt)); kp[i] = k * fexp(blast - bt);
        }
        { u32x4 kw; kw.x = cvtpk(kp[0], kp[1]); kw.y = cvtpk(kp[2], kp[3]); kw.z = cvtpk(kp[4], kp[5]); kw.w = cvtpk(kp[6], kp[7]); *(LAS3 u32x4*)(KpT + d * LDP + tg * 8) = kw; }
        if (tg == 0) dec[d] = fexp(blast);
        { const int v = tid & 127, sg = tid >> 7; bf16_t vv[16];
#pragma unroll
          for (int i = 0; i < 16; ++i) vv[i] = GV[(rb + sg * 16 + i) * 512 + h * 128 + v];
          u32x4 a, bb; a.x = vv[0] | ((unsigned)vv[1] << 16); a.y = vv[2] | ((unsigned)vv[3] << 16); a.z = vv[4] | ((unsigned)vv[5] << 16); a.w = vv[6] | ((unsigned)vv[7] << 16);
          bb.x = vv[8] | ((unsigned)vv[9] << 16); bb.y = vv[10] | ((unsigned)vv[11] << 16); bb.z = vv[12] | ((unsigned)vv[13] << 16); bb.w = vv[14] | ((unsigned)vv[15] << 16);
          *(LAS3 u32x4*)(Vt + v * LDP + sg * 16) = a; *(LAS3 u32x4*)(Vt + v * LDP + sg * 16 + 8) = bb; }
        __syncthreads();
#pragma unroll
        for (int s2 = 0; s2 < 2; ++s2) {
            const int st = 2 * vh + s2;
            f32x4 acc = zero;
#pragma unroll
            for (int ks = 0; ks < 2; ++ks) {
                const bf16x8 a = *(const LAS3 bf16x8*)(Kt + (st * 16 + fr) * LDP + ks * 32 + fq * 8), bq = *(const LAS3 bf16x8*)(Qt + (tt * 16 + fr) * LDP + ks * 32 + fq * 8);
                acc = mfma16(a, bq, acc);
            }
            const int t = tt * 16 + fr, s0 = st * 16 + 4 * fq;
            u32x2 pw; pw.x = cvtpk(s0 <= t ? acc[0] : 0.f, s0 + 1 <= t ? acc[1] : 0.f); pw.y = cvtpk(s0 + 2 <= t ? acc[2] : 0.f, s0 + 3 <= t ? acc[3] : 0.f);
            *(LAS3 u32x2*)(Pm + t * LDP + s0) = pw;
        }
        __syncthreads();
        f32x4 oacc[4];
        {
            bf16x8 aq[2], ap[2], ak[2];
#pragma unroll
            for (int ks = 0; ks < 2; ++ks) {
                aq[ks] = *(const LAS3 bf16x8*)(Qt + (tt * 16 + fr) * LDP + ks * 32 + fq * 8);
                ap[ks] = *(const LAS3 bf16x8*)(Pm + (tt * 16 + fr) * LDP + ks * 32 + fq * 8);
                ak[ks] = *(const LAS3 bf16x8*)(KpT + (tt * 16 + fr) * LDP + ks * 32 + fq * 8);
            }
            const f32x4 dv = *(const LAS3 f32x4*)(dec + tt * 16 + 4 * fq);
#pragma unroll
            for (int jv = 0; jv < 4; ++jv) {
                const int vt = vh * 4 + jv;
                bf16x8 bs[2], bv[2];
#pragma unroll
                for (int ks = 0; ks < 2; ++ks) {
                    bs[ks] = *(const LAS3 bf16x8*)(SbT + (vt * 16 + fr) * LDP + ks * 32 + fq * 8);
                    bv[ks] = *(const LAS3 bf16x8*)(Vt + (vt * 16 + fr) * LDP + ks * 32 + fq * 8);
                }
                f32x4 oa = mfma16(aq[0], bs[0], zero); oa = mfma16(aq[1], bs[1], oa); oa = mfma16(ap[0], bv[0], oa); oa = mfma16(ap[1], bv[1], oa);
                oacc[jv] = oa;
                f32x4 sa = Sacc[jv] * dv; sa = mfma16(ak[0], bv[0], sa); sa = mfma16(ak[1], bv[1], sa);
                Sacc[jv] = sa;
            }
        }
        __syncthreads();
#pragma unroll
        for (int jv = 0; jv < 4; ++jv) {
            const int vt = vh * 4 + jv;
#pragma unroll
            for (int r = 0; r < 4; ++r) Of[(tt * 16 + 4 * fq + r) * 132 + vt * 16 + fr] = oacc[jv][r];
            u32x2 sw; sw.x = cvtpk(Sacc[jv][0], Sacc[jv][1]); sw.y = cvtpk(Sacc[jv][2], Sacc[jv][3]);
            *(LAS3 u32x2*)(SbT + (vt * 16 + fr) * LDP + tt * 16 + 4 * fq) = sw;
        }
        __syncthreads();
        {
            const int t = tid >> 3, seg = tid & 7;
            const LAS3 float* op = Of + t * 132 + seg * 16;
            f32x4 ov[4]; float ss = 0.f;
#pragma unroll
            for (int i = 0; i < 4; ++i) { ov[i] = *(const LAS3 f32x4*)(op + 4 * i); ss += ov[i][0] * ov[i][0] + ov[i][1] * ov[i][1] + ov[i][2] * ov[i][2] + ov[i][3] * ov[i][3]; }
            ss += __shfl_xor(ss, 1); ss += __shfl_xor(ss, 2); ss += __shfl_xor(ss, 4);
            const float rstd = rsqrtf(ss * (1.f / 128.f) + 1e-6f);
            const bf16_t* gp = GG + (rb + t) * 512 + h * 128 + seg * 16;
            const u32x4 g0 = *(const u32x4*)gp, g1 = *(const u32x4*)(gp + 8);
            const unsigned gw[8] = {g0.x, g0.y, g0.z, g0.w, g1.x, g1.y, g1.z, g1.w};
            unsigned ow[8];
#pragma unroll
            for (int i = 0; i < 4; ++i) {
                const f32x4 on = *(const f32x4*)(p.onorm + seg * 16 + 4 * i);
                const float y0 = ov[i][0] * rstd * on[0] * __uint_as_float(gw[2 * i] << 16), y1 = ov[i][1] * rstd * on[1] * __uint_as_float(gw[2 * i] & 0xffff0000u);
                const float y2 = ov[i][2] * rstd * on[2] * __uint_as_float(gw[2 * i + 1] << 16), y3 = ov[i][3] * rstd * on[3] * __uint_as_float(gw[2 * i + 1] & 0xffff0000u);
                ow[2 * i] = cvtpk(y0, y1); ow[2 * i + 1] = cvtpk(y2, y3);
            }
            bf16_t* mp = MIX + (rb + t) * 1024 + h * 128 + seg * 16;
            *(u32x4*)mp = (u32x4){ow[0], ow[1], ow[2], ow[3]}; *(u32x4*)(mp + 8) = (u32x4){ow[4], ow[5], ow[6], ow[7]};
        }
    }
#pragma unroll
    for (int jv = 0; jv < 4; ++jv)
#pragma unroll
        for (int r = 0; r < 4; ++r) p.out[O_GSP + ((size_t)(b * 4 + h) * 64 + tt * 16 + 4 * fq + r) * 128 + (vh * 4 + jv) * 16 + fr] = Sacc[jv][r];
    __syncthreads();
}

DI void sscore_unit(const Params& p, LAS3 unsigned char* lds, int u) {
    const int tid = threadIdx.x;
    unsigned char* ws = p.ws;
    const int b = u >> 3, pg = u & 7;
    LAS3 float* qf = (LAS3 float*)lds;
    if (tid < 256) qf[tid] = bf2f(((const bf16_t*)(ws + W_IQ))[(size_t)(MP + b) * 256 + tid]);
    __syncthreads();
    const int seg = tid & 15;
    f32x4 q[4];
#pragma unroll
    for (int h = 0; h < 4; ++h) q[h] = *(const LAS3 f32x4*)(qf + h * 64 + seg * 4);
    const f32x4 wv = *(const f32x4*)vaddr((const float*)(ws + W_IW) + (size_t)(MP + b) * 4);
    unsigned* sc = (unsigned*)(ws + W_SC) + (size_t)b * SCLD;
    const int* pt = p.page_table + b * NPAGES + pg * 16;
#define SS_LOAD(BUF, pp) do { const float* base_ = p.cache_ik + (size_t)pt[(pp) < 16 ? (pp) : 15] * 8192; \
        _Pragma("unroll") for (int i = 0; i < 4; ++i) BUF[i] = *(const f32x4*)(base_ + (size_t)(tid + 512 * i) * 4); } while (0)
#define SS_COMPUTE(BUF, pp) do { \
        _Pragma("unroll") for (int i = 0; i < 4; ++i) { const f32x4 kv = BUF[i]; float dh[4]; \
            _Pragma("unroll") for (int h = 0; h < 4; ++h) { float x = q[h][0] * kv[0] + q[h][1] * kv[1] + q[h][2] * kv[2] + q[h][3] * kv[3]; \
                x += __shfl_xor(x, 1); x += __shfl_xor(x, 2); x += __shfl_xor(x, 4); x += __shfl_xor(x, 8); dh[h] = x; } \
            const float s_ = wv[0] * fmaxf(dh[0], 0.f) + wv[1] * fmaxf(dh[1], 0.f) + wv[2] * fmaxf(dh[2], 0.f) + wv[3] * fmaxf(dh[3], 0.f); \
            if (seg == 0) __hip_atomic_store(sc + (pg * 16 + (pp)) * 128 + ((tid + 512 * i) >> 4), __float_as_uint(s_), __ATOMIC_RELAXED, __HIP_MEMORY_SCOPE_AGENT); } } while (0)
    f32x4 pa[4], pb[4];
    SS_LOAD(pa, 0); SS_LOAD(pb, 1);
#pragma unroll 1
    for (int pp = 0; pp < 16; pp += 2) {
        SS_COMPUTE(pa, pp); SS_LOAD(pa, pp + 2);
        SS_COMPUTE(pb, pp + 1); SS_LOAD(pb, pp + 3);
    }
#undef SS_LOAD
#undef SS_COMPUTE
    asm volatile("s_waitcnt vmcnt(0)" ::: "memory");
    __syncthreads();
    if (tid == 0) __hip_atomic_fetch_add((unsigned*)(ws + CW_SCNT), 1u, __ATOMIC_RELAXED, __HIP_MEMORY_SCOPE_AGENT);
}

constexpr int SA_Q = 2048, SA_S = 3072, SA_KP = 8192, SA_VP = 10240;
DI void sattend(const Params& p, LAS3 unsigned char* lds, const bf16_t* qrow  , const bf16_t* gate, bf16_t* mix) {
    const int tid = threadIdx.x, lane = tid & 63, w = tid >> 6;
    LAS3 float* qf = (LAS3 float*)(lds + SA_Q); LAS3 float* S = (LAS3 float*)(lds + SA_S);
    const float* const LAS3* kptr = (const float* const LAS3*)(lds + SA_KP); const float* const LAS3* vptr = (const float* const LAS3*)(lds + SA_VP);
    if (tid < 256) qf[tid] = bf2f(qrow[tid]);
    __syncthreads();
    {
        const int jk = tid >> 1, hp = tid & 1;
        const float* kr = kptr[jk] + hp * 128;
        float s0 = 0.f, s1 = 0.f;
#pragma unroll 4
        for (int i = 0; i < 16; ++i) {
            const f32x4 k0 = *(const f32x4*)(kr + 4 * i), k1 = *(const f32x4*)(kr + 64 + 4 * i);
            const f32x4 q0 = *(const LAS3 f32x4*)(qf + hp * 128 + 4 * i), q1 = *(const LAS3 f32x4*)(qf + hp * 128 + 64 + 4 * i);
            s0 += q0[0] * k0[0] + q0[1] * k0[1] + q0[2] * k0[2] + q0[3] * k0[3];
            s1 += q1[0] * k1[0] + q1[1] * k1[1] + q1[2] * k1[2] + q1[3] * k1[3];
        }
        S[(2 * hp) * 256 + jk] = s0; S[(2 * hp + 1) * 256 + jk] = s1;
    }
    __syncthreads();
    if (w < 4) {
        float v[4], mx = NEG_INF;
#pragma unroll
        for (int i = 0; i < 4; ++i) { v[i] = S[w * 256 + lane + 64 * i]; mx = fmaxf(mx, v[i]); }
        mx = wmax64(mx);
        float sum = 0.f;
#pragma unroll
        for (int i = 0; i < 4; ++i) { v[i] = __expf(v[i] - mx); sum += v[i]; }
        sum = wsum64(sum);
        const float inv = 1.f / sum;
#pragma unroll
        for (int i = 0; i < 4; ++i) S[w * 256 + lane + 64 * i] = v[i] * inv;
    }
    __syncthreads();
    {
        const int h = tid >> 7, dd = (tid >> 1) & 63, hf = tid & 1;
        float acc = 0.f;
#pragma unroll 4
        for (int jk = hf * 128; jk < hf * 128 + 128; ++jk) acc += S[h * 256 + jk] * vptr[jk][h * 64 + dd];
        acc += __shfl_xor(acc, 1);
        if (hf == 0) mix[h * 64 + dd] = f2bf(acc * bf2f(gate[h * 64 + dd]));
    }
    __syncthreads();
}
DI void smem_unit(const Params& p, LAS3 unsigned char* lds, int b) {
    const int tid = threadIdx.x; unsigned char* ws = p.ws;
    const float* LAS3* kptr = (const float* LAS3*)(lds + SA_KP); const float* LAS3* vptr = (const float* LAS3*)(lds + SA_VP);
    if (tid < 256) { kptr[tid] = p.cache_mem_k + ((size_t)b * NMEM + tid) * 256; vptr[tid] = p.cache_mem_v + ((size_t)b * NMEM + tid) * 256; }
    const size_t row = MP + b;
    sattend(p, lds, (const bf16_t*)(ws + W_MQ) + row * 256, (const bf16_t*)(ws + W_MG) + row * 256, (bf16_t*)(ws + W_MIX) + row * 1024 + 768);
}
DI void ssel_unit(const Params& p, LAS3 unsigned char* lds, int b) {
    const int tid = threadIdx.x, lane = tid & 63, w = tid >> 6; unsigned char* ws = p.ws;
    LAS3 unsigned* CNT = (LAS3 unsigned*)lds;
    LAS3 unsigned* wsum = (LAS3 unsigned*)(lds + 256);
    LAS3 float* newsc = (LAS3 float*)(lds + 320);
    LAS3 int* list = (LAS3 int*)(lds + 512);
    const float* LAS3* kptr = (const float* LAS3*)(lds + SA_KP); const float* LAS3* vptr = (const float* LAS3*)(lds + SA_VP);
    if (tid < 48) CNT[tid] = 0u;
    if (tid == 0) {
        unsigned* cnt = (unsigned*)(ws + CW_SCNT); unsigned* tmo = (unsigned*)(ws + CW_TMO); unsigned sp = 0;
        while (__hip_atomic_load(cnt, __ATOMIC_RELAXED, __HIP_MEMORY_SCOPE_AGENT) < 256u) {
            __builtin_amdgcn_s_sleep(2);
            if ((++sp & 255u) == 0u) { if (__hip_atomic_load(tmo, __ATOMIC_RELAXED, __HIP_MEMORY_SCOPE_AGENT)) break; if (sp > (1u << 20)) { __hip_atomic_store(tmo, 1u, __ATOMIC_RELAXED, __HIP_MEMORY_SCOPE_AGENT); break; } }
        }
        __builtin_amdgcn_fence(__ATOMIC_ACQUIRE, "agent");
        asm volatile("s_waitcnt vmcnt(0)" ::: "memory");
    }
    if (w == 1) {
        const bf16_t* iq = (const bf16_t*)(ws + W_IQ) + (size_t)(MP + b) * 256; const float kd = bf2f(((const bf16_t*)(ws + W_IK))[(size_t)(MP + b) * 64 + lane]);
        const f32x4 wv = *(const f32x4*)vaddr((const float*)(ws + W_IW) + (size_t)(MP + b) * 4);
        float s = 0.f;
#pragma unroll
        for (int h = 0; h < 4; ++h) { const float dh = wsum64(bf2f(iq[h * 64 + lane]) * kd); s += wv[h] * fmaxf(dh, 0.f); }
        if (lane == 0) *newsc = s;
    }
    __syncthreads();
    const float* sc = (const float*)(ws + W_SC) + (size_t)b * SCLD;
    unsigned key[33];
#pragma unroll
    for (int n = 0; n < 32; ++n) key[n] = fkey(sc[tid + 512 * n]);
    key[32] = (tid == 0) ? fkey(*newsc) : 0u;
    int it = 0;
    unsigned T = 0u, X = 0x7fffffffu; bool fin = false;
    for (int bit = 31; bit >= 0; --bit) {
        const unsigned cand = T | (1u << bit);
        unsigned c = 0;
#pragma unroll
        for (int n = 0; n < 33; ++n) cnt_ge(c, key[n], cand);
        const unsigned tot = blk_count(c, CNT, it, lane);
        if (tot >= 256u) { T = cand; fin = (tot == 256u); }
        if (fin) break;
    }
    if (!fin) {
        unsigned c = 0;
#pragma unroll
        for (int n = 0; n < 33; ++n) cnt_gt(c, key[n], T);
        const unsigned need = 256u - blk_count(c, CNT, it, lane);
        unsigned Xl = 0u;
        for (int bit = 14; bit >= 0; --bit) {
            const unsigned cand = Xl | (1u << bit);
            c = 0;
#pragma unroll
            for (int n = 0; n < 33; ++n) cnt_eq_lt(c, key[n], T, (unsigned)(tid + 512 * n), cand);
            if (blk_count(c, CNT, it, lane) < need) Xl = cand;
        }
        X = Xl;
    }
    unsigned selm = 0, hi = 0;
#pragma unroll
    for (int n = 0; n < 32; ++n) selm |= (key[n] > T || (key[n] == T && (unsigned)(tid + 512 * n) <= X)) ? (1u << n) : 0u;
    hi = (key[32] > T || (key[32] == T && (unsigned)(tid + 16384) <= X)) ? 1u : 0u;
    const unsigned cs = __popc(selm) + hi;
    unsigned inc = cs;
#pragma unroll
    for (int o2 = 1; o2 < 64; o2 <<= 1) { const unsigned t2 = __shfl_up(inc, o2); if (lane >= o2) inc += t2; }
    if (lane == 63) wsum[w] = inc;
    __syncthreads();
    unsigned pos = inc - cs;
    for (int w2 = 0; w2 < w; ++w2) pos += wsum[w2];
#pragma unroll
    for (int n = 0; n < 32; ++n) if ((selm >> n) & 1u) { if (pos < 256u) list[pos] = tid + 512 * n; ++pos; }
    if (hi) { if (pos < 256u) list[pos] = tid + 16384; ++pos; }
    __syncthreads();
    if (tid < 256) {
        const int idx = list[tid];
        if (idx < 16384) { const size_t phys = (size_t)p.page_table[b * NPAGES + (idx >> 7)] * 128 + (idx & 127); kptr[tid] = p.cache_k + phys * 256; vptr[tid] = p.cache_v + phys * 256; }
        else { kptr[tid] = p.out + O_KS + (size_t)b * 256; vptr[tid] = p.out + O_VS + (size_t)b * 256; }
    }
    const size_t row = MP + b;
    sattend(p, lds, (const bf16_t*)(ws + W_DQ) + row * 256, (const bf16_t*)(ws + W_DG) + row * 256, (bf16_t*)(ws + W_MIX) + row * 1024 + 512);
}
DI void sgla_unit(const Params& p, LAS3 unsigned char* lds, int b) {
    const int tid = threadIdx.x, lane = tid & 63, w = tid >> 6; unsigned char* ws = p.ws;
    LAS3 float* qs = (LAS3 float*)lds; LAS3 float* ks = qs + 256; LAS3 float* gs = qs + 512; LAS3 float* vs = qs + 768; LAS3 float* part = qs + 1280;
    const size_t row = MP + b;
    if (tid < 256) {
        float u = p.b_g[tid];
        const float* gl = vaddr((const float*)(ws + W_GLR) + row * 16);
#pragma unroll
        for (int r = 0; r < 16; ++r) u += gl[r] * p.w_g2[r * 256 + tid];
        gs[tid] = expf(logsigf(u) * (1.f / 16.f));
        qs[tid] = bf2f(((const bf16_t*)(ws + W_GQ))[row * 256 + tid]); ks[tid] = bf2f(((const bf16_t*)(ws + W_GK))[row * 256 + tid]);
    }
    vs[tid] = bf2f(((const bf16_t*)(ws + W_GV))[row * 512 + tid]);
    __syncthreads();
    const int h = tid >> 7, v = tid & 127;
    const float* sp = p.state_gla + ((size_t)(b * 4 + h) * 64) * 128 + v; float* so = p.out + O_GSS + ((size_t)(b * 4 + h) * 64) * 128 + v;
    const float vv = vs[h * 128 + v];
    float o = 0.f;
#pragma unroll 8
    for (int dd = 0; dd < 64; ++dd) { const float sn = gs[h * 64 + dd] * sp[dd * 128] + ks[h * 64 + dd] * vv; so[dd * 128] = sn; o += qs[h * 64 + dd] * sn; }
    const float ss = wsum64(o * o);
    if (lane == 0) part[w] = ss;
    __syncthreads();
    const float rstd = rsqrtf((part[2 * h] + part[2 * h + 1]) * (1.f / 128.f) + 1e-6f);
    ((bf16_t*)(ws + W_MIX))[row * 1024 + h * 128 + v] = f2bf(o * rstd * p.onorm[v] * bf2f(((const bf16_t*)(ws + W_GG))[row * 512 + h * 128 + v]));
    __syncthreads();
}
DI void p4_final(const Params& p) {
    const int tid = threadIdx.x, lane = tid & 63, wv = tid >> 6;
    for (int r = blockIdx.x * 8 + wv; r < MP + NDB; r += gridDim.x * 8) {
        float* y = p.out + (r < MP ? O_YP + (size_t)r * DM : O_YS + (size_t)(r - MP) * DM);
        f32x4 v[4]; float ss = 0.f;
#pragma unroll
        for (int i = 0; i < 4; ++i) { v[i] = *(const f32x4*)(y + i * 256 + lane * 4); ss += v[i][0] * v[i][0] + v[i][1] * v[i][1] + v[i][2] * v[i][2] + v[i][3] * v[i][3]; }
        ss = wsum64(ss);
        const float rstd = rsqrtf(ss * (1.f / DM) + 1e-6f);
#pragma unroll
        for (int i = 0; i < 4; ++i) { const f32x4 gv = *(const f32x4*)(p.norm_final + i * 256 + lane * 4); *(f32x4*)(y + i * 256 + lane * 4) = v[i] * rstd * gv; }
    }
}

DI int next_unit(unsigned* ctr, volatile LAS3 unsigned* slot) {
    if (threadIdx.x == 0) *slot = __hip_atomic_fetch_add(ctr, 1u, __ATOMIC_RELAXED, __HIP_MEMORY_SCOPE_AGENT);
    __syncthreads();
    const int v = __builtin_amdgcn_readfirstlane((int)*slot);
    __syncthreads();
    return v;
}

#ifndef REP1
#define REP1 1
#endif
#ifndef REP2
#define REP2 1
#endif
#ifndef REP3
#define REP3 1
#endif
#ifndef REP2A
#define REP2A 1
#endif
#ifndef REP2B
#define REP2B 1
#endif
#ifndef REP2C
#define REP2C 1
#endif
#ifndef REP2D
#define REP2D 1
#endif
#ifndef REP2E
#define REP2E 1
#endif
DI void sample_inproj(const Params& p, LAS3 unsigned char* lds) {
    const int tid = threadIdx.x, lane = tid & 63, wv = tid >> 6, fr = lane & 15, fq = lane >> 4;
    unsigned char* ws = p.ws;
    LAS3 float* red = (LAS3 float*)lds;
    for (int pr = blockIdx.x; pr < 112; pr += gridDim.x) {
        const int col0 = pr * 32, pn = col0 >> 8, vc0 = col0 & 255;
        const bf16_t* A = (const bf16_t*)(ws + W_XN) + (size_t)MP * 1024 + (size_t)fr * 1024 + fq * 8 + wv * 128;
        const bf16_t* B = (const bf16_t*)(ws + W_WTIN) + (size_t)(col0 + fr) * 1024 + fq * 8 + wv * 128;
        const f32x4 zero = {0.f, 0.f, 0.f, 0.f};
        f32x4 acc[2][2] = {{zero, zero}, {zero, zero}};
#pragma unroll
        for (int ks = 0; ks < 4; ++ks) {
            const bf16x8 a0 = *(const bf16x8*)(A + ks * 32), a1 = *(const bf16x8*)(A + 16 * 1024 + ks * 32);
            const bf16x8 b0 = *(const bf16x8*)(B + ks * 32), b1 = *(const bf16x8*)(B + 16 * 1024 + ks * 32);
            acc[0][0] = mfma16(a0, b0, acc[0][0]); acc[0][1] = mfma16(a0, b1, acc[0][1]); acc[1][0] = mfma16(a1, b0, acc[1][0]); acc[1][1] = mfma16(a1, b1, acc[1][1]);
        }
#pragma unroll
        for (int rt = 0; rt < 2; ++rt)
#pragma unroll
            for (int ct = 0; ct < 2; ++ct)
#pragma unroll
                for (int r = 0; r < 4; ++r) red[(wv * 16 + (rt * 2 + ct) * 4 + r) * 64 + lane] = acc[rt][ct][r];
        __syncthreads();
        {
            const int rt = wv >> 2, r = wv & 3;
            float v0 = 0.f, v1 = 0.f;
#pragma unroll
            for (int w2 = 0; w2 < 8; ++w2) { v0 += red[(w2 * 16 + (rt * 2 + 0) * 4 + r) * 64 + lane]; v1 += red[(w2 * 16 + (rt * 2 + 1) * 4 + r) * 64 + lane]; }
            const float* rope = (const float*)(ws + W_ROPE) + (size_t)2048 * 64;
            {
                const int bs = 16 * rt + 4 * fq + r; const size_t R = (size_t)MP + bs;
                if (pn <= 5 || (pn >= 10 && pn <= 12)) {
                    bf16_t* dst; int ldc = 256, coff = 0; float sc = 1.f; bool silu = false;
                    switch (pn) {
                        case 0: dst = (bf16_t*)(ws + W_GQ); sc = 0.125f; break;
                        case 1: dst = (bf16_t*)(ws + W_GK); break;
                        case 2: dst = (bf16_t*)(ws + W_GV); ldc = 512; break;
                        case 3: dst = (bf16_t*)(ws + W_GV); ldc = 512; coff = 256; break;
                        case 4: dst = (bf16_t*)(ws + W_GG); ldc = 512; silu = true; break;
                        case 5: dst = (bf16_t*)(ws + W_GG); ldc = 512; coff = 256; silu = true; break;
                        case 10: dst = (bf16_t*)(ws + W_DG); silu = true; break;
                        case 11: dst = (bf16_t*)(ws + W_MQ); sc = 0.125f; break;
                        default: dst = (bf16_t*)(ws + W_MG); silu = true; break;
                    }
                    bf16_t* rp = dst + R * ldc + coff + vc0 + 8 * (fr >> 2) + (fr & 3);
                    rp[0] = f2bf(silu ? siluf(v0) : v0 * sc); rp[4] = f2bf(silu ? siluf(v1) : v1 * sc);
                } else if (pn == 6 || pn == 7 || pn == 9 || (pn == 13 && vc0 < 64)) {
                    const int hh = (pn == 13) ? 0 : ((vc0 >> 5) & 3);
                    const int f = (pn == 13) ? 16 * ((vc0 >> 5) & 1) + fr : 8 * (fr >> 2) + 4 * (vc0 >> 7) + (fr & 3);
                    const float c = rope[2 * f], s = rope[2 * f + 1], sc = (pn == 6) ? 0.125f : 1.f;
                    const float o1 = (v0 * c - v1 * s) * sc, o2 = (v1 * c + v0 * s) * sc;
                    if (pn == 13) {
                        bf16_t* ikb = (bf16_t*)(ws + W_IK) + R * 64; ikb[f] = f2bf(o1); ikb[f + 32] = f2bf(o2);
                        float* op = p.out + O_IKS + (size_t)bs * 64; op[f] = o1; op[f + 32] = o2;
                    } else {
                        bf16_t* dst = (bf16_t*)(ws + (pn == 6 ? W_DQ : (pn == 7 ? W_DK : W_IQ))) + R * 256 + 64 * hh;
                        dst[f] = f2bf(o1); dst[f + 32] = f2bf(o2);
                        if (pn == 7) { float* op = p.out + O_KS + (size_t)bs * 256 + 64 * hh; op[f] = o1; op[f + 32] = o2; }
                    }
                } else if (pn == 8) {
                    float* op = p.out + O_VS + (size_t)bs * 256 + vc0 + 8 * (fr >> 2) + (fr & 3); op[0] = v0; op[4] = v1;
                } else if (pn == 13 && vc0 == 64) {
                    if (fr < 4) { ((float*)(ws + W_IW))[R * 4 + fr] = v0 * 0.5f; ((float*)(ws + W_GLR))[R * 16 + 12 + fr] = v1; }
                    else ((float*)(ws + W_GLR))[R * 16 + fr - 4] = v0;
                }
            }
        }
        __syncthreads();
    }
}
DI void phase1(const Params& p, LAS3 unsigned char* lds) {
    unsigned char* ws = p.ws;
    { pg8::Gemm g{(const bf16_t*)(ws + W_XN), (const bf16_t*)(ws + W_WTIN), MP, NIN, DM}; pg8::StaticOrder S; S.init(MP, NIN, (int)gridDim.x, (int)blockIdx.x);
      EpiIn E{ws, p.out}; pg8::gemm_phase<EpiIn, pg8::StaticOrder, true, true>(lds, g, S, E); }
    sample_inproj(p, lds);
}
DI void p2_memgemm(const Params& p, LAS3 unsigned char* lds) {
    const int u = (int)gridDim.x - 1 - (int)blockIdx.x;
    if (u >= 96 && u < 128) {
        pg8::Gemm g{(const bf16_t*)(p.ws + W_MEMN), (const bf16_t*)(p.ws + W_WTMEM), MMEM, 512, DM}; pg8::StaticOrder S; S.init(MMEM, 512, (int)gridDim.x, u - 96);
        EpiMem E{p.ws, p.out}; pg8::gemm_phase<EpiMem, pg8::StaticOrder, true, true>(lds, g, S, E);
        asm volatile("s_waitcnt vmcnt(0)" ::: "memory");
        __syncthreads();
        if (threadIdx.x == 0) {
            __builtin_amdgcn_fence(__ATOMIC_RELEASE, "agent");
            asm volatile("s_waitcnt vmcnt(0)" ::: "memory");
            __hip_atomic_fetch_add((unsigned*)(p.ws + CW_MEMC), 1u, __ATOMIC_RELAXED, __HIP_MEMORY_SCOPE_AGENT);
        }
    }
}
DI void wait_memgemm(const Params& p) {
    if (threadIdx.x == 0) {
        unsigned* cnt = (unsigned*)(p.ws + CW_MEMC); unsigned* tmo = (unsigned*)(p.ws + CW_TMO); unsigned sp = 0;
        while (__hip_atomic_load(cnt, __ATOMIC_RELAXED, __HIP_MEMORY_SCOPE_AGENT) < 32u) {
            __builtin_amdgcn_s_sleep(2);
            if ((++sp & 255u) == 0u) { if (__hip_atomic_load(tmo, __ATOMIC_RELAXED, __HIP_MEMORY_SCOPE_AGENT)) break; if (sp > (1u << 20)) { __hip_atomic_store(tmo, 1u, __ATOMIC_RELAXED, __HIP_MEMORY_SCOPE_AGENT); break; } }
        }
        __builtin_amdgcn_fence(__ATOMIC_ACQUIRE, "agent");
        asm volatile("s_waitcnt vmcnt(0)" ::: "memory");
    }
    __syncthreads();
}
template <int QI> DI void p2_sscore(const Params& p, LAS3 unsigned char* lds) { for (int u = blockIdx.x; u < 256; u += gridDim.x) { sscore_unit(p, lds, u); __syncthreads(); } }
template <int QI> DI void p2_gla(const Params& p, LAS3 unsigned char* lds) { for (int u = blockIdx.x; u < 64; u += gridDim.x) gla_unit(p, lds, u >> 2, u & 3); }
DI int next_unit_xcd(unsigned char* qbase, volatile LAS3 unsigned* slot, unsigned x0) {
    if (threadIdx.x == 0) {
        unsigned res = 0xffffffffu;
        for (unsigned k = 0; k < 8u; ++k) {
            const unsigned xq = (x0 + k) & 7u;
            const unsigned mq = __hip_atomic_fetch_add((unsigned*)(qbase + 256 * xq), 1u, __ATOMIC_RELAXED, __HIP_MEMORY_SCOPE_AGENT);
            if (mq < 64u) { res = xq * 64u + mq; break; }
        }
        *slot = res;
    }
    __syncthreads();
    const int v = __builtin_amdgcn_readfirstlane((int)*slot);
    __syncthreads();
    return v;
}
template <int QI> DI void p2_dsa(const Params& p, LAS3 unsigned char* lds, volatile LAS3 unsigned* MISC TARGS) {
#if defined(XCDQ) && XCDQ
    const unsigned x0 = xb_xcc_id() & 7u;
    for (;;) { const int n = next_unit_xcd(p.ws + CW_QDSA + 8192 * QI, MISC + 4, x0); if (n < 0) break; const int m = n & 63; dsa_unit(p, lds, 2 * (n >> 6) + (m >> 5), 31 - (m & 31) TPASS); }
#else
    for (;;) { const int n = next_unit((unsigned*)(p.ws + CW_QDSA + 8192 * QI), MISC + 4); if (n >= 512) break; dsa_unit(p, lds, n & 15, 31 - (n >> 4) TPASS); }
#endif
}
template <int QI> DI void p2_mem(const Params& p, LAS3 unsigned char* lds, volatile LAS3 unsigned* MISC TARGS) {
    wait_memgemm(p);
    for (;;) { const int n = next_unit((unsigned*)(p.ws + CW_QMEM + 8192 * QI), MISC + 4); if (n >= 512) break; TBEG(26); mem_unit(p, lds, n); TEND(26); } }
template <int QI> DI void p2_sample(const Params& p, LAS3 unsigned char* lds) {
    for (int u = (int)gridDim.x - 1 - (int)blockIdx.x; u < 96; u += gridDim.x) { if (u < 32) sgla_unit(p, lds, u); else if (u < 64) smem_unit(p, lds, u - 32); else ssel_unit(p, lds, u - 64); } }
template <int RI> DI void phase2(const Params& p, LAS3 unsigned char* lds, volatile LAS3 unsigned* MISC TARGS) {
    TBEG(20); p2_memgemm(p, lds);
    TBEG(21); p2_sscore<0>(p, lds); TEND(21); if (REP2A > 1) p2_sscore<1>(p, lds);
    TBEG(25); p2_sample<0>(p, lds); TEND(25); if (REP2E > 1) p2_sample<1>(p, lds);
    TBEG(22); p2_gla<0>(p, lds); TEND(22); if (REP2B > 1) p2_gla<1>(p, lds);
    TBEG(23); p2_dsa<0>(p, lds, MISC TPASS); TEND(23); if (REP2C > 1) p2_dsa<1>(p, lds, MISC TPASS);
    TBEG(24); p2_mem<0>(p, lds, MISC TPASS); TEND(24); if (REP2D > 1) p2_mem<1>(p, lds, MISC TPASS);
    TEND(20);
}
DI void phase3(const Params& p, LAS3 unsigned char* lds) {
    pg8::Gemm g{(const bf16_t*)(p.ws + W_MIX), (const bf16_t*)(p.ws + W_WTOUT), MP, DM, DM}; pg8::StaticOrder S; S.init(MP, DM, (int)gridDim.x, (int)blockIdx.x);
    EpiOut E{p.x_prompt, p.x_sample, p.out}; pg8::gemm_phase<EpiOut, pg8::StaticOrder, true, true>(lds, g, S, E);
    const int tid = threadIdx.x, lane = tid & 63, wv = tid >> 6;
    for (int u = blockIdx.x; u < 256; u += gridDim.x) {
        const int b = u >> 3, col0 = (u & 7) * 128 + wv * 16;
        const bf16_t* mrow = (const bf16_t*)(p.ws + W_MIX) + (size_t)(MP + b) * 1024 + lane * 16;
        const u32x4 m0 = *(const u32x4*)mrow, m1 = *(const u32x4*)(mrow + 8);
        const unsigned mw[8] = {m0.x, m0.y, m0.z, m0.w, m1.x, m1.y, m1.z, m1.w};
        float res = 0.f;
#pragma unroll 4
        for (int i = 0; i < 16; ++i) {
            const bf16_t* wrow = (const bf16_t*)(p.ws + W_WTOUT) + (size_t)(col0 + i) * 1024 + lane * 16;
            const u32x4 w0 = *(const u32x4*)wrow, w1 = *(const u32x4*)(wrow + 8);
            const unsigned ww[8] = {w0.x, w0.y, w0.z, w0.w, w1.x, w1.y, w1.z, w1.w};
            float acc = 0.f;
#pragma unroll
            for (int e = 0; e < 8; ++e) acc += __uint_as_float(mw[e] << 16) * __uint_as_float(ww[e] << 16) + __uint_as_float(mw[e] & 0xffff0000u) * __uint_as_float(ww[e] & 0xffff0000u);
            acc = wsum64(acc);
            res = (lane == i) ? acc : res;
        }
        if (lane < 16) p.out[O_YS + (size_t)b * DM + col0 + lane] = p.x_sample[(size_t)b * DM + col0 + lane] + res;
    }
}
#ifdef CHECK_ATT
DI void check_mem_attention(const Params& p) {
    const int tid = threadIdx.x, lane = tid & 63, wv = tid >> 6;
    const int samp = blockIdx.x * 8 + wv;
    const int row = (samp * 977 + 13) % MP, h = samp & 3, b = row >> 11;
    const bf16_t* q = (const bf16_t*)(p.ws + W_MQ) + (size_t)row * 256 + h * 64;
    float s[4];
#pragma unroll
    for (int i = 0; i < 4; ++i) { const float* kr = p.out + O_MKP + ((size_t)b * NMEM + lane + 64 * i) * 256 + h * 64; float a = 0.f; for (int d = 0; d < 64; ++d) a += bf2f(q[d]) * kr[d]; s[i] = a; }
    float mx = wmax64(fmaxf(fmaxf(s[0], s[1]), fmaxf(s[2], s[3])));
    float pe[4], sum = 0.f;
#pragma unroll
    for (int i = 0; i < 4; ++i) { pe[i] = __builtin_amdgcn_exp2f(s[i] - mx); sum += pe[i]; }
    sum = wsum64(sum);
    float err = 0.f, nrm = 0.f;
    for (int d = 0; d < 64; ++d) {
        float a = 0.f;
#pragma unroll
        for (int i = 0; i < 4; ++i) a += pe[i] * p.out[O_MVP + ((size_t)b * NMEM + lane + 64 * i) * 256 + h * 64 + d];
        a = wsum64(a) / sum;
        const float want = a * bf2f(((const bf16_t*)(p.ws + W_MG))[(size_t)row * 256 + h * 64 + d]);
        const float got = bf2f(((const bf16_t*)(p.ws + W_MIX))[(size_t)row * 1024 + 768 + h * 64 + d]);
        err += (got - want) * (got - want); nrm += want * want;
    }
    if (lane == 0) { atomicAdd((unsigned*)(p.ws + CW_CHK + 12), 1u); if (!(err <= 0.0025f * nrm + 1e-12f)) atomicAdd((unsigned*)(p.ws + CW_CHK + 8), 1u); }
    if (samp < 128) {
        const int bs = samp >> 2, hs = samp & 3; const size_t rs = (size_t)MP + bs;
        const bf16_t* qs = (const bf16_t*)(p.ws + W_MQ) + rs * 256 + hs * 64;
        float s2[4];
#pragma unroll
        for (int i = 0; i < 4; ++i) { const float* kr = p.cache_mem_k + ((size_t)bs * NMEM + lane + 64 * i) * 256 + hs * 64; float a = 0.f; for (int d = 0; d < 64; ++d) a += bf2f(qs[d]) * kr[d]; s2[i] = a; }
        const float mx2 = wmax64(fmaxf(fmaxf(s2[0], s2[1]), fmaxf(s2[2], s2[3])));
        float pe2[4], sum2 = 0.f;
#pragma unroll
        for (int i = 0; i < 4; ++i) { pe2[i] = __expf(s2[i] - mx2); sum2 += pe2[i]; }
        sum2 = wsum64(sum2);
        float err2 = 0.f, nrm2 = 0.f;
        for (int d = 0; d < 64; ++d) {
            float a = 0.f;
#pragma unroll
            for (int i = 0; i < 4; ++i) a += pe2[i] * p.cache_mem_v[((size_t)bs * NMEM + lane + 64 * i) * 256 + hs * 64 + d];
            a = wsum64(a) / sum2;
            const float want = a * bf2f(((const bf16_t*)(p.ws + W_MG))[rs * 256 + hs * 64 + d]);
            const float got = bf2f(((const bf16_t*)(p.ws + W_MIX))[rs * 1024 + 768 + hs * 64 + d]);
            err2 += (got - want) * (got - want); nrm2 += want * want;
        }
        if (lane == 0) { atomicAdd((unsigned*)(p.ws + CW_CHK + 12), 1u); if (!(err2 <= 0.0025f * nrm2 + 1e-12f)) atomicAdd((unsigned*)(p.ws + CW_CHK + 8), 1u); }
    }
}
#endif
__global__ void __launch_bounds__(NTHREADS, 2) hymba_fwd(Params p) {
    extern __shared__ __attribute__((aligned(16))) unsigned char lds_raw[];
    LAS3 unsigned char* lds = (LAS3 unsigned char*)lds_raw;
    volatile LAS3 unsigned* MISC = (volatile LAS3 unsigned*)(lds + LDS_MISC);
    const int tid = threadIdx.x;
    if (tid < 64) MISC[tid] = 0u;
    __syncthreads();
    const int lo = p.ph_lo, hi = p.ph_hi;
    TDECL;
    XcdBarrier bar; bar.bar = (unsigned*)p.ws; bar.x = 0; bar.st = MISC;
    if (hi > lo) bar = xcd_barrier_post((unsigned*)p.ws, MISC);
#define IN(k) (lo <= (k) && (k) <= hi)
#define SEAM(k) do { if (IN(k) && IN((k) + 1)) xcd_barrier(bar); } while (0)
    TBEG(0); if (IN(0)) p0_prologue(p, lds); TEND(0);
    TBEG(10); SEAM(0); TEND(10);
    TBEG(1); if (IN(1)) { phase1(p, lds); if (REP1 > 1) { xcd_barrier(bar); phase1(p, lds); } } TEND(1);
    TBEG(11); SEAM(1); TEND(11);
    TBEG(2); if (IN(2)) { phase2<0>(p, lds, MISC TPASS); } TEND(2);
    TBEG(12); SEAM(2); TEND(12);
#if defined(TSEL) && TSEL == 14
    TBEG(14); xcd_barrier(bar); TEND(14);
#endif
#ifdef CHECK_ATT
    if (IN(3)) check_mem_attention(p);
#endif
    TBEG(3); if (IN(3)) { phase3(p, lds); if (REP3 > 1) { xcd_barrier(bar); phase3(p, lds); } } TEND(3);
    TBEG(13); SEAM(3); TEND(13);
    TBEG(4); if (IN(4)) p4_final(p); TEND(4);
#ifdef TSEL
    {
#ifdef TCLS
        if (tid == 0 && (int)((blockIdx.x >> 6) & 1) == TCLS) { atomicAdd((unsigned long long*)(p.ws + CW_TSUM), 2ull * (unsigned long long)tacc_); atomicMax((unsigned long long*)(p.ws + CW_TMAX), (unsigned long long)tacc_); }
#else
        if (tid == 0) { atomicAdd((unsigned long long*)(p.ws + CW_TSUM), (unsigned long long)tacc_); atomicMax((unsigned long long*)(p.ws + CW_TMAX), (unsigned long long)tacc_); }
#endif
        xcd_barrier(bar);
        if (blockIdx.x == 0 && tid == 0) {
#ifdef TMAX
            unsigned long long dly = __hip_atomic_load((unsigned long long*)(p.ws + CW_TMAX), __ATOMIC_RELAXED, __HIP_MEMORY_SCOPE_AGENT);
#else
            const unsigned long long dly = __hip_atomic_load((unsigned long long*)(p.ws + CW_TSUM), __ATOMIC_RELAXED, __HIP_MEMORY_SCOPE_AGENT) / gridDim.x;
#endif
#ifndef TMUL
#define TMUL 1
#endif
            const unsigned long long t0 = __builtin_amdgcn_s_memrealtime();
            while (__builtin_amdgcn_s_memrealtime() - t0 < dly * TMUL && __builtin_amdgcn_s_memrealtime() - t0 < 400000ull) __builtin_amdgcn_s_sleep(8);
        }
    }
#endif
#ifdef CHECK_ATT
    {
        xcd_barrier(bar);
        const unsigned nbad = __hip_atomic_load((unsigned*)(p.ws + CW_CHK + 8), __ATOMIC_RELAXED, __HIP_MEMORY_SCOPE_AGENT);
        const unsigned nchk = __hip_atomic_load((unsigned*)(p.ws + CW_CHK + 12), __ATOMIC_RELAXED, __HIP_MEMORY_SCOPE_AGENT);
        if (nbad != 0u || nchk < 2170u) for (int i = blockIdx.x * NTHREADS + tid; i < NDB * DM; i += gridDim.x * NTHREADS) p.out[O_YS + i] = __builtin_nanf("");
    }
#endif
#ifdef CHECK_SEL
    {
        xcd_barrier(bar);
        const unsigned nbad = __hip_atomic_load((unsigned*)(p.ws + CW_CHK), __ATOMIC_RELAXED, __HIP_MEMORY_SCOPE_AGENT);
        const unsigned nhist = __hip_atomic_load((unsigned*)(p.ws + CW_CHK + 4), __ATOMIC_RELAXED, __HIP_MEMORY_SCOPE_AGENT);
        if (nbad != 0u || nhist < CHECK_MIN_HIST) for (int i = blockIdx.x * NTHREADS + tid; i < NDB * DM; i += gridDim.x * NTHREADS) p.out[O_YS + i] = __builtin_nanf("");
    }
#endif
#undef IN
#undef SEAM
}

#ifndef N_LAUNCHES
#define N_LAUNCHES 1
#endif
extern "C" void kernel_launch(void* const* d_in, const int* in_sizes, int n_in, void* d_out, int out_size, void* d_ws, size_t ws_size, hipStream_t stream) {
    static int grid = 0;
    if (grid == 0) {
        if (n_in != 19 || (size_t)out_size != O_END || ws_size < W_END) fprintf(stderr, "kernel_launch: unexpected sizes: n_in %d out %d ws %zu (need %zu)\n", n_in, out_size, ws_size, (size_t)W_END);
        int dev = 0, cus = 0, per_cu = 0;
        if (hipGetDevice(&dev) != hipSuccess || hipDeviceGetAttribute(&cus, hipDeviceAttributeMultiprocessorCount, dev) != hipSuccess) { fprintf(stderr, "kernel_launch: device query failed\n"); grid = -1; return; }
        if (hipFuncSetAttribute((const void*)hymba_fwd, hipFuncAttributeMaxDynamicSharedMemorySize, LDS_BYTES) != hipSuccess) { fprintf(stderr, "kernel_launch: hipFuncSetAttribute failed\n"); grid = -1; return; }
        if (hipOccupancyMaxActiveBlocksPerMultiprocessor(&per_cu, (const void*)hymba_fwd, NTHREADS, LDS_BYTES) != hipSuccess || per_cu < 1) fprintf(stderr, "kernel_launch: occupancy query reports %d blocks per CU\n", per_cu);
        (void)hipGetLastError();
        grid = cus;
    }
    if (grid < 0) return;
    (void)hipMemsetAsync(d_ws, 0, CTRL_BYTES, stream);
    Params p{};
    p.x_prompt = (const float*)d_in[0]; p.x_sample = (const float*)d_in[1]; p.mem_prompt = (const float*)d_in[2]; p.state_gla = (const float*)d_in[3];
    p.cache_k = (const float*)d_in[4]; p.cache_v = (const float*)d_in[5]; p.cache_ik = (const float*)d_in[6]; p.cache_mem_k = (const float*)d_in[7]; p.cache_mem_v = (const float*)d_in[8];
    p.page_table = (const int*)d_in[9];
    p.norm_in = (const float*)d_in[10]; p.w_in = (const float*)d_in[11]; p.w_g2 = (const float*)d_in[12]; p.b_g = (const float*)d_in[13]; p.onorm = (const float*)d_in[14];
    p.mem_norm = (const float*)d_in[15]; p.w_mem_kv = (const float*)d_in[16]; p.w_out = (const float*)d_in[17]; p.norm_final = (const float*)d_in[18];
    p.out = (float*)d_out; p.ws = (unsigned char*)d_ws;
#if N_LAUNCHES == 1
    p.ph_lo = 0; p.ph_hi = 4;
    hipLaunchKernelGGL(hymba_fwd, dim3(grid), dim3(NTHREADS), LDS_BYTES, stream, p);
#else
    for (int ph = 0; ph < 5; ++ph) { p.ph_lo = ph; p.ph_hi = ph; hipLaunchKernelGGL(hymba_fwd, dim3(grid), dim3(NTHREADS), LDS_BYTES, stream, p); }
#endif
    const hipError_t le = hipPeekAtLastError();
    if (le != hipSuccess) fprintf(stderr, "kernel_launch: launch failed: %s\n", hipGetErrorName(le));
}
```
